# Optimizing an MI355X kernel written in HIP

```python
import math
import jax
import jax.numpy as jnp
from jax import lax
import numpy as np

D_MODEL = 2048
BATCH = 4
SEQ = 4096
DEPTH = 4

GRID_W = 64
CTX_LEN = 256
Q_BLOCK = 128
ROPE_THETA = 10000.0
EPS = 1e-6

HEAD_DIM = 128
BRANCH_WIDTH = 1024
N_BRANCHES = 3
GQA_HEADS = 8
GQA_KV_HEADS = 2
GQA_GROUP = GQA_HEADS // GQA_KV_HEADS
MLA_HEADS = 8
MLA_NOPE = 128
MLA_ROPE = 64
MLA_V = 128
MLA_KV_RANK = 512
DIFF_HEADS = 8
DIFF_QK = 64
DIFF_V = 128

IN_SIZES = (
    GQA_HEADS * HEAD_DIM,
    GQA_KV_HEADS * HEAD_DIM,
    GQA_KV_HEADS * HEAD_DIM,
    MLA_HEADS * (MLA_NOPE + MLA_ROPE),
    MLA_KV_RANK,
    MLA_ROPE,
    DIFF_HEADS * 2 * DIFF_QK,
    DIFF_HEADS * 2 * DIFF_QK,
    DIFF_HEADS * DIFF_V,
    N_BRANCHES * BRANCH_WIDTH,
    N_BRANCHES * D_MODEL,
)
IN_COLS = sum(IN_SIZES)

kernel_name = 'hybrid_gqa_mla_diffattn_prefix_block'


def rms_norm(x, w):
    x32 = x.astype(jnp.float32)
    y = x32 * lax.rsqrt(jnp.mean(jnp.square(x32), axis=-1, keepdims=True) + EPS)
    return (y * w.astype(jnp.float32)).astype(x.dtype)


def axial_rope_tables(pos_row, pos_col, rot_dim):
    axis_dim = rot_dim // 2
    inv_freq = ROPE_THETA ** (-jnp.arange(0, axis_dim, 2, dtype=jnp.float32) / axis_dim)
    ang_r = pos_row[:, None] * inv_freq
    ang_c = pos_col[:, None] * inv_freq
    ang = jnp.concatenate([ang_r, ang_r, ang_c, ang_c], axis=-1)
    return jnp.cos(ang), jnp.sin(ang)


def rotate_half(x):
    x1, x2 = jnp.split(x, 2, axis=-1)
    return jnp.concatenate([-x2, x1], axis=-1)


def apply_axial_rope(x, tab):
    cos, sin = tab
    shape = (cos.shape[0],) + (1,) * (x.ndim - 3) + (cos.shape[1],)
    cos = cos.reshape(shape).astype(x.dtype)
    sin = sin.reshape(shape).astype(x.dtype)
    xr, xc = jnp.split(x, 2, axis=-1)
    rot = jnp.concatenate([rotate_half(xr), rotate_half(xc)], axis=-1)
    return x * cos + rot * sin


def attn_probs(q, k):
    s = jnp.einsum('bqhgd,bkhd->bhgqk', q.astype(jnp.float32), k.astype(jnp.float32))
    return jax.nn.softmax(s * (q.shape[-1] ** -0.5), axis=-1)


def attn_apply(p, v):
    return jnp.einsum('bhgqk,bkhd->bqhgd', p.astype(v.dtype), v)


def sweep_query_blocks(fn, qs):
    b, n = qs[0].shape[:2]
    nblk = n // Q_BLOCK
    to_blocks = lambda a: jnp.moveaxis(a.reshape((b, nblk, Q_BLOCK) + a.shape[2:]), 1, 0)
    from_blocks = lambda a: jnp.moveaxis(a, 0, 1).reshape((b, n) + a.shape[3:])
    out = lax.map(fn, tuple(to_blocks(q) for q in qs))
    return jax.tree_util.tree_map(from_blocks, out)


def stream_qkv(h, p, tabs):
    b, n, _ = h.shape
    splits = [int(i) for i in np.cumsum(IN_SIZES)[:-1]]
    (gq, gk, gv, mq, mckv, mkr, dq, dk, dv, gate_in, merge_in) = jnp.split(h @ p['w_in'], splits, axis=-1)
    gq = rms_norm(gq.reshape(b, n, GQA_KV_HEADS, GQA_GROUP, HEAD_DIM), p['gqa_q_norm'])
    gk = rms_norm(gk.reshape(b, n, GQA_KV_HEADS, HEAD_DIM), p['gqa_k_norm'])
    gv = gv.reshape(b, n, GQA_KV_HEADS, HEAD_DIM)
    mq = mq.reshape(b, n, MLA_HEADS, 1, MLA_NOPE + MLA_ROPE)
    mq_nope = rms_norm(mq[..., :MLA_NOPE], p['mla_q_nope_norm'])
    mq_rope = rms_norm(mq[..., MLA_NOPE:], p['mla_q_rope_norm'])
    c_kv = rms_norm(mckv, p['mla_kv_norm'])
    mk_nope = rms_norm((c_kv @ p['mla_w_uk']).reshape(b, n, MLA_HEADS, MLA_NOPE), p['mla_k_nope_norm'])
    mv = (c_kv @ p['mla_w_uv']).reshape(b, n, MLA_HEADS, MLA_V)
    mk_rope = rms_norm(mkr, p['mla_k_rope_norm'])[:, :, None, :]
    dq = rms_norm(dq.reshape(b, n, DIFF_HEADS, 2, DIFF_QK), p['diff_q_norm'])
    dk = rms_norm(dk.reshape(b, n, DIFF_HEADS, 2, DIFF_QK), p['diff_k_norm'])
    dv = dv.reshape(b, n, DIFF_HEADS, DIFF_V)
    if tabs is not None:
        gq = apply_axial_rope(gq, tabs[HEAD_DIM])
        gk = apply_axial_rope(gk, tabs[HEAD_DIM])
        mq_rope = apply_axial_rope(mq_rope, tabs[MLA_ROPE])
        mk_rope = apply_axial_rope(mk_rope, tabs[MLA_ROPE])
        dq = apply_axial_rope(dq, tabs[DIFF_QK])
        dk = apply_axial_rope(dk, tabs[DIFF_QK])
    mq = jnp.concatenate([mq_nope, mq_rope], axis=-1)
    mk = jnp.concatenate([mk_nope, jnp.broadcast_to(mk_rope, (b, n, MLA_HEADS, MLA_ROPE))], axis=-1)
    queries = (gq, mq, dq[:, :, :, 0:1, :], dq[:, :, :, 1:2, :])
    kv = (gk, gv, mk, mv, dk[:, :, :, 0, :], dk[:, :, :, 1, :], dv)
    return queries, kv, gate_in, merge_in


def attend_all(queries, kv, lam):
    gq, mq, dq1, dq2 = queries
    gk, gv, mk, mv, dk1, dk2, dv = kv
    o_a = attn_apply(attn_probs(gq, gk), gv)
    o_b = attn_apply(attn_probs(mq, mk), mv)
    o_c = attn_apply(attn_probs(dq1, dk1) - lam * attn_probs(dq2, dk2), dv)
    return o_a, o_b, o_c


def merge_branches(outs, gate_in, merge_in, p, lam_init):
    o_a, o_b, o_c = outs
    b, n = gate_in.shape[:2]
    o_c = rms_norm(o_c.reshape(b, n, DIFF_HEADS, DIFF_V), p['diff_subln']) * (1.0 - lam_init)
    branches = (o_a.reshape(b, n, BRANCH_WIDTH), o_b.reshape(b, n, BRANCH_WIDTH), o_c.reshape(b, n, BRANCH_WIDTH))
    g = jnp.split(jax.nn.silu(gate_in), N_BRANCHES, axis=-1)
    m = jnp.split(jax.nn.sigmoid(merge_in + p['b_merge']), N_BRANCHES, axis=-1)
    y = (m[0] * ((branches[0] * g[0]) @ p['w_br_gqa'])
         + m[1] * ((branches[1] * g[1]) @ p['w_br_mla'])
         + m[2] * ((branches[2] * g[2]) @ p['w_br_diff']))
    return y @ p['w_out']


def setup_inputs(seed: int = 0) -> dict:
    key = jax.random.key(seed)
    ks = jax.random.split(key, 32)
    counter = iter(range(32))

    def nrm(shape, scale):
        return jax.random.normal(ks[next(counter)], shape, jnp.float32) * scale

    def gain(dim):
        return 1.0 + nrm((DEPTH, dim), 0.02)

    L = DEPTH
    return {
        'x': nrm((BATCH, SEQ, D_MODEL), 1.0),
        'c': nrm((BATCH, D_MODEL), 1.0),
        'ctx': nrm((BATCH, CTX_LEN, D_MODEL), 1.0),
        'c_ctx': nrm((D_MODEL,), 1.0),
        'norm_w': gain(D_MODEL),
        'w_ada': nrm((L, D_MODEL, 3 * D_MODEL), 0.5 * D_MODEL ** -0.5),
        'b_ada': nrm((L, 3 * D_MODEL), 0.01),
        'w_in': nrm((L, D_MODEL, IN_COLS), D_MODEL ** -0.5),
        'b_merge': nrm((L, N_BRANCHES * D_MODEL), 0.01),
        'gqa_q_norm': gain(HEAD_DIM),
        'gqa_k_norm': gain(HEAD_DIM),
        'mla_q_nope_norm': gain(MLA_NOPE),
        'mla_q_rope_norm': gain(MLA_ROPE),
        'mla_kv_norm': gain(MLA_KV_RANK),
        'mla_w_uk': nrm((L, MLA_KV_RANK, MLA_HEADS * MLA_NOPE), MLA_KV_RANK ** -0.5),
        'mla_w_uv': nrm((L, MLA_KV_RANK, MLA_HEADS * MLA_V), MLA_KV_RANK ** -0.5),
        'mla_k_nope_norm': gain(MLA_NOPE),
        'mla_k_rope_norm': gain(MLA_ROPE),
        'diff_q_norm': gain(DIFF_QK),
        'diff_k_norm': gain(DIFF_QK),
        'diff_lambda_q1': nrm((L, DIFF_QK), 0.1),
        'diff_lambda_k1': nrm((L, DIFF_QK), 0.1),
        'diff_lambda_q2': nrm((L, DIFF_QK), 0.1),
        'diff_lambda_k2': nrm((L, DIFF_QK), 0.1),
        'diff_subln': gain(DIFF_V),
        'w_br_gqa': nrm((L, BRANCH_WIDTH, D_MODEL), BRANCH_WIDTH ** -0.5),
        'w_br_mla': nrm((L, BRANCH_WIDTH, D_MODEL), BRANCH_WIDTH ** -0.5),
        'w_br_diff': nrm((L, BRANCH_WIDTH, D_MODEL), BRANCH_WIDTH ** -0.5),
        'w_out': nrm((L, D_MODEL, D_MODEL), D_MODEL ** -0.5),
    }


def reference(x, c, ctx, c_ctx, norm_w, w_ada, b_ada, w_in, b_merge,
              gqa_q_norm, gqa_k_norm,
              mla_q_nope_norm, mla_q_rope_norm, mla_kv_norm, mla_w_uk, mla_w_uv,
              mla_k_nope_norm, mla_k_rope_norm,
              diff_q_norm, diff_k_norm, diff_lambda_q1, diff_lambda_k1,
              diff_lambda_q2, diff_lambda_k2, diff_subln,
              w_br_gqa, w_br_mla, w_br_diff, w_out):
    n = x.shape[1]
    rows = n // GRID_W
    pos_row = jnp.repeat(jnp.arange(rows, dtype=jnp.float32), GRID_W)
    pos_col = jnp.tile(jnp.arange(GRID_W, dtype=jnp.float32), rows)
    tabs = {d: axial_rope_tables(pos_row, pos_col, d) for d in (HEAD_DIM, MLA_ROPE, DIFF_QK)}

    silu_c = jax.nn.silu(c)
    silu_cc = jax.nn.silu(c_ctx)
    for l in range(DEPTH):
        p = dict(
            w_in=w_in[l], b_merge=b_merge[l],
            gqa_q_norm=gqa_q_norm[l], gqa_k_norm=gqa_k_norm[l],
            mla_q_nope_norm=mla_q_nope_norm[l], mla_q_rope_norm=mla_q_rope_norm[l],
            mla_kv_norm=mla_kv_norm[l], mla_w_uk=mla_w_uk[l], mla_w_uv=mla_w_uv[l],
            mla_k_nope_norm=mla_k_nope_norm[l], mla_k_rope_norm=mla_k_rope_norm[l],
            diff_q_norm=diff_q_norm[l], diff_k_norm=diff_k_norm[l], diff_subln=diff_subln[l],
            w_br_gqa=w_br_gqa[l], w_br_mla=w_br_mla[l], w_br_diff=w_br_diff[l], w_out=w_out[l],
        )
        shift, scale, gate = jnp.split(silu_c @ w_ada[l] + b_ada[l], 3, axis=-1)
        shift_c, scale_c, gate_c = jnp.split(silu_cc @ w_ada[l] + b_ada[l], 3, axis=-1)
        h_lat = rms_norm(x, norm_w[l]) * (1.0 + scale[:, None, :]) + shift[:, None, :]
        h_ctx = rms_norm(ctx, norm_w[l]) * (1.0 + scale_c) + shift_c

        q_lat, kv_lat, gate_lat, merge_lat = stream_qkv(h_lat, p, tabs)
        q_ctx, kv_ctx, gate_ctx, merge_ctx = stream_qkv(h_ctx, p, None)

        lam_init = 0.8 - 0.6 * math.exp(-0.3 * l)
        lam = (jnp.exp(jnp.sum(diff_lambda_q1[l].astype(jnp.float32) * diff_lambda_k1[l].astype(jnp.float32)))
               - jnp.exp(jnp.sum(diff_lambda_q2[l].astype(jnp.float32) * diff_lambda_k2[l].astype(jnp.float32)))
               + lam_init)

        kv_all = tuple(jnp.concatenate([kc, kl], axis=1) for kc, kl in zip(kv_ctx, kv_lat))
        o_lat = sweep_query_blocks(lambda qb: attend_all(qb, kv_all, lam), q_lat)
        out_lat = merge_branches(o_lat, gate_lat, merge_lat, p, lam_init)
        if l < DEPTH - 1:
            o_ctx = attend_all(q_ctx, kv_ctx, lam)
            out_ctx = merge_branches(o_ctx, gate_ctx, merge_ctx, p, lam_init)
            ctx = ctx + gate_c * out_ctx
        x = x + gate[:, None, :] * out_lat
    return x
```

```cpp
#include <hip/hip_runtime.h>
#include <hip/hip_cooperative_groups.h>
#include <cstdio>
#include <cstdint>
namespace cg = cooperative_groups;

#ifndef MK_MASK
#define MK_MASK 127
#endif
#ifndef MK_ATYPE
#define MK_ATYPE 7
#endif
#ifndef MK_G1T
#define MK_G1T 127
#endif
#ifndef MK_COOP
#define MK_COOP 1
#endif

#define LAS __attribute__((address_space(3)))
typedef unsigned short bf16_t;
typedef short bf16x8 __attribute__((ext_vector_type(8)));
typedef short s16x4 __attribute__((ext_vector_type(4)));
typedef float f32x4 __attribute__((ext_vector_type(4)));
typedef float f32x16 __attribute__((ext_vector_type(16)));
typedef unsigned u32x4 __attribute__((ext_vector_type(4)));
typedef unsigned u32x2 __attribute__((ext_vector_type(2)));

constexpr int DM = 2048, NBATCH = 4, SEQ = 4096, CTXL = 256, DEPTH = 4;
constexpr int MLAT = NBATCH * SEQ, MCTX = NBATCH * CTXL, MTOT = MLAT + MCTX;
constexpr int INC = 15936, NIN = 16128;
constexpr float EPS = 1e-6f;
constexpr int NPH = 1 + 6 * DEPTH;

constexpr size_t alignup(size_t x) { return (x + 255) / 256 * 256; }
constexpr size_t WS_MOD = 0;
constexpr size_t WS_TC64 = WS_MOD + alignup((size_t)DEPTH * 5 * 6144 * 4);
constexpr size_t WS_TS64 = WS_TC64 + 4096, WS_TC128 = WS_TS64 + 4096, WS_TS128 = WS_TC128 + 8192;
constexpr size_t WS_LAM = WS_TS128 + 8192;
constexpr size_t WS_WIN = WS_LAM + 256;
constexpr size_t WS_WUP = WS_WIN + (size_t)DEPTH * NIN * DM * 2;
constexpr size_t WS_WBR = WS_WUP + (size_t)DEPTH * 2048 * 512 * 2;
constexpr size_t WS_WOUT = WS_WBR + (size_t)DEPTH * 2048 * 3072 * 2;
constexpr size_t WS_H = WS_WOUT + (size_t)DEPTH * 2048 * 2048 * 2;
constexpr size_t WS_QA = WS_H + (size_t)MTOT * 2048 * 2;
constexpr size_t WS_KA = WS_QA + (size_t)MTOT * 1024 * 2;
constexpr size_t WS_VA = WS_KA + (size_t)MTOT * 256 * 2;
constexpr size_t WS_QB = WS_VA + (size_t)MTOT * 256 * 2;
constexpr size_t WS_KB = WS_QB + (size_t)MTOT * 1536 * 2;
constexpr size_t WS_CKV = WS_KB + (size_t)MTOT * 1536 * 2;
constexpr size_t WS_VB = WS_CKV + (size_t)MTOT * 512 * 2;
constexpr size_t WS_QC = WS_VB + (size_t)MTOT * 1024 * 2;
constexpr size_t WS_KC = WS_QC + (size_t)MTOT * 1024 * 2;
constexpr size_t WS_VC = WS_KC + (size_t)MTOT * 1024 * 2;
constexpr size_t WS_GATE = WS_VC + (size_t)MTOT * 1024 * 2;
constexpr size_t WS_MRG = WS_GATE + (size_t)MTOT * 3072 * 2;
constexpr size_t WS_BR = WS_MRG + (size_t)MTOT * 6144 * 2;
constexpr size_t WS_Y = WS_BR + (size_t)MTOT * 3072 * 2;
constexpr size_t WS_SS = WS_Y + (size_t)MTOT * 2048 * 2;
constexpr size_t WS_CTXW = WS_SS + (size_t)MTOT * 8 * 4;
constexpr size_t WS_SCR = WS_CTXW + (size_t)MCTX * DM * 4;
constexpr size_t WS_END = WS_SCR + (size_t)256 * 64 * 512 * 4;

constexpr int RING_BYTES = 131072, XCH_OFF = RING_BYTES, LDS_BYTES = 147456;

__device__ __forceinline__ float bf2f(unsigned h) { return __uint_as_float(h << 16); }
__device__ __forceinline__ unsigned cvt_pk_bf16(float lo, float hi) { unsigned r; asm volatile("v_cvt_pk_bf16_f32 %0, %1, %2" : "=v"(r) : "v"(lo), "v"(hi)); return r; }
__device__ __forceinline__ float wave_sum(float v) {
#pragma unroll
    for (int o = 1; o < 64; o <<= 1) v += __shfl_xor(v, o);
    return v;
}
__device__ __forceinline__ float silu_f(float x) { return x / (1.f + __expf(-x)); }
__device__ __forceinline__ float sigm_f(float x) { return 1.f / (1.f + __expf(-x)); }
__device__ __forceinline__ void store8(bf16_t* p, f32x4 a, f32x4 b) {
    u32x4 w; w.x = cvt_pk_bf16(a[0], a[1]); w.y = cvt_pk_bf16(a[2], a[3]); w.z = cvt_pk_bf16(b[0], b[1]); w.w = cvt_pk_bf16(b[2], b[3]);
    *(u32x4*)p = w;
}

namespace pg8 {
constexpr int BM = 256, BK = 64, HALF = 128, HTB = HALF * BK * 2, NXCD = 8, WGM = 8;
__host__ __device__ __forceinline__ int lds_byte(int r, int c) { const int st = (r >> 4) * 2 + (c >> 5), rr = r & 15, cc = c & 31, ob = rr * 64 + cc * 2; return st * 1024 + (ob ^ (((ob >> 9) & 1) << 5)); }
__host__ __device__ __forceinline__ void stage_rc(int b, int& R, int& C) { const int st = b / 1024, sb = b % 1024, swz = sb ^ (((sb >> 9) & 1) << 5); R = (st >> 1) * 16 + swz / 64; C = (st & 1) * 32 + (swz % 64) / 2; }
__host__ __device__ __forceinline__ int perm32(int rho) { const int n = rho >> 4, i = rho & 15; return 8 * (i >> 2) + 4 * n + (i & 3); }

struct Unit { int pm, pn; };
struct Gemm { const bf16_t* A; const bf16_t* Bt; int M, N, K; };
struct StaticOrder {
    int nM, nN, nwg, G, c;
    __device__ void init(int M, int N, int G_, int c_) { nM = M / BM; nN = N / BM; nwg = nM * nN; G = G_; c = c_; }
    __device__ bool next(int i, Unit& u) const {
        const long L = (long)i * G + c; if (L >= nwg) return false;
        int wgid = (int)L; { const int q = nwg / NXCD, r = nwg % NXCD, xcd = wgid % NXCD, off = wgid / NXCD; wgid = (xcd < r ? xcd * (q + 1) : r * (q + 1) + (xcd - r) * q) + off; }
        const int nig = WGM * nN, gid = wgid / nig, fm = gid * WGM, gsz = (nM - fm) < WGM ? (nM - fm) : WGM;
        u.pm = fm + ((wgid % nig) % gsz); u.pn = (wgid % nig) / gsz; return true;
    }
};

template <class Epi>
__device__ __forceinline__ void gemm_phase(LAS unsigned char* lds, const Gemm g, const StaticOrder& S, const Epi& E, const int tid) {
    const int wid = __builtin_amdgcn_readfirstlane(tid >> 6), lane = tid & 63, wr = wid >> 2, wc = wid & 3, fr = lane & 15, fq = lane >> 4;
    const int K = g.K, nt = K / BK;
    unsigned voffA[2], voffB[2];
#pragma unroll
    for (int i = 0; i < 2; ++i) { int R, C; stage_rc(tid * 16 + i * 8192, R, C); const int Rb = (R & ~31) + perm32(R & 31);
        voffA[i] = (unsigned)(R * K + C) * 2u; voffB[i] = (unsigned)(Rb * K + C) * 2u; }
    const size_t kstep = (size_t)(BK * 2);
    const size_t hstep = (size_t)HALF * K * 2;
    const size_t tstep = 2 * hstep;
    const unsigned ldsw = (unsigned)wid * 1024u;
    const int aoff = lds_byte(wr * 64 + fr, fq * 8), boff = lds_byte(wc * 32 + fr, fq * 8);
#define PG8_SA(b, h) (((b) * 2 + (h)) * HTB)
#define PG8_SB(b, h) ((4 + (b) * 2 + (h)) * HTB)
#define PG8_STAGE(bufoff, gbase, voff) do { _Pragma("unroll") for (int _i = 0; _i < 2; ++_i) \
        __builtin_amdgcn_global_load_lds((const unsigned*)((const char*)(gbase) + (voff)[_i]), (LAS unsigned*)(lds + (bufoff) + ldsw + _i * 8192), 16, 0, 0); } while (0)
#define PG8_LDA(dst, b, h) do { _Pragma("unroll") for (int m = 0; m < 4; ++m) _Pragma("unroll") for (int k = 0; k < 2; ++k) dst[m][k] = *(const LAS bf16x8*)(lds + PG8_SA(b, h) + aoff + m * 2048 + k * 1024); } while (0)
#define PG8_LDB(dst, b, h) do { _Pragma("unroll") for (int n = 0; n < 2; ++n) _Pragma("unroll") for (int k = 0; k < 2; ++k) dst[n][k] = *(const LAS bf16x8*)(lds + PG8_SB(b, h) + boff + n * 2048 + k * 1024); } while (0)
#define PG8_MMA(ai, bj, At, Bt) do { __builtin_amdgcn_s_setprio(1); _Pragma("unroll") for (int m = 0; m < 4; ++m) _Pragma("unroll") for (int n = 0; n < 2; ++n) _Pragma("unroll") for (int k = 0; k < 2; ++k) \
        acc[ai][bj][m][n] = __builtin_amdgcn_mfma_f32_16x16x32_bf16(Bt[n][k], At[m][k], acc[ai][bj][m][n], 0, 0, 0); __builtin_amdgcn_s_setprio(0); } while (0)
#define PG8_WAIT_V(n) asm volatile("s_waitcnt vmcnt(" #n ")" ::: "memory")
#define PG8_WAIT_L(n) asm volatile("s_waitcnt lgkmcnt(" #n ")" ::: "memory")
#define PG8_BAR __builtin_amdgcn_s_barrier()
#define PG8_SCHED __builtin_amdgcn_sched_barrier(0)
    Unit cur, nxt; int ui = 0;
    if (!S.next(0, cur)) return;
    f32x4 acc[2][2][4][2];
#pragma unroll
    for (int a = 0; a < 2; ++a)
#pragma unroll
        for (int b = 0; b < 2; ++b)
#pragma unroll
            for (int m = 0; m < 4; ++m)
#pragma unroll
                for (int n = 0; n < 2; ++n) acc[a][b][m][n] = (f32x4){0.f, 0.f, 0.f, 0.f};
    bf16x8 At[4][2], B0[2][2], B1[2][2];
    const char* cA = (const char*)g.A + (size_t)cur.pm * tstep; const char* cB = (const char*)g.Bt + (size_t)cur.pn * tstep;
    PG8_STAGE(PG8_SB(0, 0), cB, voffB); PG8_STAGE(PG8_SB(0, 1), cB + hstep, voffB); PG8_STAGE(PG8_SA(0, 0), cA, voffA); PG8_STAGE(PG8_SA(0, 1), cA + hstep, voffA);
    if (wr == 1) PG8_BAR;
    PG8_WAIT_V(2); PG8_BAR;
    PG8_STAGE(PG8_SB(1, 0), cB + kstep, voffB); PG8_STAGE(PG8_SA(1, 0), cA + kstep, voffA); PG8_STAGE(PG8_SB(1, 1), cB + hstep + kstep, voffB);
    PG8_WAIT_V(6); PG8_BAR;
    for (;;) {
        const bool has_next = S.next(ui + 1, nxt);
        const char* nA = has_next ? (const char*)g.A + (size_t)nxt.pm * tstep : cA; const char* nB = has_next ? (const char*)g.Bt + (size_t)nxt.pn * tstep : cB;
        for (int t = 0; t < nt; t += 2) {
            const bool last = (t == nt - 2);
            const char* a1 = cA + (size_t)(t + 1) * kstep;
            const char* a2 = last ? nA : cA + (size_t)(t + 2) * kstep; const char* b2 = last ? nB : cB + (size_t)(t + 2) * kstep;
            const char* a3 = a2 + kstep; const char* b3 = b2 + kstep;
            if constexpr (Epi::MID) { if (t == 16 || t == 32) { int fr_ = fr, fq_ = fq, wr_ = wr, wc_ = wc;
                asm volatile("" : "+v"(fr_), "+v"(fq_)); asm volatile("" : "+s"(wr_), "+s"(wc_));
                E.mid(acc, cur, t >> 4, wr_, wc_, fr_, fq_); PG8_WAIT_V(0); PG8_SCHED; } }
            PG8_LDB(B0, 0, 0); PG8_LDB(B1, 0, 1); PG8_SCHED; PG8_LDA(At, 0, 0); PG8_STAGE(PG8_SA(1, 1), a1 + hstep, voffA);
            PG8_WAIT_V(8); PG8_WAIT_L(0); PG8_BAR; PG8_MMA(0, 0, At, B0); PG8_MMA(0, 1, At, B1); PG8_BAR; PG8_SCHED;
            PG8_LDA(At, 0, 1); PG8_STAGE(PG8_SB(0, 0), b2, voffB); PG8_STAGE(PG8_SB(0, 1), b2 + hstep, voffB); PG8_STAGE(PG8_SA(0, 0), a2, voffA);
            PG8_WAIT_V(8); PG8_WAIT_L(0); PG8_BAR; PG8_MMA(1, 0, At, B0); PG8_MMA(1, 1, At, B1); PG8_BAR; PG8_SCHED;
            PG8_LDB(B0, 1, 0); PG8_LDB(B1, 1, 1); PG8_SCHED; PG8_LDA(At, 1, 0); PG8_STAGE(PG8_SA(0, 1), a2 + hstep, voffA);
            PG8_WAIT_V(8); PG8_WAIT_L(0); PG8_BAR; PG8_MMA(0, 0, At, B0); PG8_MMA(0, 1, At, B1); PG8_BAR; PG8_SCHED;
            PG8_LDA(At, 1, 1); PG8_STAGE(PG8_SB(1, 0), b3, voffB); PG8_STAGE(PG8_SB(1, 1), b3 + hstep, voffB); PG8_STAGE(PG8_SA(1, 0), a3, voffA);
            PG8_WAIT_V(8); PG8_WAIT_L(0); PG8_BAR; PG8_MMA(1, 0, At, B0); PG8_MMA(1, 1, At, B1); PG8_BAR; PG8_SCHED;
        }
        if (wr == 0) PG8_BAR;
        { int fr_ = fr, fq_ = fq, wr_ = wr, wc_ = wc, wid_ = wid;
          asm volatile("" : "+v"(fr_), "+v"(fq_)); asm volatile("" : "+s"(wr_), "+s"(wc_), "+s"(wid_));
          E(acc, cur, wr_, wc_, fr_, fq_, wid_); }
        if (!has_next) break;
#pragma unroll
        for (int a = 0; a < 2; ++a)
#pragma unroll
            for (int b = 0; b < 2; ++b)
#pragma unroll
                for (int m = 0; m < 4; ++m)
#pragma unroll
                    for (int n = 0; n < 2; ++n) acc[a][b][m][n] = (f32x4){0.f, 0.f, 0.f, 0.f};
        cur = nxt; cA = nA; cB = nB; ++ui;
        if (wr == 1) PG8_BAR;
    }
    PG8_WAIT_V(0);
    PG8_BAR;
#undef PG8_SA
#undef PG8_SB
#undef PG8_STAGE
#undef PG8_LDA
#undef PG8_LDB
#undef PG8_MMA
#undef PG8_WAIT_V
#undef PG8_WAIT_L
#undef PG8_BAR
#undef PG8_SCHED
}
}
using pg8::Unit;

__device__ __forceinline__ int in_src_col(int n) {
    const int tile = n >> 8, s = n & 255, bj = s >> 7, wc = (s >> 5) & 3, c = s & 31;
    const int d128 = 64 * (wc & 1) + 32 * bj + c, g128 = wc >> 1;
    const int d64 = 32 * (c >> 4) + 16 * bj + (c & 15), g64 = wc;
    if (tile < 4) return (tile * 2 + g128) * 128 + d128;
    if (tile == 4) return 1024 + g128 * 128 + d128;
    if (tile == 5) return 1280 + s;
    if (tile < 10) return 1536 + ((tile - 6) * 2 + g128) * 192 + d128;
    if (tile < 12) return 1536 + ((tile - 10) * 4 + g64) * 192 + 128 + d64;
    if (tile < 14) return 3072 + (tile - 12) * 256 + s;
    if (tile == 14) return g64 == 0 ? 3584 + d64 : -1;
    if (tile < 19) return 3648 + ((tile - 15) * 4 + g64) * 64 + d64;
    if (tile < 23) return 4672 + ((tile - 19) * 4 + g64) * 64 + d64;
    if (tile < 27) return 5696 + (tile - 23) * 256 + s;
    if (tile < 39) return 6720 + (tile - 27) * 256 + s;
    return 9792 + (tile - 39) * 256 + s;
}
__device__ __forceinline__ int up_src_col(int n) {
    if (n >= 1024) return n;
    const int tile = n >> 8, s = n & 255, bj = s >> 7, wc = (s >> 5) & 3, c = s & 31;
    return (tile * 2 + (wc >> 1)) * 128 + 64 * (wc & 1) + 32 * bj + c;
}

template <int GS>
__device__ __forceinline__ void norm_rope_store(const f32x4 (&acc)[2][2][4][2], int pm, int wr, int wc, int fr, int fq, int wid,
                                                const float* __restrict__ w, const float* __restrict__ tcos, const float* __restrict__ tsin, bool rope,
                                                const float (&pre)[2][4], bf16_t* __restrict__ dst, int ld, int gbase, int ncopies, int copystride, LAS float* xch) {
    const int dbase = (GS == 128) ? 64 * (wc & 1) + 8 * fq : 32 * (fq >> 1) + 8 * (fq & 1);
    const int bjs = (GS == 128) ? 32 : 16;
    const int axis = (GS == 128) ? (wc & 1) : (fq >> 1);
    const int i0 = (GS == 128) ? 8 * fq : 8 * (fq & 1);
    constexpr int NF = (GS == 128) ? 32 : 16;
    const int wavebase = gbase + ((GS == 128) ? 64 * (wc & 1) : 0) + 8 * fq;
    float ssq[2][4];
#pragma unroll
    for (int ai = 0; ai < 2; ++ai)
#pragma unroll
        for (int m = 0; m < 4; ++m) {
            float s = 0.f;
#pragma unroll
            for (int bj = 0; bj < 2; ++bj)
#pragma unroll
                for (int n = 0; n < 2; ++n)
#pragma unroll
                    for (int j = 0; j < 4; ++j) { const float v = acc[ai][bj][m][n][j] * pre[ai][m]; s += v * v; }
            s += __shfl_xor(s, 16); s += __shfl_xor(s, 32);
            ssq[ai][m] = s;
        }
    if constexpr (GS == 128) {
        if (fq == 0) {
#pragma unroll
            for (int ai = 0; ai < 2; ++ai)
#pragma unroll
                for (int m = 0; m < 4; ++m) xch[wid * 128 + ai * 64 + m * 16 + fr] = ssq[ai][m];
        }
        asm volatile("s_waitcnt lgkmcnt(0)" ::: "memory"); __builtin_amdgcn_s_barrier();
#pragma unroll
        for (int ai = 0; ai < 2; ++ai)
#pragma unroll
            for (int m = 0; m < 4; ++m) ssq[ai][m] += xch[(wid ^ 1) * 128 + ai * 64 + m * 16 + fr];
    }
#pragma unroll
    for (int ai = 0; ai < 2; ++ai)
#pragma unroll
        for (int m = 0; m < 4; ++m) {
            const int rl = ai * 128 + wr * 64 + m * 16 + fr;
            const size_t row = (size_t)pm * 256 + rl;
            const float rinv = rsqrtf(ssq[ai][m] * (1.f / GS) + EPS) * pre[ai][m];
            const int t = (pm & 15) * 256 + rl; const int pos = axis ? (t & 63) : (t >> 6);
            u32x4 k0, k1;
#pragma unroll
            for (int n = 0; n < 2; ++n) {
                const f32x4 w0 = *(const f32x4*)(w + dbase + 4 * n), w1 = *(const f32x4*)(w + dbase + bjs + 4 * n);
                f32x4 y0 = acc[ai][0][m][n] * rinv * w0, y1 = acc[ai][1][m][n] * rinv * w1;
                if (rope) {
                    const f32x4 c = *(const f32x4*)(tcos + pos * NF + i0 + 4 * n), sn = *(const f32x4*)(tsin + pos * NF + i0 + 4 * n);
                    const f32x4 o0 = y0 * c - y1 * sn, o1 = y1 * c + y0 * sn;
                    y0 = o0; y1 = o1;
                }
                if (n == 0) { k0.x = cvt_pk_bf16(y0[0], y0[1]); k0.y = cvt_pk_bf16(y0[2], y0[3]); k1.x = cvt_pk_bf16(y1[0], y1[1]); k1.y = cvt_pk_bf16(y1[2], y1[3]); }
                else { k0.z = cvt_pk_bf16(y0[0], y0[1]); k0.w = cvt_pk_bf16(y0[2], y0[3]); k1.z = cvt_pk_bf16(y1[0], y1[1]); k1.w = cvt_pk_bf16(y1[2], y1[3]); }
            }
            bf16_t* p = dst + row * ld + wavebase;
            for (int cp = 0; cp < ncopies; ++cp) { *(u32x4*)(p + cp * copystride) = k0; *(u32x4*)(p + cp * copystride + 32) = k1; }
            __builtin_amdgcn_sched_barrier(0);
        }
}

struct EpiIn {
    static constexpr bool MID = false;
    bf16_t *QA, *KA, *VA, *QB, *KB, *CKV, *QC, *KC, *VC, *GATE, *MRG; float* SS;
    const float *wAq, *wAk, *wBqn, *wBqr, *wBkr, *wCq, *wCk, *bmerge;
    const float *tc64, *ts64, *tc128, *ts128;
    LAS float* xch;
    template <int ACT>
    __device__ __forceinline__ void plain(const f32x4 (&acc)[2][2][4][2], int pm, int wr, int wc, int fr, int fq, bf16_t* dst, int ld, int col0) const {
        const int colw = col0 + 32 * wc + 8 * fq;
        f32x4 b[2][2];
#pragma unroll
        for (int bj = 0; bj < 2; ++bj)
#pragma unroll
            for (int n = 0; n < 2; ++n) b[bj][n] = (ACT == 2) ? *(const f32x4*)(bmerge + colw + bj * 128 + 4 * n) : (f32x4){0.f, 0.f, 0.f, 0.f};
#pragma unroll
        for (int ai = 0; ai < 2; ++ai)
#pragma unroll
            for (int m = 0; m < 4; ++m) {
                const size_t row = (size_t)pm * 256 + ai * 128 + wr * 64 + m * 16 + fr;
#pragma unroll
                for (int bj = 0; bj < 2; ++bj) {
                    f32x4 v0 = acc[ai][bj][m][0], v1 = acc[ai][bj][m][1];
                    if (ACT == 1) { for (int j = 0; j < 4; ++j) { v0[j] = silu_f(v0[j]); v1[j] = silu_f(v1[j]); } }
                    if (ACT == 2) { v0 = v0 + b[bj][0]; v1 = v1 + b[bj][1]; for (int j = 0; j < 4; ++j) { v0[j] = sigm_f(v0[j]); v1[j] = sigm_f(v1[j]); } }
                    store8(dst + row * ld + colw + bj * 128, v0, v1);
                }
                __builtin_amdgcn_sched_barrier(0);
            }
    }
    __device__ __forceinline__ void operator()(const f32x4 (&acc)[2][2][4][2], const Unit& u, int wr, int wc, int fr, int fq, int wid) const {
        const int t = u.pn, pm = u.pm; const bool rope = pm < 64;
        const float one[2][4] = {{1.f, 1.f, 1.f, 1.f}, {1.f, 1.f, 1.f, 1.f}};
        if (t < 4 && (MK_G1T & 1)) norm_rope_store<128>(acc, pm, wr, wc, fr, fq, wid, wAq, tc128, ts128, rope, one, QA, 1024, (t * 2 + (wc >> 1)) * 128, 1, 0, xch);
        else if (t == 4 && (MK_G1T & 1)) norm_rope_store<128>(acc, pm, wr, wc, fr, fq, wid, wAk, tc128, ts128, rope, one, KA, 256, (wc >> 1) * 128, 1, 0, xch);
        else if (t == 5 && (MK_G1T & 2)) plain<0>(acc, pm, wr, wc, fr, fq, VA, 256, 0);
        else if (t < 10 && (MK_G1T & 1)) norm_rope_store<128>(acc, pm, wr, wc, fr, fq, wid, wBqn, tc128, ts128, false, one, QB, 1536, ((t - 6) * 2 + (wc >> 1)) * 192, 1, 0, xch);
        else if (t < 12 && (MK_G1T & 4)) norm_rope_store<64>(acc, pm, wr, wc, fr, fq, wid, wBqr, tc64, ts64, rope, one, QB, 1536, ((t - 10) * 4 + wc) * 192 + 128, 1, 0, xch);
        else if (t < 14 && (MK_G1T & 8)) {
            plain<0>(acc, pm, wr, wc, fr, fq, CKV, 512, (t - 12) * 256);
#pragma unroll
            for (int ai = 0; ai < 2; ++ai)
#pragma unroll
                for (int m = 0; m < 4; ++m) {
                    float s = 0.f;
#pragma unroll
                    for (int bj = 0; bj < 2; ++bj)
#pragma unroll
                        for (int n = 0; n < 2; ++n)
#pragma unroll
                            for (int j = 0; j < 4; ++j) { const float v = acc[ai][bj][m][n][j]; s += v * v; }
                    s += __shfl_xor(s, 16); s += __shfl_xor(s, 32);
                    if (fq == 0) SS[((size_t)pm * 256 + ai * 128 + wr * 64 + m * 16 + fr) * 8 + (t - 12) * 4 + wc] = s;
                }
        }
        else if (t == 14 && (MK_G1T & 16)) { if (wc == 0) norm_rope_store<64>(acc, pm, wr, wc, fr, fq, wid, wBkr, tc64, ts64, rope, one, KB, 1536, 128, 8, 192, xch); }
        else if (t < 19 && (MK_G1T & 4)) norm_rope_store<64>(acc, pm, wr, wc, fr, fq, wid, wCq, tc64, ts64, rope, one, QC, 1024, ((t - 15) * 4 + wc) * 64, 1, 0, xch);
        else if (t < 23 && (MK_G1T & 4)) norm_rope_store<64>(acc, pm, wr, wc, fr, fq, wid, wCk, tc64, ts64, rope, one, KC, 1024, ((t - 19) * 4 + wc) * 64, 1, 0, xch);
        else if (t < 27 && (MK_G1T & 2)) plain<0>(acc, pm, wr, wc, fr, fq, VC, 1024, (t - 23) * 256);
        else if (t < 39 && (MK_G1T & 32)) plain<1>(acc, pm, wr, wc, fr, fq, GATE, 3072, (t - 27) * 256);
        else if (MK_G1T & 64) plain<2>(acc, pm, wr, wc, fr, fq, MRG, 6144, (t - 39) * 256);
    }
};

struct EpiUp {
    static constexpr bool MID = false;
    bf16_t *KB, *VB; const float* SS; const float* wBkn; LAS float* xch;
    __device__ __forceinline__ void operator()(const f32x4 (&acc)[2][2][4][2], const Unit& u, int wr, int wc, int fr, int fq, int wid) const {
        const int t = u.pn, pm = u.pm;
        float pre[2][4];
#pragma unroll
        for (int ai = 0; ai < 2; ++ai)
#pragma unroll
            for (int m = 0; m < 4; ++m) {
                const size_t row = (size_t)pm * 256 + ai * 128 + wr * 64 + m * 16 + fr;
                const f32x4 a = *(const f32x4*)(SS + row * 8), b = *(const f32x4*)(SS + row * 8 + 4);
                pre[ai][m] = rsqrtf(((a[0] + a[1]) + (a[2] + a[3]) + (b[0] + b[1]) + (b[2] + b[3])) * (1.f / 512.f) + EPS);
                __builtin_amdgcn_sched_barrier(0);
            }
        if (t < 4) norm_rope_store<128>(acc, pm, wr, wc, fr, fq, wid, wBkn, nullptr, nullptr, false, pre, KB, 1536, (t * 2 + (wc >> 1)) * 192, 1, 0, xch);
        else {
            const int colw = (t - 4) * 256 + 32 * wc + 8 * fq;
#pragma unroll
            for (int ai = 0; ai < 2; ++ai)
#pragma unroll
                for (int m = 0; m < 4; ++m) {
                    const size_t row = (size_t)pm * 256 + ai * 128 + wr * 64 + m * 16 + fr;
#pragma unroll
                    for (int bj = 0; bj < 2; ++bj) store8(VB + row * 1024 + colw + bj * 128, acc[ai][bj][m][0] * pre[ai][m], acc[ai][bj][m][1] * pre[ai][m]);
                    __builtin_amdgcn_sched_barrier(0);
                }
        }
    }
};

struct EpiBr {
    static constexpr bool MID = true;
    const bf16_t* MRG; bf16_t* Y;
    __device__ __forceinline__ void mid(f32x4 (&acc)[2][2][4][2], const Unit& u, int i, int wr, int wc, int fr, int fq) const {
#pragma unroll
        for (int ai = 0; ai < 2; ++ai)
#pragma unroll
            for (int m = 0; m < 4; ++m) {
                const size_t row = (size_t)u.pm * 256 + ai * 128 + wr * 64 + m * 16 + fr;
#pragma unroll
                for (int bj = 0; bj < 2; ++bj) {
                    const int col = u.pn * 256 + bj * 128 + 32 * wc + 8 * fq;
                    const u32x4 a = *(const u32x4*)(MRG + row * 6144 + (i - 1) * 2048 + col), b = *(const u32x4*)(MRG + row * 6144 + i * 2048 + col);
#pragma unroll
                    for (int q = 0; q < 4; ++q) {
                        const float r0 = bf2f(a[q] & 0xffffu) * __builtin_amdgcn_rcpf(bf2f(b[q] & 0xffffu)), r1 = bf2f(a[q] >> 16) * __builtin_amdgcn_rcpf(bf2f(b[q] >> 16));
                        acc[ai][bj][m][q >> 1][(q & 1) * 2] *= r0; acc[ai][bj][m][q >> 1][(q & 1) * 2 + 1] *= r1;
                    }
                }
                __builtin_amdgcn_sched_barrier(0);
            }
    }
    __device__ __forceinline__ void operator()(const f32x4 (&acc)[2][2][4][2], const Unit& u, int wr, int wc, int fr, int fq, int wid) const {
#pragma unroll
        for (int ai = 0; ai < 2; ++ai)
#pragma unroll
            for (int m = 0; m < 4; ++m) {
                const size_t row = (size_t)u.pm * 256 + ai * 128 + wr * 64 + m * 16 + fr;
#pragma unroll
                for (int bj = 0; bj < 2; ++bj) {
                    const int col = u.pn * 256 + bj * 128 + 32 * wc + 8 * fq;
                    const u32x4 a = *(const u32x4*)(MRG + row * 6144 + 4096 + col);
                    f32x4 v0 = acc[ai][bj][m][0], v1 = acc[ai][bj][m][1];
                    v0[0] *= bf2f(a[0] & 0xffffu); v0[1] *= bf2f(a[0] >> 16); v0[2] *= bf2f(a[1] & 0xffffu); v0[3] *= bf2f(a[1] >> 16);
                    v1[0] *= bf2f(a[2] & 0xffffu); v1[1] *= bf2f(a[2] >> 16); v1[2] *= bf2f(a[3] & 0xffffu); v1[3] *= bf2f(a[3] >> 16);
                    store8(Y + row * 2048 + col, v0, v1);
                }
                __builtin_amdgcn_sched_barrier(0);
            }
    }
};

struct EpiOut {
    static constexpr bool MID = false;
    const float *xsrc, *csrc; float *xdst, *cdst; const float* mod;
    __device__ __forceinline__ void operator()(const f32x4 (&acc)[2][2][4][2], const Unit& u, int wr, int wc, int fr, int fq, int wid) const {
        const int pm = u.pm; const bool lat = pm < 64;
        const int mi = lat ? (pm >> 4) : 4;
        const float* src = lat ? xsrc : csrc - (size_t)MLAT * DM; float* dst = lat ? xdst : cdst - (size_t)MLAT * DM;
        const float* g = mod + mi * 6144 + 4096;
#pragma unroll
        for (int bj = 0; bj < 2; ++bj) {
            const int col = u.pn * 256 + bj * 128 + 32 * wc + 8 * fq;
            const f32x4 g0 = *(const f32x4*)(g + col), g1 = *(const f32x4*)(g + col + 4);
#pragma unroll
            for (int ai = 0; ai < 2; ++ai)
#pragma unroll
                for (int m = 0; m < 4; ++m) {
                    const size_t row = (size_t)pm * 256 + ai * 128 + wr * 64 + m * 16 + fr;
                    const f32x4 x0 = *(const f32x4*)(src + row * DM + col), x1 = *(const f32x4*)(src + row * DM + col + 4);
                    *(f32x4*)(dst + row * DM + col) = x0 + g0 * acc[ai][bj][m][0];
                    *(f32x4*)(dst + row * DM + col + 4) = x1 + g1 * acc[ai][bj][m][1];
                    __builtin_amdgcn_sched_barrier(0);
                }
        }
    }
};

namespace att {
#define SBAR() __builtin_amdgcn_sched_barrier(0)
__device__ __forceinline__ int crow(int r, int hi) { return (r & 3) + 8 * (r >> 2) + 4 * hi; }
template <int RB> __device__ __forceinline__ int kswz(int row, int colB) { const int x = (RB == 256) ? (row & 7) : ((row >> 1) & 7); return row * RB + (colB ^ (x << 4)); }
__device__ __forceinline__ int v_st(int k, int c) { const int kk = (k & ~0xC) | ((k & 4) << 1) | ((k & 8) >> 1); return ((kk >> 3) * 4 + (c >> 5)) * 512 + ((kk & 7) * 32 + (c & 31)) * 2; }
__device__ __forceinline__ int v_rd_base(int lane) { return ((lane & 3) << 3) | (((lane >> 2) & 3) << 6) | (((lane >> 4) & 1) << 5) | (((lane >> 5) & 1) << 8); }
constexpr int v_rd_off(int d0, int ks, int half) { return d0 * 512 + ks * 4096 + half * 2048; }
template <int OFF> __device__ __forceinline__ s16x4 tr_read(unsigned vb) {
    s16x4 r; asm volatile("ds_read_b64_tr_b16 %0, %1 offset:%2" : "=&v"(r) : "v"(vb), "i"(OFF) : "memory"); return r;
}
template <int D0> __device__ __forceinline__ void pv_one(f32x16& od, unsigned vb, bf16x8 pa0, bf16x8 pa1, bf16x8 pa2, bf16x8 pa3) {
    const s16x4 l0 = tr_read<v_rd_off(D0, 0, 0)>(vb), h0 = tr_read<v_rd_off(D0, 0, 1)>(vb), l1 = tr_read<v_rd_off(D0, 1, 0)>(vb), h1 = tr_read<v_rd_off(D0, 1, 1)>(vb);
    const s16x4 l2 = tr_read<v_rd_off(D0, 2, 0)>(vb), h2 = tr_read<v_rd_off(D0, 2, 1)>(vb), l3 = tr_read<v_rd_off(D0, 3, 0)>(vb), h3 = tr_read<v_rd_off(D0, 3, 1)>(vb);
    asm volatile("s_waitcnt lgkmcnt(0)" ::: "memory"); SBAR();
#define PK(L, H) (bf16x8){L[0], L[1], L[2], L[3], H[0], H[1], H[2], H[3]}
    od = __builtin_amdgcn_mfma_f32_32x32x16_bf16(pa0, PK(l0, h0), od, 0, 0, 0);
    od = __builtin_amdgcn_mfma_f32_32x32x16_bf16(pa1, PK(l1, h1), od, 0, 0, 0);
    od = __builtin_amdgcn_mfma_f32_32x32x16_bf16(pa2, PK(l2, h2), od, 0, 0, 0);
    od = __builtin_amdgcn_mfma_f32_32x32x16_bf16(pa3, PK(l3, h3), od, 0, 0, 0);
#undef PK
}
__device__ __forceinline__ void pv_d0(f32x16 (&o)[4], unsigned vb, bf16x8 pa0, bf16x8 pa1, bf16x8 pa2, bf16x8 pa3) {
    pv_one<0>(o[0], vb, pa0, pa1, pa2, pa3); pv_one<1>(o[1], vb, pa0, pa1, pa2, pa3); pv_one<2>(o[2], vb, pa0, pa1, pa2, pa3); pv_one<3>(o[3], vb, pa0, pa1, pa2, pa3);
}
__device__ __forceinline__ void partialSM(f32x16& p0, f32x16& p1, float C, float nMB) {
#pragma unroll
    for (int r = 0; r < 16; ++r) p0[r] = fmaf(p0[r], C, nMB);
#pragma unroll
    for (int r = 0; r < 16; ++r) p1[r] = fmaf(p1[r], C, nMB);
#pragma unroll
    for (int r = 0; r < 16; ++r) p0[r] = __builtin_amdgcn_exp2f(p0[r]);
}
__device__ __forceinline__ void finishSM(f32x16& p0, f32x16& p1, float& l_reg, bf16x8& pa0, bf16x8& pa1, bf16x8& pa2, bf16x8& pa3) {
#pragma unroll
    for (int r = 0; r < 16; ++r) p1[r] = __builtin_amdgcn_exp2f(p1[r]);
    float ps = 0;
#pragma unroll
    for (int r = 0; r < 16; ++r) ps += p0[r];
#pragma unroll
    for (int r = 0; r < 16; ++r) ps += p1[r];
    { auto rr = __builtin_amdgcn_permlane32_swap(__float_as_uint(ps), __float_as_uint(ps), false, false);
      ps = __uint_as_float(rr[0]) + __uint_as_float(rr[1]); }
    l_reg += ps;
#define PK4(P, BASE, OUT) do { unsigned a0 = cvt_pk_bf16(P[BASE + 0], P[BASE + 1]), a1 = cvt_pk_bf16(P[BASE + 2], P[BASE + 3]);   \
    unsigned b0 = cvt_pk_bf16(P[BASE + 4], P[BASE + 5]), b1 = cvt_pk_bf16(P[BASE + 6], P[BASE + 7]);                              \
    auto r0 = __builtin_amdgcn_permlane32_swap(a0, b0, false, false); auto r1 = __builtin_amdgcn_permlane32_swap(a1, b1, false, false); \
    u32x4 w = {r0[0], r1[0], r0[1], r1[1]}; OUT = *reinterpret_cast<bf16x8*>(&w); } while (0)
    PK4(p0, 0, pa0); PK4(p0, 8, pa1); PK4(p1, 0, pa2); PK4(p1, 8, pa3);
#undef PK4
}
template <int DQK>
__device__ __forceinline__ void qkt(f32x16& p0, f32x16& p1, const LAS char* Ks, const bf16x8 (&qr)[DQK / 16], int r32, int hi) {
    constexpr int RB = DQK * 2;
    p0 = f32x16{}; p1 = f32x16{};
#pragma unroll
    for (int d0 = 0; d0 < DQK / 16; ++d0) { const int cb = (d0 * 16 + hi * 8) * 2;
        const bf16x8 b0 = *(const LAS bf16x8*)(Ks + kswz<RB>(r32, cb));
        const bf16x8 b1 = *(const LAS bf16x8*)(Ks + kswz<RB>(32 + r32, cb));
        p0 = __builtin_amdgcn_mfma_f32_32x32x16_bf16(b0, qr[d0], p0, 0, 0, 0);
        p1 = __builtin_amdgcn_mfma_f32_32x32x16_bf16(b1, qr[d0], p1, 0, 0, 0); }
}
constexpr int V_BYTES = 64 * 128 * 2, K_OFF = 2 * V_BYTES, K_STRIDE = 64 * 192 * 2, LI_OFF = K_OFF + 2 * K_STRIDE;

template <int DQK, bool DOUBLE>
__device__ __forceinline__ void attn_pass(const bf16_t* __restrict__ Q, int ldq, const bf16_t* __restrict__ Kg, int ldk, const bf16_t* __restrict__ Vg, int ldv,
                                          int rowc, int rowl, int NT, float C, float nMB, f32x16 (&o)[4], float& l_reg, LAS char* lds, int tid) {
    constexpr int RB = DQK * 2, NCH = DQK / 8, NLD = NCH / 8;
    const int wid = tid >> 6, lane = tid & 63, r32 = lane & 31, hi = lane >> 5;
    LAS char* V_lds = lds; LAS char* K_lds = lds + K_OFF;
    bf16x8 qr[DQK / 16];
    { const bf16_t* Qw = Q + (size_t)(wid * 32 + r32) * ldq + hi * 8;
#pragma unroll
      for (int d0 = 0; d0 < DQK / 16; ++d0) qr[d0] = *(const bf16x8*)(Qw + d0 * 16); }
#pragma unroll
    for (int d = 0; d < 4; ++d) o[d] = f32x16{};
    l_reg = 0.f;
    const int sr = tid >> 4, sc = (tid & 15) * 8, vst0 = v_st(sr, sc), vst1 = v_st(32 + sr, sc);
    int krow[NLD], kcol[NLD], kst[NLD];
#pragma unroll
    for (int i = 0; i < NLD; ++i) { const int id = tid + 512 * i; krow[i] = id / NCH; kcol[i] = (id % NCH) * 8; kst[i] = kswz<RB>(krow[i], kcol[i] * 2); }
    const unsigned vb0 = (unsigned)(uintptr_t)V_lds + v_rd_base(lane);
    bf16x8 vs0, vs1, ks[NLD];
#define KROW0(j) ((j) < 4 ? rowc + 64 * (j) : rowl + 64 * ((j) - 4))
#define SLOAD(j) do { const size_t _r0 = (size_t)KROW0(j); vs0 = *(const bf16x8*)(Vg + (_r0 + sr) * ldv + sc); vs1 = *(const bf16x8*)(Vg + (_r0 + 32 + sr) * ldv + sc); \
    _Pragma("unroll") for (int _i = 0; _i < NLD; ++_i) ks[_i] = *(const bf16x8*)(Kg + (_r0 + krow[_i]) * ldk + kcol[_i]); } while (0)
#define SWRITE(b) do { *(LAS bf16x8*)(V_lds + (b) * V_BYTES + vst0) = vs0; *(LAS bf16x8*)(V_lds + (b) * V_BYTES + vst1) = vs1; \
    _Pragma("unroll") for (int _i = 0; _i < NLD; ++_i) *(LAS bf16x8*)(K_lds + (b) * K_STRIDE + kst[_i]) = ks[_i]; } while (0)
    bf16x8 pa0, pa1, pa2, pa3;
    __syncthreads();
    if constexpr (!DOUBLE) {
        f32x16 p0, p1;
        SLOAD(0); SWRITE(0); __syncthreads();
        for (int j = 0; j < NT; ++j) {
            const int b = j & 1;
            if (j + 1 < NT) SLOAD(j + 1);
            SBAR(); qkt<DQK>(p0, p1, K_lds + b * K_STRIDE, qr, r32, hi);
            partialSM(p0, p1, C, nMB); finishSM(p0, p1, l_reg, pa0, pa1, pa2, pa3); SBAR();
            pv_d0(o, vb0 + b * V_BYTES, pa0, pa1, pa2, pa3);
            if (j + 1 < NT) SWRITE(b ^ 1);
            __syncthreads();
        }
    } else {
    f32x16 pA0, pA1, pB0, pB1;
    SLOAD(0); SWRITE(0); __syncthreads();
    qkt<DQK>(pA0, pA1, K_lds, qr, r32, hi); partialSM(pA0, pA1, C, nMB);
    SLOAD(1); SWRITE(1); __syncthreads();
    for (int j = 1; j + 1 < NT; j += 2) {
        SBAR(); qkt<DQK>(pB0, pB1, K_lds + K_STRIDE, qr, r32, hi);
        finishSM(pA0, pA1, l_reg, pa0, pa1, pa2, pa3); SBAR();
        SLOAD(j + 1); SBAR();
        pv_d0(o, vb0, pa0, pa1, pa2, pa3); partialSM(pB0, pB1, C, nMB);
        __syncthreads(); SWRITE(0); __syncthreads();
        SBAR(); qkt<DQK>(pA0, pA1, K_lds, qr, r32, hi);
        finishSM(pB0, pB1, l_reg, pa0, pa1, pa2, pa3); SBAR();
        SLOAD(j + 2); SBAR();
        pv_d0(o, vb0 + V_BYTES, pa0, pa1, pa2, pa3); partialSM(pA0, pA1, C, nMB);
        __syncthreads(); SWRITE(1); __syncthreads();
    }
    SBAR(); qkt<DQK>(pB0, pB1, K_lds + K_STRIDE, qr, r32, hi);
    finishSM(pA0, pA1, l_reg, pa0, pa1, pa2, pa3); SBAR();
    pv_d0(o, vb0, pa0, pa1, pa2, pa3); partialSM(pB0, pB1, C, nMB);
    finishSM(pB0, pB1, l_reg, pa0, pa1, pa2, pa3); SBAR();
    pv_d0(o, vb0 + V_BYTES, pa0, pa1, pa2, pa3);
    }
#undef KROW0
#undef SLOAD
#undef SWRITE
}
__device__ __forceinline__ void row_recip(float l_reg, float (&rli)[16], LAS float* li, int r32, int hi) {
    if (hi == 0) li[r32] = l_reg;
    asm volatile("s_waitcnt lgkmcnt(0)" ::: "memory");
#pragma unroll
    for (int r = 0; r < 16; ++r) rli[r] = __builtin_amdgcn_rcpf(li[crow(r, hi)]);
    asm volatile("s_waitcnt lgkmcnt(0)" ::: "memory");
}
}

struct AttnBufs { const bf16_t *QA, *KA, *VA, *QB, *KB, *VB, *QC, *KC, *VC, *GATE; bf16_t* BR; float* SCR; const float* lamv; const float* subln; float lam_init; };

__device__ __forceinline__ void attn_item(const AttnBufs& T, int type, int b, int h, int qrow0, int NT, LAS char* lds, int tid_) {
    asm volatile("" : "+v"(tid_));
    const int tid = tid_, wid = tid >> 6, lane = tid & 63, r32 = lane & 31, hi = lane >> 5;
    const int rowc = MLAT + b * CTXL, rowl = b * SEQ;
    LAS float* li = (LAS float*)(lds + att::LI_OFF) + wid * 64;
    constexpr float LOG2E = 1.4426950408889634f;
    f32x16 o[4]; float l_reg; float rli[16];
    const size_t orow0 = (size_t)qrow0 + wid * 32;
    if (type == 0 && (MK_ATYPE & 1)) {
        att::attn_pass<128, true>(T.QA + (size_t)qrow0 * 1024 + h * 128, 1024, T.KA + (h >> 2) * 128, 256, T.VA + (h >> 2) * 128, 256, rowc, rowl, NT,
                            0.08838834764831845f * LOG2E, T.lamv[1], o, l_reg, lds, tid);
    } else if (type == 1 && (MK_ATYPE & 2)) {
        att::attn_pass<192, false>(T.QB + (size_t)qrow0 * 1536 + h * 192, 1536, T.KB + h * 192, 1536, T.VB + h * 128, 1024, rowc, rowl, NT,
                            0.07216878364870323f * LOG2E, T.lamv[2], o, l_reg, lds, tid);
    } else if (MK_ATYPE & 4) {
        att::attn_pass<64, true>(T.QC + (size_t)qrow0 * 1024 + h * 128, 1024, T.KC + h * 128, 1024, T.VC + h * 128, 1024, rowc, rowl, NT,
                           0.125f * LOG2E, T.lamv[3], o, l_reg, lds, tid);
        att::row_recip(l_reg, rli, li, r32, hi);
        f32x4* scr = (f32x4*)(T.SCR + ((size_t)blockIdx.x * 512 + tid) * 64);
#pragma unroll
        for (int d0 = 0; d0 < 4; ++d0)
#pragma unroll
            for (int q = 0; q < 4; ++q) scr[d0 * 4 + q] = (f32x4){o[d0][q * 4] * rli[q * 4], o[d0][q * 4 + 1] * rli[q * 4 + 1], o[d0][q * 4 + 2] * rli[q * 4 + 2], o[d0][q * 4 + 3] * rli[q * 4 + 3]};
        att::attn_pass<64, true>(T.QC + (size_t)qrow0 * 1024 + h * 128 + 64, 1024, T.KC + h * 128 + 64, 1024, T.VC + h * 128, 1024, rowc, rowl, NT,
                           0.125f * LOG2E, T.lamv[3], o, l_reg, lds, tid);
    }
    att::row_recip(l_reg, rli, li, r32, hi);
    if (type == 2) {
        const float lam = T.lamv[0];
        const f32x4* scr = (const f32x4*)(T.SCR + ((size_t)blockIdx.x * 512 + tid) * 64);
#pragma unroll
        for (int d0 = 0; d0 < 4; ++d0)
#pragma unroll
            for (int q = 0; q < 4; ++q) { const f32x4 a = scr[d0 * 4 + q];
#pragma unroll
                for (int j = 0; j < 4; ++j) o[d0][q * 4 + j] = a[j] - lam * (o[d0][q * 4 + j] * rli[q * 4 + j]); }
    } else {
#pragma unroll
        for (int d0 = 0; d0 < 4; ++d0)
#pragma unroll
            for (int r = 0; r < 16; ++r) o[d0][r] *= rli[r];
    }
    __syncthreads();
    LAS float* stg = (LAS float*)(lds + wid * 16896);
#pragma unroll
    for (int d0 = 0; d0 < 4; ++d0)
#pragma unroll
        for (int r = 0; r < 16; ++r) stg[att::crow(r, hi) * 132 + d0 * 32 + r32] = o[d0][r];
    asm volatile("s_waitcnt lgkmcnt(0)" ::: "memory");
    {
        const int rr = lane >> 5, c4 = (lane & 31) * 4;
        const int col = type * 1024 + h * 128 + c4;
        f32x4 wsub = {1.f, 1.f, 1.f, 1.f};
        if (type == 2) { wsub = *(const f32x4*)(T.subln + c4) * (1.f - T.lam_init); }
        const bf16_t* gp = T.GATE + (orow0 + rr) * 3072 + col; bf16_t* op = T.BR + (orow0 + rr) * 3072 + col;
#pragma unroll 4
        for (int i = 0; i < 16; ++i) {
            f32x4 v = *(const LAS f32x4*)(stg + (2 * i + rr) * 132 + c4);
            const u32x2 gg = *(const u32x2*)(gp + (size_t)i * 2 * 3072);
            if (type == 2) {
                float s = (v[0] * v[0] + v[1] * v[1]) + (v[2] * v[2] + v[3] * v[3]);
                s += __shfl_xor(s, 1); s += __shfl_xor(s, 2); s += __shfl_xor(s, 4); s += __shfl_xor(s, 8); s += __shfl_xor(s, 16);
                v = v * (rsqrtf(s * (1.f / 128.f) + EPS)) * wsub;
            }
            u32x2 w; w.x = cvt_pk_bf16(v[0] * bf2f(gg.x & 0xffffu), v[1] * bf2f(gg.x >> 16)); w.y = cvt_pk_bf16(v[2] * bf2f(gg.y & 0xffffu), v[3] * bf2f(gg.y >> 16));
            *(u32x2*)(op + (size_t)i * 2 * 3072) = w;
        }
    }
}

__device__ __forceinline__ void transpose_item(const float* __restrict__ W, int ldw, int k0, int srccol, const float* __restrict__ kscale,
                                               bf16_t* __restrict__ WT, int ldt, int n0, int kdst0, LAS float* scr, int lane) {
#pragma unroll 8
    for (int i = 0; i < 32; ++i) { const int kk = 2 * i + (lane >> 5);
        float v = srccol >= 0 ? W[(size_t)(k0 + kk) * ldw + srccol] : 0.f;
        if (kscale) v *= kscale[k0 + kk];
        scr[kk * 33 + (lane & 31)] = v; }
    asm volatile("s_waitcnt lgkmcnt(0)" ::: "memory");
    const int c = lane & 7;
#pragma unroll
    for (int j = 0; j < 4; ++j) { const int n = (lane >> 3) + 8 * j; const LAS float* s = scr + (8 * c) * 33 + n;
        u32x4 o; o.x = cvt_pk_bf16(s[0 * 33], s[1 * 33]); o.y = cvt_pk_bf16(s[2 * 33], s[3 * 33]); o.z = cvt_pk_bf16(s[4 * 33], s[5 * 33]); o.w = cvt_pk_bf16(s[6 * 33], s[7 * 33]);
        *(u32x4*)(WT + (size_t)(n0 + n) * ldt + kdst0 + k0 + 8 * c) = o; }
    asm volatile("s_waitcnt lgkmcnt(0)" ::: "memory");
}
__device__ const float INVF32[16] = {1.000000000e+00f, 5.623413324e-01f, 3.162277639e-01f, 1.778279394e-01f, 1.000000015e-01f, 5.623413250e-02f, 3.162277490e-02f, 1.778279431e-02f,
    9.999999776e-03f, 5.623413250e-03f, 3.162277630e-03f, 1.778279431e-03f, 1.000000047e-03f, 5.623413017e-04f, 3.162277571e-04f, 1.778279402e-04f};
__device__ const float INVF64[32] = {1.000000000e+00f, 7.498942614e-01f, 5.623413324e-01f, 4.216965139e-01f, 3.162277639e-01f, 2.371373773e-01f, 1.778279394e-01f, 1.333521307e-01f,
    1.000000015e-01f, 7.498941571e-02f, 5.623413250e-02f, 4.216965288e-02f, 3.162277490e-02f, 2.371373773e-02f, 1.778279431e-02f, 1.333521493e-02f, 9.999999776e-03f, 7.498941850e-03f,
    5.623413250e-03f, 4.216964822e-03f, 3.162277630e-03f, 2.371373586e-03f, 1.778279431e-03f, 1.333521446e-03f, 1.000000047e-03f, 7.498942432e-04f, 5.623413017e-04f, 4.216965172e-04f,
    3.162277571e-04f, 2.371373703e-04f, 1.778279402e-04f, 1.333521504e-04f};
__device__ __forceinline__ void sincos_d(double x, float& s, float& c) {
    const double twopi = 6.283185307179586476925;
    const double k = __builtin_rint(x / twopi), r = x - k * twopi, r2 = r * r;
    double st = r, ct = 1.0, ss = r, cs = 1.0;
    for (int n = 1; n <= 16; ++n) { ct *= -r2 / (double)((2 * n - 1) * (2 * n)); st *= -r2 / (double)((2 * n) * (2 * n + 1)); cs += ct; ss += st; }
    s = (float)ss; c = (float)cs;
}
__device__ __forceinline__ float absmax_n(const float* w, int n) { float m = 0.f; for (int i = 0; i < n; ++i) m = fmaxf(m, fabsf(w[i])); return m; }

struct Args { const float* in[29]; float* out; unsigned char* ws; int ph_lo, ph_hi, coop, pad; };

__global__ void __launch_bounds__(512, 2) mega_fwd(Args args) {
    extern __shared__ __attribute__((aligned(16))) unsigned char lds_raw[];
    LAS unsigned char* lds = (LAS unsigned char*)lds_raw;
    const int G = gridDim.x, bx = blockIdx.x;
    const int vcu = (G % 8 == 0) ? (bx % 8) * (G / 8) + bx / 8 : bx;
    unsigned char* ws = args.ws;
    float* MOD = (float*)(ws + WS_MOD);
    float* TC64 = (float*)(ws + WS_TC64); float* TS64 = (float*)(ws + WS_TS64); float* TC128 = (float*)(ws + WS_TC128); float* TS128 = (float*)(ws + WS_TS128);
    float* LAM = (float*)(ws + WS_LAM);
    bf16_t* WIN = (bf16_t*)(ws + WS_WIN); bf16_t* WUP = (bf16_t*)(ws + WS_WUP); bf16_t* WBR = (bf16_t*)(ws + WS_WBR); bf16_t* WOUT = (bf16_t*)(ws + WS_WOUT);
    bf16_t* H = (bf16_t*)(ws + WS_H); bf16_t* QA = (bf16_t*)(ws + WS_QA); bf16_t* KA = (bf16_t*)(ws + WS_KA); bf16_t* VA = (bf16_t*)(ws + WS_VA);
    bf16_t* QB = (bf16_t*)(ws + WS_QB); bf16_t* KB = (bf16_t*)(ws + WS_KB); bf16_t* CKV = (bf16_t*)(ws + WS_CKV); bf16_t* VB = (bf16_t*)(ws + WS_VB);
    bf16_t* QC = (bf16_t*)(ws + WS_QC); bf16_t* KC = (bf16_t*)(ws + WS_KC); bf16_t* VC = (bf16_t*)(ws + WS_VC);
    bf16_t* GATE = (bf16_t*)(ws + WS_GATE); bf16_t* MRG = (bf16_t*)(ws + WS_MRG); bf16_t* BR = (bf16_t*)(ws + WS_BR); bf16_t* Y = (bf16_t*)(ws + WS_Y);
    float* SS = (float*)(ws + WS_SS); float* CTXW = (float*)(ws + WS_CTXW); float* SCR = (float*)(ws + WS_SCR);
    LAS float* xch = (LAS float*)(lds + XCH_OFF);

    for (int ph = args.ph_lo; ph < args.ph_hi; ++ph) {
        int tid = threadIdx.x; asm volatile("" : "+v"(tid));
        const int lane = tid & 63, wave = __builtin_amdgcn_readfirstlane(tid >> 6);
        if (ph == 0 && (MK_MASK & 1)) {
            {
                LAS float* sc = (LAS float*)lds;
                LAS float* red = (LAS float*)(lds + 65536);
                for (int i = tid; i < 5 * DM; i += 512) { const float v = i < 4 * DM ? args.in[1][i] : args.in[3][i - 4 * DM]; sc[i] = silu_f(v); }
                __syncthreads();
                for (int it = bx; it < DEPTH * 96; it += G) {
                    const int l = it / 96, n0 = (it % 96) * 64;
                    const float* W = args.in[5] + (size_t)l * DM * 6144 + n0 + lane;
                    float a0 = 0.f, a1 = 0.f, a2 = 0.f, a3 = 0.f, a4 = 0.f;
                    const int kb = wave * 256;
#pragma unroll 8
                    for (int k = 0; k < 256; ++k) { const float wv = W[(size_t)(kb + k) * 6144];
                        a0 += sc[kb + k] * wv; a1 += sc[DM + kb + k] * wv; a2 += sc[2 * DM + kb + k] * wv; a3 += sc[3 * DM + kb + k] * wv; a4 += sc[4 * DM + kb + k] * wv; }
                    red[(wave * 5 + 0) * 64 + lane] = a0; red[(wave * 5 + 1) * 64 + lane] = a1; red[(wave * 5 + 2) * 64 + lane] = a2; red[(wave * 5 + 3) * 64 + lane] = a3; red[(wave * 5 + 4) * 64 + lane] = a4;
                    __syncthreads();
                    if (tid < 320) { const int i = tid >> 6; float s = 0.f;
                        for (int w8 = 0; w8 < 8; ++w8) s += red[(w8 * 5 + i) * 64 + lane];
                        MOD[((size_t)l * 5 + i) * 6144 + n0 + lane] = s + args.in[6][(size_t)l * 6144 + n0 + lane]; }
                    __syncthreads();
                }
            }
            if (bx == 1 % G) {
                for (int i = tid; i < 64 * 16; i += 512) { const int pos = i >> 4, f = i & 15; const float ang = (float)pos * INVF32[f]; float s, c; sincos_d((double)ang, s, c); TC64[i] = c; TS64[i] = s; }
                for (int i = tid; i < 64 * 32; i += 512) { const int pos = i >> 5, f = i & 31; const float ang = (float)pos * INVF64[f]; float s, c; sincos_d((double)ang, s, c); TC128[i] = c; TS128[i] = s; }
            }
            if (bx == 2 % G && tid < DEPTH) {
                const int l = tid;
                float s1 = 0.f, s2 = 0.f;
                for (int i = 0; i < 64; ++i) { s1 += args.in[20][l * 64 + i] * args.in[21][l * 64 + i]; s2 += args.in[22][l * 64 + i] * args.in[23][l * 64 + i]; }
                const float lam_init = 0.8f - 0.6f * expf(-0.3f * (float)l);
                LAM[l * 4 + 0] = expf(s1) - expf(s2) + lam_init;
                const float mAq = absmax_n(args.in[9] + l * 128, 128), mAk = absmax_n(args.in[10] + l * 128, 128);
                const float mBqn = absmax_n(args.in[11] + l * 128, 128), mBqr = absmax_n(args.in[12] + l * 64, 64), mBkn = absmax_n(args.in[16] + l * 128, 128), mBkr = absmax_n(args.in[17] + l * 64, 64);
                const float mCq = absmax_n(args.in[18] + l * 64, 64), mCk = absmax_n(args.in[19] + l * 64, 64);
                const float L2E = 1.4426950408889634f;
                LAM[l * 4 + 1] = -(sqrtf(128.f) * mAq * mAk) * L2E;
                LAM[l * 4 + 2] = -(sqrtf(128.f * mBqn * mBqn + 64.f * mBqr * mBqr) * sqrtf(128.f * mBkn * mBkn + 64.f * mBkr * mBkr) * 0.07216878364870323f) * L2E;
                LAM[l * 4 + 3] = -(8.f * mCq * mCk) * L2E;
            }
            __syncthreads();
            {
                LAS float* scr = (LAS float*)(lds + wave * 16384);
                const int gw = vcu * 8 + wave, NGW = G * 8;
                constexpr int I_IN = 32 * (NIN / 32), I_UP = 8 * 64, I_BR = 3 * 16 * 64, I_OUT = 32 * 64, I_L = I_IN + I_UP + I_BR + I_OUT;
                for (int it = gw; it < DEPTH * I_L; it += NGW) {
                    const int l = it / I_L; int r = it % I_L;
                    if (r < I_IN) { const int nb = r % (NIN / 32), kb = r / (NIN / 32); const int n0 = nb * 32;
                        transpose_item(args.in[7] + (size_t)l * DM * INC, INC, kb * 64, in_src_col(n0 + (lane & 31)), nullptr, WIN + (size_t)l * NIN * DM, DM, n0, 0, scr, lane); continue; }
                    r -= I_IN;
                    if (r < I_UP) { const int nb = r % 64, kb = r / 64; const int n0 = nb * 32; const int sc_ = up_src_col(n0 + (lane & 31));
                        const float* W = (sc_ < 1024 ? args.in[14] : args.in[15]) + (size_t)l * 512 * 1024;
                        transpose_item(W, 1024, kb * 64, sc_ & 1023, args.in[13] + l * 512, WUP + (size_t)l * 2048 * 512, 512, n0, 0, scr, lane); continue; }
                    r -= I_UP;
                    if (r < I_BR) { const int br = r / (16 * 64), r2 = r % (16 * 64); const int nb = r2 % 64, kb = r2 / 64; const int n0 = nb * 32;
                        transpose_item(args.in[25 + br] + (size_t)l * 1024 * DM, DM, kb * 64, n0 + (lane & 31), nullptr, WBR + (size_t)l * 2048 * 3072, 3072, n0, br * 1024, scr, lane); continue; }
                    r -= I_BR;
                    { const int nb = r % 64, kb = r / 64; const int n0 = nb * 32;
                      transpose_item(args.in[28] + (size_t)l * DM * DM, DM, kb * 64, n0 + (lane & 31), nullptr, WOUT + (size_t)l * DM * DM, DM, n0, 0, scr, lane); }
                }
            }
        } else {
            const int l = (ph - 1) / 6, st = (ph - 1) % 6;
            const float* xsrc = (l == 0) ? args.in[0] : args.out;
            const float* csrc = (l == 0) ? args.in[2] : CTXW;
            const float* modl = MOD + (size_t)l * 5 * 6144;
            const int Mrows = (l == DEPTH - 1) ? MLAT : MTOT;
            if (st == 0 && (MK_MASK & 2)) {
                const float* nw = args.in[4] + (size_t)l * DM;
                for (int row = bx * 8 + wave; row < MTOT; row += G * 8) {
                    const bool lat = row < MLAT; const int mi = lat ? (row >> 12) : 4;
                    const f32x4* xr = (const f32x4*)(lat ? xsrc + (size_t)row * DM : csrc + (size_t)(row - MLAT) * DM) + lane;
                    f32x4 v[8]; float s = 0.f;
#pragma unroll
                    for (int j = 0; j < 8; ++j) { v[j] = xr[64 * j]; s += (v[j][0] * v[j][0] + v[j][1] * v[j][1]) + (v[j][2] * v[j][2] + v[j][3] * v[j][3]); }
                    const float rinv = rsqrtf(wave_sum(s) * (1.f / DM) + EPS);
                    const f32x4* sh = (const f32x4*)(modl + mi * 6144) + lane; const f32x4* scl = (const f32x4*)(modl + mi * 6144 + DM) + lane; const f32x4* nwp = (const f32x4*)nw + lane;
                    u32x2* o8 = (u32x2*)(H + (size_t)row * DM) + lane;
#pragma unroll
                    for (int j = 0; j < 8; ++j) { const f32x4 y = v[j] * rinv * nwp[64 * j] * (scl[64 * j] + 1.f) + sh[64 * j];
                        u32x2 w; w.x = cvt_pk_bf16(y[0], y[1]); w.y = cvt_pk_bf16(y[2], y[3]); o8[64 * j] = w; }
                }
            } else if (st == 1 && (MK_MASK & 4)) {
                pg8::Gemm g{H, WIN + (size_t)l * NIN * DM, MTOT, NIN, DM}; pg8::StaticOrder S; S.init(MTOT, NIN, G, bx);
                EpiIn E{QA, KA, VA, QB, KB, CKV, QC, KC, VC, GATE, MRG, SS,
                        args.in[9] + l * 128, args.in[10] + l * 128, args.in[11] + l * 128, args.in[12] + l * 64, args.in[17] + l * 64, args.in[18] + l * 64, args.in[19] + l * 64,
                        args.in[8] + (size_t)l * 6144, TC64, TS64, TC128, TS128, xch};
                pg8::gemm_phase<EpiIn>(lds, g, S, E, tid);
            } else if (st == 2 && (MK_MASK & 8)) {
                pg8::Gemm g{CKV, WUP + (size_t)l * 2048 * 512, MTOT, 2048, 512}; pg8::StaticOrder S; S.init(MTOT, 2048, G, bx);
                EpiUp E{KB, VB, SS, args.in[16] + l * 128, xch};
                pg8::gemm_phase<EpiUp>(lds, g, S, E, tid);
            } else if (st == 3 && (MK_MASK & 16)) {
                AttnBufs T{QA, KA, VA, QB, KB, VB, QC, KC, VC, GATE, BR, SCR, LAM + l * 4, args.in[24] + l * 128, 0.8f - 0.6f * expf(-0.3f * (float)l)};
                const int nctx = (l < DEPTH - 1) ? 96 : 0;
                for (int k = 0;; ++k) {
                    int type, b, h, qrow0, NT;
                    if (G == 256) {
                        if (k < 6) { const int id = (k & 1) * 256 + vcu; type = k >> 1; b = id >> 7; h = (id >> 4) & 7; qrow0 = b * SEQ + (id & 15) * 256; NT = 68; }
                        else if (k == 6 && bx < nctx) { type = bx >> 5; b = (bx >> 3) & 3; h = bx & 7; qrow0 = MLAT + b * CTXL; NT = 4; }
                        else break;
                    } else {
                        const int it = bx + k * G; if (it >= 1536 + nctx) break;
                        if (it < 1536) { const int id = it & 511; type = it >> 9; b = id >> 7; h = (id >> 4) & 7; qrow0 = b * SEQ + (id & 15) * 256; NT = 68; }
                        else { const int c = it - 1536; type = c >> 5; b = (c >> 3) & 3; h = c & 7; qrow0 = MLAT + b * CTXL; NT = 4; }
                    }
                    attn_item(T, type, b, h, qrow0, NT, (LAS char*)lds, tid);
                }
                __syncthreads();
            } else if (st == 4 && (MK_MASK & 32)) {
                pg8::Gemm g{BR, WBR + (size_t)l * 2048 * 3072, Mrows, 2048, 3072}; pg8::StaticOrder S; S.init(Mrows, 2048, G, bx);
                EpiBr E{MRG, Y};
                pg8::gemm_phase<EpiBr>(lds, g, S, E, tid);
            } else if (MK_MASK & 64) {
                pg8::Gemm g{Y, WOUT + (size_t)l * DM * DM, Mrows, DM, DM}; pg8::StaticOrder S; S.init(Mrows, DM, G, bx);
                EpiOut E{xsrc, csrc, args.out, CTXW, modl};
                pg8::gemm_phase<EpiOut>(lds, g, S, E, tid);
            }
        }
        if (ph + 1 < args.ph_hi) { if (args.coop) cg::this_grid().sync(); }
    }
}

extern "C" void kernel_launch(void* const* d_in, const int* in_sizes, int n_in, void* d_out, int out_size, void* d_ws, size_t ws_size, hipStream_t stream) {
    static int grid = 0;
    if (grid == 0) {
        if (n_in != 29 || in_sizes[0] != MLAT * DM || out_size != MLAT * DM || ws_size < WS_END) {
            fprintf(stderr, "kernel_launch: unexpected shapes: n_in %d in0 %d out %d ws %zu (need %zu)\n", n_in, n_in > 0 ? in_sizes[0] : -1, out_size, ws_size, (size_t)WS_END); grid = -1; return; }
        int dev = 0, cus = 0, per_cu = 0;
        if (hipGetDevice(&dev) != hipSuccess || hipDeviceGetAttribute(&cus, hipDeviceAttributeMultiprocessorCount, dev) != hipSuccess) { grid = -1; return; }
        if (hipFuncSetAttribute((const void*)mega_fwd, hipFuncAttributeMaxDynamicSharedMemorySize, LDS_BYTES) != hipSuccess) { fprintf(stderr, "kernel_launch: hipFuncSetAttribute failed\n"); grid = -1; return; }
        if (hipOccupancyMaxActiveBlocksPerMultiprocessor(&per_cu, (const void*)mega_fwd, 512, LDS_BYTES) != hipSuccess || per_cu < 1) { fprintf(stderr, "kernel_launch: occupancy query gives %d\n", per_cu); per_cu = 1; }
        (void)hipGetLastError();
        grid = cus * 1;
    }
    if (grid < 0) return;
    Args a{};
    for (int i = 0; i < 29; ++i) a.in[i] = (const float*)d_in[i];
    a.out = (float*)d_out; a.ws = (unsigned char*)d_ws;
#if MK_COOP
    a.ph_lo = 0; a.ph_hi = NPH; a.coop = 1;
    void* kargs[] = {&a};
    hipError_t e = hipLaunchCooperativeKernel((const void*)mega_fwd, dim3(grid), dim3(512), kargs, LDS_BYTES, stream);
    if (e != hipSuccess) fprintf(stderr, "kernel_launch: cooperative launch failed: %s (grid %d)\n", hipGetErrorString(e), grid);
#else
    for (int ph = 0; ph < NPH; ++ph) {
        a.ph_lo = ph; a.ph_hi = ph + 1; a.coop = 0;
        hipLaunchKernelGGL(mega_fwd, dim3(grid), dim3(512), LDS_BYTES, stream, a);
    }
    const hipError_t le = hipPeekAtLastError();
    if (le != hipSuccess) fprintf(stderr, "kernel_launch: launch failed: %s\n", hipGetErrorName(le));
#endif
}
```

```cpp
#include <hip/hip_runtime.h>
#include <hip/hip_cooperative_groups.h>
#include <cstdio>
#include <cstdint>
namespace cg = cooperative_groups;

#ifndef MK_MASK
#define MK_MASK 127
#endif
#ifndef MK_ATYPE
#define MK_ATYPE 7
#endif
#ifndef MK_G1T
#define MK_G1T 127
#endif
#ifndef ATT_SD_A
#define ATT_SD_A 2
#endif
#ifndef ATT_SD_B
#define ATT_SD_B 1
#endif
#ifndef ATT_SD_C
#define ATT_SD_C 2
#endif
#ifndef ATT_DBL_B
#define ATT_DBL_B true
#endif
#ifndef ATT_DBL
#define ATT_DBL false
#endif
#ifndef QKT_GRP
#define QKT_GRP 0
#endif
#ifndef MK_COOP
#define MK_COOP 1
#endif

#define LAS __attribute__((address_space(3)))
typedef unsigned short bf16_t;
typedef short bf16x8 __attribute__((ext_vector_type(8)));
typedef short s16x4 __attribute__((ext_vector_type(4)));
typedef float f32x4 __attribute__((ext_vector_type(4)));
typedef float f32x16 __attribute__((ext_vector_type(16)));
typedef unsigned u32x4 __attribute__((ext_vector_type(4)));
typedef unsigned u32x2 __attribute__((ext_vector_type(2)));

constexpr int DM = 2048, NBATCH = 4, SEQ = 4096, CTXL = 256, DEPTH = 4;
constexpr int MLAT = NBATCH * SEQ, MCTX = NBATCH * CTXL, MTOT = MLAT + MCTX;
constexpr int INC = 15936, NIN = 16128;
constexpr float EPS = 1e-6f;
#ifndef MK_REP_ST
#define MK_REP_ST -1
#endif
constexpr int PPL = 6 + (MK_REP_ST >= 0 ? 1 : 0);
constexpr int NPH = 1 + PPL * DEPTH;

constexpr size_t alignup(size_t x) { return (x + 255) / 256 * 256; }
constexpr size_t WS_MOD = 0;
constexpr size_t WS_TC64 = WS_MOD + alignup((size_t)DEPTH * 5 * 6144 * 4);
constexpr size_t WS_TS64 = WS_TC64 + 4096, WS_TC128 = WS_TS64 + 4096, WS_TS128 = WS_TC128 + 8192;
constexpr size_t WS_LAM = WS_TS128 + 8192;
constexpr size_t WS_BAR = WS_LAM + 256;
constexpr size_t WS_WIN = WS_BAR + 16384;
constexpr size_t WS_WUP = WS_WIN + (size_t)DEPTH * NIN * DM * 2;
constexpr size_t WS_WBR = WS_WUP + (size_t)DEPTH * 2048 * 512 * 2;
constexpr size_t WS_WOUT = WS_WBR + (size_t)DEPTH * 2048 * 3072 * 2;
constexpr size_t WS_H = WS_WOUT + (size_t)DEPTH * 2048 * 2048 * 2;
constexpr size_t WS_QA = WS_H + (size_t)MTOT * 2048 * 2;
constexpr size_t WS_KA = WS_QA + (size_t)MTOT * 1024 * 2;
constexpr size_t WS_VA = WS_KA + (size_t)MTOT * 256 * 2;
constexpr size_t WS_QB = WS_VA + (size_t)MTOT * 256 * 2;
constexpr size_t WS_KB = WS_QB + (size_t)MTOT * 1536 * 2;
constexpr size_t WS_CKV = WS_KB + (size_t)MTOT * 1536 * 2;
constexpr size_t WS_VB = WS_CKV + (size_t)MTOT * 512 * 2;
constexpr size_t WS_QC = WS_VB + (size_t)MTOT * 1024 * 2;
constexpr size_t WS_KC = WS_QC + (size_t)MTOT * 1024 * 2;
constexpr size_t WS_VC = WS_KC + (size_t)MTOT * 1024 * 2;
constexpr size_t WS_GATE = WS_VC + (size_t)MTOT * 1024 * 2;
constexpr size_t WS_MRG = WS_GATE + (size_t)MTOT * 3072 * 2;
constexpr size_t WS_BR = WS_MRG + (size_t)MTOT * 6144 * 2;
constexpr size_t WS_Y = WS_BR + (size_t)MTOT * 3072 * 2;
constexpr size_t WS_SS = WS_Y + (size_t)MTOT * 2048 * 2;
constexpr size_t WS_CTXW = WS_SS + (size_t)MTOT * 8 * 4;
constexpr size_t WS_SCR = WS_CTXW + (size_t)MCTX * DM * 4;
constexpr size_t WS_END = WS_SCR + (size_t)256 * 64 * 512 * 4;

constexpr int RING_BYTES = 131072, XCH_OFF = RING_BYTES, LDS_BYTES = 147456;

__device__ __forceinline__ float bf2f(unsigned h) { return __uint_as_float(h << 16); }
__device__ __forceinline__ unsigned cvt_pk_bf16(float lo, float hi) { unsigned r; asm volatile("v_cvt_pk_bf16_f32 %0, %1, %2" : "=v"(r) : "v"(lo), "v"(hi)); return r; }
__device__ __forceinline__ float wave_sum(float v) {
#pragma unroll
    for (int o = 1; o < 64; o <<= 1) v += __shfl_xor(v, o);
    return v;
}
__device__ __forceinline__ float silu_f(float x) { return x / (1.f + __expf(-x)); }
__device__ __forceinline__ float sigm_f(float x) { return 1.f / (1.f + __expf(-x)); }
__device__ __forceinline__ void store8(bf16_t* p, f32x4 a, f32x4 b) {
    u32x4 w; w.x = cvt_pk_bf16(a[0], a[1]); w.y = cvt_pk_bf16(a[2], a[3]); w.z = cvt_pk_bf16(b[0], b[1]); w.w = cvt_pk_bf16(b[2], b[3]);
    *(u32x4*)p = w;
}

namespace pg8 {
constexpr int BM = 256, BK = 64, HALF = 128, HTB = HALF * BK * 2, NXCD = 8, WGM = 8;
__host__ __device__ __forceinline__ int lds_byte(int r, int c) { const int st = (r >> 4) * 2 + (c >> 5), rr = r & 15, cc = c & 31, ob = rr * 64 + cc * 2; return st * 1024 + (ob ^ (((ob >> 9) & 1) << 5)); }
__host__ __device__ __forceinline__ void stage_rc(int b, int& R, int& C) { const int st = b / 1024, sb = b % 1024, swz = sb ^ (((sb >> 9) & 1) << 5); R = (st >> 1) * 16 + swz / 64; C = (st & 1) * 32 + (swz % 64) / 2; }
__host__ __device__ __forceinline__ int perm32(int rho) { const int n = rho >> 4, i = rho & 15; return 8 * (i >> 2) + 4 * n + (i & 3); }

struct Unit { int pm, pn; };
struct Gemm { const bf16_t* A; const bf16_t* Bt; int M, N, K; };
struct StaticOrder {
    int nM, nN, nwg, G, c;
    __device__ void init(int M, int N, int G_, int c_) { nM = M / BM; nN = N / BM; nwg = nM * nN; G = G_; c = c_; }
    __device__ bool next(int i, Unit& u) const {
        const long L = (long)i * G + c; if (L >= nwg) return false;
        int wgid = (int)L; { const int q = nwg / NXCD, r = nwg % NXCD, xcd = wgid % NXCD, off = wgid / NXCD; wgid = (xcd < r ? xcd * (q + 1) : r * (q + 1) + (xcd - r) * q) + off; }
        const int nig = WGM * nN, gid = wgid / nig, fm = gid * WGM, gsz = (nM - fm) < WGM ? (nM - fm) : WGM;
        u.pm = fm + ((wgid % nig) % gsz); u.pn = (wgid % nig) / gsz; return true;
    }
};

template <class Epi>
__device__ __forceinline__ void gemm_phase(LAS unsigned char* lds, const Gemm g, const StaticOrder& S, const Epi& E, const int tid) {
    const int wid = __builtin_amdgcn_readfirstlane(tid >> 6), lane = tid & 63, wr = wid >> 2, wc = wid & 3, fr = lane & 15, fq = lane >> 4;
    const int K = g.K, nt = K / BK;
    unsigned voffA[2], voffB[2];
#pragma unroll
    for (int i = 0; i < 2; ++i) { int R, C; stage_rc(tid * 16 + i * 8192, R, C); const int Rb = (R & ~31) + perm32(R & 31);
        voffA[i] = (unsigned)(R * K + C) * 2u; voffB[i] = (unsigned)(Rb * K + C) * 2u; }
    const size_t kstep = (size_t)(BK * 2);
    const size_t hstep = (size_t)HALF * K * 2;
    const size_t tstep = 2 * hstep;
    const unsigned ldsw = (unsigned)wid * 1024u;
    const int aoff = lds_byte(wr * 64 + fr, fq * 8), boff = lds_byte(wc * 32 + fr, fq * 8);
#define PG8_SA(b, h) (((b) * 2 + (h)) * HTB)
#define PG8_SB(b, h) ((4 + (b) * 2 + (h)) * HTB)
#define PG8_STAGE(bufoff, gbase, voff) do { _Pragma("unroll") for (int _i = 0; _i < 2; ++_i) \
        __builtin_amdgcn_global_load_lds((const unsigned*)((const char*)(gbase) + (voff)[_i]), (LAS unsigned*)(lds + (bufoff) + ldsw + _i * 8192), 16, 0, 0); } while (0)
#define PG8_LDA(dst, b, h) do { _Pragma("unroll") for (int m = 0; m < 4; ++m) _Pragma("unroll") for (int k = 0; k < 2; ++k) dst[m][k] = *(const LAS bf16x8*)(lds + PG8_SA(b, h) + aoff + m * 2048 + k * 1024); } while (0)
#define PG8_LDB(dst, b, h) do { _Pragma("unroll") for (int n = 0; n < 2; ++n) _Pragma("unroll") for (int k = 0; k < 2; ++k) dst[n][k] = *(const LAS bf16x8*)(lds + PG8_SB(b, h) + boff + n * 2048 + k * 1024); } while (0)
#define PG8_MMA(ai, bj, At, Bt) do { __builtin_amdgcn_s_setprio(1); _Pragma("unroll") for (int m = 0; m < 4; ++m) _Pragma("unroll") for (int n = 0; n < 2; ++n) _Pragma("unroll") for (int k = 0; k < 2; ++k) \
        acc[ai][bj][m][n] = __builtin_amdgcn_mfma_f32_16x16x32_bf16(Bt[n][k], At[m][k], acc[ai][bj][m][n], 0, 0, 0); __builtin_amdgcn_s_setprio(0); } while (0)
#define PG8_WAIT_V(n) asm volatile("s_waitcnt vmcnt(" #n ")" ::: "memory")
#define PG8_WAIT_L(n) asm volatile("s_waitcnt lgkmcnt(" #n ")" ::: "memory")
#define PG8_BAR __builtin_amdgcn_s_barrier()
#define PG8_SCHED __builtin_amdgcn_sched_barrier(0)
    Unit cur, nxt; int ui = 0;
    if (!S.next(0, cur)) return;
    f32x4 acc[2][2][4][2];
#pragma unroll
    for (int a = 0; a < 2; ++a)
#pragma unroll
        for (int b = 0; b < 2; ++b)
#pragma unroll
            for (int m = 0; m < 4; ++m)
#pragma unroll
                for (int n = 0; n < 2; ++n) acc[a][b][m][n] = (f32x4){0.f, 0.f, 0.f, 0.f};
    bf16x8 At[4][2], B0[2][2], B1[2][2];
    const char* cA = (const char*)g.A + (size_t)cur.pm * tstep; const char* cB = (const char*)g.Bt + (size_t)cur.pn * tstep;
    PG8_STAGE(PG8_SB(0, 0), cB, voffB); PG8_STAGE(PG8_SB(0, 1), cB + hstep, voffB); PG8_STAGE(PG8_SA(0, 0), cA, voffA); PG8_STAGE(PG8_SA(0, 1), cA + hstep, voffA);
    if (wr == 1) PG8_BAR;
    PG8_WAIT_V(2); PG8_BAR;
    PG8_STAGE(PG8_SB(1, 0), cB + kstep, voffB); PG8_STAGE(PG8_SA(1, 0), cA + kstep, voffA); PG8_STAGE(PG8_SB(1, 1), cB + hstep + kstep, voffB);
    PG8_WAIT_V(6); PG8_BAR;
    for (;;) {
        const bool has_next = S.next(ui + 1, nxt);
        const char* nA = has_next ? (const char*)g.A + (size_t)nxt.pm * tstep : cA; const char* nB = has_next ? (const char*)g.Bt + (size_t)nxt.pn * tstep : cB;
        for (int t = 0; t < nt; t += 2) {
            const bool last = (t == nt - 2);
            const char* a1 = cA + (size_t)(t + 1) * kstep;
            const char* a2 = last ? nA : cA + (size_t)(t + 2) * kstep; const char* b2 = last ? nB : cB + (size_t)(t + 2) * kstep;
            const char* a3 = a2 + kstep; const char* b3 = b2 + kstep;
            if constexpr (Epi::MID) { if (t == 16 || t == 32) { int fr_ = fr, fq_ = fq, wr_ = wr, wc_ = wc;
                asm volatile("" : "+v"(fr_), "+v"(fq_)); asm volatile("" : "+s"(wr_), "+s"(wc_));
                E.mid(acc, cur, t >> 4, wr_, wc_, fr_, fq_); PG8_WAIT_V(0); PG8_SCHED; } }
            PG8_LDB(B0, 0, 0); PG8_LDB(B1, 0, 1); PG8_SCHED; PG8_LDA(At, 0, 0); PG8_STAGE(PG8_SA(1, 1), a1 + hstep, voffA);
            PG8_WAIT_V(8); PG8_WAIT_L(0); PG8_BAR; PG8_MMA(0, 0, At, B0); PG8_MMA(0, 1, At, B1); PG8_BAR; PG8_SCHED;
            PG8_LDA(At, 0, 1); PG8_STAGE(PG8_SB(0, 0), b2, voffB); PG8_STAGE(PG8_SB(0, 1), b2 + hstep, voffB); PG8_STAGE(PG8_SA(0, 0), a2, voffA);
            PG8_WAIT_V(8); PG8_WAIT_L(0); PG8_BAR; PG8_MMA(1, 0, At, B0); PG8_MMA(1, 1, At, B1); PG8_BAR; PG8_SCHED;
            PG8_LDB(B0, 1, 0); PG8_LDB(B1, 1, 1); PG8_SCHED; PG8_LDA(At, 1, 0); PG8_STAGE(PG8_SA(0, 1), a2 + hstep, voffA);
            PG8_WAIT_V(8); PG8_WAIT_L(0); PG8_BAR; PG8_MMA(0, 0, At, B0); PG8_MMA(0, 1, At, B1); PG8_BAR; PG8_SCHED;
            PG8_LDA(At, 1, 1); PG8_STAGE(PG8_SB(1, 0), b3, voffB); PG8_STAGE(PG8_SB(1, 1), b3 + hstep, voffB); PG8_STAGE(PG8_SA(1, 0), a3, voffA);
            PG8_WAIT_V(8); PG8_WAIT_L(0); PG8_BAR; PG8_MMA(1, 0, At, B0); PG8_MMA(1, 1, At, B1); PG8_BAR; PG8_SCHED;
        }
        if (wr == 0) PG8_BAR;
        { int fr_ = fr, fq_ = fq, wr_ = wr, wc_ = wc, wid_ = wid;
          asm volatile("" : "+v"(fr_), "+v"(fq_)); asm volatile("" : "+s"(wr_), "+s"(wc_), "+s"(wid_));
          E(acc, cur, wr_, wc_, fr_, fq_, wid_); }
        if (!has_next) break;
#pragma unroll
        for (int a = 0; a < 2; ++a)
#pragma unroll
            for (int b = 0; b < 2; ++b)
#pragma unroll
                for (int m = 0; m < 4; ++m)
#pragma unroll
                    for (int n = 0; n < 2; ++n) acc[a][b][m][n] = (f32x4){0.f, 0.f, 0.f, 0.f};
        cur = nxt; cA = nA; cB = nB; ++ui;
        if (wr == 1) PG8_BAR;
    }
    PG8_WAIT_V(0);
    PG8_BAR;
#undef PG8_SA
#undef PG8_SB
#undef PG8_STAGE
#undef PG8_LDA
#undef PG8_LDB
#undef PG8_MMA
#undef PG8_WAIT_V
#undef PG8_WAIT_L
#undef PG8_BAR
#undef PG8_SCHED
}
}
using pg8::Unit;

__device__ __forceinline__ int in_src_col(int n) {
    const int tile = n >> 8, s = n & 255, bj = s >> 7, wc = (s >> 5) & 3, c = s & 31;
    const int d128 = 64 * (wc & 1) + 32 * bj + c, g128 = wc >> 1;
    const int d64 = 32 * (c >> 4) + 16 * bj + (c & 15), g64 = wc;
    if (tile < 4) return (tile * 2 + g128) * 128 + d128;
    if (tile == 4) return 1024 + g128 * 128 + d128;
    if (tile == 5) return 1280 + s;
    if (tile < 10) return 1536 + ((tile - 6) * 2 + g128) * 192 + d128;
    if (tile < 12) return 1536 + ((tile - 10) * 4 + g64) * 192 + 128 + d64;
    if (tile < 14) return 3072 + (tile - 12) * 256 + s;
    if (tile == 14) return g64 == 0 ? 3584 + d64 : -1;
    if (tile < 19) return 3648 + ((tile - 15) * 4 + g64) * 64 + d64;
    if (tile < 23) return 4672 + ((tile - 19) * 4 + g64) * 64 + d64;
    if (tile < 27) return 5696 + (tile - 23) * 256 + s;
    if (tile < 39) return 6720 + (tile - 27) * 256 + s;
    return 9792 + (tile - 39) * 256 + s;
}
__device__ __forceinline__ int up_src_col(int n) {
    if (n >= 1024) return n;
    const int tile = n >> 8, s = n & 255, bj = s >> 7, wc = (s >> 5) & 3, c = s & 31;
    return (tile * 2 + (wc >> 1)) * 128 + 64 * (wc & 1) + 32 * bj + c;
}

template <int GS>
__device__ __forceinline__ void norm_rope_store(const f32x4 (&acc)[2][2][4][2], int pm, int wr, int wc, int fr, int fq, int wid,
                                                const float* __restrict__ w, const float* __restrict__ tcos, const float* __restrict__ tsin, bool rope,
                                                const float (&pre)[2][4], bf16_t* __restrict__ dst, int ld, int gbase, int ncopies, int copystride, LAS float* xch) {
    const int dbase = (GS == 128) ? 64 * (wc & 1) + 8 * fq : 32 * (fq >> 1) + 8 * (fq & 1);
    const int bjs = (GS == 128) ? 32 : 16;
    const int axis = (GS == 128) ? (wc & 1) : (fq >> 1);
    const int i0 = (GS == 128) ? 8 * fq : 8 * (fq & 1);
    constexpr int NF = (GS == 128) ? 32 : 16;
    const int wavebase = gbase + ((GS == 128) ? 64 * (wc & 1) : 0) + 8 * fq;
    float ssq[2][4];
#pragma unroll
    for (int ai = 0; ai < 2; ++ai)
#pragma unroll
        for (int m = 0; m < 4; ++m) {
            float s = 0.f;
#pragma unroll
            for (int bj = 0; bj < 2; ++bj)
#pragma unroll
                for (int n = 0; n < 2; ++n)
#pragma unroll
                    for (int j = 0; j < 4; ++j) { const float v = acc[ai][bj][m][n][j] * pre[ai][m]; s += v * v; }
            s += __shfl_xor(s, 16); s += __shfl_xor(s, 32);
            ssq[ai][m] = s;
        }
    if constexpr (GS == 128) {
        if (fq == 0) {
#pragma unroll
            for (int ai = 0; ai < 2; ++ai)
#pragma unroll
                for (int m = 0; m < 4; ++m) xch[wid * 128 + ai * 64 + m * 16 + fr] = ssq[ai][m];
        }
        asm volatile("s_waitcnt lgkmcnt(0)" ::: "memory"); __builtin_amdgcn_s_barrier();
#pragma unroll
        for (int ai = 0; ai < 2; ++ai)
#pragma unroll
            for (int m = 0; m < 4; ++m) ssq[ai][m] += xch[(wid ^ 1) * 128 + ai * 64 + m * 16 + fr];
    }
#pragma unroll
    for (int ai = 0; ai < 2; ++ai)
#pragma unroll
        for (int m = 0; m < 4; ++m) {
            const int rl = ai * 128 + wr * 64 + m * 16 + fr;
            const size_t row = (size_t)pm * 256 + rl;
            const float rinv = rsqrtf(ssq[ai][m] * (1.f / GS) + EPS) * pre[ai][m];
            const int t = (pm & 15) * 256 + rl; const int pos = axis ? (t & 63) : (t >> 6);
            u32x4 k0, k1;
#pragma unroll
            for (int n = 0; n < 2; ++n) {
                const f32x4 w0 = *(const f32x4*)(w + dbase + 4 * n), w1 = *(const f32x4*)(w + dbase + bjs + 4 * n);
                f32x4 y0 = acc[ai][0][m][n] * rinv * w0, y1 = acc[ai][1][m][n] * rinv * w1;
                if (rope) {
                    const f32x4 c = *(const f32x4*)(tcos + pos * NF + i0 + 4 * n), sn = *(const f32x4*)(tsin + pos * NF + i0 + 4 * n);
                    const f32x4 o0 = y0 * c - y1 * sn, o1 = y1 * c + y0 * sn;
                    y0 = o0; y1 = o1;
                }
                if (n == 0) { k0.x = cvt_pk_bf16(y0[0], y0[1]); k0.y = cvt_pk_bf16(y0[2], y0[3]); k1.x = cvt_pk_bf16(y1[0], y1[1]); k1.y = cvt_pk_bf16(y1[2], y1[3]); }
                else { k0.z = cvt_pk_bf16(y0[0], y0[1]); k0.w = cvt_pk_bf16(y0[2], y0[3]); k1.z = cvt_pk_bf16(y1[0], y1[1]); k1.w = cvt_pk_bf16(y1[2], y1[3]); }
            }
            bf16_t* p = dst + row * ld + wavebase;
            for (int cp = 0; cp < ncopies; ++cp) { *(u32x4*)(p + cp * copystride) = k0; *(u32x4*)(p + cp * copystride + 32) = k1; }
            __builtin_amdgcn_sched_barrier(0);
        }
}

struct EpiIn {
    static constexpr bool MID = false;
    bf16_t *QA, *KA, *VA, *QB, *KB, *CKV, *QC, *KC, *VC, *GATE, *MRG; float* SS;
    const float *wAq, *wAk, *wBqn, *wBqr, *wBkr, *wCq, *wCk, *bmerge;
    const float *tc64, *ts64, *tc128, *ts128;
    LAS float* xch;
    template <int ACT>
    __device__ __forceinline__ void plain(const f32x4 (&acc)[2][2][4][2], int pm, int wr, int wc, int fr, int fq, bf16_t* dst, int ld, int col0) const {
        const int colw = col0 + 32 * wc + 8 * fq;
        f32x4 b[2][2];
#pragma unroll
        for (int bj = 0; bj < 2; ++bj)
#pragma unroll
            for (int n = 0; n < 2; ++n) b[bj][n] = (ACT == 2) ? *(const f32x4*)(bmerge + colw + bj * 128 + 4 * n) : (f32x4){0.f, 0.f, 0.f, 0.f};
#pragma unroll
        for (int ai = 0; ai < 2; ++ai)
#pragma unroll
            for (int m = 0; m < 4; ++m) {
                const size_t row = (size_t)pm * 256 + ai * 128 + wr * 64 + m * 16 + fr;
#pragma unroll
                for (int bj = 0; bj < 2; ++bj) {
                    f32x4 v0 = acc[ai][bj][m][0], v1 = acc[ai][bj][m][1];
                    if (ACT == 1) { for (int j = 0; j < 4; ++j) { v0[j] = silu_f(v0[j]); v1[j] = silu_f(v1[j]); } }
                    if (ACT == 2) { v0 = v0 + b[bj][0]; v1 = v1 + b[bj][1]; for (int j = 0; j < 4; ++j) { v0[j] = sigm_f(v0[j]); v1[j] = sigm_f(v1[j]); } }
                    store8(dst + row * ld + colw + bj * 128, v0, v1);
                }
                __builtin_amdgcn_sched_barrier(0);
            }
    }
    __device__ __forceinline__ void operator()(const f32x4 (&acc)[2][2][4][2], const Unit& u, int wr, int wc, int fr, int fq, int wid) const {
        const int t = u.pn, pm = u.pm; const bool rope = pm < 64;
        const float one[2][4] = {{1.f, 1.f, 1.f, 1.f}, {1.f, 1.f, 1.f, 1.f}};
        if (t < 4 && (MK_G1T & 1)) norm_rope_store<128>(acc, pm, wr, wc, fr, fq, wid, wAq, tc128, ts128, rope, one, QA, 1024, (t * 2 + (wc >> 1)) * 128, 1, 0, xch);
        else if (t == 4 && (MK_G1T & 1)) norm_rope_store<128>(acc, pm, wr, wc, fr, fq, wid, wAk, tc128, ts128, rope, one, KA, 256, (wc >> 1) * 128, 1, 0, xch);
        else if (t == 5 && (MK_G1T & 2)) plain<0>(acc, pm, wr, wc, fr, fq, VA, 256, 0);
        else if (t < 10 && (MK_G1T & 1)) norm_rope_store<128>(acc, pm, wr, wc, fr, fq, wid, wBqn, tc128, ts128, false, one, QB, 1536, ((t - 6) * 2 + (wc >> 1)) * 192, 1, 0, xch);
        else if (t < 12 && (MK_G1T & 4)) norm_rope_store<64>(acc, pm, wr, wc, fr, fq, wid, wBqr, tc64, ts64, rope, one, QB, 1536, ((t - 10) * 4 + wc) * 192 + 128, 1, 0, xch);
        else if (t < 14 && (MK_G1T & 8)) {
            plain<0>(acc, pm, wr, wc, fr, fq, CKV, 512, (t - 12) * 256);
#pragma unroll
            for (int ai = 0; ai < 2; ++ai)
#pragma unroll
                for (int m = 0; m < 4; ++m) {
                    float s = 0.f;
#pragma unroll
                    for (int bj = 0; bj < 2; ++bj)
#pragma unroll
                        for (int n = 0; n < 2; ++n)
#pragma unroll
                            for (int j = 0; j < 4; ++j) { const float v = acc[ai][bj][m][n][j]; s += v * v; }
                    s += __shfl_xor(s, 16); s += __shfl_xor(s, 32);
                    if (fq == 0) SS[((size_t)pm * 256 + ai * 128 + wr * 64 + m * 16 + fr) * 8 + (t - 12) * 4 + wc] = s;
                }
        }
        else if (t == 14 && (MK_G1T & 16)) { if (wc == 0) norm_rope_store<64>(acc, pm, wr, wc, fr, fq, wid, wBkr, tc64, ts64, rope, one, KB, 1536, 128, 8, 192, xch); }
        else if (t < 19 && (MK_G1T & 4)) norm_rope_store<64>(acc, pm, wr, wc, fr, fq, wid, wCq, tc64, ts64, rope, one, QC, 1024, ((t - 15) * 4 + wc) * 64, 1, 0, xch);
        else if (t < 23 && (MK_G1T & 4)) norm_rope_store<64>(acc, pm, wr, wc, fr, fq, wid, wCk, tc64, ts64, rope, one, KC, 1024, ((t - 19) * 4 + wc) * 64, 1, 0, xch);
        else if (t < 27 && (MK_G1T & 2)) plain<0>(acc, pm, wr, wc, fr, fq, VC, 1024, (t - 23) * 256);
        else if (t < 39 && (MK_G1T & 32)) plain<1>(acc, pm, wr, wc, fr, fq, GATE, 3072, (t - 27) * 256);
        else if (MK_G1T & 64) plain<2>(acc, pm, wr, wc, fr, fq, MRG, 6144, (t - 39) * 256);
    }
};

struct EpiUp {
    static constexpr bool MID = false;
    bf16_t *KB, *VB; const float* SS; const float* wBkn; LAS float* xch;
    __device__ __forceinline__ void operator()(const f32x4 (&acc)[2][2][4][2], const Unit& u, int wr, int wc, int fr, int fq, int wid) const {
        const int t = u.pn, pm = u.pm;
        float pre[2][4];
#pragma unroll
        for (int ai = 0; ai < 2; ++ai)
#pragma unroll
            for (int m = 0; m < 4; ++m) {
                const size_t row = (size_t)pm * 256 + ai * 128 + wr * 64 + m * 16 + fr;
                const f32x4 a = *(const f32x4*)(SS + row * 8), b = *(const f32x4*)(SS + row * 8 + 4);
                pre[ai][m] = rsqrtf(((a[0] + a[1]) + (a[2] + a[3]) + (b[0] + b[1]) + (b[2] + b[3])) * (1.f / 512.f) + EPS);
                __builtin_amdgcn_sched_barrier(0);
            }
        if (t < 4) norm_rope_store<128>(acc, pm, wr, wc, fr, fq, wid, wBkn, nullptr, nullptr, false, pre, KB, 1536, (t * 2 + (wc >> 1)) * 192, 1, 0, xch);
        else {
            const int colw = (t - 4) * 256 + 32 * wc + 8 * fq;
#pragma unroll
            for (int ai = 0; ai < 2; ++ai)
#pragma unroll
                for (int m = 0; m < 4; ++m) {
                    const size_t row = (size_t)pm * 256 + ai * 128 + wr * 64 + m * 16 + fr;
#pragma unroll
                    for (int bj = 0; bj < 2; ++bj) store8(VB + row * 1024 + colw + bj * 128, acc[ai][bj][m][0] * pre[ai][m], acc[ai][bj][m][1] * pre[ai][m]);
                    __builtin_amdgcn_sched_barrier(0);
                }
        }
    }
};

struct EpiBr {
    static constexpr bool MID = true;
    const bf16_t* MRG; bf16_t* Y;
    __device__ __forceinline__ void mid(f32x4 (&acc)[2][2][4][2], const Unit& u, int i, int wr, int wc, int fr, int fq) const {
#pragma unroll
        for (int ai = 0; ai < 2; ++ai)
#pragma unroll
            for (int m = 0; m < 4; ++m) {
                const size_t row = (size_t)u.pm * 256 + ai * 128 + wr * 64 + m * 16 + fr;
#pragma unroll
                for (int bj = 0; bj < 2; ++bj) {
                    const int col = u.pn * 256 + bj * 128 + 32 * wc + 8 * fq;
                    const u32x4 a = *(const u32x4*)(MRG + row * 6144 + (i - 1) * 2048 + col), b = *(const u32x4*)(MRG + row * 6144 + i * 2048 + col);
#pragma unroll
                    for (int q = 0; q < 4; ++q) {
                        const float r0 = bf2f(a[q] & 0xffffu) * __builtin_amdgcn_rcpf(bf2f(b[q] & 0xffffu)), r1 = bf2f(a[q] >> 16) * __builtin_amdgcn_rcpf(bf2f(b[q] >> 16));
                        acc[ai][bj][m][q >> 1][(q & 1) * 2] *= r0; acc[ai][bj][m][q >> 1][(q & 1) * 2 + 1] *= r1;
                    }
                }
                __builtin_amdgcn_sched_barrier(0);
            }
    }
    __device__ __forceinline__ void operator()(const f32x4 (&acc)[2][2][4][2], const Unit& u, int wr, int wc, int fr, int fq, int wid) const {
#pragma unroll
        for (int ai = 0; ai < 2; ++ai)
#pragma unroll
            for (int m = 0; m < 4; ++m) {
                const size_t row = (size_t)u.pm * 256 + ai * 128 + wr * 64 + m * 16 + fr;
#pragma unroll
                for (int bj = 0; bj < 2; ++bj) {
                    const int col = u.pn * 256 + bj * 128 + 32 * wc + 8 * fq;
                    const u32x4 a = *(const u32x4*)(MRG + row * 6144 + 4096 + col);
                    f32x4 v0 = acc[ai][bj][m][0], v1 = acc[ai][bj][m][1];
                    v0[0] *= bf2f(a[0] & 0xffffu); v0[1] *= bf2f(a[0] >> 16); v0[2] *= bf2f(a[1] & 0xffffu); v0[3] *= bf2f(a[1] >> 16);
                    v1[0] *= bf2f(a[2] & 0xffffu); v1[1] *= bf2f(a[2] >> 16); v1[2] *= bf2f(a[3] & 0xffffu); v1[3] *= bf2f(a[3] >> 16);
                    store8(Y + row * 2048 + col, v0, v1);
                }
                __builtin_amdgcn_sched_barrier(0);
            }
    }
};

struct EpiOut {
    static constexpr bool MID = false;
    const float *xsrc, *csrc; float *xdst, *cdst; const float* mod;
    __device__ __forceinline__ void operator()(const f32x4 (&acc)[2][2][4][2], const Unit& u, int wr, int wc, int fr, int fq, int wid) const {
        const int pm = u.pm; const bool lat = pm < 64;
        const int mi = lat ? (pm >> 4) : 4;
        const float* src = lat ? xsrc : csrc - (size_t)MLAT * DM; float* dst = lat ? xdst : cdst - (size_t)MLAT * DM;
        const float* g = mod + mi * 6144 + 4096;
#pragma unroll
        for (int bj = 0; bj < 2; ++bj) {
            const int col = u.pn * 256 + bj * 128 + 32 * wc + 8 * fq;
            const f32x4 g0 = *(const f32x4*)(g + col), g1 = *(const f32x4*)(g + col + 4);
#pragma unroll
            for (int ai = 0; ai < 2; ++ai)
#pragma unroll
                for (int m = 0; m < 4; ++m) {
                    const size_t row = (size_t)pm * 256 + ai * 128 + wr * 64 + m * 16 + fr;
                    const f32x4 x0 = *(const f32x4*)(src + row * DM + col), x1 = *(const f32x4*)(src + row * DM + col + 4);
                    *(f32x4*)(dst + row * DM + col) = x0 + g0 * acc[ai][bj][m][0];
                    *(f32x4*)(dst + row * DM + col + 4) = x1 + g1 * acc[ai][bj][m][1];
                    __builtin_amdgcn_sched_barrier(0);
                }
        }
    }
};

namespace att {
#define SBAR() __builtin_amdgcn_sched_barrier(0)
__device__ __forceinline__ int crow(int r, int hi) { return (r & 3) + 8 * (r >> 2) + 4 * hi; }
template <int RB> __device__ __forceinline__ int kswz(int row, int colB) { const int x = (RB == 256) ? (row & 7) : ((row >> 1) & 7); return row * RB + (colB ^ (x << 4)); }
__device__ __forceinline__ int v_st(int k, int c) { const int kk = (k & ~0xC) | ((k & 4) << 1) | ((k & 8) >> 1); return ((kk >> 3) * 4 + (c >> 5)) * 512 + ((kk & 7) * 32 + (c & 31)) * 2; }
__device__ __forceinline__ int v_rd_base(int lane) { return ((lane & 3) << 3) | (((lane >> 2) & 3) << 6) | (((lane >> 4) & 1) << 5) | (((lane >> 5) & 1) << 8); }
constexpr int v_rd_off(int d0, int ks, int half) { return d0 * 512 + ks * 4096 + half * 2048; }
template <int OFF> __device__ __forceinline__ s16x4 tr_read(unsigned vb) {
    s16x4 r; asm volatile("ds_read_b64_tr_b16 %0, %1 offset:%2" : "=&v"(r) : "v"(vb), "i"(OFF) : "memory"); return r;
}
template <int D0> __device__ __forceinline__ void pv_one(f32x16& od, unsigned vb, bf16x8 pa0, bf16x8 pa1, bf16x8 pa2, bf16x8 pa3) {
    const s16x4 l0 = tr_read<v_rd_off(D0, 0, 0)>(vb), h0 = tr_read<v_rd_off(D0, 0, 1)>(vb), l1 = tr_read<v_rd_off(D0, 1, 0)>(vb), h1 = tr_read<v_rd_off(D0, 1, 1)>(vb);
    const s16x4 l2 = tr_read<v_rd_off(D0, 2, 0)>(vb), h2 = tr_read<v_rd_off(D0, 2, 1)>(vb), l3 = tr_read<v_rd_off(D0, 3, 0)>(vb), h3 = tr_read<v_rd_off(D0, 3, 1)>(vb);
    asm volatile("s_waitcnt lgkmcnt(0)" ::: "memory"); SBAR();
#define PK(L, H) (bf16x8){L[0], L[1], L[2], L[3], H[0], H[1], H[2], H[3]}
    od = __builtin_amdgcn_mfma_f32_32x32x16_bf16(pa0, PK(l0, h0), od, 0, 0, 0);
    od = __builtin_amdgcn_mfma_f32_32x32x16_bf16(pa1, PK(l1, h1), od, 0, 0, 0);
    od = __builtin_amdgcn_mfma_f32_32x32x16_bf16(pa2, PK(l2, h2), od, 0, 0, 0);
    od = __builtin_amdgcn_mfma_f32_32x32x16_bf16(pa3, PK(l3, h3), od, 0, 0, 0);
#undef PK
}
__device__ __forceinline__ void pv_d0(f32x16 (&o)[4], unsigned vb, bf16x8 pa0, bf16x8 pa1, bf16x8 pa2, bf16x8 pa3) {
    pv_one<0>(o[0], vb, pa0, pa1, pa2, pa3); pv_one<1>(o[1], vb, pa0, pa1, pa2, pa3); pv_one<2>(o[2], vb, pa0, pa1, pa2, pa3); pv_one<3>(o[3], vb, pa0, pa1, pa2, pa3);
}
__device__ __forceinline__ void partialSM(f32x16& p0, f32x16& p1, float C, float nMB) {
#pragma unroll
    for (int r = 0; r < 16; ++r) p0[r] = fmaf(p0[r], C, nMB);
#pragma unroll
    for (int r = 0; r < 16; ++r) p1[r] = fmaf(p1[r], C, nMB);
#pragma unroll
    for (int r = 0; r < 16; ++r) p0[r] = __builtin_amdgcn_exp2f(p0[r]);
}
__device__ __forceinline__ void finishSM(f32x16& p0, f32x16& p1, float& l_reg, bf16x8& pa0, bf16x8& pa1, bf16x8& pa2, bf16x8& pa3) {
#pragma unroll
    for (int r = 0; r < 16; ++r) p1[r] = __builtin_amdgcn_exp2f(p1[r]);
    float ps = 0;
#pragma unroll
    for (int r = 0; r < 16; ++r) ps += p0[r];
#pragma unroll
    for (int r = 0; r < 16; ++r) ps += p1[r];
    { auto rr = __builtin_amdgcn_permlane32_swap(__float_as_uint(ps), __float_as_uint(ps), false, false);
      ps = __uint_as_float(rr[0]) + __uint_as_float(rr[1]); }
    l_reg += ps;
#define PK4(P, BASE, OUT) do { unsigned a0 = cvt_pk_bf16(P[BASE + 0], P[BASE + 1]), a1 = cvt_pk_bf16(P[BASE + 2], P[BASE + 3]);   \
    unsigned b0 = cvt_pk_bf16(P[BASE + 4], P[BASE + 5]), b1 = cvt_pk_bf16(P[BASE + 6], P[BASE + 7]);                              \
    auto r0 = __builtin_amdgcn_permlane32_swap(a0, b0, false, false); auto r1 = __builtin_amdgcn_permlane32_swap(a1, b1, false, false); \
    u32x4 w = {r0[0], r1[0], r0[1], r1[1]}; OUT = *reinterpret_cast<bf16x8*>(&w); } while (0)
    PK4(p0, 0, pa0); PK4(p0, 8, pa1); PK4(p1, 0, pa2); PK4(p1, 8, pa3);
#undef PK4
}
template <int DQK>
__device__ __forceinline__ void qkt(f32x16& p0, f32x16& p1, const LAS char* Ks, const bf16x8 (&qr)[DQK / 16], int r32, int hi) {
    constexpr int RB = DQK * 2;
    p0 = f32x16{}; p1 = f32x16{};
#pragma unroll
    for (int d0 = 0; d0 < DQK / 16; ++d0) { const int cb = (d0 * 16 + hi * 8) * 2;
        const bf16x8 b0 = *(const LAS bf16x8*)(Ks + kswz<RB>(r32, cb));
        const bf16x8 b1 = *(const LAS bf16x8*)(Ks + kswz<RB>(32 + r32, cb));
        p0 = __builtin_amdgcn_mfma_f32_32x32x16_bf16(b0, qr[d0], p0, 0, 0, 0);
        p1 = __builtin_amdgcn_mfma_f32_32x32x16_bf16(b1, qr[d0], p1, 0, 0, 0);
        if (QKT_GRP > 0 && (d0 % QKT_GRP) == QKT_GRP - 1 && d0 + 1 < DQK / 16) SBAR(); }
}
constexpr int V_BYTES = 64 * 128 * 2, K_OFF = 3 * V_BYTES, K_STRIDE = 64 * 192 * 2, LI_OFF = K_OFF + 3 * K_STRIDE;

template <int DQK, bool DOUBLE>
__device__ __forceinline__ void attn_pass(const bf16_t* __restrict__ Q, int ldq, const bf16_t* __restrict__ Kg, int ldk, const bf16_t* __restrict__ Vg, int ldv,
                                          int rowc, int rowl, int NT, float C, float nMB, f32x16 (&o)[4], float& l_reg, LAS char* lds, int tid) {
    constexpr int RB = DQK * 2, NCH = DQK / 8, NLD = NCH / 8;
    const int wid = __builtin_amdgcn_readfirstlane(tid >> 6), lane = tid & 63, r32 = lane & 31, hi = lane >> 5;
    LAS char* V_lds = lds; LAS char* K_lds = lds + K_OFF;
    bf16x8 qr[DQK / 16];
    { const bf16_t* Qw = Q + (size_t)(wid * 32 + r32) * ldq + hi * 8;
#pragma unroll
      for (int d0 = 0; d0 < DQK / 16; ++d0) qr[d0] = *(const bf16x8*)(Qw + d0 * 16); }
#pragma unroll
    for (int d = 0; d < 4; ++d) o[d] = f32x16{};
    l_reg = 0.f;
    int vrow[2], vcol[2], krow[NLD], kcol[NLD];
#pragma unroll
    for (int i = 0; i < 2; ++i) { const int q = tid + 512 * i, sub = q >> 5, within = q & 31, kk = (sub >> 2) * 8 + (within >> 2);
        vrow[i] = (kk & ~0xC) | ((kk & 4) << 1) | ((kk & 8) >> 1); vcol[i] = (sub & 3) * 32 + (within & 3) * 8; }
#pragma unroll
    for (int i = 0; i < NLD; ++i) { const int q = tid + 512 * i, row = q / NCH, chp = q % NCH; const int x = (RB == 256) ? (row & 7) : ((row >> 1) & 7);
        krow[i] = row; kcol[i] = (chp ^ x) * 8; }
    const unsigned vb0 = (unsigned)(uintptr_t)V_lds + v_rd_base(lane);
#define KROW0(j) ((j) < 4 ? rowc + 64 * (j) : rowl + 64 * ((j) - 4))
#define DMA(j, b) do { const size_t _r0 = (size_t)KROW0(j); \
    _Pragma("unroll") for (int _i = 0; _i < 2; ++_i) __builtin_amdgcn_global_load_lds((const unsigned*)(Vg + (_r0 + vrow[_i]) * ldv + vcol[_i]), (LAS unsigned*)(V_lds + (b) * V_BYTES + wid * 1024 + _i * 8192), 16, 0, 0); \
    _Pragma("unroll") for (int _i = 0; _i < NLD; ++_i) __builtin_amdgcn_global_load_lds((const unsigned*)(Kg + (_r0 + krow[_i]) * ldk + kcol[_i]), (LAS unsigned*)(K_lds + (b) * K_STRIDE + wid * 1024 + _i * 8192), 16, 0, 0); } while (0)
#define VMW0() asm volatile("s_waitcnt vmcnt(0)" ::: "memory")
    bf16x8 pa0, pa1, pa2, pa3;
    __syncthreads();
    DMA(0, 0); DMA(1, 1); VMW0(); __syncthreads();
    if constexpr (!DOUBLE) {
        f32x16 p0, p1;
        DMA(2, 2);
        int bc = 0, bn = 1, bf = 2;
        for (int j = 0; j < NT; ++j) {
            SBAR(); qkt<DQK>(p0, p1, K_lds + bc * K_STRIDE, qr, r32, hi);
            partialSM(p0, p1, C, nMB); finishSM(p0, p1, l_reg, pa0, pa1, pa2, pa3); SBAR();
            pv_d0(o, vb0 + bc * V_BYTES, pa0, pa1, pa2, pa3);
            if (j + 1 < NT) { VMW0(); __syncthreads(); if (j + 3 < NT) DMA(j + 3, bc); }
            { const int _t = bc; bc = bn; bn = bf; bf = _t; }
        }
    } else {
    f32x16 pA0, pA1, pB0, pB1;
    qkt<DQK>(pA0, pA1, K_lds, qr, r32, hi); partialSM(pA0, pA1, C, nMB);
    DMA(2, 2);
    int bp = 0, bc = 1, bn = 2;
#define STEP(j, PC0, PC1, PP0, PP1) do { \
        SBAR(); qkt<DQK>(PC0, PC1, K_lds + bc * K_STRIDE, qr, r32, hi); \
        finishSM(PP0, PP1, l_reg, pa0, pa1, pa2, pa3); SBAR(); \
        pv_d0(o, vb0 + bp * V_BYTES, pa0, pa1, pa2, pa3); partialSM(PC0, PC1, C, nMB); \
        if ((j) + 1 < NT) { VMW0(); __syncthreads(); if ((j) + 2 < NT) DMA((j) + 2, bp); } \
        { const int _t = bp; bp = bc; bc = bn; bn = _t; } } while (0)
    for (int j = 1; j < NT; j += 2) {
        STEP(j, pB0, pB1, pA0, pA1);
        if (j + 1 < NT) STEP(j + 1, pA0, pA1, pB0, pB1);
    }
    finishSM(pB0, pB1, l_reg, pa0, pa1, pa2, pa3); SBAR();
    pv_d0(o, vb0 + bp * V_BYTES, pa0, pa1, pa2, pa3);
    }
#undef KROW0
#undef DMA
#undef VMW0
#undef STEP
}
__device__ __forceinline__ void row_recip(float l_reg, float (&rli)[16], LAS float* li, int r32, int hi) {
    if (hi == 0) li[r32] = l_reg;
    asm volatile("s_waitcnt lgkmcnt(0)" ::: "memory");
#pragma unroll
    for (int r = 0; r < 16; ++r) rli[r] = __builtin_amdgcn_rcpf(li[crow(r, hi)]);
    asm volatile("s_waitcnt lgkmcnt(0)" ::: "memory");
}
}

struct AttnBufs { const bf16_t *QA, *KA, *VA, *QB, *KB, *VB, *QC, *KC, *VC, *GATE; bf16_t* BR; float* SCR; const float* lamv; const float* subln; float lam_init; };

template <bool SUBLN>
__device__ __forceinline__ void attn_out(const AttnBufs& T, f32x16 (&o)[4], int type, int h, size_t orow0, LAS char* lds, int wid, int lane, int r32, int hi) {
    __syncthreads();
    LAS float* stg = (LAS float*)(lds + wid * 16896);
#pragma unroll
    for (int d0 = 0; d0 < 4; ++d0)
#pragma unroll
        for (int r = 0; r < 16; ++r) stg[att::crow(r, hi) * 132 + d0 * 32 + r32] = o[d0][r];
    asm volatile("s_waitcnt lgkmcnt(0)" ::: "memory");
    const int rr = lane >> 5, c4 = (lane & 31) * 4;
    const int col = type * 1024 + h * 128 + c4;
    f32x4 wsub = {1.f, 1.f, 1.f, 1.f};
    if (SUBLN) { wsub = *(const f32x4*)(T.subln + c4) * (1.f - T.lam_init); }
    const bf16_t* gp = T.GATE + (orow0 + rr) * 3072 + col; bf16_t* op = T.BR + (orow0 + rr) * 3072 + col;
#pragma unroll 4
    for (int i = 0; i < 16; ++i) {
        f32x4 v = *(const LAS f32x4*)(stg + (2 * i + rr) * 132 + c4);
        const u32x2 gg = *(const u32x2*)(gp + (size_t)i * 2 * 3072);
        if (SUBLN) {
            float s = (v[0] * v[0] + v[1] * v[1]) + (v[2] * v[2] + v[3] * v[3]);
            s += __shfl_xor(s, 1); s += __shfl_xor(s, 2); s += __shfl_xor(s, 4); s += __shfl_xor(s, 8); s += __shfl_xor(s, 16);
            v = v * (rsqrtf(s * (1.f / 128.f) + EPS)) * wsub;
        }
        u32x2 w; w.x = cvt_pk_bf16(v[0] * bf2f(gg.x & 0xffffu), v[1] * bf2f(gg.x >> 16)); w.y = cvt_pk_bf16(v[2] * bf2f(gg.y & 0xffffu), v[3] * bf2f(gg.y >> 16));
        *(u32x2*)(op + (size_t)i * 2 * 3072) = w;
    }
}

__device__ __forceinline__ void attn_item(const AttnBufs& T, int type, int b, int h, int qrow0, int NT, LAS char* lds, int tid_) {
    asm volatile("" : "+v"(tid_));
    const int tid = tid_, wid = __builtin_amdgcn_readfirstlane(tid >> 6), lane = tid & 63, r32 = lane & 31, hi = lane >> 5;
    const int rowc = MLAT + b * CTXL, rowl = b * SEQ;
    LAS float* li = (LAS float*)(lds + att::LI_OFF) + wid * 64;
    constexpr float LOG2E = 1.4426950408889634f;
    const size_t orow0 = (size_t)qrow0 + wid * 32;
    if (type == 0 && (MK_ATYPE & 1)) {
        f32x16 o[4]; float l_reg; float rli[16];
        att::attn_pass<128, ATT_DBL>(T.QA + (size_t)qrow0 * 1024 + h * 128, 1024, T.KA + (h >> 2) * 128, 256, T.VA + (h >> 2) * 128, 256, rowc, rowl, NT,
                            0.08838834764831845f * LOG2E, T.lamv[1], o, l_reg, lds, tid);
        att::row_recip(l_reg, rli, li, r32, hi);
#pragma unroll
        for (int d0 = 0; d0 < 4; ++d0)
#pragma unroll
            for (int r = 0; r < 16; ++r) o[d0][r] *= rli[r];
        attn_out<false>(T, o, 0, h, orow0, lds, wid, lane, r32, hi);
    } else if (type == 1 && (MK_ATYPE & 2)) {
        f32x16 o[4]; float l_reg; float rli[16];
        att::attn_pass<192, false>(T.QB + (size_t)qrow0 * 1536 + h * 192, 1536, T.KB + h * 192, 1536, T.VB + h * 128, 1024, rowc, rowl, NT,
                            0.07216878364870323f * LOG2E, T.lamv[2], o, l_reg, lds, tid);
        att::row_recip(l_reg, rli, li, r32, hi);
#pragma unroll
        for (int d0 = 0; d0 < 4; ++d0)
#pragma unroll
            for (int r = 0; r < 16; ++r) o[d0][r] *= rli[r];
        attn_out<false>(T, o, 1, h, orow0, lds, wid, lane, r32, hi);
    } else if (MK_ATYPE & 4) {
        f32x16 o[4]; float l_reg; float rli[16];
        att::attn_pass<64, ATT_DBL>(T.QC + (size_t)qrow0 * 1024 + h * 128, 1024, T.KC + h * 128, 1024, T.VC + h * 128, 1024, rowc, rowl, NT,
                           0.125f * LOG2E, T.lamv[3], o, l_reg, lds, tid);
        att::row_recip(l_reg, rli, li, r32, hi);
        f32x4* scr = (f32x4*)(T.SCR + ((size_t)blockIdx.x * 512 + tid) * 64);
#pragma unroll
        for (int d0 = 0; d0 < 4; ++d0)
#pragma unroll
            for (int q = 0; q < 4; ++q) scr[d0 * 4 + q] = (f32x4){o[d0][q * 4] * rli[q * 4], o[d0][q * 4 + 1] * rli[q * 4 + 1], o[d0][q * 4 + 2] * rli[q * 4 + 2], o[d0][q * 4 + 3] * rli[q * 4 + 3]};
        att::attn_pass<64, ATT_DBL>(T.QC + (size_t)qrow0 * 1024 + h * 128 + 64, 1024, T.KC + h * 128 + 64, 1024, T.VC + h * 128, 1024, rowc, rowl, NT,
                           0.125f * LOG2E, T.lamv[3], o, l_reg, lds, tid);
        att::row_recip(l_reg, rli, li, r32, hi);
        const float lam = T.lamv[0];
#pragma unroll
        for (int d0 = 0; d0 < 4; ++d0)
#pragma unroll
            for (int q = 0; q < 4; ++q) { const f32x4 a = scr[d0 * 4 + q];
#pragma unroll
                for (int j = 0; j < 4; ++j) o[d0][q * 4 + j] = a[j] - lam * (o[d0][q * 4 + j] * rli[q * 4 + j]); }
        attn_out<true>(T, o, 2, h, orow0, lds, wid, lane, r32, hi);
    }
}

__device__ __forceinline__ void transpose_item(const float* __restrict__ W, int ldw, int k0, int srccol, const float* __restrict__ kscale,
                                               bf16_t* __restrict__ WT, int ldt, int n0, int kdst0, LAS float* scr, int lane) {
#pragma unroll 8
    for (int i = 0; i < 32; ++i) { const int kk = 2 * i + (lane >> 5);
        float v = srccol >= 0 ? W[(size_t)(k0 + kk) * ldw + srccol] : 0.f;
        if (kscale) v *= kscale[k0 + kk];
        scr[kk * 33 + (lane & 31)] = v; }
    asm volatile("s_waitcnt lgkmcnt(0)" ::: "memory");
    const int c = lane & 7;
#pragma unroll
    for (int j = 0; j < 4; ++j) { const int n = (lane >> 3) + 8 * j; const LAS float* s = scr + (8 * c) * 33 + n;
        u32x4 o; o.x = cvt_pk_bf16(s[0 * 33], s[1 * 33]); o.y = cvt_pk_bf16(s[2 * 33], s[3 * 33]); o.z = cvt_pk_bf16(s[4 * 33], s[5 * 33]); o.w = cvt_pk_bf16(s[6 * 33], s[7 * 33]);
        *(u32x4*)(WT + (size_t)(n0 + n) * ldt + kdst0 + k0 + 8 * c) = o; }
    asm volatile("s_waitcnt lgkmcnt(0)" ::: "memory");
}
__device__ const float INVF32[16] = {1.000000000e+00f, 5.623413324e-01f, 3.162277639e-01f, 1.778279394e-01f, 1.000000015e-01f, 5.623413250e-02f, 3.162277490e-02f, 1.778279431e-02f,
    9.999999776e-03f, 5.623413250e-03f, 3.162277630e-03f, 1.778279431e-03f, 1.000000047e-03f, 5.623413017e-04f, 3.162277571e-04f, 1.778279402e-04f};
__device__ const float INVF64[32] = {1.000000000e+00f, 7.498942614e-01f, 5.623413324e-01f, 4.216965139e-01f, 3.162277639e-01f, 2.371373773e-01f, 1.778279394e-01f, 1.333521307e-01f,
    1.000000015e-01f, 7.498941571e-02f, 5.623413250e-02f, 4.216965288e-02f, 3.162277490e-02f, 2.371373773e-02f, 1.778279431e-02f, 1.333521493e-02f, 9.999999776e-03f, 7.498941850e-03f,
    5.623413250e-03f, 4.216964822e-03f, 3.162277630e-03f, 2.371373586e-03f, 1.778279431e-03f, 1.333521446e-03f, 1.000000047e-03f, 7.498942432e-04f, 5.623413017e-04f, 4.216965172e-04f,
    3.162277571e-04f, 2.371373703e-04f, 1.778279402e-04f, 1.333521504e-04f};
__device__ __forceinline__ void sincos_d(double x, float& s, float& c) {
    const double twopi = 6.283185307179586476925;
    const double k = __builtin_rint(x / twopi), r = x - k * twopi, r2 = r * r;
    double st = r, ct = 1.0, ss = r, cs = 1.0;
    for (int n = 1; n <= 16; ++n) { ct *= -r2 / (double)((2 * n - 1) * (2 * n)); st *= -r2 / (double)((2 * n) * (2 * n + 1)); cs += ct; ss += st; }
    s = (float)ss; c = (float)cs;
}
__device__ __forceinline__ float absmax_n(const float* w, int n) { float m = 0.f; for (int i = 0; i < n; ++i) m = fmaxf(m, fabsf(w[i])); return m; }

typedef unsigned v4u_unused_t;
#define XB_TMO      128
#define XB_XCNT(j)  (256  + 64 * (j))
#define XB_XSUB(j)  (1280 + 64 * (j))
#define XB_XGEN(j)  (2304 + 64 * (j))
#define XB_TOP      3328
#define XB_TOPGEN   3392
#define XCD_BAR_WORDS 3456
#define XB_SPIN_CAP (1u << 18)

__device__ __forceinline__ unsigned xb_ld(unsigned* p)              { return __hip_atomic_load(p, __ATOMIC_RELAXED, __HIP_MEMORY_SCOPE_AGENT); }
__device__ __forceinline__ unsigned xb_add(unsigned* p, unsigned v) { return __hip_atomic_fetch_add(p, v, __ATOMIC_RELAXED, __HIP_MEMORY_SCOPE_AGENT); }
__device__ __forceinline__ unsigned xb_xcc_id() { return (unsigned)__builtin_amdgcn_s_getreg((3 << 11) | 20) & 0xFu; }
#define XB_SPIN(cond, bar) do { unsigned _sp = 0; while (cond) { __builtin_amdgcn_s_sleep(1); \
    if ((++_sp & 255u) == 0u) { if (xb_ld(&(bar)[XB_TMO])) break; if (_sp > XB_SPIN_CAP) { atomicAdd(&(bar)[XB_TMO], 1u); break; } } } } while (0)

struct XcdBarrier {
    unsigned* bar; unsigned x;
    volatile LAS unsigned* st;
};

__device__ __forceinline__ XcdBarrier xcd_barrier_post(unsigned* bar, volatile LAS unsigned* st) {
    XcdBarrier b; b.bar = bar; b.x = xb_xcc_id(); b.st = st;
    if (threadIdx.x == 0) (void)xb_add(&bar[XB_XCNT(b.x)], 1u);
    return b;
}
__device__ __forceinline__ void xcd_barrier_complete(unsigned* bar, unsigned x, unsigned& nloc, unsigned& nx) {
    const unsigned G = gridDim.x * gridDim.y * gridDim.z;
    unsigned sum, cnt, mine, sp = 0u;
    for (;;) {
        sum = 0u; cnt = 0u; mine = 0u;
#pragma unroll
        for (unsigned j = 0; j < 16; ++j) { const unsigned c = xb_ld(&bar[XB_XCNT(j)]); sum += c; cnt += (c > 0u) ? 1u : 0u; mine = (j == x) ? c : mine; }
        if (sum == G) break;
        __builtin_amdgcn_s_sleep(1);
        if ((++sp & 255u) == 0u) { if (xb_ld(&bar[XB_TMO])) break; if (sp > XB_SPIN_CAP) { atomicAdd(&bar[XB_TMO], 1u); break; } }
    }
    nloc = mine > 0u ? mine : 1u; nx = cnt > 0u ? cnt : 1u;
}

__device__ __forceinline__ void xcd_barrier(const XcdBarrier& b) {
    asm volatile("s_waitcnt vmcnt(0)" ::: "memory");
    __syncthreads();
    if (threadIdx.x == 0) {
        unsigned* bar = b.bar;
        __builtin_amdgcn_s_waitcnt(0);
        unsigned nloc = b.st[0], nx = b.st[1];
        if (nloc == 0u) { xcd_barrier_complete(bar, b.x, nloc, nx); b.st[0] = nloc; b.st[1] = nx; }
        const unsigned old = xb_add(&bar[XB_XSUB(b.x)], 1u);
        const unsigned gen = old / nloc;
        if (old + 1u == (gen + 1u) * nloc) {
            __builtin_amdgcn_fence(__ATOMIC_RELEASE, "agent");
            asm volatile("s_waitcnt vmcnt(0)" ::: "memory");
            const unsigned og = xb_add(&bar[XB_TOP], 1u);
            const unsigned tg = og / nx;
            if (og + 1u == (tg + 1u) * nx) xb_add(&bar[XB_TOPGEN], 1u);
            else XB_SPIN(xb_ld(&bar[XB_TOPGEN]) == tg, bar);
            __builtin_amdgcn_fence(__ATOMIC_ACQUIRE, "agent");
            xb_add(&bar[XB_XGEN(b.x)], 1u);
            asm volatile("s_waitcnt vmcnt(0)" ::: "memory");
        } else {
            XB_SPIN(xb_ld(&bar[XB_XGEN(b.x)]) == gen, bar);
            __builtin_amdgcn_fence(__ATOMIC_ACQUIRE, "agent");
            asm volatile("s_waitcnt vmcnt(0)" ::: "memory");
        }
    }
    __syncthreads();
}

struct Args { const float* in[29]; float* out; unsigned char* ws; int ph_lo, ph_hi, coop, pad; };

__global__ void __launch_bounds__(512, 2) mega_fwd(Args args) {
    extern __shared__ __attribute__((aligned(16))) unsigned char lds_raw[];
    LAS unsigned char* lds = (LAS unsigned char*)lds_raw;
    const int G = gridDim.x, bx = blockIdx.x;
    const int vcu = (G % 8 == 0) ? (bx % 8) * (G / 8) + bx / 8 : bx;
    unsigned char* ws = args.ws;
    float* MOD = (float*)(ws + WS_MOD);
    float* TC64 = (float*)(ws + WS_TC64); float* TS64 = (float*)(ws + WS_TS64); float* TC128 = (float*)(ws + WS_TC128); float* TS128 = (float*)(ws + WS_TS128);
    float* LAM = (float*)(ws + WS_LAM);
    bf16_t* WIN = (bf16_t*)(ws + WS_WIN); bf16_t* WUP = (bf16_t*)(ws + WS_WUP); bf16_t* WBR = (bf16_t*)(ws + WS_WBR); bf16_t* WOUT = (bf16_t*)(ws + WS_WOUT);
    bf16_t* H = (bf16_t*)(ws + WS_H); bf16_t* QA = (bf16_t*)(ws + WS_QA); bf16_t* KA = (bf16_t*)(ws + WS_KA); bf16_t* VA = (bf16_t*)(ws + WS_VA);
    bf16_t* QB = (bf16_t*)(ws + WS_QB); bf16_t* KB = (bf16_t*)(ws + WS_KB); bf16_t* CKV = (bf16_t*)(ws + WS_CKV); bf16_t* VB = (bf16_t*)(ws + WS_VB);
    bf16_t* QC = (bf16_t*)(ws + WS_QC); bf16_t* KC = (bf16_t*)(ws + WS_KC); bf16_t* VC = (bf16_t*)(ws + WS_VC);
    bf16_t* GATE = (bf16_t*)(ws + WS_GATE); bf16_t* MRG = (bf16_t*)(ws + WS_MRG); bf16_t* BR = (bf16_t*)(ws + WS_BR); bf16_t* Y = (bf16_t*)(ws + WS_Y);
    float* SS = (float*)(ws + WS_SS); float* CTXW = (float*)(ws + WS_CTXW); float* SCR = (float*)(ws + WS_SCR);
    LAS float* xch = (LAS float*)(lds + XCH_OFF);
    volatile LAS unsigned* bst = (volatile LAS unsigned*)(lds + XCH_OFF + 4096);
    if (threadIdx.x < 2) bst[threadIdx.x] = 0u;
    __syncthreads();
    XcdBarrier bar = xcd_barrier_post((unsigned*)(ws + WS_BAR), bst);

    for (int ph = args.ph_lo; ph < args.ph_hi; ++ph) {
        int tid = threadIdx.x; asm volatile("" : "+v"(tid));
        const int lane = tid & 63, wave = __builtin_amdgcn_readfirstlane(tid >> 6);
        if (ph == 0 && (MK_MASK & 1)) {
            {
                LAS float* sc = (LAS float*)lds;
                LAS float* red = (LAS float*)(lds + 65536);
                for (int i = tid; i < 5 * DM; i += 512) { const float v = i < 4 * DM ? args.in[1][i] : args.in[3][i - 4 * DM]; sc[i] = silu_f(v); }
                __syncthreads();
                for (int it = bx; it < DEPTH * 96; it += G) {
                    const int l = it / 96, n0 = (it % 96) * 64;
                    const float* W = args.in[5] + (size_t)l * DM * 6144 + n0 + lane;
                    float a0 = 0.f, a1 = 0.f, a2 = 0.f, a3 = 0.f, a4 = 0.f;
                    const int kb = wave * 256;
#pragma unroll 8
                    for (int k = 0; k < 256; ++k) { const float wv = W[(size_t)(kb + k) * 6144];
                        a0 += sc[kb + k] * wv; a1 += sc[DM + kb + k] * wv; a2 += sc[2 * DM + kb + k] * wv; a3 += sc[3 * DM + kb + k] * wv; a4 += sc[4 * DM + kb + k] * wv; }
                    red[(wave * 5 + 0) * 64 + lane] = a0; red[(wave * 5 + 1) * 64 + lane] = a1; red[(wave * 5 + 2) * 64 + lane] = a2; red[(wave * 5 + 3) * 64 + lane] = a3; red[(wave * 5 + 4) * 64 + lane] = a4;
                    __syncthreads();
                    if (tid < 320) { const int i = tid >> 6; float s = 0.f;
                        for (int w8 = 0; w8 < 8; ++w8) s += red[(w8 * 5 + i) * 64 + lane];
                        MOD[((size_t)l * 5 + i) * 6144 + n0 + lane] = s + args.in[6][(size_t)l * 6144 + n0 + lane]; }
                    __syncthreads();
                }
            }
            if (bx == 1 % G) {
                for (int i = tid; i < 64 * 16; i += 512) { const int pos = i >> 4, f = i & 15; const float ang = (float)pos * INVF32[f]; float s, c; sincos_d((double)ang, s, c); TC64[i] = c; TS64[i] = s; }
                for (int i = tid; i < 64 * 32; i += 512) { const int pos = i >> 5, f = i & 31; const float ang = (float)pos * INVF64[f]; float s, c; sincos_d((double)ang, s, c); TC128[i] = c; TS128[i] = s; }
            }
            if (bx == 2 % G && tid < DEPTH) {
                const int l = tid;
                float s1 = 0.f, s2 = 0.f;
                for (int i = 0; i < 64; ++i) { s1 += args.in[20][l * 64 + i] * args.in[21][l * 64 + i]; s2 += args.in[22][l * 64 + i] * args.in[23][l * 64 + i]; }
                const float lam_init = 0.8f - 0.6f * expf(-0.3f * (float)l);
                LAM[l * 4 + 0] = expf(s1) - expf(s2) + lam_init;
                const float mAq = absmax_n(args.in[9] + l * 128, 128), mAk = absmax_n(args.in[10] + l * 128, 128);
                const float mBqn = absmax_n(args.in[11] + l * 128, 128), mBqr = absmax_n(args.in[12] + l * 64, 64), mBkn = absmax_n(args.in[16] + l * 128, 128), mBkr = absmax_n(args.in[17] + l * 64, 64);
                const float mCq = absmax_n(args.in[18] + l * 64, 64), mCk = absmax_n(args.in[19] + l * 64, 64);
                const float L2E = 1.4426950408889634f;
                LAM[l * 4 + 1] = -(sqrtf(128.f) * mAq * mAk) * L2E;
                LAM[l * 4 + 2] = -(sqrtf(128.f * mBqn * mBqn + 64.f * mBqr * mBqr) * sqrtf(128.f * mBkn * mBkn + 64.f * mBkr * mBkr) * 0.07216878364870323f) * L2E;
                LAM[l * 4 + 3] = -(8.f * mCq * mCk) * L2E;
            }
            __syncthreads();
            {
                LAS float* scr = (LAS float*)(lds + wave * 16384);
                const int gw = vcu * 8 + wave, NGW = G * 8;
                constexpr int I_IN = 32 * (NIN / 32), I_UP = 8 * 64, I_BR = 3 * 16 * 64, I_OUT = 32 * 64, I_L = I_IN + I_UP + I_BR + I_OUT;
                for (int it = gw; it < DEPTH * I_L; it += NGW) {
                    const int l = it / I_L; int r = it % I_L;
                    if (r < I_IN) { const int nb = r % (NIN / 32), kb = r / (NIN / 32); const int n0 = nb * 32;
                        transpose_item(args.in[7] + (size_t)l * DM * INC, INC, kb * 64, in_src_col(n0 + (lane & 31)), nullptr, WIN + (size_t)l * NIN * DM, DM, n0, 0, scr, lane); continue; }
                    r -= I_IN;
                    if (r < I_UP) { const int nb = r % 64, kb = r / 64; const int n0 = nb * 32; const int sc_ = up_src_col(n0 + (lane & 31));
                        const float* W = (sc_ < 1024 ? args.in[14] : args.in[15]) + (size_t)l * 512 * 1024;
                        transpose_item(W, 1024, kb * 64, sc_ & 1023, args.in[13] + l * 512, WUP + (size_t)l * 2048 * 512, 512, n0, 0, scr, lane); continue; }
                    r -= I_UP;
                    if (r < I_BR) { const int br = r / (16 * 64), r2 = r % (16 * 64); const int nb = r2 % 64, kb = r2 / 64; const int n0 = nb * 32;
                        transpose_item(args.in[25 + br] + (size_t)l * 1024 * DM, DM, kb * 64, n0 + (lane & 31), nullptr, WBR + (size_t)l * 2048 * 3072, 3072, n0, br * 1024, scr, lane); continue; }
                    r -= I_BR;
                    { const int nb = r % 64, kb = r / 64; const int n0 = nb * 32;
                      transpose_item(args.in[28] + (size_t)l * DM * DM, DM, kb * 64, n0 + (lane & 31), nullptr, WOUT + (size_t)l * DM * DM, DM, n0, 0, scr, lane); }
                }
            }
        } else {
            const int l = (ph - 1) / PPL, st_ = (ph - 1) % PPL, st = (MK_REP_ST >= 0 && st_ > MK_REP_ST) ? st_ - 1 : st_;
            const float* xsrc = (l == 0) ? args.in[0] : args.out;
            const float* csrc = (l == 0) ? args.in[2] : CTXW;
            const float* modl = MOD + (size_t)l * 5 * 6144;
            const int Mrows = (l == DEPTH - 1) ? MLAT : MTOT;
            if (st == 0 && (MK_MASK & 2)) {
                const float* nw = args.in[4] + (size_t)l * DM;
                for (int row = bx * 8 + wave; row < MTOT; row += G * 8) {
                    const bool lat = row < MLAT; const int mi = lat ? (row >> 12) : 4;
                    const f32x4* xr = (const f32x4*)(lat ? xsrc + (size_t)row * DM : csrc + (size_t)(row - MLAT) * DM) + lane;
                    f32x4 v[8]; float s = 0.f;
#pragma unroll
                    for (int j = 0; j < 8; ++j) { v[j] = xr[64 * j]; s += (v[j][0] * v[j][0] + v[j][1] * v[j][1]) + (v[j][2] * v[j][2] + v[j][3] * v[j][3]); }
                    const float rinv = rsqrtf(wave_sum(s) * (1.f / DM) + EPS);
                    const f32x4* sh = (const f32x4*)(modl + mi * 6144) + lane; const f32x4* scl = (const f32x4*)(modl + mi * 6144 + DM) + lane; const f32x4* nwp = (const f32x4*)nw + lane;
                    u32x2* o8 = (u32x2*)(H + (size_t)row * DM) + lane;
#pragma unroll
                    for (int j = 0; j < 8; ++j) { const f32x4 y = v[j] * rinv * nwp[64 * j] * (scl[64 * j] + 1.f) + sh[64 * j];
                        u32x2 w; w.x = cvt_pk_bf16(y[0], y[1]); w.y = cvt_pk_bf16(y[2], y[3]); o8[64 * j] = w; }
                }
            } else if (st == 1 && (MK_MASK & 4)) {
                pg8::Gemm g{H, WIN + (size_t)l * NIN * DM, MTOT, NIN, DM}; pg8::StaticOrder S; S.init(MTOT, NIN, G, bx);
                EpiIn E{QA, KA, VA, QB, KB, CKV, QC, KC, VC, GATE, MRG, SS,
                        args.in[9] + l * 128, args.in[10] + l * 128, args.in[11] + l * 128, args.in[12] + l * 64, args.in[17] + l * 64, args.in[18] + l * 64, args.in[19] + l * 64,
                        args.in[8] + (size_t)l * 6144, TC64, TS64, TC128, TS128, xch};
                pg8::gemm_phase<EpiIn>(lds, g, S, E, tid);
            } else if (st == 2 && (MK_MASK & 8)) {
                pg8::Gemm g{CKV, WUP + (size_t)l * 2048 * 512, MTOT, 2048, 512}; pg8::StaticOrder S; S.init(MTOT, 2048, G, bx);
                EpiUp E{KB, VB, SS, args.in[16] + l * 128, xch};
                pg8::gemm_phase<EpiUp>(lds, g, S, E, tid);
            } else if (st == 3 && (MK_MASK & 16)) {
                AttnBufs T{QA, KA, VA, QB, KB, VB, QC, KC, VC, GATE, BR, SCR, LAM + l * 4, args.in[24] + l * 128, 0.8f - 0.6f * expf(-0.3f * (float)l)};
                const int nctx = (l < DEPTH - 1) ? 96 : 0;
                for (int k = 0;; ++k) {
                    int type, b, h, qrow0, NT;
                    if (G == 256) {
                        if (k < 6) { const int id = (k & 1) * 256 + vcu; type = k >> 1; b = id >> 7; h = (id >> 4) & 7; qrow0 = b * SEQ + (id & 15) * 256; NT = 68; }
                        else if (k == 6 && bx < nctx) { type = bx >> 5; b = (bx >> 3) & 3; h = bx & 7; qrow0 = MLAT + b * CTXL; NT = 4; }
                        else break;
                    } else {
                        const int it = bx + k * G; if (it >= 1536 + nctx) break;
                        if (it < 1536) { const int id = it & 511; type = it >> 9; b = id >> 7; h = (id >> 4) & 7; qrow0 = b * SEQ + (id & 15) * 256; NT = 68; }
                        else { const int c = it - 1536; type = c >> 5; b = (c >> 3) & 3; h = c & 7; qrow0 = MLAT + b * CTXL; NT = 4; }
                    }
                    attn_item(T, type, b, h, qrow0, NT, (LAS char*)lds, tid);
                }
                __syncthreads();
            } else if (st == 4 && (MK_MASK & 32)) {
                pg8::Gemm g{BR, WBR + (size_t)l * 2048 * 3072, Mrows, 2048, 3072}; pg8::StaticOrder S; S.init(Mrows, 2048, G, bx);
                EpiBr E{MRG, Y};
                pg8::gemm_phase<EpiBr>(lds, g, S, E, tid);
            } else if (MK_MASK & 64) {
                pg8::Gemm g{Y, WOUT + (size_t)l * DM * DM, Mrows, DM, DM}; pg8::StaticOrder S; S.init(Mrows, DM, G, bx);
                EpiOut E{xsrc, csrc, args.out, CTXW, modl};
                pg8::gemm_phase<EpiOut>(lds, g, S, E, tid);
            }
        }
        if (ph + 1 < args.ph_hi) { if (args.coop) { if (ph == 0) cg::this_grid().sync(); else xcd_barrier(bar); } }
    }
}

extern "C" void kernel_launch(void* const* d_in, const int* in_sizes, int n_in, void* d_out, int out_size, void* d_ws, size_t ws_size, hipStream_t stream) {
    static int grid = 0;
    if (grid == 0) {
        if (n_in != 29 || in_sizes[0] != MLAT * DM || out_size != MLAT * DM || ws_size < WS_END) {
            fprintf(stderr, "kernel_launch: unexpected shapes: n_in %d in0 %d out %d ws %zu (need %zu)\n", n_in, n_in > 0 ? in_sizes[0] : -1, out_size, ws_size, (size_t)WS_END); grid = -1; return; }
        int dev = 0, cus = 0, per_cu = 0;
        if (hipGetDevice(&dev) != hipSuccess || hipDeviceGetAttribute(&cus, hipDeviceAttributeMultiprocessorCount, dev) != hipSuccess) { grid = -1; return; }
        if (hipFuncSetAttribute((const void*)mega_fwd, hipFuncAttributeMaxDynamicSharedMemorySize, LDS_BYTES) != hipSuccess) { fprintf(stderr, "kernel_launch: hipFuncSetAttribute failed\n"); grid = -1; return; }
        if (hipOccupancyMaxActiveBlocksPerMultiprocessor(&per_cu, (const void*)mega_fwd, 512, LDS_BYTES) != hipSuccess || per_cu < 1) { fprintf(stderr, "kernel_launch: occupancy query gives %d\n", per_cu); per_cu = 1; }
        (void)hipGetLastError();
        grid = cus * 1;
    }
    if (grid < 0) return;
    Args a{};
    for (int i = 0; i < 29; ++i) a.in[i] = (const float*)d_in[i];
    a.out = (float*)d_out; a.ws = (unsigned char*)d_ws;
#if MK_COOP
    if (hipMemsetAsync((char*)d_ws + WS_BAR, 0, 16384, stream) != hipSuccess) { fprintf(stderr, "kernel_launch: memset of the barrier words failed\n"); return; }
    a.ph_lo = 0; a.ph_hi = NPH; a.coop = 1;
    void* kargs[] = {&a};
    hipError_t e = hipLaunchCooperativeKernel((const void*)mega_fwd, dim3(grid), dim3(512), kargs, LDS_BYTES, stream);
    if (e != hipSuccess) fprintf(stderr, "kernel_launch: cooperative launch failed: %s (grid %d)\n", hipGetErrorString(e), grid);
#else
    for (int ph = 0; ph < NPH; ++ph) {
        a.ph_lo = ph; a.ph_hi = ph + 1; a.coop = 0;
        hipLaunchKernelGGL(mega_fwd, dim3(grid), dim3(512), LDS_BYTES, stream, a);
    }
    const hipError_t le = hipPeekAtLastError();
    if (le != hipSuccess) fprintf(stderr, "kernel_launch: launch failed: %s\n", hipGetErrorName(le));
#endif
}
```

```cpp
#include <hip/hip_runtime.h>
#include <hip/hip_cooperative_groups.h>
#include <cstdio>
#include <cstdint>
namespace cg = cooperative_groups;

#ifndef MK_MASK
#define MK_MASK 127
#endif
#ifndef MK_ATYPE
#define MK_ATYPE 7
#endif
#ifndef MK_G1T
#define MK_G1T 127
#endif
#ifndef ATT_SD_A
#define ATT_SD_A 2
#endif
#ifndef ATT_SD_B
#define ATT_SD_B 1
#endif
#ifndef ATT_SD_C
#define ATT_SD_C 2
#endif
#ifndef ATT_DBL_B
#define ATT_DBL_B true
#endif
#ifndef ATT_DBL
#define ATT_DBL false
#endif
#ifndef QKT_GRP
#define QKT_GRP 0
#endif
#ifndef MK_COOP
#define MK_COOP 1
#endif

#define LAS __attribute__((address_space(3)))
typedef unsigned short bf16_t;
typedef short bf16x8 __attribute__((ext_vector_type(8)));
typedef short s16x4 __attribute__((ext_vector_type(4)));
typedef float f32x4 __attribute__((ext_vector_type(4)));
typedef float f32x16 __attribute__((ext_vector_type(16)));
typedef unsigned u32x4 __attribute__((ext_vector_type(4)));
typedef unsigned u32x2 __attribute__((ext_vector_type(2)));

constexpr int DM = 2048, NBATCH = 4, SEQ = 4096, CTXL = 256, DEPTH = 4;
constexpr int MLAT = NBATCH * SEQ, MCTX = NBATCH * CTXL, MTOT = MLAT + MCTX;
constexpr int INC = 15936, NIN = 16128;
constexpr float EPS = 1e-6f;
#ifndef MK_REP_ST
#define MK_REP_ST -1
#endif
constexpr int PPL = 6 + (MK_REP_ST >= 0 ? 1 : 0);
constexpr int NPH = 1 + PPL * DEPTH;

constexpr size_t alignup(size_t x) { return (x + 255) / 256 * 256; }
constexpr size_t WS_MOD = 0;
constexpr size_t WS_TC64 = WS_MOD + alignup((size_t)DEPTH * 5 * 6144 * 4);
constexpr size_t WS_TS64 = WS_TC64 + 4096, WS_TC128 = WS_TS64 + 4096, WS_TS128 = WS_TC128 + 8192;
constexpr size_t WS_LAM = WS_TS128 + 8192;
constexpr size_t WS_BAR = WS_LAM + 256;
constexpr size_t WS_WIN = WS_BAR + 16384;
constexpr size_t WS_WUP = WS_WIN + (size_t)DEPTH * NIN * DM * 2;
constexpr size_t WS_WBR = WS_WUP + (size_t)DEPTH * 2048 * 512 * 2;
constexpr size_t WS_WOUT = WS_WBR + (size_t)DEPTH * 2048 * 3072 * 2;
constexpr size_t WS_H = WS_WOUT + (size_t)DEPTH * 2048 * 2048 * 2;
constexpr size_t WS_QA = WS_H + (size_t)MTOT * 2048 * 2;
constexpr size_t WS_KA = WS_QA + (size_t)MTOT * 1024 * 2;
constexpr size_t WS_VA = WS_KA + (size_t)MTOT * 256 * 2;
constexpr size_t WS_QB = WS_VA + (size_t)MTOT * 256 * 2;
constexpr size_t WS_KB = WS_QB + (size_t)MTOT * 1536 * 2;
constexpr size_t WS_CKV = WS_KB + (size_t)MTOT * 1536 * 2;
constexpr size_t WS_VB = WS_CKV + (size_t)MTOT * 512 * 2;
constexpr size_t WS_QC = WS_VB + (size_t)MTOT * 1024 * 2;
constexpr size_t WS_KC = WS_QC + (size_t)MTOT * 1024 * 2;
constexpr size_t WS_VC = WS_KC + (size_t)MTOT * 1024 * 2;
constexpr size_t WS_GATE = WS_VC + (size_t)MTOT * 1024 * 2;
constexpr size_t WS_MRG = WS_GATE + (size_t)MTOT * 3072 * 2;
constexpr size_t WS_BR = WS_MRG + (size_t)MTOT * 6144 * 2;
constexpr size_t WS_Y = WS_BR + (size_t)MTOT * 3072 * 2;
constexpr size_t WS_SS = WS_Y + (size_t)MTOT * 2048 * 2;
constexpr size_t WS_CTXW = WS_SS + (size_t)MTOT * 8 * 4;
constexpr size_t WS_SCR = WS_CTXW + (size_t)MCTX * DM * 4;
constexpr size_t WS_END = WS_SCR + (size_t)256 * 64 * 512 * 4;

constexpr int RING_BYTES = 131072, XCH_OFF = RING_BYTES, LDS_BYTES = 147456;

__device__ __forceinline__ float bf2f(unsigned h) { return __uint_as_float(h << 16); }
__device__ __forceinline__ unsigned cvt_pk_bf16(float lo, float hi) { unsigned r; asm volatile("v_cvt_pk_bf16_f32 %0, %1, %2" : "=v"(r) : "v"(lo), "v"(hi)); return r; }
__device__ __forceinline__ float wave_sum(float v) {
#pragma unroll
    for (int o = 1; o < 64; o <<= 1) v += __shfl_xor(v, o);
    return v;
}
__device__ __forceinline__ float silu_f(float x) { return x / (1.f + __expf(-x)); }
__device__ __forceinline__ float sigm_f(float x) { return 1.f / (1.f + __expf(-x)); }
__device__ __forceinline__ void store8(bf16_t* p, f32x4 a, f32x4 b) {
    u32x4 w; w.x = cvt_pk_bf16(a[0], a[1]); w.y = cvt_pk_bf16(a[2], a[3]); w.z = cvt_pk_bf16(b[0], b[1]); w.w = cvt_pk_bf16(b[2], b[3]);
    *(u32x4*)p = w;
}

namespace pg8 {
constexpr int BM = 256, BK = 64, HALF = 128, HTB = HALF * BK * 2, NXCD = 8, WGM = 8;
__host__ __device__ __forceinline__ int lds_byte(int r, int c) { const int st = (r >> 4) * 2 + (c >> 5), rr = r & 15, cc = c & 31, ob = rr * 64 + cc * 2; return st * 1024 + (ob ^ (((ob >> 9) & 1) << 5)); }
__host__ __device__ __forceinline__ void stage_rc(int b, int& R, int& C) { const int st = b / 1024, sb = b % 1024, swz = sb ^ (((sb >> 9) & 1) << 5); R = (st >> 1) * 16 + swz / 64; C = (st & 1) * 32 + (swz % 64) / 2; }
__host__ __device__ __forceinline__ int perm32(int rho) { const int n = rho >> 4, i = rho & 15; return 8 * (i >> 2) + 4 * n + (i & 3); }

struct Unit { int pm, pn; };
struct Gemm { const bf16_t* A; const bf16_t* Bt; int M, N, K; };
struct StaticOrder {
    int nM, nN, nwg, G, c;
    __device__ void init(int M, int N, int G_, int c_) { nM = M / BM; nN = N / BM; nwg = nM * nN; G = G_; c = c_; }
    __device__ bool next(int i, Unit& u) const {
        const long L = (long)i * G + c; if (L >= nwg) return false;
        int wgid = (int)L; { const int q = nwg / NXCD, r = nwg % NXCD, xcd = wgid % NXCD, off = wgid / NXCD; wgid = (xcd < r ? xcd * (q + 1) : r * (q + 1) + (xcd - r) * q) + off; }
        const int nig = WGM * nN, gid = wgid / nig, fm = gid * WGM, gsz = (nM - fm) < WGM ? (nM - fm) : WGM;
        u.pm = fm + ((wgid % nig) % gsz); u.pn = (wgid % nig) / gsz; return true;
    }
};

template <class Epi>
__device__ __forceinline__ void gemm_phase(LAS unsigned char* lds, const Gemm g, const StaticOrder& S, const Epi& E, const int tid) {
    const int wid = __builtin_amdgcn_readfirstlane(tid >> 6), lane = tid & 63, wr = wid >> 2, wc = wid & 3, fr = lane & 15, fq = lane >> 4;
    const int K = g.K, nt = K / BK;
    unsigned voffA[2], voffB[2];
#pragma unroll
    for (int i = 0; i < 2; ++i) { int R, C; stage_rc(tid * 16 + i * 8192, R, C); const int Rb = (R & ~31) + perm32(R & 31);
        voffA[i] = (unsigned)(R * K + C) * 2u; voffB[i] = (unsigned)(Rb * K + C) * 2u; }
    const size_t kstep = (size_t)(BK * 2);
    const size_t hstep = (size_t)HALF * K * 2;
    const size_t tstep = 2 * hstep;
    const unsigned ldsw = (unsigned)wid * 1024u;
    const int aoff = lds_byte(wr * 64 + fr, fq * 8), boff = lds_byte(wc * 32 + fr, fq * 8);
#define PG8_SA(b, h) (((b) * 2 + (h)) * HTB)
#define PG8_SB(b, h) ((4 + (b) * 2 + (h)) * HTB)
#define PG8_STAGE(bufoff, gbase, voff) do { _Pragma("unroll") for (int _i = 0; _i < 2; ++_i) \
        __builtin_amdgcn_global_load_lds((const unsigned*)((const char*)(gbase) + (voff)[_i]), (LAS unsigned*)(lds + (bufoff) + ldsw + _i * 8192), 16, 0, 0); } while (0)
#define PG8_LDA(dst, b, h) do { _Pragma("unroll") for (int m = 0; m < 4; ++m) _Pragma("unroll") for (int k = 0; k < 2; ++k) dst[m][k] = *(const LAS bf16x8*)(lds + PG8_SA(b, h) + aoff + m * 2048 + k * 1024); } while (0)
#define PG8_LDB(dst, b, h) do { _Pragma("unroll") for (int n = 0; n < 2; ++n) _Pragma("unroll") for (int k = 0; k < 2; ++k) dst[n][k] = *(const LAS bf16x8*)(lds + PG8_SB(b, h) + boff + n * 2048 + k * 1024); } while (0)
#define PG8_MMA(ai, bj, At, Bt) do { __builtin_amdgcn_s_setprio(1); _Pragma("unroll") for (int m = 0; m < 4; ++m) _Pragma("unroll") for (int n = 0; n < 2; ++n) _Pragma("unroll") for (int k = 0; k < 2; ++k) \
        acc[ai][bj][m][n] = __builtin_amdgcn_mfma_f32_16x16x32_bf16(Bt[n][k], At[m][k], acc[ai][bj][m][n], 0, 0, 0); __builtin_amdgcn_s_setprio(0); } while (0)
#define PG8_WAIT_V(n) asm volatile("s_waitcnt vmcnt(" #n ")" ::: "memory")
#define PG8_WAIT_L(n) asm volatile("s_waitcnt lgkmcnt(" #n ")" ::: "memory")
#define PG8_BAR __builtin_amdgcn_s_barrier()
#define PG8_SCHED __builtin_amdgcn_sched_barrier(0)
    Unit cur, nxt; int ui = 0;
    if (!S.next(0, cur)) return;
    f32x4 acc[2][2][4][2];
#pragma unroll
    for (int a = 0; a < 2; ++a)
#pragma unroll
        for (int b = 0; b < 2; ++b)
#pragma unroll
            for (int m = 0; m < 4; ++m)
#pragma unroll
                for (int n = 0; n < 2; ++n) acc[a][b][m][n] = (f32x4){0.f, 0.f, 0.f, 0.f};
    bf16x8 At[4][2], B0[2][2], B1[2][2];
    const char* cA = (const char*)g.A + (size_t)cur.pm * tstep; const char* cB = (const char*)g.Bt + (size_t)cur.pn * tstep;
    PG8_STAGE(PG8_SB(0, 0), cB, voffB); PG8_STAGE(PG8_SB(0, 1), cB + hstep, voffB); PG8_STAGE(PG8_SA(0, 0), cA, voffA); PG8_STAGE(PG8_SA(0, 1), cA + hstep, voffA);
    if (wr == 1) PG8_BAR;
    PG8_WAIT_V(2); PG8_BAR;
    PG8_STAGE(PG8_SB(1, 0), cB + kstep, voffB); PG8_STAGE(PG8_SA(1, 0), cA + kstep, voffA); PG8_STAGE(PG8_SB(1, 1), cB + hstep + kstep, voffB);
    PG8_WAIT_V(6); PG8_BAR;
    for (;;) {
        const bool has_next = S.next(ui + 1, nxt);
        const char* nA = has_next ? (const char*)g.A + (size_t)nxt.pm * tstep : cA; const char* nB = has_next ? (const char*)g.Bt + (size_t)nxt.pn * tstep : cB;
        for (int t = 0; t < nt; t += 2) {
            const bool last = (t == nt - 2);
            const char* a1 = cA + (size_t)(t + 1) * kstep;
            const char* a2 = last ? nA : cA + (size_t)(t + 2) * kstep; const char* b2 = last ? nB : cB + (size_t)(t + 2) * kstep;
            const char* a3 = a2 + kstep; const char* b3 = b2 + kstep;
            if constexpr (Epi::MID) { if (t == 16 || t == 32) { int fr_ = fr, fq_ = fq, wr_ = wr, wc_ = wc;
                asm volatile("" : "+v"(fr_), "+v"(fq_)); asm volatile("" : "+s"(wr_), "+s"(wc_));
                E.mid(acc, cur, t >> 4, wr_, wc_, fr_, fq_); PG8_WAIT_V(0); PG8_SCHED; } }
            PG8_LDB(B0, 0, 0); PG8_LDB(B1, 0, 1); PG8_SCHED; PG8_LDA(At, 0, 0); PG8_STAGE(PG8_SA(1, 1), a1 + hstep, voffA);
            PG8_WAIT_V(8); PG8_WAIT_L(0); PG8_BAR; PG8_MMA(0, 0, At, B0); PG8_MMA(0, 1, At, B1); PG8_BAR; PG8_SCHED;
            PG8_LDA(At, 0, 1); PG8_STAGE(PG8_SB(0, 0), b2, voffB); PG8_STAGE(PG8_SB(0, 1), b2 + hstep, voffB); PG8_STAGE(PG8_SA(0, 0), a2, voffA);
            PG8_WAIT_V(8); PG8_WAIT_L(0); PG8_BAR; PG8_MMA(1, 0, At, B0); PG8_MMA(1, 1, At, B1); PG8_BAR; PG8_SCHED;
            PG8_LDB(B0, 1, 0); PG8_LDB(B1, 1, 1); PG8_SCHED; PG8_LDA(At, 1, 0); PG8_STAGE(PG8_SA(0, 1), a2 + hstep, voffA);
            PG8_WAIT_V(8); PG8_WAIT_L(0); PG8_BAR; PG8_MMA(0, 0, At, B0); PG8_MMA(0, 1, At, B1); PG8_BAR; PG8_SCHED;
            PG8_LDA(At, 1, 1); PG8_STAGE(PG8_SB(1, 0), b3, voffB); PG8_STAGE(PG8_SB(1, 1), b3 + hstep, voffB); PG8_STAGE(PG8_SA(1, 0), a3, voffA);
            PG8_WAIT_V(8); PG8_WAIT_L(0); PG8_BAR; PG8_MMA(1, 0, At, B0); PG8_MMA(1, 1, At, B1); PG8_BAR; PG8_SCHED;
        }
        if (wr == 0) PG8_BAR;
        { int fr_ = fr, fq_ = fq, wr_ = wr, wc_ = wc, wid_ = wid;
          asm volatile("" : "+v"(fr_), "+v"(fq_)); asm volatile("" : "+s"(wr_), "+s"(wc_), "+s"(wid_));
          E(acc, cur, wr_, wc_, fr_, fq_, wid_); }
        if (!has_next) break;
#pragma unroll
        for (int a = 0; a < 2; ++a)
#pragma unroll
            for (int b = 0; b < 2; ++b)
#pragma unroll
                for (int m = 0; m < 4; ++m)
#pragma unroll
                    for (int n = 0; n < 2; ++n) acc[a][b][m][n] = (f32x4){0.f, 0.f, 0.f, 0.f};
        cur = nxt; cA = nA; cB = nB; ++ui;
        if (wr == 1) PG8_BAR;
    }
    PG8_WAIT_V(0);
    PG8_BAR;
#undef PG8_SA
#undef PG8_SB
#undef PG8_STAGE
#undef PG8_LDA
#undef PG8_LDB
#undef PG8_MMA
#undef PG8_WAIT_V
#undef PG8_WAIT_L
#undef PG8_BAR
#undef PG8_SCHED
}
}
using pg8::Unit;

__device__ __forceinline__ int in_src_col(int n) {
    const int tile = n >> 8, s = n & 255, bj = s >> 7, wc = (s >> 5) & 3, c = s & 31;
    const int d128 = 64 * (wc & 1) + 32 * bj + c, g128 = wc >> 1;
    const int d64 = 32 * (c >> 4) + 16 * bj + (c & 15), g64 = wc;
    if (tile < 4) return (tile * 2 + g128) * 128 + d128;
    if (tile == 4) return 1024 + g128 * 128 + d128;
    if (tile == 5) return 1280 + s;
    if (tile < 10) return 1536 + ((tile - 6) * 2 + g128) * 192 + d128;
    if (tile < 12) return 1536 + ((tile - 10) * 4 + g64) * 192 + 128 + d64;
    if (tile < 14) return 3072 + (tile - 12) * 256 + s;
    if (tile == 14) return g64 == 0 ? 3584 + d64 : -1;
    if (tile < 19) return 3648 + ((tile - 15) * 4 + g64) * 64 + d64;
    if (tile < 23) return 4672 + ((tile - 19) * 4 + g64) * 64 + d64;
    if (tile < 27) return 5696 + (tile - 23) * 256 + s;
    if (tile < 39) return 6720 + (tile - 27) * 256 + s;
    return 9792 + (tile - 39) * 256 + s;
}
__device__ __forceinline__ int up_src_col(int n) {
    if (n >= 1024) return n;
    const int tile = n >> 8, s = n & 255, bj = s >> 7, wc = (s >> 5) & 3, c = s & 31;
    return (tile * 2 + (wc >> 1)) * 128 + 64 * (wc & 1) + 32 * bj + c;
}

template <int GS>
__device__ __forceinline__ void norm_rope_store(const f32x4 (&acc)[2][2][4][2], int pm, int wr, int wc, int fr, int fq, int wid,
                                                const float* __restrict__ w, const float* __restrict__ tcos, const float* __restrict__ tsin, bool rope,
                                                const float (&pre)[2][4], bf16_t* __restrict__ dst, int ld, int gbase, int ncopies, int copystride, LAS float* xch) {
    const int dbase = (GS == 128) ? 64 * (wc & 1) + 8 * fq : 32 * (fq >> 1) + 8 * (fq & 1);
    const int bjs = (GS == 128) ? 32 : 16;
    const int axis = (GS == 128) ? (wc & 1) : (fq >> 1);
    const int i0 = (GS == 128) ? 8 * fq : 8 * (fq & 1);
    constexpr int NF = (GS == 128) ? 32 : 16;
    const int wavebase = gbase + ((GS == 128) ? 64 * (wc & 1) : 0) + 8 * fq;
    float ssq[2][4];
#pragma unroll
    for (int ai = 0; ai < 2; ++ai)
#pragma unroll
        for (int m = 0; m < 4; ++m) {
            float s = 0.f;
#pragma unroll
            for (int bj = 0; bj < 2; ++bj)
#pragma unroll
                for (int n = 0; n < 2; ++n)
#pragma unroll
                    for (int j = 0; j < 4; ++j) { const float v = acc[ai][bj][m][n][j] * pre[ai][m]; s += v * v; }
            s += __shfl_xor(s, 16); s += __shfl_xor(s, 32);
            ssq[ai][m] = s;
        }
    if constexpr (GS == 128) {
        if (fq == 0) {
#pragma unroll
            for (int ai = 0; ai < 2; ++ai)
#pragma unroll
                for (int m = 0; m < 4; ++m) xch[wid * 128 + ai * 64 + m * 16 + fr] = ssq[ai][m];
        }
        asm volatile("s_waitcnt lgkmcnt(0)" ::: "memory"); __builtin_amdgcn_s_barrier();
#pragma unroll
        for (int ai = 0; ai < 2; ++ai)
#pragma unroll
            for (int m = 0; m < 4; ++m) ssq[ai][m] += xch[(wid ^ 1) * 128 + ai * 64 + m * 16 + fr];
    }
#pragma unroll
    for (int ai = 0; ai < 2; ++ai)
#pragma unroll
        for (int m = 0; m < 4; ++m) {
            const int rl = ai * 128 + wr * 64 + m * 16 + fr;
            const size_t row = (size_t)pm * 256 + rl;
            const float rinv = rsqrtf(ssq[ai][m] * (1.f / GS) + EPS) * pre[ai][m];
            const int t = (pm & 15) * 256 + rl; const int pos = axis ? (t & 63) : (t >> 6);
            u32x4 k0, k1;
#pragma unroll
            for (int n = 0; n < 2; ++n) {
                const f32x4 w0 = *(const f32x4*)(w + dbase + 4 * n), w1 = *(const f32x4*)(w + dbase + bjs + 4 * n);
                f32x4 y0 = acc[ai][0][m][n] * rinv * w0, y1 = acc[ai][1][m][n] * rinv * w1;
                if (rope) {
                    const f32x4 c = *(const f32x4*)(tcos + pos * NF + i0 + 4 * n), sn = *(const f32x4*)(tsin + pos * NF + i0 + 4 * n);
                    const f32x4 o0 = y0 * c - y1 * sn, o1 = y1 * c + y0 * sn;
                    y0 = o0; y1 = o1;
                }
                if (n == 0) { k0.x = cvt_pk_bf16(y0[0], y0[1]); k0.y = cvt_pk_bf16(y0[2], y0[3]); k1.x = cvt_pk_bf16(y1[0], y1[1]); k1.y = cvt_pk_bf16(y1[2], y1[3]); }
                else { k0.z = cvt_pk_bf16(y0[0], y0[1]); k0.w = cvt_pk_bf16(y0[2], y0[3]); k1.z = cvt_pk_bf16(y1[0], y1[1]); k1.w = cvt_pk_bf16(y1[2], y1[3]); }
            }
            bf16_t* p = dst + row * ld + wavebase;
            for (int cp = 0; cp < ncopies; ++cp) { *(u32x4*)(p + cp * copystride) = k0; *(u32x4*)(p + cp * copystride + 32) = k1; }
            __builtin_amdgcn_sched_barrier(0);
        }
}

struct EpiIn {
    static constexpr bool MID = false;
    bf16_t *QA, *KA, *VA, *QB, *KB, *CKV, *QC, *KC, *VC, *GATE, *MRG; float* SS;
    const float *wAq, *wAk, *wBqn, *wBqr, *wBkr, *wCq, *wCk, *bmerge;
    const float *tc64, *ts64, *tc128, *ts128;
    LAS float* xch;
    template <int ACT>
    __device__ __forceinline__ void plain(const f32x4 (&acc)[2][2][4][2], int pm, int wr, int wc, int fr, int fq, bf16_t* dst, int ld, int col0) const {
        const int colw = col0 + 32 * wc + 8 * fq;
        f32x4 b[2][2];
#pragma unroll
        for (int bj = 0; bj < 2; ++bj)
#pragma unroll
            for (int n = 0; n < 2; ++n) b[bj][n] = (ACT == 2) ? *(const f32x4*)(bmerge + colw + bj * 128 + 4 * n) : (f32x4){0.f, 0.f, 0.f, 0.f};
#pragma unroll
        for (int ai = 0; ai < 2; ++ai)
#pragma unroll
            for (int m = 0; m < 4; ++m) {
                const size_t row = (size_t)pm * 256 + ai * 128 + wr * 64 + m * 16 + fr;
#pragma unroll
                for (int bj = 0; bj < 2; ++bj) {
                    f32x4 v0 = acc[ai][bj][m][0], v1 = acc[ai][bj][m][1];
                    if (ACT == 1) { for (int j = 0; j < 4; ++j) { v0[j] = silu_f(v0[j]); v1[j] = silu_f(v1[j]); } }
                    if (ACT == 2) { v0 = v0 + b[bj][0]; v1 = v1 + b[bj][1]; for (int j = 0; j < 4; ++j) { v0[j] = sigm_f(v0[j]); v1[j] = sigm_f(v1[j]); } }
                    store8(dst + row * ld + colw + bj * 128, v0, v1);
                }
                __builtin_amdgcn_sched_barrier(0);
            }
    }
    __device__ __forceinline__ void operator()(const f32x4 (&acc)[2][2][4][2], const Unit& u, int wr, int wc, int fr, int fq, int wid) const {
        const int t = u.pn, pm = u.pm; const bool rope = pm < 64;
        const float one[2][4] = {{1.f, 1.f, 1.f, 1.f}, {1.f, 1.f, 1.f, 1.f}};
        if (t < 4 && (MK_G1T & 1)) norm_rope_store<128>(acc, pm, wr, wc, fr, fq, wid, wAq, tc128, ts128, rope, one, QA, 1024, (t * 2 + (wc >> 1)) * 128, 1, 0, xch);
        else if (t == 4 && (MK_G1T & 1)) norm_rope_store<128>(acc, pm, wr, wc, fr, fq, wid, wAk, tc128, ts128, rope, one, KA, 256, (wc >> 1) * 128, 1, 0, xch);
        else if (t == 5 && (MK_G1T & 2)) plain<0>(acc, pm, wr, wc, fr, fq, VA, 256, 0);
        else if (t < 10 && (MK_G1T & 1)) norm_rope_store<128>(acc, pm, wr, wc, fr, fq, wid, wBqn, tc128, ts128, false, one, QB, 1536, ((t - 6) * 2 + (wc >> 1)) * 192, 1, 0, xch);
        else if (t < 12 && (MK_G1T & 4)) norm_rope_store<64>(acc, pm, wr, wc, fr, fq, wid, wBqr, tc64, ts64, rope, one, QB, 1536, ((t - 10) * 4 + wc) * 192 + 128, 1, 0, xch);
        else if (t < 14 && (MK_G1T & 8)) {
            plain<0>(acc, pm, wr, wc, fr, fq, CKV, 512, (t - 12) * 256);
#pragma unroll
            for (int ai = 0; ai < 2; ++ai)
#pragma unroll
                for (int m = 0; m < 4; ++m) {
                    float s = 0.f;
#pragma unroll
                    for (int bj = 0; bj < 2; ++bj)
#pragma unroll
                        for (int n = 0; n < 2; ++n)
#pragma unroll
                            for (int j = 0; j < 4; ++j) { const float v = acc[ai][bj][m][n][j]; s += v * v; }
                    s += __shfl_xor(s, 16); s += __shfl_xor(s, 32);
                    if (fq == 0) SS[((size_t)pm * 256 + ai * 128 + wr * 64 + m * 16 + fr) * 8 + (t - 12) * 4 + wc] = s;
                }
        }
        else if (t == 14 && (MK_G1T & 16)) { if (wc == 0) norm_rope_store<64>(acc, pm, wr, wc, fr, fq, wid, wBkr, tc64, ts64, rope, one, KB, 1536, 128, 8, 192, xch); }
        else if (t < 19 && (MK_G1T & 4)) norm_rope_store<64>(acc, pm, wr, wc, fr, fq, wid, wCq, tc64, ts64, rope, one, QC, 1024, ((t - 15) * 4 + wc) * 64, 1, 0, xch);
        else if (t < 23 && (MK_G1T & 4)) norm_rope_store<64>(acc, pm, wr, wc, fr, fq, wid, wCk, tc64, ts64, rope, one, KC, 1024, ((t - 19) * 4 + wc) * 64, 1, 0, xch);
        else if (t < 27 && (MK_G1T & 2)) plain<0>(acc, pm, wr, wc, fr, fq, VC, 1024, (t - 23) * 256);
        else if (t < 39 && (MK_G1T & 32)) plain<1>(acc, pm, wr, wc, fr, fq, GATE, 3072, (t - 27) * 256);
        else if (MK_G1T & 64) plain<2>(acc, pm, wr, wc, fr, fq, MRG, 6144, (t - 39) * 256);
    }
};

struct EpiUp {
    static constexpr bool MID = false;
    bf16_t *KB, *VB; const float* SS; const float* wBkn; LAS float* xch;
    __device__ __forceinline__ void operator()(const f32x4 (&acc)[2][2][4][2], const Unit& u, int wr, int wc, int fr, int fq, int wid) const {
        const int t = u.pn, pm = u.pm;
        float pre[2][4];
#pragma unroll
        for (int ai = 0; ai < 2; ++ai)
#pragma unroll
            for (int m = 0; m < 4; ++m) {
                const size_t row = (size_t)pm * 256 + ai * 128 + wr * 64 + m * 16 + fr;
                const f32x4 a = *(const f32x4*)(SS + row * 8), b = *(const f32x4*)(SS + row * 8 + 4);
                pre[ai][m] = rsqrtf(((a[0] + a[1]) + (a[2] + a[3]) + (b[0] + b[1]) + (b[2] + b[3])) * (1.f / 512.f) + EPS);
                __builtin_amdgcn_sched_barrier(0);
            }
        if (t < 4) norm_rope_store<128>(acc, pm, wr, wc, fr, fq, wid, wBkn, nullptr, nullptr, false, pre, KB, 1536, (t * 2 + (wc >> 1)) * 192, 1, 0, xch);
        else {
            const int colw = (t - 4) * 256 + 32 * wc + 8 * fq;
#pragma unroll
            for (int ai = 0; ai < 2; ++ai)
#pragma unroll
                for (int m = 0; m < 4; ++m) {
                    const size_t row = (size_t)pm * 256 + ai * 128 + wr * 64 + m * 16 + fr;
#pragma unroll
                    for (int bj = 0; bj < 2; ++bj) store8(VB + row * 1024 + colw + bj * 128, acc[ai][bj][m][0] * pre[ai][m], acc[ai][bj][m][1] * pre[ai][m]);
                    __builtin_amdgcn_sched_barrier(0);
                }
        }
    }
};

struct EpiBr {
    static constexpr bool MID = true;
    const bf16_t* MRG; bf16_t* Y;
    __device__ __forceinline__ void mid(f32x4 (&acc)[2][2][4][2], const Unit& u, int i, int wr, int wc, int fr, int fq) const {
#pragma unroll
        for (int ai = 0; ai < 2; ++ai)
#pragma unroll
            for (int m = 0; m < 4; ++m) {
                const size_t row = (size_t)u.pm * 256 + ai * 128 + wr * 64 + m * 16 + fr;
#pragma unroll
                for (int bj = 0; bj < 2; ++bj) {
                    const int col = u.pn * 256 + bj * 128 + 32 * wc + 8 * fq;
                    const u32x4 a = *(const u32x4*)(MRG + row * 6144 + (i - 1) * 2048 + col), b = *(const u32x4*)(MRG + row * 6144 + i * 2048 + col);
#pragma unroll
                    for (int q = 0; q < 4; ++q) {
                        const float r0 = bf2f(a[q] & 0xffffu) * __builtin_amdgcn_rcpf(bf2f(b[q] & 0xffffu)), r1 = bf2f(a[q] >> 16) * __builtin_amdgcn_rcpf(bf2f(b[q] >> 16));
                        acc[ai][bj][m][q >> 1][(q & 1) * 2] *= r0; acc[ai][bj][m][q >> 1][(q & 1) * 2 + 1] *= r1;
                    }
                }
                __builtin_amdgcn_sched_barrier(0);
            }
    }
    __device__ __forceinline__ void operator()(const f32x4 (&acc)[2][2][4][2], const Unit& u, int wr, int wc, int fr, int fq, int wid) const {
#pragma unroll
        for (int ai = 0; ai < 2; ++ai)
#pragma unroll
            for (int m = 0; m < 4; ++m) {
                const size_t row = (size_t)u.pm * 256 + ai * 128 + wr * 64 + m * 16 + fr;
#pragma unroll
                for (int bj = 0; bj < 2; ++bj) {
                    const int col = u.pn * 256 + bj * 128 + 32 * wc + 8 * fq;
                    const u32x4 a = *(const u32x4*)(MRG + row * 6144 + 4096 + col);
                    f32x4 v0 = acc[ai][bj][m][0], v1 = acc[ai][bj][m][1];
                    v0[0] *= bf2f(a[0] & 0xffffu); v0[1] *= bf2f(a[0] >> 16); v0[2] *= bf2f(a[1] & 0xffffu); v0[3] *= bf2f(a[1] >> 16);
                    v1[0] *= bf2f(a[2] & 0xffffu); v1[1] *= bf2f(a[2] >> 16); v1[2] *= bf2f(a[3] & 0xffffu); v1[3] *= bf2f(a[3] >> 16);
                    store8(Y + row * 2048 + col, v0, v1);
                }
                __builtin_amdgcn_sched_barrier(0);
            }
    }
};

struct EpiOut {
    static constexpr bool MID = false;
    const float *xsrc, *csrc; float *xdst, *cdst; const float* mod;
    __device__ __forceinline__ void operator()(const f32x4 (&acc)[2][2][4][2], const Unit& u, int wr, int wc, int fr, int fq, int wid) const {
        const int pm = u.pm; const bool lat = pm < 64;
        const int mi = lat ? (pm >> 4) : 4;
        const float* src = lat ? xsrc : csrc - (size_t)MLAT * DM; float* dst = lat ? xdst : cdst - (size_t)MLAT * DM;
        const float* g = mod + mi * 6144 + 4096;
#pragma unroll
        for (int bj = 0; bj < 2; ++bj) {
            const int col = u.pn * 256 + bj * 128 + 32 * wc + 8 * fq;
            const f32x4 g0 = *(const f32x4*)(g + col), g1 = *(const f32x4*)(g + col + 4);
#pragma unroll
            for (int ai = 0; ai < 2; ++ai)
#pragma unroll
                for (int m = 0; m < 4; ++m) {
                    const size_t row = (size_t)pm * 256 + ai * 128 + wr * 64 + m * 16 + fr;
                    const f32x4 x0 = *(const f32x4*)(src + row * DM + col), x1 = *(const f32x4*)(src + row * DM + col + 4);
                    *(f32x4*)(dst + row * DM + col) = x0 + g0 * acc[ai][bj][m][0];
                    *(f32x4*)(dst + row * DM + col + 4) = x1 + g1 * acc[ai][bj][m][1];
                    __builtin_amdgcn_sched_barrier(0);
                }
        }
    }
};

namespace att {
#define SBAR() __builtin_amdgcn_sched_barrier(0)
__device__ __forceinline__ int crow(int r, int hi) { return (r & 3) + 8 * (r >> 2) + 4 * hi; }
template <int RB> __device__ __forceinline__ int kswz(int row, int colB) { const int x = (RB == 256) ? (row & 7) : ((row >> 1) & 7); return row * RB + (colB ^ (x << 4)); }
__device__ __forceinline__ int v_st(int k, int c) { const int kk = (k & ~0xC) | ((k & 4) << 1) | ((k & 8) >> 1); return ((kk >> 3) * 4 + (c >> 5)) * 512 + ((kk & 7) * 32 + (c & 31)) * 2; }
__device__ __forceinline__ int v_rd_base(int lane) { return ((lane & 3) << 3) | (((lane >> 2) & 3) << 6) | (((lane >> 4) & 1) << 5) | (((lane >> 5) & 1) << 8); }
constexpr int v_rd_off(int d0, int ks, int half) { return d0 * 512 + ks * 4096 + half * 2048; }
template <int OFF> __device__ __forceinline__ s16x4 tr_read(unsigned vb) {
    s16x4 r; asm volatile("ds_read_b64_tr_b16 %0, %1 offset:%2" : "=&v"(r) : "v"(vb), "i"(OFF) : "memory"); return r;
}
template <int D0> __device__ __forceinline__ void pv_one(f32x16& od, unsigned vb, bf16x8 pa0, bf16x8 pa1, bf16x8 pa2, bf16x8 pa3) {
    const s16x4 l0 = tr_read<v_rd_off(D0, 0, 0)>(vb), h0 = tr_read<v_rd_off(D0, 0, 1)>(vb), l1 = tr_read<v_rd_off(D0, 1, 0)>(vb), h1 = tr_read<v_rd_off(D0, 1, 1)>(vb);
    const s16x4 l2 = tr_read<v_rd_off(D0, 2, 0)>(vb), h2 = tr_read<v_rd_off(D0, 2, 1)>(vb), l3 = tr_read<v_rd_off(D0, 3, 0)>(vb), h3 = tr_read<v_rd_off(D0, 3, 1)>(vb);
    asm volatile("s_waitcnt lgkmcnt(0)" ::: "memory"); SBAR();
#define PK(L, H) (bf16x8){L[0], L[1], L[2], L[3], H[0], H[1], H[2], H[3]}
    od = __builtin_amdgcn_mfma_f32_32x32x16_bf16(pa0, PK(l0, h0), od, 0, 0, 0);
    od = __builtin_amdgcn_mfma_f32_32x32x16_bf16(pa1, PK(l1, h1), od, 0, 0, 0);
    od = __builtin_amdgcn_mfma_f32_32x32x16_bf16(pa2, PK(l2, h2), od, 0, 0, 0);
    od = __builtin_amdgcn_mfma_f32_32x32x16_bf16(pa3, PK(l3, h3), od, 0, 0, 0);
#undef PK
}
__device__ __forceinline__ void pv_d0(f32x16 (&o)[4], unsigned vb, bf16x8 pa0, bf16x8 pa1, bf16x8 pa2, bf16x8 pa3) {
    pv_one<0>(o[0], vb, pa0, pa1, pa2, pa3); pv_one<1>(o[1], vb, pa0, pa1, pa2, pa3); pv_one<2>(o[2], vb, pa0, pa1, pa2, pa3); pv_one<3>(o[3], vb, pa0, pa1, pa2, pa3);
}
__device__ __forceinline__ void partialSM(f32x16& p0, f32x16& p1, float C, float nMB) {
#pragma unroll
    for (int r = 0; r < 16; ++r) p0[r] = fmaf(p0[r], C, nMB);
#pragma unroll
    for (int r = 0; r < 16; ++r) p1[r] = fmaf(p1[r], C, nMB);
#pragma unroll
    for (int r = 0; r < 16; ++r) p0[r] = __builtin_amdgcn_exp2f(p0[r]);
}
__device__ __forceinline__ void finishSM(f32x16& p0, f32x16& p1, float& l_reg, bf16x8& pa0, bf16x8& pa1, bf16x8& pa2, bf16x8& pa3) {
#pragma unroll
    for (int r = 0; r < 16; ++r) p1[r] = __builtin_amdgcn_exp2f(p1[r]);
    float ps = 0;
#pragma unroll
    for (int r = 0; r < 16; ++r) ps += p0[r];
#pragma unroll
    for (int r = 0; r < 16; ++r) ps += p1[r];
    { auto rr = __builtin_amdgcn_permlane32_swap(__float_as_uint(ps), __float_as_uint(ps), false, false);
      ps = __uint_as_float(rr[0]) + __uint_as_float(rr[1]); }
    l_reg += ps;
#define PK4(P, BASE, OUT) do { unsigned a0 = cvt_pk_bf16(P[BASE + 0], P[BASE + 1]), a1 = cvt_pk_bf16(P[BASE + 2], P[BASE + 3]);   \
    unsigned b0 = cvt_pk_bf16(P[BASE + 4], P[BASE + 5]), b1 = cvt_pk_bf16(P[BASE + 6], P[BASE + 7]);                              \
    auto r0 = __builtin_amdgcn_permlane32_swap(a0, b0, false, false); auto r1 = __builtin_amdgcn_permlane32_swap(a1, b1, false, false); \
    u32x4 w = {r0[0], r1[0], r0[1], r1[1]}; OUT = *reinterpret_cast<bf16x8*>(&w); } while (0)
    PK4(p0, 0, pa0); PK4(p0, 8, pa1); PK4(p1, 0, pa2); PK4(p1, 8, pa3);
#undef PK4
}
template <int DQK>
__device__ __forceinline__ void qkt(f32x16& p0, f32x16& p1, const LAS char* Ks, const bf16x8 (&qr)[DQK / 16], int r32, int hi) {
    constexpr int RB = DQK * 2;
    p0 = f32x16{}; p1 = f32x16{};
#pragma unroll
    for (int d0 = 0; d0 < DQK / 16; ++d0) { const int cb = (d0 * 16 + hi * 8) * 2;
        const bf16x8 b0 = *(const LAS bf16x8*)(Ks + kswz<RB>(r32, cb));
        const bf16x8 b1 = *(const LAS bf16x8*)(Ks + kswz<RB>(32 + r32, cb));
        p0 = __builtin_amdgcn_mfma_f32_32x32x16_bf16(b0, qr[d0], p0, 0, 0, 0);
        p1 = __builtin_amdgcn_mfma_f32_32x32x16_bf16(b1, qr[d0], p1, 0, 0, 0);
        if (QKT_GRP > 0 && (d0 % QKT_GRP) == QKT_GRP - 1 && d0 + 1 < DQK / 16) SBAR(); }
}
constexpr int V_BYTES = 64 * 128 * 2, K_OFF = 3 * V_BYTES, K_STRIDE = 64 * 192 * 2, LI_OFF = K_OFF + 3 * K_STRIDE;

template <int DQK, bool DOUBLE>
__device__ __forceinline__ void attn_pass(const bf16_t* __restrict__ Q, int ldq, const bf16_t* __restrict__ Kg, int ldk, const bf16_t* __restrict__ Vg, int ldv,
                                          int rowc, int rowl, int NT, float C, float nMB, f32x16 (&o)[4], float& l_reg, LAS char* lds, int tid) {
    constexpr int RB = DQK * 2, NCH = DQK / 8, NLD = NCH / 8;
    const int wid = __builtin_amdgcn_readfirstlane(tid >> 6), lane = tid & 63, r32 = lane & 31, hi = lane >> 5;
    LAS char* V_lds = lds; LAS char* K_lds = lds + K_OFF;
    bf16x8 qr[DQK / 16];
    { const bf16_t* Qw = Q + (size_t)(wid * 32 + r32) * ldq + hi * 8;
#pragma unroll
      for (int d0 = 0; d0 < DQK / 16; ++d0) qr[d0] = *(const bf16x8*)(Qw + d0 * 16); }
#pragma unroll
    for (int d = 0; d < 4; ++d) o[d] = f32x16{};
    l_reg = 0.f;
    int vrow[2], vcol[2], krow[NLD], kcol[NLD];
#pragma unroll
    for (int i = 0; i < 2; ++i) { const int q = tid + 512 * i, sub = q >> 5, within = q & 31, kk = (sub >> 2) * 8 + (within >> 2);
        vrow[i] = (kk & ~0xC) | ((kk & 4) << 1) | ((kk & 8) >> 1); vcol[i] = (sub & 3) * 32 + (within & 3) * 8; }
#pragma unroll
    for (int i = 0; i < NLD; ++i) { const int q = tid + 512 * i, row = q / NCH, chp = q % NCH; const int x = (RB == 256) ? (row & 7) : ((row >> 1) & 7);
        krow[i] = row; kcol[i] = (chp ^ x) * 8; }
    const unsigned vb0 = (unsigned)(uintptr_t)V_lds + v_rd_base(lane);
#define KROW0(j) ((j) < 4 ? rowc + 64 * (j) : rowl + 64 * ((j) - 4))
#define DMA(j, b) do { const size_t _r0 = (size_t)KROW0(j); \
    _Pragma("unroll") for (int _i = 0; _i < 2; ++_i) __builtin_amdgcn_global_load_lds((const unsigned*)(Vg + (_r0 + vrow[_i]) * ldv + vcol[_i]), (LAS unsigned*)(V_lds + (b) * V_BYTES + wid * 1024 + _i * 8192), 16, 0, 0); \
    _Pragma("unroll") for (int _i = 0; _i < NLD; ++_i) __builtin_amdgcn_global_load_lds((const unsigned*)(Kg + (_r0 + krow[_i]) * ldk + kcol[_i]), (LAS unsigned*)(K_lds + (b) * K_STRIDE + wid * 1024 + _i * 8192), 16, 0, 0); } while (0)
#define VMW0() asm volatile("s_waitcnt vmcnt(0)" ::: "memory")
    bf16x8 pa0, pa1, pa2, pa3;
    __syncthreads();
    DMA(0, 0); DMA(1, 1); VMW0(); __syncthreads();
    if constexpr (!DOUBLE) {
        f32x16 p0, p1;
        DMA(2, 2);
        int bc = 0, bn = 1, bf = 2;
        for (int j = 0; j < NT; ++j) {
            SBAR(); qkt<DQK>(p0, p1, K_lds + bc * K_STRIDE, qr, r32, hi);
            partialSM(p0, p1, C, nMB); finishSM(p0, p1, l_reg, pa0, pa1, pa2, pa3); SBAR();
            pv_d0(o, vb0 + bc * V_BYTES, pa0, pa1, pa2, pa3);
            if (j + 1 < NT) { VMW0(); __syncthreads(); if (j + 3 < NT) DMA(j + 3, bc); }
            { const int _t = bc; bc = bn; bn = bf; bf = _t; }
        }
    } else {
    f32x16 pA0, pA1, pB0, pB1;
    qkt<DQK>(pA0, pA1, K_lds, qr, r32, hi); partialSM(pA0, pA1, C, nMB);
    DMA(2, 2);
    int bp = 0, bc = 1, bn = 2;
#define STEP(j, PC0, PC1, PP0, PP1) do { \
        SBAR(); qkt<DQK>(PC0, PC1, K_lds + bc * K_STRIDE, qr, r32, hi); \
        finishSM(PP0, PP1, l_reg, pa0, pa1, pa2, pa3); SBAR(); \
        pv_d0(o, vb0 + bp * V_BYTES, pa0, pa1, pa2, pa3); partialSM(PC0, PC1, C, nMB); \
        if ((j) + 1 < NT) { VMW0(); __syncthreads(); if ((j) + 2 < NT) DMA((j) + 2, bp); } \
        { const int _t = bp; bp = bc; bc = bn; bn = _t; } } while (0)
    for (int j = 1; j < NT; j += 2) {
        STEP(j, pB0, pB1, pA0, pA1);
        if (j + 1 < NT) STEP(j + 1, pA0, pA1, pB0, pB1);
    }
    finishSM(pB0, pB1, l_reg, pa0, pa1, pa2, pa3); SBAR();
    pv_d0(o, vb0 + bp * V_BYTES, pa0, pa1, pa2, pa3);
    }
#undef KROW0
#undef DMA
#undef VMW0
#undef STEP
}
__device__ __forceinline__ void row_recip(float l_reg, float (&rli)[16], LAS float* li, int r32, int hi) {
    if (hi == 0) li[r32] = l_reg;
    asm volatile("s_waitcnt lgkmcnt(0)" ::: "memory");
#pragma unroll
    for (int r = 0; r < 16; ++r) rli[r] = __builtin_amdgcn_rcpf(li[crow(r, hi)]);
    asm volatile("s_waitcnt lgkmcnt(0)" ::: "memory");
}
}

struct AttnBufs { const bf16_t *QA, *KA, *VA, *QB, *KB, *VB, *QC, *KC, *VC, *GATE; bf16_t* BR; float* SCR; const float* lamv; const float* subln; float lam_init; };

template <bool SUBLN>
__device__ __forceinline__ void attn_out(const AttnBufs& T, f32x16 (&o)[4], int type, int h, size_t orow0, LAS char* lds, int wid, int lane, int r32, int hi) {
    __syncthreads();
    LAS float* stg = (LAS float*)(lds + wid * 16896);
#pragma unroll
    for (int d0 = 0; d0 < 4; ++d0)
#pragma unroll
        for (int r = 0; r < 16; ++r) stg[att::crow(r, hi) * 132 + d0 * 32 + r32] = o[d0][r];
    asm volatile("s_waitcnt lgkmcnt(0)" ::: "memory");
    const int rr = lane >> 5, c4 = (lane & 31) * 4;
    const int col = type * 1024 + h * 128 + c4;
    f32x4 wsub = {1.f, 1.f, 1.f, 1.f};
    if (SUBLN) { wsub = *(const f32x4*)(T.subln + c4) * (1.f - T.lam_init); }
    const bf16_t* gp = T.GATE + (orow0 + rr) * 3072 + col; bf16_t* op = T.BR + (orow0 + rr) * 3072 + col;
#pragma unroll 4
    for (int i = 0; i < 16; ++i) {
        f32x4 v = *(const LAS f32x4*)(stg + (2 * i + rr) * 132 + c4);
        const u32x2 gg = *(const u32x2*)(gp + (size_t)i * 2 * 3072);
        if (SUBLN) {
            float s = (v[0] * v[0] + v[1] * v[1]) + (v[2] * v[2] + v[3] * v[3]);
            s += __shfl_xor(s, 1); s += __shfl_xor(s, 2); s += __shfl_xor(s, 4); s += __shfl_xor(s, 8); s += __shfl_xor(s, 16);
            v = v * (rsqrtf(s * (1.f / 128.f) + EPS)) * wsub;
        }
        u32x2 w; w.x = cvt_pk_bf16(v[0] * bf2f(gg.x & 0xffffu), v[1] * bf2f(gg.x >> 16)); w.y = cvt_pk_bf16(v[2] * bf2f(gg.y & 0xffffu), v[3] * bf2f(gg.y >> 16));
        *(u32x2*)(op + (size_t)i * 2 * 3072) = w;
    }
}

__device__ __forceinline__ void attn_item(const AttnBufs& T, int type, int b, int h, int qrow0, int NT, LAS char* lds, int tid_) {
    asm volatile("" : "+v"(tid_));
    const int tid = tid_, wid = __builtin_amdgcn_readfirstlane(tid >> 6), lane = tid & 63, r32 = lane & 31, hi = lane >> 5;
    const int rowc = MLAT + b * CTXL, rowl = b * SEQ;
    LAS float* li = (LAS float*)(lds + att::LI_OFF) + wid * 64;
    constexpr float LOG2E = 1.4426950408889634f;
    const size_t orow0 = (size_t)qrow0 + wid * 32;
    if (type == 0 && (MK_ATYPE & 1)) {
        f32x16 o[4]; float l_reg; float rli[16];
        att::attn_pass<128, ATT_DBL>(T.QA + (size_t)qrow0 * 1024 + h * 128, 1024, T.KA + (h >> 2) * 128, 256, T.VA + (h >> 2) * 128, 256, rowc, rowl, NT,
                            0.08838834764831845f * LOG2E, T.lamv[1], o, l_reg, lds, tid);
        att::row_recip(l_reg, rli, li, r32, hi);
#pragma unroll
        for (int d0 = 0; d0 < 4; ++d0)
#pragma unroll
            for (int r = 0; r < 16; ++r) o[d0][r] *= rli[r];
        attn_out<false>(T, o, 0, h, orow0, lds, wid, lane, r32, hi);
    } else if (type == 1 && (MK_ATYPE & 2)) {
        f32x16 o[4]; float l_reg; float rli[16];
        att::attn_pass<192, false>(T.QB + (size_t)qrow0 * 1536 + h * 192, 1536, T.KB + h * 192, 1536, T.VB + h * 128, 1024, rowc, rowl, NT,
                            0.07216878364870323f * LOG2E, T.lamv[2], o, l_reg, lds, tid);
        att::row_recip(l_reg, rli, li, r32, hi);
#pragma unroll
        for (int d0 = 0; d0 < 4; ++d0)
#pragma unroll
            for (int r = 0; r < 16; ++r) o[d0][r] *= rli[r];
        attn_out<false>(T, o, 1, h, orow0, lds, wid, lane, r32, hi);
    } else if (MK_ATYPE & 4) {
        f32x16 o[4]; float l_reg; float rli[16];
        att::attn_pass<64, ATT_DBL>(T.QC + (size_t)qrow0 * 1024 + h * 128, 1024, T.KC + h * 128, 1024, T.VC + h * 128, 1024, rowc, rowl, NT,
                           0.125f * LOG2E, T.lamv[3], o, l_reg, lds, tid);
        att::row_recip(l_reg, rli, li, r32, hi);
        f32x4* scr = (f32x4*)(T.SCR + ((size_t)blockIdx.x * 512 + tid) * 64);
#pragma unroll
        for (int d0 = 0; d0 < 4; ++d0)
#pragma unroll
            for (int q = 0; q < 4; ++q) scr[d0 * 4 + q] = (f32x4){o[d0][q * 4] * rli[q * 4], o[d0][q * 4 + 1] * rli[q * 4 + 1], o[d0][q * 4 + 2] * rli[q * 4 + 2], o[d0][q * 4 + 3] * rli[q * 4 + 3]};
        att::attn_pass<64, ATT_DBL>(T.QC + (size_t)qrow0 * 1024 + h * 128 + 64, 1024, T.KC + h * 128 + 64, 1024, T.VC + h * 128, 1024, rowc, rowl, NT,
                           0.125f * LOG2E, T.lamv[3], o, l_reg, lds, tid);
        att::row_recip(l_reg, rli, li, r32, hi);
        const float lam = T.lamv[0];
#pragma unroll
        for (int d0 = 0; d0 < 4; ++d0)
#pragma unroll
            for (int q = 0; q < 4; ++q) { const f32x4 a = scr[d0 * 4 + q];
#pragma unroll
                for (int j = 0; j < 4; ++j) o[d0][q * 4 + j] = a[j] - lam * (o[d0][q * 4 + j] * rli[q * 4 + j]); }
        attn_out<true>(T, o, 2, h, orow0, lds, wid, lane, r32, hi);
    }
}

__device__ __forceinline__ void transpose_item(const float* __restrict__ W, int ldw, int k0, int srccol4, const float* __restrict__ kscale,
                                               bf16_t* __restrict__ WT, int ldt, int n0, int kdst0, LAS float* scr, int lane) {
    const int ks = lane >> 4, n4 = (lane & 15) * 4;
#pragma unroll 8
    for (int i = 0; i < 16; ++i) { const int kk = 4 * i + ks;
        f32x4 v = srccol4 >= 0 ? *(const f32x4*)(W + (size_t)(k0 + kk) * ldw + srccol4) : (f32x4){0.f, 0.f, 0.f, 0.f};
        if (kscale) v = v * kscale[k0 + kk];
        LAS float* d = scr + kk * 65 + n4; d[0] = v[0]; d[1] = v[1]; d[2] = v[2]; d[3] = v[3]; }
    asm volatile("s_waitcnt lgkmcnt(0)" ::: "memory");
    const int nn = lane & 7, c = lane >> 3;
#pragma unroll
    for (int j = 0; j < 8; ++j) { const int n = nn + 8 * j; const LAS float* s = scr + (8 * c) * 65 + n;
        u32x4 o; o.x = cvt_pk_bf16(s[0 * 65], s[1 * 65]); o.y = cvt_pk_bf16(s[2 * 65], s[3 * 65]); o.z = cvt_pk_bf16(s[4 * 65], s[5 * 65]); o.w = cvt_pk_bf16(s[6 * 65], s[7 * 65]);
        *(u32x4*)(WT + (size_t)(n0 + n) * ldt + kdst0 + k0 + 8 * c) = o; }
    asm volatile("s_waitcnt lgkmcnt(0)" ::: "memory");
}
__device__ const float INVF32[16] = {1.000000000e+00f, 5.623413324e-01f, 3.162277639e-01f, 1.778279394e-01f, 1.000000015e-01f, 5.623413250e-02f, 3.162277490e-02f, 1.778279431e-02f,
    9.999999776e-03f, 5.623413250e-03f, 3.162277630e-03f, 1.778279431e-03f, 1.000000047e-03f, 5.623413017e-04f, 3.162277571e-04f, 1.778279402e-04f};
__device__ const float INVF64[32] = {1.000000000e+00f, 7.498942614e-01f, 5.623413324e-01f, 4.216965139e-01f, 3.162277639e-01f, 2.371373773e-01f, 1.778279394e-01f, 1.333521307e-01f,
    1.000000015e-01f, 7.498941571e-02f, 5.623413250e-02f, 4.216965288e-02f, 3.162277490e-02f, 2.371373773e-02f, 1.778279431e-02f, 1.333521493e-02f, 9.999999776e-03f, 7.498941850e-03f,
    5.623413250e-03f, 4.216964822e-03f, 3.162277630e-03f, 2.371373586e-03f, 1.778279431e-03f, 1.333521446e-03f, 1.000000047e-03f, 7.498942432e-04f, 5.623413017e-04f, 4.216965172e-04f,
    3.162277571e-04f, 2.371373703e-04f, 1.778279402e-04f, 1.333521504e-04f};
__device__ __forceinline__ void sincos_d(double x, float& s, float& c) {
    const double twopi = 6.283185307179586476925;
    const double k = __builtin_rint(x / twopi), r = x - k * twopi, r2 = r * r;
    double st = r, ct = 1.0, ss = r, cs = 1.0;
    for (int n = 1; n <= 16; ++n) { ct *= -r2 / (double)((2 * n - 1) * (2 * n)); st *= -r2 / (double)((2 * n) * (2 * n + 1)); cs += ct; ss += st; }
    s = (float)ss; c = (float)cs;
}
__device__ __forceinline__ float absmax_n(const float* w, int n) { float m = 0.f; for (int i = 0; i < n; ++i) m = fmaxf(m, fabsf(w[i])); return m; }

typedef unsigned v4u_unused_t;
#define XB_TMO      128
#define XB_XCNT(j)  (256  + 64 * (j))
#define XB_XSUB(j)  (1280 + 64 * (j))
#define XB_XGEN(j)  (2304 + 64 * (j))
#define XB_TOP      3328
#define XB_TOPGEN   3392
#define XCD_BAR_WORDS 3456
#define XB_SPIN_CAP (1u << 18)

__device__ __forceinline__ unsigned xb_ld(unsigned* p)              { return __hip_atomic_load(p, __ATOMIC_RELAXED, __HIP_MEMORY_SCOPE_AGENT); }
__device__ __forceinline__ unsigned xb_add(unsigned* p, unsigned v) { return __hip_atomic_fetch_add(p, v, __ATOMIC_RELAXED, __HIP_MEMORY_SCOPE_AGENT); }
__device__ __forceinline__ unsigned xb_xcc_id() { return (unsigned)__builtin_amdgcn_s_getreg((3 << 11) | 20) & 0xFu; }
#define XB_SPIN(cond, bar) do { unsigned _sp = 0; while (cond) { __builtin_amdgcn_s_sleep(1); \
    if ((++_sp & 255u) == 0u) { if (xb_ld(&(bar)[XB_TMO])) break; if (_sp > XB_SPIN_CAP) { atomicAdd(&(bar)[XB_TMO], 1u); break; } } } } while (0)

struct XcdBarrier {
    unsigned* bar; unsigned x;
    volatile LAS unsigned* st;
};

__device__ __forceinline__ XcdBarrier xcd_barrier_post(unsigned* bar, volatile LAS unsigned* st) {
    XcdBarrier b; b.bar = bar; b.x = xb_xcc_id(); b.st = st;
    if (threadIdx.x == 0) (void)xb_add(&bar[XB_XCNT(b.x)], 1u);
    return b;
}
__device__ __forceinline__ void xcd_barrier_complete(unsigned* bar, unsigned x, unsigned& nloc, unsigned& nx) {
    const unsigned G = gridDim.x * gridDim.y * gridDim.z;
    unsigned sum, cnt, mine, sp = 0u;
    for (;;) {
        sum = 0u; cnt = 0u; mine = 0u;
#pragma unroll
        for (unsigned j = 0; j < 16; ++j) { const unsigned c = xb_ld(&bar[XB_XCNT(j)]); sum += c; cnt += (c > 0u) ? 1u : 0u; mine = (j == x) ? c : mine; }
        if (sum == G) break;
        __builtin_amdgcn_s_sleep(1);
        if ((++sp & 255u) == 0u) { if (xb_ld(&bar[XB_TMO])) break; if (sp > XB_SPIN_CAP) { atomicAdd(&bar[XB_TMO], 1u); break; } }
    }
    nloc = mine > 0u ? mine : 1u; nx = cnt > 0u ? cnt : 1u;
}

__device__ __forceinline__ void xcd_barrier(const XcdBarrier& b) {
    asm volatile("s_waitcnt vmcnt(0)" ::: "memory");
    __syncthreads();
    if (threadIdx.x == 0) {
        unsigned* bar = b.bar;
        __builtin_amdgcn_s_waitcnt(0);
        unsigned nloc = b.st[0], nx = b.st[1];
        if (nloc == 0u) { xcd_barrier_complete(bar, b.x, nloc, nx); b.st[0] = nloc; b.st[1] = nx; }
        const unsigned old = xb_add(&bar[XB_XSUB(b.x)], 1u);
        const unsigned gen = old / nloc;
        if (old + 1u == (gen + 1u) * nloc) {
            __builtin_amdgcn_fence(__ATOMIC_RELEASE, "agent");
            asm volatile("s_waitcnt vmcnt(0)" ::: "memory");
            const unsigned og = xb_add(&bar[XB_TOP], 1u);
            const unsigned tg = og / nx;
            if (og + 1u == (tg + 1u) * nx) xb_add(&bar[XB_TOPGEN], 1u);
            else XB_SPIN(xb_ld(&bar[XB_TOPGEN]) == tg, bar);
            __builtin_amdgcn_fence(__ATOMIC_ACQUIRE, "agent");
            xb_add(&bar[XB_XGEN(b.x)], 1u);
            asm volatile("s_waitcnt vmcnt(0)" ::: "memory");
        } else {
            XB_SPIN(xb_ld(&bar[XB_XGEN(b.x)]) == gen, bar);
            __builtin_amdgcn_fence(__ATOMIC_ACQUIRE, "agent");
            asm volatile("s_waitcnt vmcnt(0)" ::: "memory");
        }
    }
    __syncthreads();
}

struct Args { const float* in[29]; float* out; unsigned char* ws; int ph_lo, ph_hi, coop, pad; };

__global__ void __launch_bounds__(512, 2) mega_fwd(Args args) {
    extern __shared__ __attribute__((aligned(16))) unsigned char lds_raw[];
    LAS unsigned char* lds = (LAS unsigned char*)lds_raw;
    const int G = gridDim.x, bx = blockIdx.x;
    const int vcu = (G % 8 == 0) ? (bx % 8) * (G / 8) + bx / 8 : bx;
    unsigned char* ws = args.ws;
    float* MOD = (float*)(ws + WS_MOD);
    float* TC64 = (float*)(ws + WS_TC64); float* TS64 = (float*)(ws + WS_TS64); float* TC128 = (float*)(ws + WS_TC128); float* TS128 = (float*)(ws + WS_TS128);
    float* LAM = (float*)(ws + WS_LAM);
    bf16_t* WIN = (bf16_t*)(ws + WS_WIN); bf16_t* WUP = (bf16_t*)(ws + WS_WUP); bf16_t* WBR = (bf16_t*)(ws + WS_WBR); bf16_t* WOUT = (bf16_t*)(ws + WS_WOUT);
    bf16_t* H = (bf16_t*)(ws + WS_H); bf16_t* QA = (bf16_t*)(ws + WS_QA); bf16_t* KA = (bf16_t*)(ws + WS_KA); bf16_t* VA = (bf16_t*)(ws + WS_VA);
    bf16_t* QB = (bf16_t*)(ws + WS_QB); bf16_t* KB = (bf16_t*)(ws + WS_KB); bf16_t* CKV = (bf16_t*)(ws + WS_CKV); bf16_t* VB = (bf16_t*)(ws + WS_VB);
    bf16_t* QC = (bf16_t*)(ws + WS_QC); bf16_t* KC = (bf16_t*)(ws + WS_KC); bf16_t* VC = (bf16_t*)(ws + WS_VC);
    bf16_t* GATE = (bf16_t*)(ws + WS_GATE); bf16_t* MRG = (bf16_t*)(ws + WS_MRG); bf16_t* BR = (bf16_t*)(ws + WS_BR); bf16_t* Y = (bf16_t*)(ws + WS_Y);
    float* SS = (float*)(ws + WS_SS); float* CTXW = (float*)(ws + WS_CTXW); float* SCR = (float*)(ws + WS_SCR);
    LAS float* xch = (LAS float*)(lds + XCH_OFF);
    volatile LAS unsigned* bst = (volatile LAS unsigned*)(lds + XCH_OFF + 4096);
    if (threadIdx.x < 2) bst[threadIdx.x] = 0u;
    __syncthreads();
    XcdBarrier bar = xcd_barrier_post((unsigned*)(ws + WS_BAR), bst);

    for (int ph = args.ph_lo; ph < args.ph_hi; ++ph) {
        int tid = threadIdx.x; asm volatile("" : "+v"(tid));
        const int lane = tid & 63, wave = __builtin_amdgcn_readfirstlane(tid >> 6);
        if (ph == 0 && (MK_MASK & 1)) {
            {
                LAS float* sc = (LAS float*)lds;
                LAS float* red = (LAS float*)(lds + 65536);
                for (int i = tid; i < 5 * DM; i += 512) { const float v = i < 4 * DM ? args.in[1][i] : args.in[3][i - 4 * DM]; sc[i] = silu_f(v); }
                __syncthreads();
                for (int it = bx; it < DEPTH * 96; it += G) {
                    const int l = it / 96, n0 = (it % 96) * 64;
                    const float* W = args.in[5] + (size_t)l * DM * 6144 + n0 + lane;
                    float a0 = 0.f, a1 = 0.f, a2 = 0.f, a3 = 0.f, a4 = 0.f;
                    const int kb = wave * 256;
#pragma unroll 8
                    for (int k = 0; k < 256; ++k) { const float wv = W[(size_t)(kb + k) * 6144];
                        a0 += sc[kb + k] * wv; a1 += sc[DM + kb + k] * wv; a2 += sc[2 * DM + kb + k] * wv; a3 += sc[3 * DM + kb + k] * wv; a4 += sc[4 * DM + kb + k] * wv; }
                    red[(wave * 5 + 0) * 64 + lane] = a0; red[(wave * 5 + 1) * 64 + lane] = a1; red[(wave * 5 + 2) * 64 + lane] = a2; red[(wave * 5 + 3) * 64 + lane] = a3; red[(wave * 5 + 4) * 64 + lane] = a4;
                    __syncthreads();
                    if (tid < 320) { const int i = tid >> 6; float s = 0.f;
                        for (int w8 = 0; w8 < 8; ++w8) s += red[(w8 * 5 + i) * 64 + lane];
                        MOD[((size_t)l * 5 + i) * 6144 + n0 + lane] = s + args.in[6][(size_t)l * 6144 + n0 + lane]; }
                    __syncthreads();
                }
            }
            if (bx == 1 % G) {
                for (int i = tid; i < 64 * 16; i += 512) { const int pos = i >> 4, f = i & 15; const float ang = (float)pos * INVF32[f]; float s, c; sincos_d((double)ang, s, c); TC64[i] = c; TS64[i] = s; }
                for (int i = tid; i < 64 * 32; i += 512) { const int pos = i >> 5, f = i & 31; const float ang = (float)pos * INVF64[f]; float s, c; sincos_d((double)ang, s, c); TC128[i] = c; TS128[i] = s; }
            }
            if (bx == 2 % G && tid < DEPTH) {
                const int l = tid;
                float s1 = 0.f, s2 = 0.f;
                for (int i = 0; i < 64; ++i) { s1 += args.in[20][l * 64 + i] * args.in[21][l * 64 + i]; s2 += args.in[22][l * 64 + i] * args.in[23][l * 64 + i]; }
                const float lam_init = 0.8f - 0.6f * expf(-0.3f * (float)l);
                LAM[l * 4 + 0] = expf(s1) - expf(s2) + lam_init;
                const float mAq = absmax_n(args.in[9] + l * 128, 128), mAk = absmax_n(args.in[10] + l * 128, 128);
                const float mBqn = absmax_n(args.in[11] + l * 128, 128), mBqr = absmax_n(args.in[12] + l * 64, 64), mBkn = absmax_n(args.in[16] + l * 128, 128), mBkr = absmax_n(args.in[17] + l * 64, 64);
                const float mCq = absmax_n(args.in[18] + l * 64, 64), mCk = absmax_n(args.in[19] + l * 64, 64);
                const float L2E = 1.4426950408889634f;
                LAM[l * 4 + 1] = -(sqrtf(128.f) * mAq * mAk) * L2E;
                LAM[l * 4 + 2] = -(sqrtf(128.f * mBqn * mBqn + 64.f * mBqr * mBqr) * sqrtf(128.f * mBkn * mBkn + 64.f * mBkr * mBkr) * 0.07216878364870323f) * L2E;
                LAM[l * 4 + 3] = -(8.f * mCq * mCk) * L2E;
            }
            __syncthreads();
            {
                LAS float* scr = (LAS float*)(lds + wave * 16640);
                const int gw = vcu * 8 + wave, NGW = G * 8;
                constexpr int I_IN = 32 * (NIN / 64), I_UP = 8 * 32, I_BR = 3 * 16 * 32, I_OUT = 32 * 32, I_L = I_IN + I_UP + I_BR + I_OUT;
                const int n4 = (lane & 15) * 4;
                for (int it = gw; it < DEPTH * I_L; it += NGW) {
                    const int l = it / I_L; int r = it % I_L;
                    if (r < I_IN) { const int nb = r % (NIN / 64), kb = r / (NIN / 64); const int n0 = nb * 64;
                        transpose_item(args.in[7] + (size_t)l * DM * INC, INC, kb * 64, in_src_col(n0 + n4), nullptr, WIN + (size_t)l * NIN * DM, DM, n0, 0, scr, lane); continue; }
                    r -= I_IN;
                    if (r < I_UP) { const int nb = r % 32, kb = r / 32; const int n0 = nb * 64; const int sc_ = up_src_col(n0 + n4);
                        const float* W = (sc_ < 1024 ? args.in[14] : args.in[15]) + (size_t)l * 512 * 1024;
                        transpose_item(W, 1024, kb * 64, sc_ & 1023, args.in[13] + l * 512, WUP + (size_t)l * 2048 * 512, 512, n0, 0, scr, lane); continue; }
                    r -= I_UP;
                    if (r < I_BR) { const int br = r / (16 * 32), r2 = r % (16 * 32); const int nb = r2 % 32, kb = r2 / 32; const int n0 = nb * 64;
                        transpose_item(args.in[25 + br] + (size_t)l * 1024 * DM, DM, kb * 64, n0 + n4, nullptr, WBR + (size_t)l * 2048 * 3072, 3072, n0, br * 1024, scr, lane); continue; }
                    r -= I_BR;
                    { const int nb = r % 32, kb = r / 32; const int n0 = nb * 64;
                      transpose_item(args.in[28] + (size_t)l * DM * DM, DM, kb * 64, n0 + n4, nullptr, WOUT + (size_t)l * DM * DM, DM, n0, 0, scr, lane); }
                }
            }
        } else {
            const int l = (ph - 1) / PPL, st_ = (ph - 1) % PPL, st = (MK_REP_ST >= 0 && st_ > MK_REP_ST) ? st_ - 1 : st_;
            const float* xsrc = (l == 0) ? args.in[0] : args.out;
            const float* csrc = (l == 0) ? args.in[2] : CTXW;
            const float* modl = MOD + (size_t)l * 5 * 6144;
            const int Mrows = (l == DEPTH - 1) ? MLAT : MTOT;
            if (st == 0 && (MK_MASK & 2)) {
                const float* nw = args.in[4] + (size_t)l * DM;
                for (int row = bx * 8 + wave; row < MTOT; row += G * 8) {
                    const bool lat = row < MLAT; const int mi = lat ? (row >> 12) : 4;
                    const f32x4* xr = (const f32x4*)(lat ? xsrc + (size_t)row * DM : csrc + (size_t)(row - MLAT) * DM) + lane;
                    f32x4 v[8]; float s = 0.f;
#pragma unroll
                    for (int j = 0; j < 8; ++j) { v[j] = xr[64 * j]; s += (v[j][0] * v[j][0] + v[j][1] * v[j][1]) + (v[j][2] * v[j][2] + v[j][3] * v[j][3]); }
                    const float rinv = rsqrtf(wave_sum(s) * (1.f / DM) + EPS);
                    const f32x4* sh = (const f32x4*)(modl + mi * 6144) + lane; const f32x4* scl = (const f32x4*)(modl + mi * 6144 + DM) + lane; const f32x4* nwp = (const f32x4*)nw + lane;
                    u32x2* o8 = (u32x2*)(H + (size_t)row * DM) + lane;
#pragma unroll
                    for (int j = 0; j < 8; ++j) { const f32x4 y = v[j] * rinv * nwp[64 * j] * (scl[64 * j] + 1.f) + sh[64 * j];
                        u32x2 w; w.x = cvt_pk_bf16(y[0], y[1]); w.y = cvt_pk_bf16(y[2], y[3]); o8[64 * j] = w; }
                }
            } else if (st == 1 && (MK_MASK & 4)) {
                pg8::Gemm g{H, WIN + (size_t)l * NIN * DM, MTOT, NIN, DM}; pg8::StaticOrder S; S.init(MTOT, NIN, G, bx);
                EpiIn E{QA, KA, VA, QB, KB, CKV, QC, KC, VC, GATE, MRG, SS,
                        args.in[9] + l * 128, args.in[10] + l * 128, args.in[11] + l * 128, args.in[12] + l * 64, args.in[17] + l * 64, args.in[18] + l * 64, args.in[19] + l * 64,
                        args.in[8] + (size_t)l * 6144, TC64, TS64, TC128, TS128, xch};
                pg8::gemm_phase<EpiIn>(lds, g, S, E, tid);
            } else if (st == 2 && (MK_MASK & 8)) {
                pg8::Gemm g{CKV, WUP + (size_t)l * 2048 * 512, MTOT, 2048, 512}; pg8::StaticOrder S; S.init(MTOT, 2048, G, bx);
                EpiUp E{KB, VB, SS, args.in[16] + l * 128, xch};
                pg8::gemm_phase<EpiUp>(lds, g, S, E, tid);
            } else if (st == 3 && (MK_MASK & 16)) {
                AttnBufs T{QA, KA, VA, QB, KB, VB, QC, KC, VC, GATE, BR, SCR, LAM + l * 4, args.in[24] + l * 128, 0.8f - 0.6f * expf(-0.3f * (float)l)};
                const int nctx = (l < DEPTH - 1) ? 96 : 0;
                for (int k = 0;; ++k) {
                    int type, b, h, qrow0, NT;
                    if (G == 256) {
                        if (k < 6) { const int id = (k & 1) * 256 + vcu; type = k >> 1; b = id >> 7; h = (id >> 4) & 7; qrow0 = b * SEQ + (id & 15) * 256; NT = 68; }
                        else if (k == 6 && bx < nctx) { type = bx >> 5; b = (bx >> 3) & 3; h = bx & 7; qrow0 = MLAT + b * CTXL; NT = 4; }
                        else break;
                    } else {
                        const int it = bx + k * G; if (it >= 1536 + nctx) break;
                        if (it < 1536) { const int id = it & 511; type = it >> 9; b = id >> 7; h = (id >> 4) & 7; qrow0 = b * SEQ + (id & 15) * 256; NT = 68; }
                        else { const int c = it - 1536; type = c >> 5; b = (c >> 3) & 3; h = c & 7; qrow0 = MLAT + b * CTXL; NT = 4; }
                    }
                    attn_item(T, type, b, h, qrow0, NT, (LAS char*)lds, tid);
                }
                __syncthreads();
            } else if (st == 4 && (MK_MASK & 32)) {
                pg8::Gemm g{BR, WBR + (size_t)l * 2048 * 3072, Mrows, 2048, 3072}; pg8::StaticOrder S; S.init(Mrows, 2048, G, bx);
                EpiBr E{MRG, Y};
                pg8::gemm_phase<EpiBr>(lds, g, S, E, tid);
            } else if (MK_MASK & 64) {
                pg8::Gemm g{Y, WOUT + (size_t)l * DM * DM, Mrows, DM, DM}; pg8::StaticOrder S; S.init(Mrows, DM, G, bx);
                EpiOut E{xsrc, csrc, args.out, CTXW, modl};
                pg8::gemm_phase<EpiOut>(lds, g, S, E, tid);
            }
        }
        if (ph + 1 < args.ph_hi) { if (args.coop) { if (ph == 0) cg::this_grid().sync(); else xcd_barrier(bar); } }
    }
}

extern "C" void kernel_launch(void* const* d_in, const int* in_sizes, int n_in, void* d_out, int out_size, void* d_ws, size_t ws_size, hipStream_t stream) {
    static int grid = 0;
    if (grid == 0) {
        if (n_in != 29 || in_sizes[0] != MLAT * DM || out_size != MLAT * DM || ws_size < WS_END) {
            fprintf(stderr, "kernel_launch: unexpected shapes: n_in %d in0 %d out %d ws %zu (need %zu)\n", n_in, n_in > 0 ? in_sizes[0] : -1, out_size, ws_size, (size_t)WS_END); grid = -1; return; }
        int dev = 0, cus = 0, per_cu = 0;
        if (hipGetDevice(&dev) != hipSuccess || hipDeviceGetAttribute(&cus, hipDeviceAttributeMultiprocessorCount, dev) != hipSuccess) { grid = -1; return; }
        if (hipFuncSetAttribute((const void*)mega_fwd, hipFuncAttributeMaxDynamicSharedMemorySize, LDS_BYTES) != hipSuccess) { fprintf(stderr, "kernel_launch: hipFuncSetAttribute failed\n"); grid = -1; return; }
        if (hipOccupancyMaxActiveBlocksPerMultiprocessor(&per_cu, (const void*)mega_fwd, 512, LDS_BYTES) != hipSuccess || per_cu < 1) { fprintf(stderr, "kernel_launch: occupancy query gives %d\n", per_cu); per_cu = 1; }
        (void)hipGetLastError();
        grid = cus * 1;
    }
    if (grid < 0) return;
    Args a{};
    for (int i = 0; i < 29; ++i) a.in[i] = (const float*)d_in[i];
    a.out = (float*)d_out; a.ws = (unsigned char*)d_ws;
#if MK_COOP
    if (hipMemsetAsync((char*)d_ws + WS_BAR, 0, 16384, stream) != hipSuccess) { fprintf(stderr, "kernel_launch: memset of the barrier words failed\n"); return; }
    a.ph_lo = 0; a.ph_hi = NPH; a.coop = 1;
    void* kargs[] = {&a};
    hipError_t e = hipLaunchCooperativeKernel((const void*)mega_fwd, dim3(grid), dim3(512), kargs, LDS_BYTES, stream);
    if (e != hipSuccess) fprintf(stderr, "kernel_launch: cooperative launch failed: %s (grid %d)\n", hipGetErrorString(e), grid);
#else
    for (int ph = 0; ph < NPH; ++ph) {
        a.ph_lo = ph; a.ph_hi = ph + 1; a.coop = 0;
        hipLaunchKernelGGL(mega_fwd, dim3(grid), dim3(512), LDS_BYTES, stream, a);
    }
    const hipError_t le = hipPeekAtLastError();
    if (le != hipSuccess) fprintf(stderr, "kernel_launch: launch failed: %s\n", hipGetErrorName(le));
#endif
}
```

```cpp
#include <hip/hip_runtime.h>
#include <hip/hip_cooperative_groups.h>
#include <cstdio>
#include <cstdint>
namespace cg = cooperative_groups;

#ifndef MK_MASK
#define MK_MASK 127
#endif
#ifndef MK_ATYPE
#define MK_ATYPE 7
#endif
#ifndef MK_G1T
#define MK_G1T 127
#endif
#ifndef ATT_SD_A
#define ATT_SD_A 2
#endif
#ifndef ATT_SD_B
#define ATT_SD_B 1
#endif
#ifndef ATT_SD_C
#define ATT_SD_C 2
#endif
#ifndef ATT_DBL_B
#define ATT_DBL_B true
#endif
#ifndef ATT_DBL
#define ATT_DBL false
#endif
#ifndef QKT_GRP
#define QKT_GRP 0
#endif
#ifndef MK_COOP
#define MK_COOP 1
#endif

#define LAS __attribute__((address_space(3)))
typedef unsigned short bf16_t;
typedef short bf16x8 __attribute__((ext_vector_type(8)));
typedef short s16x4 __attribute__((ext_vector_type(4)));
typedef float f32x4 __attribute__((ext_vector_type(4)));
typedef float f32x16 __attribute__((ext_vector_type(16)));
typedef unsigned u32x4 __attribute__((ext_vector_type(4)));
typedef unsigned u32x2 __attribute__((ext_vector_type(2)));

constexpr int DM = 2048, NBATCH = 4, SEQ = 4096, CTXL = 256, DEPTH = 4;
constexpr int MLAT = NBATCH * SEQ, MCTX = NBATCH * CTXL, MTOT = MLAT + MCTX;
constexpr int INC = 15936, NIN = 16128;
constexpr float EPS = 1e-6f;
#ifndef MK_REP_ST
#define MK_REP_ST -1
#endif
constexpr int PPL = 6 + (MK_REP_ST >= 0 ? 1 : 0);
constexpr int NPH = 1 + PPL * DEPTH;

constexpr size_t alignup(size_t x) { return (x + 255) / 256 * 256; }
constexpr size_t WS_MOD = 0;
constexpr size_t WS_TC64 = WS_MOD + alignup((size_t)DEPTH * 5 * 6144 * 4);
constexpr size_t WS_TS64 = WS_TC64 + 4096, WS_TC128 = WS_TS64 + 4096, WS_TS128 = WS_TC128 + 8192;
constexpr size_t WS_LAM = WS_TS128 + 8192;
constexpr size_t WS_BAR = WS_LAM + 256;
constexpr size_t WS_WIN = WS_BAR + 16384;
constexpr size_t WS_WUP = WS_WIN + (size_t)DEPTH * NIN * DM * 2;
constexpr size_t WS_WBR = WS_WUP + (size_t)DEPTH * 2048 * 512 * 2;
constexpr size_t WS_WOUT = WS_WBR + (size_t)DEPTH * 2048 * 3072 * 2;
constexpr size_t WS_H = WS_WOUT + (size_t)DEPTH * 2048 * 2048 * 2;
constexpr size_t WS_QA = WS_H + (size_t)MTOT * 2048 * 2;
constexpr size_t WS_KA = WS_QA + (size_t)MTOT * 1024 * 2;
constexpr size_t WS_VA = WS_KA + (size_t)MTOT * 256 * 2;
constexpr size_t WS_QB = WS_VA + (size_t)MTOT * 256 * 2;
constexpr size_t WS_KB = WS_QB + (size_t)MTOT * 1536 * 2;
constexpr size_t WS_CKV = WS_KB + (size_t)MTOT * 1536 * 2;
constexpr size_t WS_VB = WS_CKV + (size_t)MTOT * 512 * 2;
constexpr size_t WS_QC = WS_VB + (size_t)MTOT * 1024 * 2;
constexpr size_t WS_KC = WS_QC + (size_t)MTOT * 1024 * 2;
constexpr size_t WS_VC = WS_KC + (size_t)MTOT * 1024 * 2;
constexpr size_t WS_GATE = WS_VC + (size_t)MTOT * 1024 * 2;
constexpr size_t WS_MRG = WS_GATE + (size_t)MTOT * 3072 * 2;
constexpr size_t WS_BR = WS_MRG + (size_t)MTOT * 6144 * 2;
constexpr size_t WS_Y = WS_BR + (size_t)MTOT * 3072 * 2;
constexpr size_t WS_SS = WS_Y + (size_t)MTOT * 2048 * 2;
constexpr size_t WS_CTXW = WS_SS + (size_t)MTOT * 8 * 4;
constexpr size_t WS_SCR = WS_CTXW + (size_t)MCTX * DM * 4;
constexpr size_t WS_END = WS_SCR + (size_t)256 * 64 * 512 * 4;

constexpr int RING_BYTES = 131072, XCH_OFF = RING_BYTES, LDS_BYTES = 147456;

__device__ __forceinline__ float bf2f(unsigned h) { return __uint_as_float(h << 16); }
__device__ __forceinline__ unsigned cvt_pk_bf16(float lo, float hi) { unsigned r; asm volatile("v_cvt_pk_bf16_f32 %0, %1, %2" : "=v"(r) : "v"(lo), "v"(hi)); return r; }
__device__ __forceinline__ float wave_sum(float v) {
#pragma unroll
    for (int o = 1; o < 64; o <<= 1) v += __shfl_xor(v, o);
    return v;
}
__device__ __forceinline__ float sigm_f(float x) { return __builtin_amdgcn_rcpf(1.f + __builtin_amdgcn_exp2f(-1.4426950408889634f * x)); }
__device__ __forceinline__ float silu_f(float x) { return x * sigm_f(x); }
__device__ __forceinline__ unsigned cvt_pk_bf16_safe(float lo, float hi) { unsigned r; asm volatile("s_nop 1\n\tv_cvt_pk_bf16_f32 %0, %1, %2" : "=v"(r) : "v"(lo), "v"(hi)); return r; }
__device__ __forceinline__ void store8_safe(bf16_t* p, f32x4 a, f32x4 b) {
    u32x4 w; w.x = cvt_pk_bf16_safe(a[0], a[1]); w.y = cvt_pk_bf16_safe(a[2], a[3]); w.z = cvt_pk_bf16_safe(b[0], b[1]); w.w = cvt_pk_bf16_safe(b[2], b[3]);
    *(u32x4*)p = w;
}
__device__ __forceinline__ void store8(bf16_t* p, f32x4 a, f32x4 b) {
    u32x4 w; w.x = cvt_pk_bf16(a[0], a[1]); w.y = cvt_pk_bf16(a[2], a[3]); w.z = cvt_pk_bf16(b[0], b[1]); w.w = cvt_pk_bf16(b[2], b[3]);
    *(u32x4*)p = w;
}

namespace pg8 {
constexpr int BM = 256, BK = 64, HALF = 128, HTB = HALF * BK * 2, NXCD = 8, WGM = 8;
__host__ __device__ __forceinline__ int lds_byte(int r, int c) { const int st = (r >> 4) * 2 + (c >> 5), rr = r & 15, cc = c & 31, ob = rr * 64 + cc * 2; return st * 1024 + (ob ^ (((ob >> 9) & 1) << 5)); }
__host__ __device__ __forceinline__ void stage_rc(int b, int& R, int& C) { const int st = b / 1024, sb = b % 1024, swz = sb ^ (((sb >> 9) & 1) << 5); R = (st >> 1) * 16 + swz / 64; C = (st & 1) * 32 + (swz % 64) / 2; }
__host__ __device__ __forceinline__ int perm32(int rho) { const int n = rho >> 4, i = rho & 15; return 8 * (i >> 2) + 4 * n + (i & 3); }

struct Unit { int pm, pn; };
struct Gemm { const bf16_t* A; const bf16_t* Bt; int M, N, K; };
struct StaticOrder {
    int nM, nN, nwg, G, c;
    __device__ void init(int M, int N, int G_, int c_) { nM = M / BM; nN = N / BM; nwg = nM * nN; G = G_; c = c_; }
    __device__ bool next(int i, Unit& u) const {
        const long L = (long)i * G + c; if (L >= nwg) return false;
        int wgid = (int)L; { const int q = nwg / NXCD, r = nwg % NXCD, xcd = wgid % NXCD, off = wgid / NXCD; wgid = (xcd < r ? xcd * (q + 1) : r * (q + 1) + (xcd - r) * q) + off; }
        const int nig = WGM * nN, gid = wgid / nig, fm = gid * WGM, gsz = (nM - fm) < WGM ? (nM - fm) : WGM;
        u.pm = fm + ((wgid % nig) % gsz); u.pn = (wgid % nig) / gsz; return true;
    }
};

template <class Epi>
__device__ __forceinline__ void gemm_phase(LAS unsigned char* lds, const Gemm g, const StaticOrder& S, const Epi& E, const int tid) {
    const int wid = __builtin_amdgcn_readfirstlane(tid >> 6), lane = tid & 63, wr = wid >> 2, wc = wid & 3, fr = lane & 15, fq = lane >> 4;
    const int K = g.K, nt = K / BK;
    unsigned voffA[2], voffB[2];
#pragma unroll
    for (int i = 0; i < 2; ++i) { int R, C; stage_rc(tid * 16 + i * 8192, R, C); const int Rb = (R & ~31) + perm32(R & 31);
        voffA[i] = (unsigned)(R * K + C) * 2u; voffB[i] = (unsigned)(Rb * K + C) * 2u; }
    const size_t kstep = (size_t)(BK * 2);
    const size_t hstep = (size_t)HALF * K * 2;
    const size_t tstep = 2 * hstep;
    const unsigned ldsw = (unsigned)wid * 1024u;
    const int aoff = lds_byte(wr * 64 + fr, fq * 8), boff = lds_byte(wc * 32 + fr, fq * 8);
#define PG8_SA(b, h) (((b) * 2 + (h)) * HTB)
#define PG8_SB(b, h) ((4 + (b) * 2 + (h)) * HTB)
#define PG8_STAGE(bufoff, gbase, voff) do { _Pragma("unroll") for (int _i = 0; _i < 2; ++_i) \
        __builtin_amdgcn_global_load_lds((const unsigned*)((const char*)(gbase) + (voff)[_i]), (LAS unsigned*)(lds + (bufoff) + ldsw + _i * 8192), 16, 0, 0); } while (0)
#define PG8_LDA(dst, b, h) do { _Pragma("unroll") for (int m = 0; m < 4; ++m) _Pragma("unroll") for (int k = 0; k < 2; ++k) dst[m][k] = *(const LAS bf16x8*)(lds + PG8_SA(b, h) + aoff + m * 2048 + k * 1024); } while (0)
#define PG8_LDB(dst, b, h) do { _Pragma("unroll") for (int n = 0; n < 2; ++n) _Pragma("unroll") for (int k = 0; k < 2; ++k) dst[n][k] = *(const LAS bf16x8*)(lds + PG8_SB(b, h) + boff + n * 2048 + k * 1024); } while (0)
#define PG8_MMA(ai, bj, At, Bt) do { __builtin_amdgcn_s_setprio(1); _Pragma("unroll") for (int m = 0; m < 4; ++m) _Pragma("unroll") for (int n = 0; n < 2; ++n) _Pragma("unroll") for (int k = 0; k < 2; ++k) \
        acc[ai][bj][m][n] = __builtin_amdgcn_mfma_f32_16x16x32_bf16(Bt[n][k], At[m][k], acc[ai][bj][m][n], 0, 0, 0); __builtin_amdgcn_s_setprio(0); } while (0)
#define PG8_WAIT_V(n) asm volatile("s_waitcnt vmcnt(" #n ")" ::: "memory")
#define PG8_WAIT_L(n) asm volatile("s_waitcnt lgkmcnt(" #n ")" ::: "memory")
#define PG8_BAR __builtin_amdgcn_s_barrier()
#define PG8_SCHED __builtin_amdgcn_sched_barrier(0)
    Unit cur, nxt; int ui = 0;
    if (!S.next(0, cur)) return;
    f32x4 acc[2][2][4][2];
#pragma unroll
    for (int a = 0; a < 2; ++a)
#pragma unroll
        for (int b = 0; b < 2; ++b)
#pragma unroll
            for (int m = 0; m < 4; ++m)
#pragma unroll
                for (int n = 0; n < 2; ++n) acc[a][b][m][n] = (f32x4){0.f, 0.f, 0.f, 0.f};
    bf16x8 At[4][2], B0[2][2], B1[2][2];
    const char* cA = (const char*)g.A + (size_t)cur.pm * tstep; const char* cB = (const char*)g.Bt + (size_t)cur.pn * tstep;
    PG8_STAGE(PG8_SB(0, 0), cB, voffB); PG8_STAGE(PG8_SB(0, 1), cB + hstep, voffB); PG8_STAGE(PG8_SA(0, 0), cA, voffA); PG8_STAGE(PG8_SA(0, 1), cA + hstep, voffA);
    if (wr == 1) PG8_BAR;
    PG8_WAIT_V(2); PG8_BAR;
    PG8_STAGE(PG8_SB(1, 0), cB + kstep, voffB); PG8_STAGE(PG8_SA(1, 0), cA + kstep, voffA); PG8_STAGE(PG8_SB(1, 1), cB + hstep + kstep, voffB);
    PG8_WAIT_V(6); PG8_BAR;
    for (;;) {
        const bool has_next = S.next(ui + 1, nxt);
        const char* nA = has_next ? (const char*)g.A + (size_t)nxt.pm * tstep : cA; const char* nB = has_next ? (const char*)g.Bt + (size_t)nxt.pn * tstep : cB;
        for (int t = 0; t < nt; t += 2) {
            const bool last = (t == nt - 2);
            const char* a1 = cA + (size_t)(t + 1) * kstep;
            const char* a2 = last ? nA : cA + (size_t)(t + 2) * kstep; const char* b2 = last ? nB : cB + (size_t)(t + 2) * kstep;
            const char* a3 = a2 + kstep; const char* b3 = b2 + kstep;
            if constexpr (Epi::MID) { if (t == 16 || t == 32) { int fr_ = fr, fq_ = fq, wr_ = wr, wc_ = wc;
                asm volatile("" : "+v"(fr_), "+v"(fq_)); asm volatile("" : "+s"(wr_), "+s"(wc_));
                E.mid(acc, cur, t >> 4, wr_, wc_, fr_, fq_); PG8_WAIT_V(0); PG8_SCHED; } }
            PG8_LDB(B0, 0, 0); PG8_LDB(B1, 0, 1); PG8_SCHED; PG8_LDA(At, 0, 0); PG8_STAGE(PG8_SA(1, 1), a1 + hstep, voffA);
            PG8_WAIT_V(8); PG8_WAIT_L(0); PG8_BAR; PG8_MMA(0, 0, At, B0); PG8_MMA(0, 1, At, B1); PG8_BAR; PG8_SCHED;
            PG8_LDA(At, 0, 1); PG8_STAGE(PG8_SB(0, 0), b2, voffB); PG8_STAGE(PG8_SB(0, 1), b2 + hstep, voffB); PG8_STAGE(PG8_SA(0, 0), a2, voffA);
            PG8_WAIT_V(8); PG8_WAIT_L(0); PG8_BAR; PG8_MMA(1, 0, At, B0); PG8_MMA(1, 1, At, B1); PG8_BAR; PG8_SCHED;
            PG8_LDB(B0, 1, 0); PG8_LDB(B1, 1, 1); PG8_SCHED; PG8_LDA(At, 1, 0); PG8_STAGE(PG8_SA(0, 1), a2 + hstep, voffA);
            PG8_WAIT_V(8); PG8_WAIT_L(0); PG8_BAR; PG8_MMA(0, 0, At, B0); PG8_MMA(0, 1, At, B1); PG8_BAR; PG8_SCHED;
            PG8_LDA(At, 1, 1); PG8_STAGE(PG8_SB(1, 0), b3, voffB); PG8_STAGE(PG8_SB(1, 1), b3 + hstep, voffB); PG8_STAGE(PG8_SA(1, 0), a3, voffA);
            PG8_WAIT_V(8); PG8_WAIT_L(0); PG8_BAR; PG8_MMA(1, 0, At, B0); PG8_MMA(1, 1, At, B1); PG8_BAR; PG8_SCHED;
        }
        if (wr == 0) PG8_BAR;
        { int fr_ = fr, fq_ = fq, wr_ = wr, wc_ = wc, wid_ = wid;
          asm volatile("" : "+v"(fr_), "+v"(fq_)); asm volatile("" : "+s"(wr_), "+s"(wc_), "+s"(wid_));
          E(acc, cur, wr_, wc_, fr_, fq_, wid_); }
        if (!has_next) break;
#pragma unroll
        for (int a = 0; a < 2; ++a)
#pragma unroll
            for (int b = 0; b < 2; ++b)
#pragma unroll
                for (int m = 0; m < 4; ++m)
#pragma unroll
                    for (int n = 0; n < 2; ++n) acc[a][b][m][n] = (f32x4){0.f, 0.f, 0.f, 0.f};
        cur = nxt; cA = nA; cB = nB; ++ui;
        if (wr == 1) PG8_BAR;
    }
    PG8_WAIT_V(0);
    PG8_BAR;
#undef PG8_SA
#undef PG8_SB
#undef PG8_STAGE
#undef PG8_LDA
#undef PG8_LDB
#undef PG8_MMA
#undef PG8_WAIT_V
#undef PG8_WAIT_L
#undef PG8_BAR
#undef PG8_SCHED
}
}
using pg8::Unit;

__device__ __forceinline__ int in_src_col(int n) {
    const int tile = n >> 8, s = n & 255, bj = s >> 7, wc = (s >> 5) & 3, c = s & 31;
    const int d128 = 64 * (wc & 1) + 32 * bj + c, g128 = wc >> 1;
    const int d64 = 32 * (c >> 4) + 16 * bj + (c & 15), g64 = wc;
    if (tile < 4) return (tile * 2 + g128) * 128 + d128;
    if (tile == 4) return 1024 + g128 * 128 + d128;
    if (tile == 5) return 1280 + s;
    if (tile < 10) return 1536 + ((tile - 6) * 2 + g128) * 192 + d128;
    if (tile < 12) return 1536 + ((tile - 10) * 4 + g64) * 192 + 128 + d64;
    if (tile < 14) return 3072 + (tile - 12) * 256 + s;
    if (tile == 14) return g64 == 0 ? 3584 + d64 : -1;
    if (tile < 19) return 3648 + ((tile - 15) * 4 + g64) * 64 + d64;
    if (tile < 23) return 4672 + ((tile - 19) * 4 + g64) * 64 + d64;
    if (tile < 27) return 5696 + (tile - 23) * 256 + s;
    if (tile < 39) return 6720 + (tile - 27) * 256 + s;
    return 9792 + (tile - 39) * 256 + s;
}
__device__ __forceinline__ int up_src_col(int n) {
    if (n >= 1024) return n;
    const int tile = n >> 8, s = n & 255, bj = s >> 7, wc = (s >> 5) & 3, c = s & 31;
    return (tile * 2 + (wc >> 1)) * 128 + 64 * (wc & 1) + 32 * bj + c;
}

template <int GS>
__device__ __forceinline__ void norm_rope_store(const f32x4 (&acc)[2][2][4][2], int pm, int wr, int wc, int fr, int fq, int wid,
                                                const float* __restrict__ w, const float* __restrict__ tcos, const float* __restrict__ tsin, bool rope,
                                                const float (&pre)[2][4], bf16_t* __restrict__ dst, int ld, int gbase, int ncopies, int copystride, LAS float* xch) {
    const int dbase = (GS == 128) ? 64 * (wc & 1) + 8 * fq : 32 * (fq >> 1) + 8 * (fq & 1);
    const int bjs = (GS == 128) ? 32 : 16;
    const int axis = (GS == 128) ? (wc & 1) : (fq >> 1);
    const int i0 = (GS == 128) ? 8 * fq : 8 * (fq & 1);
    constexpr int NF = (GS == 128) ? 32 : 16;
    const int wavebase = gbase + ((GS == 128) ? 64 * (wc & 1) : 0) + 8 * fq;
    float ssq[2][4];
#pragma unroll
    for (int ai = 0; ai < 2; ++ai)
#pragma unroll
        for (int m = 0; m < 4; ++m) {
            float s = 0.f;
#pragma unroll
            for (int bj = 0; bj < 2; ++bj)
#pragma unroll
                for (int n = 0; n < 2; ++n)
#pragma unroll
                    for (int j = 0; j < 4; ++j) { const float v = acc[ai][bj][m][n][j] * pre[ai][m]; s += v * v; }
            s += __shfl_xor(s, 16); s += __shfl_xor(s, 32);
            ssq[ai][m] = s;
        }
    if constexpr (GS == 128) {
        if (fq == 0) {
#pragma unroll
            for (int ai = 0; ai < 2; ++ai)
#pragma unroll
                for (int m = 0; m < 4; ++m) xch[wid * 128 + ai * 64 + m * 16 + fr] = ssq[ai][m];
        }
        asm volatile("s_waitcnt lgkmcnt(0)" ::: "memory"); __builtin_amdgcn_s_barrier();
#pragma unroll
        for (int ai = 0; ai < 2; ++ai)
#pragma unroll
            for (int m = 0; m < 4; ++m) ssq[ai][m] += xch[(wid ^ 1) * 128 + ai * 64 + m * 16 + fr];
    }
#pragma unroll
    for (int ai = 0; ai < 2; ++ai)
#pragma unroll
        for (int m = 0; m < 4; ++m) {
            const int rl = ai * 128 + wr * 64 + m * 16 + fr;
            const size_t row = (size_t)pm * 256 + rl;
            const float rinv = rsqrtf(ssq[ai][m] * (1.f / GS) + EPS) * pre[ai][m];
            const int t = (pm & 15) * 256 + rl; const int pos = axis ? (t & 63) : (t >> 6);
            u32x4 k0, k1;
#pragma unroll
            for (int n = 0; n < 2; ++n) {
                const f32x4 w0 = *(const f32x4*)(w + dbase + 4 * n), w1 = *(const f32x4*)(w + dbase + bjs + 4 * n);
                f32x4 y0 = acc[ai][0][m][n] * rinv * w0, y1 = acc[ai][1][m][n] * rinv * w1;
                if (rope) {
                    const f32x4 c = *(const f32x4*)(tcos + pos * NF + i0 + 4 * n), sn = *(const f32x4*)(tsin + pos * NF + i0 + 4 * n);
                    const f32x4 o0 = y0 * c - y1 * sn, o1 = y1 * c + y0 * sn;
                    y0 = o0; y1 = o1;
                }
                if (n == 0) { k0.x = cvt_pk_bf16(y0[0], y0[1]); k0.y = cvt_pk_bf16(y0[2], y0[3]); k1.x = cvt_pk_bf16(y1[0], y1[1]); k1.y = cvt_pk_bf16(y1[2], y1[3]); }
                else { k0.z = cvt_pk_bf16(y0[0], y0[1]); k0.w = cvt_pk_bf16(y0[2], y0[3]); k1.z = cvt_pk_bf16(y1[0], y1[1]); k1.w = cvt_pk_bf16(y1[2], y1[3]); }
            }
            bf16_t* p = dst + row * ld + wavebase;
            for (int cp = 0; cp < ncopies; ++cp) { *(u32x4*)(p + cp * copystride) = k0; *(u32x4*)(p + cp * copystride + 32) = k1; }
            __builtin_amdgcn_sched_barrier(0);
        }
}

struct EpiIn {
    static constexpr bool MID = false;
    bf16_t *QA, *KA, *VA, *QB, *KB, *CKV, *QC, *KC, *VC, *GATE, *MRG; float* SS;
    const float *wAq, *wAk, *wBqn, *wBqr, *wBkr, *wCq, *wCk, *bmerge;
    const float *tc64, *ts64, *tc128, *ts128;
    LAS float* xch;
    template <int ACT>
    __device__ __forceinline__ void plain(const f32x4 (&acc)[2][2][4][2], int pm, int wr, int wc, int fr, int fq, bf16_t* dst, int ld, int col0) const {
        const int colw = col0 + 32 * wc + 8 * fq;
        f32x4 b[2][2];
#pragma unroll
        for (int bj = 0; bj < 2; ++bj)
#pragma unroll
            for (int n = 0; n < 2; ++n) b[bj][n] = (ACT == 2) ? *(const f32x4*)(bmerge + colw + bj * 128 + 4 * n) : (f32x4){0.f, 0.f, 0.f, 0.f};
#pragma unroll
        for (int ai = 0; ai < 2; ++ai)
#pragma unroll
            for (int m = 0; m < 4; ++m) {
                const size_t row = (size_t)pm * 256 + ai * 128 + wr * 64 + m * 16 + fr;
#pragma unroll
                for (int bj = 0; bj < 2; ++bj) {
                    f32x4 v0 = acc[ai][bj][m][0], v1 = acc[ai][bj][m][1];
                    if (ACT == 1) { for (int j = 0; j < 4; ++j) { v0[j] = silu_f(v0[j]); v1[j] = silu_f(v1[j]); } }
                    if (ACT == 2) { v0 = v0 + b[bj][0]; v1 = v1 + b[bj][1]; for (int j = 0; j < 4; ++j) { v0[j] = sigm_f(v0[j]); v1[j] = sigm_f(v1[j]); } }
                    if (ACT == 0) store8(dst + row * ld + colw + bj * 128, v0, v1); else store8_safe(dst + row * ld + colw + bj * 128, v0, v1);
                }
                __builtin_amdgcn_sched_barrier(0);
            }
    }
    __device__ __forceinline__ void operator()(const f32x4 (&acc)[2][2][4][2], const Unit& u, int wr, int wc, int fr, int fq, int wid) const {
        const int t = u.pn, pm = u.pm; const bool rope = pm < 64;
        const float one[2][4] = {{1.f, 1.f, 1.f, 1.f}, {1.f, 1.f, 1.f, 1.f}};
        if (t < 4 && (MK_G1T & 1)) norm_rope_store<128>(acc, pm, wr, wc, fr, fq, wid, wAq, tc128, ts128, rope, one, QA, 1024, (t * 2 + (wc >> 1)) * 128, 1, 0, xch);
        else if (t == 4 && (MK_G1T & 1)) norm_rope_store<128>(acc, pm, wr, wc, fr, fq, wid, wAk, tc128, ts128, rope, one, KA, 256, (wc >> 1) * 128, 1, 0, xch);
        else if (t == 5 && (MK_G1T & 2)) plain<0>(acc, pm, wr, wc, fr, fq, VA, 256, 0);
        else if (t < 10 && (MK_G1T & 1)) norm_rope_store<128>(acc, pm, wr, wc, fr, fq, wid, wBqn, tc128, ts128, false, one, QB, 1536, ((t - 6) * 2 + (wc >> 1)) * 192, 1, 0, xch);
        else if (t < 12 && (MK_G1T & 4)) norm_rope_store<64>(acc, pm, wr, wc, fr, fq, wid, wBqr, tc64, ts64, rope, one, QB, 1536, ((t - 10) * 4 + wc) * 192 + 128, 1, 0, xch);
        else if (t < 14 && (MK_G1T & 8)) {
            plain<0>(acc, pm, wr, wc, fr, fq, CKV, 512, (t - 12) * 256);
#pragma unroll
            for (int ai = 0; ai < 2; ++ai)
#pragma unroll
                for (int m = 0; m < 4; ++m) {
                    float s = 0.f;
#pragma unroll
                    for (int bj = 0; bj < 2; ++bj)
#pragma unroll
                        for (int n = 0; n < 2; ++n)
#pragma unroll
                            for (int j = 0; j < 4; ++j) { const float v = acc[ai][bj][m][n][j]; s += v * v; }
                    s += __shfl_xor(s, 16); s += __shfl_xor(s, 32);
                    if (fq == 0) SS[((size_t)pm * 256 + ai * 128 + wr * 64 + m * 16 + fr) * 8 + (t - 12) * 4 + wc] = s;
                }
        }
        else if (t == 14 && (MK_G1T & 16)) { if (wc == 0) norm_rope_store<64>(acc, pm, wr, wc, fr, fq, wid, wBkr, tc64, ts64, rope, one, KB, 1536, 128, 8, 192, xch); }
        else if (t < 19 && (MK_G1T & 4)) norm_rope_store<64>(acc, pm, wr, wc, fr, fq, wid, wCq, tc64, ts64, rope, one, QC, 1024, ((t - 15) * 4 + wc) * 64, 1, 0, xch);
        else if (t < 23 && (MK_G1T & 4)) norm_rope_store<64>(acc, pm, wr, wc, fr, fq, wid, wCk, tc64, ts64, rope, one, KC, 1024, ((t - 19) * 4 + wc) * 64, 1, 0, xch);
        else if (t < 27 && (MK_G1T & 2)) plain<0>(acc, pm, wr, wc, fr, fq, VC, 1024, (t - 23) * 256);
        else if (t < 39 && (MK_G1T & 32)) plain<1>(acc, pm, wr, wc, fr, fq, GATE, 3072, (t - 27) * 256);
        else if (MK_G1T & 64) plain<2>(acc, pm, wr, wc, fr, fq, MRG, 6144, (t - 39) * 256);
    }
};

struct EpiUp {
    static constexpr bool MID = false;
    bf16_t *KB, *VB; const float* SS; const float* wBkn; LAS float* xch;
    __device__ __forceinline__ void operator()(const f32x4 (&acc)[2][2][4][2], const Unit& u, int wr, int wc, int fr, int fq, int wid) const {
        const int t = u.pn, pm = u.pm;
        float pre[2][4];
#pragma unroll
        for (int ai = 0; ai < 2; ++ai)
#pragma unroll
            for (int m = 0; m < 4; ++m) {
                const size_t row = (size_t)pm * 256 + ai * 128 + wr * 64 + m * 16 + fr;
                const f32x4 a = *(const f32x4*)(SS + row * 8), b = *(const f32x4*)(SS + row * 8 + 4);
                pre[ai][m] = rsqrtf(((a[0] + a[1]) + (a[2] + a[3]) + (b[0] + b[1]) + (b[2] + b[3])) * (1.f / 512.f) + EPS);
                __builtin_amdgcn_sched_barrier(0);
            }
        if (t < 4) norm_rope_store<128>(acc, pm, wr, wc, fr, fq, wid, wBkn, nullptr, nullptr, false, pre, KB, 1536, (t * 2 + (wc >> 1)) * 192, 1, 0, xch);
        else {
            const int colw = (t - 4) * 256 + 32 * wc + 8 * fq;
#pragma unroll
            for (int ai = 0; ai < 2; ++ai)
#pragma unroll
                for (int m = 0; m < 4; ++m) {
                    const size_t row = (size_t)pm * 256 + ai * 128 + wr * 64 + m * 16 + fr;
#pragma unroll
                    for (int bj = 0; bj < 2; ++bj) store8(VB + row * 1024 + colw + bj * 128, acc[ai][bj][m][0] * pre[ai][m], acc[ai][bj][m][1] * pre[ai][m]);
                    __builtin_amdgcn_sched_barrier(0);
                }
        }
    }
};

struct EpiBr {
    static constexpr bool MID = true;
    const bf16_t* MRG; bf16_t* Y;
    __device__ __forceinline__ void mid(f32x4 (&acc)[2][2][4][2], const Unit& u, int i, int wr, int wc, int fr, int fq) const {
#pragma unroll
        for (int ai = 0; ai < 2; ++ai)
#pragma unroll
            for (int m = 0; m < 4; ++m) {
                const size_t row = (size_t)u.pm * 256 + ai * 128 + wr * 64 + m * 16 + fr;
#pragma unroll
                for (int bj = 0; bj < 2; ++bj) {
                    const int col = u.pn * 256 + bj * 128 + 32 * wc + 8 * fq;
                    const u32x4 a = *(const u32x4*)(MRG + row * 6144 + (i - 1) * 2048 + col), b = *(const u32x4*)(MRG + row * 6144 + i * 2048 + col);
#pragma unroll
                    for (int q = 0; q < 4; ++q) {
                        const float r0 = bf2f(a[q] & 0xffffu) * __builtin_amdgcn_rcpf(bf2f(b[q] & 0xffffu)), r1 = bf2f(a[q] >> 16) * __builtin_amdgcn_rcpf(bf2f(b[q] >> 16));
                        acc[ai][bj][m][q >> 1][(q & 1) * 2] *= r0; acc[ai][bj][m][q >> 1][(q & 1) * 2 + 1] *= r1;
                    }
                }
                __builtin_amdgcn_sched_barrier(0);
            }
    }
    __device__ __forceinline__ void operator()(const f32x4 (&acc)[2][2][4][2], const Unit& u, int wr, int wc, int fr, int fq, int wid) const {
#pragma unroll
        for (int ai = 0; ai < 2; ++ai)
#pragma unroll
            for (int m = 0; m < 4; ++m) {
                const size_t row = (size_t)u.pm * 256 + ai * 128 + wr * 64 + m * 16 + fr;
#pragma unroll
                for (int bj = 0; bj < 2; ++bj) {
                    const int col = u.pn * 256 + bj * 128 + 32 * wc + 8 * fq;
                    const u32x4 a = *(const u32x4*)(MRG + row * 6144 + 4096 + col);
                    f32x4 v0 = acc[ai][bj][m][0], v1 = acc[ai][bj][m][1];
                    v0[0] *= bf2f(a[0] & 0xffffu); v0[1] *= bf2f(a[0] >> 16); v0[2] *= bf2f(a[1] & 0xffffu); v0[3] *= bf2f(a[1] >> 16);
                    v1[0] *= bf2f(a[2] & 0xffffu); v1[1] *= bf2f(a[2] >> 16); v1[2] *= bf2f(a[3] & 0xffffu); v1[3] *= bf2f(a[3] >> 16);
                    store8(Y + row * 2048 + col, v0, v1);
                }
                __builtin_amdgcn_sched_barrier(0);
            }
    }
};

struct EpiOut {
    static constexpr bool MID = false;
    const float *xsrc, *csrc; float *xdst, *cdst; const float* mod;
    __device__ __forceinline__ void operator()(const f32x4 (&acc)[2][2][4][2], const Unit& u, int wr, int wc, int fr, int fq, int wid) const {
        const int pm = u.pm; const bool lat = pm < 64;
        const int mi = lat ? (pm >> 4) : 4;
        const float* src = lat ? xsrc : csrc - (size_t)MLAT * DM; float* dst = lat ? xdst : cdst - (size_t)MLAT * DM;
        const float* g = mod + mi * 6144 + 4096;
#pragma unroll
        for (int bj = 0; bj < 2; ++bj) {
            const int col = u.pn * 256 + bj * 128 + 32 * wc + 8 * fq;
            const f32x4 g0 = *(const f32x4*)(g + col), g1 = *(const f32x4*)(g + col + 4);
#pragma unroll
            for (int ai = 0; ai < 2; ++ai)
#pragma unroll
                for (int m = 0; m < 4; ++m) {
                    const size_t row = (size_t)pm * 256 + ai * 128 + wr * 64 + m * 16 + fr;
                    const f32x4 x0 = *(const f32x4*)(src + row * DM + col), x1 = *(const f32x4*)(src + row * DM + col + 4);
                    *(f32x4*)(dst + row * DM + col) = x0 + g0 * acc[ai][bj][m][0];
                    *(f32x4*)(dst + row * DM + col + 4) = x1 + g1 * acc[ai][bj][m][1];
                    __builtin_amdgcn_sched_barrier(0);
                }
        }
    }
};

namespace att {
#define SBAR() __builtin_amdgcn_sched_barrier(0)
__device__ __forceinline__ int crow(int r, int hi) { return (r & 3) + 8 * (r >> 2) + 4 * hi; }
template <int RB> __device__ __forceinline__ int kswz(int row, int colB) { const int x = (RB == 256) ? (row & 7) : ((row >> 1) & 7); return row * RB + (colB ^ (x << 4)); }
__device__ __forceinline__ int v_st(int k, int c) { const int kk = (k & ~0xC) | ((k & 4) << 1) | ((k & 8) >> 1); return ((kk >> 3) * 4 + (c >> 5)) * 512 + ((kk & 7) * 32 + (c & 31)) * 2; }
__device__ __forceinline__ int v_rd_base(int lane) { return ((lane & 3) << 3) | (((lane >> 2) & 3) << 6) | (((lane >> 4) & 1) << 5) | (((lane >> 5) & 1) << 8); }
constexpr int v_rd_off(int d0, int ks, int half) { return d0 * 512 + ks * 4096 + half * 2048; }
template <int OFF> __device__ __forceinline__ s16x4 tr_read(unsigned vb) {
    s16x4 r; asm volatile("ds_read_b64_tr_b16 %0, %1 offset:%2" : "=&v"(r) : "v"(vb), "i"(OFF) : "memory"); return r;
}
template <int D0> __device__ __forceinline__ void pv_one(f32x16& od, unsigned vb, bf16x8 pa0, bf16x8 pa1, bf16x8 pa2, bf16x8 pa3) {
    const s16x4 l0 = tr_read<v_rd_off(D0, 0, 0)>(vb), h0 = tr_read<v_rd_off(D0, 0, 1)>(vb), l1 = tr_read<v_rd_off(D0, 1, 0)>(vb), h1 = tr_read<v_rd_off(D0, 1, 1)>(vb);
    const s16x4 l2 = tr_read<v_rd_off(D0, 2, 0)>(vb), h2 = tr_read<v_rd_off(D0, 2, 1)>(vb), l3 = tr_read<v_rd_off(D0, 3, 0)>(vb), h3 = tr_read<v_rd_off(D0, 3, 1)>(vb);
    asm volatile("s_waitcnt lgkmcnt(0)" ::: "memory"); SBAR();
#define PK(L, H) (bf16x8){L[0], L[1], L[2], L[3], H[0], H[1], H[2], H[3]}
    od = __builtin_amdgcn_mfma_f32_32x32x16_bf16(pa0, PK(l0, h0), od, 0, 0, 0);
    od = __builtin_amdgcn_mfma_f32_32x32x16_bf16(pa1, PK(l1, h1), od, 0, 0, 0);
    od = __builtin_amdgcn_mfma_f32_32x32x16_bf16(pa2, PK(l2, h2), od, 0, 0, 0);
    od = __builtin_amdgcn_mfma_f32_32x32x16_bf16(pa3, PK(l3, h3), od, 0, 0, 0);
#undef PK
}
__device__ __forceinline__ void pv_d0(f32x16 (&o)[4], unsigned vb, bf16x8 pa0, bf16x8 pa1, bf16x8 pa2, bf16x8 pa3) {
    pv_one<0>(o[0], vb, pa0, pa1, pa2, pa3); pv_one<1>(o[1], vb, pa0, pa1, pa2, pa3); pv_one<2>(o[2], vb, pa0, pa1, pa2, pa3); pv_one<3>(o[3], vb, pa0, pa1, pa2, pa3);
}
__device__ __forceinline__ void partialSM(f32x16& p0, f32x16& p1, float C, float nMB) {
#pragma unroll
    for (int r = 0; r < 16; ++r) p0[r] = fmaf(p0[r], C, nMB);
#pragma unroll
    for (int r = 0; r < 16; ++r) p1[r] = fmaf(p1[r], C, nMB);
#pragma unroll
    for (int r = 0; r < 16; ++r) p0[r] = __builtin_amdgcn_exp2f(p0[r]);
}
__device__ __forceinline__ void finishSM(f32x16& p0, f32x16& p1, float& l_reg, bf16x8& pa0, bf16x8& pa1, bf16x8& pa2, bf16x8& pa3) {
#pragma unroll
    for (int r = 0; r < 16; ++r) p1[r] = __builtin_amdgcn_exp2f(p1[r]);
    float ps = 0;
#pragma unroll
    for (int r = 0; r < 16; ++r) ps += p0[r];
#pragma unroll
    for (int r = 0; r < 16; ++r) ps += p1[r];
    { auto rr = __builtin_amdgcn_permlane32_swap(__float_as_uint(ps), __float_as_uint(ps), false, false);
      ps = __uint_as_float(rr[0]) + __uint_as_float(rr[1]); }
    l_reg += ps;
#define PK4(P, BASE, OUT) do { unsigned a0 = cvt_pk_bf16(P[BASE + 0], P[BASE + 1]), a1 = cvt_pk_bf16(P[BASE + 2], P[BASE + 3]);   \
    unsigned b0 = cvt_pk_bf16(P[BASE + 4], P[BASE + 5]), b1 = cvt_pk_bf16(P[BASE + 6], P[BASE + 7]);                              \
    auto r0 = __builtin_amdgcn_permlane32_swap(a0, b0, false, false); auto r1 = __builtin_amdgcn_permlane32_swap(a1, b1, false, false); \
    u32x4 w = {r0[0], r1[0], r0[1], r1[1]}; OUT = *reinterpret_cast<bf16x8*>(&w); } while (0)
    PK4(p0, 0, pa0); PK4(p0, 8, pa1); PK4(p1, 0, pa2); PK4(p1, 8, pa3);
#undef PK4
}
template <int DQK>
__device__ __forceinline__ void qkt(f32x16& p0, f32x16& p1, const LAS char* Ks, const bf16x8 (&qr)[DQK / 16], int r32, int hi) {
    constexpr int RB = DQK * 2;
    p0 = f32x16{}; p1 = f32x16{};
#pragma unroll
    for (int d0 = 0; d0 < DQK / 16; ++d0) { const int cb = (d0 * 16 + hi * 8) * 2;
        const bf16x8 b0 = *(const LAS bf16x8*)(Ks + kswz<RB>(r32, cb));
        const bf16x8 b1 = *(const LAS bf16x8*)(Ks + kswz<RB>(32 + r32, cb));
        p0 = __builtin_amdgcn_mfma_f32_32x32x16_bf16(b0, qr[d0], p0, 0, 0, 0);
        p1 = __builtin_amdgcn_mfma_f32_32x32x16_bf16(b1, qr[d0], p1, 0, 0, 0);
        if (QKT_GRP > 0 && (d0 % QKT_GRP) == QKT_GRP - 1 && d0 + 1 < DQK / 16) SBAR(); }
}
constexpr int V_BYTES = 64 * 128 * 2, K_OFF = 3 * V_BYTES, K_STRIDE = 64 * 192 * 2, LI_OFF = K_OFF + 3 * K_STRIDE;

template <int DQK, bool DOUBLE>
__device__ __forceinline__ void attn_pass(const bf16_t* __restrict__ Q, int ldq, const bf16_t* __restrict__ Kg, int ldk, const bf16_t* __restrict__ Vg, int ldv,
                                          int rowc, int rowl, int NT, float C, float nMB, f32x16 (&o)[4], float& l_reg, LAS char* lds, int tid) {
    constexpr int RB = DQK * 2, NCH = DQK / 8, NLD = NCH / 8;
    const int wid = __builtin_amdgcn_readfirstlane(tid >> 6), lane = tid & 63, r32 = lane & 31, hi = lane >> 5;
    LAS char* V_lds = lds; LAS char* K_lds = lds + K_OFF;
    bf16x8 qr[DQK / 16];
    { const bf16_t* Qw = Q + (size_t)(wid * 32 + r32) * ldq + hi * 8;
#pragma unroll
      for (int d0 = 0; d0 < DQK / 16; ++d0) qr[d0] = *(const bf16x8*)(Qw + d0 * 16); }
#pragma unroll
    for (int d = 0; d < 4; ++d) o[d] = f32x16{};
    l_reg = 0.f;
    int vrow[2], vcol[2], krow[NLD], kcol[NLD];
#pragma unroll
    for (int i = 0; i < 2; ++i) { const int q = tid + 512 * i, sub = q >> 5, within = q & 31, kk = (sub >> 2) * 8 + (within >> 2);
        vrow[i] = (kk & ~0xC) | ((kk & 4) << 1) | ((kk & 8) >> 1); vcol[i] = (sub & 3) * 32 + (within & 3) * 8; }
#pragma unroll
    for (int i = 0; i < NLD; ++i) { const int q = tid + 512 * i, row = q / NCH, chp = q % NCH; const int x = (RB == 256) ? (row & 7) : ((row >> 1) & 7);
        krow[i] = row; kcol[i] = (chp ^ x) * 8; }
    const unsigned vb0 = (unsigned)(uintptr_t)V_lds + v_rd_base(lane);
#define KROW0(j) ((j) < 4 ? rowc + 64 * (j) : rowl + 64 * ((j) - 4))
#define DMA(j, b) do { const size_t _r0 = (size_t)KROW0(j); \
    _Pragma("unroll") for (int _i = 0; _i < 2; ++_i) __builtin_amdgcn_global_load_lds((const unsigned*)(Vg + (_r0 + vrow[_i]) * ldv + vcol[_i]), (LAS unsigned*)(V_lds + (b) * V_BYTES + wid * 1024 + _i * 8192), 16, 0, 0); \
    _Pragma("unroll") for (int _i = 0; _i < NLD; ++_i) __builtin_amdgcn_global_load_lds((const unsigned*)(Kg + (_r0 + krow[_i]) * ldk + kcol[_i]), (LAS unsigned*)(K_lds + (b) * K_STRIDE + wid * 1024 + _i * 8192), 16, 0, 0); } while (0)
#define VMW0() asm volatile("s_waitcnt vmcnt(0)" ::: "memory")
    bf16x8 pa0, pa1, pa2, pa3;
    __syncthreads();
    DMA(0, 0); DMA(1, 1); VMW0(); __syncthreads();
    if constexpr (!DOUBLE) {
        f32x16 p0, p1;
        DMA(2, 2);
        int bc = 0, bn = 1, bf = 2;
        for (int j = 0; j < NT; ++j) {
            SBAR(); qkt<DQK>(p0, p1, K_lds + bc * K_STRIDE, qr, r32, hi);
            partialSM(p0, p1, C, nMB); finishSM(p0, p1, l_reg, pa0, pa1, pa2, pa3); SBAR();
            pv_d0(o, vb0 + bc * V_BYTES, pa0, pa1, pa2, pa3);
            if (j + 1 < NT) { VMW0(); __syncthreads(); if (j + 3 < NT) DMA(j + 3, bc); }
            { const int _t = bc; bc = bn; bn = bf; bf = _t; }
        }
    } else {
    f32x16 pA0, pA1, pB0, pB1;
    qkt<DQK>(pA0, pA1, K_lds, qr, r32, hi); partialSM(pA0, pA1, C, nMB);
    DMA(2, 2);
    int bp = 0, bc = 1, bn = 2;
#define STEP(j, PC0, PC1, PP0, PP1) do { \
        SBAR(); qkt<DQK>(PC0, PC1, K_lds + bc * K_STRIDE, qr, r32, hi); \
        finishSM(PP0, PP1, l_reg, pa0, pa1, pa2, pa3); SBAR(); \
        pv_d0(o, vb0 + bp * V_BYTES, pa0, pa1, pa2, pa3); partialSM(PC0, PC1, C, nMB); \
        if ((j) + 1 < NT) { VMW0(); __syncthreads(); if ((j) + 2 < NT) DMA((j) + 2, bp); } \
        { const int _t = bp; bp = bc; bc = bn; bn = _t; } } while (0)
    for (int j = 1; j < NT; j += 2) {
        STEP(j, pB0, pB1, pA0, pA1);
        if (j + 1 < NT) STEP(j + 1, pA0, pA1, pB0, pB1);
    }
    finishSM(pB0, pB1, l_reg, pa0, pa1, pa2, pa3); SBAR();
    pv_d0(o, vb0 + bp * V_BYTES, pa0, pa1, pa2, pa3);
    }
#undef KROW0
#undef DMA
#undef VMW0
#undef STEP
}
__device__ __forceinline__ void row_recip(float l_reg, float (&rli)[16], LAS float* li, int r32, int hi) {
    if (hi == 0) li[r32] = l_reg;
    asm volatile("s_waitcnt lgkmcnt(0)" ::: "memory");
#pragma unroll
    for (int r = 0; r < 16; ++r) rli[r] = __builtin_amdgcn_rcpf(li[crow(r, hi)]);
    asm volatile("s_waitcnt lgkmcnt(0)" ::: "memory");
}
}

struct AttnBufs { const bf16_t *QA, *KA, *VA, *QB, *KB, *VB, *QC, *KC, *VC, *GATE; bf16_t* BR; float* SCR; const float* lamv; const float* subln; float lam_init; };

template <bool SUBLN>
__device__ __forceinline__ void attn_out(const AttnBufs& T, f32x16 (&o)[4], int type, int h, size_t orow0, LAS char* lds, int wid, int lane, int r32, int hi) {
    __syncthreads();
    LAS float* stg = (LAS float*)(lds + wid * 16896);
#pragma unroll
    for (int d0 = 0; d0 < 4; ++d0)
#pragma unroll
        for (int r = 0; r < 16; ++r) stg[att::crow(r, hi) * 132 + d0 * 32 + r32] = o[d0][r];
    asm volatile("s_waitcnt lgkmcnt(0)" ::: "memory");
    const int rr = lane >> 5, c4 = (lane & 31) * 4;
    const int col = type * 1024 + h * 128 + c4;
    f32x4 wsub = {1.f, 1.f, 1.f, 1.f};
    if (SUBLN) { wsub = *(const f32x4*)(T.subln + c4) * (1.f - T.lam_init); }
    const bf16_t* gp = T.GATE + (orow0 + rr) * 3072 + col; bf16_t* op = T.BR + (orow0 + rr) * 3072 + col;
#pragma unroll 4
    for (int i = 0; i < 16; ++i) {
        f32x4 v = *(const LAS f32x4*)(stg + (2 * i + rr) * 132 + c4);
        const u32x2 gg = *(const u32x2*)(gp + (size_t)i * 2 * 3072);
        if (SUBLN) {
            float s = (v[0] * v[0] + v[1] * v[1]) + (v[2] * v[2] + v[3] * v[3]);
            s += __shfl_xor(s, 1); s += __shfl_xor(s, 2); s += __shfl_xor(s, 4); s += __shfl_xor(s, 8); s += __shfl_xor(s, 16);
            v = v * (rsqrtf(s * (1.f / 128.f) + EPS)) * wsub;
        }
        u32x2 w; w.x = cvt_pk_bf16(v[0] * bf2f(gg.x & 0xffffu), v[1] * bf2f(gg.x >> 16)); w.y = cvt_pk_bf16(v[2] * bf2f(gg.y & 0xffffu), v[3] * bf2f(gg.y >> 16));
        *(u32x2*)(op + (size_t)i * 2 * 3072) = w;
    }
}

__device__ __forceinline__ void attn_item(const AttnBufs& T, int type, int b, int h, int qrow0, int NT, LAS char* lds, int tid_) {
    asm volatile("" : "+v"(tid_));
    const int tid = tid_, wid = __builtin_amdgcn_readfirstlane(tid >> 6), lane = tid & 63, r32 = lane & 31, hi = lane >> 5;
    const int rowc = MLAT + b * CTXL, rowl = b * SEQ;
    LAS float* li = (LAS float*)(lds + att::LI_OFF) + wid * 64;
    constexpr float LOG2E = 1.4426950408889634f;
    const size_t orow0 = (size_t)qrow0 + wid * 32;
    if (type == 0 && (MK_ATYPE & 1)) {
        f32x16 o[4]; float l_reg; float rli[16];
        att::attn_pass<128, ATT_DBL>(T.QA + (size_t)qrow0 * 1024 + h * 128, 1024, T.KA + (h >> 2) * 128, 256, T.VA + (h >> 2) * 128, 256, rowc, rowl, NT,
                            0.08838834764831845f * LOG2E, T.lamv[1], o, l_reg, lds, tid);
        att::row_recip(l_reg, rli, li, r32, hi);
#pragma unroll
        for (int d0 = 0; d0 < 4; ++d0)
#pragma unroll
            for (int r = 0; r < 16; ++r) o[d0][r] *= rli[r];
        attn_out<false>(T, o, 0, h, orow0, lds, wid, lane, r32, hi);
    } else if (type == 1 && (MK_ATYPE & 2)) {
        f32x16 o[4]; float l_reg; float rli[16];
        att::attn_pass<192, false>(T.QB + (size_t)qrow0 * 1536 + h * 192, 1536, T.KB + h * 192, 1536, T.VB + h * 128, 1024, rowc, rowl, NT,
                            0.07216878364870323f * LOG2E, T.lamv[2], o, l_reg, lds, tid);
        att::row_recip(l_reg, rli, li, r32, hi);
#pragma unroll
        for (int d0 = 0; d0 < 4; ++d0)
#pragma unroll
            for (int r = 0; r < 16; ++r) o[d0][r] *= rli[r];
        attn_out<false>(T, o, 1, h, orow0, lds, wid, lane, r32, hi);
    } else if (MK_ATYPE & 4) {
        f32x16 o[4]; float l_reg; float rli[16];
        att::attn_pass<64, ATT_DBL>(T.QC + (size_t)qrow0 * 1024 + h * 128, 1024, T.KC + h * 128, 1024, T.VC + h * 128, 1024, rowc, rowl, NT,
                           0.125f * LOG2E, T.lamv[3], o, l_reg, lds, tid);
        att::row_recip(l_reg, rli, li, r32, hi);
        f32x4* scr = (f32x4*)(T.SCR + ((size_t)blockIdx.x * 512 + tid) * 64);
#pragma unroll
        for (int d0 = 0; d0 < 4; ++d0)
#pragma unroll
            for (int q = 0; q < 4; ++q) scr[d0 * 4 + q] = (f32x4){o[d0][q * 4] * rli[q * 4], o[d0][q * 4 + 1] * rli[q * 4 + 1], o[d0][q * 4 + 2] * rli[q * 4 + 2], o[d0][q * 4 + 3] * rli[q * 4 + 3]};
        att::attn_pass<64, ATT_DBL>(T.QC + (size_t)qrow0 * 1024 + h * 128 + 64, 1024, T.KC + h * 128 + 64, 1024, T.VC + h * 128, 1024, rowc, rowl, NT,
                           0.125f * LOG2E, T.lamv[3], o, l_reg, lds, tid);
        att::row_recip(l_reg, rli, li, r32, hi);
        const float lam = T.lamv[0];
#pragma unroll
        for (int d0 = 0; d0 < 4; ++d0)
#pragma unroll
            for (int q = 0; q < 4; ++q) { const f32x4 a = scr[d0 * 4 + q];
#pragma unroll
                for (int j = 0; j < 4; ++j) o[d0][q * 4 + j] = a[j] - lam * (o[d0][q * 4 + j] * rli[q * 4 + j]); }
        attn_out<true>(T, o, 2, h, orow0, lds, wid, lane, r32, hi);
    }
}

__device__ __forceinline__ void transpose_item(const float* __restrict__ W, int ldw, int k0, int srccol4, const float* __restrict__ kscale,
                                               bf16_t* __restrict__ WT, int ldt, int n0, int kdst0, LAS float* scr, int lane) {
    const int ks = lane >> 4, n4 = (lane & 15) * 4;
#pragma unroll 8
    for (int i = 0; i < 16; ++i) { const int kk = 4 * i + ks;
        f32x4 v = srccol4 >= 0 ? *(const f32x4*)(W + (size_t)(k0 + kk) * ldw + srccol4) : (f32x4){0.f, 0.f, 0.f, 0.f};
        if (kscale) v = v * kscale[k0 + kk];
        LAS float* d = scr + kk * 65 + n4; d[0] = v[0]; d[1] = v[1]; d[2] = v[2]; d[3] = v[3]; }
    asm volatile("s_waitcnt lgkmcnt(0)" ::: "memory");
    const int nn = lane & 7, c = lane >> 3;
#pragma unroll
    for (int j = 0; j < 8; ++j) { const int n = nn + 8 * j; const LAS float* s = scr + (8 * c) * 65 + n;
        u32x4 o; o.x = cvt_pk_bf16(s[0 * 65], s[1 * 65]); o.y = cvt_pk_bf16(s[2 * 65], s[3 * 65]); o.z = cvt_pk_bf16(s[4 * 65], s[5 * 65]); o.w = cvt_pk_bf16(s[6 * 65], s[7 * 65]);
        *(u32x4*)(WT + (size_t)(n0 + n) * ldt + kdst0 + k0 + 8 * c) = o; }
    asm volatile("s_waitcnt lgkmcnt(0)" ::: "memory");
}
__device__ const float INVF32[16] = {1.000000000e+00f, 5.623413324e-01f, 3.162277639e-01f, 1.778279394e-01f, 1.000000015e-01f, 5.623413250e-02f, 3.162277490e-02f, 1.778279431e-02f,
    9.999999776e-03f, 5.623413250e-03f, 3.162277630e-03f, 1.778279431e-03f, 1.000000047e-03f, 5.623413017e-04f, 3.162277571e-04f, 1.778279402e-04f};
__device__ const float INVF64[32] = {1.000000000e+00f, 7.498942614e-01f, 5.623413324e-01f, 4.216965139e-01f, 3.162277639e-01f, 2.371373773e-01f, 1.778279394e-01f, 1.333521307e-01f,
    1.000000015e-01f, 7.498941571e-02f, 5.623413250e-02f, 4.216965288e-02f, 3.162277490e-02f, 2.371373773e-02f, 1.778279431e-02f, 1.333521493e-02f, 9.999999776e-03f, 7.498941850e-03f,
    5.623413250e-03f, 4.216964822e-03f, 3.162277630e-03f, 2.371373586e-03f, 1.778279431e-03f, 1.333521446e-03f, 1.000000047e-03f, 7.498942432e-04f, 5.623413017e-04f, 4.216965172e-04f,
    3.162277571e-04f, 2.371373703e-04f, 1.778279402e-04f, 1.333521504e-04f};
__device__ __forceinline__ void sincos_d(double x, float& s, float& c) {
    const double twopi = 6.283185307179586476925;
    const double k = __builtin_rint(x / twopi), r = x - k * twopi, r2 = r * r;
    double st = r, ct = 1.0, ss = r, cs = 1.0;
    for (int n = 1; n <= 16; ++n) { ct *= -r2 / (double)((2 * n - 1) * (2 * n)); st *= -r2 / (double)((2 * n) * (2 * n + 1)); cs += ct; ss += st; }
    s = (float)ss; c = (float)cs;
}
__device__ __forceinline__ float absmax_n(const float* w, int n) { float m = 0.f; for (int i = 0; i < n; ++i) m = fmaxf(m, fabsf(w[i])); return m; }

typedef unsigned v4u_unused_t;
#define XB_TMO      128
#define XB_XCNT(j)  (256  + 64 * (j))
#define XB_XSUB(j)  (1280 + 64 * (j))
#define XB_XGEN(j)  (2304 + 64 * (j))
#define XB_TOP      3328
#define XB_TOPGEN   3392
#define XCD_BAR_WORDS 3456
#define XB_SPIN_CAP (1u << 18)

__device__ __forceinline__ unsigned xb_ld(unsigned* p)              { return __hip_atomic_load(p, __ATOMIC_RELAXED, __HIP_MEMORY_SCOPE_AGENT); }
__device__ __forceinline__ unsigned xb_add(unsigned* p, unsigned v) { return __hip_atomic_fetch_add(p, v, __ATOMIC_RELAXED, __HIP_MEMORY_SCOPE_AGENT); }
__device__ __forceinline__ unsigned xb_xcc_id() { return (unsigned)__builtin_amdgcn_s_getreg((3 << 11) | 20) & 0xFu; }
#define XB_SPIN(cond, bar) do { unsigned _sp = 0; while (cond) { __builtin_amdgcn_s_sleep(1); \
    if ((++_sp & 255u) == 0u) { if (xb_ld(&(bar)[XB_TMO])) break; if (_sp > XB_SPIN_CAP) { atomicAdd(&(bar)[XB_TMO], 1u); break; } } } } while (0)

struct XcdBarrier {
    unsigned* bar; unsigned x;
    volatile LAS unsigned* st;
};

__device__ __forceinline__ XcdBarrier xcd_barrier_post(unsigned* bar, volatile LAS unsigned* st) {
    XcdBarrier b; b.bar = bar; b.x = xb_xcc_id(); b.st = st;
    if (threadIdx.x == 0) (void)xb_add(&bar[XB_XCNT(b.x)], 1u);
    return b;
}
__device__ __forceinline__ void xcd_barrier_complete(unsigned* bar, unsigned x, unsigned& nloc, unsigned& nx) {
    const unsigned G = gridDim.x * gridDim.y * gridDim.z;
    unsigned sum, cnt, mine, sp = 0u;
    for (;;) {
        sum = 0u; cnt = 0u; mine = 0u;
#pragma unroll
        for (unsigned j = 0; j < 16; ++j) { const unsigned c = xb_ld(&bar[XB_XCNT(j)]); sum += c; cnt += (c > 0u) ? 1u : 0u; mine = (j == x) ? c : mine; }
        if (sum == G) break;
        __builtin_amdgcn_s_sleep(1);
        if ((++sp & 255u) == 0u) { if (xb_ld(&bar[XB_TMO])) break; if (sp > XB_SPIN_CAP) { atomicAdd(&bar[XB_TMO], 1u); break; } }
    }
    nloc = mine > 0u ? mine : 1u; nx = cnt > 0u ? cnt : 1u;
}

__device__ __forceinline__ void xcd_barrier(const XcdBarrier& b) {
    asm volatile("s_waitcnt vmcnt(0)" ::: "memory");
    __syncthreads();
    if (threadIdx.x == 0) {
        unsigned* bar = b.bar;
        __builtin_amdgcn_s_waitcnt(0);
        unsigned nloc = b.st[0], nx = b.st[1];
        if (nloc == 0u) { xcd_barrier_complete(bar, b.x, nloc, nx); b.st[0] = nloc; b.st[1] = nx; }
        const unsigned old = xb_add(&bar[XB_XSUB(b.x)], 1u);
        const unsigned gen = old / nloc;
        if (old + 1u == (gen + 1u) * nloc) {
            __builtin_amdgcn_fence(__ATOMIC_RELEASE, "agent");
            asm volatile("s_waitcnt vmcnt(0)" ::: "memory");
            const unsigned og = xb_add(&bar[XB_TOP], 1u);
            const unsigned tg = og / nx;
            if (og + 1u == (tg + 1u) * nx) xb_add(&bar[XB_TOPGEN], 1u);
            else XB_SPIN(xb_ld(&bar[XB_TOPGEN]) == tg, bar);
            __builtin_amdgcn_fence(__ATOMIC_ACQUIRE, "agent");
            xb_add(&bar[XB_XGEN(b.x)], 1u);
            asm volatile("s_waitcnt vmcnt(0)" ::: "memory");
        } else {
            XB_SPIN(xb_ld(&bar[XB_XGEN(b.x)]) == gen, bar);
            __builtin_amdgcn_fence(__ATOMIC_ACQUIRE, "agent");
            asm volatile("s_waitcnt vmcnt(0)" ::: "memory");
        }
    }
    __syncthreads();
}

struct Args { const float* in[29]; float* out; unsigned char* ws; int ph_lo, ph_hi, coop, pad; };

__global__ void __launch_bounds__(512, 2) mega_fwd(Args args) {
    extern __shared__ __attribute__((aligned(16))) unsigned char lds_raw[];
    LAS unsigned char* lds = (LAS unsigned char*)lds_raw;
    const int G = gridDim.x, bx = blockIdx.x;
    const int vcu = (G % 8 == 0) ? (bx % 8) * (G / 8) + bx / 8 : bx;
    unsigned char* ws = args.ws;
    float* MOD = (float*)(ws + WS_MOD);
    float* TC64 = (float*)(ws + WS_TC64); float* TS64 = (float*)(ws + WS_TS64); float* TC128 = (float*)(ws + WS_TC128); float* TS128 = (float*)(ws + WS_TS128);
    float* LAM = (float*)(ws + WS_LAM);
    bf16_t* WIN = (bf16_t*)(ws + WS_WIN); bf16_t* WUP = (bf16_t*)(ws + WS_WUP); bf16_t* WBR = (bf16_t*)(ws + WS_WBR); bf16_t* WOUT = (bf16_t*)(ws + WS_WOUT);
    bf16_t* H = (bf16_t*)(ws + WS_H); bf16_t* QA = (bf16_t*)(ws + WS_QA); bf16_t* KA = (bf16_t*)(ws + WS_KA); bf16_t* VA = (bf16_t*)(ws + WS_VA);
    bf16_t* QB = (bf16_t*)(ws + WS_QB); bf16_t* KB = (bf16_t*)(ws + WS_KB); bf16_t* CKV = (bf16_t*)(ws + WS_CKV); bf16_t* VB = (bf16_t*)(ws + WS_VB);
    bf16_t* QC = (bf16_t*)(ws + WS_QC); bf16_t* KC = (bf16_t*)(ws + WS_KC); bf16_t* VC = (bf16_t*)(ws + WS_VC);
    bf16_t* GATE = (bf16_t*)(ws + WS_GATE); bf16_t* MRG = (bf16_t*)(ws + WS_MRG); bf16_t* BR = (bf16_t*)(ws + WS_BR); bf16_t* Y = (bf16_t*)(ws + WS_Y);
    float* SS = (float*)(ws + WS_SS); float* CTXW = (float*)(ws + WS_CTXW); float* SCR = (float*)(ws + WS_SCR);
    LAS float* xch = (LAS float*)(lds + XCH_OFF);
    volatile LAS unsigned* bst = (volatile LAS unsigned*)(lds + XCH_OFF + 4096);
    if (threadIdx.x < 2) bst[threadIdx.x] = 0u;
    __syncthreads();
    XcdBarrier bar = xcd_barrier_post((unsigned*)(ws + WS_BAR), bst);

    for (int ph = args.ph_lo; ph < args.ph_hi; ++ph) {
        int tid = threadIdx.x; asm volatile("" : "+v"(tid));
        const int lane = tid & 63, wave = __builtin_amdgcn_readfirstlane(tid >> 6);
        if (ph == 0 && (MK_MASK & 1)) {
            {
                LAS float* sc = (LAS float*)lds;
                LAS float* red = (LAS float*)(lds + 65536);
                for (int i = tid; i < 5 * DM; i += 512) { const float v = i < 4 * DM ? args.in[1][i] : args.in[3][i - 4 * DM]; sc[i] = silu_f(v); }
                __syncthreads();
                for (int it = bx; it < DEPTH * 96; it += G) {
                    const int l = it / 96, n0 = (it % 96) * 64;
                    const float* W = args.in[5] + (size_t)l * DM * 6144 + n0 + lane;
                    float a0 = 0.f, a1 = 0.f, a2 = 0.f, a3 = 0.f, a4 = 0.f;
                    const int kb = wave * 256;
#pragma unroll 8
                    for (int k = 0; k < 256; ++k) { const float wv = W[(size_t)(kb + k) * 6144];
                        a0 += sc[kb + k] * wv; a1 += sc[DM + kb + k] * wv; a2 += sc[2 * DM + kb + k] * wv; a3 += sc[3 * DM + kb + k] * wv; a4 += sc[4 * DM + kb + k] * wv; }
                    red[(wave * 5 + 0) * 64 + lane] = a0; red[(wave * 5 + 1) * 64 + lane] = a1; red[(wave * 5 + 2) * 64 + lane] = a2; red[(wave * 5 + 3) * 64 + lane] = a3; red[(wave * 5 + 4) * 64 + lane] = a4;
                    __syncthreads();
                    if (tid < 320) { const int i = tid >> 6; float s = 0.f;
                        for (int w8 = 0; w8 < 8; ++w8) s += red[(w8 * 5 + i) * 64 + lane];
                        MOD[((size_t)l * 5 + i) * 6144 + n0 + lane] = s + args.in[6][(size_t)l * 6144 + n0 + lane]; }
                    __syncthreads();
                }
            }
            if (bx == 1 % G) {
                for (int i = tid; i < 64 * 16; i += 512) { const int pos = i >> 4, f = i & 15; const float ang = (float)pos * INVF32[f]; float s, c; sincos_d((double)ang, s, c); TC64[i] = c; TS64[i] = s; }
                for (int i = tid; i < 64 * 32; i += 512) { const int pos = i >> 5, f = i & 31; const float ang = (float)pos * INVF64[f]; float s, c; sincos_d((double)ang, s, c); TC128[i] = c; TS128[i] = s; }
            }
            if (bx == 2 % G && tid < DEPTH) {
                const int l = tid;
                float s1 = 0.f, s2 = 0.f;
                for (int i = 0; i < 64; ++i) { s1 += args.in[20][l * 64 + i] * args.in[21][l * 64 + i]; s2 += args.in[22][l * 64 + i] * args.in[23][l * 64 + i]; }
                const float lam_init = 0.8f - 0.6f * expf(-0.3f * (float)l);
                LAM[l * 4 + 0] = expf(s1) - expf(s2) + lam_init;
                const float mAq = absmax_n(args.in[9] + l * 128, 128), mAk = absmax_n(args.in[10] + l * 128, 128);
                const float mBqn = absmax_n(args.in[11] + l * 128, 128), mBqr = absmax_n(args.in[12] + l * 64, 64), mBkn = absmax_n(args.in[16] + l * 128, 128), mBkr = absmax_n(args.in[17] + l * 64, 64);
                const float mCq = absmax_n(args.in[18] + l * 64, 64), mCk = absmax_n(args.in[19] + l * 64, 64);
                const float L2E = 1.4426950408889634f;
                LAM[l * 4 + 1] = -(sqrtf(128.f) * mAq * mAk) * L2E;
                LAM[l * 4 + 2] = -(sqrtf(128.f * mBqn * mBqn + 64.f * mBqr * mBqr) * sqrtf(128.f * mBkn * mBkn + 64.f * mBkr * mBkr) * 0.07216878364870323f) * L2E;
                LAM[l * 4 + 3] = -(8.f * mCq * mCk) * L2E;
            }
            __syncthreads();
            {
                LAS float* scr = (LAS float*)(lds + wave * 16640);
                const int gw = vcu * 8 + wave, NGW = G * 8;
                constexpr int I_IN = 32 * (NIN / 64), I_UP = 8 * 32, I_BR = 3 * 16 * 32, I_OUT = 32 * 32, I_L = I_IN + I_UP + I_BR + I_OUT;
                const int n4 = (lane & 15) * 4;
                for (int it = gw; it < DEPTH * I_L; it += NGW) {
                    const int l = it / I_L; int r = it % I_L;
                    if (r < I_IN) { const int nb = r % (NIN / 64), kb = r / (NIN / 64); const int n0 = nb * 64;
                        transpose_item(args.in[7] + (size_t)l * DM * INC, INC, kb * 64, in_src_col(n0 + n4), nullptr, WIN + (size_t)l * NIN * DM, DM, n0, 0, scr, lane); continue; }
                    r -= I_IN;
                    if (r < I_UP) { const int nb = r % 32, kb = r / 32; const int n0 = nb * 64; const int sc_ = up_src_col(n0 + n4);
                        const float* W = (sc_ < 1024 ? args.in[14] : args.in[15]) + (size_t)l * 512 * 1024;
                        transpose_item(W, 1024, kb * 64, sc_ & 1023, args.in[13] + l * 512, WUP + (size_t)l * 2048 * 512, 512, n0, 0, scr, lane); continue; }
                    r -= I_UP;
                    if (r < I_BR) { const int br = r / (16 * 32), r2 = r % (16 * 32); const int nb = r2 % 32, kb = r2 / 32; const int n0 = nb * 64;
                        transpose_item(args.in[25 + br] + (size_t)l * 1024 * DM, DM, kb * 64, n0 + n4, nullptr, WBR + (size_t)l * 2048 * 3072, 3072, n0, br * 1024, scr, lane); continue; }
                    r -= I_BR;
                    { const int nb = r % 32, kb = r / 32; const int n0 = nb * 64;
                      transpose_item(args.in[28] + (size_t)l * DM * DM, DM, kb * 64, n0 + n4, nullptr, WOUT + (size_t)l * DM * DM, DM, n0, 0, scr, lane); }
                }
            }
        } else {
            const int l = (ph - 1) / PPL, st_ = (ph - 1) % PPL, st = (MK_REP_ST >= 0 && st_ > MK_REP_ST) ? st_ - 1 : st_;
            const float* xsrc = (l == 0) ? args.in[0] : args.out;
            const float* csrc = (l == 0) ? args.in[2] : CTXW;
            const float* modl = MOD + (size_t)l * 5 * 6144;
            const int Mrows = (l == DEPTH - 1) ? MLAT : MTOT;
            if (st == 0 && (MK_MASK & 2)) {
                const float* nw = args.in[4] + (size_t)l * DM;
                for (int row = bx * 8 + wave; row < MTOT; row += G * 8) {
                    const bool lat = row < MLAT; const int mi = lat ? (row >> 12) : 4;
                    const f32x4* xr = (const f32x4*)(lat ? xsrc + (size_t)row * DM : csrc + (size_t)(row - MLAT) * DM) + lane;
                    f32x4 v[8]; float s = 0.f;
#pragma unroll
                    for (int j = 0; j < 8; ++j) { v[j] = xr[64 * j]; s += (v[j][0] * v[j][0] + v[j][1] * v[j][1]) + (v[j][2] * v[j][2] + v[j][3] * v[j][3]); }
                    const float rinv = rsqrtf(wave_sum(s) * (1.f / DM) + EPS);
                    const f32x4* sh = (const f32x4*)(modl + mi * 6144) + lane; const f32x4* scl = (const f32x4*)(modl + mi * 6144 + DM) + lane; const f32x4* nwp = (const f32x4*)nw + lane;
                    u32x2* o8 = (u32x2*)(H + (size_t)row * DM) + lane;
#pragma unroll
                    for (int j = 0; j < 8; ++j) { const f32x4 y = v[j] * rinv * nwp[64 * j] * (scl[64 * j] + 1.f) + sh[64 * j];
                        u32x2 w; w.x = cvt_pk_bf16(y[0], y[1]); w.y = cvt_pk_bf16(y[2], y[3]); o8[64 * j] = w; }
                }
            } else if (st == 1 && (MK_MASK & 4)) {
                pg8::Gemm g{H, WIN + (size_t)l * NIN * DM, MTOT, NIN, DM}; pg8::StaticOrder S; S.init(MTOT, NIN, G, bx);
                EpiIn E{QA, KA, VA, QB, KB, CKV, QC, KC, VC, GATE, MRG, SS,
                        args.in[9] + l * 128, args.in[10] + l * 128, args.in[11] + l * 128, args.in[12] + l * 64, args.in[17] + l * 64, args.in[18] + l * 64, args.in[19] + l * 64,
                        args.in[8] + (size_t)l * 6144, TC64, TS64, TC128, TS128, xch};
                pg8::gemm_phase<EpiIn>(lds, g, S, E, tid);
            } else if (st == 2 && (MK_MASK & 8)) {
                pg8::Gemm g{CKV, WUP + (size_t)l * 2048 * 512, MTOT, 2048, 512}; pg8::StaticOrder S; S.init(MTOT, 2048, G, bx);
                EpiUp E{KB, VB, SS, args.in[16] + l * 128, xch};
                pg8::gemm_phase<EpiUp>(lds, g, S, E, tid);
            } else if (st == 3 && (MK_MASK & 16)) {
                AttnBufs T{QA, KA, VA, QB, KB, VB, QC, KC, VC, GATE, BR, SCR, LAM + l * 4, args.in[24] + l * 128, 0.8f - 0.6f * expf(-0.3f * (float)l)};
                const int nctx = (l < DEPTH - 1) ? 96 : 0;
                for (int k = 0;; ++k) {
                    int type, b, h, qrow0, NT;
                    if (G == 256) {
                        if (k < 6) { const int id = (k & 1) * 256 + vcu; type = k >> 1; b = id >> 7; h = (id >> 4) & 7; qrow0 = b * SEQ + (id & 15) * 256; NT = 68; }
                        else if (k == 6 && bx < nctx) { type = bx >> 5; b = (bx >> 3) & 3; h = bx & 7; qrow0 = MLAT + b * CTXL; NT = 4; }
                        else break;
                    } else {
                        const int it = bx + k * G; if (it >= 1536 + nctx) break;
                        if (it < 1536) { const int id = it & 511; type = it >> 9; b = id >> 7; h = (id >> 4) & 7; qrow0 = b * SEQ + (id & 15) * 256; NT = 68; }
                        else { const int c = it - 1536; type = c >> 5; b = (c >> 3) & 3; h = c & 7; qrow0 = MLAT + b * CTXL; NT = 4; }
                    }
                    attn_item(T, type, b, h, qrow0, NT, (LAS char*)lds, tid);
                }
                __syncthreads();
            } else if (st == 4 && (MK_MASK & 32)) {
                pg8::Gemm g{BR, WBR + (size_t)l * 2048 * 3072, Mrows, 2048, 3072}; pg8::StaticOrder S; S.init(Mrows, 2048, G, bx);
                EpiBr E{MRG, Y};
                pg8::gemm_phase<EpiBr>(lds, g, S, E, tid);
            } else if (MK_MASK & 64) {
                pg8::Gemm g{Y, WOUT + (size_t)l * DM * DM, Mrows, DM, DM}; pg8::StaticOrder S; S.init(Mrows, DM, G, bx);
                EpiOut E{xsrc, csrc, args.out, CTXW, modl};
                pg8::gemm_phase<EpiOut>(lds, g, S, E, tid);
            }
        }
        if (ph + 1 < args.ph_hi) { if (args.coop) { if (ph == 0) cg::this_grid().sync(); else xcd_barrier(bar); } }
    }
}

extern "C" void kernel_launch(void* const* d_in, const int* in_sizes, int n_in, void* d_out, int out_size, void* d_ws, size_t ws_size, hipStream_t stream) {
    static int grid = 0;
    if (grid == 0) {
        if (n_in != 29 || in_sizes[0] != MLAT * DM || out_size != MLAT * DM || ws_size < WS_END) {
            fprintf(stderr, "kernel_launch: unexpected shapes: n_in %d in0 %d out %d ws %zu (need %zu)\n", n_in, n_in > 0 ? in_sizes[0] : -1, out_size, ws_size, (size_t)WS_END); grid = -1; return; }
        int dev = 0, cus = 0, per_cu = 0;
        if (hipGetDevice(&dev) != hipSuccess || hipDeviceGetAttribute(&cus, hipDeviceAttributeMultiprocessorCount, dev) != hipSuccess) { grid = -1; return; }
        if (hipFuncSetAttribute((const void*)mega_fwd, hipFuncAttributeMaxDynamicSharedMemorySize, LDS_BYTES) != hipSuccess) { fprintf(stderr, "kernel_launch: hipFuncSetAttribute failed\n"); grid = -1; return; }
        if (hipOccupancyMaxActiveBlocksPerMultiprocessor(&per_cu, (const void*)mega_fwd, 512, LDS_BYTES) != hipSuccess || per_cu < 1) { fprintf(stderr, "kernel_launch: occupancy query gives %d\n", per_cu); per_cu = 1; }
        (void)hipGetLastError();
        grid = cus * 1;
    }
    if (grid < 0) return;
    Args a{};
    for (int i = 0; i < 29; ++i) a.in[i] = (const float*)d_in[i];
    a.out = (float*)d_out; a.ws = (unsigned char*)d_ws;
#if MK_COOP
    if (hipMemsetAsync((char*)d_ws + WS_BAR, 0, 16384, stream) != hipSuccess) { fprintf(stderr, "kernel_launch: memset of the barrier words failed\n"); return; }
    a.ph_lo = 0; a.ph_hi = NPH; a.coop = 1;
    void* kargs[] = {&a};
    hipError_t e = hipLaunchCooperativeKernel((const void*)mega_fwd, dim3(grid), dim3(512), kargs, LDS_BYTES, stream);
    if (e != hipSuccess) fprintf(stderr, "kernel_launch: cooperative launch failed: %s (grid %d)\n", hipGetErrorString(e), grid);
#else
    for (int ph = 0; ph < NPH; ++ph) {
        a.ph_lo = ph; a.ph_hi = ph + 1; a.coop = 0;
        hipLaunchKernelGGL(mega_fwd, dim3(grid), dim3(512), LDS_BYTES, stream, a);
    }
    const hipError_t le = hipPeekAtLastError();
    if (le != hipSuccess) fprintf(stderr, "kernel_launch: launch failed: %s\n", hipGetErrorName(le));
#endif
}
```

```cpp
#include <hip/hip_runtime.h>
#include <hip/hip_cooperative_groups.h>
#include <cstdio>
#include <cstdint>
namespace cg = cooperative_groups;

#ifndef MK_MASK
#define MK_MASK 127
#endif
#ifndef MK_ATYPE
#define MK_ATYPE 7
#endif
#ifndef MK_G1T
#define MK_G1T 127
#endif
#ifndef ATT_SD_A
#define ATT_SD_A 2
#endif
#ifndef ATT_SD_B
#define ATT_SD_B 1
#endif
#ifndef ATT_SD_C
#define ATT_SD_C 2
#endif
#ifndef ATT_DBL_B
#define ATT_DBL_B true
#endif
#ifndef ATT_DBL
#define ATT_DBL false
#endif
#ifndef QKT_GRP
#define QKT_GRP 0
#endif
#ifndef MK_COOP
#define MK_COOP 1
#endif

#define LAS __attribute__((address_space(3)))
typedef unsigned short bf16_t;
typedef short bf16x8 __attribute__((ext_vector_type(8)));
typedef short s16x4 __attribute__((ext_vector_type(4)));
typedef float f32x4 __attribute__((ext_vector_type(4)));
typedef float f32x16 __attribute__((ext_vector_type(16)));
typedef unsigned u32x4 __attribute__((ext_vector_type(4)));
typedef unsigned u32x2 __attribute__((ext_vector_type(2)));

constexpr int DM = 2048, NBATCH = 4, SEQ = 4096, CTXL = 256, DEPTH = 4;
constexpr int MLAT = NBATCH * SEQ, MCTX = NBATCH * CTXL, MTOT = MLAT + MCTX;
constexpr int INC = 15936, NIN = 16128;
constexpr float EPS = 1e-6f;
#ifndef MK_REP_ST
#define MK_REP_ST -1
#endif
constexpr int PPL = 5;
constexpr int NPH = 1 + PPL * DEPTH;

constexpr size_t alignup(size_t x) { return (x + 255) / 256 * 256; }
constexpr size_t WS_MOD = 0;
constexpr size_t WS_TC64 = WS_MOD + alignup((size_t)DEPTH * 5 * 6144 * 4);
constexpr size_t WS_TS64 = WS_TC64 + 4096, WS_TC128 = WS_TS64 + 4096, WS_TS128 = WS_TC128 + 8192;
constexpr size_t WS_LAM = WS_TS128 + 8192;
constexpr size_t WS_BAR = WS_LAM + 256;
constexpr size_t WS_CNT = WS_BAR + 16384;
constexpr size_t CNT_BYTES = (size_t)DEPTH * 68 * 256;
constexpr size_t WS_WIN = WS_CNT + CNT_BYTES;
constexpr size_t WS_WUP = WS_WIN + (size_t)DEPTH * NIN * DM * 2;
constexpr size_t WS_WBR = WS_WUP + (size_t)DEPTH * 2048 * 512 * 2;
constexpr size_t WS_WOUT = WS_WBR + (size_t)DEPTH * 2048 * 3072 * 2;
constexpr size_t WS_H = WS_WOUT + (size_t)DEPTH * 2048 * 2048 * 2;
constexpr size_t WS_QA = WS_H + (size_t)MTOT * 2048 * 2;
constexpr size_t WS_KA = WS_QA + (size_t)MTOT * 1024 * 2;
constexpr size_t WS_VA = WS_KA + (size_t)MTOT * 256 * 2;
constexpr size_t WS_QB = WS_VA + (size_t)MTOT * 256 * 2;
constexpr size_t WS_KB = WS_QB + (size_t)MTOT * 1536 * 2;
constexpr size_t WS_CKV = WS_KB + (size_t)MTOT * 1536 * 2;
constexpr size_t WS_VB = WS_CKV + (size_t)MTOT * 512 * 2;
constexpr size_t WS_QC = WS_VB + (size_t)MTOT * 1024 * 2;
constexpr size_t WS_KC = WS_QC + (size_t)MTOT * 1024 * 2;
constexpr size_t WS_VC = WS_KC + (size_t)MTOT * 1024 * 2;
constexpr size_t WS_GATE = WS_VC + (size_t)MTOT * 1024 * 2;
constexpr size_t WS_MRG = WS_GATE + (size_t)MTOT * 3072 * 2;
constexpr size_t WS_BR = WS_MRG + (size_t)MTOT * 6144 * 2;
constexpr size_t WS_Y = WS_BR + (size_t)MTOT * 3072 * 2;
constexpr size_t WS_SS = WS_Y + (size_t)MTOT * 2048 * 2;
constexpr size_t WS_CTXW = WS_SS + (size_t)MTOT * 8 * 4;
constexpr size_t WS_SCR = WS_CTXW + (size_t)MCTX * DM * 4;
constexpr size_t WS_END = WS_SCR + (size_t)256 * 64 * 512 * 4;

constexpr int RING_BYTES = 131072, XCH_OFF = RING_BYTES, LDS_BYTES = 147456;

__device__ __forceinline__ float bf2f(unsigned h) { return __uint_as_float(h << 16); }
__device__ __forceinline__ unsigned cvt_pk_bf16(float lo, float hi) { unsigned r; asm volatile("v_cvt_pk_bf16_f32 %0, %1, %2" : "=v"(r) : "v"(lo), "v"(hi)); return r; }
__device__ __forceinline__ float wave_sum(float v) {
#pragma unroll
    for (int o = 1; o < 64; o <<= 1) v += __shfl_xor(v, o);
    return v;
}
__device__ __forceinline__ float sigm_f(float x) { return __builtin_amdgcn_rcpf(1.f + __builtin_amdgcn_exp2f(-1.4426950408889634f * x)); }
__device__ __forceinline__ float silu_f(float x) { return x * sigm_f(x); }
__device__ __forceinline__ unsigned cvt_pk_bf16_safe(float lo, float hi) { unsigned r; asm volatile("s_nop 1\n\tv_cvt_pk_bf16_f32 %0, %1, %2" : "=v"(r) : "v"(lo), "v"(hi)); return r; }
__device__ __forceinline__ void store8_safe(bf16_t* p, f32x4 a, f32x4 b) {
    u32x4 w; w.x = cvt_pk_bf16_safe(a[0], a[1]); w.y = cvt_pk_bf16_safe(a[2], a[3]); w.z = cvt_pk_bf16_safe(b[0], b[1]); w.w = cvt_pk_bf16_safe(b[2], b[3]);
    *(u32x4*)p = w;
}
__device__ __forceinline__ void store8(bf16_t* p, f32x4 a, f32x4 b) {
    u32x4 w; w.x = cvt_pk_bf16(a[0], a[1]); w.y = cvt_pk_bf16(a[2], a[3]); w.z = cvt_pk_bf16(b[0], b[1]); w.w = cvt_pk_bf16(b[2], b[3]);
    *(u32x4*)p = w;
}

namespace pg8 {
constexpr int BM = 256, BK = 64, HALF = 128, HTB = HALF * BK * 2, NXCD = 8, WGM = 8;
__host__ __device__ __forceinline__ int lds_byte(int r, int c) { const int st = (r >> 4) * 2 + (c >> 5), rr = r & 15, cc = c & 31, ob = rr * 64 + cc * 2; return st * 1024 + (ob ^ (((ob >> 9) & 1) << 5)); }
__host__ __device__ __forceinline__ void stage_rc(int b, int& R, int& C) { const int st = b / 1024, sb = b % 1024, swz = sb ^ (((sb >> 9) & 1) << 5); R = (st >> 1) * 16 + swz / 64; C = (st & 1) * 32 + (swz % 64) / 2; }
__host__ __device__ __forceinline__ int perm32(int rho) { const int n = rho >> 4, i = rho & 15; return 8 * (i >> 2) + 4 * n + (i & 3); }

struct Unit { int pm, pn; };
struct Gemm { const bf16_t* A; const bf16_t* Bt; int M, N, K; };
struct StaticOrder {
    int nM, nN, nwg, G, c, fixed, fpm, fpn;
    __device__ void init(int M, int N, int G_, int c_) { nM = M / BM; nN = N / BM; nwg = nM * nN; G = G_; c = c_; fixed = 0; fpm = 0; fpn = 0; }
    __device__ void init_one(int pm, int pn) { nM = 1; nN = 1; nwg = 1; G = 1; c = 0; fixed = 1; fpm = pm; fpn = pn; }
    __device__ bool next(int i, Unit& u) const {
        if (fixed) { if (i > 0) return false; u.pm = fpm; u.pn = fpn; return true; }
        const long L = (long)i * G + c; if (L >= nwg) return false;
        int wgid = (int)L; { const int q = nwg / NXCD, r = nwg % NXCD, xcd = wgid % NXCD, off = wgid / NXCD; wgid = (xcd < r ? xcd * (q + 1) : r * (q + 1) + (xcd - r) * q) + off; }
        const int nig = WGM * nN, gid = wgid / nig, fm = gid * WGM, gsz = (nM - fm) < WGM ? (nM - fm) : WGM;
        u.pm = fm + ((wgid % nig) % gsz); u.pn = (wgid % nig) / gsz; return true;
    }
};

template <class Epi>
__device__ __forceinline__ void gemm_phase(LAS unsigned char* lds, const Gemm g, const StaticOrder& S, const Epi& E, const int tid) {
    const int wid = __builtin_amdgcn_readfirstlane(tid >> 6), lane = tid & 63, wr = wid >> 2, wc = wid & 3, fr = lane & 15, fq = lane >> 4;
    const int K = g.K, nt = K / BK;
    unsigned voffA[2], voffB[2];
#pragma unroll
    for (int i = 0; i < 2; ++i) { int R, C; stage_rc(tid * 16 + i * 8192, R, C); const int Rb = (R & ~31) + perm32(R & 31);
        voffA[i] = (unsigned)(R * K + C) * 2u; voffB[i] = (unsigned)(Rb * K + C) * 2u; }
    const size_t kstep = (size_t)(BK * 2);
    const size_t hstep = (size_t)HALF * K * 2;
    const size_t tstep = 2 * hstep;
    const unsigned ldsw = (unsigned)wid * 1024u;
    const int aoff = lds_byte(wr * 64 + fr, fq * 8), boff = lds_byte(wc * 32 + fr, fq * 8);
#define PG8_SA(b, h) (((b) * 2 + (h)) * HTB)
#define PG8_SB(b, h) ((4 + (b) * 2 + (h)) * HTB)
#define PG8_STAGE(bufoff, gbase, voff) do { _Pragma("unroll") for (int _i = 0; _i < 2; ++_i) \
        __builtin_amdgcn_global_load_lds((const unsigned*)((const char*)(gbase) + (voff)[_i]), (LAS unsigned*)(lds + (bufoff) + ldsw + _i * 8192), 16, 0, 0); } while (0)
#define PG8_LDA(dst, b, h) do { _Pragma("unroll") for (int m = 0; m < 4; ++m) _Pragma("unroll") for (int k = 0; k < 2; ++k) dst[m][k] = *(const LAS bf16x8*)(lds + PG8_SA(b, h) + aoff + m * 2048 + k * 1024); } while (0)
#define PG8_LDB(dst, b, h) do { _Pragma("unroll") for (int n = 0; n < 2; ++n) _Pragma("unroll") for (int k = 0; k < 2; ++k) dst[n][k] = *(const LAS bf16x8*)(lds + PG8_SB(b, h) + boff + n * 2048 + k * 1024); } while (0)
#define PG8_MMA(ai, bj, At, Bt) do { __builtin_amdgcn_s_setprio(1); _Pragma("unroll") for (int m = 0; m < 4; ++m) _Pragma("unroll") for (int n = 0; n < 2; ++n) _Pragma("unroll") for (int k = 0; k < 2; ++k) \
        acc[ai][bj][m][n] = __builtin_amdgcn_mfma_f32_16x16x32_bf16(Bt[n][k], At[m][k], acc[ai][bj][m][n], 0, 0, 0); __builtin_amdgcn_s_setprio(0); } while (0)
#define PG8_WAIT_V(n) asm volatile("s_waitcnt vmcnt(" #n ")" ::: "memory")
#define PG8_WAIT_L(n) asm volatile("s_waitcnt lgkmcnt(" #n ")" ::: "memory")
#define PG8_BAR __builtin_amdgcn_s_barrier()
#define PG8_SCHED __builtin_amdgcn_sched_barrier(0)
    Unit cur, nxt; int ui = 0;
    if (!S.next(0, cur)) return;
    f32x4 acc[2][2][4][2];
#pragma unroll
    for (int a = 0; a < 2; ++a)
#pragma unroll
        for (int b = 0; b < 2; ++b)
#pragma unroll
            for (int m = 0; m < 4; ++m)
#pragma unroll
                for (int n = 0; n < 2; ++n) acc[a][b][m][n] = (f32x4){0.f, 0.f, 0.f, 0.f};
    bf16x8 At[4][2], B0[2][2], B1[2][2];
    const char* cA = (const char*)g.A + (size_t)cur.pm * tstep; const char* cB = (const char*)g.Bt + (size_t)cur.pn * tstep;
    PG8_STAGE(PG8_SB(0, 0), cB, voffB); PG8_STAGE(PG8_SB(0, 1), cB + hstep, voffB); PG8_STAGE(PG8_SA(0, 0), cA, voffA); PG8_STAGE(PG8_SA(0, 1), cA + hstep, voffA);
    if (wr == 1) PG8_BAR;
    PG8_WAIT_V(2); PG8_BAR;
    PG8_STAGE(PG8_SB(1, 0), cB + kstep, voffB); PG8_STAGE(PG8_SA(1, 0), cA + kstep, voffA); PG8_STAGE(PG8_SB(1, 1), cB + hstep + kstep, voffB);
    PG8_WAIT_V(6); PG8_BAR;
    for (;;) {
        const bool has_next = S.next(ui + 1, nxt);
        const char* nA = has_next ? (const char*)g.A + (size_t)nxt.pm * tstep : cA; const char* nB = has_next ? (const char*)g.Bt + (size_t)nxt.pn * tstep : cB;
        for (int t = 0; t < nt; t += 2) {
            const bool last = (t == nt - 2);
            const char* a1 = cA + (size_t)(t + 1) * kstep;
            const char* a2 = last ? nA : cA + (size_t)(t + 2) * kstep; const char* b2 = last ? nB : cB + (size_t)(t + 2) * kstep;
            const char* a3 = a2 + kstep; const char* b3 = b2 + kstep;
            if constexpr (Epi::MID) { if (t == 16 || t == 32) { int fr_ = fr, fq_ = fq, wr_ = wr, wc_ = wc;
                asm volatile("" : "+v"(fr_), "+v"(fq_)); asm volatile("" : "+s"(wr_), "+s"(wc_));
                E.mid(acc, cur, t >> 4, wr_, wc_, fr_, fq_); PG8_WAIT_V(0); PG8_SCHED; } }
            PG8_LDB(B0, 0, 0); PG8_LDB(B1, 0, 1); PG8_SCHED; PG8_LDA(At, 0, 0); PG8_STAGE(PG8_SA(1, 1), a1 + hstep, voffA);
            PG8_WAIT_V(8); PG8_WAIT_L(0); PG8_BAR; PG8_MMA(0, 0, At, B0); PG8_MMA(0, 1, At, B1); PG8_BAR; PG8_SCHED;
            PG8_LDA(At, 0, 1); PG8_STAGE(PG8_SB(0, 0), b2, voffB); PG8_STAGE(PG8_SB(0, 1), b2 + hstep, voffB); PG8_STAGE(PG8_SA(0, 0), a2, voffA);
            PG8_WAIT_V(8); PG8_WAIT_L(0); PG8_BAR; PG8_MMA(1, 0, At, B0); PG8_MMA(1, 1, At, B1); PG8_BAR; PG8_SCHED;
            PG8_LDB(B0, 1, 0); PG8_LDB(B1, 1, 1); PG8_SCHED; PG8_LDA(At, 1, 0); PG8_STAGE(PG8_SA(0, 1), a2 + hstep, voffA);
            PG8_WAIT_V(8); PG8_WAIT_L(0); PG8_BAR; PG8_MMA(0, 0, At, B0); PG8_MMA(0, 1, At, B1); PG8_BAR; PG8_SCHED;
            PG8_LDA(At, 1, 1); PG8_STAGE(PG8_SB(1, 0), b3, voffB); PG8_STAGE(PG8_SB(1, 1), b3 + hstep, voffB); PG8_STAGE(PG8_SA(1, 0), a3, voffA);
            PG8_WAIT_V(8); PG8_WAIT_L(0); PG8_BAR; PG8_MMA(1, 0, At, B0); PG8_MMA(1, 1, At, B1); PG8_BAR; PG8_SCHED;
        }
        if (wr == 0) PG8_BAR;
        { int fr_ = fr, fq_ = fq, wr_ = wr, wc_ = wc, wid_ = wid;
          asm volatile("" : "+v"(fr_), "+v"(fq_)); asm volatile("" : "+s"(wr_), "+s"(wc_), "+s"(wid_));
          E(acc, cur, wr_, wc_, fr_, fq_, wid_); }
        if (!has_next) break;
#pragma unroll
        for (int a = 0; a < 2; ++a)
#pragma unroll
            for (int b = 0; b < 2; ++b)
#pragma unroll
                for (int m = 0; m < 4; ++m)
#pragma unroll
                    for (int n = 0; n < 2; ++n) acc[a][b][m][n] = (f32x4){0.f, 0.f, 0.f, 0.f};
        cur = nxt; cA = nA; cB = nB; ++ui;
        if (wr == 1) PG8_BAR;
    }
    PG8_WAIT_V(0);
    PG8_BAR;
#undef PG8_SA
#undef PG8_SB
#undef PG8_STAGE
#undef PG8_LDA
#undef PG8_LDB
#undef PG8_MMA
#undef PG8_WAIT_V
#undef PG8_WAIT_L
#undef PG8_BAR
#undef PG8_SCHED
}
}
using pg8::Unit;

__device__ __forceinline__ int in_src_col(int n) {
    const int tile = n >> 8, s = n & 255, bj = s >> 7, wc = (s >> 5) & 3, c = s & 31;
    const int d128 = 64 * (wc & 1) + 32 * bj + c, g128 = wc >> 1;
    const int d64 = 32 * (c >> 4) + 16 * bj + (c & 15), g64 = wc;
    if (tile < 4) return (tile * 2 + g128) * 128 + d128;
    if (tile == 4) return 1024 + g128 * 128 + d128;
    if (tile == 5) return 1280 + s;
    if (tile < 10) return 1536 + ((tile - 6) * 2 + g128) * 192 + d128;
    if (tile < 12) return 1536 + ((tile - 10) * 4 + g64) * 192 + 128 + d64;
    if (tile < 14) return 3072 + (tile - 12) * 256 + s;
    if (tile == 14) return g64 == 0 ? 3584 + d64 : -1;
    if (tile < 19) return 3648 + ((tile - 15) * 4 + g64) * 64 + d64;
    if (tile < 23) return 4672 + ((tile - 19) * 4 + g64) * 64 + d64;
    if (tile < 27) return 5696 + (tile - 23) * 256 + s;
    if (tile < 39) return 6720 + (tile - 27) * 256 + s;
    return 9792 + (tile - 39) * 256 + s;
}
__device__ __forceinline__ int up_src_col(int n) {
    if (n >= 1024) return n;
    const int tile = n >> 8, s = n & 255, bj = s >> 7, wc = (s >> 5) & 3, c = s & 31;
    return (tile * 2 + (wc >> 1)) * 128 + 64 * (wc & 1) + 32 * bj + c;
}

template <int GS>
__device__ __forceinline__ void norm_rope_store(const f32x4 (&acc)[2][2][4][2], int pm, int wr, int wc, int fr, int fq, int wid,
                                                const float* __restrict__ w, const float* __restrict__ tcos, const float* __restrict__ tsin, bool rope,
                                                const float (&pre)[2][4], bf16_t* __restrict__ dst, int ld, int gbase, int ncopies, int copystride, LAS float* xch) {
    const int dbase = (GS == 128) ? 64 * (wc & 1) + 8 * fq : 32 * (fq >> 1) + 8 * (fq & 1);
    const int bjs = (GS == 128) ? 32 : 16;
    const int axis = (GS == 128) ? (wc & 1) : (fq >> 1);
    const int i0 = (GS == 128) ? 8 * fq : 8 * (fq & 1);
    constexpr int NF = (GS == 128) ? 32 : 16;
    const int wavebase = gbase + ((GS == 128) ? 64 * (wc & 1) : 0) + 8 * fq;
    float ssq[2][4];
#pragma unroll
    for (int ai = 0; ai < 2; ++ai)
#pragma unroll
        for (int m = 0; m < 4; ++m) {
            float s = 0.f;
#pragma unroll
            for (int bj = 0; bj < 2; ++bj)
#pragma unroll
                for (int n = 0; n < 2; ++n)
#pragma unroll
                    for (int j = 0; j < 4; ++j) { const float v = acc[ai][bj][m][n][j] * pre[ai][m]; s += v * v; }
            s += __shfl_xor(s, 16); s += __shfl_xor(s, 32);
            ssq[ai][m] = s;
        }
    if constexpr (GS == 128) {
        if (fq == 0) {
#pragma unroll
            for (int ai = 0; ai < 2; ++ai)
#pragma unroll
                for (int m = 0; m < 4; ++m) xch[wid * 128 + ai * 64 + m * 16 + fr] = ssq[ai][m];
        }
        asm volatile("s_waitcnt lgkmcnt(0)" ::: "memory"); __builtin_amdgcn_s_barrier();
#pragma unroll
        for (int ai = 0; ai < 2; ++ai)
#pragma unroll
            for (int m = 0; m < 4; ++m) ssq[ai][m] += xch[(wid ^ 1) * 128 + ai * 64 + m * 16 + fr];
    }
#pragma unroll
    for (int ai = 0; ai < 2; ++ai)
#pragma unroll
        for (int m = 0; m < 4; ++m) {
            const int rl = ai * 128 + wr * 64 + m * 16 + fr;
            const size_t row = (size_t)pm * 256 + rl;
            const float rinv = rsqrtf(ssq[ai][m] * (1.f / GS) + EPS) * pre[ai][m];
            const int t = (pm & 15) * 256 + rl; const int pos = axis ? (t & 63) : (t >> 6);
            u32x4 k0, k1;
#pragma unroll
            for (int n = 0; n < 2; ++n) {
                const f32x4 w0 = *(const f32x4*)(w + dbase + 4 * n), w1 = *(const f32x4*)(w + dbase + bjs + 4 * n);
                f32x4 y0 = acc[ai][0][m][n] * rinv * w0, y1 = acc[ai][1][m][n] * rinv * w1;
                if (rope) {
                    const f32x4 c = *(const f32x4*)(tcos + pos * NF + i0 + 4 * n), sn = *(const f32x4*)(tsin + pos * NF + i0 + 4 * n);
                    const f32x4 o0 = y0 * c - y1 * sn, o1 = y1 * c + y0 * sn;
                    y0 = o0; y1 = o1;
                }
                if (n == 0) { k0.x = cvt_pk_bf16(y0[0], y0[1]); k0.y = cvt_pk_bf16(y0[2], y0[3]); k1.x = cvt_pk_bf16(y1[0], y1[1]); k1.y = cvt_pk_bf16(y1[2], y1[3]); }
                else { k0.z = cvt_pk_bf16(y0[0], y0[1]); k0.w = cvt_pk_bf16(y0[2], y0[3]); k1.z = cvt_pk_bf16(y1[0], y1[1]); k1.w = cvt_pk_bf16(y1[2], y1[3]); }
            }
            bf16_t* p = dst + row * ld + wavebase;
            for (int cp = 0; cp < ncopies; ++cp) { *(u32x4*)(p + cp * copystride) = k0; *(u32x4*)(p + cp * copystride + 32) = k1; }
            __builtin_amdgcn_sched_barrier(0);
        }
}

struct EpiIn {
    static constexpr bool MID = false;
    bf16_t *QA, *KA, *VA, *QB, *KB, *CKV, *QC, *KC, *VC, *GATE, *MRG; float* SS;
    const float *wAq, *wAk, *wBqn, *wBqr, *wBkr, *wCq, *wCk, *bmerge;
    const float *tc64, *ts64, *tc128, *ts128;
    LAS float* xch;
    template <int ACT>
    __device__ __forceinline__ void plain(const f32x4 (&acc)[2][2][4][2], int pm, int wr, int wc, int fr, int fq, bf16_t* dst, int ld, int col0) const {
        const int colw = col0 + 32 * wc + 8 * fq;
        f32x4 b[2][2];
#pragma unroll
        for (int bj = 0; bj < 2; ++bj)
#pragma unroll
            for (int n = 0; n < 2; ++n) b[bj][n] = (ACT == 2) ? *(const f32x4*)(bmerge + colw + bj * 128 + 4 * n) : (f32x4){0.f, 0.f, 0.f, 0.f};
#pragma unroll
        for (int ai = 0; ai < 2; ++ai)
#pragma unroll
            for (int m = 0; m < 4; ++m) {
                const size_t row = (size_t)pm * 256 + ai * 128 + wr * 64 + m * 16 + fr;
#pragma unroll
                for (int bj = 0; bj < 2; ++bj) {
                    f32x4 v0 = acc[ai][bj][m][0], v1 = acc[ai][bj][m][1];
                    if (ACT == 1) { for (int j = 0; j < 4; ++j) { v0[j] = silu_f(v0[j]); v1[j] = silu_f(v1[j]); } }
                    if (ACT == 2) { v0 = v0 + b[bj][0]; v1 = v1 + b[bj][1]; for (int j = 0; j < 4; ++j) { v0[j] = sigm_f(v0[j]); v1[j] = sigm_f(v1[j]); } }
                    if (ACT == 0) store8(dst + row * ld + colw + bj * 128, v0, v1); else store8_safe(dst + row * ld + colw + bj * 128, v0, v1);
                }
                __builtin_amdgcn_sched_barrier(0);
            }
    }
    __device__ __forceinline__ void operator()(const f32x4 (&acc)[2][2][4][2], const Unit& u, int wr, int wc, int fr, int fq, int wid) const {
        const int t = u.pn, pm = u.pm; const bool rope = pm < 64;
        const float one[2][4] = {{1.f, 1.f, 1.f, 1.f}, {1.f, 1.f, 1.f, 1.f}};
        if (t < 4 && (MK_G1T & 1)) norm_rope_store<128>(acc, pm, wr, wc, fr, fq, wid, wAq, tc128, ts128, rope, one, QA, 1024, (t * 2 + (wc >> 1)) * 128, 1, 0, xch);
        else if (t == 4 && (MK_G1T & 1)) norm_rope_store<128>(acc, pm, wr, wc, fr, fq, wid, wAk, tc128, ts128, rope, one, KA, 256, (wc >> 1) * 128, 1, 0, xch);
        else if (t == 5 && (MK_G1T & 2)) plain<0>(acc, pm, wr, wc, fr, fq, VA, 256, 0);
        else if (t < 10 && (MK_G1T & 1)) norm_rope_store<128>(acc, pm, wr, wc, fr, fq, wid, wBqn, tc128, ts128, false, one, QB, 1536, ((t - 6) * 2 + (wc >> 1)) * 192, 1, 0, xch);
        else if (t < 12 && (MK_G1T & 4)) norm_rope_store<64>(acc, pm, wr, wc, fr, fq, wid, wBqr, tc64, ts64, rope, one, QB, 1536, ((t - 10) * 4 + wc) * 192 + 128, 1, 0, xch);
        else if (t < 14 && (MK_G1T & 8)) {
            plain<0>(acc, pm, wr, wc, fr, fq, CKV, 512, (t - 12) * 256);
#pragma unroll
            for (int ai = 0; ai < 2; ++ai)
#pragma unroll
                for (int m = 0; m < 4; ++m) {
                    float s = 0.f;
#pragma unroll
                    for (int bj = 0; bj < 2; ++bj)
#pragma unroll
                        for (int n = 0; n < 2; ++n)
#pragma unroll
                            for (int j = 0; j < 4; ++j) { const float v = acc[ai][bj][m][n][j]; s += v * v; }
                    s += __shfl_xor(s, 16); s += __shfl_xor(s, 32);
                    if (fq == 0) SS[((size_t)pm * 256 + ai * 128 + wr * 64 + m * 16 + fr) * 8 + (t - 12) * 4 + wc] = s;
                }
        }
        else if (t == 14 && (MK_G1T & 16)) { if (wc == 0) norm_rope_store<64>(acc, pm, wr, wc, fr, fq, wid, wBkr, tc64, ts64, rope, one, KB, 1536, 128, 8, 192, xch); }
        else if (t < 19 && (MK_G1T & 4)) norm_rope_store<64>(acc, pm, wr, wc, fr, fq, wid, wCq, tc64, ts64, rope, one, QC, 1024, ((t - 15) * 4 + wc) * 64, 1, 0, xch);
        else if (t < 23 && (MK_G1T & 4)) norm_rope_store<64>(acc, pm, wr, wc, fr, fq, wid, wCk, tc64, ts64, rope, one, KC, 1024, ((t - 19) * 4 + wc) * 64, 1, 0, xch);
        else if (t < 27 && (MK_G1T & 2)) plain<0>(acc, pm, wr, wc, fr, fq, VC, 1024, (t - 23) * 256);
        else if (t < 39 && (MK_G1T & 32)) plain<1>(acc, pm, wr, wc, fr, fq, GATE, 3072, (t - 27) * 256);
        else if (MK_G1T & 64) plain<2>(acc, pm, wr, wc, fr, fq, MRG, 6144, (t - 39) * 256);
    }
};

struct EpiUp {
    static constexpr bool MID = false;
    bf16_t *KB, *VB; const float* SS; const float* wBkn; LAS float* xch;
    __device__ __forceinline__ void operator()(const f32x4 (&acc)[2][2][4][2], const Unit& u, int wr, int wc, int fr, int fq, int wid) const {
        const int t = u.pn, pm = u.pm;
        float pre[2][4];
#pragma unroll
        for (int ai = 0; ai < 2; ++ai)
#pragma unroll
            for (int m = 0; m < 4; ++m) {
                const size_t row = (size_t)pm * 256 + ai * 128 + wr * 64 + m * 16 + fr;
                const f32x4 a = *(const f32x4*)(SS + row * 8), b = *(const f32x4*)(SS + row * 8 + 4);
                pre[ai][m] = rsqrtf(((a[0] + a[1]) + (a[2] + a[3]) + (b[0] + b[1]) + (b[2] + b[3])) * (1.f / 512.f) + EPS);
                __builtin_amdgcn_sched_barrier(0);
            }
        if (t < 4) norm_rope_store<128>(acc, pm, wr, wc, fr, fq, wid, wBkn, nullptr, nullptr, false, pre, KB, 1536, (t * 2 + (wc >> 1)) * 192, 1, 0, xch);
        else {
            const int colw = (t - 4) * 256 + 32 * wc + 8 * fq;
#pragma unroll
            for (int ai = 0; ai < 2; ++ai)
#pragma unroll
                for (int m = 0; m < 4; ++m) {
                    const size_t row = (size_t)pm * 256 + ai * 128 + wr * 64 + m * 16 + fr;
#pragma unroll
                    for (int bj = 0; bj < 2; ++bj) store8(VB + row * 1024 + colw + bj * 128, acc[ai][bj][m][0] * pre[ai][m], acc[ai][bj][m][1] * pre[ai][m]);
                    __builtin_amdgcn_sched_barrier(0);
                }
        }
    }
};

struct EpiBr {
    static constexpr bool MID = true;
    const bf16_t* MRG; bf16_t* Y;
    __device__ __forceinline__ void mid(f32x4 (&acc)[2][2][4][2], const Unit& u, int i, int wr, int wc, int fr, int fq) const {
#pragma unroll
        for (int ai = 0; ai < 2; ++ai)
#pragma unroll
            for (int m = 0; m < 4; ++m) {
                const size_t row = (size_t)u.pm * 256 + ai * 128 + wr * 64 + m * 16 + fr;
#pragma unroll
                for (int bj = 0; bj < 2; ++bj) {
                    const int col = u.pn * 256 + bj * 128 + 32 * wc + 8 * fq;
                    const u32x4 a = *(const u32x4*)(MRG + row * 6144 + (i - 1) * 2048 + col), b = *(const u32x4*)(MRG + row * 6144 + i * 2048 + col);
#pragma unroll
                    for (int q = 0; q < 4; ++q) {
                        const float r0 = bf2f(a[q] & 0xffffu) * __builtin_amdgcn_rcpf(bf2f(b[q] & 0xffffu)), r1 = bf2f(a[q] >> 16) * __builtin_amdgcn_rcpf(bf2f(b[q] >> 16));
                        acc[ai][bj][m][q >> 1][(q & 1) * 2] *= r0; acc[ai][bj][m][q >> 1][(q & 1) * 2 + 1] *= r1;
                    }
                }
                __builtin_amdgcn_sched_barrier(0);
            }
    }
    __device__ __forceinline__ void operator()(const f32x4 (&acc)[2][2][4][2], const Unit& u, int wr, int wc, int fr, int fq, int wid) const {
#pragma unroll
        for (int ai = 0; ai < 2; ++ai)
#pragma unroll
            for (int m = 0; m < 4; ++m) {
                const size_t row = (size_t)u.pm * 256 + ai * 128 + wr * 64 + m * 16 + fr;
#pragma unroll
                for (int bj = 0; bj < 2; ++bj) {
                    const int col = u.pn * 256 + bj * 128 + 32 * wc + 8 * fq;
                    const u32x4 a = *(const u32x4*)(MRG + row * 6144 + 4096 + col);
                    f32x4 v0 = acc[ai][bj][m][0], v1 = acc[ai][bj][m][1];
                    v0[0] *= bf2f(a[0] & 0xffffu); v0[1] *= bf2f(a[0] >> 16); v0[2] *= bf2f(a[1] & 0xffffu); v0[3] *= bf2f(a[1] >> 16);
                    v1[0] *= bf2f(a[2] & 0xffffu); v1[1] *= bf2f(a[2] >> 16); v1[2] *= bf2f(a[3] & 0xffffu); v1[3] *= bf2f(a[3] >> 16);
                    store8(Y + row * 2048 + col, v0, v1);
                }
                __builtin_amdgcn_sched_barrier(0);
            }
    }
};

struct EpiOut {
    static constexpr bool MID = false;
    const float *xsrc, *csrc; float *xdst, *cdst; const float* mod;
    __device__ __forceinline__ void operator()(const f32x4 (&acc)[2][2][4][2], const Unit& u, int wr, int wc, int fr, int fq, int wid) const {
        const int pm = u.pm; const bool lat = pm < 64;
        const int mi = lat ? (pm >> 4) : 4;
        const float* src = lat ? xsrc : csrc - (size_t)MLAT * DM; float* dst = lat ? xdst : cdst - (size_t)MLAT * DM;
        const float* g = mod + mi * 6144 + 4096;
#pragma unroll
        for (int bj = 0; bj < 2; ++bj) {
            const int col = u.pn * 256 + bj * 128 + 32 * wc + 8 * fq;
            const f32x4 g0 = *(const f32x4*)(g + col), g1 = *(const f32x4*)(g + col + 4);
#pragma unroll
            for (int ai = 0; ai < 2; ++ai)
#pragma unroll
                for (int m = 0; m < 4; ++m) {
                    const size_t row = (size_t)pm * 256 + ai * 128 + wr * 64 + m * 16 + fr;
                    const f32x4 x0 = *(const f32x4*)(src + row * DM + col), x1 = *(const f32x4*)(src + row * DM + col + 4);
                    *(f32x4*)(dst + row * DM + col) = x0 + g0 * acc[ai][bj][m][0];
                    *(f32x4*)(dst + row * DM + col + 4) = x1 + g1 * acc[ai][bj][m][1];
                    __builtin_amdgcn_sched_barrier(0);
                }
        }
    }
};

namespace att {
#define SBAR() __builtin_amdgcn_sched_barrier(0)
__device__ __forceinline__ int crow(int r, int hi) { return (r & 3) + 8 * (r >> 2) + 4 * hi; }
template <int RB> __device__ __forceinline__ int kswz(int row, int colB) { const int x = (RB == 256) ? (row & 7) : ((row >> 1) & 7); return row * RB + (colB ^ (x << 4)); }
__device__ __forceinline__ int v_st(int k, int c) { const int kk = (k & ~0xC) | ((k & 4) << 1) | ((k & 8) >> 1); return ((kk >> 3) * 4 + (c >> 5)) * 512 + ((kk & 7) * 32 + (c & 31)) * 2; }
__device__ __forceinline__ int v_rd_base(int lane) { return ((lane & 3) << 3) | (((lane >> 2) & 3) << 6) | (((lane >> 4) & 1) << 5) | (((lane >> 5) & 1) << 8); }
constexpr int v_rd_off(int d0, int ks, int half) { return d0 * 512 + ks * 4096 + half * 2048; }
template <int OFF> __device__ __forceinline__ s16x4 tr_read(unsigned vb) {
    s16x4 r; asm volatile("ds_read_b64_tr_b16 %0, %1 offset:%2" : "=&v"(r) : "v"(vb), "i"(OFF) : "memory"); return r;
}
template <int D0> __device__ __forceinline__ void pv_one(f32x16& od, unsigned vb, bf16x8 pa0, bf16x8 pa1, bf16x8 pa2, bf16x8 pa3) {
    const s16x4 l0 = tr_read<v_rd_off(D0, 0, 0)>(vb), h0 = tr_read<v_rd_off(D0, 0, 1)>(vb), l1 = tr_read<v_rd_off(D0, 1, 0)>(vb), h1 = tr_read<v_rd_off(D0, 1, 1)>(vb);
    const s16x4 l2 = tr_read<v_rd_off(D0, 2, 0)>(vb), h2 = tr_read<v_rd_off(D0, 2, 1)>(vb), l3 = tr_read<v_rd_off(D0, 3, 0)>(vb), h3 = tr_read<v_rd_off(D0, 3, 1)>(vb);
    asm volatile("s_waitcnt lgkmcnt(0)" ::: "memory"); SBAR();
#define PK(L, H) (bf16x8){L[0], L[1], L[2], L[3], H[0], H[1], H[2], H[3]}
    od = __builtin_amdgcn_mfma_f32_32x32x16_bf16(pa0, PK(l0, h0), od, 0, 0, 0);
    od = __builtin_amdgcn_mfma_f32_32x32x16_bf16(pa1, PK(l1, h1), od, 0, 0, 0);
    od = __builtin_amdgcn_mfma_f32_32x32x16_bf16(pa2, PK(l2, h2), od, 0, 0, 0);
    od = __builtin_amdgcn_mfma_f32_32x32x16_bf16(pa3, PK(l3, h3), od, 0, 0, 0);
#undef PK
}
__device__ __forceinline__ void pv_d0(f32x16 (&o)[4], unsigned vb, bf16x8 pa0, bf16x8 pa1, bf16x8 pa2, bf16x8 pa3) {
    pv_one<0>(o[0], vb, pa0, pa1, pa2, pa3); pv_one<1>(o[1], vb, pa0, pa1, pa2, pa3); pv_one<2>(o[2], vb, pa0, pa1, pa2, pa3); pv_one<3>(o[3], vb, pa0, pa1, pa2, pa3);
}
__device__ __forceinline__ void partialSM(f32x16& p0, f32x16& p1, float C, float nMB) {
#pragma unroll
    for (int r = 0; r < 16; ++r) p0[r] = fmaf(p0[r], C, nMB);
#pragma unroll
    for (int r = 0; r < 16; ++r) p1[r] = fmaf(p1[r], C, nMB);
#pragma unroll
    for (int r = 0; r < 16; ++r) p0[r] = __builtin_amdgcn_exp2f(p0[r]);
}
__device__ __forceinline__ void finishSM(f32x16& p0, f32x16& p1, float& l_reg, bf16x8& pa0, bf16x8& pa1, bf16x8& pa2, bf16x8& pa3) {
#pragma unroll
    for (int r = 0; r < 16; ++r) p1[r] = __builtin_amdgcn_exp2f(p1[r]);
    float ps = 0;
#pragma unroll
    for (int r = 0; r < 16; ++r) ps += p0[r];
#pragma unroll
    for (int r = 0; r < 16; ++r) ps += p1[r];
    { auto rr = __builtin_amdgcn_permlane32_swap(__float_as_uint(ps), __float_as_uint(ps), false, false);
      ps = __uint_as_float(rr[0]) + __uint_as_float(rr[1]); }
    l_reg += ps;
#define PK4(P, BASE, OUT) do { unsigned a0 = cvt_pk_bf16(P[BASE + 0], P[BASE + 1]), a1 = cvt_pk_bf16(P[BASE + 2], P[BASE + 3]);   \
    unsigned b0 = cvt_pk_bf16(P[BASE + 4], P[BASE + 5]), b1 = cvt_pk_bf16(P[BASE + 6], P[BASE + 7]);                              \
    auto r0 = __builtin_amdgcn_permlane32_swap(a0, b0, false, false); auto r1 = __builtin_amdgcn_permlane32_swap(a1, b1, false, false); \
    u32x4 w = {r0[0], r1[0], r0[1], r1[1]}; OUT = *reinterpret_cast<bf16x8*>(&w); } while (0)
    PK4(p0, 0, pa0); PK4(p0, 8, pa1); PK4(p1, 0, pa2); PK4(p1, 8, pa3);
#undef PK4
}
template <int DQK>
__device__ __forceinline__ void qkt(f32x16& p0, f32x16& p1, const LAS char* Ks, const bf16x8 (&qr)[DQK / 16], int r32, int hi) {
    constexpr int RB = DQK * 2;
    p0 = f32x16{}; p1 = f32x16{};
#pragma unroll
    for (int d0 = 0; d0 < DQK / 16; ++d0) { const int cb = (d0 * 16 + hi * 8) * 2;
        const bf16x8 b0 = *(const LAS bf16x8*)(Ks + kswz<RB>(r32, cb));
        const bf16x8 b1 = *(const LAS bf16x8*)(Ks + kswz<RB>(32 + r32, cb));
        p0 = __builtin_amdgcn_mfma_f32_32x32x16_bf16(b0, qr[d0], p0, 0, 0, 0);
        p1 = __builtin_amdgcn_mfma_f32_32x32x16_bf16(b1, qr[d0], p1, 0, 0, 0);
        if (QKT_GRP > 0 && (d0 % QKT_GRP) == QKT_GRP - 1 && d0 + 1 < DQK / 16) SBAR(); }
}
constexpr int V_BYTES = 64 * 128 * 2, K_OFF = 3 * V_BYTES, K_STRIDE = 64 * 192 * 2, LI_OFF = K_OFF + 3 * K_STRIDE;

template <int DQK, bool DOUBLE>
__device__ __forceinline__ void attn_pass(const bf16_t* __restrict__ Q, int ldq, const bf16_t* __restrict__ Kg, int ldk, const bf16_t* __restrict__ Vg, int ldv,
                                          int rowc, int rowl, int NT, float C, float nMB, f32x16 (&o)[4], float& l_reg, LAS char* lds, int tid) {
    constexpr int RB = DQK * 2, NCH = DQK / 8, NLD = NCH / 8;
    const int wid = __builtin_amdgcn_readfirstlane(tid >> 6), lane = tid & 63, r32 = lane & 31, hi = lane >> 5;
    LAS char* V_lds = lds; LAS char* K_lds = lds + K_OFF;
    bf16x8 qr[DQK / 16];
    { const bf16_t* Qw = Q + (size_t)(wid * 32 + r32) * ldq + hi * 8;
#pragma unroll
      for (int d0 = 0; d0 < DQK / 16; ++d0) qr[d0] = *(const bf16x8*)(Qw + d0 * 16); }
#pragma unroll
    for (int d = 0; d < 4; ++d) o[d] = f32x16{};
    l_reg = 0.f;
    int vrow[2], vcol[2], krow[NLD], kcol[NLD];
#pragma unroll
    for (int i = 0; i < 2; ++i) { const int q = tid + 512 * i, sub = q >> 5, within = q & 31, kk = (sub >> 2) * 8 + (within >> 2);
        vrow[i] = (kk & ~0xC) | ((kk & 4) << 1) | ((kk & 8) >> 1); vcol[i] = (sub & 3) * 32 + (within & 3) * 8; }
#pragma unroll
    for (int i = 0; i < NLD; ++i) { const int q = tid + 512 * i, row = q / NCH, chp = q % NCH; const int x = (RB == 256) ? (row & 7) : ((row >> 1) & 7);
        krow[i] = row; kcol[i] = (chp ^ x) * 8; }
    const unsigned vb0 = (unsigned)(uintptr_t)V_lds + v_rd_base(lane);
#define KROW0(j) ((j) < 4 ? rowc + 64 * (j) : rowl + 64 * ((j) - 4))
#define DMA(j, b) do { const size_t _r0 = (size_t)KROW0(j); \
    _Pragma("unroll") for (int _i = 0; _i < 2; ++_i) __builtin_amdgcn_global_load_lds((const unsigned*)(Vg + (_r0 + vrow[_i]) * ldv + vcol[_i]), (LAS unsigned*)(V_lds + (b) * V_BYTES + wid * 1024 + _i * 8192), 16, 0, 0); \
    _Pragma("unroll") for (int _i = 0; _i < NLD; ++_i) __builtin_amdgcn_global_load_lds((const unsigned*)(Kg + (_r0 + krow[_i]) * ldk + kcol[_i]), (LAS unsigned*)(K_lds + (b) * K_STRIDE + wid * 1024 + _i * 8192), 16, 0, 0); } while (0)
#define VMW0() asm volatile("s_waitcnt vmcnt(0)" ::: "memory")
    bf16x8 pa0, pa1, pa2, pa3;
    __syncthreads();
    DMA(0, 0); DMA(1, 1); VMW0(); __syncthreads();
    if constexpr (!DOUBLE) {
        f32x16 p0, p1;
        DMA(2, 2);
        int bc = 0, bn = 1, bf = 2;
        for (int j = 0; j < NT; ++j) {
            SBAR(); qkt<DQK>(p0, p1, K_lds + bc * K_STRIDE, qr, r32, hi);
            partialSM(p0, p1, C, nMB); finishSM(p0, p1, l_reg, pa0, pa1, pa2, pa3); SBAR();
            pv_d0(o, vb0 + bc * V_BYTES, pa0, pa1, pa2, pa3);
            if (j + 1 < NT) { VMW0(); __syncthreads(); if (j + 3 < NT) DMA(j + 3, bc); }
            { const int _t = bc; bc = bn; bn = bf; bf = _t; }
        }
    } else {
    f32x16 pA0, pA1, pB0, pB1;
    qkt<DQK>(pA0, pA1, K_lds, qr, r32, hi); partialSM(pA0, pA1, C, nMB);
    DMA(2, 2);
    int bp = 0, bc = 1, bn = 2;
#define STEP(j, PC0, PC1, PP0, PP1) do { \
        SBAR(); qkt<DQK>(PC0, PC1, K_lds + bc * K_STRIDE, qr, r32, hi); \
        finishSM(PP0, PP1, l_reg, pa0, pa1, pa2, pa3); SBAR(); \
        pv_d0(o, vb0 + bp * V_BYTES, pa0, pa1, pa2, pa3); partialSM(PC0, PC1, C, nMB); \
        if ((j) + 1 < NT) { VMW0(); __syncthreads(); if ((j) + 2 < NT) DMA((j) + 2, bp); } \
        { const int _t = bp; bp = bc; bc = bn; bn = _t; } } while (0)
    for (int j = 1; j < NT; j += 2) {
        STEP(j, pB0, pB1, pA0, pA1);
        if (j + 1 < NT) STEP(j + 1, pA0, pA1, pB0, pB1);
    }
    finishSM(pB0, pB1, l_reg, pa0, pa1, pa2, pa3); SBAR();
    pv_d0(o, vb0 + bp * V_BYTES, pa0, pa1, pa2, pa3);
    }
#undef KROW0
#undef DMA
#undef VMW0
#undef STEP
}
__device__ __forceinline__ void row_recip(float l_reg, float (&rli)[16], LAS float* li, int r32, int hi) {
    if (hi == 0) li[r32] = l_reg;
    asm volatile("s_waitcnt lgkmcnt(0)" ::: "memory");
#pragma unroll
    for (int r = 0; r < 16; ++r) rli[r] = __builtin_amdgcn_rcpf(li[crow(r, hi)]);
    asm volatile("s_waitcnt lgkmcnt(0)" ::: "memory");
}
}

struct AttnBufs { const bf16_t *QA, *KA, *VA, *QB, *KB, *VB, *QC, *KC, *VC, *GATE; bf16_t* BR; float* SCR; const float* lamv; const float* subln; float lam_init; };

template <bool SUBLN>
__device__ __forceinline__ void attn_out(const AttnBufs& T, f32x16 (&o)[4], int type, int h, size_t orow0, LAS char* lds, int wid, int lane, int r32, int hi) {
    __syncthreads();
    LAS float* stg = (LAS float*)(lds + wid * 16896);
#pragma unroll
    for (int d0 = 0; d0 < 4; ++d0)
#pragma unroll
        for (int r = 0; r < 16; ++r) stg[att::crow(r, hi) * 132 + d0 * 32 + r32] = o[d0][r];
    asm volatile("s_waitcnt lgkmcnt(0)" ::: "memory");
    const int rr = lane >> 5, c4 = (lane & 31) * 4;
    const int col = type * 1024 + h * 128 + c4;
    f32x4 wsub = {1.f, 1.f, 1.f, 1.f};
    if (SUBLN) { wsub = *(const f32x4*)(T.subln + c4) * (1.f - T.lam_init); }
    const bf16_t* gp = T.GATE + (orow0 + rr) * 3072 + col; bf16_t* op = T.BR + (orow0 + rr) * 3072 + col;
#pragma unroll 4
    for (int i = 0; i < 16; ++i) {
        f32x4 v = *(const LAS f32x4*)(stg + (2 * i + rr) * 132 + c4);
        const u32x2 gg = *(const u32x2*)(gp + (size_t)i * 2 * 3072);
        if (SUBLN) {
            float s = (v[0] * v[0] + v[1] * v[1]) + (v[2] * v[2] + v[3] * v[3]);
            s += __shfl_xor(s, 1); s += __shfl_xor(s, 2); s += __shfl_xor(s, 4); s += __shfl_xor(s, 8); s += __shfl_xor(s, 16);
            v = v * (rsqrtf(s * (1.f / 128.f) + EPS)) * wsub;
        }
        u32x2 w; w.x = cvt_pk_bf16(v[0] * bf2f(gg.x & 0xffffu), v[1] * bf2f(gg.x >> 16)); w.y = cvt_pk_bf16(v[2] * bf2f(gg.y & 0xffffu), v[3] * bf2f(gg.y >> 16));
        *(u32x2*)(op + (size_t)i * 2 * 3072) = w;
    }
}

__device__ __forceinline__ void attn_item(const AttnBufs& T, int type, int b, int h, int qrow0, int NT, LAS char* lds, int tid_) {
    asm volatile("" : "+v"(tid_));
    const int tid = tid_, wid = __builtin_amdgcn_readfirstlane(tid >> 6), lane = tid & 63, r32 = lane & 31, hi = lane >> 5;
    const int rowc = MLAT + b * CTXL, rowl = b * SEQ;
    LAS float* li = (LAS float*)(lds + att::LI_OFF) + wid * 64;
    constexpr float LOG2E = 1.4426950408889634f;
    const size_t orow0 = (size_t)qrow0 + wid * 32;
    if (type == 0 && (MK_ATYPE & 1)) {
        f32x16 o[4]; float l_reg; float rli[16];
        att::attn_pass<128, ATT_DBL>(T.QA + (size_t)qrow0 * 1024 + h * 128, 1024, T.KA + (h >> 2) * 128, 256, T.VA + (h >> 2) * 128, 256, rowc, rowl, NT,
                            0.08838834764831845f * LOG2E, T.lamv[1], o, l_reg, lds, tid);
        att::row_recip(l_reg, rli, li, r32, hi);
#pragma unroll
        for (int d0 = 0; d0 < 4; ++d0)
#pragma unroll
            for (int r = 0; r < 16; ++r) o[d0][r] *= rli[r];
        attn_out<false>(T, o, 0, h, orow0, lds, wid, lane, r32, hi);
    } else if (type == 1 && (MK_ATYPE & 2)) {
        f32x16 o[4]; float l_reg; float rli[16];
        att::attn_pass<192, false>(T.QB + (size_t)qrow0 * 1536 + h * 192, 1536, T.KB + h * 192, 1536, T.VB + h * 128, 1024, rowc, rowl, NT,
                            0.07216878364870323f * LOG2E, T.lamv[2], o, l_reg, lds, tid);
        att::row_recip(l_reg, rli, li, r32, hi);
#pragma unroll
        for (int d0 = 0; d0 < 4; ++d0)
#pragma unroll
            for (int r = 0; r < 16; ++r) o[d0][r] *= rli[r];
        attn_out<false>(T, o, 1, h, orow0, lds, wid, lane, r32, hi);
    } else if (MK_ATYPE & 4) {
        f32x16 o[4]; float l_reg; float rli[16];
        att::attn_pass<64, ATT_DBL>(T.QC + (size_t)qrow0 * 1024 + h * 128, 1024, T.KC + h * 128, 1024, T.VC + h * 128, 1024, rowc, rowl, NT,
                           0.125f * LOG2E, T.lamv[3], o, l_reg, lds, tid);
        att::row_recip(l_reg, rli, li, r32, hi);
        f32x4* scr = (f32x4*)(T.SCR + ((size_t)blockIdx.x * 512 + tid) * 64);
#pragma unroll
        for (int d0 = 0; d0 < 4; ++d0)
#pragma unroll
            for (int q = 0; q < 4; ++q) scr[d0 * 4 + q] = (f32x4){o[d0][q * 4] * rli[q * 4], o[d0][q * 4 + 1] * rli[q * 4 + 1], o[d0][q * 4 + 2] * rli[q * 4 + 2], o[d0][q * 4 + 3] * rli[q * 4 + 3]};
        att::attn_pass<64, ATT_DBL>(T.QC + (size_t)qrow0 * 1024 + h * 128 + 64, 1024, T.KC + h * 128 + 64, 1024, T.VC + h * 128, 1024, rowc, rowl, NT,
                           0.125f * LOG2E, T.lamv[3], o, l_reg, lds, tid);
        att::row_recip(l_reg, rli, li, r32, hi);
        const float lam = T.lamv[0];
#pragma unroll
        for (int d0 = 0; d0 < 4; ++d0)
#pragma unroll
            for (int q = 0; q < 4; ++q) { const f32x4 a = scr[d0 * 4 + q];
#pragma unroll
                for (int j = 0; j < 4; ++j) o[d0][q * 4 + j] = a[j] - lam * (o[d0][q * 4 + j] * rli[q * 4 + j]); }
        attn_out<true>(T, o, 2, h, orow0, lds, wid, lane, r32, hi);
    }
}

__device__ __forceinline__ void transpose_item(const float* __restrict__ W, int ldw, int k0, int srccol4, const float* __restrict__ kscale,
                                               bf16_t* __restrict__ WT, int ldt, int n0, int kdst0, LAS float* scr, int lane) {
    const int ks = lane >> 4, n4 = (lane & 15) * 4;
#pragma unroll 8
    for (int i = 0; i < 16; ++i) { const int kk = 4 * i + ks;
        f32x4 v = srccol4 >= 0 ? *(const f32x4*)(W + (size_t)(k0 + kk) * ldw + srccol4) : (f32x4){0.f, 0.f, 0.f, 0.f};
        if (kscale) v = v * kscale[k0 + kk];
        LAS float* d = scr + kk * 65 + n4; d[0] = v[0]; d[1] = v[1]; d[2] = v[2]; d[3] = v[3]; }
    asm volatile("s_waitcnt lgkmcnt(0)" ::: "memory");
    const int nn = lane & 7, c = lane >> 3;
#pragma unroll
    for (int j = 0; j < 8; ++j) { const int n = nn + 8 * j; const LAS float* s = scr + (8 * c) * 65 + n;
        u32x4 o; o.x = cvt_pk_bf16(s[0 * 65], s[1 * 65]); o.y = cvt_pk_bf16(s[2 * 65], s[3 * 65]); o.z = cvt_pk_bf16(s[4 * 65], s[5 * 65]); o.w = cvt_pk_bf16(s[6 * 65], s[7 * 65]);
        *(u32x4*)(WT + (size_t)(n0 + n) * ldt + kdst0 + k0 + 8 * c) = o; }
    asm volatile("s_waitcnt lgkmcnt(0)" ::: "memory");
}
__device__ const float INVF32[16] = {1.000000000e+00f, 5.623413324e-01f, 3.162277639e-01f, 1.778279394e-01f, 1.000000015e-01f, 5.623413250e-02f, 3.162277490e-02f, 1.778279431e-02f,
    9.999999776e-03f, 5.623413250e-03f, 3.162277630e-03f, 1.778279431e-03f, 1.000000047e-03f, 5.623413017e-04f, 3.162277571e-04f, 1.778279402e-04f};
__device__ const float INVF64[32] = {1.000000000e+00f, 7.498942614e-01f, 5.623413324e-01f, 4.216965139e-01f, 3.162277639e-01f, 2.371373773e-01f, 1.778279394e-01f, 1.333521307e-01f,
    1.000000015e-01f, 7.498941571e-02f, 5.623413250e-02f, 4.216965288e-02f, 3.162277490e-02f, 2.371373773e-02f, 1.778279431e-02f, 1.333521493e-02f, 9.999999776e-03f, 7.498941850e-03f,
    5.623413250e-03f, 4.216964822e-03f, 3.162277630e-03f, 2.371373586e-03f, 1.778279431e-03f, 1.333521446e-03f, 1.000000047e-03f, 7.498942432e-04f, 5.623413017e-04f, 4.216965172e-04f,
    3.162277571e-04f, 2.371373703e-04f, 1.778279402e-04f, 1.333521504e-04f};
__device__ __forceinline__ void sincos_d(double x, float& s, float& c) {
    const double twopi = 6.283185307179586476925;
    const double k = __builtin_rint(x / twopi), r = x - k * twopi, r2 = r * r;
    double st = r, ct = 1.0, ss = r, cs = 1.0;
    for (int n = 1; n <= 16; ++n) { ct *= -r2 / (double)((2 * n - 1) * (2 * n)); st *= -r2 / (double)((2 * n) * (2 * n + 1)); cs += ct; ss += st; }
    s = (float)ss; c = (float)cs;
}
__device__ __forceinline__ float absmax_n(const float* w, int n) { float m = 0.f; for (int i = 0; i < n; ++i) m = fmaxf(m, fabsf(w[i])); return m; }

typedef unsigned v4u_unused_t;
#define XB_TMO      128
#define XB_XCNT(j)  (256  + 64 * (j))
#define XB_XSUB(j)  (1280 + 64 * (j))
#define XB_XGEN(j)  (2304 + 64 * (j))
#define XB_TOP      3328
#define XB_TOPGEN   3392
#define XCD_BAR_WORDS 3456
#define XB_SPIN_CAP (1u << 18)

__device__ __forceinline__ unsigned xb_ld(unsigned* p)              { return __hip_atomic_load(p, __ATOMIC_RELAXED, __HIP_MEMORY_SCOPE_AGENT); }
__device__ __forceinline__ unsigned xb_add(unsigned* p, unsigned v) { return __hip_atomic_fetch_add(p, v, __ATOMIC_RELAXED, __HIP_MEMORY_SCOPE_AGENT); }
__device__ __forceinline__ unsigned xb_xcc_id() { return (unsigned)__builtin_amdgcn_s_getreg((3 << 11) | 20) & 0xFu; }
#define XB_SPIN(cond, bar) do { unsigned _sp = 0; while (cond) { __builtin_amdgcn_s_sleep(1); \
    if ((++_sp & 255u) == 0u) { if (xb_ld(&(bar)[XB_TMO])) break; if (_sp > XB_SPIN_CAP) { atomicAdd(&(bar)[XB_TMO], 1u); break; } } } } while (0)

struct XcdBarrier {
    unsigned* bar; unsigned x;
    volatile LAS unsigned* st;
};

__device__ __forceinline__ XcdBarrier xcd_barrier_post(unsigned* bar, volatile LAS unsigned* st) {
    XcdBarrier b; b.bar = bar; b.x = xb_xcc_id(); b.st = st;
    if (threadIdx.x == 0) (void)xb_add(&bar[XB_XCNT(b.x)], 1u);
    return b;
}
__device__ __forceinline__ void xcd_barrier_complete(unsigned* bar, unsigned x, unsigned& nloc, unsigned& nx) {
    const unsigned G = gridDim.x * gridDim.y * gridDim.z;
    unsigned sum, cnt, mine, sp = 0u;
    for (;;) {
        sum = 0u; cnt = 0u; mine = 0u;
#pragma unroll
        for (unsigned j = 0; j < 16; ++j) { const unsigned c = xb_ld(&bar[XB_XCNT(j)]); sum += c; cnt += (c > 0u) ? 1u : 0u; mine = (j == x) ? c : mine; }
        if (sum == G) break;
        __builtin_amdgcn_s_sleep(1);
        if ((++sp & 255u) == 0u) { if (xb_ld(&bar[XB_TMO])) break; if (sp > XB_SPIN_CAP) { atomicAdd(&bar[XB_TMO], 1u); break; } }
    }
    nloc = mine > 0u ? mine : 1u; nx = cnt > 0u ? cnt : 1u;
}

__device__ __forceinline__ void xcd_barrier(const XcdBarrier& b) {
    asm volatile("s_waitcnt vmcnt(0)" ::: "memory");
    __syncthreads();
    if (threadIdx.x == 0) {
        unsigned* bar = b.bar;
        __builtin_amdgcn_s_waitcnt(0);
        unsigned nloc = b.st[0], nx = b.st[1];
        if (nloc == 0u) { xcd_barrier_complete(bar, b.x, nloc, nx); b.st[0] = nloc; b.st[1] = nx; }
        const unsigned old = xb_add(&bar[XB_XSUB(b.x)], 1u);
        const unsigned gen = old / nloc;
        if (old + 1u == (gen + 1u) * nloc) {
            __builtin_amdgcn_fence(__ATOMIC_RELEASE, "agent");
            asm volatile("s_waitcnt vmcnt(0)" ::: "memory");
            const unsigned og = xb_add(&bar[XB_TOP], 1u);
            const unsigned tg = og / nx;
            if (og + 1u == (tg + 1u) * nx) xb_add(&bar[XB_TOPGEN], 1u);
            else XB_SPIN(xb_ld(&bar[XB_TOPGEN]) == tg, bar);
            __builtin_amdgcn_fence(__ATOMIC_ACQUIRE, "agent");
            xb_add(&bar[XB_XGEN(b.x)], 1u);
            asm volatile("s_waitcnt vmcnt(0)" ::: "memory");
        } else {
            XB_SPIN(xb_ld(&bar[XB_XGEN(b.x)]) == gen, bar);
            __builtin_amdgcn_fence(__ATOMIC_ACQUIRE, "agent");
            asm volatile("s_waitcnt vmcnt(0)" ::: "memory");
        }
    }
    __syncthreads();
}

struct Args { const float* in[29]; float* out; unsigned char* ws; int ph_lo, ph_hi, coop, pad; };

__global__ void __launch_bounds__(512, 2) mega_fwd(Args args) {
    extern __shared__ __attribute__((aligned(16))) unsigned char lds_raw[];
    LAS unsigned char* lds = (LAS unsigned char*)lds_raw;
    const int G = gridDim.x, bx = blockIdx.x;
    const int vcu = (G % 8 == 0) ? (bx % 8) * (G / 8) + bx / 8 : bx;
    unsigned char* ws = args.ws;
    float* MOD = (float*)(ws + WS_MOD);
    float* TC64 = (float*)(ws + WS_TC64); float* TS64 = (float*)(ws + WS_TS64); float* TC128 = (float*)(ws + WS_TC128); float* TS128 = (float*)(ws + WS_TS128);
    float* LAM = (float*)(ws + WS_LAM);
    bf16_t* WIN = (bf16_t*)(ws + WS_WIN); bf16_t* WUP = (bf16_t*)(ws + WS_WUP); bf16_t* WBR = (bf16_t*)(ws + WS_WBR); bf16_t* WOUT = (bf16_t*)(ws + WS_WOUT);
    bf16_t* H = (bf16_t*)(ws + WS_H); bf16_t* QA = (bf16_t*)(ws + WS_QA); bf16_t* KA = (bf16_t*)(ws + WS_KA); bf16_t* VA = (bf16_t*)(ws + WS_VA);
    bf16_t* QB = (bf16_t*)(ws + WS_QB); bf16_t* KB = (bf16_t*)(ws + WS_KB); bf16_t* CKV = (bf16_t*)(ws + WS_CKV); bf16_t* VB = (bf16_t*)(ws + WS_VB);
    bf16_t* QC = (bf16_t*)(ws + WS_QC); bf16_t* KC = (bf16_t*)(ws + WS_KC); bf16_t* VC = (bf16_t*)(ws + WS_VC);
    bf16_t* GATE = (bf16_t*)(ws + WS_GATE); bf16_t* MRG = (bf16_t*)(ws + WS_MRG); bf16_t* BR = (bf16_t*)(ws + WS_BR); bf16_t* Y = (bf16_t*)(ws + WS_Y);
    float* SS = (float*)(ws + WS_SS); float* CTXW = (float*)(ws + WS_CTXW); float* SCR = (float*)(ws + WS_SCR);
    LAS float* xch = (LAS float*)(lds + XCH_OFF);
    volatile LAS unsigned* bst = (volatile LAS unsigned*)(lds + XCH_OFF + 4096);
    if (threadIdx.x < 2) bst[threadIdx.x] = 0u;
    __syncthreads();
    XcdBarrier bar = xcd_barrier_post((unsigned*)(ws + WS_BAR), bst);

    for (int ph = args.ph_lo; ph < args.ph_hi; ++ph) {
        int tid = threadIdx.x; asm volatile("" : "+v"(tid));
        const int lane = tid & 63, wave = __builtin_amdgcn_readfirstlane(tid >> 6);
        if (ph == 0 && (MK_MASK & 1)) {
            {
                LAS float* sc = (LAS float*)lds;
                LAS float* red = (LAS float*)(lds + 65536);
                for (int i = tid; i < 5 * DM; i += 512) { const float v = i < 4 * DM ? args.in[1][i] : args.in[3][i - 4 * DM]; sc[i] = silu_f(v); }
                __syncthreads();
                for (int it = bx; it < DEPTH * 96; it += G) {
                    const int l = it / 96, n0 = (it % 96) * 64;
                    const float* W = args.in[5] + (size_t)l * DM * 6144 + n0 + lane;
                    float a0 = 0.f, a1 = 0.f, a2 = 0.f, a3 = 0.f, a4 = 0.f;
                    const int kb = wave * 256;
#pragma unroll 8
                    for (int k = 0; k < 256; ++k) { const float wv = W[(size_t)(kb + k) * 6144];
                        a0 += sc[kb + k] * wv; a1 += sc[DM + kb + k] * wv; a2 += sc[2 * DM + kb + k] * wv; a3 += sc[3 * DM + kb + k] * wv; a4 += sc[4 * DM + kb + k] * wv; }
                    red[(wave * 5 + 0) * 64 + lane] = a0; red[(wave * 5 + 1) * 64 + lane] = a1; red[(wave * 5 + 2) * 64 + lane] = a2; red[(wave * 5 + 3) * 64 + lane] = a3; red[(wave * 5 + 4) * 64 + lane] = a4;
                    __syncthreads();
                    if (tid < 320) { const int i = tid >> 6; float s = 0.f;
                        for (int w8 = 0; w8 < 8; ++w8) s += red[(w8 * 5 + i) * 64 + lane];
                        MOD[((size_t)l * 5 + i) * 6144 + n0 + lane] = s + args.in[6][(size_t)l * 6144 + n0 + lane]; }
                    __syncthreads();
                }
            }
            if (bx == 1 % G) {
                for (int i = tid; i < 64 * 16; i += 512) { const int pos = i >> 4, f = i & 15; const float ang = (float)pos * INVF32[f]; float s, c; sincos_d((double)ang, s, c); TC64[i] = c; TS64[i] = s; }
                for (int i = tid; i < 64 * 32; i += 512) { const int pos = i >> 5, f = i & 31; const float ang = (float)pos * INVF64[f]; float s, c; sincos_d((double)ang, s, c); TC128[i] = c; TS128[i] = s; }
            }
            if (bx == 2 % G && tid < DEPTH) {
                const int l = tid;
                float s1 = 0.f, s2 = 0.f;
                for (int i = 0; i < 64; ++i) { s1 += args.in[20][l * 64 + i] * args.in[21][l * 64 + i]; s2 += args.in[22][l * 64 + i] * args.in[23][l * 64 + i]; }
                const float lam_init = 0.8f - 0.6f * expf(-0.3f * (float)l);
                LAM[l * 4 + 0] = expf(s1) - expf(s2) + lam_init;
                const float mAq = absmax_n(args.in[9] + l * 128, 128), mAk = absmax_n(args.in[10] + l * 128, 128);
                const float mBqn = absmax_n(args.in[11] + l * 128, 128), mBqr = absmax_n(args.in[12] + l * 64, 64), mBkn = absmax_n(args.in[16] + l * 128, 128), mBkr = absmax_n(args.in[17] + l * 64, 64);
                const float mCq = absmax_n(args.in[18] + l * 64, 64), mCk = absmax_n(args.in[19] + l * 64, 64);
                const float L2E = 1.4426950408889634f;
                LAM[l * 4 + 1] = -(sqrtf(128.f) * mAq * mAk) * L2E;
                LAM[l * 4 + 2] = -(sqrtf(128.f * mBqn * mBqn + 64.f * mBqr * mBqr) * sqrtf(128.f * mBkn * mBkn + 64.f * mBkr * mBkr) * 0.07216878364870323f) * L2E;
                LAM[l * 4 + 3] = -(8.f * mCq * mCk) * L2E;
            }
            __syncthreads();
            {
                LAS float* scr = (LAS float*)(lds + wave * 16640);
                const int gw = vcu * 8 + wave, NGW = G * 8;
                constexpr int I_IN = 32 * (NIN / 64), I_UP = 8 * 32, I_BR = 3 * 16 * 32, I_OUT = 32 * 32, I_L = I_IN + I_UP + I_BR + I_OUT;
                const int n4 = (lane & 15) * 4;
                for (int it = gw; it < DEPTH * I_L; it += NGW) {
                    const int l = it / I_L; int r = it % I_L;
                    if (r < I_IN) { const int nb = r % (NIN / 64), kb = r / (NIN / 64); const int n0 = nb * 64;
                        transpose_item(args.in[7] + (size_t)l * DM * INC, INC, kb * 64, in_src_col(n0 + n4), nullptr, WIN + (size_t)l * NIN * DM, DM, n0, 0, scr, lane); continue; }
                    r -= I_IN;
                    if (r < I_UP) { const int nb = r % 32, kb = r / 32; const int n0 = nb * 64; const int sc_ = up_src_col(n0 + n4);
                        const float* W = (sc_ < 1024 ? args.in[14] : args.in[15]) + (size_t)l * 512 * 1024;
                        transpose_item(W, 1024, kb * 64, sc_ & 1023, args.in[13] + l * 512, WUP + (size_t)l * 2048 * 512, 512, n0, 0, scr, lane); continue; }
                    r -= I_UP;
                    if (r < I_BR) { const int br = r / (16 * 32), r2 = r % (16 * 32); const int nb = r2 % 32, kb = r2 / 32; const int n0 = nb * 64;
                        transpose_item(args.in[25 + br] + (size_t)l * 1024 * DM, DM, kb * 64, n0 + n4, nullptr, WBR + (size_t)l * 2048 * 3072, 3072, n0, br * 1024, scr, lane); continue; }
                    r -= I_BR;
                    { const int nb = r % 32, kb = r / 32; const int n0 = nb * 64;
                      transpose_item(args.in[28] + (size_t)l * DM * DM, DM, kb * 64, n0 + n4, nullptr, WOUT + (size_t)l * DM * DM, DM, n0, 0, scr, lane); }
                }
            }
        } else {
            const int l = (ph - 1) / PPL, st = (ph - 1) % PPL;
            const float* xsrc = (l == 0) ? args.in[0] : args.out;
            const float* csrc = (l == 0) ? args.in[2] : CTXW;
            const float* modl = MOD + (size_t)l * 5 * 6144;
            const int Mrows = (l == DEPTH - 1) ? MLAT : MTOT;
            if (st == 0 && (MK_MASK & 2)) {
                const float* nw = args.in[4] + (size_t)l * DM;
                for (int row = bx * 8 + wave; row < MTOT; row += G * 8) {
                    const bool lat = row < MLAT; const int mi = lat ? (row >> 12) : 4;
                    const f32x4* xr = (const f32x4*)(lat ? xsrc + (size_t)row * DM : csrc + (size_t)(row - MLAT) * DM) + lane;
                    f32x4 v[8]; float s = 0.f;
#pragma unroll
                    for (int j = 0; j < 8; ++j) { v[j] = xr[64 * j]; s += (v[j][0] * v[j][0] + v[j][1] * v[j][1]) + (v[j][2] * v[j][2] + v[j][3] * v[j][3]); }
                    const float rinv = rsqrtf(wave_sum(s) * (1.f / DM) + EPS);
                    const f32x4* sh = (const f32x4*)(modl + mi * 6144) + lane; const f32x4* scl = (const f32x4*)(modl + mi * 6144 + DM) + lane; const f32x4* nwp = (const f32x4*)nw + lane;
                    u32x2* o8 = (u32x2*)(H + (size_t)row * DM) + lane;
#pragma unroll
                    for (int j = 0; j < 8; ++j) { const f32x4 y = v[j] * rinv * nwp[64 * j] * (scl[64 * j] + 1.f) + sh[64 * j];
                        u32x2 w; w.x = cvt_pk_bf16(y[0], y[1]); w.y = cvt_pk_bf16(y[2], y[3]); o8[64 * j] = w; }
                }
            } else if (st == 1 && (MK_MASK & 4)) {
                pg8::Gemm g{H, WIN + (size_t)l * NIN * DM, MTOT, NIN, DM}; pg8::StaticOrder S; S.init(MTOT, NIN, G, bx);
                EpiIn E{QA, KA, VA, QB, KB, CKV, QC, KC, VC, GATE, MRG, SS,
                        args.in[9] + l * 128, args.in[10] + l * 128, args.in[11] + l * 128, args.in[12] + l * 64, args.in[17] + l * 64, args.in[18] + l * 64, args.in[19] + l * 64,
                        args.in[8] + (size_t)l * 6144, TC64, TS64, TC128, TS128, xch};
                pg8::gemm_phase<EpiIn>(lds, g, S, E, tid);
            } else if (st == 2 && (MK_MASK & 8)) {
                pg8::Gemm g{CKV, WUP + (size_t)l * 2048 * 512, MTOT, 2048, 512}; pg8::StaticOrder S; S.init(MTOT, 2048, G, bx);
                EpiUp E{KB, VB, SS, args.in[16] + l * 128, xch};
                pg8::gemm_phase<EpiUp>(lds, g, S, E, tid);
            } else if (st == 3 && (MK_MASK & 16)) {
                AttnBufs T{QA, KA, VA, QB, KB, VB, QC, KC, VC, GATE, BR, SCR, LAM + l * 4, args.in[24] + l * 128, 0.8f - 0.6f * expf(-0.3f * (float)l)};
                const int nctx = (l < DEPTH - 1) ? 96 : 0;
                for (int k = 0;; ++k) {
                    int type, b, h, qrow0, NT;
                    if (G == 256) {
                        if (k < 6) { const int id = (k & 1) * 256 + vcu; type = k >> 1; b = id >> 7; h = (id >> 4) & 7; qrow0 = b * SEQ + (id & 15) * 256; NT = 68; }
                        else if (k == 6 && bx < nctx) { type = bx >> 5; b = (bx >> 3) & 3; h = bx & 7; qrow0 = MLAT + b * CTXL; NT = 4; }
                        else break;
                    } else {
                        const int it = bx + k * G; if (it >= 1536 + nctx) break;
                        if (it < 1536) { const int id = it & 511; type = it >> 9; b = id >> 7; h = (id >> 4) & 7; qrow0 = b * SEQ + (id & 15) * 256; NT = 68; }
                        else { const int c = it - 1536; type = c >> 5; b = (c >> 3) & 3; h = c & 7; qrow0 = MLAT + b * CTXL; NT = 4; }
                    }
                    attn_item(T, type, b, h, qrow0, NT, (LAS char*)lds, tid);
                }
                __syncthreads();
            } else {
                unsigned* CNT = (unsigned*)(ws + WS_CNT) + (size_t)l * 68 * 64;
                const bool merged = (G == 256) && args.coop;
                const bool ctxl = l < DEPTH - 1;
                pg8::Gemm g3{BR, WBR + (size_t)l * 2048 * 3072, Mrows, 2048, 3072}; EpiBr E3{MRG, Y};
                pg8::Gemm g4{Y, WOUT + (size_t)l * DM * DM, Mrows, DM, DM}; EpiOut E4{xsrc, csrc, args.out, CTXW, modl};
                for (int part = 0; part < 2; ++part) {
                    pg8::StaticOrder S;
                    if (!merged) { if (part) break; S.init(Mrows, 2048, G, bx); }
                    else if (part == 0) S.init(MLAT, 2048, G, bx);
                    else { if (!(ctxl && bx < 32)) break; S.init_one(64 + (bx >> 3), bx & 7); }
                    { int t2 = threadIdx.x; asm volatile("" : "+v"(t2)); pg8::gemm_phase<EpiBr>(lds, g3, S, E3, t2); }
                    if (merged && threadIdx.x == 0) {
                        __builtin_amdgcn_fence(__ATOMIC_RELEASE, "agent");
                        asm volatile("s_waitcnt vmcnt(0)" ::: "memory");
                        pg8::Unit u; for (int i = 0; S.next(i, u); ++i) __hip_atomic_fetch_add(&CNT[u.pm * 64], 1u, __ATOMIC_RELAXED, __HIP_MEMORY_SCOPE_AGENT);
                    }
                }
                if (!merged && args.coop) xcd_barrier(bar);
                for (int part = 0; part < 2; ++part) {
                    pg8::StaticOrder S;
                    if (!merged) { if (part) break; S.init(Mrows, DM, G, bx); }
                    else if (part == 0) S.init(MLAT, DM, G, bx);
                    else { if (!(ctxl && bx >= 32 && bx < 64)) break; S.init_one(64 + ((bx - 32) >> 3), bx & 7); }
                    if (merged) {
                        if (threadIdx.x == 0) {
                            pg8::Unit u;
                            for (int i = 0; S.next(i, u); ++i) { unsigned sp = 0;
                                while (__hip_atomic_load(&CNT[u.pm * 64], __ATOMIC_RELAXED, __HIP_MEMORY_SCOPE_AGENT) < 8u) { __builtin_amdgcn_s_sleep(1); if (++sp > (1u << 22)) break; } }
                            __builtin_amdgcn_fence(__ATOMIC_ACQUIRE, "agent");
                            asm volatile("s_waitcnt vmcnt(0)" ::: "memory");
                        }
                        __syncthreads();
                    }
                    { int t2 = threadIdx.x; asm volatile("" : "+v"(t2)); pg8::gemm_phase<EpiOut>(lds, g4, S, E4, t2); }
                }
            }
        }
        if (ph + 1 < args.ph_hi) { if (args.coop) { if (ph == 0) cg::this_grid().sync(); else xcd_barrier(bar); } }
    }
}

extern "C" void kernel_launch(void* const* d_in, const int* in_sizes, int n_in, void* d_out, int out_size, void* d_ws, size_t ws_size, hipStream_t stream) {
    static int grid = 0;
    if (grid == 0) {
        if (n_in != 29 || in_sizes[0] != MLAT * DM || out_size != MLAT * DM || ws_size < WS_END) {
            fprintf(stderr, "kernel_launch: unexpected shapes: n_in %d in0 %d out %d ws %zu (need %zu)\n", n_in, n_in > 0 ? in_sizes[0] : -1, out_size, ws_size, (size_t)WS_END); grid = -1; return; }
        int dev = 0, cus = 0, per_cu = 0;
        if (hipGetDevice(&dev) != hipSuccess || hipDeviceGetAttribute(&cus, hipDeviceAttributeMultiprocessorCount, dev) != hipSuccess) { grid = -1; return; }
        if (hipFuncSetAttribute((const void*)mega_fwd, hipFuncAttributeMaxDynamicSharedMemorySize, LDS_BYTES) != hipSuccess) { fprintf(stderr, "kernel_launch: hipFuncSetAttribute failed\n"); grid = -1; return; }
        if (hipOccupancyMaxActiveBlocksPerMultiprocessor(&per_cu, (const void*)mega_fwd, 512, LDS_BYTES) != hipSuccess || per_cu < 1) { fprintf(stderr, "kernel_launch: occupancy query gives %d\n", per_cu); per_cu = 1; }
        (void)hipGetLastError();
        grid = cus * 1;
    }
    if (grid < 0) return;
    Args a{};
    for (int i = 0; i < 29; ++i) a.in[i] = (const float*)d_in[i];
    a.out = (float*)d_out; a.ws = (unsigned char*)d_ws;
#if MK_COOP
    if (hipMemsetAsync((char*)d_ws + WS_BAR, 0, 16384 + CNT_BYTES, stream) != hipSuccess) { fprintf(stderr, "kernel_launch: memset of the barrier words failed\n"); return; }
    a.ph_lo = 0; a.ph_hi = NPH; a.coop = 1;
    void* kargs[] = {&a};
    hipError_t e = hipLaunchCooperativeKernel((const void*)mega_fwd, dim3(grid), dim3(512), kargs, LDS_BYTES, stream);
    if (e != hipSuccess) fprintf(stderr, "kernel_launch: cooperative launch failed: %s (grid %d)\n", hipGetErrorString(e), grid);
#else
    for (int ph = 0; ph < NPH; ++ph) {
        a.ph_lo = ph; a.ph_hi = ph + 1; a.coop = 0;
        hipLaunchKernelGGL(mega_fwd, dim3(grid), dim3(512), LDS_BYTES, stream, a);
    }
    const hipError_t le = hipPeekAtLastError();
    if (le != hipSuccess) fprintf(stderr, "kernel_launch: launch failed: %s\n", hipGetErrorName(le));
#endif
}
```

```cpp
#include <hip/hip_runtime.h>
#include <hip/hip_cooperative_groups.h>
#include <cstdio>
#include <cstdint>
namespace cg = cooperative_groups;

#ifndef MK_MASK
#define MK_MASK 127
#endif
#ifndef MK_ATYPE
#define MK_ATYPE 7
#endif
#ifndef MK_G1T
#define MK_G1T 127
#endif
#ifndef ATT_SD_A
#define ATT_SD_A 2
#endif
#ifndef ATT_SD_B
#define ATT_SD_B 1
#endif
#ifndef ATT_SD_C
#define ATT_SD_C 2
#endif
#ifndef ATT_DBL_B
#define ATT_DBL_B true
#endif
#ifndef ATT_DBL
#define ATT_DBL false
#endif
#ifndef QKT_GRP
#define QKT_GRP 0
#endif
#ifndef MK_COOP
#define MK_COOP 1
#endif

#define LAS __attribute__((address_space(3)))
typedef unsigned short bf16_t;
typedef short bf16x8 __attribute__((ext_vector_type(8)));
typedef short s16x4 __attribute__((ext_vector_type(4)));
typedef float f32x4 __attribute__((ext_vector_type(4)));
typedef float f32x16 __attribute__((ext_vector_type(16)));
typedef unsigned u32x4 __attribute__((ext_vector_type(4)));
typedef unsigned u32x2 __attribute__((ext_vector_type(2)));

constexpr int DM = 2048, NBATCH = 4, SEQ = 4096, CTXL = 256, DEPTH = 4;
constexpr int MLAT = NBATCH * SEQ, MCTX = NBATCH * CTXL, MTOT = MLAT + MCTX;
constexpr int INC = 15936, NIN = 16128;
constexpr float EPS = 1e-6f;
#ifndef MK_REP_ST
#define MK_REP_ST -1
#endif
constexpr int PPL = 5;
constexpr int NPH = 2 + 4 * DEPTH;

constexpr size_t alignup(size_t x) { return (x + 255) / 256 * 256; }
constexpr size_t WS_MOD = 0;
constexpr size_t WS_TC64 = WS_MOD + alignup((size_t)DEPTH * 5 * 6144 * 4);
constexpr size_t WS_TS64 = WS_TC64 + 4096, WS_TC128 = WS_TS64 + 4096, WS_TS128 = WS_TC128 + 8192;
constexpr size_t WS_LAM = WS_TS128 + 8192;
constexpr size_t WS_BAR = WS_LAM + 256;
constexpr size_t WS_CNT = WS_BAR + 16384;
constexpr size_t CNT_BYTES = (size_t)2 * DEPTH * 68 * 256;
constexpr size_t WS_WIN = WS_CNT + CNT_BYTES;
constexpr size_t WS_WUP = WS_WIN + (size_t)DEPTH * NIN * DM * 2;
constexpr size_t WS_WBR = WS_WUP + (size_t)DEPTH * 2048 * 512 * 2;
constexpr size_t WS_WOUT = WS_WBR + (size_t)DEPTH * 2048 * 3072 * 2;
constexpr size_t WS_H = WS_WOUT + (size_t)DEPTH * 2048 * 2048 * 2;
constexpr size_t WS_QA = WS_H + (size_t)MTOT * 2048 * 2;
constexpr size_t WS_KA = WS_QA + (size_t)MTOT * 1024 * 2;
constexpr size_t WS_VA = WS_KA + (size_t)MTOT * 256 * 2;
constexpr size_t WS_QB = WS_VA + (size_t)MTOT * 256 * 2;
constexpr size_t WS_KB = WS_QB + (size_t)MTOT * 1536 * 2;
constexpr size_t WS_CKV = WS_KB + (size_t)MTOT * 1536 * 2;
constexpr size_t WS_VB = WS_CKV + (size_t)MTOT * 512 * 2;
constexpr size_t WS_QC = WS_VB + (size_t)MTOT * 1024 * 2;
constexpr size_t WS_KC = WS_QC + (size_t)MTOT * 1024 * 2;
constexpr size_t WS_VC = WS_KC + (size_t)MTOT * 1024 * 2;
constexpr size_t WS_GATE = WS_VC + (size_t)MTOT * 1024 * 2;
constexpr size_t WS_MRG = WS_GATE + (size_t)MTOT * 3072 * 2;
constexpr size_t WS_BR = WS_MRG + (size_t)MTOT * 6144 * 2;
constexpr size_t WS_Y = WS_BR + (size_t)MTOT * 3072 * 2;
constexpr size_t WS_SS = WS_Y + (size_t)MTOT * 2048 * 2;
constexpr size_t WS_CTXW = WS_SS + (size_t)MTOT * 8 * 4;
constexpr size_t WS_SCR = WS_CTXW + (size_t)MCTX * DM * 4;
constexpr size_t WS_END = WS_SCR + (size_t)256 * 64 * 512 * 4;

constexpr int RING_BYTES = 131072, XCH_OFF = RING_BYTES, LDS_BYTES = 147456;

__device__ __forceinline__ float bf2f(unsigned h) { return __uint_as_float(h << 16); }
__device__ __forceinline__ unsigned cvt_pk_bf16(float lo, float hi) { unsigned r; asm volatile("v_cvt_pk_bf16_f32 %0, %1, %2" : "=v"(r) : "v"(lo), "v"(hi)); return r; }
__device__ __forceinline__ float wave_sum(float v) {
#pragma unroll
    for (int o = 1; o < 64; o <<= 1) v += __shfl_xor(v, o);
    return v;
}
__device__ __forceinline__ float sigm_f(float x) { return __builtin_amdgcn_rcpf(1.f + __builtin_amdgcn_exp2f(-1.4426950408889634f * x)); }
__device__ __forceinline__ float silu_f(float x) { return x * sigm_f(x); }
__device__ __forceinline__ unsigned cvt_pk_bf16_safe(float lo, float hi) { unsigned r; asm volatile("s_nop 1\n\tv_cvt_pk_bf16_f32 %0, %1, %2" : "=v"(r) : "v"(lo), "v"(hi)); return r; }
__device__ __forceinline__ void store8_safe(bf16_t* p, f32x4 a, f32x4 b) {
    u32x4 w; w.x = cvt_pk_bf16_safe(a[0], a[1]); w.y = cvt_pk_bf16_safe(a[2], a[3]); w.z = cvt_pk_bf16_safe(b[0], b[1]); w.w = cvt_pk_bf16_safe(b[2], b[3]);
    *(u32x4*)p = w;
}
__device__ __forceinline__ void store8(bf16_t* p, f32x4 a, f32x4 b) {
    u32x4 w; w.x = cvt_pk_bf16(a[0], a[1]); w.y = cvt_pk_bf16(a[2], a[3]); w.z = cvt_pk_bf16(b[0], b[1]); w.w = cvt_pk_bf16(b[2], b[3]);
    *(u32x4*)p = w;
}

namespace pg8 {
constexpr int BM = 256, BK = 64, HALF = 128, HTB = HALF * BK * 2, NXCD = 8, WGM = 8;
__host__ __device__ __forceinline__ int lds_byte(int r, int c) { const int st = (r >> 4) * 2 + (c >> 5), rr = r & 15, cc = c & 31, ob = rr * 64 + cc * 2; return st * 1024 + (ob ^ (((ob >> 9) & 1) << 5)); }
__host__ __device__ __forceinline__ void stage_rc(int b, int& R, int& C) { const int st = b / 1024, sb = b % 1024, swz = sb ^ (((sb >> 9) & 1) << 5); R = (st >> 1) * 16 + swz / 64; C = (st & 1) * 32 + (swz % 64) / 2; }
__host__ __device__ __forceinline__ int perm32(int rho) { const int n = rho >> 4, i = rho & 15; return 8 * (i >> 2) + 4 * n + (i & 3); }

struct Unit { int pm, pn; };
struct Gemm { const bf16_t* A; const bf16_t* Bt; int M, N, K; };
struct StaticOrder {
    int nM, nN, nwg, G, c, fixed, fpm, fpn;
    __device__ void init(int M, int N, int G_, int c_) { nM = M / BM; nN = N / BM; nwg = nM * nN; G = G_; c = c_; fixed = 0; fpm = 0; fpn = 0; }
    __device__ void init_one(int pm, int pn) { nM = 1; nN = 1; nwg = 1; G = 1; c = 0; fixed = 1; fpm = pm; fpn = pn; }
    __device__ bool next(int i, Unit& u) const {
        if (fixed) { if (i > 0) return false; u.pm = fpm; u.pn = fpn; return true; }
        const long L = (long)i * G + c; if (L >= nwg) return false;
        int wgid = (int)L; { const int q = nwg / NXCD, r = nwg % NXCD, xcd = wgid % NXCD, off = wgid / NXCD; wgid = (xcd < r ? xcd * (q + 1) : r * (q + 1) + (xcd - r) * q) + off; }
        const int nig = WGM * nN, gid = wgid / nig, fm = gid * WGM, gsz = (nM - fm) < WGM ? (nM - fm) : WGM;
        u.pm = fm + ((wgid % nig) % gsz); u.pn = (wgid % nig) / gsz; return true;
    }
};

template <class Epi>
__device__ __forceinline__ void gemm_phase(LAS unsigned char* lds, const Gemm g, const StaticOrder& S, const Epi& E, const int tid) {
    const int wid = __builtin_amdgcn_readfirstlane(tid >> 6), lane = tid & 63, wr = wid >> 2, wc = wid & 3, fr = lane & 15, fq = lane >> 4;
    const int K = g.K, nt = K / BK;
    unsigned voffA[2], voffB[2];
#pragma unroll
    for (int i = 0; i < 2; ++i) { int R, C; stage_rc(tid * 16 + i * 8192, R, C); const int Rb = (R & ~31) + perm32(R & 31);
        voffA[i] = (unsigned)(R * K + C) * 2u; voffB[i] = (unsigned)(Rb * K + C) * 2u; }
    const size_t kstep = (size_t)(BK * 2);
    const size_t hstep = (size_t)HALF * K * 2;
    const size_t tstep = 2 * hstep;
    const unsigned ldsw = (unsigned)wid * 1024u;
    const int aoff = lds_byte(wr * 64 + fr, fq * 8), boff = lds_byte(wc * 32 + fr, fq * 8);
#define PG8_SA(b, h) (((b) * 2 + (h)) * HTB)
#define PG8_SB(b, h) ((4 + (b) * 2 + (h)) * HTB)
#define PG8_STAGE(bufoff, gbase, voff) do { _Pragma("unroll") for (int _i = 0; _i < 2; ++_i) \
        __builtin_amdgcn_global_load_lds((const unsigned*)((const char*)(gbase) + (voff)[_i]), (LAS unsigned*)(lds + (bufoff) + ldsw + _i * 8192), 16, 0, 0); } while (0)
#define PG8_LDA(dst, b, h) do { _Pragma("unroll") for (int m = 0; m < 4; ++m) _Pragma("unroll") for (int k = 0; k < 2; ++k) dst[m][k] = *(const LAS bf16x8*)(lds + PG8_SA(b, h) + aoff + m * 2048 + k * 1024); } while (0)
#define PG8_LDB(dst, b, h) do { _Pragma("unroll") for (int n = 0; n < 2; ++n) _Pragma("unroll") for (int k = 0; k < 2; ++k) dst[n][k] = *(const LAS bf16x8*)(lds + PG8_SB(b, h) + boff + n * 2048 + k * 1024); } while (0)
#define PG8_MMA(ai, bj, At, Bt) do { __builtin_amdgcn_s_setprio(1); _Pragma("unroll") for (int m = 0; m < 4; ++m) _Pragma("unroll") for (int n = 0; n < 2; ++n) _Pragma("unroll") for (int k = 0; k < 2; ++k) \
        acc[ai][bj][m][n] = __builtin_amdgcn_mfma_f32_16x16x32_bf16(Bt[n][k], At[m][k], acc[ai][bj][m][n], 0, 0, 0); __builtin_amdgcn_s_setprio(0); } while (0)
#define PG8_WAIT_V(n) asm volatile("s_waitcnt vmcnt(" #n ")" ::: "memory")
#define PG8_WAIT_L(n) asm volatile("s_waitcnt lgkmcnt(" #n ")" ::: "memory")
#define PG8_BAR __builtin_amdgcn_s_barrier()
#define PG8_SCHED __builtin_amdgcn_sched_barrier(0)
    Unit cur, nxt; int ui = 0;
    if (!S.next(0, cur)) return;
    f32x4 acc[2][2][4][2];
#pragma unroll
    for (int a = 0; a < 2; ++a)
#pragma unroll
        for (int b = 0; b < 2; ++b)
#pragma unroll
            for (int m = 0; m < 4; ++m)
#pragma unroll
                for (int n = 0; n < 2; ++n) acc[a][b][m][n] = (f32x4){0.f, 0.f, 0.f, 0.f};
    bf16x8 At[4][2], B0[2][2], B1[2][2];
    const char* cA = (const char*)g.A + (size_t)cur.pm * tstep; const char* cB = (const char*)g.Bt + (size_t)cur.pn * tstep;
    PG8_STAGE(PG8_SB(0, 0), cB, voffB); PG8_STAGE(PG8_SB(0, 1), cB + hstep, voffB); PG8_STAGE(PG8_SA(0, 0), cA, voffA); PG8_STAGE(PG8_SA(0, 1), cA + hstep, voffA);
    if (wr == 1) PG8_BAR;
    PG8_WAIT_V(2); PG8_BAR;
    PG8_STAGE(PG8_SB(1, 0), cB + kstep, voffB); PG8_STAGE(PG8_SA(1, 0), cA + kstep, voffA); PG8_STAGE(PG8_SB(1, 1), cB + hstep + kstep, voffB);
    PG8_WAIT_V(6); PG8_BAR;
    for (;;) {
        const bool has_next = S.next(ui + 1, nxt);
        const char* nA = has_next ? (const char*)g.A + (size_t)nxt.pm * tstep : cA; const char* nB = has_next ? (const char*)g.Bt + (size_t)nxt.pn * tstep : cB;
        for (int t = 0; t < nt; t += 2) {
            const bool last = (t == nt - 2);
            const char* a1 = cA + (size_t)(t + 1) * kstep;
            const char* a2 = last ? nA : cA + (size_t)(t + 2) * kstep; const char* b2 = last ? nB : cB + (size_t)(t + 2) * kstep;
            const char* a3 = a2 + kstep; const char* b3 = b2 + kstep;
            if constexpr (Epi::MID) { if (t == 16 || t == 32) { int fr_ = fr, fq_ = fq, wr_ = wr, wc_ = wc;
                asm volatile("" : "+v"(fr_), "+v"(fq_)); asm volatile("" : "+s"(wr_), "+s"(wc_));
                E.mid(acc, cur, t >> 4, wr_, wc_, fr_, fq_); PG8_WAIT_V(0); PG8_SCHED; } }
            PG8_LDB(B0, 0, 0); PG8_LDB(B1, 0, 1); PG8_SCHED; PG8_LDA(At, 0, 0); PG8_STAGE(PG8_SA(1, 1), a1 + hstep, voffA);
            PG8_WAIT_V(8); PG8_WAIT_L(0); PG8_BAR; PG8_MMA(0, 0, At, B0); PG8_MMA(0, 1, At, B1); PG8_BAR; PG8_SCHED;
            PG8_LDA(At, 0, 1); PG8_STAGE(PG8_SB(0, 0), b2, voffB); PG8_STAGE(PG8_SB(0, 1), b2 + hstep, voffB); PG8_STAGE(PG8_SA(0, 0), a2, voffA);
            PG8_WAIT_V(8); PG8_WAIT_L(0); PG8_BAR; PG8_MMA(1, 0, At, B0); PG8_MMA(1, 1, At, B1); PG8_BAR; PG8_SCHED;
            PG8_LDB(B0, 1, 0); PG8_LDB(B1, 1, 1); PG8_SCHED; PG8_LDA(At, 1, 0); PG8_STAGE(PG8_SA(0, 1), a2 + hstep, voffA);
            PG8_WAIT_V(8); PG8_WAIT_L(0); PG8_BAR; PG8_MMA(0, 0, At, B0); PG8_MMA(0, 1, At, B1); PG8_BAR; PG8_SCHED;
            PG8_LDA(At, 1, 1); PG8_STAGE(PG8_SB(1, 0), b3, voffB); PG8_STAGE(PG8_SB(1, 1), b3 + hstep, voffB); PG8_STAGE(PG8_SA(1, 0), a3, voffA);
            PG8_WAIT_V(8); PG8_WAIT_L(0); PG8_BAR; PG8_MMA(1, 0, At, B0); PG8_MMA(1, 1, At, B1); PG8_BAR; PG8_SCHED;
        }
        if (wr == 0) PG8_BAR;
        { int fr_ = fr, fq_ = fq, wr_ = wr, wc_ = wc, wid_ = wid;
          asm volatile("" : "+v"(fr_), "+v"(fq_)); asm volatile("" : "+s"(wr_), "+s"(wc_), "+s"(wid_));
          E(acc, cur, wr_, wc_, fr_, fq_, wid_); }
        if (!has_next) break;
#pragma unroll
        for (int a = 0; a < 2; ++a)
#pragma unroll
            for (int b = 0; b < 2; ++b)
#pragma unroll
                for (int m = 0; m < 4; ++m)
#pragma unroll
                    for (int n = 0; n < 2; ++n) acc[a][b][m][n] = (f32x4){0.f, 0.f, 0.f, 0.f};
        cur = nxt; cA = nA; cB = nB; ++ui;
        if (wr == 1) PG8_BAR;
    }
    PG8_WAIT_V(0);
    PG8_BAR;
#undef PG8_SA
#undef PG8_SB
#undef PG8_STAGE
#undef PG8_LDA
#undef PG8_LDB
#undef PG8_MMA
#undef PG8_WAIT_V
#undef PG8_WAIT_L
#undef PG8_BAR
#undef PG8_SCHED
}
}
using pg8::Unit;

__device__ __forceinline__ int in_src_col(int n) {
    const int tile = n >> 8, s = n & 255, bj = s >> 7, wc = (s >> 5) & 3, c = s & 31;
    const int d128 = 64 * (wc & 1) + 32 * bj + c, g128 = wc >> 1;
    const int d64 = 32 * (c >> 4) + 16 * bj + (c & 15), g64 = wc;
    if (tile < 4) return (tile * 2 + g128) * 128 + d128;
    if (tile == 4) return 1024 + g128 * 128 + d128;
    if (tile == 5) return 1280 + s;
    if (tile < 10) return 1536 + ((tile - 6) * 2 + g128) * 192 + d128;
    if (tile < 12) return 1536 + ((tile - 10) * 4 + g64) * 192 + 128 + d64;
    if (tile < 14) return 3072 + (tile - 12) * 256 + s;
    if (tile == 14) return g64 == 0 ? 3584 + d64 : -1;
    if (tile < 19) return 3648 + ((tile - 15) * 4 + g64) * 64 + d64;
    if (tile < 23) return 4672 + ((tile - 19) * 4 + g64) * 64 + d64;
    if (tile < 27) return 5696 + (tile - 23) * 256 + s;
    if (tile < 39) return 6720 + (tile - 27) * 256 + s;
    return 9792 + (tile - 39) * 256 + s;
}
__device__ __forceinline__ int up_src_col(int n) {
    if (n >= 1024) return n;
    const int tile = n >> 8, s = n & 255, bj = s >> 7, wc = (s >> 5) & 3, c = s & 31;
    return (tile * 2 + (wc >> 1)) * 128 + 64 * (wc & 1) + 32 * bj + c;
}

template <int GS>
__device__ __forceinline__ void norm_rope_store(const f32x4 (&acc)[2][2][4][2], int pm, int wr, int wc, int fr, int fq, int wid,
                                                const float* __restrict__ w, const float* __restrict__ tcos, const float* __restrict__ tsin, bool rope,
                                                const float (&pre)[2][4], bf16_t* __restrict__ dst, int ld, int gbase, int ncopies, int copystride, LAS float* xch) {
    const int dbase = (GS == 128) ? 64 * (wc & 1) + 8 * fq : 32 * (fq >> 1) + 8 * (fq & 1);
    const int bjs = (GS == 128) ? 32 : 16;
    const int axis = (GS == 128) ? (wc & 1) : (fq >> 1);
    const int i0 = (GS == 128) ? 8 * fq : 8 * (fq & 1);
    constexpr int NF = (GS == 128) ? 32 : 16;
    const int wavebase = gbase + ((GS == 128) ? 64 * (wc & 1) : 0) + 8 * fq;
    float ssq[2][4];
#pragma unroll
    for (int ai = 0; ai < 2; ++ai)
#pragma unroll
        for (int m = 0; m < 4; ++m) {
            float s = 0.f;
#pragma unroll
            for (int bj = 0; bj < 2; ++bj)
#pragma unroll
                for (int n = 0; n < 2; ++n)
#pragma unroll
                    for (int j = 0; j < 4; ++j) { const float v = acc[ai][bj][m][n][j] * pre[ai][m]; s += v * v; }
            s += __shfl_xor(s, 16); s += __shfl_xor(s, 32);
            ssq[ai][m] = s;
        }
    if constexpr (GS == 128) {
        if (fq == 0) {
#pragma unroll
            for (int ai = 0; ai < 2; ++ai)
#pragma unroll
                for (int m = 0; m < 4; ++m) xch[wid * 128 + ai * 64 + m * 16 + fr] = ssq[ai][m];
        }
        asm volatile("s_waitcnt lgkmcnt(0)" ::: "memory"); __builtin_amdgcn_s_barrier();
#pragma unroll
        for (int ai = 0; ai < 2; ++ai)
#pragma unroll
            for (int m = 0; m < 4; ++m) ssq[ai][m] += xch[(wid ^ 1) * 128 + ai * 64 + m * 16 + fr];
    }
#pragma unroll
    for (int ai = 0; ai < 2; ++ai)
#pragma unroll
        for (int m = 0; m < 4; ++m) {
            const int rl = ai * 128 + wr * 64 + m * 16 + fr;
            const size_t row = (size_t)pm * 256 + rl;
            const float rinv = rsqrtf(ssq[ai][m] * (1.f / GS) + EPS) * pre[ai][m];
            const int t = (pm & 15) * 256 + rl; const int pos = axis ? (t & 63) : (t >> 6);
            u32x4 k0, k1;
#pragma unroll
            for (int n = 0; n < 2; ++n) {
                const f32x4 w0 = *(const f32x4*)(w + dbase + 4 * n), w1 = *(const f32x4*)(w + dbase + bjs + 4 * n);
                f32x4 y0 = acc[ai][0][m][n] * rinv * w0, y1 = acc[ai][1][m][n] * rinv * w1;
                if (rope) {
                    const f32x4 c = *(const f32x4*)(tcos + pos * NF + i0 + 4 * n), sn = *(const f32x4*)(tsin + pos * NF + i0 + 4 * n);
                    const f32x4 o0 = y0 * c - y1 * sn, o1 = y1 * c + y0 * sn;
                    y0 = o0; y1 = o1;
                }
                if (n == 0) { k0.x = cvt_pk_bf16(y0[0], y0[1]); k0.y = cvt_pk_bf16(y0[2], y0[3]); k1.x = cvt_pk_bf16(y1[0], y1[1]); k1.y = cvt_pk_bf16(y1[2], y1[3]); }
                else { k0.z = cvt_pk_bf16(y0[0], y0[1]); k0.w = cvt_pk_bf16(y0[2], y0[3]); k1.z = cvt_pk_bf16(y1[0], y1[1]); k1.w = cvt_pk_bf16(y1[2], y1[3]); }
            }
            bf16_t* p = dst + row * ld + wavebase;
            for (int cp = 0; cp < ncopies; ++cp) { *(u32x4*)(p + cp * copystride) = k0; *(u32x4*)(p + cp * copystride + 32) = k1; }
            __builtin_amdgcn_sched_barrier(0);
        }
}

struct EpiIn {
    static constexpr bool MID = false;
    bf16_t *QA, *KA, *VA, *QB, *KB, *CKV, *QC, *KC, *VC, *GATE, *MRG; float* SS;
    const float *wAq, *wAk, *wBqn, *wBqr, *wBkr, *wCq, *wCk, *bmerge;
    const float *tc64, *ts64, *tc128, *ts128;
    LAS float* xch;
    template <int ACT>
    __device__ __forceinline__ void plain(const f32x4 (&acc)[2][2][4][2], int pm, int wr, int wc, int fr, int fq, bf16_t* dst, int ld, int col0) const {
        const int colw = col0 + 32 * wc + 8 * fq;
        f32x4 b[2][2];
#pragma unroll
        for (int bj = 0; bj < 2; ++bj)
#pragma unroll
            for (int n = 0; n < 2; ++n) b[bj][n] = (ACT == 2) ? *(const f32x4*)(bmerge + colw + bj * 128 + 4 * n) : (f32x4){0.f, 0.f, 0.f, 0.f};
#pragma unroll
        for (int ai = 0; ai < 2; ++ai)
#pragma unroll
            for (int m = 0; m < 4; ++m) {
                const size_t row = (size_t)pm * 256 + ai * 128 + wr * 64 + m * 16 + fr;
#pragma unroll
                for (int bj = 0; bj < 2; ++bj) {
                    f32x4 v0 = acc[ai][bj][m][0], v1 = acc[ai][bj][m][1];
                    if (ACT == 1) { for (int j = 0; j < 4; ++j) { v0[j] = silu_f(v0[j]); v1[j] = silu_f(v1[j]); } }
                    if (ACT == 2) { v0 = v0 + b[bj][0]; v1 = v1 + b[bj][1]; for (int j = 0; j < 4; ++j) { v0[j] = sigm_f(v0[j]); v1[j] = sigm_f(v1[j]); } }
                    if (ACT == 0) store8(dst + row * ld + colw + bj * 128, v0, v1); else store8_safe(dst + row * ld + colw + bj * 128, v0, v1);
                }
                __builtin_amdgcn_sched_barrier(0);
            }
    }
    __device__ __forceinline__ void operator()(const f32x4 (&acc)[2][2][4][2], const Unit& u, int wr, int wc, int fr, int fq, int wid) const {
        const int t = u.pn, pm = u.pm; const bool rope = pm < 64;
        const float one[2][4] = {{1.f, 1.f, 1.f, 1.f}, {1.f, 1.f, 1.f, 1.f}};
        if (t < 4 && (MK_G1T & 1)) norm_rope_store<128>(acc, pm, wr, wc, fr, fq, wid, wAq, tc128, ts128, rope, one, QA, 1024, (t * 2 + (wc >> 1)) * 128, 1, 0, xch);
        else if (t == 4 && (MK_G1T & 1)) norm_rope_store<128>(acc, pm, wr, wc, fr, fq, wid, wAk, tc128, ts128, rope, one, KA, 256, (wc >> 1) * 128, 1, 0, xch);
        else if (t == 5 && (MK_G1T & 2)) plain<0>(acc, pm, wr, wc, fr, fq, VA, 256, 0);
        else if (t < 10 && (MK_G1T & 1)) norm_rope_store<128>(acc, pm, wr, wc, fr, fq, wid, wBqn, tc128, ts128, false, one, QB, 1536, ((t - 6) * 2 + (wc >> 1)) * 192, 1, 0, xch);
        else if (t < 12 && (MK_G1T & 4)) norm_rope_store<64>(acc, pm, wr, wc, fr, fq, wid, wBqr, tc64, ts64, rope, one, QB, 1536, ((t - 10) * 4 + wc) * 192 + 128, 1, 0, xch);
        else if (t < 14 && (MK_G1T & 8)) {
            plain<0>(acc, pm, wr, wc, fr, fq, CKV, 512, (t - 12) * 256);
#pragma unroll
            for (int ai = 0; ai < 2; ++ai)
#pragma unroll
                for (int m = 0; m < 4; ++m) {
                    float s = 0.f;
#pragma unroll
                    for (int bj = 0; bj < 2; ++bj)
#pragma unroll
                        for (int n = 0; n < 2; ++n)
#pragma unroll
                            for (int j = 0; j < 4; ++j) { const float v = acc[ai][bj][m][n][j]; s += v * v; }
                    s += __shfl_xor(s, 16); s += __shfl_xor(s, 32);
                    if (fq == 0) SS[((size_t)pm * 256 + ai * 128 + wr * 64 + m * 16 + fr) * 8 + (t - 12) * 4 + wc] = s;
                }
        }
        else if (t == 14 && (MK_G1T & 16)) { if (wc == 0) norm_rope_store<64>(acc, pm, wr, wc, fr, fq, wid, wBkr, tc64, ts64, rope, one, KB, 1536, 128, 8, 192, xch); }
        else if (t < 19 && (MK_G1T & 4)) norm_rope_store<64>(acc, pm, wr, wc, fr, fq, wid, wCq, tc64, ts64, rope, one, QC, 1024, ((t - 15) * 4 + wc) * 64, 1, 0, xch);
        else if (t < 23 && (MK_G1T & 4)) norm_rope_store<64>(acc, pm, wr, wc, fr, fq, wid, wCk, tc64, ts64, rope, one, KC, 1024, ((t - 19) * 4 + wc) * 64, 1, 0, xch);
        else if (t < 27 && (MK_G1T & 2)) plain<0>(acc, pm, wr, wc, fr, fq, VC, 1024, (t - 23) * 256);
        else if (t < 39 && (MK_G1T & 32)) plain<1>(acc, pm, wr, wc, fr, fq, GATE, 3072, (t - 27) * 256);
        else if (MK_G1T & 64) plain<2>(acc, pm, wr, wc, fr, fq, MRG, 6144, (t - 39) * 256);
    }
};

struct EpiUp {
    static constexpr bool MID = false;
    bf16_t *KB, *VB; const float* SS; const float* wBkn; LAS float* xch;
    __device__ __forceinline__ void operator()(const f32x4 (&acc)[2][2][4][2], const Unit& u, int wr, int wc, int fr, int fq, int wid) const {
        const int t = u.pn, pm = u.pm;
        float pre[2][4];
#pragma unroll
        for (int ai = 0; ai < 2; ++ai)
#pragma unroll
            for (int m = 0; m < 4; ++m) {
                const size_t row = (size_t)pm * 256 + ai * 128 + wr * 64 + m * 16 + fr;
                const f32x4 a = *(const f32x4*)(SS + row * 8), b = *(const f32x4*)(SS + row * 8 + 4);
                pre[ai][m] = rsqrtf(((a[0] + a[1]) + (a[2] + a[3]) + (b[0] + b[1]) + (b[2] + b[3])) * (1.f / 512.f) + EPS);
                __builtin_amdgcn_sched_barrier(0);
            }
        if (t < 4) norm_rope_store<128>(acc, pm, wr, wc, fr, fq, wid, wBkn, nullptr, nullptr, false, pre, KB, 1536, (t * 2 + (wc >> 1)) * 192, 1, 0, xch);
        else {
            const int colw = (t - 4) * 256 + 32 * wc + 8 * fq;
#pragma unroll
            for (int ai = 0; ai < 2; ++ai)
#pragma unroll
                for (int m = 0; m < 4; ++m) {
                    const size_t row = (size_t)pm * 256 + ai * 128 + wr * 64 + m * 16 + fr;
#pragma unroll
                    for (int bj = 0; bj < 2; ++bj) store8(VB + row * 1024 + colw + bj * 128, acc[ai][bj][m][0] * pre[ai][m], acc[ai][bj][m][1] * pre[ai][m]);
                    __builtin_amdgcn_sched_barrier(0);
                }
        }
    }
};

struct EpiBr {
    static constexpr bool MID = true;
    const bf16_t* MRG; bf16_t* Y;
    __device__ __forceinline__ void mid(f32x4 (&acc)[2][2][4][2], const Unit& u, int i, int wr, int wc, int fr, int fq) const {
#pragma unroll
        for (int ai = 0; ai < 2; ++ai)
#pragma unroll
            for (int m = 0; m < 4; ++m) {
                const size_t row = (size_t)u.pm * 256 + ai * 128 + wr * 64 + m * 16 + fr;
#pragma unroll
                for (int bj = 0; bj < 2; ++bj) {
                    const int col = u.pn * 256 + bj * 128 + 32 * wc + 8 * fq;
                    const u32x4 a = *(const u32x4*)(MRG + row * 6144 + (i - 1) * 2048 + col), b = *(const u32x4*)(MRG + row * 6144 + i * 2048 + col);
#pragma unroll
                    for (int q = 0; q < 4; ++q) {
                        const float r0 = bf2f(a[q] & 0xffffu) * __builtin_amdgcn_rcpf(bf2f(b[q] & 0xffffu)), r1 = bf2f(a[q] >> 16) * __builtin_amdgcn_rcpf(bf2f(b[q] >> 16));
                        acc[ai][bj][m][q >> 1][(q & 1) * 2] *= r0; acc[ai][bj][m][q >> 1][(q & 1) * 2 + 1] *= r1;
                    }
                }
                __builtin_amdgcn_sched_barrier(0);
            }
    }
    __device__ __forceinline__ void operator()(const f32x4 (&acc)[2][2][4][2], const Unit& u, int wr, int wc, int fr, int fq, int wid) const {
#pragma unroll
        for (int ai = 0; ai < 2; ++ai)
#pragma unroll
            for (int m = 0; m < 4; ++m) {
                const size_t row = (size_t)u.pm * 256 + ai * 128 + wr * 64 + m * 16 + fr;
#pragma unroll
                for (int bj = 0; bj < 2; ++bj) {
                    const int col = u.pn * 256 + bj * 128 + 32 * wc + 8 * fq;
                    const u32x4 a = *(const u32x4*)(MRG + row * 6144 + 4096 + col);
                    f32x4 v0 = acc[ai][bj][m][0], v1 = acc[ai][bj][m][1];
                    v0[0] *= bf2f(a[0] & 0xffffu); v0[1] *= bf2f(a[0] >> 16); v0[2] *= bf2f(a[1] & 0xffffu); v0[3] *= bf2f(a[1] >> 16);
                    v1[0] *= bf2f(a[2] & 0xffffu); v1[1] *= bf2f(a[2] >> 16); v1[2] *= bf2f(a[3] & 0xffffu); v1[3] *= bf2f(a[3] >> 16);
                    store8(Y + row * 2048 + col, v0, v1);
                }
                __builtin_amdgcn_sched_barrier(0);
            }
    }
};

struct EpiOut {
    static constexpr bool MID = false;
    const float *xsrc, *csrc; float *xdst, *cdst; const float* mod;
    __device__ __forceinline__ void operator()(const f32x4 (&acc)[2][2][4][2], const Unit& u, int wr, int wc, int fr, int fq, int wid) const {
        const int pm = u.pm; const bool lat = pm < 64;
        const int mi = lat ? (pm >> 4) : 4;
        const float* src = lat ? xsrc : csrc - (size_t)MLAT * DM; float* dst = lat ? xdst : cdst - (size_t)MLAT * DM;
        const float* g = mod + mi * 6144 + 4096;
#pragma unroll
        for (int bj = 0; bj < 2; ++bj) {
            const int col = u.pn * 256 + bj * 128 + 32 * wc + 8 * fq;
            const f32x4 g0 = *(const f32x4*)(g + col), g1 = *(const f32x4*)(g + col + 4);
#pragma unroll
            for (int ai = 0; ai < 2; ++ai)
#pragma unroll
                for (int m = 0; m < 4; ++m) {
                    const size_t row = (size_t)pm * 256 + ai * 128 + wr * 64 + m * 16 + fr;
                    const f32x4 x0 = *(const f32x4*)(src + row * DM + col), x1 = *(const f32x4*)(src + row * DM + col + 4);
                    *(f32x4*)(dst + row * DM + col) = x0 + g0 * acc[ai][bj][m][0];
                    *(f32x4*)(dst + row * DM + col + 4) = x1 + g1 * acc[ai][bj][m][1];
                    __builtin_amdgcn_sched_barrier(0);
                }
        }
    }
};

namespace att {
#define SBAR() __builtin_amdgcn_sched_barrier(0)
__device__ __forceinline__ int crow(int r, int hi) { return (r & 3) + 8 * (r >> 2) + 4 * hi; }
template <int RB> __device__ __forceinline__ int kswz(int row, int colB) { const int x = (RB == 256) ? (row & 7) : ((row >> 1) & 7); return row * RB + (colB ^ (x << 4)); }
__device__ __forceinline__ int v_st(int k, int c) { const int kk = (k & ~0xC) | ((k & 4) << 1) | ((k & 8) >> 1); return ((kk >> 3) * 4 + (c >> 5)) * 512 + ((kk & 7) * 32 + (c & 31)) * 2; }
__device__ __forceinline__ int v_rd_base(int lane) { return ((lane & 3) << 3) | (((lane >> 2) & 3) << 6) | (((lane >> 4) & 1) << 5) | (((lane >> 5) & 1) << 8); }
constexpr int v_rd_off(int d0, int ks, int half) { return d0 * 512 + ks * 4096 + half * 2048; }
template <int OFF> __device__ __forceinline__ s16x4 tr_read(unsigned vb) {
    s16x4 r; asm volatile("ds_read_b64_tr_b16 %0, %1 offset:%2" : "=&v"(r) : "v"(vb), "i"(OFF) : "memory"); return r;
}
template <int D0> __device__ __forceinline__ void pv_one(f32x16& od, unsigned vb, bf16x8 pa0, bf16x8 pa1, bf16x8 pa2, bf16x8 pa3) {
    const s16x4 l0 = tr_read<v_rd_off(D0, 0, 0)>(vb), h0 = tr_read<v_rd_off(D0, 0, 1)>(vb), l1 = tr_read<v_rd_off(D0, 1, 0)>(vb), h1 = tr_read<v_rd_off(D0, 1, 1)>(vb);
    const s16x4 l2 = tr_read<v_rd_off(D0, 2, 0)>(vb), h2 = tr_read<v_rd_off(D0, 2, 1)>(vb), l3 = tr_read<v_rd_off(D0, 3, 0)>(vb), h3 = tr_read<v_rd_off(D0, 3, 1)>(vb);
    asm volatile("s_waitcnt lgkmcnt(0)" ::: "memory"); SBAR();
#define PK(L, H) (bf16x8){L[0], L[1], L[2], L[3], H[0], H[1], H[2], H[3]}
    od = __builtin_amdgcn_mfma_f32_32x32x16_bf16(pa0, PK(l0, h0), od, 0, 0, 0);
    od = __builtin_amdgcn_mfma_f32_32x32x16_bf16(pa1, PK(l1, h1), od, 0, 0, 0);
    od = __builtin_amdgcn_mfma_f32_32x32x16_bf16(pa2, PK(l2, h2), od, 0, 0, 0);
    od = __builtin_amdgcn_mfma_f32_32x32x16_bf16(pa3, PK(l3, h3), od, 0, 0, 0);
#undef PK
}
__device__ __forceinline__ void pv_d0(f32x16 (&o)[4], unsigned vb, bf16x8 pa0, bf16x8 pa1, bf16x8 pa2, bf16x8 pa3) {
    pv_one<0>(o[0], vb, pa0, pa1, pa2, pa3); pv_one<1>(o[1], vb, pa0, pa1, pa2, pa3); pv_one<2>(o[2], vb, pa0, pa1, pa2, pa3); pv_one<3>(o[3], vb, pa0, pa1, pa2, pa3);
}
__device__ __forceinline__ void partialSM(f32x16& p0, f32x16& p1, float C, float nMB) {
#pragma unroll
    for (int r = 0; r < 16; ++r) p0[r] = fmaf(p0[r], C, nMB);
#pragma unroll
    for (int r = 0; r < 16; ++r) p1[r] = fmaf(p1[r], C, nMB);
#pragma unroll
    for (int r = 0; r < 16; ++r) p0[r] = __builtin_amdgcn_exp2f(p0[r]);
}
__device__ __forceinline__ void finishSM(f32x16& p0, f32x16& p1, float& l_reg, bf16x8& pa0, bf16x8& pa1, bf16x8& pa2, bf16x8& pa3) {
#pragma unroll
    for (int r = 0; r < 16; ++r) p1[r] = __builtin_amdgcn_exp2f(p1[r]);
    float ps = 0;
#pragma unroll
    for (int r = 0; r < 16; ++r) ps += p0[r];
#pragma unroll
    for (int r = 0; r < 16; ++r) ps += p1[r];
    { auto rr = __builtin_amdgcn_permlane32_swap(__float_as_uint(ps), __float_as_uint(ps), false, false);
      ps = __uint_as_float(rr[0]) + __uint_as_float(rr[1]); }
    l_reg += ps;
#define PK4(P, BASE, OUT) do { unsigned a0 = cvt_pk_bf16(P[BASE + 0], P[BASE + 1]), a1 = cvt_pk_bf16(P[BASE + 2], P[BASE + 3]);   \
    unsigned b0 = cvt_pk_bf16(P[BASE + 4], P[BASE + 5]), b1 = cvt_pk_bf16(P[BASE + 6], P[BASE + 7]);                              \
    auto r0 = __builtin_amdgcn_permlane32_swap(a0, b0, false, false); auto r1 = __builtin_amdgcn_permlane32_swap(a1, b1, false, false); \
    u32x4 w = {r0[0], r1[0], r0[1], r1[1]}; OUT = *reinterpret_cast<bf16x8*>(&w); } while (0)
    PK4(p0, 0, pa0); PK4(p0, 8, pa1); PK4(p1, 0, pa2); PK4(p1, 8, pa3);
#undef PK4
}
template <int DQK>
__device__ __forceinline__ void qkt(f32x16& p0, f32x16& p1, const LAS char* Ks, const bf16x8 (&qr)[DQK / 16], int r32, int hi) {
    constexpr int RB = DQK * 2;
    p0 = f32x16{}; p1 = f32x16{};
#pragma unroll
    for (int d0 = 0; d0 < DQK / 16; ++d0) { const int cb = (d0 * 16 + hi * 8) * 2;
        const bf16x8 b0 = *(const LAS bf16x8*)(Ks + kswz<RB>(r32, cb));
        const bf16x8 b1 = *(const LAS bf16x8*)(Ks + kswz<RB>(32 + r32, cb));
        p0 = __builtin_amdgcn_mfma_f32_32x32x16_bf16(b0, qr[d0], p0, 0, 0, 0);
        p1 = __builtin_amdgcn_mfma_f32_32x32x16_bf16(b1, qr[d0], p1, 0, 0, 0);
        if (QKT_GRP > 0 && (d0 % QKT_GRP) == QKT_GRP - 1 && d0 + 1 < DQK / 16) SBAR(); }
}
constexpr int V_BYTES = 64 * 128 * 2, K_OFF = 3 * V_BYTES, K_STRIDE = 64 * 192 * 2, LI_OFF = K_OFF + 3 * K_STRIDE;

template <int DQK, bool DOUBLE>
__device__ __forceinline__ void attn_pass(const bf16_t* __restrict__ Q, int ldq, const bf16_t* __restrict__ Kg, int ldk, const bf16_t* __restrict__ Vg, int ldv,
                                          int rowc, int rowl, int NT, float C, float nMB, f32x16 (&o)[4], float& l_reg, LAS char* lds, int tid) {
    constexpr int RB = DQK * 2, NCH = DQK / 8, NLD = NCH / 8;
    const int wid = __builtin_amdgcn_readfirstlane(tid >> 6), lane = tid & 63, r32 = lane & 31, hi = lane >> 5;
    LAS char* V_lds = lds; LAS char* K_lds = lds + K_OFF;
    bf16x8 qr[DQK / 16];
    { const bf16_t* Qw = Q + (size_t)(wid * 32 + r32) * ldq + hi * 8;
#pragma unroll
      for (int d0 = 0; d0 < DQK / 16; ++d0) qr[d0] = *(const bf16x8*)(Qw + d0 * 16); }
#pragma unroll
    for (int d = 0; d < 4; ++d) o[d] = f32x16{};
    l_reg = 0.f;
    int vrow[2], vcol[2], krow[NLD], kcol[NLD];
#pragma unroll
    for (int i = 0; i < 2; ++i) { const int q = tid + 512 * i, sub = q >> 5, within = q & 31, kk = (sub >> 2) * 8 + (within >> 2);
        vrow[i] = (kk & ~0xC) | ((kk & 4) << 1) | ((kk & 8) >> 1); vcol[i] = (sub & 3) * 32 + (within & 3) * 8; }
#pragma unroll
    for (int i = 0; i < NLD; ++i) { const int q = tid + 512 * i, row = q / NCH, chp = q % NCH; const int x = (RB == 256) ? (row & 7) : ((row >> 1) & 7);
        krow[i] = row; kcol[i] = (chp ^ x) * 8; }
    const unsigned vb0 = (unsigned)(uintptr_t)V_lds + v_rd_base(lane);
#define KROW0(j) ((j) < 4 ? rowc + 64 * (j) : rowl + 64 * ((j) - 4))
#define DMA(j, b) do { const size_t _r0 = (size_t)KROW0(j); \
    _Pragma("unroll") for (int _i = 0; _i < 2; ++_i) __builtin_amdgcn_global_load_lds((const unsigned*)(Vg + (_r0 + vrow[_i]) * ldv + vcol[_i]), (LAS unsigned*)(V_lds + (b) * V_BYTES + wid * 1024 + _i * 8192), 16, 0, 0); \
    _Pragma("unroll") for (int _i = 0; _i < NLD; ++_i) __builtin_amdgcn_global_load_lds((const unsigned*)(Kg + (_r0 + krow[_i]) * ldk + kcol[_i]), (LAS unsigned*)(K_lds + (b) * K_STRIDE + wid * 1024 + _i * 8192), 16, 0, 0); } while (0)
#define VMW0() asm volatile("s_waitcnt vmcnt(0)" ::: "memory")
    bf16x8 pa0, pa1, pa2, pa3;
    __syncthreads();
    DMA(0, 0); DMA(1, 1); VMW0(); __syncthreads();
    if constexpr (!DOUBLE) {
        f32x16 p0, p1;
        DMA(2, 2);
        int bc = 0, bn = 1, bf = 2;
        for (int j = 0; j < NT; ++j) {
            SBAR(); qkt<DQK>(p0, p1, K_lds + bc * K_STRIDE, qr, r32, hi);
            partialSM(p0, p1, C, nMB); finishSM(p0, p1, l_reg, pa0, pa1, pa2, pa3); SBAR();
            pv_d0(o, vb0 + bc * V_BYTES, pa0, pa1, pa2, pa3);
            if (j + 1 < NT) { VMW0(); __syncthreads(); if (j + 3 < NT) DMA(j + 3, bc); }
            { const int _t = bc; bc = bn; bn = bf; bf = _t; }
        }
    } else {
    f32x16 pA0, pA1, pB0, pB1;
    qkt<DQK>(pA0, pA1, K_lds, qr, r32, hi); partialSM(pA0, pA1, C, nMB);
    DMA(2, 2);
    int bp = 0, bc = 1, bn = 2;
#define STEP(j, PC0, PC1, PP0, PP1) do { \
        SBAR(); qkt<DQK>(PC0, PC1, K_lds + bc * K_STRIDE, qr, r32, hi); \
        finishSM(PP0, PP1, l_reg, pa0, pa1, pa2, pa3); SBAR(); \
        pv_d0(o, vb0 + bp * V_BYTES, pa0, pa1, pa2, pa3); partialSM(PC0, PC1, C, nMB); \
        if ((j) + 1 < NT) { VMW0(); __syncthreads(); if ((j) + 2 < NT) DMA((j) + 2, bp); } \
        { const int _t = bp; bp = bc; bc = bn; bn = _t; } } while (0)
    for (int j = 1; j < NT; j += 2) {
        STEP(j, pB0, pB1, pA0, pA1);
        if (j + 1 < NT) STEP(j + 1, pA0, pA1, pB0, pB1);
    }
    finishSM(pB0, pB1, l_reg, pa0, pa1, pa2, pa3); SBAR();
    pv_d0(o, vb0 + bp * V_BYTES, pa0, pa1, pa2, pa3);
    }
#undef KROW0
#undef DMA
#undef VMW0
#undef STEP
}
__device__ __forceinline__ void row_recip(float l_reg, float (&rli)[16], LAS float* li, int r32, int hi) {
    if (hi == 0) li[r32] = l_reg;
    asm volatile("s_waitcnt lgkmcnt(0)" ::: "memory");
#pragma unroll
    for (int r = 0; r < 16; ++r) rli[r] = __builtin_amdgcn_rcpf(li[crow(r, hi)]);
    asm volatile("s_waitcnt lgkmcnt(0)" ::: "memory");
}
}

struct AttnBufs { const bf16_t *QA, *KA, *VA, *QB, *KB, *VB, *QC, *KC, *VC, *GATE; bf16_t* BR; float* SCR; const float* lamv; const float* subln; float lam_init; };

template <bool SUBLN>
__device__ __forceinline__ void attn_out(const AttnBufs& T, f32x16 (&o)[4], int type, int h, size_t orow0, LAS char* lds, int wid, int lane, int r32, int hi) {
    __syncthreads();
    LAS float* stg = (LAS float*)(lds + wid * 16896);
#pragma unroll
    for (int d0 = 0; d0 < 4; ++d0)
#pragma unroll
        for (int r = 0; r < 16; ++r) stg[att::crow(r, hi) * 132 + d0 * 32 + r32] = o[d0][r];
    asm volatile("s_waitcnt lgkmcnt(0)" ::: "memory");
    const int rr = lane >> 5, c4 = (lane & 31) * 4;
    const int col = type * 1024 + h * 128 + c4;
    f32x4 wsub = {1.f, 1.f, 1.f, 1.f};
    if (SUBLN) { wsub = *(const f32x4*)(T.subln + c4) * (1.f - T.lam_init); }
    const bf16_t* gp = T.GATE + (orow0 + rr) * 3072 + col; bf16_t* op = T.BR + (orow0 + rr) * 3072 + col;
#pragma unroll 4
    for (int i = 0; i < 16; ++i) {
        f32x4 v = *(const LAS f32x4*)(stg + (2 * i + rr) * 132 + c4);
        const u32x2 gg = *(const u32x2*)(gp + (size_t)i * 2 * 3072);
        if (SUBLN) {
            float s = (v[0] * v[0] + v[1] * v[1]) + (v[2] * v[2] + v[3] * v[3]);
            s += __shfl_xor(s, 1); s += __shfl_xor(s, 2); s += __shfl_xor(s, 4); s += __shfl_xor(s, 8); s += __shfl_xor(s, 16);
            v = v * (rsqrtf(s * (1.f / 128.f) + EPS)) * wsub;
        }
        u32x2 w; w.x = cvt_pk_bf16(v[0] * bf2f(gg.x & 0xffffu), v[1] * bf2f(gg.x >> 16)); w.y = cvt_pk_bf16(v[2] * bf2f(gg.y & 0xffffu), v[3] * bf2f(gg.y >> 16));
        *(u32x2*)(op + (size_t)i * 2 * 3072) = w;
    }
}

__device__ __forceinline__ void attn_item(const AttnBufs& T, int type, int b, int h, int qrow0, int NT, LAS char* lds, int tid_) {
    asm volatile("" : "+v"(tid_));
    const int tid = tid_, wid = __builtin_amdgcn_readfirstlane(tid >> 6), lane = tid & 63, r32 = lane & 31, hi = lane >> 5;
    const int rowc = MLAT + b * CTXL, rowl = b * SEQ;
    LAS float* li = (LAS float*)(lds + att::LI_OFF) + wid * 64;
    constexpr float LOG2E = 1.4426950408889634f;
    const size_t orow0 = (size_t)qrow0 + wid * 32;
    if (type == 0 && (MK_ATYPE & 1)) {
        f32x16 o[4]; float l_reg; float rli[16];
        att::attn_pass<128, ATT_DBL>(T.QA + (size_t)qrow0 * 1024 + h * 128, 1024, T.KA + (h >> 2) * 128, 256, T.VA + (h >> 2) * 128, 256, rowc, rowl, NT,
                            0.08838834764831845f * LOG2E, T.lamv[1], o, l_reg, lds, tid);
        att::row_recip(l_reg, rli, li, r32, hi);
#pragma unroll
        for (int d0 = 0; d0 < 4; ++d0)
#pragma unroll
            for (int r = 0; r < 16; ++r) o[d0][r] *= rli[r];
        attn_out<false>(T, o, 0, h, orow0, lds, wid, lane, r32, hi);
    } else if (type == 1 && (MK_ATYPE & 2)) {
        f32x16 o[4]; float l_reg; float rli[16];
        att::attn_pass<192, false>(T.QB + (size_t)qrow0 * 1536 + h * 192, 1536, T.KB + h * 192, 1536, T.VB + h * 128, 1024, rowc, rowl, NT,
                            0.07216878364870323f * LOG2E, T.lamv[2], o, l_reg, lds, tid);
        att::row_recip(l_reg, rli, li, r32, hi);
#pragma unroll
        for (int d0 = 0; d0 < 4; ++d0)
#pragma unroll
            for (int r = 0; r < 16; ++r) o[d0][r] *= rli[r];
        attn_out<false>(T, o, 1, h, orow0, lds, wid, lane, r32, hi);
    } else if (MK_ATYPE & 4) {
        f32x16 o[4]; float l_reg; float rli[16];
        att::attn_pass<64, ATT_DBL>(T.QC + (size_t)qrow0 * 1024 + h * 128, 1024, T.KC + h * 128, 1024, T.VC + h * 128, 1024, rowc, rowl, NT,
                           0.125f * LOG2E, T.lamv[3], o, l_reg, lds, tid);
        att::row_recip(l_reg, rli, li, r32, hi);
        f32x4* scr = (f32x4*)(T.SCR + ((size_t)blockIdx.x * 512 + tid) * 64);
#pragma unroll
        for (int d0 = 0; d0 < 4; ++d0)
#pragma unroll
            for (int q = 0; q < 4; ++q) scr[d0 * 4 + q] = (f32x4){o[d0][q * 4] * rli[q * 4], o[d0][q * 4 + 1] * rli[q * 4 + 1], o[d0][q * 4 + 2] * rli[q * 4 + 2], o[d0][q * 4 + 3] * rli[q * 4 + 3]};
        att::attn_pass<64, ATT_DBL>(T.QC + (size_t)qrow0 * 1024 + h * 128 + 64, 1024, T.KC + h * 128 + 64, 1024, T.VC + h * 128, 1024, rowc, rowl, NT,
                           0.125f * LOG2E, T.lamv[3], o, l_reg, lds, tid);
        att::row_recip(l_reg, rli, li, r32, hi);
        const float lam = T.lamv[0];
#pragma unroll
        for (int d0 = 0; d0 < 4; ++d0)
#pragma unroll
            for (int q = 0; q < 4; ++q) { const f32x4 a = scr[d0 * 4 + q];
#pragma unroll
                for (int j = 0; j < 4; ++j) o[d0][q * 4 + j] = a[j] - lam * (o[d0][q * 4 + j] * rli[q * 4 + j]); }
        attn_out<true>(T, o, 2, h, orow0, lds, wid, lane, r32, hi);
    }
}

__device__ __forceinline__ void transpose_item(const float* __restrict__ W, int ldw, int k0, int srccol4, const float* __restrict__ kscale,
                                               bf16_t* __restrict__ WT, int ldt, int n0, int kdst0, LAS float* scr, int lane) {
    const int ks = lane >> 4, n4 = (lane & 15) * 4;
#pragma unroll 8
    for (int i = 0; i < 16; ++i) { const int kk = 4 * i + ks;
        f32x4 v = srccol4 >= 0 ? *(const f32x4*)(W + (size_t)(k0 + kk) * ldw + srccol4) : (f32x4){0.f, 0.f, 0.f, 0.f};
        if (kscale) v = v * kscale[k0 + kk];
        LAS float* d = scr + kk * 65 + n4; d[0] = v[0]; d[1] = v[1]; d[2] = v[2]; d[3] = v[3]; }
    asm volatile("s_waitcnt lgkmcnt(0)" ::: "memory");
    const int nn = lane & 7, c = lane >> 3;
#pragma unroll
    for (int j = 0; j < 8; ++j) { const int n = nn + 8 * j; const LAS float* s = scr + (8 * c) * 65 + n;
        u32x4 o; o.x = cvt_pk_bf16(s[0 * 65], s[1 * 65]); o.y = cvt_pk_bf16(s[2 * 65], s[3 * 65]); o.z = cvt_pk_bf16(s[4 * 65], s[5 * 65]); o.w = cvt_pk_bf16(s[6 * 65], s[7 * 65]);
        *(u32x4*)(WT + (size_t)(n0 + n) * ldt + kdst0 + k0 + 8 * c) = o; }
    asm volatile("s_waitcnt lgkmcnt(0)" ::: "memory");
}
__device__ const float INVF32[16] = {1.000000000e+00f, 5.623413324e-01f, 3.162277639e-01f, 1.778279394e-01f, 1.000000015e-01f, 5.623413250e-02f, 3.162277490e-02f, 1.778279431e-02f,
    9.999999776e-03f, 5.623413250e-03f, 3.162277630e-03f, 1.778279431e-03f, 1.000000047e-03f, 5.623413017e-04f, 3.162277571e-04f, 1.778279402e-04f};
__device__ const float INVF64[32] = {1.000000000e+00f, 7.498942614e-01f, 5.623413324e-01f, 4.216965139e-01f, 3.162277639e-01f, 2.371373773e-01f, 1.778279394e-01f, 1.333521307e-01f,
    1.000000015e-01f, 7.498941571e-02f, 5.623413250e-02f, 4.216965288e-02f, 3.162277490e-02f, 2.371373773e-02f, 1.778279431e-02f, 1.333521493e-02f, 9.999999776e-03f, 7.498941850e-03f,
    5.623413250e-03f, 4.216964822e-03f, 3.162277630e-03f, 2.371373586e-03f, 1.778279431e-03f, 1.333521446e-03f, 1.000000047e-03f, 7.498942432e-04f, 5.623413017e-04f, 4.216965172e-04f,
    3.162277571e-04f, 2.371373703e-04f, 1.778279402e-04f, 1.333521504e-04f};
__device__ __forceinline__ void sincos_d(double x, float& s, float& c) {
    const double twopi = 6.283185307179586476925;
    const double k = __builtin_rint(x / twopi), r = x - k * twopi, r2 = r * r;
    double st = r, ct = 1.0, ss = r, cs = 1.0;
    for (int n = 1; n <= 16; ++n) { ct *= -r2 / (double)((2 * n - 1) * (2 * n)); st *= -r2 / (double)((2 * n) * (2 * n + 1)); cs += ct; ss += st; }
    s = (float)ss; c = (float)cs;
}
__device__ __forceinline__ float absmax_n(const float* w, int n) { float m = 0.f; for (int i = 0; i < n; ++i) m = fmaxf(m, fabsf(w[i])); return m; }

typedef unsigned v4u_unused_t;
#define XB_TMO      128
#define XB_XCNT(j)  (256  + 64 * (j))
#define XB_XSUB(j)  (1280 + 64 * (j))
#define XB_XGEN(j)  (2304 + 64 * (j))
#define XB_TOP      3328
#define XB_TOPGEN   3392
#define XCD_BAR_WORDS 3456
#define XB_SPIN_CAP (1u << 18)

__device__ __forceinline__ unsigned xb_ld(unsigned* p)              { return __hip_atomic_load(p, __ATOMIC_RELAXED, __HIP_MEMORY_SCOPE_AGENT); }
__device__ __forceinline__ unsigned xb_add(unsigned* p, unsigned v) { return __hip_atomic_fetch_add(p, v, __ATOMIC_RELAXED, __HIP_MEMORY_SCOPE_AGENT); }
__device__ __forceinline__ unsigned xb_xcc_id() { return (unsigned)__builtin_amdgcn_s_getreg((3 << 11) | 20) & 0xFu; }
#define XB_SPIN(cond, bar) do { unsigned _sp = 0; while (cond) { __builtin_amdgcn_s_sleep(1); \
    if ((++_sp & 255u) == 0u) { if (xb_ld(&(bar)[XB_TMO])) break; if (_sp > XB_SPIN_CAP) { atomicAdd(&(bar)[XB_TMO], 1u); break; } } } } while (0)

struct XcdBarrier {
    unsigned* bar; unsigned x;
    volatile LAS unsigned* st;
};

__device__ __forceinline__ XcdBarrier xcd_barrier_post(unsigned* bar, volatile LAS unsigned* st) {
    XcdBarrier b; b.bar = bar; b.x = xb_xcc_id(); b.st = st;
    if (threadIdx.x == 0) (void)xb_add(&bar[XB_XCNT(b.x)], 1u);
    return b;
}
__device__ __forceinline__ void xcd_barrier_complete(unsigned* bar, unsigned x, unsigned& nloc, unsigned& nx) {
    const unsigned G = gridDim.x * gridDim.y * gridDim.z;
    unsigned sum, cnt, mine, sp = 0u;
    for (;;) {
        sum = 0u; cnt = 0u; mine = 0u;
#pragma unroll
        for (unsigned j = 0; j < 16; ++j) { const unsigned c = xb_ld(&bar[XB_XCNT(j)]); sum += c; cnt += (c > 0u) ? 1u : 0u; mine = (j == x) ? c : mine; }
        if (sum == G) break;
        __builtin_amdgcn_s_sleep(1);
        if ((++sp & 255u) == 0u) { if (xb_ld(&bar[XB_TMO])) break; if (sp > XB_SPIN_CAP) { atomicAdd(&bar[XB_TMO], 1u); break; } }
    }
    nloc = mine > 0u ? mine : 1u; nx = cnt > 0u ? cnt : 1u;
}

__device__ __forceinline__ void xcd_barrier(const XcdBarrier& b) {
    asm volatile("s_waitcnt vmcnt(0)" ::: "memory");
    __syncthreads();
    if (threadIdx.x == 0) {
        unsigned* bar = b.bar;
        __builtin_amdgcn_s_waitcnt(0);
        unsigned nloc = b.st[0], nx = b.st[1];
        if (nloc == 0u) { xcd_barrier_complete(bar, b.x, nloc, nx); b.st[0] = nloc; b.st[1] = nx; }
        const unsigned old = xb_add(&bar[XB_XSUB(b.x)], 1u);
        const unsigned gen = old / nloc;
        if (old + 1u == (gen + 1u) * nloc) {
            __builtin_amdgcn_fence(__ATOMIC_RELEASE, "agent");
            asm volatile("s_waitcnt vmcnt(0)" ::: "memory");
            const unsigned og = xb_add(&bar[XB_TOP], 1u);
            const unsigned tg = og / nx;
            if (og + 1u == (tg + 1u) * nx) xb_add(&bar[XB_TOPGEN], 1u);
            else XB_SPIN(xb_ld(&bar[XB_TOPGEN]) == tg, bar);
            __builtin_amdgcn_fence(__ATOMIC_ACQUIRE, "agent");
            xb_add(&bar[XB_XGEN(b.x)], 1u);
            asm volatile("s_waitcnt vmcnt(0)" ::: "memory");
        } else {
            XB_SPIN(xb_ld(&bar[XB_XGEN(b.x)]) == gen, bar);
            __builtin_amdgcn_fence(__ATOMIC_ACQUIRE, "agent");
            asm volatile("s_waitcnt vmcnt(0)" ::: "memory");
        }
    }
    __syncthreads();
}

__device__ __forceinline__ void p1_row(int row, const float* __restrict__ xsrc, const float* __restrict__ csrc, const float* __restrict__ modl, const float* __restrict__ nw,
                                       bf16_t* __restrict__ H, int lane) {
    const bool lat = row < MLAT; const int mi = lat ? (row >> 12) : 4;
    const f32x4* xr = (const f32x4*)(lat ? xsrc + (size_t)row * DM : csrc + (size_t)(row - MLAT) * DM) + lane;
    f32x4 v[8]; float s = 0.f;
#pragma unroll
    for (int j = 0; j < 8; ++j) { v[j] = xr[64 * j]; s += (v[j][0] * v[j][0] + v[j][1] * v[j][1]) + (v[j][2] * v[j][2] + v[j][3] * v[j][3]); }
    const float rinv = rsqrtf(wave_sum(s) * (1.f / DM) + EPS);
    const f32x4* sh = (const f32x4*)(modl + mi * 6144) + lane; const f32x4* scl = (const f32x4*)(modl + mi * 6144 + DM) + lane; const f32x4* nwp = (const f32x4*)nw + lane;
    u32x2* o8 = (u32x2*)(H + (size_t)row * DM) + lane;
#pragma unroll
    for (int j = 0; j < 8; ++j) { const f32x4 y = v[j] * rinv * nwp[64 * j] * (scl[64 * j] + 1.f) + sh[64 * j];
        u32x2 w; w.x = cvt_pk_bf16(y[0], y[1]); w.y = cvt_pk_bf16(y[2], y[3]); o8[64 * j] = w; }
}

__device__ __forceinline__ void p1_row2(int rowA, int rowB, const float* __restrict__ xsrc, const float* __restrict__ csrc, const float* __restrict__ modl,
                                        const float* __restrict__ nw, bf16_t* __restrict__ H, int lane) {
    if (rowB < 0) { p1_row(rowA, xsrc, csrc, modl, nw, H, lane); return; }
    const bool latA = rowA < MLAT, latB = rowB < MLAT; const int miA = latA ? (rowA >> 12) : 4, miB = latB ? (rowB >> 12) : 4;
    const f32x4* xa = (const f32x4*)(latA ? xsrc + (size_t)rowA * DM : csrc + (size_t)(rowA - MLAT) * DM) + lane;
    const f32x4* xb = (const f32x4*)(latB ? xsrc + (size_t)rowB * DM : csrc + (size_t)(rowB - MLAT) * DM) + lane;
    f32x4 va[8], vb[8]; float sa = 0.f, sb = 0.f;
#pragma unroll
    for (int j = 0; j < 8; ++j) { va[j] = xa[64 * j]; vb[j] = xb[64 * j]; }
#pragma unroll
    for (int j = 0; j < 8; ++j) { sa += (va[j][0] * va[j][0] + va[j][1] * va[j][1]) + (va[j][2] * va[j][2] + va[j][3] * va[j][3]);
                                  sb += (vb[j][0] * vb[j][0] + vb[j][1] * vb[j][1]) + (vb[j][2] * vb[j][2] + vb[j][3] * vb[j][3]); }
    const float ra = rsqrtf(wave_sum(sa) * (1.f / DM) + EPS), rb = rsqrtf(wave_sum(sb) * (1.f / DM) + EPS);
    const f32x4* nwp = (const f32x4*)nw + lane;
    const f32x4* sha = (const f32x4*)(modl + miA * 6144) + lane; const f32x4* sca = (const f32x4*)(modl + miA * 6144 + DM) + lane;
    const f32x4* shb = (const f32x4*)(modl + miB * 6144) + lane; const f32x4* scb = (const f32x4*)(modl + miB * 6144 + DM) + lane;
    u32x2* oa = (u32x2*)(H + (size_t)rowA * DM) + lane; u32x2* ob = (u32x2*)(H + (size_t)rowB * DM) + lane;
#pragma unroll
    for (int j = 0; j < 8; ++j) { const f32x4 w4 = nwp[64 * j];
        const f32x4 ya = va[j] * ra * w4 * (sca[64 * j] + 1.f) + sha[64 * j], yb = vb[j] * rb * w4 * (scb[64 * j] + 1.f) + shb[64 * j];
        u32x2 wa, wb; wa.x = cvt_pk_bf16(ya[0], ya[1]); wa.y = cvt_pk_bf16(ya[2], ya[3]); wb.x = cvt_pk_bf16(yb[0], yb[1]); wb.y = cvt_pk_bf16(yb[2], yb[3]);
        oa[64 * j] = wa; ob[64 * j] = wb; }
}

struct Args { const float* in[29]; float* out; unsigned char* ws; int ph_lo, ph_hi, coop, pad; };

__global__ void __launch_bounds__(512, 2) mega_fwd(Args args) {
    extern __shared__ __attribute__((aligned(16))) unsigned char lds_raw[];
    LAS unsigned char* lds = (LAS unsigned char*)lds_raw;
    const int G = gridDim.x, bx = blockIdx.x;
    const int vcu = (G % 8 == 0) ? (bx % 8) * (G / 8) + bx / 8 : bx;
    unsigned char* ws = args.ws;
    float* MOD = (float*)(ws + WS_MOD);
    float* TC64 = (float*)(ws + WS_TC64); float* TS64 = (float*)(ws + WS_TS64); float* TC128 = (float*)(ws + WS_TC128); float* TS128 = (float*)(ws + WS_TS128);
    float* LAM = (float*)(ws + WS_LAM);
    bf16_t* WIN = (bf16_t*)(ws + WS_WIN); bf16_t* WUP = (bf16_t*)(ws + WS_WUP); bf16_t* WBR = (bf16_t*)(ws + WS_WBR); bf16_t* WOUT = (bf16_t*)(ws + WS_WOUT);
    bf16_t* H = (bf16_t*)(ws + WS_H); bf16_t* QA = (bf16_t*)(ws + WS_QA); bf16_t* KA = (bf16_t*)(ws + WS_KA); bf16_t* VA = (bf16_t*)(ws + WS_VA);
    bf16_t* QB = (bf16_t*)(ws + WS_QB); bf16_t* KB = (bf16_t*)(ws + WS_KB); bf16_t* CKV = (bf16_t*)(ws + WS_CKV); bf16_t* VB = (bf16_t*)(ws + WS_VB);
    bf16_t* QC = (bf16_t*)(ws + WS_QC); bf16_t* KC = (bf16_t*)(ws + WS_KC); bf16_t* VC = (bf16_t*)(ws + WS_VC);
    bf16_t* GATE = (bf16_t*)(ws + WS_GATE); bf16_t* MRG = (bf16_t*)(ws + WS_MRG); bf16_t* BR = (bf16_t*)(ws + WS_BR); bf16_t* Y = (bf16_t*)(ws + WS_Y);
    float* SS = (float*)(ws + WS_SS); float* CTXW = (float*)(ws + WS_CTXW); float* SCR = (float*)(ws + WS_SCR);
    LAS float* xch = (LAS float*)(lds + XCH_OFF);
    volatile LAS unsigned* bst = (volatile LAS unsigned*)(lds + XCH_OFF + 4096);
    if (threadIdx.x < 2) bst[threadIdx.x] = 0u;
    __syncthreads();
    XcdBarrier bar = xcd_barrier_post((unsigned*)(ws + WS_BAR), bst);

    for (int ph = args.ph_lo; ph < args.ph_hi; ++ph) {
        int tid = threadIdx.x; asm volatile("" : "+v"(tid));
        const int lane = tid & 63, wave = __builtin_amdgcn_readfirstlane(tid >> 6);
        if (ph == 0 && (MK_MASK & 1)) {
            {
                LAS float* sc = (LAS float*)lds;
                LAS float* red = (LAS float*)(lds + 65536);
                for (int i = tid; i < 5 * DM; i += 512) { const float v = i < 4 * DM ? args.in[1][i] : args.in[3][i - 4 * DM]; sc[i] = silu_f(v); }
                __syncthreads();
                for (int it = bx; it < DEPTH * 96; it += G) {
                    const int l = it / 96, n0 = (it % 96) * 64;
                    const float* W = args.in[5] + (size_t)l * DM * 6144 + n0 + lane;
                    float a0 = 0.f, a1 = 0.f, a2 = 0.f, a3 = 0.f, a4 = 0.f;
                    const int kb = wave * 256;
#pragma unroll 8
                    for (int k = 0; k < 256; ++k) { const float wv = W[(size_t)(kb + k) * 6144];
                        a0 += sc[kb + k] * wv; a1 += sc[DM + kb + k] * wv; a2 += sc[2 * DM + kb + k] * wv; a3 += sc[3 * DM + kb + k] * wv; a4 += sc[4 * DM + kb + k] * wv; }
                    red[(wave * 5 + 0) * 64 + lane] = a0; red[(wave * 5 + 1) * 64 + lane] = a1; red[(wave * 5 + 2) * 64 + lane] = a2; red[(wave * 5 + 3) * 64 + lane] = a3; red[(wave * 5 + 4) * 64 + lane] = a4;
                    __syncthreads();
                    if (tid < 320) { const int i = tid >> 6; float s = 0.f;
                        for (int w8 = 0; w8 < 8; ++w8) s += red[(w8 * 5 + i) * 64 + lane];
                        MOD[((size_t)l * 5 + i) * 6144 + n0 + lane] = s + args.in[6][(size_t)l * 6144 + n0 + lane]; }
                    __syncthreads();
                }
            }
            if (bx == 1 % G) {
                for (int i = tid; i < 64 * 16; i += 512) { const int pos = i >> 4, f = i & 15; const float ang = (float)pos * INVF32[f]; float s, c; sincos_d((double)ang, s, c); TC64[i] = c; TS64[i] = s; }
                for (int i = tid; i < 64 * 32; i += 512) { const int pos = i >> 5, f = i & 31; const float ang = (float)pos * INVF64[f]; float s, c; sincos_d((double)ang, s, c); TC128[i] = c; TS128[i] = s; }
            }
            if (bx == 2 % G && tid < DEPTH) {
                const int l = tid;
                float s1 = 0.f, s2 = 0.f;
                for (int i = 0; i < 64; ++i) { s1 += args.in[20][l * 64 + i] * args.in[21][l * 64 + i]; s2 += args.in[22][l * 64 + i] * args.in[23][l * 64 + i]; }
                const float lam_init = 0.8f - 0.6f * expf(-0.3f * (float)l);
                LAM[l * 4 + 0] = expf(s1) - expf(s2) + lam_init;
                const float mAq = absmax_n(args.in[9] + l * 128, 128), mAk = absmax_n(args.in[10] + l * 128, 128);
                const float mBqn = absmax_n(args.in[11] + l * 128, 128), mBqr = absmax_n(args.in[12] + l * 64, 64), mBkn = absmax_n(args.in[16] + l * 128, 128), mBkr = absmax_n(args.in[17] + l * 64, 64);
                const float mCq = absmax_n(args.in[18] + l * 64, 64), mCk = absmax_n(args.in[19] + l * 64, 64);
                const float L2E = 1.4426950408889634f;
                LAM[l * 4 + 1] = -(sqrtf(128.f) * mAq * mAk) * L2E;
                LAM[l * 4 + 2] = -(sqrtf(128.f * mBqn * mBqn + 64.f * mBqr * mBqr) * sqrtf(128.f * mBkn * mBkn + 64.f * mBkr * mBkr) * 0.07216878364870323f) * L2E;
                LAM[l * 4 + 3] = -(8.f * mCq * mCk) * L2E;
            }
            __syncthreads();
            {
                LAS float* scr = (LAS float*)(lds + wave * 16640);
                const int gw = vcu * 8 + wave, NGW = G * 8;
                constexpr int I_IN = 32 * (NIN / 64), I_UP = 8 * 32, I_BR = 3 * 16 * 32, I_OUT = 32 * 32, I_L = I_IN + I_UP + I_BR + I_OUT;
                const int n4 = (lane & 15) * 4;
                for (int it = gw; it < DEPTH * I_L; it += NGW) {
                    const int l = it / I_L; int r = it % I_L;
                    if (r < I_IN) { const int nb = r % (NIN / 64), kb = r / (NIN / 64); const int n0 = nb * 64;
                        transpose_item(args.in[7] + (size_t)l * DM * INC, INC, kb * 64, in_src_col(n0 + n4), nullptr, WIN + (size_t)l * NIN * DM, DM, n0, 0, scr, lane); continue; }
                    r -= I_IN;
                    if (r < I_UP) { const int nb = r % 32, kb = r / 32; const int n0 = nb * 64; const int sc_ = up_src_col(n0 + n4);
                        const float* W = (sc_ < 1024 ? args.in[14] : args.in[15]) + (size_t)l * 512 * 1024;
                        transpose_item(W, 1024, kb * 64, sc_ & 1023, args.in[13] + l * 512, WUP + (size_t)l * 2048 * 512, 512, n0, 0, scr, lane); continue; }
                    r -= I_UP;
                    if (r < I_BR) { const int br = r / (16 * 32), r2 = r % (16 * 32); const int nb = r2 % 32, kb = r2 / 32; const int n0 = nb * 64;
                        transpose_item(args.in[25 + br] + (size_t)l * 1024 * DM, DM, kb * 64, n0 + n4, nullptr, WBR + (size_t)l * 2048 * 3072, 3072, n0, br * 1024, scr, lane); continue; }
                    r -= I_BR;
                    { const int nb = r % 32, kb = r / 32; const int n0 = nb * 64;
                      transpose_item(args.in[28] + (size_t)l * DM * DM, DM, kb * 64, n0 + n4, nullptr, WOUT + (size_t)l * DM * DM, DM, n0, 0, scr, lane); }
                }
            }
        } else {
            const int l = (ph == 1) ? 0 : (ph - 2) / 4, st = (ph == 1) ? 0 : 1 + (ph - 2) % 4;
            const float* xsrc = (l == 0) ? args.in[0] : args.out;
            const float* csrc = (l == 0) ? args.in[2] : CTXW;
            const float* modl = MOD + (size_t)l * 5 * 6144;
            const int Mrows = (l == DEPTH - 1) ? MLAT : MTOT;
            if (st == 0 && (MK_MASK & 2)) {
                const float* nw = args.in[4] + (size_t)l * DM;
                for (int row = bx * 8 + wave; row < MTOT; row += G * 16) { const int rb = row + G * 8; p1_row2(row, rb < MTOT ? rb : -1, xsrc, csrc, modl, nw, H, lane); }
            } else if (st == 1 && (MK_MASK & 4)) {
                pg8::Gemm g{H, WIN + (size_t)l * NIN * DM, MTOT, NIN, DM}; pg8::StaticOrder S; S.init(MTOT, NIN, G, bx);
                EpiIn E{QA, KA, VA, QB, KB, CKV, QC, KC, VC, GATE, MRG, SS,
                        args.in[9] + l * 128, args.in[10] + l * 128, args.in[11] + l * 128, args.in[12] + l * 64, args.in[17] + l * 64, args.in[18] + l * 64, args.in[19] + l * 64,
                        args.in[8] + (size_t)l * 6144, TC64, TS64, TC128, TS128, xch};
                pg8::gemm_phase<EpiIn>(lds, g, S, E, tid);
            } else if (st == 2 && (MK_MASK & 8)) {
                pg8::Gemm g{CKV, WUP + (size_t)l * 2048 * 512, MTOT, 2048, 512}; pg8::StaticOrder S; S.init(MTOT, 2048, G, bx);
                EpiUp E{KB, VB, SS, args.in[16] + l * 128, xch};
                pg8::gemm_phase<EpiUp>(lds, g, S, E, tid);
            } else if (st == 3 && (MK_MASK & 16)) {
                AttnBufs T{QA, KA, VA, QB, KB, VB, QC, KC, VC, GATE, BR, SCR, LAM + l * 4, args.in[24] + l * 128, 0.8f - 0.6f * expf(-0.3f * (float)l)};
                const int nctx = (l < DEPTH - 1) ? 96 : 0;
                for (int k = 0;; ++k) {
                    int type, b, h, qrow0, NT;
                    if (G == 256) {
                        if (k < 6) { const int id = (k & 1) * 256 + vcu; type = k >> 1; b = id >> 7; h = (id >> 4) & 7; qrow0 = b * SEQ + (id & 15) * 256; NT = 68; }
                        else if (k == 6 && bx < nctx) { type = bx >> 5; b = (bx >> 3) & 3; h = bx & 7; qrow0 = MLAT + b * CTXL; NT = 4; }
                        else break;
                    } else {
                        const int it = bx + k * G; if (it >= 1536 + nctx) break;
                        if (it < 1536) { const int id = it & 511; type = it >> 9; b = id >> 7; h = (id >> 4) & 7; qrow0 = b * SEQ + (id & 15) * 256; NT = 68; }
                        else { const int c = it - 1536; type = c >> 5; b = (c >> 3) & 3; h = c & 7; qrow0 = MLAT + b * CTXL; NT = 4; }
                    }
                    attn_item(T, type, b, h, qrow0, NT, (LAS char*)lds, tid);
                }
                __syncthreads();
            } else {
                unsigned* CNT = (unsigned*)(ws + WS_CNT) + (size_t)l * 68 * 64;
                const bool merged = (G == 256) && args.coop;
                const bool ctxl = l < DEPTH - 1;
                pg8::Gemm g3{BR, WBR + (size_t)l * 2048 * 3072, Mrows, 2048, 3072}; EpiBr E3{MRG, Y};
                pg8::Gemm g4{Y, WOUT + (size_t)l * DM * DM, Mrows, DM, DM}; EpiOut E4{xsrc, csrc, args.out, CTXW, modl};
                for (int part = 0; part < 2; ++part) {
                    pg8::StaticOrder S;
                    if (!merged) { if (part) break; S.init(Mrows, 2048, G, bx); }
                    else if (part == 0) S.init(MLAT, 2048, G, bx);
                    else { if (!(ctxl && bx < 32)) break; S.init_one(64 + (bx >> 3), bx & 7); }
                    { int t2 = threadIdx.x; asm volatile("" : "+v"(t2)); pg8::gemm_phase<EpiBr>(lds, g3, S, E3, t2); }
                    if (merged && threadIdx.x == 0) {
                        __builtin_amdgcn_fence(__ATOMIC_RELEASE, "agent");
                        asm volatile("s_waitcnt vmcnt(0)" ::: "memory");
                        pg8::Unit u; for (int i = 0; S.next(i, u); ++i) __hip_atomic_fetch_add(&CNT[u.pm * 64], 1u, __ATOMIC_RELAXED, __HIP_MEMORY_SCOPE_AGENT);
                    }
                }
                if (!merged && args.coop) xcd_barrier(bar);
                for (int part = 0; part < 2; ++part) {
                    pg8::StaticOrder S;
                    if (!merged) { if (part) break; S.init(Mrows, DM, G, bx); }
                    else if (part == 0) S.init(MLAT, DM, G, bx);
                    else { if (!(ctxl && bx >= 32 && bx < 64)) break; S.init_one(64 + ((bx - 32) >> 3), bx & 7); }
                    if (merged) {
                        if (threadIdx.x == 0) {
                            pg8::Unit u;
                            for (int i = 0; S.next(i, u); ++i) { unsigned sp = 0;
                                while (__hip_atomic_load(&CNT[u.pm * 64], __ATOMIC_RELAXED, __HIP_MEMORY_SCOPE_AGENT) < 8u) { __builtin_amdgcn_s_sleep(1); if (++sp > (1u << 22)) break; } }
                            __builtin_amdgcn_fence(__ATOMIC_ACQUIRE, "agent");
                            asm volatile("s_waitcnt vmcnt(0)" ::: "memory");
                        }
                        __syncthreads();
                    }
                    { int t2 = threadIdx.x; asm volatile("" : "+v"(t2)); pg8::gemm_phase<EpiOut>(lds, g4, S, E4, t2); }
                    if (merged && ctxl && threadIdx.x == 0) {
                        __builtin_amdgcn_fence(__ATOMIC_RELEASE, "agent");
                        asm volatile("s_waitcnt vmcnt(0)" ::: "memory");
                        pg8::Unit u; for (int i = 0; S.next(i, u); ++i) __hip_atomic_fetch_add(&CNT[(DEPTH * 68 + u.pm) * 64], 1u, __ATOMIC_RELAXED, __HIP_MEMORY_SCOPE_AGENT);
                    }
                }
                if (l < DEPTH - 1) {
                    const float* nw1 = args.in[4] + (size_t)(l + 1) * DM; const float* mod1 = MOD + (size_t)(l + 1) * 5 * 6144;
                    int t3 = threadIdx.x; asm volatile("" : "+v"(t3));
                    const int lane3 = t3 & 63, wave3 = __builtin_amdgcn_readfirstlane(t3 >> 6);
                    if (merged) {
                        const int r0 = 68 * bx;
                        if (threadIdx.x == 0) {
                            for (int pm = r0 >> 8; pm <= (r0 + 67) >> 8; ++pm) { unsigned sp = 0;
                                while (__hip_atomic_load(&CNT[(DEPTH * 68 + pm) * 64], __ATOMIC_RELAXED, __HIP_MEMORY_SCOPE_AGENT) < 8u) { __builtin_amdgcn_s_sleep(1); if (++sp > (1u << 22)) break; } }
                            __builtin_amdgcn_fence(__ATOMIC_ACQUIRE, "agent");
                            asm volatile("s_waitcnt vmcnt(0)" ::: "memory");
                        }
                        __syncthreads();
                        for (int row = r0 + wave3; row < r0 + 68; row += 16) { const int rb = row + 8; p1_row2(row, rb < r0 + 68 ? rb : -1, args.out, CTXW, mod1, nw1, H, lane3); }
                    } else {
                        if (args.coop) xcd_barrier(bar);
                        for (int row = bx * 8 + wave3; row < MTOT; row += G * 16) { const int rb = row + G * 8; p1_row2(row, rb < MTOT ? rb : -1, args.out, CTXW, mod1, nw1, H, lane3); }
                    }
                }
            }
        }
        if (ph + 1 < args.ph_hi) { if (args.coop) { if (ph == 0) cg::this_grid().sync(); else xcd_barrier(bar); } }
    }
}

extern "C" void kernel_launch(void* const* d_in, const int* in_sizes, int n_in, void* d_out, int out_size, void* d_ws, size_t ws_size, hipStream_t stream) {
    static int grid = 0;
    if (grid == 0) {
        if (n_in != 29 || in_sizes[0] != MLAT * DM || out_size != MLAT * DM || ws_size < WS_END) {
            fprintf(stderr, "kernel_launch: unexpected shapes: n_in %d in0 %d out %d ws %zu (need %zu)\n", n_in, n_in > 0 ? in_sizes[0] : -1, out_size, ws_size, (size_t)WS_END); grid = -1; return; }
        int dev = 0, cus = 0, per_cu = 0;
        if (hipGetDevice(&dev) != hipSuccess || hipDeviceGetAttribute(&cus, hipDeviceAttributeMultiprocessorCount, dev) != hipSuccess) { grid = -1; return; }
        if (hipFuncSetAttribute((const void*)mega_fwd, hipFuncAttributeMaxDynamicSharedMemorySize, LDS_BYTES) != hipSuccess) { fprintf(stderr, "kernel_launch: hipFuncSetAttribute failed\n"); grid = -1; return; }
        if (hipOccupancyMaxActiveBlocksPerMultiprocessor(&per_cu, (const void*)mega_fwd, 512, LDS_BYTES) != hipSuccess || per_cu < 1) { fprintf(stderr, "kernel_launch: occupancy query gives %d\n", per_cu); per_cu = 1; }
        (void)hipGetLastError();
        grid = cus * 1;
    }
    if (grid < 0) return;
    Args a{};
    for (int i = 0; i < 29; ++i) a.in[i] = (const float*)d_in[i];
    a.out = (float*)d_out; a.ws = (unsigned char*)d_ws;
#if MK_COOP
    if (hipMemsetAsync((char*)d_ws + WS_BAR, 0, 16384 + CNT_BYTES, stream) != hipSuccess) { fprintf(stderr, "kernel_launch: memset of the barrier words failed\n"); return; }
    a.ph_lo = 0; a.ph_hi = NPH; a.coop = 1;
    void* kargs[] = {&a};
    hipError_t e = hipLaunchCooperativeKernel((const void*)mega_fwd, dim3(grid), dim3(512), kargs, LDS_BYTES, stream);
    if (e != hipSuccess) fprintf(stderr, "kernel_launch: cooperative launch failed: %s (grid %d)\n", hipGetErrorString(e), grid);
#else
    for (int ph = 0; ph < NPH; ++ph) {
        a.ph_lo = ph; a.ph_hi = ph + 1; a.coop = 0;
        hipLaunchKernelGGL(mega_fwd, dim3(grid), dim3(512), LDS_BYTES, stream, a);
    }
    const hipError_t le = hipPeekAtLastError();
    if (le != hipSuccess) fprintf(stderr, "kernel_launch: launch failed: %s\n", hipGetErrorName(le));
#endif
}
```

```cpp
#include <hip/hip_runtime.h>
#include <hip/hip_cooperative_groups.h>
#include <cstdio>
#include <cstdint>
namespace cg = cooperative_groups;

#ifndef MK_MASK
#define MK_MASK 127
#endif
#ifndef MK_ATYPE
#define MK_ATYPE 7
#endif
#ifndef MK_G1T
#define MK_G1T 127
#endif
#ifndef ATT_SD_A
#define ATT_SD_A 2
#endif
#ifndef ATT_SD_B
#define ATT_SD_B 1
#endif
#ifndef ATT_SD_C
#define ATT_SD_C 2
#endif
#ifndef ATT_DBL_B
#define ATT_DBL_B true
#endif
#ifndef ATT_DBL
#define ATT_DBL false
#endif
#ifndef QKT_GRP
#define QKT_GRP 0
#endif
#ifndef MK_COOP
#define MK_COOP 1
#endif

#define LAS __attribute__((address_space(3)))
typedef unsigned short bf16_t;
typedef short bf16x8 __attribute__((ext_vector_type(8)));
typedef short s16x4 __attribute__((ext_vector_type(4)));
typedef float f32x4 __attribute__((ext_vector_type(4)));
typedef float f32x16 __attribute__((ext_vector_type(16)));
typedef unsigned u32x4 __attribute__((ext_vector_type(4)));
typedef unsigned u32x2 __attribute__((ext_vector_type(2)));

constexpr int DM = 2048, NBATCH = 4, SEQ = 4096, CTXL = 256, DEPTH = 4;
constexpr int MLAT = NBATCH * SEQ, MCTX = NBATCH * CTXL, MTOT = MLAT + MCTX;
constexpr int INC = 15936, NIN = 16128;
constexpr float EPS = 1e-6f;
#ifndef MK_REP_ST
#define MK_REP_ST -1
#endif
constexpr int PPL = 5;
constexpr int NPH = 2 + 3 * DEPTH;

constexpr size_t alignup(size_t x) { return (x + 255) / 256 * 256; }
constexpr size_t WS_MOD = 0;
constexpr size_t WS_TC64 = WS_MOD + alignup((size_t)DEPTH * 5 * 6144 * 4);
constexpr size_t WS_TS64 = WS_TC64 + 4096, WS_TC128 = WS_TS64 + 4096, WS_TS128 = WS_TC128 + 8192;
constexpr size_t WS_LAM = WS_TS128 + 8192;
constexpr size_t WS_BAR = WS_LAM + 256;
constexpr size_t WS_CNT = WS_BAR + 16384;
constexpr size_t CNT_BYTES = (size_t)(2 * DEPTH * 68 + DEPTH) * 256;
constexpr size_t WS_WIN = WS_CNT + CNT_BYTES;
constexpr size_t WS_WUP = WS_WIN + (size_t)DEPTH * NIN * DM * 2;
constexpr size_t WS_WBR = WS_WUP + (size_t)DEPTH * 2048 * 512 * 2;
constexpr size_t WS_WOUT = WS_WBR + (size_t)DEPTH * 2048 * 3072 * 2;
constexpr size_t WS_H = WS_WOUT + (size_t)DEPTH * 2048 * 2048 * 2;
constexpr size_t WS_QA = WS_H + (size_t)MTOT * 2048 * 2;
constexpr size_t WS_KA = WS_QA + (size_t)MTOT * 1024 * 2;
constexpr size_t WS_VA = WS_KA + (size_t)MTOT * 256 * 2;
constexpr size_t WS_QB = WS_VA + (size_t)MTOT * 256 * 2;
constexpr size_t WS_KB = WS_QB + (size_t)MTOT * 1536 * 2;
constexpr size_t WS_CKV = WS_KB + (size_t)MTOT * 1536 * 2;
constexpr size_t WS_VB = WS_CKV + (size_t)MTOT * 512 * 2;
constexpr size_t WS_QC = WS_VB + (size_t)MTOT * 1024 * 2;
constexpr size_t WS_KC = WS_QC + (size_t)MTOT * 1024 * 2;
constexpr size_t WS_VC = WS_KC + (size_t)MTOT * 1024 * 2;
constexpr size_t WS_GATE = WS_VC + (size_t)MTOT * 1024 * 2;
constexpr size_t WS_MRG = WS_GATE + (size_t)MTOT * 3072 * 2;
constexpr size_t WS_BR = WS_MRG + (size_t)MTOT * 6144 * 2;
constexpr size_t WS_Y = WS_BR + (size_t)MTOT * 3072 * 2;
constexpr size_t WS_SS = WS_Y + (size_t)MTOT * 2048 * 2;
constexpr size_t WS_CTXW = WS_SS + (size_t)MTOT * 8 * 4;
constexpr size_t WS_SCR = WS_CTXW + (size_t)MCTX * DM * 4;
constexpr size_t WS_END = WS_SCR + (size_t)256 * 64 * 512 * 4;

constexpr int RING_BYTES = 131072, XCH_OFF = RING_BYTES, LDS_BYTES = 147456;

__device__ __forceinline__ float bf2f(unsigned h) { return __uint_as_float(h << 16); }
__device__ __forceinline__ unsigned cvt_pk_bf16(float lo, float hi) { unsigned r; asm volatile("v_cvt_pk_bf16_f32 %0, %1, %2" : "=v"(r) : "v"(lo), "v"(hi)); return r; }
__device__ __forceinline__ float wave_sum(float v) {
#pragma unroll
    for (int o = 1; o < 64; o <<= 1) v += __shfl_xor(v, o);
    return v;
}
__device__ __forceinline__ float sigm_f(float x) { return __builtin_amdgcn_rcpf(1.f + __builtin_amdgcn_exp2f(-1.4426950408889634f * x)); }
__device__ __forceinline__ float silu_f(float x) { return x * sigm_f(x); }
__device__ __forceinline__ unsigned cvt_pk_bf16_safe(float lo, float hi) { unsigned r; asm volatile("s_nop 1\n\tv_cvt_pk_bf16_f32 %0, %1, %2" : "=v"(r) : "v"(lo), "v"(hi)); return r; }
__device__ __forceinline__ void store8_safe(bf16_t* p, f32x4 a, f32x4 b) {
    u32x4 w; w.x = cvt_pk_bf16_safe(a[0], a[1]); w.y = cvt_pk_bf16_safe(a[2], a[3]); w.z = cvt_pk_bf16_safe(b[0], b[1]); w.w = cvt_pk_bf16_safe(b[2], b[3]);
    *(u32x4*)p = w;
}
__device__ __forceinline__ void store8(bf16_t* p, f32x4 a, f32x4 b) {
    u32x4 w; w.x = cvt_pk_bf16(a[0], a[1]); w.y = cvt_pk_bf16(a[2], a[3]); w.z = cvt_pk_bf16(b[0], b[1]); w.w = cvt_pk_bf16(b[2], b[3]);
    *(u32x4*)p = w;
}

namespace pg8 {
constexpr int BM = 256, BK = 64, HALF = 128, HTB = HALF * BK * 2, NXCD = 8, WGM = 8;
__host__ __device__ __forceinline__ int lds_byte(int r, int c) { const int st = (r >> 4) * 2 + (c >> 5), rr = r & 15, cc = c & 31, ob = rr * 64 + cc * 2; return st * 1024 + (ob ^ (((ob >> 9) & 1) << 5)); }
__host__ __device__ __forceinline__ void stage_rc(int b, int& R, int& C) { const int st = b / 1024, sb = b % 1024, swz = sb ^ (((sb >> 9) & 1) << 5); R = (st >> 1) * 16 + swz / 64; C = (st & 1) * 32 + (swz % 64) / 2; }
__host__ __device__ __forceinline__ int perm32(int rho) { const int n = rho >> 4, i = rho & 15; return 8 * (i >> 2) + 4 * n + (i & 3); }

struct Unit { int pm, pn; };
struct Gemm { const bf16_t* A; const bf16_t* Bt; int M, N, K; };
struct StaticOrder {
    int nM, nN, nwg, G, c, fixed, fpm, fpn;
    __device__ void init(int M, int N, int G_, int c_) { nM = M / BM; nN = N / BM; nwg = nM * nN; G = G_; c = c_; fixed = 0; fpm = 0; fpn = 0; }
    __device__ void init_one(int pm, int pn) { nM = 1; nN = 1; nwg = 1; G = 1; c = 0; fixed = 1; fpm = pm; fpn = pn; }
    __device__ bool next(int i, Unit& u) const {
        if (fixed) { if (i > 0) return false; u.pm = fpm; u.pn = fpn; return true; }
        const long L = (long)i * G + c; if (L >= nwg) return false;
        int wgid = (int)L; { const int q = nwg / NXCD, r = nwg % NXCD, xcd = wgid % NXCD, off = wgid / NXCD; wgid = (xcd < r ? xcd * (q + 1) : r * (q + 1) + (xcd - r) * q) + off; }
        const int nig = WGM * nN, gid = wgid / nig, fm = gid * WGM, gsz = (nM - fm) < WGM ? (nM - fm) : WGM;
        u.pm = fm + ((wgid % nig) % gsz); u.pn = (wgid % nig) / gsz; return true;
    }
};

template <class Epi>
__device__ __forceinline__ void gemm_phase(LAS unsigned char* lds, const Gemm g, const StaticOrder& S, const Epi& E, const int tid) {
    const int wid = __builtin_amdgcn_readfirstlane(tid >> 6), lane = tid & 63, wr = wid >> 2, wc = wid & 3, fr = lane & 15, fq = lane >> 4;
    const int K = g.K, nt = K / BK;
    unsigned voffA[2], voffB[2];
#pragma unroll
    for (int i = 0; i < 2; ++i) { int R, C; stage_rc(tid * 16 + i * 8192, R, C); const int Rb = (R & ~31) + perm32(R & 31);
        voffA[i] = (unsigned)(R * K + C) * 2u; voffB[i] = (unsigned)(Rb * K + C) * 2u; }
    const size_t kstep = (size_t)(BK * 2);
    const size_t hstep = (size_t)HALF * K * 2;
    const size_t tstep = 2 * hstep;
    const unsigned ldsw = (unsigned)wid * 1024u;
    const int aoff = lds_byte(wr * 64 + fr, fq * 8), boff = lds_byte(wc * 32 + fr, fq * 8);
#define PG8_SA(b, h) (((b) * 2 + (h)) * HTB)
#define PG8_SB(b, h) ((4 + (b) * 2 + (h)) * HTB)
#define PG8_STAGE(bufoff, gbase, voff) do { _Pragma("unroll") for (int _i = 0; _i < 2; ++_i) \
        __builtin_amdgcn_global_load_lds((const unsigned*)((const char*)(gbase) + (voff)[_i]), (LAS unsigned*)(lds + (bufoff) + ldsw + _i * 8192), 16, 0, 0); } while (0)
#define PG8_LDA(dst, b, h) do { _Pragma("unroll") for (int m = 0; m < 4; ++m) _Pragma("unroll") for (int k = 0; k < 2; ++k) dst[m][k] = *(const LAS bf16x8*)(lds + PG8_SA(b, h) + aoff + m * 2048 + k * 1024); } while (0)
#define PG8_LDB(dst, b, h) do { _Pragma("unroll") for (int n = 0; n < 2; ++n) _Pragma("unroll") for (int k = 0; k < 2; ++k) dst[n][k] = *(const LAS bf16x8*)(lds + PG8_SB(b, h) + boff + n * 2048 + k * 1024); } while (0)
#define PG8_MMA(ai, bj, At, Bt) do { __builtin_amdgcn_s_setprio(1); _Pragma("unroll") for (int m = 0; m < 4; ++m) _Pragma("unroll") for (int n = 0; n < 2; ++n) _Pragma("unroll") for (int k = 0; k < 2; ++k) \
        acc[ai][bj][m][n] = __builtin_amdgcn_mfma_f32_16x16x32_bf16(Bt[n][k], At[m][k], acc[ai][bj][m][n], 0, 0, 0); __builtin_amdgcn_s_setprio(0); } while (0)
#define PG8_WAIT_V(n) asm volatile("s_waitcnt vmcnt(" #n ")" ::: "memory")
#define PG8_WAIT_L(n) asm volatile("s_waitcnt lgkmcnt(" #n ")" ::: "memory")
#define PG8_BAR __builtin_amdgcn_s_barrier()
#define PG8_SCHED __builtin_amdgcn_sched_barrier(0)
    Unit cur, nxt; int ui = 0;
    if (!S.next(0, cur)) return;
    f32x4 acc[2][2][4][2];
#pragma unroll
    for (int a = 0; a < 2; ++a)
#pragma unroll
        for (int b = 0; b < 2; ++b)
#pragma unroll
            for (int m = 0; m < 4; ++m)
#pragma unroll
                for (int n = 0; n < 2; ++n) acc[a][b][m][n] = (f32x4){0.f, 0.f, 0.f, 0.f};
    bf16x8 At[4][2], B0[2][2], B1[2][2];
    const char* cA = (const char*)g.A + (size_t)cur.pm * tstep; const char* cB = (const char*)g.Bt + (size_t)cur.pn * tstep;
    PG8_STAGE(PG8_SB(0, 0), cB, voffB); PG8_STAGE(PG8_SB(0, 1), cB + hstep, voffB); PG8_STAGE(PG8_SA(0, 0), cA, voffA); PG8_STAGE(PG8_SA(0, 1), cA + hstep, voffA);
    if (wr == 1) PG8_BAR;
    PG8_WAIT_V(2); PG8_BAR;
    PG8_STAGE(PG8_SB(1, 0), cB + kstep, voffB); PG8_STAGE(PG8_SA(1, 0), cA + kstep, voffA); PG8_STAGE(PG8_SB(1, 1), cB + hstep + kstep, voffB);
    PG8_WAIT_V(6); PG8_BAR;
    for (;;) {
        const bool has_next = S.next(ui + 1, nxt);
        const char* nA = has_next ? (const char*)g.A + (size_t)nxt.pm * tstep : cA; const char* nB = has_next ? (const char*)g.Bt + (size_t)nxt.pn * tstep : cB;
        for (int t = 0; t < nt; t += 2) {
            const bool last = (t == nt - 2);
            const char* a1 = cA + (size_t)(t + 1) * kstep;
            const char* a2 = last ? nA : cA + (size_t)(t + 2) * kstep; const char* b2 = last ? nB : cB + (size_t)(t + 2) * kstep;
            const char* a3 = a2 + kstep; const char* b3 = b2 + kstep;
            if constexpr (Epi::MID) { if (t == 16 || t == 32) { int fr_ = fr, fq_ = fq, wr_ = wr, wc_ = wc;
                asm volatile("" : "+v"(fr_), "+v"(fq_)); asm volatile("" : "+s"(wr_), "+s"(wc_));
                E.mid(acc, cur, t >> 4, wr_, wc_, fr_, fq_); PG8_WAIT_V(0); PG8_SCHED; } }
            PG8_LDB(B0, 0, 0); PG8_LDB(B1, 0, 1); PG8_SCHED; PG8_LDA(At, 0, 0); PG8_STAGE(PG8_SA(1, 1), a1 + hstep, voffA);
            PG8_WAIT_V(8); PG8_WAIT_L(0); PG8_BAR; PG8_MMA(0, 0, At, B0); PG8_MMA(0, 1, At, B1); PG8_BAR; PG8_SCHED;
            PG8_LDA(At, 0, 1); PG8_STAGE(PG8_SB(0, 0), b2, voffB); PG8_STAGE(PG8_SB(0, 1), b2 + hstep, voffB); PG8_STAGE(PG8_SA(0, 0), a2, voffA);
            PG8_WAIT_V(8); PG8_WAIT_L(0); PG8_BAR; PG8_MMA(1, 0, At, B0); PG8_MMA(1, 1, At, B1); PG8_BAR; PG8_SCHED;
            PG8_LDB(B0, 1, 0); PG8_LDB(B1, 1, 1); PG8_SCHED; PG8_LDA(At, 1, 0); PG8_STAGE(PG8_SA(0, 1), a2 + hstep, voffA);
            PG8_WAIT_V(8); PG8_WAIT_L(0); PG8_BAR; PG8_MMA(0, 0, At, B0); PG8_MMA(0, 1, At, B1); PG8_BAR; PG8_SCHED;
            PG8_LDA(At, 1, 1); PG8_STAGE(PG8_SB(1, 0), b3, voffB); PG8_STAGE(PG8_SB(1, 1), b3 + hstep, voffB); PG8_STAGE(PG8_SA(1, 0), a3, voffA);
            PG8_WAIT_V(8); PG8_WAIT_L(0); PG8_BAR; PG8_MMA(1, 0, At, B0); PG8_MMA(1, 1, At, B1); PG8_BAR; PG8_SCHED;
        }
        if (wr == 0) PG8_BAR;
        { int fr_ = fr, fq_ = fq, wr_ = wr, wc_ = wc, wid_ = wid;
          asm volatile("" : "+v"(fr_), "+v"(fq_)); asm volatile("" : "+s"(wr_), "+s"(wc_), "+s"(wid_));
          E(acc, cur, wr_, wc_, fr_, fq_, wid_); }
        if (!has_next) break;
#pragma unroll
        for (int a = 0; a < 2; ++a)
#pragma unroll
            for (int b = 0; b < 2; ++b)
#pragma unroll
                for (int m = 0; m < 4; ++m)
#pragma unroll
                    for (int n = 0; n < 2; ++n) acc[a][b][m][n] = (f32x4){0.f, 0.f, 0.f, 0.f};
        cur = nxt; cA = nA; cB = nB; ++ui;
        if (wr == 1) PG8_BAR;
    }
    PG8_WAIT_V(0);
    PG8_BAR;
#undef PG8_SA
#undef PG8_SB
#undef PG8_STAGE
#undef PG8_LDA
#undef PG8_LDB
#undef PG8_MMA
#undef PG8_WAIT_V
#undef PG8_WAIT_L
#undef PG8_BAR
#undef PG8_SCHED
}
}
using pg8::Unit;

__device__ __forceinline__ int in_src_col(int n) {
    const int tile = n >> 8, s = n & 255, bj = s >> 7, wc = (s >> 5) & 3, c = s & 31;
    const int d128 = 64 * (wc & 1) + 32 * bj + c, g128 = wc >> 1;
    const int d64 = 32 * (c >> 4) + 16 * bj + (c & 15), g64 = wc;
    if (tile < 4) return (tile * 2 + g128) * 128 + d128;
    if (tile == 4) return 1024 + g128 * 128 + d128;
    if (tile == 5) return 1280 + s;
    if (tile < 10) return 1536 + ((tile - 6) * 2 + g128) * 192 + d128;
    if (tile < 12) return 1536 + ((tile - 10) * 4 + g64) * 192 + 128 + d64;
    if (tile < 14) return 3072 + (tile - 12) * 256 + s;
    if (tile == 14) return g64 == 0 ? 3584 + d64 : -1;
    if (tile < 19) return 3648 + ((tile - 15) * 4 + g64) * 64 + d64;
    if (tile < 23) return 4672 + ((tile - 19) * 4 + g64) * 64 + d64;
    if (tile < 27) return 5696 + (tile - 23) * 256 + s;
    if (tile < 39) return 6720 + (tile - 27) * 256 + s;
    return 9792 + (tile - 39) * 256 + s;
}
__device__ __forceinline__ int up_src_col(int n) {
    if (n >= 1024) return n;
    const int tile = n >> 8, s = n & 255, bj = s >> 7, wc = (s >> 5) & 3, c = s & 31;
    return (tile * 2 + (wc >> 1)) * 128 + 64 * (wc & 1) + 32 * bj + c;
}

template <int GS>
__device__ __forceinline__ void norm_rope_store(const f32x4 (&acc)[2][2][4][2], int pm, int wr, int wc, int fr, int fq, int wid,
                                                const float* __restrict__ w, const float* __restrict__ tcos, const float* __restrict__ tsin, bool rope,
                                                const float (&pre)[2][4], bf16_t* __restrict__ dst, int ld, int gbase, int ncopies, int copystride, LAS float* xch) {
    const int dbase = (GS == 128) ? 64 * (wc & 1) + 8 * fq : 32 * (fq >> 1) + 8 * (fq & 1);
    const int bjs = (GS == 128) ? 32 : 16;
    const int axis = (GS == 128) ? (wc & 1) : (fq >> 1);
    const int i0 = (GS == 128) ? 8 * fq : 8 * (fq & 1);
    constexpr int NF = (GS == 128) ? 32 : 16;
    const int wavebase = gbase + ((GS == 128) ? 64 * (wc & 1) : 0) + 8 * fq;
    float ssq[2][4];
#pragma unroll
    for (int ai = 0; ai < 2; ++ai)
#pragma unroll
        for (int m = 0; m < 4; ++m) {
            float s = 0.f;
#pragma unroll
            for (int bj = 0; bj < 2; ++bj)
#pragma unroll
                for (int n = 0; n < 2; ++n)
#pragma unroll
                    for (int j = 0; j < 4; ++j) { const float v = acc[ai][bj][m][n][j] * pre[ai][m]; s += v * v; }
            s += __shfl_xor(s, 16); s += __shfl_xor(s, 32);
            ssq[ai][m] = s;
        }
    if constexpr (GS == 128) {
        if (fq == 0) {
#pragma unroll
            for (int ai = 0; ai < 2; ++ai)
#pragma unroll
                for (int m = 0; m < 4; ++m) xch[wid * 128 + ai * 64 + m * 16 + fr] = ssq[ai][m];
        }
        asm volatile("s_waitcnt lgkmcnt(0)" ::: "memory"); __builtin_amdgcn_s_barrier();
#pragma unroll
        for (int ai = 0; ai < 2; ++ai)
#pragma unroll
            for (int m = 0; m < 4; ++m) ssq[ai][m] += xch[(wid ^ 1) * 128 + ai * 64 + m * 16 + fr];
    }
#pragma unroll
    for (int ai = 0; ai < 2; ++ai)
#pragma unroll
        for (int m = 0; m < 4; ++m) {
            const int rl = ai * 128 + wr * 64 + m * 16 + fr;
            const size_t row = (size_t)pm * 256 + rl;
            const float rinv = rsqrtf(ssq[ai][m] * (1.f / GS) + EPS) * pre[ai][m];
            const int t = (pm & 15) * 256 + rl; const int pos = axis ? (t & 63) : (t >> 6);
            u32x4 k0, k1;
#pragma unroll
            for (int n = 0; n < 2; ++n) {
                const f32x4 w0 = *(const f32x4*)(w + dbase + 4 * n), w1 = *(const f32x4*)(w + dbase + bjs + 4 * n);
                f32x4 y0 = acc[ai][0][m][n] * rinv * w0, y1 = acc[ai][1][m][n] * rinv * w1;
                if (rope) {
                    const f32x4 c = *(const f32x4*)(tcos + pos * NF + i0 + 4 * n), sn = *(const f32x4*)(tsin + pos * NF + i0 + 4 * n);
                    const f32x4 o0 = y0 * c - y1 * sn, o1 = y1 * c + y0 * sn;
                    y0 = o0; y1 = o1;
                }
                if (n == 0) { k0.x = cvt_pk_bf16(y0[0], y0[1]); k0.y = cvt_pk_bf16(y0[2], y0[3]); k1.x = cvt_pk_bf16(y1[0], y1[1]); k1.y = cvt_pk_bf16(y1[2], y1[3]); }
                else { k0.z = cvt_pk_bf16(y0[0], y0[1]); k0.w = cvt_pk_bf16(y0[2], y0[3]); k1.z = cvt_pk_bf16(y1[0], y1[1]); k1.w = cvt_pk_bf16(y1[2], y1[3]); }
            }
            bf16_t* p = dst + row * ld + wavebase;
            for (int cp = 0; cp < ncopies; ++cp) { *(u32x4*)(p + cp * copystride) = k0; *(u32x4*)(p + cp * copystride + 32) = k1; }
            __builtin_amdgcn_sched_barrier(0);
        }
}

struct EpiIn {
    static constexpr bool MID = false;
    bf16_t *QA, *KA, *VA, *QB, *KB, *CKV, *QC, *KC, *VC, *GATE, *MRG; float* SS;
    const float *wAq, *wAk, *wBqn, *wBqr, *wBkr, *wCq, *wCk, *bmerge;
    const float *tc64, *ts64, *tc128, *ts128;
    LAS float* xch;
    template <int ACT>
    __device__ __forceinline__ void plain(const f32x4 (&acc)[2][2][4][2], int pm, int wr, int wc, int fr, int fq, bf16_t* dst, int ld, int col0) const {
        const int colw = col0 + 32 * wc + 8 * fq;
        f32x4 b[2][2];
#pragma unroll
        for (int bj = 0; bj < 2; ++bj)
#pragma unroll
            for (int n = 0; n < 2; ++n) b[bj][n] = (ACT == 2) ? *(const f32x4*)(bmerge + colw + bj * 128 + 4 * n) : (f32x4){0.f, 0.f, 0.f, 0.f};
#pragma unroll
        for (int ai = 0; ai < 2; ++ai)
#pragma unroll
            for (int m = 0; m < 4; ++m) {
                const size_t row = (size_t)pm * 256 + ai * 128 + wr * 64 + m * 16 + fr;
#pragma unroll
                for (int bj = 0; bj < 2; ++bj) {
                    f32x4 v0 = acc[ai][bj][m][0], v1 = acc[ai][bj][m][1];
                    if (ACT == 1) { for (int j = 0; j < 4; ++j) { v0[j] = silu_f(v0[j]); v1[j] = silu_f(v1[j]); } }
                    if (ACT == 2) { v0 = v0 + b[bj][0]; v1 = v1 + b[bj][1]; for (int j = 0; j < 4; ++j) { v0[j] = sigm_f(v0[j]); v1[j] = sigm_f(v1[j]); } }
                    if (ACT == 0) store8(dst + row * ld + colw + bj * 128, v0, v1); else store8_safe(dst + row * ld + colw + bj * 128, v0, v1);
                }
                __builtin_amdgcn_sched_barrier(0);
            }
    }
    __device__ __forceinline__ void operator()(const f32x4 (&acc)[2][2][4][2], const Unit& u, int wr, int wc, int fr, int fq, int wid) const {
        const int t = u.pn, pm = u.pm; const bool rope = pm < 64;
        const float one[2][4] = {{1.f, 1.f, 1.f, 1.f}, {1.f, 1.f, 1.f, 1.f}};
        if (t < 4 && (MK_G1T & 1)) norm_rope_store<128>(acc, pm, wr, wc, fr, fq, wid, wAq, tc128, ts128, rope, one, QA, 1024, (t * 2 + (wc >> 1)) * 128, 1, 0, xch);
        else if (t == 4 && (MK_G1T & 1)) norm_rope_store<128>(acc, pm, wr, wc, fr, fq, wid, wAk, tc128, ts128, rope, one, KA, 256, (wc >> 1) * 128, 1, 0, xch);
        else if (t == 5 && (MK_G1T & 2)) plain<0>(acc, pm, wr, wc, fr, fq, VA, 256, 0);
        else if (t < 10 && (MK_G1T & 1)) norm_rope_store<128>(acc, pm, wr, wc, fr, fq, wid, wBqn, tc128, ts128, false, one, QB, 1536, ((t - 6) * 2 + (wc >> 1)) * 192, 1, 0, xch);
        else if (t < 12 && (MK_G1T & 4)) norm_rope_store<64>(acc, pm, wr, wc, fr, fq, wid, wBqr, tc64, ts64, rope, one, QB, 1536, ((t - 10) * 4 + wc) * 192 + 128, 1, 0, xch);
        else if (t < 14 && (MK_G1T & 8)) {
            plain<0>(acc, pm, wr, wc, fr, fq, CKV, 512, (t - 12) * 256);
#pragma unroll
            for (int ai = 0; ai < 2; ++ai)
#pragma unroll
                for (int m = 0; m < 4; ++m) {
                    float s = 0.f;
#pragma unroll
                    for (int bj = 0; bj < 2; ++bj)
#pragma unroll
                        for (int n = 0; n < 2; ++n)
#pragma unroll
                            for (int j = 0; j < 4; ++j) { const float v = acc[ai][bj][m][n][j]; s += v * v; }
                    s += __shfl_xor(s, 16); s += __shfl_xor(s, 32);
                    if (fq == 0) SS[((size_t)pm * 256 + ai * 128 + wr * 64 + m * 16 + fr) * 8 + (t - 12) * 4 + wc] = s;
                }
        }
        else if (t == 14 && (MK_G1T & 16)) { if (wc == 0) norm_rope_store<64>(acc, pm, wr, wc, fr, fq, wid, wBkr, tc64, ts64, rope, one, KB, 1536, 128, 8, 192, xch); }
        else if (t < 19 && (MK_G1T & 4)) norm_rope_store<64>(acc, pm, wr, wc, fr, fq, wid, wCq, tc64, ts64, rope, one, QC, 1024, ((t - 15) * 4 + wc) * 64, 1, 0, xch);
        else if (t < 23 && (MK_G1T & 4)) norm_rope_store<64>(acc, pm, wr, wc, fr, fq, wid, wCk, tc64, ts64, rope, one, KC, 1024, ((t - 19) * 4 + wc) * 64, 1, 0, xch);
        else if (t < 27 && (MK_G1T & 2)) plain<0>(acc, pm, wr, wc, fr, fq, VC, 1024, (t - 23) * 256);
        else if (t < 39 && (MK_G1T & 32)) plain<1>(acc, pm, wr, wc, fr, fq, GATE, 3072, (t - 27) * 256);
        else if (MK_G1T & 64) plain<2>(acc, pm, wr, wc, fr, fq, MRG, 6144, (t - 39) * 256);
    }
};

struct EpiUp {
    static constexpr bool MID = false;
    bf16_t *KB, *VB; const float* SS; const float* wBkn; LAS float* xch;
    __device__ __forceinline__ void operator()(const f32x4 (&acc)[2][2][4][2], const Unit& u, int wr, int wc, int fr, int fq, int wid) const {
        const int t = u.pn, pm = u.pm;
        float pre[2][4];
#pragma unroll
        for (int ai = 0; ai < 2; ++ai)
#pragma unroll
            for (int m = 0; m < 4; ++m) {
                const size_t row = (size_t)pm * 256 + ai * 128 + wr * 64 + m * 16 + fr;
                const f32x4 a = *(const f32x4*)(SS + row * 8), b = *(const f32x4*)(SS + row * 8 + 4);
                pre[ai][m] = rsqrtf(((a[0] + a[1]) + (a[2] + a[3]) + (b[0] + b[1]) + (b[2] + b[3])) * (1.f / 512.f) + EPS);
                __builtin_amdgcn_sched_barrier(0);
            }
        if (t < 4) norm_rope_store<128>(acc, pm, wr, wc, fr, fq, wid, wBkn, nullptr, nullptr, false, pre, KB, 1536, (t * 2 + (wc >> 1)) * 192, 1, 0, xch);
        else {
            const int colw = (t - 4) * 256 + 32 * wc + 8 * fq;
#pragma unroll
            for (int ai = 0; ai < 2; ++ai)
#pragma unroll
                for (int m = 0; m < 4; ++m) {
                    const size_t row = (size_t)pm * 256 + ai * 128 + wr * 64 + m * 16 + fr;
#pragma unroll
                    for (int bj = 0; bj < 2; ++bj) store8(VB + row * 1024 + colw + bj * 128, acc[ai][bj][m][0] * pre[ai][m], acc[ai][bj][m][1] * pre[ai][m]);
                    __builtin_amdgcn_sched_barrier(0);
                }
        }
    }
};

struct EpiBr {
    static constexpr bool MID = true;
    const bf16_t* MRG; bf16_t* Y;
    __device__ __forceinline__ void mid(f32x4 (&acc)[2][2][4][2], const Unit& u, int i, int wr, int wc, int fr, int fq) const {
#pragma unroll
        for (int ai = 0; ai < 2; ++ai)
#pragma unroll
            for (int m = 0; m < 4; ++m) {
                const size_t row = (size_t)u.pm * 256 + ai * 128 + wr * 64 + m * 16 + fr;
#pragma unroll
                for (int bj = 0; bj < 2; ++bj) {
                    const int col = u.pn * 256 + bj * 128 + 32 * wc + 8 * fq;
                    const u32x4 a = *(const u32x4*)(MRG + row * 6144 + (i - 1) * 2048 + col), b = *(const u32x4*)(MRG + row * 6144 + i * 2048 + col);
#pragma unroll
                    for (int q = 0; q < 4; ++q) {
                        const float r0 = bf2f(a[q] & 0xffffu) * __builtin_amdgcn_rcpf(bf2f(b[q] & 0xffffu)), r1 = bf2f(a[q] >> 16) * __builtin_amdgcn_rcpf(bf2f(b[q] >> 16));
                        acc[ai][bj][m][q >> 1][(q & 1) * 2] *= r0; acc[ai][bj][m][q >> 1][(q & 1) * 2 + 1] *= r1;
                    }
                }
                __builtin_amdgcn_sched_barrier(0);
            }
    }
    __device__ __forceinline__ void operator()(const f32x4 (&acc)[2][2][4][2], const Unit& u, int wr, int wc, int fr, int fq, int wid) const {
#pragma unroll
        for (int ai = 0; ai < 2; ++ai)
#pragma unroll
            for (int m = 0; m < 4; ++m) {
                const size_t row = (size_t)u.pm * 256 + ai * 128 + wr * 64 + m * 16 + fr;
#pragma unroll
                for (int bj = 0; bj < 2; ++bj) {
                    const int col = u.pn * 256 + bj * 128 + 32 * wc + 8 * fq;
                    const u32x4 a = *(const u32x4*)(MRG + row * 6144 + 4096 + col);
                    f32x4 v0 = acc[ai][bj][m][0], v1 = acc[ai][bj][m][1];
                    v0[0] *= bf2f(a[0] & 0xffffu); v0[1] *= bf2f(a[0] >> 16); v0[2] *= bf2f(a[1] & 0xffffu); v0[3] *= bf2f(a[1] >> 16);
                    v1[0] *= bf2f(a[2] & 0xffffu); v1[1] *= bf2f(a[2] >> 16); v1[2] *= bf2f(a[3] & 0xffffu); v1[3] *= bf2f(a[3] >> 16);
                    store8(Y + row * 2048 + col, v0, v1);
                }
                __builtin_amdgcn_sched_barrier(0);
            }
    }
};

struct EpiOut {
    static constexpr bool MID = false;
    const float *xsrc, *csrc; float *xdst, *cdst; const float* mod;
    __device__ __forceinline__ void operator()(const f32x4 (&acc)[2][2][4][2], const Unit& u, int wr, int wc, int fr, int fq, int wid) const {
        const int pm = u.pm; const bool lat = pm < 64;
        const int mi = lat ? (pm >> 4) : 4;
        const float* src = lat ? xsrc : csrc - (size_t)MLAT * DM; float* dst = lat ? xdst : cdst - (size_t)MLAT * DM;
        const float* g = mod + mi * 6144 + 4096;
#pragma unroll
        for (int bj = 0; bj < 2; ++bj) {
            const int col = u.pn * 256 + bj * 128 + 32 * wc + 8 * fq;
            const f32x4 g0 = *(const f32x4*)(g + col), g1 = *(const f32x4*)(g + col + 4);
#pragma unroll
            for (int ai = 0; ai < 2; ++ai)
#pragma unroll
                for (int m = 0; m < 4; ++m) {
                    const size_t row = (size_t)pm * 256 + ai * 128 + wr * 64 + m * 16 + fr;
                    const f32x4 x0 = *(const f32x4*)(src + row * DM + col), x1 = *(const f32x4*)(src + row * DM + col + 4);
                    *(f32x4*)(dst + row * DM + col) = x0 + g0 * acc[ai][bj][m][0];
                    *(f32x4*)(dst + row * DM + col + 4) = x1 + g1 * acc[ai][bj][m][1];
                    __builtin_amdgcn_sched_barrier(0);
                }
        }
    }
};

namespace att {
#define SBAR() __builtin_amdgcn_sched_barrier(0)
__device__ __forceinline__ int crow(int r, int hi) { return (r & 3) + 8 * (r >> 2) + 4 * hi; }
template <int RB> __device__ __forceinline__ int kswz(int row, int colB) { const int x = (RB == 256) ? (row & 7) : ((row >> 1) & 7); return row * RB + (colB ^ (x << 4)); }
__device__ __forceinline__ int v_st(int k, int c) { const int kk = (k & ~0xC) | ((k & 4) << 1) | ((k & 8) >> 1); return ((kk >> 3) * 4 + (c >> 5)) * 512 + ((kk & 7) * 32 + (c & 31)) * 2; }
__device__ __forceinline__ int v_rd_base(int lane) { return ((lane & 3) << 3) | (((lane >> 2) & 3) << 6) | (((lane >> 4) & 1) << 5) | (((lane >> 5) & 1) << 8); }
constexpr int v_rd_off(int d0, int ks, int half) { return d0 * 512 + ks * 4096 + half * 2048; }
template <int OFF> __device__ __forceinline__ s16x4 tr_read(unsigned vb) {
    s16x4 r; asm volatile("ds_read_b64_tr_b16 %0, %1 offset:%2" : "=&v"(r) : "v"(vb), "i"(OFF) : "memory"); return r;
}
template <int D0> __device__ __forceinline__ void pv_one(f32x16& od, unsigned vb, bf16x8 pa0, bf16x8 pa1, bf16x8 pa2, bf16x8 pa3) {
    const s16x4 l0 = tr_read<v_rd_off(D0, 0, 0)>(vb), h0 = tr_read<v_rd_off(D0, 0, 1)>(vb), l1 = tr_read<v_rd_off(D0, 1, 0)>(vb), h1 = tr_read<v_rd_off(D0, 1, 1)>(vb);
    const s16x4 l2 = tr_read<v_rd_off(D0, 2, 0)>(vb), h2 = tr_read<v_rd_off(D0, 2, 1)>(vb), l3 = tr_read<v_rd_off(D0, 3, 0)>(vb), h3 = tr_read<v_rd_off(D0, 3, 1)>(vb);
    asm volatile("s_waitcnt lgkmcnt(0)" ::: "memory"); SBAR();
#define PK(L, H) (bf16x8){L[0], L[1], L[2], L[3], H[0], H[1], H[2], H[3]}
    od = __builtin_amdgcn_mfma_f32_32x32x16_bf16(pa0, PK(l0, h0), od, 0, 0, 0);
    od = __builtin_amdgcn_mfma_f32_32x32x16_bf16(pa1, PK(l1, h1), od, 0, 0, 0);
    od = __builtin_amdgcn_mfma_f32_32x32x16_bf16(pa2, PK(l2, h2), od, 0, 0, 0);
    od = __builtin_amdgcn_mfma_f32_32x32x16_bf16(pa3, PK(l3, h3), od, 0, 0, 0);
#undef PK
}
__device__ __forceinline__ void pv_d0(f32x16 (&o)[4], unsigned vb, bf16x8 pa0, bf16x8 pa1, bf16x8 pa2, bf16x8 pa3) {
    pv_one<0>(o[0], vb, pa0, pa1, pa2, pa3); pv_one<1>(o[1], vb, pa0, pa1, pa2, pa3); pv_one<2>(o[2], vb, pa0, pa1, pa2, pa3); pv_one<3>(o[3], vb, pa0, pa1, pa2, pa3);
}
__device__ __forceinline__ void partialSM(f32x16& p0, f32x16& p1, float C, float nMB) {
#pragma unroll
    for (int r = 0; r < 16; ++r) p0[r] = fmaf(p0[r], C, nMB);
#pragma unroll
    for (int r = 0; r < 16; ++r) p1[r] = fmaf(p1[r], C, nMB);
#pragma unroll
    for (int r = 0; r < 16; ++r) p0[r] = __builtin_amdgcn_exp2f(p0[r]);
}
__device__ __forceinline__ void finishSM(f32x16& p0, f32x16& p1, float& l_reg, bf16x8& pa0, bf16x8& pa1, bf16x8& pa2, bf16x8& pa3) {
#pragma unroll
    for (int r = 0; r < 16; ++r) p1[r] = __builtin_amdgcn_exp2f(p1[r]);
    float ps = 0;
#pragma unroll
    for (int r = 0; r < 16; ++r) ps += p0[r];
#pragma unroll
    for (int r = 0; r < 16; ++r) ps += p1[r];
    { auto rr = __builtin_amdgcn_permlane32_swap(__float_as_uint(ps), __float_as_uint(ps), false, false);
      ps = __uint_as_float(rr[0]) + __uint_as_float(rr[1]); }
    l_reg += ps;
#define PK4(P, BASE, OUT) do { unsigned a0 = cvt_pk_bf16(P[BASE + 0], P[BASE + 1]), a1 = cvt_pk_bf16(P[BASE + 2], P[BASE + 3]);   \
    unsigned b0 = cvt_pk_bf16(P[BASE + 4], P[BASE + 5]), b1 = cvt_pk_bf16(P[BASE + 6], P[BASE + 7]);                              \
    auto r0 = __builtin_amdgcn_permlane32_swap(a0, b0, false, false); auto r1 = __builtin_amdgcn_permlane32_swap(a1, b1, false, false); \
    u32x4 w = {r0[0], r1[0], r0[1], r1[1]}; OUT = *reinterpret_cast<bf16x8*>(&w); } while (0)
    PK4(p0, 0, pa0); PK4(p0, 8, pa1); PK4(p1, 0, pa2); PK4(p1, 8, pa3);
#undef PK4
}
template <int DQK>
__device__ __forceinline__ void qkt(f32x16& p0, f32x16& p1, const LAS char* Ks, const bf16x8 (&qr)[DQK / 16], int r32, int hi) {
    constexpr int RB = DQK * 2;
    p0 = f32x16{}; p1 = f32x16{};
#pragma unroll
    for (int d0 = 0; d0 < DQK / 16; ++d0) { const int cb = (d0 * 16 + hi * 8) * 2;
        const bf16x8 b0 = *(const LAS bf16x8*)(Ks + kswz<RB>(r32, cb));
        const bf16x8 b1 = *(const LAS bf16x8*)(Ks + kswz<RB>(32 + r32, cb));
        p0 = __builtin_amdgcn_mfma_f32_32x32x16_bf16(b0, qr[d0], p0, 0, 0, 0);
        p1 = __builtin_amdgcn_mfma_f32_32x32x16_bf16(b1, qr[d0], p1, 0, 0, 0);
        if (QKT_GRP > 0 && (d0 % QKT_GRP) == QKT_GRP - 1 && d0 + 1 < DQK / 16) SBAR(); }
}
constexpr int V_BYTES = 64 * 128 * 2, K_OFF = 3 * V_BYTES, K_STRIDE = 64 * 192 * 2, LI_OFF = K_OFF + 3 * K_STRIDE;

template <int DQK, bool DOUBLE>
__device__ __forceinline__ void attn_pass(const bf16_t* __restrict__ Q, int ldq, const bf16_t* __restrict__ Kg, int ldk, const bf16_t* __restrict__ Vg, int ldv,
                                          int rowc, int rowl, int NT, float C, float nMB, f32x16 (&o)[4], float& l_reg, LAS char* lds, int tid) {
    constexpr int RB = DQK * 2, NCH = DQK / 8, NLD = NCH / 8;
    const int wid = __builtin_amdgcn_readfirstlane(tid >> 6), lane = tid & 63, r32 = lane & 31, hi = lane >> 5;
    LAS char* V_lds = lds; LAS char* K_lds = lds + K_OFF;
    bf16x8 qr[DQK / 16];
    { const bf16_t* Qw = Q + (size_t)(wid * 32 + r32) * ldq + hi * 8;
#pragma unroll
      for (int d0 = 0; d0 < DQK / 16; ++d0) qr[d0] = *(const bf16x8*)(Qw + d0 * 16); }
#pragma unroll
    for (int d = 0; d < 4; ++d) o[d] = f32x16{};
    l_reg = 0.f;
    int vrow[2], vcol[2], krow[NLD], kcol[NLD];
#pragma unroll
    for (int i = 0; i < 2; ++i) { const int q = tid + 512 * i, sub = q >> 5, within = q & 31, kk = (sub >> 2) * 8 + (within >> 2);
        vrow[i] = (kk & ~0xC) | ((kk & 4) << 1) | ((kk & 8) >> 1); vcol[i] = (sub & 3) * 32 + (within & 3) * 8; }
#pragma unroll
    for (int i = 0; i < NLD; ++i) { const int q = tid + 512 * i, row = q / NCH, chp = q % NCH; const int x = (RB == 256) ? (row & 7) : ((row >> 1) & 7);
        krow[i] = row; kcol[i] = (chp ^ x) * 8; }
    const unsigned vb0 = (unsigned)(uintptr_t)V_lds + v_rd_base(lane);
#define KROW0(j) ((j) < 4 ? rowc + 64 * (j) : rowl + 64 * ((j) - 4))
#define DMA(j, b) do { const size_t _r0 = (size_t)KROW0(j); \
    _Pragma("unroll") for (int _i = 0; _i < 2; ++_i) __builtin_amdgcn_global_load_lds((const unsigned*)(Vg + (_r0 + vrow[_i]) * ldv + vcol[_i]), (LAS unsigned*)(V_lds + (b) * V_BYTES + wid * 1024 + _i * 8192), 16, 0, 0); \
    _Pragma("unroll") for (int _i = 0; _i < NLD; ++_i) __builtin_amdgcn_global_load_lds((const unsigned*)(Kg + (_r0 + krow[_i]) * ldk + kcol[_i]), (LAS unsigned*)(K_lds + (b) * K_STRIDE + wid * 1024 + _i * 8192), 16, 0, 0); } while (0)
#define VMW0() asm volatile("s_waitcnt vmcnt(0)" ::: "memory")
    bf16x8 pa0, pa1, pa2, pa3;
    __syncthreads();
    DMA(0, 0); DMA(1, 1); VMW0(); __syncthreads();
    if constexpr (!DOUBLE) {
        f32x16 p0, p1;
        DMA(2, 2);
        int bc = 0, bn = 1, bf = 2;
        for (int j = 0; j < NT; ++j) {
            SBAR(); qkt<DQK>(p0, p1, K_lds + bc * K_STRIDE, qr, r32, hi);
            partialSM(p0, p1, C, nMB); finishSM(p0, p1, l_reg, pa0, pa1, pa2, pa3); SBAR();
            pv_d0(o, vb0 + bc * V_BYTES, pa0, pa1, pa2, pa3);
            if (j + 1 < NT) { VMW0(); __syncthreads(); if (j + 3 < NT) DMA(j + 3, bc); }
            { const int _t = bc; bc = bn; bn = bf; bf = _t; }
        }
    } else {
    f32x16 pA0, pA1, pB0, pB1;
    qkt<DQK>(pA0, pA1, K_lds, qr, r32, hi); partialSM(pA0, pA1, C, nMB);
    DMA(2, 2);
    int bp = 0, bc = 1, bn = 2;
#define STEP(j, PC0, PC1, PP0, PP1) do { \
        SBAR(); qkt<DQK>(PC0, PC1, K_lds + bc * K_STRIDE, qr, r32, hi); \
        finishSM(PP0, PP1, l_reg, pa0, pa1, pa2, pa3); SBAR(); \
        pv_d0(o, vb0 + bp * V_BYTES, pa0, pa1, pa2, pa3); partialSM(PC0, PC1, C, nMB); \
        if ((j) + 1 < NT) { VMW0(); __syncthreads(); if ((j) + 2 < NT) DMA((j) + 2, bp); } \
        { const int _t = bp; bp = bc; bc = bn; bn = _t; } } while (0)
    for (int j = 1; j < NT; j += 2) {
        STEP(j, pB0, pB1, pA0, pA1);
        if (j + 1 < NT) STEP(j + 1, pA0, pA1, pB0, pB1);
    }
    finishSM(pB0, pB1, l_reg, pa0, pa1, pa2, pa3); SBAR();
    pv_d0(o, vb0 + bp * V_BYTES, pa0, pa1, pa2, pa3);
    }
#undef KROW0
#undef DMA
#undef VMW0
#undef STEP
}
__device__ __forceinline__ void row_recip(float l_reg, float (&rli)[16], LAS float* li, int r32, int hi) {
    if (hi == 0) li[r32] = l_reg;
    asm volatile("s_waitcnt lgkmcnt(0)" ::: "memory");
#pragma unroll
    for (int r = 0; r < 16; ++r) rli[r] = __builtin_amdgcn_rcpf(li[crow(r, hi)]);
    asm volatile("s_waitcnt lgkmcnt(0)" ::: "memory");
}
}

struct AttnBufs { const bf16_t *QA, *KA, *VA, *QB, *KB, *VB, *QC, *KC, *VC, *GATE; bf16_t* BR; float* SCR; const float* lamv; const float* subln; float lam_init; };

template <bool SUBLN>
__device__ __forceinline__ void attn_out(const AttnBufs& T, f32x16 (&o)[4], int type, int h, size_t orow0, LAS char* lds, int wid, int lane, int r32, int hi) {
    __syncthreads();
    LAS float* stg = (LAS float*)(lds + wid * 16896);
#pragma unroll
    for (int d0 = 0; d0 < 4; ++d0)
#pragma unroll
        for (int r = 0; r < 16; ++r) stg[att::crow(r, hi) * 132 + d0 * 32 + r32] = o[d0][r];
    asm volatile("s_waitcnt lgkmcnt(0)" ::: "memory");
    const int rr = lane >> 5, c4 = (lane & 31) * 4;
    const int col = type * 1024 + h * 128 + c4;
    f32x4 wsub = {1.f, 1.f, 1.f, 1.f};
    if (SUBLN) { wsub = *(const f32x4*)(T.subln + c4) * (1.f - T.lam_init); }
    const bf16_t* gp = T.GATE + (orow0 + rr) * 3072 + col; bf16_t* op = T.BR + (orow0 + rr) * 3072 + col;
#pragma unroll 4
    for (int i = 0; i < 16; ++i) {
        f32x4 v = *(const LAS f32x4*)(stg + (2 * i + rr) * 132 + c4);
        const u32x2 gg = *(const u32x2*)(gp + (size_t)i * 2 * 3072);
        if (SUBLN) {
            float s = (v[0] * v[0] + v[1] * v[1]) + (v[2] * v[2] + v[3] * v[3]);
            s += __shfl_xor(s, 1); s += __shfl_xor(s, 2); s += __shfl_xor(s, 4); s += __shfl_xor(s, 8); s += __shfl_xor(s, 16);
            v = v * (rsqrtf(s * (1.f / 128.f) + EPS)) * wsub;
        }
        u32x2 w; w.x = cvt_pk_bf16(v[0] * bf2f(gg.x & 0xffffu), v[1] * bf2f(gg.x >> 16)); w.y = cvt_pk_bf16(v[2] * bf2f(gg.y & 0xffffu), v[3] * bf2f(gg.y >> 16));
        *(u32x2*)(op + (size_t)i * 2 * 3072) = w;
    }
}

__device__ __forceinline__ void attn_item(const AttnBufs& T, int type, int b, int h, int qrow0, int NT, LAS char* lds, int tid_) {
    asm volatile("" : "+v"(tid_));
    const int tid = tid_, wid = __builtin_amdgcn_readfirstlane(tid >> 6), lane = tid & 63, r32 = lane & 31, hi = lane >> 5;
    const int rowc = MLAT + b * CTXL, rowl = b * SEQ;
    LAS float* li = (LAS float*)(lds + att::LI_OFF) + wid * 64;
    constexpr float LOG2E = 1.4426950408889634f;
    const size_t orow0 = (size_t)qrow0 + wid * 32;
    if (type == 0 && (MK_ATYPE & 1)) {
        f32x16 o[4]; float l_reg; float rli[16];
        att::attn_pass<128, ATT_DBL>(T.QA + (size_t)qrow0 * 1024 + h * 128, 1024, T.KA + (h >> 2) * 128, 256, T.VA + (h >> 2) * 128, 256, rowc, rowl, NT,
                            0.08838834764831845f * LOG2E, T.lamv[1], o, l_reg, lds, tid);
        att::row_recip(l_reg, rli, li, r32, hi);
#pragma unroll
        for (int d0 = 0; d0 < 4; ++d0)
#pragma unroll
            for (int r = 0; r < 16; ++r) o[d0][r] *= rli[r];
        attn_out<false>(T, o, 0, h, orow0, lds, wid, lane, r32, hi);
    } else if (type == 1 && (MK_ATYPE & 2)) {
        f32x16 o[4]; float l_reg; float rli[16];
        att::attn_pass<192, false>(T.QB + (size_t)qrow0 * 1536 + h * 192, 1536, T.KB + h * 192, 1536, T.VB + h * 128, 1024, rowc, rowl, NT,
                            0.07216878364870323f * LOG2E, T.lamv[2], o, l_reg, lds, tid);
        att::row_recip(l_reg, rli, li, r32, hi);
#pragma unroll
        for (int d0 = 0; d0 < 4; ++d0)
#pragma unroll
            for (int r = 0; r < 16; ++r) o[d0][r] *= rli[r];
        attn_out<false>(T, o, 1, h, orow0, lds, wid, lane, r32, hi);
    } else if (MK_ATYPE & 4) {
        f32x16 o[4]; float l_reg; float rli[16];
        att::attn_pass<64, ATT_DBL>(T.QC + (size_t)qrow0 * 1024 + h * 128, 1024, T.KC + h * 128, 1024, T.VC + h * 128, 1024, rowc, rowl, NT,
                           0.125f * LOG2E, T.lamv[3], o, l_reg, lds, tid);
        att::row_recip(l_reg, rli, li, r32, hi);
        f32x4* scr = (f32x4*)(T.SCR + ((size_t)blockIdx.x * 512 + tid) * 64);
#pragma unroll
        for (int d0 = 0; d0 < 4; ++d0)
#pragma unroll
            for (int q = 0; q < 4; ++q) scr[d0 * 4 + q] = (f32x4){o[d0][q * 4] * rli[q * 4], o[d0][q * 4 + 1] * rli[q * 4 + 1], o[d0][q * 4 + 2] * rli[q * 4 + 2], o[d0][q * 4 + 3] * rli[q * 4 + 3]};
        att::attn_pass<64, ATT_DBL>(T.QC + (size_t)qrow0 * 1024 + h * 128 + 64, 1024, T.KC + h * 128 + 64, 1024, T.VC + h * 128, 1024, rowc, rowl, NT,
                           0.125f * LOG2E, T.lamv[3], o, l_reg, lds, tid);
        att::row_recip(l_reg, rli, li, r32, hi);
        const float lam = T.lamv[0];
#pragma unroll
        for (int d0 = 0; d0 < 4; ++d0)
#pragma unroll
            for (int q = 0; q < 4; ++q) { const f32x4 a = scr[d0 * 4 + q];
#pragma unroll
                for (int j = 0; j < 4; ++j) o[d0][q * 4 + j] = a[j] - lam * (o[d0][q * 4 + j] * rli[q * 4 + j]); }
        attn_out<true>(T, o, 2, h, orow0, lds, wid, lane, r32, hi);
    }
}

__device__ __forceinline__ void transpose_item(const float* __restrict__ W, int ldw, int k0, int srccol4, const float* __restrict__ kscale,
                                               bf16_t* __restrict__ WT, int ldt, int n0, int kdst0, LAS float* scr, int lane) {
    const int ks = lane >> 4, n4 = (lane & 15) * 4;
#pragma unroll 8
    for (int i = 0; i < 16; ++i) { const int kk = 4 * i + ks;
        f32x4 v = srccol4 >= 0 ? *(const f32x4*)(W + (size_t)(k0 + kk) * ldw + srccol4) : (f32x4){0.f, 0.f, 0.f, 0.f};
        if (kscale) v = v * kscale[k0 + kk];
        LAS float* d = scr + kk * 65 + n4; d[0] = v[0]; d[1] = v[1]; d[2] = v[2]; d[3] = v[3]; }
    asm volatile("s_waitcnt lgkmcnt(0)" ::: "memory");
    const int nn = lane & 7, c = lane >> 3;
#pragma unroll
    for (int j = 0; j < 8; ++j) { const int n = nn + 8 * j; const LAS float* s = scr + (8 * c) * 65 + n;
        u32x4 o; o.x = cvt_pk_bf16(s[0 * 65], s[1 * 65]); o.y = cvt_pk_bf16(s[2 * 65], s[3 * 65]); o.z = cvt_pk_bf16(s[4 * 65], s[5 * 65]); o.w = cvt_pk_bf16(s[6 * 65], s[7 * 65]);
        *(u32x4*)(WT + (size_t)(n0 + n) * ldt + kdst0 + k0 + 8 * c) = o; }
    asm volatile("s_waitcnt lgkmcnt(0)" ::: "memory");
}
__device__ const float INVF32[16] = {1.000000000e+00f, 5.623413324e-01f, 3.162277639e-01f, 1.778279394e-01f, 1.000000015e-01f, 5.623413250e-02f, 3.162277490e-02f, 1.778279431e-02f,
    9.999999776e-03f, 5.623413250e-03f, 3.162277630e-03f, 1.778279431e-03f, 1.000000047e-03f, 5.623413017e-04f, 3.162277571e-04f, 1.778279402e-04f};
__device__ const float INVF64[32] = {1.000000000e+00f, 7.498942614e-01f, 5.623413324e-01f, 4.216965139e-01f, 3.162277639e-01f, 2.371373773e-01f, 1.778279394e-01f, 1.333521307e-01f,
    1.000000015e-01f, 7.498941571e-02f, 5.623413250e-02f, 4.216965288e-02f, 3.162277490e-02f, 2.371373773e-02f, 1.778279431e-02f, 1.333521493e-02f, 9.999999776e-03f, 7.498941850e-03f,
    5.623413250e-03f, 4.216964822e-03f, 3.162277630e-03f, 2.371373586e-03f, 1.778279431e-03f, 1.333521446e-03f, 1.000000047e-03f, 7.498942432e-04f, 5.623413017e-04f, 4.216965172e-04f,
    3.162277571e-04f, 2.371373703e-04f, 1.778279402e-04f, 1.333521504e-04f};
__device__ __forceinline__ void sincos_d(double x, float& s, float& c) {
    const double twopi = 6.283185307179586476925;
    const double k = __builtin_rint(x / twopi), r = x - k * twopi, r2 = r * r;
    double st = r, ct = 1.0, ss = r, cs = 1.0;
    for (int n = 1; n <= 16; ++n) { ct *= -r2 / (double)((2 * n - 1) * (2 * n)); st *= -r2 / (double)((2 * n) * (2 * n + 1)); cs += ct; ss += st; }
    s = (float)ss; c = (float)cs;
}
__device__ __forceinline__ float absmax_n(const float* w, int n) { float m = 0.f; for (int i = 0; i < n; ++i) m = fmaxf(m, fabsf(w[i])); return m; }

typedef unsigned v4u_unused_t;
#define XB_TMO      128
#define XB_XCNT(j)  (256  + 64 * (j))
#define XB_XSUB(j)  (1280 + 64 * (j))
#define XB_XGEN(j)  (2304 + 64 * (j))
#define XB_TOP      3328
#define XB_TOPGEN   3392
#define XCD_BAR_WORDS 3456
#define XB_SPIN_CAP (1u << 18)

__device__ __forceinline__ unsigned xb_ld(unsigned* p)              { return __hip_atomic_load(p, __ATOMIC_RELAXED, __HIP_MEMORY_SCOPE_AGENT); }
__device__ __forceinline__ unsigned xb_add(unsigned* p, unsigned v) { return __hip_atomic_fetch_add(p, v, __ATOMIC_RELAXED, __HIP_MEMORY_SCOPE_AGENT); }
__device__ __forceinline__ unsigned xb_xcc_id() { return (unsigned)__builtin_amdgcn_s_getreg((3 << 11) | 20) & 0xFu; }
#define XB_SPIN(cond, bar) do { unsigned _sp = 0; while (cond) { __builtin_amdgcn_s_sleep(1); \
    if ((++_sp & 255u) == 0u) { if (xb_ld(&(bar)[XB_TMO])) break; if (_sp > XB_SPIN_CAP) { atomicAdd(&(bar)[XB_TMO], 1u); break; } } } } while (0)

struct XcdBarrier {
    unsigned* bar; unsigned x;
    volatile LAS unsigned* st;
};

__device__ __forceinline__ XcdBarrier xcd_barrier_post(unsigned* bar, volatile LAS unsigned* st) {
    XcdBarrier b; b.bar = bar; b.x = xb_xcc_id(); b.st = st;
    if (threadIdx.x == 0) (void)xb_add(&bar[XB_XCNT(b.x)], 1u);
    return b;
}
__device__ __forceinline__ void xcd_barrier_complete(unsigned* bar, unsigned x, unsigned& nloc, unsigned& nx) {
    const unsigned G = gridDim.x * gridDim.y * gridDim.z;
    unsigned sum, cnt, mine, sp = 0u;
    for (;;) {
        sum = 0u; cnt = 0u; mine = 0u;
#pragma unroll
        for (unsigned j = 0; j < 16; ++j) { const unsigned c = xb_ld(&bar[XB_XCNT(j)]); sum += c; cnt += (c > 0u) ? 1u : 0u; mine = (j == x) ? c : mine; }
        if (sum == G) break;
        __builtin_amdgcn_s_sleep(1);
        if ((++sp & 255u) == 0u) { if (xb_ld(&bar[XB_TMO])) break; if (sp > XB_SPIN_CAP) { atomicAdd(&bar[XB_TMO], 1u); break; } }
    }
    nloc = mine > 0u ? mine : 1u; nx = cnt > 0u ? cnt : 1u;
}

__device__ __forceinline__ void xcd_barrier(const XcdBarrier& b) {
    asm volatile("s_waitcnt vmcnt(0)" ::: "memory");
    __syncthreads();
    if (threadIdx.x == 0) {
        unsigned* bar = b.bar;
        __builtin_amdgcn_s_waitcnt(0);
        unsigned nloc = b.st[0], nx = b.st[1];
        if (nloc == 0u) { xcd_barrier_complete(bar, b.x, nloc, nx); b.st[0] = nloc; b.st[1] = nx; }
        const unsigned old = xb_add(&bar[XB_XSUB(b.x)], 1u);
        const unsigned gen = old / nloc;
        if (old + 1u == (gen + 1u) * nloc) {
            __builtin_amdgcn_fence(__ATOMIC_RELEASE, "agent");
            asm volatile("s_waitcnt vmcnt(0)" ::: "memory");
            const unsigned og = xb_add(&bar[XB_TOP], 1u);
            const unsigned tg = og / nx;
            if (og + 1u == (tg + 1u) * nx) xb_add(&bar[XB_TOPGEN], 1u);
            else XB_SPIN(xb_ld(&bar[XB_TOPGEN]) == tg, bar);
            __builtin_amdgcn_fence(__ATOMIC_ACQUIRE, "agent");
            xb_add(&bar[XB_XGEN(b.x)], 1u);
            asm volatile("s_waitcnt vmcnt(0)" ::: "memory");
        } else {
            XB_SPIN(xb_ld(&bar[XB_XGEN(b.x)]) == gen, bar);
            __builtin_amdgcn_fence(__ATOMIC_ACQUIRE, "agent");
            asm volatile("s_waitcnt vmcnt(0)" ::: "memory");
        }
    }
    __syncthreads();
}

__device__ __forceinline__ void p1_row(int row, const float* __restrict__ xsrc, const float* __restrict__ csrc, const float* __restrict__ modl, const float* __restrict__ nw,
                                       bf16_t* __restrict__ H, int lane) {
    const bool lat = row < MLAT; const int mi = lat ? (row >> 12) : 4;
    const f32x4* xr = (const f32x4*)(lat ? xsrc + (size_t)row * DM : csrc + (size_t)(row - MLAT) * DM) + lane;
    f32x4 v[8]; float s = 0.f;
#pragma unroll
    for (int j = 0; j < 8; ++j) { v[j] = xr[64 * j]; s += (v[j][0] * v[j][0] + v[j][1] * v[j][1]) + (v[j][2] * v[j][2] + v[j][3] * v[j][3]); }
    const float rinv = rsqrtf(wave_sum(s) * (1.f / DM) + EPS);
    const f32x4* sh = (const f32x4*)(modl + mi * 6144) + lane; const f32x4* scl = (const f32x4*)(modl + mi * 6144 + DM) + lane; const f32x4* nwp = (const f32x4*)nw + lane;
    u32x2* o8 = (u32x2*)(H + (size_t)row * DM) + lane;
#pragma unroll
    for (int j = 0; j < 8; ++j) { const f32x4 y = v[j] * rinv * nwp[64 * j] * (scl[64 * j] + 1.f) + sh[64 * j];
        u32x2 w; w.x = cvt_pk_bf16(y[0], y[1]); w.y = cvt_pk_bf16(y[2], y[3]); o8[64 * j] = w; }
}

__device__ __forceinline__ void p1_row2(int rowA, int rowB, const float* __restrict__ xsrc, const float* __restrict__ csrc, const float* __restrict__ modl,
                                        const float* __restrict__ nw, bf16_t* __restrict__ H, int lane) {
    if (rowB < 0) { p1_row(rowA, xsrc, csrc, modl, nw, H, lane); return; }
    const bool latA = rowA < MLAT, latB = rowB < MLAT; const int miA = latA ? (rowA >> 12) : 4, miB = latB ? (rowB >> 12) : 4;
    const f32x4* xa = (const f32x4*)(latA ? xsrc + (size_t)rowA * DM : csrc + (size_t)(rowA - MLAT) * DM) + lane;
    const f32x4* xb = (const f32x4*)(latB ? xsrc + (size_t)rowB * DM : csrc + (size_t)(rowB - MLAT) * DM) + lane;
    f32x4 va[8], vb[8]; float sa = 0.f, sb = 0.f;
#pragma unroll
    for (int j = 0; j < 8; ++j) { va[j] = xa[64 * j]; vb[j] = xb[64 * j]; }
#pragma unroll
    for (int j = 0; j < 8; ++j) { sa += (va[j][0] * va[j][0] + va[j][1] * va[j][1]) + (va[j][2] * va[j][2] + va[j][3] * va[j][3]);
                                  sb += (vb[j][0] * vb[j][0] + vb[j][1] * vb[j][1]) + (vb[j][2] * vb[j][2] + vb[j][3] * vb[j][3]); }
    const float ra = rsqrtf(wave_sum(sa) * (1.f / DM) + EPS), rb = rsqrtf(wave_sum(sb) * (1.f / DM) + EPS);
    const f32x4* nwp = (const f32x4*)nw + lane;
    const f32x4* sha = (const f32x4*)(modl + miA * 6144) + lane; const f32x4* sca = (const f32x4*)(modl + miA * 6144 + DM) + lane;
    const f32x4* shb = (const f32x4*)(modl + miB * 6144) + lane; const f32x4* scb = (const f32x4*)(modl + miB * 6144 + DM) + lane;
    u32x2* oa = (u32x2*)(H + (size_t)rowA * DM) + lane; u32x2* ob = (u32x2*)(H + (size_t)rowB * DM) + lane;
#pragma unroll
    for (int j = 0; j < 8; ++j) { const f32x4 w4 = nwp[64 * j];
        const f32x4 ya = va[j] * ra * w4 * (sca[64 * j] + 1.f) + sha[64 * j], yb = vb[j] * rb * w4 * (scb[64 * j] + 1.f) + shb[64 * j];
        u32x2 wa, wb; wa.x = cvt_pk_bf16(ya[0], ya[1]); wa.y = cvt_pk_bf16(ya[2], ya[3]); wb.x = cvt_pk_bf16(yb[0], yb[1]); wb.y = cvt_pk_bf16(yb[2], yb[3]);
        oa[64 * j] = wa; ob[64 * j] = wb; }
}

struct Args { const float* in[29]; float* out; unsigned char* ws; int ph_lo, ph_hi, coop, pad; };

__global__ void __launch_bounds__(512, 2) mega_fwd(Args args) {
    extern __shared__ __attribute__((aligned(16))) unsigned char lds_raw[];
    LAS unsigned char* lds = (LAS unsigned char*)lds_raw;
    const int G = gridDim.x, bx = blockIdx.x;
    const int vcu = (G % 8 == 0) ? (bx % 8) * (G / 8) + bx / 8 : bx;
    unsigned char* ws = args.ws;
    float* MOD = (float*)(ws + WS_MOD);
    float* TC64 = (float*)(ws + WS_TC64); float* TS64 = (float*)(ws + WS_TS64); float* TC128 = (float*)(ws + WS_TC128); float* TS128 = (float*)(ws + WS_TS128);
    float* LAM = (float*)(ws + WS_LAM);
    bf16_t* WIN = (bf16_t*)(ws + WS_WIN); bf16_t* WUP = (bf16_t*)(ws + WS_WUP); bf16_t* WBR = (bf16_t*)(ws + WS_WBR); bf16_t* WOUT = (bf16_t*)(ws + WS_WOUT);
    bf16_t* H = (bf16_t*)(ws + WS_H); bf16_t* QA = (bf16_t*)(ws + WS_QA); bf16_t* KA = (bf16_t*)(ws + WS_KA); bf16_t* VA = (bf16_t*)(ws + WS_VA);
    bf16_t* QB = (bf16_t*)(ws + WS_QB); bf16_t* KB = (bf16_t*)(ws + WS_KB); bf16_t* CKV = (bf16_t*)(ws + WS_CKV); bf16_t* VB = (bf16_t*)(ws + WS_VB);
    bf16_t* QC = (bf16_t*)(ws + WS_QC); bf16_t* KC = (bf16_t*)(ws + WS_KC); bf16_t* VC = (bf16_t*)(ws + WS_VC);
    bf16_t* GATE = (bf16_t*)(ws + WS_GATE); bf16_t* MRG = (bf16_t*)(ws + WS_MRG); bf16_t* BR = (bf16_t*)(ws + WS_BR); bf16_t* Y = (bf16_t*)(ws + WS_Y);
    float* SS = (float*)(ws + WS_SS); float* CTXW = (float*)(ws + WS_CTXW); float* SCR = (float*)(ws + WS_SCR);
    LAS float* xch = (LAS float*)(lds + XCH_OFF);
    volatile LAS unsigned* bst = (volatile LAS unsigned*)(lds + XCH_OFF + 4096);
    if (threadIdx.x < 2) bst[threadIdx.x] = 0u;
    __syncthreads();
    XcdBarrier bar = xcd_barrier_post((unsigned*)(ws + WS_BAR), bst);

    for (int ph = args.ph_lo; ph < args.ph_hi; ++ph) {
        int tid = threadIdx.x; asm volatile("" : "+v"(tid));
        const int lane = tid & 63, wave = __builtin_amdgcn_readfirstlane(tid >> 6);
        if (ph == 0 && (MK_MASK & 1)) {
            {
                LAS float* sc = (LAS float*)lds;
                LAS float* red = (LAS float*)(lds + 65536);
                for (int i = tid; i < 5 * DM; i += 512) { const float v = i < 4 * DM ? args.in[1][i] : args.in[3][i - 4 * DM]; sc[i] = silu_f(v); }
                __syncthreads();
                for (int it = bx; it < DEPTH * 96; it += G) {
                    const int l = it / 96, n0 = (it % 96) * 64;
                    const float* W = args.in[5] + (size_t)l * DM * 6144 + n0 + lane;
                    float a0 = 0.f, a1 = 0.f, a2 = 0.f, a3 = 0.f, a4 = 0.f;
                    const int kb = wave * 256;
#pragma unroll 8
                    for (int k = 0; k < 256; ++k) { const float wv = W[(size_t)(kb + k) * 6144];
                        a0 += sc[kb + k] * wv; a1 += sc[DM + kb + k] * wv; a2 += sc[2 * DM + kb + k] * wv; a3 += sc[3 * DM + kb + k] * wv; a4 += sc[4 * DM + kb + k] * wv; }
                    red[(wave * 5 + 0) * 64 + lane] = a0; red[(wave * 5 + 1) * 64 + lane] = a1; red[(wave * 5 + 2) * 64 + lane] = a2; red[(wave * 5 + 3) * 64 + lane] = a3; red[(wave * 5 + 4) * 64 + lane] = a4;
                    __syncthreads();
                    if (tid < 320) { const int i = tid >> 6; float s = 0.f;
                        for (int w8 = 0; w8 < 8; ++w8) s += red[(w8 * 5 + i) * 64 + lane];
                        MOD[((size_t)l * 5 + i) * 6144 + n0 + lane] = s + args.in[6][(size_t)l * 6144 + n0 + lane]; }
                    __syncthreads();
                }
            }
            if (bx == 1 % G) {
                for (int i = tid; i < 64 * 16; i += 512) { const int pos = i >> 4, f = i & 15; const float ang = (float)pos * INVF32[f]; float s, c; sincos_d((double)ang, s, c); TC64[i] = c; TS64[i] = s; }
                for (int i = tid; i < 64 * 32; i += 512) { const int pos = i >> 5, f = i & 31; const float ang = (float)pos * INVF64[f]; float s, c; sincos_d((double)ang, s, c); TC128[i] = c; TS128[i] = s; }
            }
            if (bx == 2 % G && tid < DEPTH) {
                const int l = tid;
                float s1 = 0.f, s2 = 0.f;
                for (int i = 0; i < 64; ++i) { s1 += args.in[20][l * 64 + i] * args.in[21][l * 64 + i]; s2 += args.in[22][l * 64 + i] * args.in[23][l * 64 + i]; }
                const float lam_init = 0.8f - 0.6f * expf(-0.3f * (float)l);
                LAM[l * 4 + 0] = expf(s1) - expf(s2) + lam_init;
                const float mAq = absmax_n(args.in[9] + l * 128, 128), mAk = absmax_n(args.in[10] + l * 128, 128);
                const float mBqn = absmax_n(args.in[11] + l * 128, 128), mBqr = absmax_n(args.in[12] + l * 64, 64), mBkn = absmax_n(args.in[16] + l * 128, 128), mBkr = absmax_n(args.in[17] + l * 64, 64);
                const float mCq = absmax_n(args.in[18] + l * 64, 64), mCk = absmax_n(args.in[19] + l * 64, 64);
                const float L2E = 1.4426950408889634f;
                LAM[l * 4 + 1] = -(sqrtf(128.f) * mAq * mAk) * L2E;
                LAM[l * 4 + 2] = -(sqrtf(128.f * mBqn * mBqn + 64.f * mBqr * mBqr) * sqrtf(128.f * mBkn * mBkn + 64.f * mBkr * mBkr) * 0.07216878364870323f) * L2E;
                LAM[l * 4 + 3] = -(8.f * mCq * mCk) * L2E;
            }
            __syncthreads();
            {
                LAS float* scr = (LAS float*)(lds + wave * 16640);
                const int gw = vcu * 8 + wave, NGW = G * 8;
                constexpr int I_IN = 32 * (NIN / 64), I_UP = 8 * 32, I_BR = 3 * 16 * 32, I_OUT = 32 * 32, I_L = I_IN + I_UP + I_BR + I_OUT;
                const int n4 = (lane & 15) * 4;
                for (int it = gw; it < DEPTH * I_L; it += NGW) {
                    const int l = it / I_L; int r = it % I_L;
                    if (r < I_IN) { const int nb = r % (NIN / 64), kb = r / (NIN / 64); const int n0 = nb * 64;
                        transpose_item(args.in[7] + (size_t)l * DM * INC, INC, kb * 64, in_src_col(n0 + n4), nullptr, WIN + (size_t)l * NIN * DM, DM, n0, 0, scr, lane); continue; }
                    r -= I_IN;
                    if (r < I_UP) { const int nb = r % 32, kb = r / 32; const int n0 = nb * 64; const int sc_ = up_src_col(n0 + n4);
                        const float* W = (sc_ < 1024 ? args.in[14] : args.in[15]) + (size_t)l * 512 * 1024;
                        transpose_item(W, 1024, kb * 64, sc_ & 1023, args.in[13] + l * 512, WUP + (size_t)l * 2048 * 512, 512, n0, 0, scr, lane); continue; }
                    r -= I_UP;
                    if (r < I_BR) { const int br = r / (16 * 32), r2 = r % (16 * 32); const int nb = r2 % 32, kb = r2 / 32; const int n0 = nb * 64;
                        transpose_item(args.in[25 + br] + (size_t)l * 1024 * DM, DM, kb * 64, n0 + n4, nullptr, WBR + (size_t)l * 2048 * 3072, 3072, n0, br * 1024, scr, lane); continue; }
                    r -= I_BR;
                    { const int nb = r % 32, kb = r / 32; const int n0 = nb * 64;
                      transpose_item(args.in[28] + (size_t)l * DM * DM, DM, kb * 64, n0 + n4, nullptr, WOUT + (size_t)l * DM * DM, DM, n0, 0, scr, lane); }
                }
            }
        } else {
            const int l = (ph == 1) ? 0 : (ph - 2) / 3, st_ = (ph == 1) ? 0 : 1 + (ph - 2) % 3, st = (st_ >= 2) ? st_ + 1 : st_;
            const float* xsrc = (l == 0) ? args.in[0] : args.out;
            const float* csrc = (l == 0) ? args.in[2] : CTXW;
            const float* modl = MOD + (size_t)l * 5 * 6144;
            const int Mrows = (l == DEPTH - 1) ? MLAT : MTOT;
            if (st == 0 && (MK_MASK & 2)) {
                const float* nw = args.in[4] + (size_t)l * DM;
                for (int row = bx * 8 + wave; row < MTOT; row += G * 16) { const int rb = row + G * 8; p1_row2(row, rb < MTOT ? rb : -1, xsrc, csrc, modl, nw, H, lane); }
            } else if (st == 1 && (MK_MASK & 4)) {
                pg8::Gemm g{H, WIN + (size_t)l * NIN * DM, MTOT, NIN, DM}; pg8::StaticOrder S; S.init(MTOT, NIN, G, bx);
                EpiIn E{QA, KA, VA, QB, KB, CKV, QC, KC, VC, GATE, MRG, SS,
                        args.in[9] + l * 128, args.in[10] + l * 128, args.in[11] + l * 128, args.in[12] + l * 64, args.in[17] + l * 64, args.in[18] + l * 64, args.in[19] + l * 64,
                        args.in[8] + (size_t)l * 6144, TC64, TS64, TC128, TS128, xch};
                pg8::gemm_phase<EpiIn>(lds, g, S, E, tid);
            } else if (st == 3 && (MK_MASK & 16)) {
                unsigned* UPC = (unsigned*)(ws + WS_CNT) + (size_t)(2 * DEPTH * 68 + l) * 64;
                const bool merged = (G == 256) && args.coop;
                {
                    pg8::Gemm g{CKV, WUP + (size_t)l * 2048 * 512, MTOT, 2048, 512}; pg8::StaticOrder S; S.init(MTOT, 2048, G, bx);
                    EpiUp E{KB, VB, SS, args.in[16] + l * 128, xch};
                    pg8::gemm_phase<EpiUp>(lds, g, S, E, tid);
                    if (merged) {
                        if (threadIdx.x == 0) {
                            __builtin_amdgcn_fence(__ATOMIC_RELEASE, "agent");
                            asm volatile("s_waitcnt vmcnt(0)" ::: "memory");
                            pg8::Unit u; unsigned n = 0; for (int i = 0; S.next(i, u); ++i) ++n;
                            __hip_atomic_fetch_add(UPC, n, __ATOMIC_RELAXED, __HIP_MEMORY_SCOPE_AGENT);
                        }
                    } else if (args.coop) xcd_barrier(bar);
                }
                AttnBufs T{QA, KA, VA, QB, KB, VB, QC, KC, VC, GATE, BR, SCR, LAM + l * 4, args.in[24] + l * 128, 0.8f - 0.6f * expf(-0.3f * (float)l)};
                const int nctx = (l < DEPTH - 1) ? 96 : 0;
                for (int k = 0;; ++k) {
                    int type, b, h, qrow0, NT;
                    if (G == 256) {
                        if (k == 4 && merged) {
                            if (threadIdx.x == 0) { unsigned sp = 0;
                                while (__hip_atomic_load(UPC, __ATOMIC_RELAXED, __HIP_MEMORY_SCOPE_AGENT) < 544u) { __builtin_amdgcn_s_sleep(1); if (++sp > (1u << 22)) break; }
                                __builtin_amdgcn_fence(__ATOMIC_ACQUIRE, "agent");
                                asm volatile("s_waitcnt vmcnt(0)" ::: "memory"); }
                            __syncthreads();
                        }
                        if (k < 6) { const int id = (k & 1) * 256 + vcu; type = (k < 2) ? 0 : (k < 4 ? 2 : 1); b = id >> 7; h = (id >> 4) & 7; qrow0 = b * SEQ + (id & 15) * 256; NT = 68; }
                        else if (k == 6 && bx < nctx) { type = bx >> 5; b = (bx >> 3) & 3; h = bx & 7; qrow0 = MLAT + b * CTXL; NT = 4; }
                        else break;
                    } else {
                        const int it = bx + k * G; if (it >= 1536 + nctx) break;
                        if (it < 1536) { const int id = it & 511; type = it >> 9; b = id >> 7; h = (id >> 4) & 7; qrow0 = b * SEQ + (id & 15) * 256; NT = 68; }
                        else { const int c = it - 1536; type = c >> 5; b = (c >> 3) & 3; h = c & 7; qrow0 = MLAT + b * CTXL; NT = 4; }
                    }
                    attn_item(T, type, b, h, qrow0, NT, (LAS char*)lds, tid);
                }
                __syncthreads();
            } else {
                unsigned* CNT = (unsigned*)(ws + WS_CNT) + (size_t)l * 68 * 64;
                const bool merged = (G == 256) && args.coop;
                const bool ctxl = l < DEPTH - 1;
                pg8::Gemm g3{BR, WBR + (size_t)l * 2048 * 3072, Mrows, 2048, 3072}; EpiBr E3{MRG, Y};
                pg8::Gemm g4{Y, WOUT + (size_t)l * DM * DM, Mrows, DM, DM}; EpiOut E4{xsrc, csrc, args.out, CTXW, modl};
                for (int part = 0; part < 2; ++part) {
                    pg8::StaticOrder S;
                    if (!merged) { if (part) break; S.init(Mrows, 2048, G, bx); }
                    else if (part == 0) S.init(MLAT, 2048, G, bx);
                    else { if (!(ctxl && bx < 32)) break; S.init_one(64 + (bx >> 3), bx & 7); }
                    { int t2 = threadIdx.x; asm volatile("" : "+v"(t2)); pg8::gemm_phase<EpiBr>(lds, g3, S, E3, t2); }
                    if (merged && threadIdx.x == 0) {
                        __builtin_amdgcn_fence(__ATOMIC_RELEASE, "agent");
                        asm volatile("s_waitcnt vmcnt(0)" ::: "memory");
                        pg8::Unit u; for (int i = 0; S.next(i, u); ++i) __hip_atomic_fetch_add(&CNT[u.pm * 64], 1u, __ATOMIC_RELAXED, __HIP_MEMORY_SCOPE_AGENT);
                    }
                }
                if (!merged && args.coop) xcd_barrier(bar);
                for (int part = 0; part < 2; ++part) {
                    pg8::StaticOrder S;
                    if (!merged) { if (part) break; S.init(Mrows, DM, G, bx); }
                    else if (part == 0) S.init(MLAT, DM, G, bx);
                    else { if (!(ctxl && bx >= 32 && bx < 64)) break; S.init_one(64 + ((bx - 32) >> 3), bx & 7); }
                    if (merged) {
                        if (threadIdx.x == 0) {
                            pg8::Unit u;
                            for (int i = 0; S.next(i, u); ++i) { unsigned sp = 0;
                                while (__hip_atomic_load(&CNT[u.pm * 64], __ATOMIC_RELAXED, __HIP_MEMORY_SCOPE_AGENT) < 8u) { __builtin_amdgcn_s_sleep(1); if (++sp > (1u << 22)) break; } }
                            __builtin_amdgcn_fence(__ATOMIC_ACQUIRE, "agent");
                            asm volatile("s_waitcnt vmcnt(0)" ::: "memory");
                        }
                        __syncthreads();
                    }
                    { int t2 = threadIdx.x; asm volatile("" : "+v"(t2)); pg8::gemm_phase<EpiOut>(lds, g4, S, E4, t2); }
                    if (merged && ctxl && threadIdx.x == 0) {
                        __builtin_amdgcn_fence(__ATOMIC_RELEASE, "agent");
                        asm volatile("s_waitcnt vmcnt(0)" ::: "memory");
                        pg8::Unit u; for (int i = 0; S.next(i, u); ++i) __hip_atomic_fetch_add(&CNT[(DEPTH * 68 + u.pm) * 64], 1u, __ATOMIC_RELAXED, __HIP_MEMORY_SCOPE_AGENT);
                    }
                }
                if (l < DEPTH - 1) {
                    const float* nw1 = args.in[4] + (size_t)(l + 1) * DM; const float* mod1 = MOD + (size_t)(l + 1) * 5 * 6144;
                    int t3 = threadIdx.x; asm volatile("" : "+v"(t3));
                    const int lane3 = t3 & 63, wave3 = __builtin_amdgcn_readfirstlane(t3 >> 6);
                    if (merged) {
                        const int r0 = 68 * bx;
                        if (threadIdx.x == 0) {
                            for (int pm = r0 >> 8; pm <= (r0 + 67) >> 8; ++pm) { unsigned sp = 0;
                                while (__hip_atomic_load(&CNT[(DEPTH * 68 + pm) * 64], __ATOMIC_RELAXED, __HIP_MEMORY_SCOPE_AGENT) < 8u) { __builtin_amdgcn_s_sleep(1); if (++sp > (1u << 22)) break; } }
                            __builtin_amdgcn_fence(__ATOMIC_ACQUIRE, "agent");
                            asm volatile("s_waitcnt vmcnt(0)" ::: "memory");
                        }
                        __syncthreads();
                        for (int row = r0 + wave3; row < r0 + 68; row += 16) { const int rb = row + 8; p1_row2(row, rb < r0 + 68 ? rb : -1, args.out, CTXW, mod1, nw1, H, lane3); }
                    } else {
                        if (args.coop) xcd_barrier(bar);
                        for (int row = bx * 8 + wave3; row < MTOT; row += G * 16) { const int rb = row + G * 8; p1_row2(row, rb < MTOT ? rb : -1, args.out, CTXW, mod1, nw1, H, lane3); }
                    }
                }
            }
        }
        if (ph + 1 < args.ph_hi) { if (args.coop) { if (ph == 0) cg::this_grid().sync(); else xcd_barrier(bar); } }
    }
}

extern "C" void kernel_launch(void* const* d_in, const int* in_sizes, int n_in, void* d_out, int out_size, void* d_ws, size_t ws_size, hipStream_t stream) {
    static int grid = 0;
    if (grid == 0) {
        if (n_in != 29 || in_sizes[0] != MLAT * DM || out_size != MLAT * DM || ws_size < WS_END) {
            fprintf(stderr, "kernel_launch: unexpected shapes: n_in %d in0 %d out %d ws %zu (need %zu)\n", n_in, n_in > 0 ? in_sizes[0] : -1, out_size, ws_size, (size_t)WS_END); grid = -1; return; }
        int dev = 0, cus = 0, per_cu = 0;
        if (hipGetDevice(&dev) != hipSuccess || hipDeviceGetAttribute(&cus, hipDeviceAttributeMultiprocessorCount, dev) != hipSuccess) { grid = -1; return; }
        if (hipFuncSetAttribute((const void*)mega_fwd, hipFuncAttributeMaxDynamicSharedMemorySize, LDS_BYTES) != hipSuccess) { fprintf(stderr, "kernel_launch: hipFuncSetAttribute failed\n"); grid = -1; return; }
        if (hipOccupancyMaxActiveBlocksPerMultiprocessor(&per_cu, (const void*)mega_fwd, 512, LDS_BYTES) != hipSuccess || per_cu < 1) { fprintf(stderr, "kernel_launch: occupancy query gives %d\n", per_cu); per_cu = 1; }
        (void)hipGetLastError();
        grid = cus * 1;
    }
    if (grid < 0) return;
    Args a{};
    for (int i = 0; i < 29; ++i) a.in[i] = (const float*)d_in[i];
    a.out = (float*)d_out; a.ws = (unsigned char*)d_ws;
#if MK_COOP
    if (hipMemsetAsync((char*)d_ws + WS_BAR, 0, 16384 + CNT_BYTES, stream) != hipSuccess) { fprintf(stderr, "kernel_launch: memset of the barrier words failed\n"); return; }
    a.ph_lo = 0; a.ph_hi = NPH; a.coop = 1;
    void* kargs[] = {&a};
    hipError_t e = hipLaunchCooperativeKernel((const void*)mega_fwd, dim3(grid), dim3(512), kargs, LDS_BYTES, stream);
    if (e != hipSuccess) fprintf(stderr, "kernel_launch: cooperative launch failed: %s (grid %d)\n", hipGetErrorString(e), grid);
#else
    for (int ph = 0; ph < NPH; ++ph) {
        a.ph_lo = ph; a.ph_hi = ph + 1; a.coop = 0;
        hipLaunchKernelGGL(mega_fwd, dim3(grid), dim3(512), LDS_BYTES, stream, a);
    }
    const hipError_t le = hipPeekAtLastError();
    if (le != hipSuccess) fprintf(stderr, "kernel_launch: launch failed: %s\n", hipGetErrorName(le));
#endif
}
```

```cpp
#include <hip/hip_runtime.h>
#include <hip/hip_cooperative_groups.h>
#include <cstdio>
#include <cstdint>
namespace cg = cooperative_groups;

#ifndef MK_MASK
#define MK_MASK 127
#endif
#ifndef MK_ATYPE
#define MK_ATYPE 7
#endif
#ifndef MK_G1T
#define MK_G1T 127
#endif
#ifndef ATT_SD_A
#define ATT_SD_A 2
#endif
#ifndef ATT_SD_B
#define ATT_SD_B 1
#endif
#ifndef ATT_SD_C
#define ATT_SD_C 2
#endif
#ifndef ATT_DBL_B
#define ATT_DBL_B true
#endif
#ifndef ATT_DBL
#define ATT_DBL false
#endif
#ifndef QKT_GRP
#define QKT_GRP 0
#endif
#ifndef MK_COOP
#define MK_COOP 1
#endif

#define LAS __attribute__((address_space(3)))
typedef unsigned short bf16_t;
typedef short bf16x8 __attribute__((ext_vector_type(8)));
typedef short s16x4 __attribute__((ext_vector_type(4)));
typedef float f32x4 __attribute__((ext_vector_type(4)));
typedef float f32x16 __attribute__((ext_vector_type(16)));
typedef unsigned u32x4 __attribute__((ext_vector_type(4)));
typedef unsigned u32x2 __attribute__((ext_vector_type(2)));

constexpr int DM = 2048, NBATCH = 4, SEQ = 4096, CTXL = 256, DEPTH = 4;
constexpr int MLAT = NBATCH * SEQ, MCTX = NBATCH * CTXL, MTOT = MLAT + MCTX;
constexpr int INC = 15936, NIN = 16128;
constexpr float EPS = 1e-6f;
#ifndef MK_REP_ST
#define MK_REP_ST -1
#endif
constexpr int PPL = 5;
constexpr int NPH = 2 + 3 * DEPTH;

constexpr size_t alignup(size_t x) { return (x + 255) / 256 * 256; }
constexpr size_t WS_MOD = 0;
constexpr size_t WS_TC64 = WS_MOD + alignup((size_t)DEPTH * 5 * 6144 * 4);
constexpr size_t WS_TS64 = WS_TC64 + 4096, WS_TC128 = WS_TS64 + 4096, WS_TS128 = WS_TC128 + 8192;
constexpr size_t WS_LAM = WS_TS128 + 8192;
constexpr size_t WS_BAR = WS_LAM + 256;
constexpr size_t WS_CNT = WS_BAR + 16384;
constexpr size_t CNT_BYTES = (size_t)(2 * DEPTH * 68 + DEPTH) * 256;
constexpr size_t WS_WIN = WS_CNT + CNT_BYTES;
constexpr size_t WS_WUP = WS_WIN + (size_t)DEPTH * NIN * DM * 2;
constexpr size_t WS_WBR = WS_WUP + (size_t)DEPTH * 2048 * 512 * 2;
constexpr size_t WS_WOUT = WS_WBR + (size_t)DEPTH * 2048 * 3072 * 2;
constexpr size_t WS_H = WS_WOUT + (size_t)DEPTH * 2048 * 2048 * 2;
constexpr size_t WS_QA = WS_H + (size_t)MTOT * 2048 * 2;
constexpr size_t WS_KA = WS_QA + (size_t)MTOT * 1024 * 2;
constexpr size_t WS_VA = WS_KA + (size_t)MTOT * 256 * 2;
constexpr size_t WS_QB = WS_VA + (size_t)MTOT * 256 * 2;
constexpr size_t WS_KB = WS_QB + (size_t)MTOT * 1536 * 2;
constexpr size_t WS_CKV = WS_KB + (size_t)MTOT * 1536 * 2;
constexpr size_t WS_VB = WS_CKV + (size_t)MTOT * 512 * 2;
constexpr size_t WS_QC = WS_VB + (size_t)MTOT * 1024 * 2;
constexpr size_t WS_KC = WS_QC + (size_t)MTOT * 1024 * 2;
constexpr size_t WS_VC = WS_KC + (size_t)MTOT * 1024 * 2;
constexpr size_t WS_GATE = WS_VC + (size_t)MTOT * 1024 * 2;
constexpr size_t WS_MRG = WS_GATE + (size_t)MTOT * 3072 * 2;
constexpr size_t WS_BR = WS_MRG + (size_t)MTOT * 6144 * 2;
constexpr size_t WS_Y = WS_BR + (size_t)MTOT * 3072 * 2;
constexpr size_t WS_SS = WS_Y + (size_t)MTOT * 2048 * 2;
constexpr size_t WS_CTXW = WS_SS + (size_t)MTOT * 8 * 4;
constexpr size_t WS_SCR = WS_CTXW + (size_t)MCTX * DM * 4;
constexpr size_t WS_END = WS_SCR + (size_t)256 * 64 * 512 * 4;

constexpr int RING_BYTES = 131072, XCH_OFF = RING_BYTES, LDS_BYTES = 147456;

__device__ __forceinline__ float bf2f(unsigned h) { return __uint_as_float(h << 16); }
__device__ __forceinline__ unsigned cvt_pk_bf16(float lo, float hi) { unsigned r; asm volatile("v_cvt_pk_bf16_f32 %0, %1, %2" : "=v"(r) : "v"(lo), "v"(hi)); return r; }
__device__ __forceinline__ float wave_sum(float v) {
#pragma unroll
    for (int o = 1; o < 64; o <<= 1) v += __shfl_xor(v, o);
    return v;
}
__device__ __forceinline__ float sigm_f(float x) { return __builtin_amdgcn_rcpf(1.f + __builtin_amdgcn_exp2f(-1.4426950408889634f * x)); }
__device__ __forceinline__ float silu_f(float x) { return x * sigm_f(x); }
__device__ __forceinline__ unsigned cvt_pk_bf16_safe(float lo, float hi) { unsigned r; asm volatile("s_nop 1\n\tv_cvt_pk_bf16_f32 %0, %1, %2" : "=v"(r) : "v"(lo), "v"(hi)); return r; }
__device__ __forceinline__ void store8_safe(bf16_t* p, f32x4 a, f32x4 b) {
    u32x4 w; w.x = cvt_pk_bf16_safe(a[0], a[1]); w.y = cvt_pk_bf16_safe(a[2], a[3]); w.z = cvt_pk_bf16_safe(b[0], b[1]); w.w = cvt_pk_bf16_safe(b[2], b[3]);
    *(u32x4*)p = w;
}
__device__ __forceinline__ void store8(bf16_t* p, f32x4 a, f32x4 b) {
    u32x4 w; w.x = cvt_pk_bf16(a[0], a[1]); w.y = cvt_pk_bf16(a[2], a[3]); w.z = cvt_pk_bf16(b[0], b[1]); w.w = cvt_pk_bf16(b[2], b[3]);
    *(u32x4*)p = w;
}

namespace pg8 {
constexpr int BM = 256, BK = 64, HALF = 128, HTB = HALF * BK * 2, NXCD = 8, WGM = 8;
__host__ __device__ __forceinline__ int lds_byte(int r, int c) { const int st = (r >> 4) * 2 + (c >> 5), rr = r & 15, cc = c & 31, ob = rr * 64 + cc * 2; return st * 1024 + (ob ^ (((ob >> 9) & 1) << 5)); }
__host__ __device__ __forceinline__ void stage_rc(int b, int& R, int& C) { const int st = b / 1024, sb = b % 1024, swz = sb ^ (((sb >> 9) & 1) << 5); R = (st >> 1) * 16 + swz / 64; C = (st & 1) * 32 + (swz % 64) / 2; }
__host__ __device__ __forceinline__ int perm32(int rho) { const int n = rho >> 4, i = rho & 15; return 8 * (i >> 2) + 4 * n + (i & 3); }

struct Unit { int pm, pn; };
struct Gemm { const bf16_t* A; const bf16_t* Bt; int M, N, K; };
struct StaticOrder {
    int nM, nN, nwg, G, c, fixed, fpm, fpn;
    __device__ void init(int M, int N, int G_, int c_) { nM = M / BM; nN = N / BM; nwg = nM * nN; G = G_; c = c_; fixed = 0; fpm = 0; fpn = 0; }
    __device__ void init_one(int pm, int pn) { nM = 1; nN = 1; nwg = 1; G = 1; c = 0; fixed = 1; fpm = pm; fpn = pn; }
    __device__ bool next(int i, Unit& u) const {
        if (fixed) { if (i > 0) return false; u.pm = fpm; u.pn = fpn; return true; }
        const long L = (long)i * G + c; if (L >= nwg) return false;
        int wgid = (int)L; { const int q = nwg / NXCD, r = nwg % NXCD, xcd = wgid % NXCD, off = wgid / NXCD; wgid = (xcd < r ? xcd * (q + 1) : r * (q + 1) + (xcd - r) * q) + off; }
        const int nig = WGM * nN, gid = wgid / nig, fm = gid * WGM, gsz = (nM - fm) < WGM ? (nM - fm) : WGM;
        u.pm = fm + ((wgid % nig) % gsz); u.pn = (wgid % nig) / gsz; return true;
    }
};

template <class Epi>
__device__ __forceinline__ void gemm_phase(LAS unsigned char* lds, const Gemm g, const StaticOrder& S, const Epi& E, const int tid) {
    const int wid = __builtin_amdgcn_readfirstlane(tid >> 6), lane = tid & 63, wr = wid >> 2, wc = wid & 3, fr = lane & 15, fq = lane >> 4;
    const int K = g.K, nt = K / BK;
    unsigned voffA[2], voffB[2];
#pragma unroll
    for (int i = 0; i < 2; ++i) { int R, C; stage_rc(tid * 16 + i * 8192, R, C); const int Rb = (R & ~31) + perm32(R & 31);
        voffA[i] = (unsigned)(R * K + C) * 2u; voffB[i] = (unsigned)(Rb * K + C) * 2u; }
    const size_t kstep = (size_t)(BK * 2);
    const size_t hstep = (size_t)HALF * K * 2;
    const size_t tstep = 2 * hstep;
    const unsigned ldsw = (unsigned)wid * 1024u;
    const int aoff = lds_byte(wr * 64 + fr, fq * 8), boff = lds_byte(wc * 32 + fr, fq * 8);
#define PG8_SA(b, h) (((b) * 2 + (h)) * HTB)
#define PG8_SB(b, h) ((4 + (b) * 2 + (h)) * HTB)
#define PG8_STAGE(bufoff, gbase, voff) do { _Pragma("unroll") for (int _i = 0; _i < 2; ++_i) \
        __builtin_amdgcn_global_load_lds((const unsigned*)((const char*)(gbase) + (voff)[_i]), (LAS unsigned*)(lds + (bufoff) + ldsw + _i * 8192), 16, 0, 0); } while (0)
#define PG8_LDA(dst, b, h) do { _Pragma("unroll") for (int m = 0; m < 4; ++m) _Pragma("unroll") for (int k = 0; k < 2; ++k) dst[m][k] = *(const LAS bf16x8*)(lds + PG8_SA(b, h) + aoff + m * 2048 + k * 1024); } while (0)
#define PG8_LDB(dst, b, h) do { _Pragma("unroll") for (int n = 0; n < 2; ++n) _Pragma("unroll") for (int k = 0; k < 2; ++k) dst[n][k] = *(const LAS bf16x8*)(lds + PG8_SB(b, h) + boff + n * 2048 + k * 1024); } while (0)
#define PG8_MMA(ai, bj, At, Bt) do { __builtin_amdgcn_s_setprio(1); _Pragma("unroll") for (int m = 0; m < 4; ++m) _Pragma("unroll") for (int n = 0; n < 2; ++n) _Pragma("unroll") for (int k = 0; k < 2; ++k) \
        acc[ai][bj][m][n] = __builtin_amdgcn_mfma_f32_16x16x32_bf16(Bt[n][k], At[m][k], acc[ai][bj][m][n], 0, 0, 0); __builtin_amdgcn_s_setprio(0); } while (0)
#define PG8_WAIT_V(n) asm volatile("s_waitcnt vmcnt(" #n ")" ::: "memory")
#define PG8_WAIT_L(n) asm volatile("s_waitcnt lgkmcnt(" #n ")" ::: "memory")
#define PG8_BAR __builtin_amdgcn_s_barrier()
#define PG8_SCHED __builtin_amdgcn_sched_barrier(0)
    Unit cur, nxt; int ui = 0;
    if (!S.next(0, cur)) return;
    f32x4 acc[2][2][4][2];
#pragma unroll
    for (int a = 0; a < 2; ++a)
#pragma unroll
        for (int b = 0; b < 2; ++b)
#pragma unroll
            for (int m = 0; m < 4; ++m)
#pragma unroll
                for (int n = 0; n < 2; ++n) acc[a][b][m][n] = (f32x4){0.f, 0.f, 0.f, 0.f};
    bf16x8 At[4][2], B0[2][2], B1[2][2];
    const char* cA = (const char*)g.A + (size_t)cur.pm * tstep; const char* cB = (const char*)g.Bt + (size_t)cur.pn * tstep;
    PG8_STAGE(PG8_SB(0, 0), cB, voffB); PG8_STAGE(PG8_SB(0, 1), cB + hstep, voffB); PG8_STAGE(PG8_SA(0, 0), cA, voffA); PG8_STAGE(PG8_SA(0, 1), cA + hstep, voffA);
    if (wr == 1) PG8_BAR;
    PG8_WAIT_V(2); PG8_BAR;
    PG8_STAGE(PG8_SB(1, 0), cB + kstep, voffB); PG8_STAGE(PG8_SA(1, 0), cA + kstep, voffA); PG8_STAGE(PG8_SB(1, 1), cB + hstep + kstep, voffB);
    PG8_WAIT_V(6); PG8_BAR;
    for (;;) {
        const bool has_next = S.next(ui + 1, nxt);
        const char* nA = has_next ? (const char*)g.A + (size_t)nxt.pm * tstep : cA; const char* nB = has_next ? (const char*)g.Bt + (size_t)nxt.pn * tstep : cB;
        for (int t = 0; t < nt; t += 2) {
            const bool last = (t == nt - 2);
            const char* a1 = cA + (size_t)(t + 1) * kstep;
            const char* a2 = last ? nA : cA + (size_t)(t + 2) * kstep; const char* b2 = last ? nB : cB + (size_t)(t + 2) * kstep;
            const char* a3 = a2 + kstep; const char* b3 = b2 + kstep;
            if constexpr (Epi::MID) { if (t == 16 || t == 32) { int fr_ = fr, fq_ = fq, wr_ = wr, wc_ = wc;
                asm volatile("" : "+v"(fr_), "+v"(fq_)); asm volatile("" : "+s"(wr_), "+s"(wc_));
                E.mid(acc, cur, t >> 4, wr_, wc_, fr_, fq_); PG8_WAIT_V(0); PG8_SCHED; } }
            PG8_LDB(B0, 0, 0); PG8_LDB(B1, 0, 1); PG8_SCHED; PG8_LDA(At, 0, 0); PG8_STAGE(PG8_SA(1, 1), a1 + hstep, voffA);
            PG8_WAIT_V(8); PG8_WAIT_L(0); PG8_BAR; PG8_MMA(0, 0, At, B0); PG8_MMA(0, 1, At, B1); PG8_BAR; PG8_SCHED;
            PG8_LDA(At, 0, 1); PG8_STAGE(PG8_SB(0, 0), b2, voffB); PG8_STAGE(PG8_SB(0, 1), b2 + hstep, voffB); PG8_STAGE(PG8_SA(0, 0), a2, voffA);
            PG8_WAIT_V(8); PG8_WAIT_L(0); PG8_BAR; PG8_MMA(1, 0, At, B0); PG8_MMA(1, 1, At, B1); PG8_BAR; PG8_SCHED;
            PG8_LDB(B0, 1, 0); PG8_LDB(B1, 1, 1); PG8_SCHED; PG8_LDA(At, 1, 0); PG8_STAGE(PG8_SA(0, 1), a2 + hstep, voffA);
            PG8_WAIT_V(8); PG8_WAIT_L(0); PG8_BAR; PG8_MMA(0, 0, At, B0); PG8_MMA(0, 1, At, B1); PG8_BAR; PG8_SCHED;
            PG8_LDA(At, 1, 1); PG8_STAGE(PG8_SB(1, 0), b3, voffB); PG8_STAGE(PG8_SB(1, 1), b3 + hstep, voffB); PG8_STAGE(PG8_SA(1, 0), a3, voffA);
            PG8_WAIT_V(8); PG8_WAIT_L(0); PG8_BAR; PG8_MMA(1, 0, At, B0); PG8_MMA(1, 1, At, B1); PG8_BAR; PG8_SCHED;
        }
        if (wr == 0) PG8_BAR;
        { int fr_ = fr, fq_ = fq, wr_ = wr, wc_ = wc, wid_ = wid;
          asm volatile("" : "+v"(fr_), "+v"(fq_)); asm volatile("" : "+s"(wr_), "+s"(wc_), "+s"(wid_));
          E(acc, cur, wr_, wc_, fr_, fq_, wid_); }
        if (!has_next) break;
#pragma unroll
        for (int a = 0; a < 2; ++a)
#pragma unroll
            for (int b = 0; b < 2; ++b)
#pragma unroll
                for (int m = 0; m < 4; ++m)
#pragma unroll
                    for (int n = 0; n < 2; ++n) acc[a][b][m][n] = (f32x4){0.f, 0.f, 0.f, 0.f};
        cur = nxt; cA = nA; cB = nB; ++ui;
        if (wr == 1) PG8_BAR;
    }
    PG8_WAIT_V(0);
    PG8_BAR;
#undef PG8_SA
#undef PG8_SB
#undef PG8_STAGE
#undef PG8_LDA
#undef PG8_LDB
#undef PG8_MMA
#undef PG8_WAIT_V
#undef PG8_WAIT_L
#undef PG8_BAR
#undef PG8_SCHED
}
}
using pg8::Unit;

__device__ __forceinline__ int in_src_col(int n) {
    const int tile = n >> 8, s = n & 255, bj = s >> 7, wc = (s >> 5) & 3, c = s & 31;
    const int d128 = 64 * (wc & 1) + 32 * bj + c, g128 = wc >> 1;
    const int d64 = 32 * (c >> 4) + 16 * bj + (c & 15), g64 = wc;
    if (tile < 4) return (tile * 2 + g128) * 128 + d128;
    if (tile == 4) return 1024 + g128 * 128 + d128;
    if (tile == 5) return 1280 + s;
    if (tile < 10) return 1536 + ((tile - 6) * 2 + g128) * 192 + d128;
    if (tile < 12) return 1536 + ((tile - 10) * 4 + g64) * 192 + 128 + d64;
    if (tile < 14) return 3072 + (tile - 12) * 256 + s;
    if (tile == 14) return g64 == 0 ? 3584 + d64 : -1;
    if (tile < 19) return 3648 + ((tile - 15) * 4 + g64) * 64 + d64;
    if (tile < 23) return 4672 + ((tile - 19) * 4 + g64) * 64 + d64;
    if (tile < 27) return 5696 + (tile - 23) * 256 + s;
    if (tile < 39) return 6720 + (tile - 27) * 256 + s;
    return 9792 + (tile - 39) * 256 + s;
}
__device__ __forceinline__ int up_src_col(int n) {
    if (n >= 1024) return n;
    const int tile = n >> 8, s = n & 255, bj = s >> 7, wc = (s >> 5) & 3, c = s & 31;
    return (tile * 2 + (wc >> 1)) * 128 + 64 * (wc & 1) + 32 * bj + c;
}

template <int GS>
__device__ __forceinline__ void norm_rope_store(const f32x4 (&acc)[2][2][4][2], int pm, int wr, int wc, int fr, int fq, int wid,
                                                const float* __restrict__ w, const float* __restrict__ tcos, const float* __restrict__ tsin, bool rope,
                                                const float (&pre)[2][4], bf16_t* __restrict__ dst, int ld, int gbase, int ncopies, int copystride, LAS float* xch, const float qs = 1.f) {
    const int dbase = (GS == 128) ? 64 * (wc & 1) + 8 * fq : 32 * (fq >> 1) + 8 * (fq & 1);
    const int bjs = (GS == 128) ? 32 : 16;
    const int axis = (GS == 128) ? (wc & 1) : (fq >> 1);
    const int i0 = (GS == 128) ? 8 * fq : 8 * (fq & 1);
    constexpr int NF = (GS == 128) ? 32 : 16;
    const int wavebase = gbase + ((GS == 128) ? 64 * (wc & 1) : 0) + 8 * fq;
    float ssq[2][4];
#pragma unroll
    for (int ai = 0; ai < 2; ++ai)
#pragma unroll
        for (int m = 0; m < 4; ++m) {
            float s = 0.f;
#pragma unroll
            for (int bj = 0; bj < 2; ++bj)
#pragma unroll
                for (int n = 0; n < 2; ++n)
#pragma unroll
                    for (int j = 0; j < 4; ++j) { const float v = acc[ai][bj][m][n][j] * pre[ai][m]; s += v * v; }
            s += __shfl_xor(s, 16); s += __shfl_xor(s, 32);
            ssq[ai][m] = s;
        }
    if constexpr (GS == 128) {
        if (fq == 0) {
#pragma unroll
            for (int ai = 0; ai < 2; ++ai)
#pragma unroll
                for (int m = 0; m < 4; ++m) xch[wid * 128 + ai * 64 + m * 16 + fr] = ssq[ai][m];
        }
        asm volatile("s_waitcnt lgkmcnt(0)" ::: "memory"); __builtin_amdgcn_s_barrier();
#pragma unroll
        for (int ai = 0; ai < 2; ++ai)
#pragma unroll
            for (int m = 0; m < 4; ++m) ssq[ai][m] += xch[(wid ^ 1) * 128 + ai * 64 + m * 16 + fr];
    }
#pragma unroll
    for (int ai = 0; ai < 2; ++ai)
#pragma unroll
        for (int m = 0; m < 4; ++m) {
            const int rl = ai * 128 + wr * 64 + m * 16 + fr;
            const size_t row = (size_t)pm * 256 + rl;
            const float rinv = rsqrtf(ssq[ai][m] * (1.f / GS) + EPS) * pre[ai][m] * qs;
            const int t = (pm & 15) * 256 + rl; const int pos = axis ? (t & 63) : (t >> 6);
            u32x4 k0, k1;
#pragma unroll
            for (int n = 0; n < 2; ++n) {
                const f32x4 w0 = *(const f32x4*)(w + dbase + 4 * n), w1 = *(const f32x4*)(w + dbase + bjs + 4 * n);
                f32x4 y0 = acc[ai][0][m][n] * rinv * w0, y1 = acc[ai][1][m][n] * rinv * w1;
                if (rope) {
                    const f32x4 c = *(const f32x4*)(tcos + pos * NF + i0 + 4 * n), sn = *(const f32x4*)(tsin + pos * NF + i0 + 4 * n);
                    const f32x4 o0 = y0 * c - y1 * sn, o1 = y1 * c + y0 * sn;
                    y0 = o0; y1 = o1;
                }
                if (n == 0) { k0.x = cvt_pk_bf16(y0[0], y0[1]); k0.y = cvt_pk_bf16(y0[2], y0[3]); k1.x = cvt_pk_bf16(y1[0], y1[1]); k1.y = cvt_pk_bf16(y1[2], y1[3]); }
                else { k0.z = cvt_pk_bf16(y0[0], y0[1]); k0.w = cvt_pk_bf16(y0[2], y0[3]); k1.z = cvt_pk_bf16(y1[0], y1[1]); k1.w = cvt_pk_bf16(y1[2], y1[3]); }
            }
            bf16_t* p = dst + row * ld + wavebase;
            for (int cp = 0; cp < ncopies; ++cp) { *(u32x4*)(p + cp * copystride) = k0; *(u32x4*)(p + cp * copystride + 32) = k1; }
            __builtin_amdgcn_sched_barrier(0);
        }
}

struct EpiIn {
    static constexpr bool MID = false;
    bf16_t *QA, *KA, *VA, *QB, *KB, *CKV, *QC, *KC, *VC, *GATE, *MRG; float* SS;
    const float *wAq, *wAk, *wBqn, *wBqr, *wBkr, *wCq, *wCk, *bmerge;
    const float *tc64, *ts64, *tc128, *ts128;
    LAS float* xch;
    template <int ACT>
    __device__ __forceinline__ void plain(const f32x4 (&acc)[2][2][4][2], int pm, int wr, int wc, int fr, int fq, bf16_t* dst, int ld, int col0) const {
        const int colw = col0 + 32 * wc + 8 * fq;
        f32x4 b[2][2];
#pragma unroll
        for (int bj = 0; bj < 2; ++bj)
#pragma unroll
            for (int n = 0; n < 2; ++n) b[bj][n] = (ACT == 2) ? *(const f32x4*)(bmerge + colw + bj * 128 + 4 * n) : (f32x4){0.f, 0.f, 0.f, 0.f};
#pragma unroll
        for (int ai = 0; ai < 2; ++ai)
#pragma unroll
            for (int m = 0; m < 4; ++m) {
                const size_t row = (size_t)pm * 256 + ai * 128 + wr * 64 + m * 16 + fr;
#pragma unroll
                for (int bj = 0; bj < 2; ++bj) {
                    f32x4 v0 = acc[ai][bj][m][0], v1 = acc[ai][bj][m][1];
                    if (ACT == 1) { for (int j = 0; j < 4; ++j) { v0[j] = silu_f(v0[j]); v1[j] = silu_f(v1[j]); } }
                    if (ACT == 2) { v0 = v0 + b[bj][0]; v1 = v1 + b[bj][1]; for (int j = 0; j < 4; ++j) { v0[j] = sigm_f(v0[j]); v1[j] = sigm_f(v1[j]); } }
                    if (ACT == 0) store8(dst + row * ld + colw + bj * 128, v0, v1); else store8_safe(dst + row * ld + colw + bj * 128, v0, v1);
                }
                __builtin_amdgcn_sched_barrier(0);
            }
    }
    __device__ __forceinline__ void operator()(const f32x4 (&acc)[2][2][4][2], const Unit& u, int wr, int wc, int fr, int fq, int wid) const {
        const int t = u.pn, pm = u.pm; const bool rope = pm < 64;
        const float one[2][4] = {{1.f, 1.f, 1.f, 1.f}, {1.f, 1.f, 1.f, 1.f}};
        if (t < 4 && (MK_G1T & 1)) norm_rope_store<128>(acc, pm, wr, wc, fr, fq, wid, wAq, tc128, ts128, rope, one, QA, 1024, (t * 2 + (wc >> 1)) * 128, 1, 0, xch, 0.08838834764831845f * 1.4426950408889634f);
        else if (t == 4 && (MK_G1T & 1)) norm_rope_store<128>(acc, pm, wr, wc, fr, fq, wid, wAk, tc128, ts128, rope, one, KA, 256, (wc >> 1) * 128, 1, 0, xch);
        else if (t == 5 && (MK_G1T & 2)) plain<0>(acc, pm, wr, wc, fr, fq, VA, 256, 0);
        else if (t < 10 && (MK_G1T & 1)) norm_rope_store<128>(acc, pm, wr, wc, fr, fq, wid, wBqn, tc128, ts128, false, one, QB, 1536, ((t - 6) * 2 + (wc >> 1)) * 192, 1, 0, xch, 0.07216878364870323f * 1.4426950408889634f);
        else if (t < 12 && (MK_G1T & 4)) norm_rope_store<64>(acc, pm, wr, wc, fr, fq, wid, wBqr, tc64, ts64, rope, one, QB, 1536, ((t - 10) * 4 + wc) * 192 + 128, 1, 0, xch, 0.07216878364870323f * 1.4426950408889634f);
        else if (t < 14 && (MK_G1T & 8)) {
            plain<0>(acc, pm, wr, wc, fr, fq, CKV, 512, (t - 12) * 256);
#pragma unroll
            for (int ai = 0; ai < 2; ++ai)
#pragma unroll
                for (int m = 0; m < 4; ++m) {
                    float s = 0.f;
#pragma unroll
                    for (int bj = 0; bj < 2; ++bj)
#pragma unroll
                        for (int n = 0; n < 2; ++n)
#pragma unroll
                            for (int j = 0; j < 4; ++j) { const float v = acc[ai][bj][m][n][j]; s += v * v; }
                    s += __shfl_xor(s, 16); s += __shfl_xor(s, 32);
                    if (fq == 0) SS[((size_t)pm * 256 + ai * 128 + wr * 64 + m * 16 + fr) * 8 + (t - 12) * 4 + wc] = s;
                }
        }
        else if (t == 14 && (MK_G1T & 16)) { if (wc == 0) norm_rope_store<64>(acc, pm, wr, wc, fr, fq, wid, wBkr, tc64, ts64, rope, one, KB, 1536, 128, 8, 192, xch); }
        else if (t < 19 && (MK_G1T & 4)) norm_rope_store<64>(acc, pm, wr, wc, fr, fq, wid, wCq, tc64, ts64, rope, one, QC, 1024, ((t - 15) * 4 + wc) * 64, 1, 0, xch, 0.125f * 1.4426950408889634f);
        else if (t < 23 && (MK_G1T & 4)) norm_rope_store<64>(acc, pm, wr, wc, fr, fq, wid, wCk, tc64, ts64, rope, one, KC, 1024, ((t - 19) * 4 + wc) * 64, 1, 0, xch);
        else if (t < 27 && (MK_G1T & 2)) plain<0>(acc, pm, wr, wc, fr, fq, VC, 1024, (t - 23) * 256);
        else if (t < 39 && (MK_G1T & 32)) plain<1>(acc, pm, wr, wc, fr, fq, GATE, 3072, (t - 27) * 256);
        else if (MK_G1T & 64) plain<2>(acc, pm, wr, wc, fr, fq, MRG, 6144, (t - 39) * 256);
    }
};

struct EpiUp {
    static constexpr bool MID = false;
    bf16_t *KB, *VB; const float* SS; const float* wBkn; LAS float* xch;
    __device__ __forceinline__ void operator()(const f32x4 (&acc)[2][2][4][2], const Unit& u, int wr, int wc, int fr, int fq, int wid) const {
        const int t = u.pn, pm = u.pm;
        float pre[2][4];
#pragma unroll
        for (int ai = 0; ai < 2; ++ai)
#pragma unroll
            for (int m = 0; m < 4; ++m) {
                const size_t row = (size_t)pm * 256 + ai * 128 + wr * 64 + m * 16 + fr;
                const f32x4 a = *(const f32x4*)(SS + row * 8), b = *(const f32x4*)(SS + row * 8 + 4);
                pre[ai][m] = rsqrtf(((a[0] + a[1]) + (a[2] + a[3]) + (b[0] + b[1]) + (b[2] + b[3])) * (1.f / 512.f) + EPS);
                __builtin_amdgcn_sched_barrier(0);
            }
        if (t < 4) norm_rope_store<128>(acc, pm, wr, wc, fr, fq, wid, wBkn, nullptr, nullptr, false, pre, KB, 1536, (t * 2 + (wc >> 1)) * 192, 1, 0, xch);
        else {
            const int colw = (t - 4) * 256 + 32 * wc + 8 * fq;
#pragma unroll
            for (int ai = 0; ai < 2; ++ai)
#pragma unroll
                for (int m = 0; m < 4; ++m) {
                    const size_t row = (size_t)pm * 256 + ai * 128 + wr * 64 + m * 16 + fr;
#pragma unroll
                    for (int bj = 0; bj < 2; ++bj) store8(VB + row * 1024 + colw + bj * 128, acc[ai][bj][m][0] * pre[ai][m], acc[ai][bj][m][1] * pre[ai][m]);
                    __builtin_amdgcn_sched_barrier(0);
                }
        }
    }
};

struct EpiBr {
    static constexpr bool MID = true;
    const bf16_t* MRG; bf16_t* Y;
    __device__ __forceinline__ void mid(f32x4 (&acc)[2][2][4][2], const Unit& u, int i, int wr, int wc, int fr, int fq) const {
#pragma unroll
        for (int ai = 0; ai < 2; ++ai)
#pragma unroll
            for (int m = 0; m < 4; ++m) {
                const size_t row = (size_t)u.pm * 256 + ai * 128 + wr * 64 + m * 16 + fr;
#pragma unroll
                for (int bj = 0; bj < 2; ++bj) {
                    const int col = u.pn * 256 + bj * 128 + 32 * wc + 8 * fq;
                    const u32x4 a = *(const u32x4*)(MRG + row * 6144 + (i - 1) * 2048 + col), b = *(const u32x4*)(MRG + row * 6144 + i * 2048 + col);
#pragma unroll
                    for (int q = 0; q < 4; ++q) {
                        const float r0 = bf2f(a[q] & 0xffffu) * __builtin_amdgcn_rcpf(bf2f(b[q] & 0xffffu)), r1 = bf2f(a[q] >> 16) * __builtin_amdgcn_rcpf(bf2f(b[q] >> 16));
                        acc[ai][bj][m][q >> 1][(q & 1) * 2] *= r0; acc[ai][bj][m][q >> 1][(q & 1) * 2 + 1] *= r1;
                    }
                }
                __builtin_amdgcn_sched_barrier(0);
            }
    }
    __device__ __forceinline__ void operator()(const f32x4 (&acc)[2][2][4][2], const Unit& u, int wr, int wc, int fr, int fq, int wid) const {
#pragma unroll
        for (int ai = 0; ai < 2; ++ai)
#pragma unroll
            for (int m = 0; m < 4; ++m) {
                const size_t row = (size_t)u.pm * 256 + ai * 128 + wr * 64 + m * 16 + fr;
#pragma unroll
                for (int bj = 0; bj < 2; ++bj) {
                    const int col = u.pn * 256 + bj * 128 + 32 * wc + 8 * fq;
                    const u32x4 a = *(const u32x4*)(MRG + row * 6144 + 4096 + col);
                    f32x4 v0 = acc[ai][bj][m][0], v1 = acc[ai][bj][m][1];
                    v0[0] *= bf2f(a[0] & 0xffffu); v0[1] *= bf2f(a[0] >> 16); v0[2] *= bf2f(a[1] & 0xffffu); v0[3] *= bf2f(a[1] >> 16);
                    v1[0] *= bf2f(a[2] & 0xffffu); v1[1] *= bf2f(a[2] >> 16); v1[2] *= bf2f(a[3] & 0xffffu); v1[3] *= bf2f(a[3] >> 16);
                    store8(Y + row * 2048 + col, v0, v1);
                }
                __builtin_amdgcn_sched_barrier(0);
            }
    }
};

struct EpiOut {
    static constexpr bool MID = false;
    const float *xsrc, *csrc; float *xdst, *cdst; const float* mod;
    __device__ __forceinline__ void operator()(const f32x4 (&acc)[2][2][4][2], const Unit& u, int wr, int wc, int fr, int fq, int wid) const {
        const int pm = u.pm; const bool lat = pm < 64;
        const int mi = lat ? (pm >> 4) : 4;
        const float* src = lat ? xsrc : csrc - (size_t)MLAT * DM; float* dst = lat ? xdst : cdst - (size_t)MLAT * DM;
        const float* g = mod + mi * 6144 + 4096;
#pragma unroll
        for (int bj = 0; bj < 2; ++bj) {
            const int col = u.pn * 256 + bj * 128 + 32 * wc + 8 * fq;
            const f32x4 g0 = *(const f32x4*)(g + col), g1 = *(const f32x4*)(g + col + 4);
#pragma unroll
            for (int ai = 0; ai < 2; ++ai)
#pragma unroll
                for (int m = 0; m < 4; ++m) {
                    const size_t row = (size_t)pm * 256 + ai * 128 + wr * 64 + m * 16 + fr;
                    const f32x4 x0 = *(const f32x4*)(src + row * DM + col), x1 = *(const f32x4*)(src + row * DM + col + 4);
                    *(f32x4*)(dst + row * DM + col) = x0 + g0 * acc[ai][bj][m][0];
                    *(f32x4*)(dst + row * DM + col + 4) = x1 + g1 * acc[ai][bj][m][1];
                    __builtin_amdgcn_sched_barrier(0);
                }
        }
    }
};

namespace att {
#define SBAR() __builtin_amdgcn_sched_barrier(0)
__device__ __forceinline__ int crow(int r, int hi) { return (r & 3) + 8 * (r >> 2) + 4 * hi; }
template <int RB> __device__ __forceinline__ int kswz(int row, int colB) { const int x = (RB == 256) ? (row & 15) : ((row >> 1) & 7); return row * RB + (colB ^ (x << 4)); }
__device__ __forceinline__ int v_st(int k, int c) { const int kk = (k & ~0xC) | ((k & 4) << 1) | ((k & 8) >> 1); return ((kk >> 3) * 4 + (c >> 5)) * 512 + ((kk & 7) * 32 + (c & 31)) * 2; }
__device__ __forceinline__ int v_rd_base(int lane) { return ((lane & 3) << 3) | (((lane >> 2) & 3) << 6) | (((lane >> 4) & 1) << 5) | (((lane >> 5) & 1) << 8); }
constexpr int v_rd_off(int d0, int ks, int half) { return d0 * 512 + ks * 4096 + half * 2048; }
template <int OFF> __device__ __forceinline__ s16x4 tr_read(unsigned vb) {
    s16x4 r; asm volatile("ds_read_b64_tr_b16 %0, %1 offset:%2" : "=&v"(r) : "v"(vb), "i"(OFF) : "memory"); return r;
}
template <int D0> __device__ __forceinline__ void pv_one(f32x16& od, unsigned vb, bf16x8 pa0, bf16x8 pa1, bf16x8 pa2, bf16x8 pa3) {
    const s16x4 l0 = tr_read<v_rd_off(D0, 0, 0)>(vb), h0 = tr_read<v_rd_off(D0, 0, 1)>(vb), l1 = tr_read<v_rd_off(D0, 1, 0)>(vb), h1 = tr_read<v_rd_off(D0, 1, 1)>(vb);
    const s16x4 l2 = tr_read<v_rd_off(D0, 2, 0)>(vb), h2 = tr_read<v_rd_off(D0, 2, 1)>(vb), l3 = tr_read<v_rd_off(D0, 3, 0)>(vb), h3 = tr_read<v_rd_off(D0, 3, 1)>(vb);
    asm volatile("s_waitcnt lgkmcnt(0)" ::: "memory"); SBAR();
#define PK(L, H) (bf16x8){L[0], L[1], L[2], L[3], H[0], H[1], H[2], H[3]}
    od = __builtin_amdgcn_mfma_f32_32x32x16_bf16(pa0, PK(l0, h0), od, 0, 0, 0);
    od = __builtin_amdgcn_mfma_f32_32x32x16_bf16(pa1, PK(l1, h1), od, 0, 0, 0);
    od = __builtin_amdgcn_mfma_f32_32x32x16_bf16(pa2, PK(l2, h2), od, 0, 0, 0);
    od = __builtin_amdgcn_mfma_f32_32x32x16_bf16(pa3, PK(l3, h3), od, 0, 0, 0);
#undef PK
}
__device__ __forceinline__ void pv_d0(f32x16 (&o)[4], unsigned vb, bf16x8 pa0, bf16x8 pa1, bf16x8 pa2, bf16x8 pa3) {
    pv_one<0>(o[0], vb, pa0, pa1, pa2, pa3); pv_one<1>(o[1], vb, pa0, pa1, pa2, pa3); pv_one<2>(o[2], vb, pa0, pa1, pa2, pa3); pv_one<3>(o[3], vb, pa0, pa1, pa2, pa3);
}
__device__ __forceinline__ void partialSM(f32x16& p0, f32x16& p1) {
#pragma unroll
    for (int r = 0; r < 16; ++r) p0[r] = __builtin_amdgcn_exp2f(p0[r]);
}
__device__ __forceinline__ void finishSM(f32x16& p0, f32x16& p1, float& l_reg, bf16x8& pa0, bf16x8& pa1, bf16x8& pa2, bf16x8& pa3) {
#pragma unroll
    for (int r = 0; r < 16; ++r) p1[r] = __builtin_amdgcn_exp2f(p1[r]);
    float ps = 0;
#pragma unroll
    for (int r = 0; r < 16; ++r) ps += p0[r];
#pragma unroll
    for (int r = 0; r < 16; ++r) ps += p1[r];
    { auto rr = __builtin_amdgcn_permlane32_swap(__float_as_uint(ps), __float_as_uint(ps), false, false);
      ps = __uint_as_float(rr[0]) + __uint_as_float(rr[1]); }
    l_reg += ps;
#define PK4(P, BASE, OUT) do { unsigned a0 = cvt_pk_bf16(P[BASE + 0], P[BASE + 1]), a1 = cvt_pk_bf16(P[BASE + 2], P[BASE + 3]);   \
    unsigned b0 = cvt_pk_bf16(P[BASE + 4], P[BASE + 5]), b1 = cvt_pk_bf16(P[BASE + 6], P[BASE + 7]);                              \
    auto r0 = __builtin_amdgcn_permlane32_swap(a0, b0, false, false); auto r1 = __builtin_amdgcn_permlane32_swap(a1, b1, false, false); \
    u32x4 w = {r0[0], r1[0], r0[1], r1[1]}; OUT = *reinterpret_cast<bf16x8*>(&w); } while (0)
    PK4(p0, 0, pa0); PK4(p0, 8, pa1); PK4(p1, 0, pa2); PK4(p1, 8, pa3);
#undef PK4
}
template <int DQK>
__device__ __forceinline__ void qkt(f32x16& p0, f32x16& p1, const LAS char* Ks, const bf16x8 (&qr)[DQK / 16], int r32, int hi, float nMB) {
    constexpr int RB = DQK * 2;
#pragma unroll
    for (int r = 0; r < 16; ++r) { p0[r] = nMB; p1[r] = nMB; }
#pragma unroll
    for (int d0 = 0; d0 < DQK / 16; ++d0) { const int cb = (d0 * 16 + hi * 8) * 2;
        const bf16x8 b0 = *(const LAS bf16x8*)(Ks + kswz<RB>(r32, cb));
        const bf16x8 b1 = *(const LAS bf16x8*)(Ks + kswz<RB>(32 + r32, cb));
        p0 = __builtin_amdgcn_mfma_f32_32x32x16_bf16(b0, qr[d0], p0, 0, 0, 0);
        p1 = __builtin_amdgcn_mfma_f32_32x32x16_bf16(b1, qr[d0], p1, 0, 0, 0);
        if (QKT_GRP > 0 && (d0 % QKT_GRP) == QKT_GRP - 1 && d0 + 1 < DQK / 16) SBAR(); }
}
constexpr int V_BYTES = 64 * 128 * 2, K_OFF = 3 * V_BYTES, K_STRIDE = 64 * 192 * 2, LI_OFF = K_OFF + 3 * K_STRIDE;

template <int DQK, bool DOUBLE>
__device__ __forceinline__ void attn_pass(const bf16_t* __restrict__ Q, int ldq, const bf16_t* __restrict__ Kg, int ldk, const bf16_t* __restrict__ Vg, int ldv,
                                          int rowc, int rowl, int NT, float nMB, f32x16 (&o)[4], float& l_reg, LAS char* lds, int tid) {
    constexpr int RB = DQK * 2, NCH = DQK / 8, NLD = NCH / 8;
    const int wid = __builtin_amdgcn_readfirstlane(tid >> 6), lane = tid & 63, r32 = lane & 31, hi = lane >> 5;
    LAS char* V_lds = lds; LAS char* K_lds = lds + K_OFF;
    bf16x8 qr[DQK / 16];
    { const bf16_t* Qw = Q + (size_t)(wid * 32 + r32) * ldq + hi * 8;
#pragma unroll
      for (int d0 = 0; d0 < DQK / 16; ++d0) qr[d0] = *(const bf16x8*)(Qw + d0 * 16); }
#pragma unroll
    for (int d = 0; d < 4; ++d) o[d] = f32x16{};
    l_reg = 0.f;
    int vrow[2], vcol[2], krow[NLD], kcol[NLD];
#pragma unroll
    for (int i = 0; i < 2; ++i) { const int q = tid + 512 * i, sub = q >> 5, within = q & 31, kk = (sub >> 2) * 8 + (within >> 2);
        vrow[i] = (kk & ~0xC) | ((kk & 4) << 1) | ((kk & 8) >> 1); vcol[i] = (sub & 3) * 32 + (within & 3) * 8; }
#pragma unroll
    for (int i = 0; i < NLD; ++i) { const int q = tid + 512 * i, row = q / NCH, chp = q % NCH; const int x = (RB == 256) ? (row & 15) : ((row >> 1) & 7);
        krow[i] = row; kcol[i] = (chp ^ x) * 8; }
    const unsigned vb0 = (unsigned)(uintptr_t)V_lds + v_rd_base(lane);
#define KROW0(j) ((j) < 4 ? rowc + 64 * (j) : rowl + 64 * ((j) - 4))
#define DMA(j, b) do { const size_t _r0 = (size_t)KROW0(j); \
    _Pragma("unroll") for (int _i = 0; _i < 2; ++_i) __builtin_amdgcn_global_load_lds((const unsigned*)(Vg + (_r0 + vrow[_i]) * ldv + vcol[_i]), (LAS unsigned*)(V_lds + (b) * V_BYTES + wid * 1024 + _i * 8192), 16, 0, 0); \
    _Pragma("unroll") for (int _i = 0; _i < NLD; ++_i) __builtin_amdgcn_global_load_lds((const unsigned*)(Kg + (_r0 + krow[_i]) * ldk + kcol[_i]), (LAS unsigned*)(K_lds + (b) * K_STRIDE + wid * 1024 + _i * 8192), 16, 0, 0); } while (0)
#define VMW0() asm volatile("s_waitcnt vmcnt(0)" ::: "memory")
    bf16x8 pa0, pa1, pa2, pa3;
    __syncthreads();
    DMA(0, 0); DMA(1, 1); VMW0(); __syncthreads();
    if constexpr (!DOUBLE) {
        f32x16 p0, p1;
        DMA(2, 2);
        int bc = 0, bn = 1, bf = 2;
        for (int j = 0; j < NT; ++j) {
            SBAR(); qkt<DQK>(p0, p1, K_lds + bc * K_STRIDE, qr, r32, hi, nMB);
            partialSM(p0, p1); finishSM(p0, p1, l_reg, pa0, pa1, pa2, pa3); SBAR();
            pv_d0(o, vb0 + bc * V_BYTES, pa0, pa1, pa2, pa3);
            if (j + 1 < NT) { VMW0(); __syncthreads(); if (j + 3 < NT) DMA(j + 3, bc); }
            { const int _t = bc; bc = bn; bn = bf; bf = _t; }
        }
    } else {
    f32x16 pA0, pA1, pB0, pB1;
    qkt<DQK>(pA0, pA1, K_lds, qr, r32, hi, nMB); partialSM(pA0, pA1);
    DMA(2, 2);
    int bp = 0, bc = 1, bn = 2;
#define STEP(j, PC0, PC1, PP0, PP1) do { \
        SBAR(); qkt<DQK>(PC0, PC1, K_lds + bc * K_STRIDE, qr, r32, hi, nMB); \
        finishSM(PP0, PP1, l_reg, pa0, pa1, pa2, pa3); SBAR(); \
        pv_d0(o, vb0 + bp * V_BYTES, pa0, pa1, pa2, pa3); partialSM(PC0, PC1); \
        if ((j) + 1 < NT) { VMW0(); __syncthreads(); if ((j) + 2 < NT) DMA((j) + 2, bp); } \
        { const int _t = bp; bp = bc; bc = bn; bn = _t; } } while (0)
    for (int j = 1; j < NT; j += 2) {
        STEP(j, pB0, pB1, pA0, pA1);
        if (j + 1 < NT) STEP(j + 1, pA0, pA1, pB0, pB1);
    }
    finishSM(pB0, pB1, l_reg, pa0, pa1, pa2, pa3); SBAR();
    pv_d0(o, vb0 + bp * V_BYTES, pa0, pa1, pa2, pa3);
    }
#undef KROW0
#undef DMA
#undef VMW0
#undef STEP
}
__device__ __forceinline__ void row_recip(float l_reg, float (&rli)[16], LAS float* li, int r32, int hi) {
    if (hi == 0) li[r32] = l_reg;
    asm volatile("s_waitcnt lgkmcnt(0)" ::: "memory");
#pragma unroll
    for (int r = 0; r < 16; ++r) rli[r] = __builtin_amdgcn_rcpf(li[crow(r, hi)]);
    asm volatile("s_waitcnt lgkmcnt(0)" ::: "memory");
}
}

struct AttnBufs { const bf16_t *QA, *KA, *VA, *QB, *KB, *VB, *QC, *KC, *VC, *GATE; bf16_t* BR; float* SCR; const float* lamv; const float* subln; float lam_init; };

template <bool SUBLN>
__device__ __forceinline__ void attn_out(const AttnBufs& T, f32x16 (&o)[4], int type, int h, size_t orow0, LAS char* lds, int wid, int lane, int r32, int hi) {
    __syncthreads();
    LAS float* stg = (LAS float*)(lds + wid * 16896);
#pragma unroll
    for (int d0 = 0; d0 < 4; ++d0)
#pragma unroll
        for (int r = 0; r < 16; ++r) stg[att::crow(r, hi) * 132 + d0 * 32 + r32] = o[d0][r];
    asm volatile("s_waitcnt lgkmcnt(0)" ::: "memory");
    const int rr = lane >> 5, c4 = (lane & 31) * 4;
    const int col = type * 1024 + h * 128 + c4;
    f32x4 wsub = {1.f, 1.f, 1.f, 1.f};
    if (SUBLN) { wsub = *(const f32x4*)(T.subln + c4) * (1.f - T.lam_init); }
    const bf16_t* gp = T.GATE + (orow0 + rr) * 3072 + col; bf16_t* op = T.BR + (orow0 + rr) * 3072 + col;
#pragma unroll 4
    for (int i = 0; i < 16; ++i) {
        f32x4 v = *(const LAS f32x4*)(stg + (2 * i + rr) * 132 + c4);
        const u32x2 gg = *(const u32x2*)(gp + (size_t)i * 2 * 3072);
        if (SUBLN) {
            float s = (v[0] * v[0] + v[1] * v[1]) + (v[2] * v[2] + v[3] * v[3]);
            s += __shfl_xor(s, 1); s += __shfl_xor(s, 2); s += __shfl_xor(s, 4); s += __shfl_xor(s, 8); s += __shfl_xor(s, 16);
            v = v * (rsqrtf(s * (1.f / 128.f) + EPS)) * wsub;
        }
        u32x2 w; w.x = cvt_pk_bf16(v[0] * bf2f(gg.x & 0xffffu), v[1] * bf2f(gg.x >> 16)); w.y = cvt_pk_bf16(v[2] * bf2f(gg.y & 0xffffu), v[3] * bf2f(gg.y >> 16));
        *(u32x2*)(op + (size_t)i * 2 * 3072) = w;
    }
}

__device__ __forceinline__ void attn_item(const AttnBufs& T, int type, int b, int h, int qrow0, int NT, LAS char* lds, int tid_) {
    asm volatile("" : "+v"(tid_));
    const int tid = tid_, wid = __builtin_amdgcn_readfirstlane(tid >> 6), lane = tid & 63, r32 = lane & 31, hi = lane >> 5;
    const int rowc = MLAT + b * CTXL, rowl = b * SEQ;
    LAS float* li = (LAS float*)(lds + att::LI_OFF) + wid * 64;
    constexpr float LOG2E = 1.4426950408889634f;
    const size_t orow0 = (size_t)qrow0 + wid * 32;
    if (type == 0 && (MK_ATYPE & 1)) {
        f32x16 o[4]; float l_reg; float rli[16];
        att::attn_pass<128, ATT_DBL>(T.QA + (size_t)qrow0 * 1024 + h * 128, 1024, T.KA + (h >> 2) * 128, 256, T.VA + (h >> 2) * 128, 256, rowc, rowl, NT,
                            T.lamv[1], o, l_reg, lds, tid);
        att::row_recip(l_reg, rli, li, r32, hi);
#pragma unroll
        for (int d0 = 0; d0 < 4; ++d0)
#pragma unroll
            for (int r = 0; r < 16; ++r) o[d0][r] *= rli[r];
        attn_out<false>(T, o, 0, h, orow0, lds, wid, lane, r32, hi);
    } else if (type == 1 && (MK_ATYPE & 2)) {
        f32x16 o[4]; float l_reg; float rli[16];
        att::attn_pass<192, false>(T.QB + (size_t)qrow0 * 1536 + h * 192, 1536, T.KB + h * 192, 1536, T.VB + h * 128, 1024, rowc, rowl, NT,
                            T.lamv[2], o, l_reg, lds, tid);
        att::row_recip(l_reg, rli, li, r32, hi);
#pragma unroll
        for (int d0 = 0; d0 < 4; ++d0)
#pragma unroll
            for (int r = 0; r < 16; ++r) o[d0][r] *= rli[r];
        attn_out<false>(T, o, 1, h, orow0, lds, wid, lane, r32, hi);
    } else if (MK_ATYPE & 4) {
        f32x16 o[4]; float l_reg; float rli[16];
        att::attn_pass<64, ATT_DBL>(T.QC + (size_t)qrow0 * 1024 + h * 128, 1024, T.KC + h * 128, 1024, T.VC + h * 128, 1024, rowc, rowl, NT,
                           T.lamv[3], o, l_reg, lds, tid);
        att::row_recip(l_reg, rli, li, r32, hi);
        f32x4* scr = (f32x4*)(T.SCR + ((size_t)blockIdx.x * 512 + tid) * 64);
#pragma unroll
        for (int d0 = 0; d0 < 4; ++d0)
#pragma unroll
            for (int q = 0; q < 4; ++q) scr[d0 * 4 + q] = (f32x4){o[d0][q * 4] * rli[q * 4], o[d0][q * 4 + 1] * rli[q * 4 + 1], o[d0][q * 4 + 2] * rli[q * 4 + 2], o[d0][q * 4 + 3] * rli[q * 4 + 3]};
        att::attn_pass<64, ATT_DBL>(T.QC + (size_t)qrow0 * 1024 + h * 128 + 64, 1024, T.KC + h * 128 + 64, 1024, T.VC + h * 128, 1024, rowc, rowl, NT,
                           T.lamv[3], o, l_reg, lds, tid);
        att::row_recip(l_reg, rli, li, r32, hi);
        const float lam = T.lamv[0];
#pragma unroll
        for (int d0 = 0; d0 < 4; ++d0)
#pragma unroll
            for (int q = 0; q < 4; ++q) { const f32x4 a = scr[d0 * 4 + q];
#pragma unroll
                for (int j = 0; j < 4; ++j) o[d0][q * 4 + j] = a[j] - lam * (o[d0][q * 4 + j] * rli[q * 4 + j]); }
        attn_out<true>(T, o, 2, h, orow0, lds, wid, lane, r32, hi);
    }
}

__device__ __forceinline__ void transpose_item(const float* __restrict__ W, int ldw, int k0, int srccol4, const float* __restrict__ kscale,
                                               bf16_t* __restrict__ WT, int ldt, int n0, int kdst0, LAS float* scr, int lane) {
    const int ks = lane >> 4, n4 = (lane & 15) * 4;
#pragma unroll 8
    for (int i = 0; i < 16; ++i) { const int kk = 4 * i + ks;
        f32x4 v = srccol4 >= 0 ? *(const f32x4*)(W + (size_t)(k0 + kk) * ldw + srccol4) : (f32x4){0.f, 0.f, 0.f, 0.f};
        if (kscale) v = v * kscale[k0 + kk];
        LAS float* d = scr + kk * 65 + n4; d[0] = v[0]; d[1] = v[1]; d[2] = v[2]; d[3] = v[3]; }
    asm volatile("s_waitcnt lgkmcnt(0)" ::: "memory");
    const int nn = lane & 7, c = lane >> 3;
#pragma unroll
    for (int j = 0; j < 8; ++j) { const int n = nn + 8 * j; const LAS float* s = scr + (8 * c) * 65 + n;
        u32x4 o; o.x = cvt_pk_bf16(s[0 * 65], s[1 * 65]); o.y = cvt_pk_bf16(s[2 * 65], s[3 * 65]); o.z = cvt_pk_bf16(s[4 * 65], s[5 * 65]); o.w = cvt_pk_bf16(s[6 * 65], s[7 * 65]);
        *(u32x4*)(WT + (size_t)(n0 + n) * ldt + kdst0 + k0 + 8 * c) = o; }
    asm volatile("s_waitcnt lgkmcnt(0)" ::: "memory");
}
__device__ const float INVF32[16] = {1.000000000e+00f, 5.623413324e-01f, 3.162277639e-01f, 1.778279394e-01f, 1.000000015e-01f, 5.623413250e-02f, 3.162277490e-02f, 1.778279431e-02f,
    9.999999776e-03f, 5.623413250e-03f, 3.162277630e-03f, 1.778279431e-03f, 1.000000047e-03f, 5.623413017e-04f, 3.162277571e-04f, 1.778279402e-04f};
__device__ const float INVF64[32] = {1.000000000e+00f, 7.498942614e-01f, 5.623413324e-01f, 4.216965139e-01f, 3.162277639e-01f, 2.371373773e-01f, 1.778279394e-01f, 1.333521307e-01f,
    1.000000015e-01f, 7.498941571e-02f, 5.623413250e-02f, 4.216965288e-02f, 3.162277490e-02f, 2.371373773e-02f, 1.778279431e-02f, 1.333521493e-02f, 9.999999776e-03f, 7.498941850e-03f,
    5.623413250e-03f, 4.216964822e-03f, 3.162277630e-03f, 2.371373586e-03f, 1.778279431e-03f, 1.333521446e-03f, 1.000000047e-03f, 7.498942432e-04f, 5.623413017e-04f, 4.216965172e-04f,
    3.162277571e-04f, 2.371373703e-04f, 1.778279402e-04f, 1.333521504e-04f};
__device__ __forceinline__ void sincos_d(double x, float& s, float& c) {
    const double twopi = 6.283185307179586476925;
    const double k = __builtin_rint(x / twopi), r = x - k * twopi, r2 = r * r;
    double st = r, ct = 1.0, ss = r, cs = 1.0;
    for (int n = 1; n <= 16; ++n) { ct *= -r2 / (double)((2 * n - 1) * (2 * n)); st *= -r2 / (double)((2 * n) * (2 * n + 1)); cs += ct; ss += st; }
    s = (float)ss; c = (float)cs;
}
__device__ __forceinline__ float absmax_n(const float* w, int n) { float m = 0.f; for (int i = 0; i < n; ++i) m = fmaxf(m, fabsf(w[i])); return m; }

typedef unsigned v4u_unused_t;
#define XB_TMO      128
#define XB_XCNT(j)  (256  + 64 * (j))
#define XB_XSUB(j)  (1280 + 64 * (j))
#define XB_XGEN(j)  (2304 + 64 * (j))
#define XB_TOP      3328
#define XB_TOPGEN   3392
#define XCD_BAR_WORDS 3456
#define XB_SPIN_CAP (1u << 18)

__device__ __forceinline__ unsigned xb_ld(unsigned* p)              { return __hip_atomic_load(p, __ATOMIC_RELAXED, __HIP_MEMORY_SCOPE_AGENT); }
__device__ __forceinline__ unsigned xb_add(unsigned* p, unsigned v) { return __hip_atomic_fetch_add(p, v, __ATOMIC_RELAXED, __HIP_MEMORY_SCOPE_AGENT); }
__device__ __forceinline__ unsigned xb_xcc_id() { return (unsigned)__builtin_amdgcn_s_getreg((3 << 11) | 20) & 0xFu; }
#define XB_SPIN(cond, bar) do { unsigned _sp = 0; while (cond) { __builtin_amdgcn_s_sleep(1); \
    if ((++_sp & 255u) == 0u) { if (xb_ld(&(bar)[XB_TMO])) break; if (_sp > XB_SPIN_CAP) { atomicAdd(&(bar)[XB_TMO], 1u); break; } } } } while (0)

struct XcdBarrier {
    unsigned* bar; unsigned x;
    volatile LAS unsigned* st;
};

__device__ __forceinline__ XcdBarrier xcd_barrier_post(unsigned* bar, volatile LAS unsigned* st) {
    XcdBarrier b; b.bar = bar; b.x = xb_xcc_id(); b.st = st;
    if (threadIdx.x == 0) (void)xb_add(&bar[XB_XCNT(b.x)], 1u);
    return b;
}
__device__ __forceinline__ void xcd_barrier_complete(unsigned* bar, unsigned x, unsigned& nloc, unsigned& nx) {
    const unsigned G = gridDim.x * gridDim.y * gridDim.z;
    unsigned sum, cnt, mine, sp = 0u;
    for (;;) {
        sum = 0u; cnt = 0u; mine = 0u;
#pragma unroll
        for (unsigned j = 0; j < 16; ++j) { const unsigned c = xb_ld(&bar[XB_XCNT(j)]); sum += c; cnt += (c > 0u) ? 1u : 0u; mine = (j == x) ? c : mine; }
        if (sum == G) break;
        __builtin_amdgcn_s_sleep(1);
        if ((++sp & 255u) == 0u) { if (xb_ld(&bar[XB_TMO])) break; if (sp > XB_SPIN_CAP) { atomicAdd(&bar[XB_TMO], 1u); break; } }
    }
    nloc = mine > 0u ? mine : 1u; nx = cnt > 0u ? cnt : 1u;
}

__device__ __forceinline__ void xcd_barrier(const XcdBarrier& b) {
    asm volatile("s_waitcnt vmcnt(0)" ::: "memory");
    __syncthreads();
    if (threadIdx.x == 0) {
        unsigned* bar = b.bar;
        __builtin_amdgcn_s_waitcnt(0);
        unsigned nloc = b.st[0], nx = b.st[1];
        if (nloc == 0u) { xcd_barrier_complete(bar, b.x, nloc, nx); b.st[0] = nloc; b.st[1] = nx; }
        const unsigned old = xb_add(&bar[XB_XSUB(b.x)], 1u);
        const unsigned gen = old / nloc;
        if (old + 1u == (gen + 1u) * nloc) {
            __builtin_amdgcn_fence(__ATOMIC_RELEASE, "agent");
            asm volatile("s_waitcnt vmcnt(0)" ::: "memory");
            const unsigned og = xb_add(&bar[XB_TOP], 1u);
            const unsigned tg = og / nx;
            if (og + 1u == (tg + 1u) * nx) xb_add(&bar[XB_TOPGEN], 1u);
            else XB_SPIN(xb_ld(&bar[XB_TOPGEN]) == tg, bar);
            __builtin_amdgcn_fence(__ATOMIC_ACQUIRE, "agent");
            xb_add(&bar[XB_XGEN(b.x)], 1u);
            asm volatile("s_waitcnt vmcnt(0)" ::: "memory");
        } else {
            XB_SPIN(xb_ld(&bar[XB_XGEN(b.x)]) == gen, bar);
            __builtin_amdgcn_fence(__ATOMIC_ACQUIRE, "agent");
            asm volatile("s_waitcnt vmcnt(0)" ::: "memory");
        }
    }
    __syncthreads();
}

__device__ __forceinline__ void p1_row(int row, const float* __restrict__ xsrc, const float* __restrict__ csrc, const float* __restrict__ modl, const float* __restrict__ nw,
                                       bf16_t* __restrict__ H, int lane) {
    const bool lat = row < MLAT; const int mi = lat ? (row >> 12) : 4;
    const f32x4* xr = (const f32x4*)(lat ? xsrc + (size_t)row * DM : csrc + (size_t)(row - MLAT) * DM) + lane;
    f32x4 v[8]; float s = 0.f;
#pragma unroll
    for (int j = 0; j < 8; ++j) { v[j] = xr[64 * j]; s += (v[j][0] * v[j][0] + v[j][1] * v[j][1]) + (v[j][2] * v[j][2] + v[j][3] * v[j][3]); }
    const float rinv = rsqrtf(wave_sum(s) * (1.f / DM) + EPS);
    const f32x4* sh = (const f32x4*)(modl + mi * 6144) + lane; const f32x4* scl = (const f32x4*)(modl + mi * 6144 + DM) + lane; const f32x4* nwp = (const f32x4*)nw + lane;
    u32x2* o8 = (u32x2*)(H + (size_t)row * DM) + lane;
#pragma unroll
    for (int j = 0; j < 8; ++j) { const f32x4 y = v[j] * rinv * nwp[64 * j] * (scl[64 * j] + 1.f) + sh[64 * j];
        u32x2 w; w.x = cvt_pk_bf16(y[0], y[1]); w.y = cvt_pk_bf16(y[2], y[3]); o8[64 * j] = w; }
}

__device__ __forceinline__ void p1_row2(int rowA, int rowB, const float* __restrict__ xsrc, const float* __restrict__ csrc, const float* __restrict__ modl,
                                        const float* __restrict__ nw, bf16_t* __restrict__ H, int lane) {
    if (rowB < 0) { p1_row(rowA, xsrc, csrc, modl, nw, H, lane); return; }
    const bool latA = rowA < MLAT, latB = rowB < MLAT; const int miA = latA ? (rowA >> 12) : 4, miB = latB ? (rowB >> 12) : 4;
    const f32x4* xa = (const f32x4*)(latA ? xsrc + (size_t)rowA * DM : csrc + (size_t)(rowA - MLAT) * DM) + lane;
    const f32x4* xb = (const f32x4*)(latB ? xsrc + (size_t)rowB * DM : csrc + (size_t)(rowB - MLAT) * DM) + lane;
    f32x4 va[8], vb[8]; float sa = 0.f, sb = 0.f;
#pragma unroll
    for (int j = 0; j < 8; ++j) { va[j] = xa[64 * j]; vb[j] = xb[64 * j]; }
#pragma unroll
    for (int j = 0; j < 8; ++j) { sa += (va[j][0] * va[j][0] + va[j][1] * va[j][1]) + (va[j][2] * va[j][2] + va[j][3] * va[j][3]);
                                  sb += (vb[j][0] * vb[j][0] + vb[j][1] * vb[j][1]) + (vb[j][2] * vb[j][2] + vb[j][3] * vb[j][3]); }
    const float ra = rsqrtf(wave_sum(sa) * (1.f / DM) + EPS), rb = rsqrtf(wave_sum(sb) * (1.f / DM) + EPS);
    const f32x4* nwp = (const f32x4*)nw + lane;
    const f32x4* sha = (const f32x4*)(modl + miA * 6144) + lane; const f32x4* sca = (const f32x4*)(modl + miA * 6144 + DM) + lane;
    const f32x4* shb = (const f32x4*)(modl + miB * 6144) + lane; const f32x4* scb = (const f32x4*)(modl + miB * 6144 + DM) + lane;
    u32x2* oa = (u32x2*)(H + (size_t)rowA * DM) + lane; u32x2* ob = (u32x2*)(H + (size_t)rowB * DM) + lane;
#pragma unroll
    for (int j = 0; j < 8; ++j) { const f32x4 w4 = nwp[64 * j];
        const f32x4 ya = va[j] * ra * w4 * (sca[64 * j] + 1.f) + sha[64 * j], yb = vb[j] * rb * w4 * (scb[64 * j] + 1.f) + shb[64 * j];
        u32x2 wa, wb; wa.x = cvt_pk_bf16(ya[0], ya[1]); wa.y = cvt_pk_bf16(ya[2], ya[3]); wb.x = cvt_pk_bf16(yb[0], yb[1]); wb.y = cvt_pk_bf16(yb[2], yb[3]);
        oa[64 * j] = wa; ob[64 * j] = wb; }
}

struct Args { const float* in[29]; float* out; unsigned char* ws; int ph_lo, ph_hi, coop, pad; };

__global__ void __launch_bounds__(512, 2) mega_fwd(Args args) {
    extern __shared__ __attribute__((aligned(16))) unsigned char lds_raw[];
    LAS unsigned char* lds = (LAS unsigned char*)lds_raw;
    const int G = gridDim.x, bx = blockIdx.x;
    const int vcu = (G % 8 == 0) ? (bx % 8) * (G / 8) + bx / 8 : bx;
    unsigned char* ws = args.ws;
    float* MOD = (float*)(ws + WS_MOD);
    float* TC64 = (float*)(ws + WS_TC64); float* TS64 = (float*)(ws + WS_TS64); float* TC128 = (float*)(ws + WS_TC128); float* TS128 = (float*)(ws + WS_TS128);
    float* LAM = (float*)(ws + WS_LAM);
    bf16_t* WIN = (bf16_t*)(ws + WS_WIN); bf16_t* WUP = (bf16_t*)(ws + WS_WUP); bf16_t* WBR = (bf16_t*)(ws + WS_WBR); bf16_t* WOUT = (bf16_t*)(ws + WS_WOUT);
    bf16_t* H = (bf16_t*)(ws + WS_H); bf16_t* QA = (bf16_t*)(ws + WS_QA); bf16_t* KA = (bf16_t*)(ws + WS_KA); bf16_t* VA = (bf16_t*)(ws + WS_VA);
    bf16_t* QB = (bf16_t*)(ws + WS_QB); bf16_t* KB = (bf16_t*)(ws + WS_KB); bf16_t* CKV = (bf16_t*)(ws + WS_CKV); bf16_t* VB = (bf16_t*)(ws + WS_VB);
    bf16_t* QC = (bf16_t*)(ws + WS_QC); bf16_t* KC = (bf16_t*)(ws + WS_KC); bf16_t* VC = (bf16_t*)(ws + WS_VC);
    bf16_t* GATE = (bf16_t*)(ws + WS_GATE); bf16_t* MRG = (bf16_t*)(ws + WS_MRG); bf16_t* BR = (bf16_t*)(ws + WS_BR); bf16_t* Y = (bf16_t*)(ws + WS_Y);
    float* SS = (float*)(ws + WS_SS); float* CTXW = (float*)(ws + WS_CTXW); float* SCR = (float*)(ws + WS_SCR);
    LAS float* xch = (LAS float*)(lds + XCH_OFF);
    volatile LAS unsigned* bst = (volatile LAS unsigned*)(lds + XCH_OFF + 4096);
    if (threadIdx.x < 2) bst[threadIdx.x] = 0u;
    __syncthreads();
    XcdBarrier bar = xcd_barrier_post((unsigned*)(ws + WS_BAR), bst);

    for (int ph = args.ph_lo; ph < args.ph_hi; ++ph) {
        int tid = threadIdx.x; asm volatile("" : "+v"(tid));
        const int lane = tid & 63, wave = __builtin_amdgcn_readfirstlane(tid >> 6);
        if (ph == 0 && (MK_MASK & 1)) {
            {
                LAS float* sc = (LAS float*)lds;
                LAS float* red = (LAS float*)(lds + 65536);
                for (int i = tid; i < 5 * DM; i += 512) { const float v = i < 4 * DM ? args.in[1][i] : args.in[3][i - 4 * DM]; sc[i] = silu_f(v); }
                __syncthreads();
                for (int it = bx; it < DEPTH * 96; it += G) {
                    const int l = it / 96, n0 = (it % 96) * 64;
                    const float* W = args.in[5] + (size_t)l * DM * 6144 + n0 + lane;
                    float a0 = 0.f, a1 = 0.f, a2 = 0.f, a3 = 0.f, a4 = 0.f;
                    const int kb = wave * 256;
#pragma unroll 8
                    for (int k = 0; k < 256; ++k) { const float wv = W[(size_t)(kb + k) * 6144];
                        a0 += sc[kb + k] * wv; a1 += sc[DM + kb + k] * wv; a2 += sc[2 * DM + kb + k] * wv; a3 += sc[3 * DM + kb + k] * wv; a4 += sc[4 * DM + kb + k] * wv; }
                    red[(wave * 5 + 0) * 64 + lane] = a0; red[(wave * 5 + 1) * 64 + lane] = a1; red[(wave * 5 + 2) * 64 + lane] = a2; red[(wave * 5 + 3) * 64 + lane] = a3; red[(wave * 5 + 4) * 64 + lane] = a4;
                    __syncthreads();
                    if (tid < 320) { const int i = tid >> 6; float s = 0.f;
                        for (int w8 = 0; w8 < 8; ++w8) s += red[(w8 * 5 + i) * 64 + lane];
                        MOD[((size_t)l * 5 + i) * 6144 + n0 + lane] = s + args.in[6][(size_t)l * 6144 + n0 + lane]; }
                    __syncthreads();
                }
            }
            if (bx == 1 % G) {
                for (int i = tid; i < 64 * 16; i += 512) { const int pos = i >> 4, f = i & 15; const float ang = (float)pos * INVF32[f]; float s, c; sincos_d((double)ang, s, c); TC64[i] = c; TS64[i] = s; }
                for (int i = tid; i < 64 * 32; i += 512) { const int pos = i >> 5, f = i & 31; const float ang = (float)pos * INVF64[f]; float s, c; sincos_d((double)ang, s, c); TC128[i] = c; TS128[i] = s; }
            }
            if (bx == 2 % G && tid < DEPTH) {
                const int l = tid;
                float s1 = 0.f, s2 = 0.f;
                for (int i = 0; i < 64; ++i) { s1 += args.in[20][l * 64 + i] * args.in[21][l * 64 + i]; s2 += args.in[22][l * 64 + i] * args.in[23][l * 64 + i]; }
                const float lam_init = 0.8f - 0.6f * expf(-0.3f * (float)l);
                LAM[l * 4 + 0] = expf(s1) - expf(s2) + lam_init;
                const float mAq = absmax_n(args.in[9] + l * 128, 128), mAk = absmax_n(args.in[10] + l * 128, 128);
                const float mBqn = absmax_n(args.in[11] + l * 128, 128), mBqr = absmax_n(args.in[12] + l * 64, 64), mBkn = absmax_n(args.in[16] + l * 128, 128), mBkr = absmax_n(args.in[17] + l * 64, 64);
                const float mCq = absmax_n(args.in[18] + l * 64, 64), mCk = absmax_n(args.in[19] + l * 64, 64);
                const float L2E = 1.4426950408889634f;
                LAM[l * 4 + 1] = -(sqrtf(128.f) * mAq * mAk) * L2E;
                LAM[l * 4 + 2] = -(sqrtf(128.f * mBqn * mBqn + 64.f * mBqr * mBqr) * sqrtf(128.f * mBkn * mBkn + 64.f * mBkr * mBkr) * 0.07216878364870323f) * L2E;
                LAM[l * 4 + 3] = -(8.f * mCq * mCk) * L2E;
            }
            __syncthreads();
            {
                LAS float* scr = (LAS float*)(lds + wave * 16640);
                const int gw = vcu * 8 + wave, NGW = G * 8;
                constexpr int I_IN = 32 * (NIN / 64), I_UP = 8 * 32, I_BR = 3 * 16 * 32, I_OUT = 32 * 32, I_L = I_IN + I_UP + I_BR + I_OUT;
                const int n4 = (lane & 15) * 4;
                for (int it = gw; it < DEPTH * I_L; it += NGW) {
                    const int l = it / I_L; int r = it % I_L;
                    if (r < I_IN) { const int nb = r % (NIN / 64), kb = r / (NIN / 64); const int n0 = nb * 64;
                        transpose_item(args.in[7] + (size_t)l * DM * INC, INC, kb * 64, in_src_col(n0 + n4), nullptr, WIN + (size_t)l * NIN * DM, DM, n0, 0, scr, lane); continue; }
                    r -= I_IN;
                    if (r < I_UP) { const int nb = r % 32, kb = r / 32; const int n0 = nb * 64; const int sc_ = up_src_col(n0 + n4);
                        const float* W = (sc_ < 1024 ? args.in[14] : args.in[15]) + (size_t)l * 512 * 1024;
                        transpose_item(W, 1024, kb * 64, sc_ & 1023, args.in[13] + l * 512, WUP + (size_t)l * 2048 * 512, 512, n0, 0, scr, lane); continue; }
                    r -= I_UP;
                    if (r < I_BR) { const int br = r / (16 * 32), r2 = r % (16 * 32); const int nb = r2 % 32, kb = r2 / 32; const int n0 = nb * 64;
                        transpose_item(args.in[25 + br] + (size_t)l * 1024 * DM, DM, kb * 64, n0 + n4, nullptr, WBR + (size_t)l * 2048 * 3072, 3072, n0, br * 1024, scr, lane); continue; }
                    r -= I_BR;
                    { const int nb = r % 32, kb = r / 32; const int n0 = nb * 64;
                      transpose_item(args.in[28] + (size_t)l * DM * DM, DM, kb * 64, n0 + n4, nullptr, WOUT + (size_t)l * DM * DM, DM, n0, 0, scr, lane); }
                }
            }
        } else {
            const int l = (ph == 1) ? 0 : (ph - 2) / 3, st_ = (ph == 1) ? 0 : 1 + (ph - 2) % 3, st = (st_ >= 2) ? st_ + 1 : st_;
            const float* xsrc = (l == 0) ? args.in[0] : args.out;
            const float* csrc = (l == 0) ? args.in[2] : CTXW;
            const float* modl = MOD + (size_t)l * 5 * 6144;
            const int Mrows = (l == DEPTH - 1) ? MLAT : MTOT;
            if (st == 0 && (MK_MASK & 2)) {
                const float* nw = args.in[4] + (size_t)l * DM;
                for (int row = bx * 8 + wave; row < MTOT; row += G * 16) { const int rb = row + G * 8; p1_row2(row, rb < MTOT ? rb : -1, xsrc, csrc, modl, nw, H, lane); }
            } else if (st == 1 && (MK_MASK & 4)) {
                pg8::Gemm g{H, WIN + (size_t)l * NIN * DM, MTOT, NIN, DM}; pg8::StaticOrder S; S.init(MTOT, NIN, G, bx);
                EpiIn E{QA, KA, VA, QB, KB, CKV, QC, KC, VC, GATE, MRG, SS,
                        args.in[9] + l * 128, args.in[10] + l * 128, args.in[11] + l * 128, args.in[12] + l * 64, args.in[17] + l * 64, args.in[18] + l * 64, args.in[19] + l * 64,
                        args.in[8] + (size_t)l * 6144, TC64, TS64, TC128, TS128, xch};
                pg8::gemm_phase<EpiIn>(lds, g, S, E, tid);
            } else if (st == 3 && (MK_MASK & 16)) {
                unsigned* UPC = (unsigned*)(ws + WS_CNT) + (size_t)(2 * DEPTH * 68 + l) * 64;
                const bool merged = (G == 256) && args.coop;
                {
                    pg8::Gemm g{CKV, WUP + (size_t)l * 2048 * 512, MTOT, 2048, 512}; pg8::StaticOrder S; S.init(MTOT, 2048, G, bx);
                    EpiUp E{KB, VB, SS, args.in[16] + l * 128, xch};
                    pg8::gemm_phase<EpiUp>(lds, g, S, E, tid);
                    if (merged) {
                        if (threadIdx.x == 0) {
                            __builtin_amdgcn_fence(__ATOMIC_RELEASE, "agent");
                            asm volatile("s_waitcnt vmcnt(0)" ::: "memory");
                            pg8::Unit u; unsigned n = 0; for (int i = 0; S.next(i, u); ++i) ++n;
                            __hip_atomic_fetch_add(UPC, n, __ATOMIC_RELAXED, __HIP_MEMORY_SCOPE_AGENT);
                        }
                    } else if (args.coop) xcd_barrier(bar);
                }
                AttnBufs T{QA, KA, VA, QB, KB, VB, QC, KC, VC, GATE, BR, SCR, LAM + l * 4, args.in[24] + l * 128, 0.8f - 0.6f * expf(-0.3f * (float)l)};
                const int nctx = (l < DEPTH - 1) ? 96 : 0;
                for (int k = 0;; ++k) {
                    int type, b, h, qrow0, NT;
                    if (G == 256) {
                        if (k == 4 && merged) {
                            if (threadIdx.x == 0) { unsigned sp = 0;
                                while (__hip_atomic_load(UPC, __ATOMIC_RELAXED, __HIP_MEMORY_SCOPE_AGENT) < 544u) { __builtin_amdgcn_s_sleep(1); if (++sp > (1u << 22)) break; }
                                __builtin_amdgcn_fence(__ATOMIC_ACQUIRE, "agent");
                                asm volatile("s_waitcnt vmcnt(0)" ::: "memory"); }
                            __syncthreads();
                        }
                        if (k < 6) { const int id = (k & 1) * 256 + vcu; type = (k < 2) ? 0 : (k < 4 ? 2 : 1); b = id >> 7; h = (id >> 4) & 7; qrow0 = b * SEQ + (id & 15) * 256; NT = 68; }
                        else if (k == 6 && bx < nctx) { type = bx >> 5; b = (bx >> 3) & 3; h = bx & 7; qrow0 = MLAT + b * CTXL; NT = 4; }
                        else break;
                    } else {
                        const int it = bx + k * G; if (it >= 1536 + nctx) break;
                        if (it < 1536) { const int id = it & 511; type = it >> 9; b = id >> 7; h = (id >> 4) & 7; qrow0 = b * SEQ + (id & 15) * 256; NT = 68; }
                        else { const int c = it - 1536; type = c >> 5; b = (c >> 3) & 3; h = c & 7; qrow0 = MLAT + b * CTXL; NT = 4; }
                    }
                    attn_item(T, type, b, h, qrow0, NT, (LAS char*)lds, tid);
                }
                __syncthreads();
            } else {
                unsigned* CNT = (unsigned*)(ws + WS_CNT) + (size_t)l * 68 * 64;
                const bool merged = (G == 256) && args.coop;
                const bool ctxl = l < DEPTH - 1;
                pg8::Gemm g3{BR, WBR + (size_t)l * 2048 * 3072, Mrows, 2048, 3072}; EpiBr E3{MRG, Y};
                pg8::Gemm g4{Y, WOUT + (size_t)l * DM * DM, Mrows, DM, DM}; EpiOut E4{xsrc, csrc, args.out, CTXW, modl};
                for (int part = 0; part < 2; ++part) {
                    pg8::StaticOrder S;
                    if (!merged) { if (part) break; S.init(Mrows, 2048, G, bx); }
                    else if (part == 0) S.init(MLAT, 2048, G, bx);
                    else { if (!(ctxl && bx < 32)) break; S.init_one(64 + (bx >> 3), bx & 7); }
                    { int t2 = threadIdx.x; asm volatile("" : "+v"(t2)); pg8::gemm_phase<EpiBr>(lds, g3, S, E3, t2); }
                    if (merged && threadIdx.x == 0) {
                        __builtin_amdgcn_fence(__ATOMIC_RELEASE, "agent");
                        asm volatile("s_waitcnt vmcnt(0)" ::: "memory");
                        pg8::Unit u; for (int i = 0; S.next(i, u); ++i) __hip_atomic_fetch_add(&CNT[u.pm * 64], 1u, __ATOMIC_RELAXED, __HIP_MEMORY_SCOPE_AGENT);
                    }
                }
                if (!merged && args.coop) xcd_barrier(bar);
                for (int part = 0; part < 2; ++part) {
                    pg8::StaticOrder S;
                    if (!merged) { if (part) break; S.init(Mrows, DM, G, bx); }
                    else if (part == 0) S.init(MLAT, DM, G, bx);
                    else { if (!(ctxl && bx >= 32 && bx < 64)) break; S.init_one(64 + ((bx - 32) >> 3), bx & 7); }
                    if (merged) {
                        if (threadIdx.x == 0) {
                            pg8::Unit u;
                            for (int i = 0; S.next(i, u); ++i) { unsigned sp = 0;
                                while (__hip_atomic_load(&CNT[u.pm * 64], __ATOMIC_RELAXED, __HIP_MEMORY_SCOPE_AGENT) < 8u) { __builtin_amdgcn_s_sleep(1); if (++sp > (1u << 22)) break; } }
                            __builtin_amdgcn_fence(__ATOMIC_ACQUIRE, "agent");
                            asm volatile("s_waitcnt vmcnt(0)" ::: "memory");
                        }
                        __syncthreads();
                    }
                    { int t2 = threadIdx.x; asm volatile("" : "+v"(t2)); pg8::gemm_phase<EpiOut>(lds, g4, S, E4, t2); }
                    if (merged && ctxl && threadIdx.x == 0) {
                        __builtin_amdgcn_fence(__ATOMIC_RELEASE, "agent");
                        asm volatile("s_waitcnt vmcnt(0)" ::: "memory");
                        pg8::Unit u; for (int i = 0; S.next(i, u); ++i) __hip_atomic_fetch_add(&CNT[(DEPTH * 68 + u.pm) * 64], 1u, __ATOMIC_RELAXED, __HIP_MEMORY_SCOPE_AGENT);
                    }
                }
                if (l < DEPTH - 1) {
                    const float* nw1 = args.in[4] + (size_t)(l + 1) * DM; const float* mod1 = MOD + (size_t)(l + 1) * 5 * 6144;
                    int t3 = threadIdx.x; asm volatile("" : "+v"(t3));
                    const int lane3 = t3 & 63, wave3 = __builtin_amdgcn_readfirstlane(t3 >> 6);
                    if (merged) {
                        const int r0 = 68 * bx;
                        if (threadIdx.x == 0) {
                            for (int pm = r0 >> 8; pm <= (r0 + 67) >> 8; ++pm) { unsigned sp = 0;
                                while (__hip_atomic_load(&CNT[(DEPTH * 68 + pm) * 64], __ATOMIC_RELAXED, __HIP_MEMORY_SCOPE_AGENT) < 8u) { __builtin_amdgcn_s_sleep(1); if (++sp > (1u << 22)) break; } }
                            __builtin_amdgcn_fence(__ATOMIC_ACQUIRE, "agent");
                            asm volatile("s_waitcnt vmcnt(0)" ::: "memory");
                        }
                        __syncthreads();
                        for (int row = r0 + wave3; row < r0 + 68; row += 16) { const int rb = row + 8; p1_row2(row, rb < r0 + 68 ? rb : -1, args.out, CTXW, mod1, nw1, H, lane3); }
                    } else {
                        if (args.coop) xcd_barrier(bar);
                        for (int row = bx * 8 + wave3; row < MTOT; row += G * 16) { const int rb = row + G * 8; p1_row2(row, rb < MTOT ? rb : -1, args.out, CTXW, mod1, nw1, H, lane3); }
                    }
                }
            }
        }
        if (ph + 1 < args.ph_hi) { if (args.coop) { if (ph == 0) cg::this_grid().sync(); else xcd_barrier(bar); } }
    }
}

extern "C" void kernel_launch(void* const* d_in, const int* in_sizes, int n_in, void* d_out, int out_size, void* d_ws, size_t ws_size, hipStream_t stream) {
    static int grid = 0;
    if (grid == 0) {
        if (n_in != 29 || in_sizes[0] != MLAT * DM || out_size != MLAT * DM || ws_size < WS_END) {
            fprintf(stderr, "kernel_launch: unexpected shapes: n_in %d in0 %d out %d ws %zu (need %zu)\n", n_in, n_in > 0 ? in_sizes[0] : -1, out_size, ws_size, (size_t)WS_END); grid = -1; return; }
        int dev = 0, cus = 0, per_cu = 0;
        if (hipGetDevice(&dev) != hipSuccess || hipDeviceGetAttribute(&cus, hipDeviceAttributeMultiprocessorCount, dev) != hipSuccess) { grid = -1; return; }
        if (hipFuncSetAttribute((const void*)mega_fwd, hipFuncAttributeMaxDynamicSharedMemorySize, LDS_BYTES) != hipSuccess) { fprintf(stderr, "kernel_launch: hipFuncSetAttribute failed\n"); grid = -1; return; }
        if (hipOccupancyMaxActiveBlocksPerMultiprocessor(&per_cu, (const void*)mega_fwd, 512, LDS_BYTES) != hipSuccess || per_cu < 1) { fprintf(stderr, "kernel_launch: occupancy query gives %d\n", per_cu); per_cu = 1; }
        (void)hipGetLastError();
        grid = cus * 1;
    }
    if (grid < 0) return;
    Args a{};
    for (int i = 0; i < 29; ++i) a.in[i] = (const float*)d_in[i];
    a.out = (float*)d_out; a.ws = (unsigned char*)d_ws;
#if MK_COOP
    if (hipMemsetAsync((char*)d_ws + WS_BAR, 0, 16384 + CNT_BYTES, stream) != hipSuccess) { fprintf(stderr, "kernel_launch: memset of the barrier words failed\n"); return; }
    a.ph_lo = 0; a.ph_hi = NPH; a.coop = 1;
    void* kargs[] = {&a};
    hipError_t e = hipLaunchCooperativeKernel((const void*)mega_fwd, dim3(grid), dim3(512), kargs, LDS_BYTES, stream);
    if (e != hipSuccess) fprintf(stderr, "kernel_launch: cooperative launch failed: %s (grid %d)\n", hipGetErrorString(e), grid);
#else
    for (int ph = 0; ph < NPH; ++ph) {
        a.ph_lo = ph; a.ph_hi = ph + 1; a.coop = 0;
        hipLaunchKernelGGL(mega_fwd, dim3(grid), dim3(512), LDS_BYTES, stream, a);
    }
    const hipError_t le = hipPeekAtLastError();
    if (le != hipSuccess) fprintf(stderr, "kernel_launch: launch failed: %s\n", hipGetErrorName(le));
#endif
}
```

```cpp
#include <hip/hip_runtime.h>
#include <hip/hip_cooperative_groups.h>
#include <cstdio>
#include <cstdint>
namespace cg = cooperative_groups;

#ifndef MK_MASK
#define MK_MASK 127
#endif
#ifndef MK_ATYPE
#define MK_ATYPE 7
#endif
#ifndef MK_G1T
#define MK_G1T 127
#endif
#ifndef ATT_SD_A
#define ATT_SD_A 2
#endif
#ifndef ATT_SD_B
#define ATT_SD_B 1
#endif
#ifndef ATT_SD_C
#define ATT_SD_C 2
#endif
#ifndef ATT_DBL_B
#define ATT_DBL_B true
#endif
#ifndef ATT_DBL
#define ATT_DBL false
#endif
#ifndef QKT_GRP
#define QKT_GRP 0
#endif
#ifndef MK_COOP
#define MK_COOP 1
#endif

#define LAS __attribute__((address_space(3)))
typedef unsigned short bf16_t;
typedef short bf16x8 __attribute__((ext_vector_type(8)));
typedef short s16x4 __attribute__((ext_vector_type(4)));
typedef float f32x4 __attribute__((ext_vector_type(4)));
typedef float f32x16 __attribute__((ext_vector_type(16)));
typedef unsigned u32x4 __attribute__((ext_vector_type(4)));
typedef unsigned u32x2 __attribute__((ext_vector_type(2)));

constexpr int DM = 2048, NBATCH = 4, SEQ = 4096, CTXL = 256, DEPTH = 4;
constexpr int MLAT = NBATCH * SEQ, MCTX = NBATCH * CTXL, MTOT = MLAT + MCTX;
constexpr int INC = 15936, NIN = 16128;
constexpr float EPS = 1e-6f;
#ifndef MK_REP_ST
#define MK_REP_ST -1
#endif
constexpr int PPL = 5;
constexpr int NPH = 2 + 3 * DEPTH;

constexpr size_t alignup(size_t x) { return (x + 255) / 256 * 256; }
constexpr size_t WS_MOD = 0;
constexpr size_t WS_TC64 = WS_MOD + alignup((size_t)DEPTH * 5 * 6144 * 4);
constexpr size_t WS_TS64 = WS_TC64 + 4096, WS_TC128 = WS_TS64 + 4096, WS_TS128 = WS_TC128 + 8192;
constexpr size_t WS_LAM = WS_TS128 + 8192;
constexpr size_t WS_BAR = WS_LAM + 256;
constexpr size_t WS_CNT = WS_BAR + 16384;
constexpr size_t CNT_BYTES = (size_t)(2 * DEPTH * 68 + DEPTH) * 256;
constexpr size_t WS_WIN = WS_CNT + CNT_BYTES;
constexpr size_t WS_WUP = WS_WIN + (size_t)DEPTH * NIN * DM * 2;
constexpr size_t WS_WBR = WS_WUP + (size_t)DEPTH * 2048 * 512 * 2;
constexpr size_t WS_WOUT = WS_WBR + (size_t)DEPTH * 2048 * 3072 * 2;
constexpr size_t WS_H = WS_WOUT + (size_t)DEPTH * 2048 * 2048 * 2;
constexpr size_t WS_QA = WS_H + (size_t)MTOT * 2048 * 2;
constexpr size_t WS_KA = WS_QA + (size_t)MTOT * 1024 * 2;
constexpr size_t WS_VA = WS_KA + (size_t)MTOT * 256 * 2;
constexpr size_t WS_QB = WS_VA + (size_t)MTOT * 256 * 2;
constexpr size_t WS_KB = WS_QB + (size_t)MTOT * 1536 * 2;
constexpr size_t WS_CKV = WS_KB + (size_t)MTOT * 1536 * 2;
constexpr size_t WS_VB = WS_CKV + (size_t)MTOT * 512 * 2;
constexpr size_t WS_QC = WS_VB + (size_t)MTOT * 1024 * 2;
constexpr size_t WS_KC = WS_QC + (size_t)MTOT * 1024 * 2;
constexpr size_t WS_VC = WS_KC + (size_t)MTOT * 1024 * 2;
constexpr size_t WS_GATE = WS_VC + (size_t)MTOT * 1024 * 2;
constexpr size_t WS_MRG = WS_GATE + (size_t)MTOT * 3072 * 2;
constexpr size_t WS_BR = WS_MRG + (size_t)MTOT * 6144 * 2;
constexpr size_t WS_Y = WS_BR + (size_t)MTOT * 3072 * 2;
constexpr size_t WS_SS = WS_Y + (size_t)MTOT * 2048 * 2;
constexpr size_t WS_CTXW = WS_SS + (size_t)MTOT * 8 * 4;
constexpr size_t WS_SCR = WS_CTXW + (size_t)MCTX * DM * 4;
constexpr size_t WS_END = WS_SCR + (size_t)256 * 64 * 512 * 4;

constexpr int RING_BYTES = 131072, XCH_OFF = RING_BYTES, LDS_BYTES = 147456;

__device__ __forceinline__ float bf2f(unsigned h) { return __uint_as_float(h << 16); }
__device__ __forceinline__ unsigned cvt_pk_bf16(float lo, float hi) { unsigned r; asm volatile("v_cvt_pk_bf16_f32 %0, %1, %2" : "=v"(r) : "v"(lo), "v"(hi)); return r; }
__device__ __forceinline__ float wave_sum(float v) {
#pragma unroll
    for (int o = 1; o < 64; o <<= 1) v += __shfl_xor(v, o);
    return v;
}
__device__ __forceinline__ float sigm_f(float x) { return __builtin_amdgcn_rcpf(1.f + __builtin_amdgcn_exp2f(-1.4426950408889634f * x)); }
__device__ __forceinline__ float silu_f(float x) { return x * sigm_f(x); }
__device__ __forceinline__ unsigned cvt_pk_bf16_safe(float lo, float hi) { unsigned r; asm volatile("s_nop 1\n\tv_cvt_pk_bf16_f32 %0, %1, %2" : "=v"(r) : "v"(lo), "v"(hi)); return r; }
__device__ __forceinline__ void store8_safe(bf16_t* p, f32x4 a, f32x4 b) {
    u32x4 w; w.x = cvt_pk_bf16_safe(a[0], a[1]); w.y = cvt_pk_bf16_safe(a[2], a[3]); w.z = cvt_pk_bf16_safe(b[0], b[1]); w.w = cvt_pk_bf16_safe(b[2], b[3]);
    *(u32x4*)p = w;
}
__device__ __forceinline__ void store8(bf16_t* p, f32x4 a, f32x4 b) {
    u32x4 w; w.x = cvt_pk_bf16(a[0], a[1]); w.y = cvt_pk_bf16(a[2], a[3]); w.z = cvt_pk_bf16(b[0], b[1]); w.w = cvt_pk_bf16(b[2], b[3]);
    *(u32x4*)p = w;
}

namespace pg8 {
constexpr int BM = 256, BK = 64, HALF = 128, HTB = HALF * BK * 2, NXCD = 8, WGM = 8;
__host__ __device__ __forceinline__ int lds_byte(int r, int c) { const int st = (r >> 4) * 2 + (c >> 5), rr = r & 15, cc = c & 31, ob = rr * 64 + cc * 2; return st * 1024 + (ob ^ (((ob >> 9) & 1) << 5)); }
__host__ __device__ __forceinline__ void stage_rc(int b, int& R, int& C) { const int st = b / 1024, sb = b % 1024, swz = sb ^ (((sb >> 9) & 1) << 5); R = (st >> 1) * 16 + swz / 64; C = (st & 1) * 32 + (swz % 64) / 2; }
__host__ __device__ __forceinline__ int perm32(int rho) { const int n = rho >> 4, i = rho & 15; return 8 * (i >> 2) + 4 * n + (i & 3); }

struct Unit { int pm, pn; };
struct Gemm { const bf16_t* A; const bf16_t* Bt; int M, N, K; };
struct StaticOrder {
    int nM, nN, nwg, G, c, fixed, fpm, fpn;
    __device__ void init(int M, int N, int G_, int c_) { nM = M / BM; nN = N / BM; nwg = nM * nN; G = G_; c = c_; fixed = 0; fpm = 0; fpn = 0; }
    __device__ void init_one(int pm, int pn) { nM = 1; nN = 1; nwg = 1; G = 1; c = 0; fixed = 1; fpm = pm; fpn = pn; }
    __device__ bool next(int i, Unit& u) const {
        if (fixed) { if (i > 0) return false; u.pm = fpm; u.pn = fpn; return true; }
        const long L = (long)i * G + c; if (L >= nwg) return false;
        int wgid = (int)L; { const int q = nwg / NXCD, r = nwg % NXCD, xcd = wgid % NXCD, off = wgid / NXCD; wgid = (xcd < r ? xcd * (q + 1) : r * (q + 1) + (xcd - r) * q) + off; }
        const int nig = WGM * nN, gid = wgid / nig, fm = gid * WGM, gsz = (nM - fm) < WGM ? (nM - fm) : WGM;
        u.pm = fm + ((wgid % nig) % gsz); u.pn = (wgid % nig) / gsz; return true;
    }
};

template <class Epi>
__device__ __forceinline__ void gemm_phase(LAS unsigned char* lds, const Gemm g, const StaticOrder& S, const Epi& E, const int tid) {
    const int wid = __builtin_amdgcn_readfirstlane(tid >> 6), lane = tid & 63, wr = wid >> 2, wc = wid & 3, fr = lane & 15, fq = lane >> 4;
    const int K = g.K, nt = K / BK;
    unsigned voffA[2], voffB[2];
#pragma unroll
    for (int i = 0; i < 2; ++i) { int R, C; stage_rc(tid * 16 + i * 8192, R, C); const int Rb = (R & ~31) + perm32(R & 31);
        voffA[i] = (unsigned)(R * K + C) * 2u; voffB[i] = (unsigned)(Rb * K + C) * 2u; }
    const size_t kstep = (size_t)(BK * 2);
    const size_t hstep = (size_t)HALF * K * 2;
    const size_t tstep = 2 * hstep;
    const unsigned ldsw = (unsigned)wid * 1024u;
    const int aoff = lds_byte(wr * 64 + fr, fq * 8), boff = lds_byte(wc * 32 + fr, fq * 8);
#define PG8_SA(b, h) (((b) * 2 + (h)) * HTB)
#define PG8_SB(b, h) ((4 + (b) * 2 + (h)) * HTB)
#define PG8_STAGE(bufoff, gbase, voff) do { _Pragma("unroll") for (int _i = 0; _i < 2; ++_i) \
        __builtin_amdgcn_global_load_lds((const unsigned*)((const char*)(gbase) + (voff)[_i]), (LAS unsigned*)(lds + (bufoff) + ldsw + _i * 8192), 16, 0, 0); } while (0)
#define PG8_LDA(dst, b, h) do { _Pragma("unroll") for (int m = 0; m < 4; ++m) _Pragma("unroll") for (int k = 0; k < 2; ++k) dst[m][k] = *(const LAS bf16x8*)(lds + PG8_SA(b, h) + aoff + m * 2048 + k * 1024); } while (0)
#define PG8_LDB(dst, b, h) do { _Pragma("unroll") for (int n = 0; n < 2; ++n) _Pragma("unroll") for (int k = 0; k < 2; ++k) dst[n][k] = *(const LAS bf16x8*)(lds + PG8_SB(b, h) + boff + n * 2048 + k * 1024); } while (0)
#define PG8_MMA(ai, bj, At, Bt) do { __builtin_amdgcn_s_setprio(1); _Pragma("unroll") for (int m = 0; m < 4; ++m) _Pragma("unroll") for (int n = 0; n < 2; ++n) _Pragma("unroll") for (int k = 0; k < 2; ++k) \
        acc[ai][bj][m][n] = __builtin_amdgcn_mfma_f32_16x16x32_bf16(Bt[n][k], At[m][k], acc[ai][bj][m][n], 0, 0, 0); __builtin_amdgcn_s_setprio(0); } while (0)
#define PG8_WAIT_V(n) asm volatile("s_waitcnt vmcnt(" #n ")" ::: "memory")
#define PG8_WAIT_L(n) asm volatile("s_waitcnt lgkmcnt(" #n ")" ::: "memory")
#define PG8_BAR __builtin_amdgcn_s_barrier()
#define PG8_SCHED __builtin_amdgcn_sched_barrier(0)
    Unit cur, nxt; int ui = 0;
    if (!S.next(0, cur)) return;
    f32x4 acc[2][2][4][2];
#pragma unroll
    for (int a = 0; a < 2; ++a)
#pragma unroll
        for (int b = 0; b < 2; ++b)
#pragma unroll
            for (int m = 0; m < 4; ++m)
#pragma unroll
                for (int n = 0; n < 2; ++n) acc[a][b][m][n] = (f32x4){0.f, 0.f, 0.f, 0.f};
    bf16x8 At[4][2], B0[2][2], B1[2][2];
    const char* cA = (const char*)g.A + (size_t)cur.pm * tstep; const char* cB = (const char*)g.Bt + (size_t)cur.pn * tstep;
    PG8_STAGE(PG8_SB(0, 0), cB, voffB); PG8_STAGE(PG8_SB(0, 1), cB + hstep, voffB); PG8_STAGE(PG8_SA(0, 0), cA, voffA); PG8_STAGE(PG8_SA(0, 1), cA + hstep, voffA);
    if (wr == 1) PG8_BAR;
    PG8_WAIT_V(2); PG8_BAR;
    PG8_STAGE(PG8_SB(1, 0), cB + kstep, voffB); PG8_STAGE(PG8_SA(1, 0), cA + kstep, voffA); PG8_STAGE(PG8_SB(1, 1), cB + hstep + kstep, voffB);
    PG8_WAIT_V(6); PG8_BAR;
    for (;;) {
        const bool has_next = S.next(ui + 1, nxt);
        const char* nA = has_next ? (const char*)g.A + (size_t)nxt.pm * tstep : cA; const char* nB = has_next ? (const char*)g.Bt + (size_t)nxt.pn * tstep : cB;
        for (int t = 0; t < nt; t += 2) {
            const bool last = (t == nt - 2);
            const char* a1 = cA + (size_t)(t + 1) * kstep;
            const char* a2 = last ? nA : cA + (size_t)(t + 2) * kstep; const char* b2 = last ? nB : cB + (size_t)(t + 2) * kstep;
            const char* a3 = a2 + kstep; const char* b3 = b2 + kstep;
            if constexpr (Epi::MID) { if (t == 16 || t == 32) { int fr_ = fr, fq_ = fq, wr_ = wr, wc_ = wc;
                asm volatile("" : "+v"(fr_), "+v"(fq_)); asm volatile("" : "+s"(wr_), "+s"(wc_));
                E.mid(acc, cur, t >> 4, wr_, wc_, fr_, fq_); PG8_WAIT_V(0); PG8_SCHED; } }
            PG8_LDB(B0, 0, 0); PG8_LDB(B1, 0, 1); PG8_SCHED; PG8_LDA(At, 0, 0); PG8_STAGE(PG8_SA(1, 1), a1 + hstep, voffA);
            PG8_WAIT_V(8); PG8_WAIT_L(0); PG8_BAR; PG8_MMA(0, 0, At, B0); PG8_MMA(0, 1, At, B1); PG8_BAR; PG8_SCHED;
            PG8_LDA(At, 0, 1); PG8_STAGE(PG8_SB(0, 0), b2, voffB); PG8_STAGE(PG8_SB(0, 1), b2 + hstep, voffB); PG8_STAGE(PG8_SA(0, 0), a2, voffA);
            PG8_WAIT_V(8); PG8_WAIT_L(0); PG8_BAR; PG8_MMA(1, 0, At, B0); PG8_MMA(1, 1, At, B1); PG8_BAR; PG8_SCHED;
            PG8_LDB(B0, 1, 0); PG8_LDB(B1, 1, 1); PG8_SCHED; PG8_LDA(At, 1, 0); PG8_STAGE(PG8_SA(0, 1), a2 + hstep, voffA);
            PG8_WAIT_V(8); PG8_WAIT_L(0); PG8_BAR; PG8_MMA(0, 0, At, B0); PG8_MMA(0, 1, At, B1); PG8_BAR; PG8_SCHED;
            PG8_LDA(At, 1, 1); PG8_STAGE(PG8_SB(1, 0), b3, voffB); PG8_STAGE(PG8_SB(1, 1), b3 + hstep, voffB); PG8_STAGE(PG8_SA(1, 0), a3, voffA);
            PG8_WAIT_V(8); PG8_WAIT_L(0); PG8_BAR; PG8_MMA(1, 0, At, B0); PG8_MMA(1, 1, At, B1); PG8_BAR; PG8_SCHED;
        }
        if (wr == 0) PG8_BAR;
        { int fr_ = fr, fq_ = fq, wr_ = wr, wc_ = wc, wid_ = wid;
          asm volatile("" : "+v"(fr_), "+v"(fq_)); asm volatile("" : "+s"(wr_), "+s"(wc_), "+s"(wid_));
          E(acc, cur, wr_, wc_, fr_, fq_, wid_); }
        if (!has_next) break;
#pragma unroll
        for (int a = 0; a < 2; ++a)
#pragma unroll
            for (int b = 0; b < 2; ++b)
#pragma unroll
                for (int m = 0; m < 4; ++m)
#pragma unroll
                    for (int n = 0; n < 2; ++n) acc[a][b][m][n] = (f32x4){0.f, 0.f, 0.f, 0.f};
        cur = nxt; cA = nA; cB = nB; ++ui;
        if (wr == 1) PG8_BAR;
    }
    PG8_WAIT_V(0);
    PG8_BAR;
#undef PG8_SA
#undef PG8_SB
#undef PG8_STAGE
#undef PG8_LDA
#undef PG8_LDB
#undef PG8_MMA
#undef PG8_WAIT_V
#undef PG8_WAIT_L
#undef PG8_BAR
#undef PG8_SCHED
}
}
using pg8::Unit;

__device__ __forceinline__ int in_src_col(int n) {
    const int tile = n >> 8, s = n & 255, bj = s >> 7, wc = (s >> 5) & 3, c = s & 31;
    const int d128 = 64 * (wc & 1) + 32 * bj + c, g128 = wc >> 1;
    const int d64 = 32 * (c >> 4) + 16 * bj + (c & 15), g64 = wc;
    if (tile < 4) return (tile * 2 + g128) * 128 + d128;
    if (tile == 4) return 1024 + g128 * 128 + d128;
    if (tile == 5) return 1280 + s;
    if (tile < 10) return 1536 + ((tile - 6) * 2 + g128) * 192 + d128;
    if (tile < 12) return 1536 + ((tile - 10) * 4 + g64) * 192 + 128 + d64;
    if (tile < 14) return 3072 + (tile - 12) * 256 + s;
    if (tile == 14) return g64 == 0 ? 3584 + d64 : -1;
    if (tile < 19) return 3648 + ((tile - 15) * 4 + g64) * 64 + d64;
    if (tile < 23) return 4672 + ((tile - 19) * 4 + g64) * 64 + d64;
    if (tile < 27) return 5696 + (tile - 23) * 256 + s;
    if (tile < 39) return 6720 + (tile - 27) * 256 + s;
    return 9792 + (tile - 39) * 256 + s;
}
__device__ __forceinline__ int up_src_col(int n) {
    if (n >= 1024) return n;
    const int tile = n >> 8, s = n & 255, bj = s >> 7, wc = (s >> 5) & 3, c = s & 31;
    return (tile * 2 + (wc >> 1)) * 128 + 64 * (wc & 1) + 32 * bj + c;
}

template <int GS>
__device__ __forceinline__ void norm_rope_store(const f32x4 (&acc)[2][2][4][2], int pm, int wr, int wc, int fr, int fq, int wid,
                                                const float* __restrict__ w, const float* __restrict__ tcos, const float* __restrict__ tsin, bool rope,
                                                const float (&pre)[2][4], bf16_t* __restrict__ dst, int ld, int gbase, int ncopies, int copystride, LAS float* xch, const float qs = 1.f) {
    const int dbase = (GS == 128) ? 64 * (wc & 1) + 8 * fq : 32 * (fq >> 1) + 8 * (fq & 1);
    const int bjs = (GS == 128) ? 32 : 16;
    const int axis = (GS == 128) ? (wc & 1) : (fq >> 1);
    const int i0 = (GS == 128) ? 8 * fq : 8 * (fq & 1);
    constexpr int NF = (GS == 128) ? 32 : 16;
    const int wavebase = gbase + ((GS == 128) ? 64 * (wc & 1) : 0) + 8 * fq;
    float ssq[2][4];
#pragma unroll
    for (int ai = 0; ai < 2; ++ai)
#pragma unroll
        for (int m = 0; m < 4; ++m) {
            float s = 0.f;
#pragma unroll
            for (int bj = 0; bj < 2; ++bj)
#pragma unroll
                for (int n = 0; n < 2; ++n)
#pragma unroll
                    for (int j = 0; j < 4; ++j) { const float v = acc[ai][bj][m][n][j] * pre[ai][m]; s += v * v; }
            s += __shfl_xor(s, 16); s += __shfl_xor(s, 32);
            ssq[ai][m] = s;
        }
    if constexpr (GS == 128) {
        if (fq == 0) {
#pragma unroll
            for (int ai = 0; ai < 2; ++ai)
#pragma unroll
                for (int m = 0; m < 4; ++m) xch[wid * 128 + ai * 64 + m * 16 + fr] = ssq[ai][m];
        }
        asm volatile("s_waitcnt lgkmcnt(0)" ::: "memory"); __builtin_amdgcn_s_barrier();
#pragma unroll
        for (int ai = 0; ai < 2; ++ai)
#pragma unroll
            for (int m = 0; m < 4; ++m) ssq[ai][m] += xch[(wid ^ 1) * 128 + ai * 64 + m * 16 + fr];
    }
#pragma unroll
    for (int ai = 0; ai < 2; ++ai)
#pragma unroll
        for (int m = 0; m < 4; ++m) {
            const int rl = ai * 128 + wr * 64 + m * 16 + fr;
            const size_t row = (size_t)pm * 256 + rl;
            const float rinv = rsqrtf(ssq[ai][m] * (1.f / GS) + EPS) * pre[ai][m] * qs;
            const int t = (pm & 15) * 256 + rl; const int pos = axis ? (t & 63) : (t >> 6);
            u32x4 k0, k1;
#pragma unroll
            for (int n = 0; n < 2; ++n) {
                const f32x4 w0 = *(const f32x4*)(w + dbase + 4 * n), w1 = *(const f32x4*)(w + dbase + bjs + 4 * n);
                f32x4 y0 = acc[ai][0][m][n] * rinv * w0, y1 = acc[ai][1][m][n] * rinv * w1;
                if (rope) {
                    const f32x4 c = *(const f32x4*)(tcos + pos * NF + i0 + 4 * n), sn = *(const f32x4*)(tsin + pos * NF + i0 + 4 * n);
                    const f32x4 o0 = y0 * c - y1 * sn, o1 = y1 * c + y0 * sn;
                    y0 = o0; y1 = o1;
                }
                if (n == 0) { k0.x = cvt_pk_bf16(y0[0], y0[1]); k0.y = cvt_pk_bf16(y0[2], y0[3]); k1.x = cvt_pk_bf16(y1[0], y1[1]); k1.y = cvt_pk_bf16(y1[2], y1[3]); }
                else { k0.z = cvt_pk_bf16(y0[0], y0[1]); k0.w = cvt_pk_bf16(y0[2], y0[3]); k1.z = cvt_pk_bf16(y1[0], y1[1]); k1.w = cvt_pk_bf16(y1[2], y1[3]); }
            }
            bf16_t* p = dst + row * ld + wavebase;
            for (int cp = 0; cp < ncopies; ++cp) { *(u32x4*)(p + cp * copystride) = k0; *(u32x4*)(p + cp * copystride + 32) = k1; }
            __builtin_amdgcn_sched_barrier(0);
        }
}

struct EpiIn {
    static constexpr bool MID = false;
    bf16_t *QA, *KA, *VA, *QB, *KB, *CKV, *QC, *KC, *VC, *GATE, *MRG; float* SS;
    const float *wAq, *wAk, *wBqn, *wBqr, *wBkr, *wCq, *wCk, *bmerge;
    const float *tc64, *ts64, *tc128, *ts128;
    LAS float* xch;
    template <int ACT>
    __device__ __forceinline__ void plain(const f32x4 (&acc)[2][2][4][2], int pm, int wr, int wc, int fr, int fq, bf16_t* dst, int ld, int col0) const {
        const int colw = col0 + 32 * wc + 8 * fq;
        f32x4 b[2][2];
#pragma unroll
        for (int bj = 0; bj < 2; ++bj)
#pragma unroll
            for (int n = 0; n < 2; ++n) b[bj][n] = (ACT == 2) ? *(const f32x4*)(bmerge + colw + bj * 128 + 4 * n) : (f32x4){0.f, 0.f, 0.f, 0.f};
#pragma unroll
        for (int ai = 0; ai < 2; ++ai)
#pragma unroll
            for (int m = 0; m < 4; ++m) {
                const size_t row = (size_t)pm * 256 + ai * 128 + wr * 64 + m * 16 + fr;
#pragma unroll
                for (int bj = 0; bj < 2; ++bj) {
                    f32x4 v0 = acc[ai][bj][m][0], v1 = acc[ai][bj][m][1];
                    if (ACT == 1) { for (int j = 0; j < 4; ++j) { v0[j] = silu_f(v0[j]); v1[j] = silu_f(v1[j]); } }
                    if (ACT == 2) { v0 = v0 + b[bj][0]; v1 = v1 + b[bj][1]; for (int j = 0; j < 4; ++j) { v0[j] = sigm_f(v0[j]); v1[j] = sigm_f(v1[j]); } }
                    if (ACT == 0) store8(dst + row * ld + colw + bj * 128, v0, v1); else store8_safe(dst + row * ld + colw + bj * 128, v0, v1);
                }
                __builtin_amdgcn_sched_barrier(0);
            }
    }
    __device__ __forceinline__ void operator()(const f32x4 (&acc)[2][2][4][2], const Unit& u, int wr, int wc, int fr, int fq, int wid) const {
        const int t = u.pn, pm = u.pm; const bool rope = pm < 64;
        const float one[2][4] = {{1.f, 1.f, 1.f, 1.f}, {1.f, 1.f, 1.f, 1.f}};
        if (t < 4 && (MK_G1T & 1)) norm_rope_store<128>(acc, pm, wr, wc, fr, fq, wid, wAq, tc128, ts128, rope, one, QA, 1024, (t * 2 + (wc >> 1)) * 128, 1, 0, xch, 0.08838834764831845f * 1.4426950408889634f);
        else if (t == 4 && (MK_G1T & 1)) norm_rope_store<128>(acc, pm, wr, wc, fr, fq, wid, wAk, tc128, ts128, rope, one, KA, 256, (wc >> 1) * 128, 1, 0, xch);
        else if (t == 5 && (MK_G1T & 2)) plain<0>(acc, pm, wr, wc, fr, fq, VA, 256, 0);
        else if (t < 10 && (MK_G1T & 1)) norm_rope_store<128>(acc, pm, wr, wc, fr, fq, wid, wBqn, tc128, ts128, false, one, QB, 1536, ((t - 6) * 2 + (wc >> 1)) * 192, 1, 0, xch, 0.07216878364870323f * 1.4426950408889634f);
        else if (t < 12 && (MK_G1T & 4)) norm_rope_store<64>(acc, pm, wr, wc, fr, fq, wid, wBqr, tc64, ts64, rope, one, QB, 1536, ((t - 10) * 4 + wc) * 192 + 128, 1, 0, xch, 0.07216878364870323f * 1.4426950408889634f);
        else if (t < 14 && (MK_G1T & 8)) {
            plain<0>(acc, pm, wr, wc, fr, fq, CKV, 512, (t - 12) * 256);
#pragma unroll
            for (int ai = 0; ai < 2; ++ai)
#pragma unroll
                for (int m = 0; m < 4; ++m) {
                    float s = 0.f;
#pragma unroll
                    for (int bj = 0; bj < 2; ++bj)
#pragma unroll
                        for (int n = 0; n < 2; ++n)
#pragma unroll
                            for (int j = 0; j < 4; ++j) { const float v = acc[ai][bj][m][n][j]; s += v * v; }
                    s += __shfl_xor(s, 16); s += __shfl_xor(s, 32);
                    if (fq == 0) SS[((size_t)pm * 256 + ai * 128 + wr * 64 + m * 16 + fr) * 8 + (t - 12) * 4 + wc] = s;
                }
        }
        else if (t == 14 && (MK_G1T & 16)) { if (wc == 0) norm_rope_store<64>(acc, pm, wr, wc, fr, fq, wid, wBkr, tc64, ts64, rope, one, KB, 1536, 128, 8, 192, xch); }
        else if (t < 19 && (MK_G1T & 4)) norm_rope_store<64>(acc, pm, wr, wc, fr, fq, wid, wCq, tc64, ts64, rope, one, QC, 1024, ((t - 15) * 4 + wc) * 64, 1, 0, xch, 0.125f * 1.4426950408889634f);
        else if (t < 23 && (MK_G1T & 4)) norm_rope_store<64>(acc, pm, wr, wc, fr, fq, wid, wCk, tc64, ts64, rope, one, KC, 1024, ((t - 19) * 4 + wc) * 64, 1, 0, xch);
        else if (t < 27 && (MK_G1T & 2)) plain<0>(acc, pm, wr, wc, fr, fq, VC, 1024, (t - 23) * 256);
        else if (t < 39 && (MK_G1T & 32)) plain<1>(acc, pm, wr, wc, fr, fq, GATE, 3072, (t - 27) * 256);
        else if (MK_G1T & 64) plain<2>(acc, pm, wr, wc, fr, fq, MRG, 6144, (t - 39) * 256);
    }
};

struct EpiUp {
    static constexpr bool MID = false;
    bf16_t *KB, *VB; const float* SS; const float* wBkn; LAS float* xch;
    __device__ __forceinline__ void operator()(const f32x4 (&acc)[2][2][4][2], const Unit& u, int wr, int wc, int fr, int fq, int wid) const {
        const int t = u.pn, pm = u.pm;
        float pre[2][4];
#pragma unroll
        for (int ai = 0; ai < 2; ++ai)
#pragma unroll
            for (int m = 0; m < 4; ++m) {
                const size_t row = (size_t)pm * 256 + ai * 128 + wr * 64 + m * 16 + fr;
                const f32x4 a = *(const f32x4*)(SS + row * 8), b = *(const f32x4*)(SS + row * 8 + 4);
                pre[ai][m] = rsqrtf(((a[0] + a[1]) + (a[2] + a[3]) + (b[0] + b[1]) + (b[2] + b[3])) * (1.f / 512.f) + EPS);
                __builtin_amdgcn_sched_barrier(0);
            }
        if (t < 4) norm_rope_store<128>(acc, pm, wr, wc, fr, fq, wid, wBkn, nullptr, nullptr, false, pre, KB, 1536, (t * 2 + (wc >> 1)) * 192, 1, 0, xch);
        else {
            const int colw = (t - 4) * 256 + 32 * wc + 8 * fq;
#pragma unroll
            for (int ai = 0; ai < 2; ++ai)
#pragma unroll
                for (int m = 0; m < 4; ++m) {
                    const size_t row = (size_t)pm * 256 + ai * 128 + wr * 64 + m * 16 + fr;
#pragma unroll
                    for (int bj = 0; bj < 2; ++bj) store8(VB + row * 1024 + colw + bj * 128, acc[ai][bj][m][0] * pre[ai][m], acc[ai][bj][m][1] * pre[ai][m]);
                    __builtin_amdgcn_sched_barrier(0);
                }
        }
    }
};

struct EpiBr {
    static constexpr bool MID = true;
    const bf16_t* MRG; bf16_t* Y;
    __device__ __forceinline__ void mid(f32x4 (&acc)[2][2][4][2], const Unit& u, int i, int wr, int wc, int fr, int fq) const {
#pragma unroll
        for (int ai = 0; ai < 2; ++ai)
#pragma unroll
            for (int m = 0; m < 4; ++m) {
                const size_t row = (size_t)u.pm * 256 + ai * 128 + wr * 64 + m * 16 + fr;
#pragma unroll
                for (int bj = 0; bj < 2; ++bj) {
                    const int col = u.pn * 256 + bj * 128 + 32 * wc + 8 * fq;
                    const u32x4 a = *(const u32x4*)(MRG + row * 6144 + (i - 1) * 2048 + col), b = *(const u32x4*)(MRG + row * 6144 + i * 2048 + col);
#pragma unroll
                    for (int q = 0; q < 4; ++q) {
                        const float r0 = bf2f(a[q] & 0xffffu) * __builtin_amdgcn_rcpf(bf2f(b[q] & 0xffffu)), r1 = bf2f(a[q] >> 16) * __builtin_amdgcn_rcpf(bf2f(b[q] >> 16));
                        acc[ai][bj][m][q >> 1][(q & 1) * 2] *= r0; acc[ai][bj][m][q >> 1][(q & 1) * 2 + 1] *= r1;
                    }
                }
                __builtin_amdgcn_sched_barrier(0);
            }
    }
    __device__ __forceinline__ void operator()(const f32x4 (&acc)[2][2][4][2], const Unit& u, int wr, int wc, int fr, int fq, int wid) const {
#pragma unroll
        for (int ai = 0; ai < 2; ++ai)
#pragma unroll
            for (int m = 0; m < 4; ++m) {
                const size_t row = (size_t)u.pm * 256 + ai * 128 + wr * 64 + m * 16 + fr;
#pragma unroll
                for (int bj = 0; bj < 2; ++bj) {
                    const int col = u.pn * 256 + bj * 128 + 32 * wc + 8 * fq;
                    const u32x4 a = *(const u32x4*)(MRG + row * 6144 + 4096 + col);
                    f32x4 v0 = acc[ai][bj][m][0], v1 = acc[ai][bj][m][1];
                    v0[0] *= bf2f(a[0] & 0xffffu); v0[1] *= bf2f(a[0] >> 16); v0[2] *= bf2f(a[1] & 0xffffu); v0[3] *= bf2f(a[1] >> 16);
                    v1[0] *= bf2f(a[2] & 0xffffu); v1[1] *= bf2f(a[2] >> 16); v1[2] *= bf2f(a[3] & 0xffffu); v1[3] *= bf2f(a[3] >> 16);
                    store8(Y + row * 2048 + col, v0, v1);
                }
                __builtin_amdgcn_sched_barrier(0);
            }
    }
};

struct EpiOut {
    static constexpr bool MID = false;
    const float *xsrc, *csrc; float *xdst, *cdst; const float* mod;
    __device__ __forceinline__ void operator()(const f32x4 (&acc)[2][2][4][2], const Unit& u, int wr, int wc, int fr, int fq, int wid) const {
        const int pm = u.pm; const bool lat = pm < 64;
        const int mi = lat ? (pm >> 4) : 4;
        const float* src = lat ? xsrc : csrc - (size_t)MLAT * DM; float* dst = lat ? xdst : cdst - (size_t)MLAT * DM;
        const float* g = mod + mi * 6144 + 4096;
#pragma unroll
        for (int bj = 0; bj < 2; ++bj) {
            const int col = u.pn * 256 + bj * 128 + 32 * wc + 8 * fq;
            const f32x4 g0 = *(const f32x4*)(g + col), g1 = *(const f32x4*)(g + col + 4);
#pragma unroll
            for (int ai = 0; ai < 2; ++ai)
#pragma unroll
                for (int m = 0; m < 4; ++m) {
                    const size_t row = (size_t)pm * 256 + ai * 128 + wr * 64 + m * 16 + fr;
                    const f32x4 x0 = *(const f32x4*)(src + row * DM + col), x1 = *(const f32x4*)(src + row * DM + col + 4);
                    *(f32x4*)(dst + row * DM + col) = x0 + g0 * acc[ai][bj][m][0];
                    *(f32x4*)(dst + row * DM + col + 4) = x1 + g1 * acc[ai][bj][m][1];
                    __builtin_amdgcn_sched_barrier(0);
                }
        }
    }
};

namespace att {
#define SBAR() __builtin_amdgcn_sched_barrier(0)
__device__ __forceinline__ int crow(int r, int hi) { return (r & 3) + 8 * (r >> 2) + 4 * hi; }
template <int RB> __device__ __forceinline__ int kswz(int row, int colB) { const int x = (RB == 256) ? (row & 15) : ((row >> 1) & 7); return row * RB + (colB ^ (x << 4)); }
__device__ __forceinline__ int v_st(int k, int c) { const int kk = (k & ~0xC) | ((k & 4) << 1) | ((k & 8) >> 1); return ((kk >> 3) * 4 + (c >> 5)) * 512 + ((kk & 7) * 32 + (c & 31)) * 2; }
__device__ __forceinline__ int v_rd_base(int lane) { return ((lane & 3) << 3) | (((lane >> 2) & 3) << 6) | (((lane >> 4) & 1) << 5) | (((lane >> 5) & 1) << 8); }
constexpr int v_rd_off(int d0, int ks, int half) { return d0 * 512 + ks * 4096 + half * 2048; }
template <int OFF> __device__ __forceinline__ s16x4 tr_read(unsigned vb) {
    s16x4 r; asm volatile("ds_read_b64_tr_b16 %0, %1 offset:%2" : "=&v"(r) : "v"(vb), "i"(OFF) : "memory"); return r;
}
template <int D0> __device__ __forceinline__ void pv_one(f32x16& od, unsigned vb, bf16x8 pa0, bf16x8 pa1, bf16x8 pa2, bf16x8 pa3) {
    const s16x4 l0 = tr_read<v_rd_off(D0, 0, 0)>(vb), h0 = tr_read<v_rd_off(D0, 0, 1)>(vb), l1 = tr_read<v_rd_off(D0, 1, 0)>(vb), h1 = tr_read<v_rd_off(D0, 1, 1)>(vb);
    const s16x4 l2 = tr_read<v_rd_off(D0, 2, 0)>(vb), h2 = tr_read<v_rd_off(D0, 2, 1)>(vb), l3 = tr_read<v_rd_off(D0, 3, 0)>(vb), h3 = tr_read<v_rd_off(D0, 3, 1)>(vb);
    asm volatile("s_waitcnt lgkmcnt(0)" ::: "memory"); SBAR();
#define PK(L, H) (bf16x8){L[0], L[1], L[2], L[3], H[0], H[1], H[2], H[3]}
    od = __builtin_amdgcn_mfma_f32_32x32x16_bf16(pa0, PK(l0, h0), od, 0, 0, 0);
    od = __builtin_amdgcn_mfma_f32_32x32x16_bf16(pa1, PK(l1, h1), od, 0, 0, 0);
    od = __builtin_amdgcn_mfma_f32_32x32x16_bf16(pa2, PK(l2, h2), od, 0, 0, 0);
    od = __builtin_amdgcn_mfma_f32_32x32x16_bf16(pa3, PK(l3, h3), od, 0, 0, 0);
#undef PK
}
__device__ __forceinline__ void pv_d0(f32x16 (&o)[4], unsigned vb, bf16x8 pa0, bf16x8 pa1, bf16x8 pa2, bf16x8 pa3) {
    pv_one<0>(o[0], vb, pa0, pa1, pa2, pa3); pv_one<1>(o[1], vb, pa0, pa1, pa2, pa3); pv_one<2>(o[2], vb, pa0, pa1, pa2, pa3); pv_one<3>(o[3], vb, pa0, pa1, pa2, pa3);
}
__device__ __forceinline__ void partialSM(f32x16& p0, f32x16& p1) {
#pragma unroll
    for (int r = 0; r < 16; ++r) p0[r] = __builtin_amdgcn_exp2f(p0[r]);
}
__device__ __forceinline__ void finishSM(f32x16& p0, f32x16& p1, float& l_reg, bf16x8& pa0, bf16x8& pa1, bf16x8& pa2, bf16x8& pa3) {
#pragma unroll
    for (int r = 0; r < 16; ++r) p1[r] = __builtin_amdgcn_exp2f(p1[r]);
    float ps = 0;
#pragma unroll
    for (int r = 0; r < 16; ++r) ps += p0[r];
#pragma unroll
    for (int r = 0; r < 16; ++r) ps += p1[r];
    l_reg += ps;
#define PK8(P, BASE, OUT) do { u32x4 w = {cvt_pk_bf16(P[BASE + 0], P[BASE + 1]), cvt_pk_bf16(P[BASE + 2], P[BASE + 3]), cvt_pk_bf16(P[BASE + 4], P[BASE + 5]), cvt_pk_bf16(P[BASE + 6], P[BASE + 7])}; \
    OUT = *reinterpret_cast<bf16x8*>(&w); } while (0)
    PK8(p0, 0, pa0); PK8(p0, 8, pa1); PK8(p1, 0, pa2); PK8(p1, 8, pa3);
#undef PK8
}
template <int DQK>
__device__ __forceinline__ void qkt(f32x16& p0, f32x16& p1, const LAS char* Ks, const bf16x8 (&qr)[DQK / 16], const int (&ka)[8], float nMB) {
    constexpr int RB = DQK * 2, NA = (RB == 256) ? 8 : 4;
#pragma unroll
    for (int r = 0; r < 16; ++r) { p0[r] = nMB; p1[r] = nMB; }
#pragma unroll
    for (int d0 = 0; d0 < DQK / 16; ++d0) {
        const LAS char* a = Ks + ka[d0 % NA] + (d0 / NA) * (NA * 32);
        const bf16x8 b0 = *(const LAS bf16x8*)(a);
        const bf16x8 b1 = *(const LAS bf16x8*)(a + 32 * RB);
        p0 = __builtin_amdgcn_mfma_f32_32x32x16_bf16(b0, qr[d0], p0, 0, 0, 0);
        p1 = __builtin_amdgcn_mfma_f32_32x32x16_bf16(b1, qr[d0], p1, 0, 0, 0); }
}
constexpr int V_BYTES = 64 * 128 * 2, K_OFF = 3 * V_BYTES, K_STRIDE = 64 * 192 * 2, LI_OFF = K_OFF + 3 * K_STRIDE;

template <int DQK, bool DOUBLE>
__device__ __forceinline__ void attn_pass(const bf16_t* __restrict__ Q, int ldq, const bf16_t* __restrict__ Kg, int ldk, const bf16_t* __restrict__ Vg, int ldv,
                                          int rowc, int rowl, int NT, float nMB, f32x16 (&o)[4], float& l_reg, LAS char* lds, int tid) {
    constexpr int RB = DQK * 2, NCH = DQK / 8, NLD = NCH / 8;
    const int wid = __builtin_amdgcn_readfirstlane(tid >> 6), lane = tid & 63, r32 = lane & 31, hi = lane >> 5;
    LAS char* V_lds = lds; LAS char* K_lds = lds + K_OFF;
    bf16x8 qr[DQK / 16];
    { const bf16_t* Qw = Q + (size_t)(wid * 32 + r32) * ldq + hi * 8;
#pragma unroll
      for (int d0 = 0; d0 < DQK / 16; ++d0) qr[d0] = *(const bf16x8*)(Qw + d0 * 16); }
#pragma unroll
    for (int d = 0; d < 4; ++d) o[d] = f32x16{};
    l_reg = 0.f;
    int vrow[2], vcol[2], krow[NLD], kcol[NLD];
#pragma unroll
    for (int i = 0; i < 2; ++i) { const int q = tid + 512 * i, sub = q >> 5, within = q & 31, kk = (sub >> 2) * 8 + (within >> 2);
        vrow[i] = kk; vcol[i] = (sub & 3) * 32 + (within & 3) * 8; }
#pragma unroll
    for (int i = 0; i < NLD; ++i) { const int q = tid + 512 * i, row = q / NCH, chp = q % NCH; const int x = (RB == 256) ? (row & 15) : ((row >> 1) & 7);
        krow[i] = row; kcol[i] = (chp ^ x) * 8; }
    const unsigned vb0 = (unsigned)(uintptr_t)V_lds + v_rd_base(lane);
    int ka[8];
#pragma unroll
    for (int q = 0; q < 8; ++q) ka[q] = kswz<RB>(r32, q * 32 + hi * 16);
#define KROW0(j) ((j) < 4 ? rowc + 64 * (j) : rowl + 64 * ((j) - 4))
#define DMA(j, b) do { const size_t _r0 = (size_t)KROW0(j); \
    _Pragma("unroll") for (int _i = 0; _i < 2; ++_i) __builtin_amdgcn_global_load_lds((const unsigned*)(Vg + (_r0 + vrow[_i]) * ldv + vcol[_i]), (LAS unsigned*)(V_lds + (b) * V_BYTES + wid * 1024 + _i * 8192), 16, 0, 0); \
    _Pragma("unroll") for (int _i = 0; _i < NLD; ++_i) __builtin_amdgcn_global_load_lds((const unsigned*)(Kg + (_r0 + krow[_i]) * ldk + kcol[_i]), (LAS unsigned*)(K_lds + (b) * K_STRIDE + wid * 1024 + _i * 8192), 16, 0, 0); } while (0)
#define VMW0() asm volatile("s_waitcnt vmcnt(0)" ::: "memory")
    bf16x8 pa0, pa1, pa2, pa3;
    __syncthreads();
    DMA(0, 0); DMA(1, 1); VMW0(); __syncthreads();
    if constexpr (!DOUBLE) {
        f32x16 p0, p1;
        DMA(2, 2);
        int bc = 0, bn = 1, bf = 2;
        for (int j = 0; j < NT; ++j) {
            SBAR(); qkt<DQK>(p0, p1, K_lds + bc * K_STRIDE, qr, ka, nMB);
            partialSM(p0, p1); finishSM(p0, p1, l_reg, pa0, pa1, pa2, pa3); SBAR();
            pv_d0(o, vb0 + bc * V_BYTES, pa0, pa1, pa2, pa3);
            if (j + 1 < NT) { VMW0(); __syncthreads(); if (j + 3 < NT) DMA(j + 3, bc); }
            { const int _t = bc; bc = bn; bn = bf; bf = _t; }
        }
    } else {
    f32x16 pA0, pA1, pB0, pB1;
    qkt<DQK>(pA0, pA1, K_lds, qr, ka, nMB); partialSM(pA0, pA1);
    DMA(2, 2);
    int bp = 0, bc = 1, bn = 2;
#define STEP(j, PC0, PC1, PP0, PP1) do { \
        SBAR(); qkt<DQK>(PC0, PC1, K_lds + bc * K_STRIDE, qr, ka, nMB); \
        finishSM(PP0, PP1, l_reg, pa0, pa1, pa2, pa3); SBAR(); \
        pv_d0(o, vb0 + bp * V_BYTES, pa0, pa1, pa2, pa3); partialSM(PC0, PC1); \
        if ((j) + 1 < NT) { VMW0(); __syncthreads(); if ((j) + 2 < NT) DMA((j) + 2, bp); } \
        { const int _t = bp; bp = bc; bc = bn; bn = _t; } } while (0)
    for (int j = 1; j < NT; j += 2) {
        STEP(j, pB0, pB1, pA0, pA1);
        if (j + 1 < NT) STEP(j + 1, pA0, pA1, pB0, pB1);
    }
    finishSM(pB0, pB1, l_reg, pa0, pa1, pa2, pa3); SBAR();
    pv_d0(o, vb0 + bp * V_BYTES, pa0, pa1, pa2, pa3);
    }
#undef KROW0
#undef DMA
#undef VMW0
#undef STEP
}
__device__ __forceinline__ void row_recip(float l_reg, float (&rli)[16], LAS float* li, int r32, int hi) {
    { auto rr = __builtin_amdgcn_permlane32_swap(__float_as_uint(l_reg), __float_as_uint(l_reg), false, false);
      l_reg = __uint_as_float(rr[0]) + __uint_as_float(rr[1]); }
    if (hi == 0) li[r32] = l_reg;
    asm volatile("s_waitcnt lgkmcnt(0)" ::: "memory");
#pragma unroll
    for (int r = 0; r < 16; ++r) rli[r] = __builtin_amdgcn_rcpf(li[crow(r, hi)]);
    asm volatile("s_waitcnt lgkmcnt(0)" ::: "memory");
}
}

struct AttnBufs { const bf16_t *QA, *KA, *VA, *QB, *KB, *VB, *QC, *KC, *VC, *GATE; bf16_t* BR; float* SCR; const float* lamv; const float* subln; float lam_init; };

template <bool SUBLN>
__device__ __forceinline__ void attn_out(const AttnBufs& T, f32x16 (&o)[4], int type, int h, size_t orow0, LAS char* lds, int wid, int lane, int r32, int hi) {
    __syncthreads();
    LAS float* stg = (LAS float*)(lds + wid * 16896);
#pragma unroll
    for (int d0 = 0; d0 < 4; ++d0)
#pragma unroll
        for (int r = 0; r < 16; ++r) stg[att::crow(r, hi) * 132 + d0 * 32 + r32] = o[d0][r];
    asm volatile("s_waitcnt lgkmcnt(0)" ::: "memory");
    const int rr = lane >> 5, c4 = (lane & 31) * 4;
    const int col = type * 1024 + h * 128 + c4;
    f32x4 wsub = {1.f, 1.f, 1.f, 1.f};
    if (SUBLN) { wsub = *(const f32x4*)(T.subln + c4) * (1.f - T.lam_init); }
    const bf16_t* gp = T.GATE + (orow0 + rr) * 3072 + col; bf16_t* op = T.BR + (orow0 + rr) * 3072 + col;
#pragma unroll 4
    for (int i = 0; i < 16; ++i) {
        f32x4 v = *(const LAS f32x4*)(stg + (2 * i + rr) * 132 + c4);
        const u32x2 gg = *(const u32x2*)(gp + (size_t)i * 2 * 3072);
        if (SUBLN) {
            float s = (v[0] * v[0] + v[1] * v[1]) + (v[2] * v[2] + v[3] * v[3]);
            s += __shfl_xor(s, 1); s += __shfl_xor(s, 2); s += __shfl_xor(s, 4); s += __shfl_xor(s, 8); s += __shfl_xor(s, 16);
            v = v * (rsqrtf(s * (1.f / 128.f) + EPS)) * wsub;
        }
        u32x2 w; w.x = cvt_pk_bf16(v[0] * bf2f(gg.x & 0xffffu), v[1] * bf2f(gg.x >> 16)); w.y = cvt_pk_bf16(v[2] * bf2f(gg.y & 0xffffu), v[3] * bf2f(gg.y >> 16));
        *(u32x2*)(op + (size_t)i * 2 * 3072) = w;
    }
}

__device__ __forceinline__ void attn_item(const AttnBufs& T, int type, int b, int h, int qrow0, int NT, LAS char* lds, int tid_) {
    asm volatile("" : "+v"(tid_));
    const int tid = tid_, wid = __builtin_amdgcn_readfirstlane(tid >> 6), lane = tid & 63, r32 = lane & 31, hi = lane >> 5;
    const int rowc = MLAT + b * CTXL, rowl = b * SEQ;
    LAS float* li = (LAS float*)(lds + att::LI_OFF) + wid * 64;
    constexpr float LOG2E = 1.4426950408889634f;
    const size_t orow0 = (size_t)qrow0 + wid * 32;
    if (type == 0 && (MK_ATYPE & 1)) {
        f32x16 o[4]; float l_reg; float rli[16];
        att::attn_pass<128, ATT_DBL>(T.QA + (size_t)qrow0 * 1024 + h * 128, 1024, T.KA + (h >> 2) * 128, 256, T.VA + (h >> 2) * 128, 256, rowc, rowl, NT,
                            T.lamv[1], o, l_reg, lds, tid);
        att::row_recip(l_reg, rli, li, r32, hi);
#pragma unroll
        for (int d0 = 0; d0 < 4; ++d0)
#pragma unroll
            for (int r = 0; r < 16; ++r) o[d0][r] *= rli[r];
        attn_out<false>(T, o, 0, h, orow0, lds, wid, lane, r32, hi);
    } else if (type == 1 && (MK_ATYPE & 2)) {
        f32x16 o[4]; float l_reg; float rli[16];
        att::attn_pass<192, false>(T.QB + (size_t)qrow0 * 1536 + h * 192, 1536, T.KB + h * 192, 1536, T.VB + h * 128, 1024, rowc, rowl, NT,
                            T.lamv[2], o, l_reg, lds, tid);
        att::row_recip(l_reg, rli, li, r32, hi);
#pragma unroll
        for (int d0 = 0; d0 < 4; ++d0)
#pragma unroll
            for (int r = 0; r < 16; ++r) o[d0][r] *= rli[r];
        attn_out<false>(T, o, 1, h, orow0, lds, wid, lane, r32, hi);
    } else if (MK_ATYPE & 4) {
        f32x16 o[4]; float l_reg; float rli[16];
        att::attn_pass<64, ATT_DBL>(T.QC + (size_t)qrow0 * 1024 + h * 128, 1024, T.KC + h * 128, 1024, T.VC + h * 128, 1024, rowc, rowl, NT,
                           T.lamv[3], o, l_reg, lds, tid);
        att::row_recip(l_reg, rli, li, r32, hi);
        f32x4* scr = (f32x4*)(T.SCR + ((size_t)blockIdx.x * 512 + tid) * 64);
#pragma unroll
        for (int d0 = 0; d0 < 4; ++d0)
#pragma unroll
            for (int q = 0; q < 4; ++q) scr[d0 * 4 + q] = (f32x4){o[d0][q * 4] * rli[q * 4], o[d0][q * 4 + 1] * rli[q * 4 + 1], o[d0][q * 4 + 2] * rli[q * 4 + 2], o[d0][q * 4 + 3] * rli[q * 4 + 3]};
        att::attn_pass<64, ATT_DBL>(T.QC + (size_t)qrow0 * 1024 + h * 128 + 64, 1024, T.KC + h * 128 + 64, 1024, T.VC + h * 128, 1024, rowc, rowl, NT,
                           T.lamv[3], o, l_reg, lds, tid);
        att::row_recip(l_reg, rli, li, r32, hi);
        const float lam = T.lamv[0];
#pragma unroll
        for (int d0 = 0; d0 < 4; ++d0)
#pragma unroll
            for (int q = 0; q < 4; ++q) { const f32x4 a = scr[d0 * 4 + q];
#pragma unroll
                for (int j = 0; j < 4; ++j) o[d0][q * 4 + j] = a[j] - lam * (o[d0][q * 4 + j] * rli[q * 4 + j]); }
        attn_out<true>(T, o, 2, h, orow0, lds, wid, lane, r32, hi);
    }
}

__device__ __forceinline__ void transpose_item(const float* __restrict__ W, int ldw, int k0, int srccol4, const float* __restrict__ kscale,
                                               bf16_t* __restrict__ WT, int ldt, int n0, int kdst0, LAS float* scr, int lane) {
    const int ks = lane >> 4, n4 = (lane & 15) * 4;
#pragma unroll 8
    for (int i = 0; i < 16; ++i) { const int kk = 4 * i + ks;
        f32x4 v = srccol4 >= 0 ? *(const f32x4*)(W + (size_t)(k0 + kk) * ldw + srccol4) : (f32x4){0.f, 0.f, 0.f, 0.f};
        if (kscale) v = v * kscale[k0 + kk];
        LAS float* d = scr + kk * 65 + n4; d[0] = v[0]; d[1] = v[1]; d[2] = v[2]; d[3] = v[3]; }
    asm volatile("s_waitcnt lgkmcnt(0)" ::: "memory");
    const int nn = lane & 7, c = lane >> 3;
#pragma unroll
    for (int j = 0; j < 8; ++j) { const int n = nn + 8 * j; const LAS float* s = scr + (8 * c) * 65 + n;
        u32x4 o; o.x = cvt_pk_bf16(s[0 * 65], s[1 * 65]); o.y = cvt_pk_bf16(s[2 * 65], s[3 * 65]); o.z = cvt_pk_bf16(s[4 * 65], s[5 * 65]); o.w = cvt_pk_bf16(s[6 * 65], s[7 * 65]);
        *(u32x4*)(WT + (size_t)(n0 + n) * ldt + kdst0 + k0 + 8 * c) = o; }
    asm volatile("s_waitcnt lgkmcnt(0)" ::: "memory");
}
__device__ const float INVF32[16] = {1.000000000e+00f, 5.623413324e-01f, 3.162277639e-01f, 1.778279394e-01f, 1.000000015e-01f, 5.623413250e-02f, 3.162277490e-02f, 1.778279431e-02f,
    9.999999776e-03f, 5.623413250e-03f, 3.162277630e-03f, 1.778279431e-03f, 1.000000047e-03f, 5.623413017e-04f, 3.162277571e-04f, 1.778279402e-04f};
__device__ const float INVF64[32] = {1.000000000e+00f, 7.498942614e-01f, 5.623413324e-01f, 4.216965139e-01f, 3.162277639e-01f, 2.371373773e-01f, 1.778279394e-01f, 1.333521307e-01f,
    1.000000015e-01f, 7.498941571e-02f, 5.623413250e-02f, 4.216965288e-02f, 3.162277490e-02f, 2.371373773e-02f, 1.778279431e-02f, 1.333521493e-02f, 9.999999776e-03f, 7.498941850e-03f,
    5.623413250e-03f, 4.216964822e-03f, 3.162277630e-03f, 2.371373586e-03f, 1.778279431e-03f, 1.333521446e-03f, 1.000000047e-03f, 7.498942432e-04f, 5.623413017e-04f, 4.216965172e-04f,
    3.162277571e-04f, 2.371373703e-04f, 1.778279402e-04f, 1.333521504e-04f};
__device__ __forceinline__ void sincos_d(double x, float& s, float& c) {
    const double twopi = 6.283185307179586476925;
    const double k = __builtin_rint(x / twopi), r = x - k * twopi, r2 = r * r;
    double st = r, ct = 1.0, ss = r, cs = 1.0;
    for (int n = 1; n <= 16; ++n) { ct *= -r2 / (double)((2 * n - 1) * (2 * n)); st *= -r2 / (double)((2 * n) * (2 * n + 1)); cs += ct; ss += st; }
    s = (float)ss; c = (float)cs;
}
__device__ __forceinline__ float absmax_n(const float* w, int n) { float m = 0.f; for (int i = 0; i < n; ++i) m = fmaxf(m, fabsf(w[i])); return m; }

typedef unsigned v4u_unused_t;
#define XB_TMO      128
#define XB_XCNT(j)  (256  + 64 * (j))
#define XB_XSUB(j)  (1280 + 64 * (j))
#define XB_XGEN(j)  (2304 + 64 * (j))
#define XB_TOP      3328
#define XB_TOPGEN   3392
#define XCD_BAR_WORDS 3456
#define XB_SPIN_CAP (1u << 18)

__device__ __forceinline__ unsigned xb_ld(unsigned* p)              { return __hip_atomic_load(p, __ATOMIC_RELAXED, __HIP_MEMORY_SCOPE_AGENT); }
__device__ __forceinline__ unsigned xb_add(unsigned* p, unsigned v) { return __hip_atomic_fetch_add(p, v, __ATOMIC_RELAXED, __HIP_MEMORY_SCOPE_AGENT); }
__device__ __forceinline__ unsigned xb_xcc_id() { return (unsigned)__builtin_amdgcn_s_getreg((3 << 11) | 20) & 0xFu; }
#define XB_SPIN(cond, bar) do { unsigned _sp = 0; while (cond) { __builtin_amdgcn_s_sleep(1); \
    if ((++_sp & 255u) == 0u) { if (xb_ld(&(bar)[XB_TMO])) break; if (_sp > XB_SPIN_CAP) { atomicAdd(&(bar)[XB_TMO], 1u); break; } } } } while (0)

struct XcdBarrier {
    unsigned* bar; unsigned x;
    volatile LAS unsigned* st;
};

__device__ __forceinline__ XcdBarrier xcd_barrier_post(unsigned* bar, volatile LAS unsigned* st) {
    XcdBarrier b; b.bar = bar; b.x = xb_xcc_id(); b.st = st;
    if (threadIdx.x == 0) (void)xb_add(&bar[XB_XCNT(b.x)], 1u);
    return b;
}
__device__ __forceinline__ void xcd_barrier_complete(unsigned* bar, unsigned x, unsigned& nloc, unsigned& nx) {
    const unsigned G = gridDim.x * gridDim.y * gridDim.z;
    unsigned sum, cnt, mine, sp = 0u;
    for (;;) {
        sum = 0u; cnt = 0u; mine = 0u;
#pragma unroll
        for (unsigned j = 0; j < 16; ++j) { const unsigned c = xb_ld(&bar[XB_XCNT(j)]); sum += c; cnt += (c > 0u) ? 1u : 0u; mine = (j == x) ? c : mine; }
        if (sum == G) break;
        __builtin_amdgcn_s_sleep(1);
        if ((++sp & 255u) == 0u) { if (xb_ld(&bar[XB_TMO])) break; if (sp > XB_SPIN_CAP) { atomicAdd(&bar[XB_TMO], 1u); break; } }
    }
    nloc = mine > 0u ? mine : 1u; nx = cnt > 0u ? cnt : 1u;
}

__device__ __forceinline__ void xcd_barrier(const XcdBarrier& b) {
    asm volatile("s_waitcnt vmcnt(0)" ::: "memory");
    __syncthreads();
    if (threadIdx.x == 0) {
        unsigned* bar = b.bar;
        __builtin_amdgcn_s_waitcnt(0);
        unsigned nloc = b.st[0], nx = b.st[1];
        if (nloc == 0u) { xcd_barrier_complete(bar, b.x, nloc, nx); b.st[0] = nloc; b.st[1] = nx; }
        const unsigned old = xb_add(&bar[XB_XSUB(b.x)], 1u);
        const unsigned gen = old / nloc;
        if (old + 1u == (gen + 1u) * nloc) {
            __builtin_amdgcn_fence(__ATOMIC_RELEASE, "agent");
            asm volatile("s_waitcnt vmcnt(0)" ::: "memory");
            const unsigned og = xb_add(&bar[XB_TOP], 1u);
            const unsigned tg = og / nx;
            if (og + 1u == (tg + 1u) * nx) xb_add(&bar[XB_TOPGEN], 1u);
            else XB_SPIN(xb_ld(&bar[XB_TOPGEN]) == tg, bar);
            __builtin_amdgcn_fence(__ATOMIC_ACQUIRE, "agent");
            xb_add(&bar[XB_XGEN(b.x)], 1u);
            asm volatile("s_waitcnt vmcnt(0)" ::: "memory");
        } else {
            XB_SPIN(xb_ld(&bar[XB_XGEN(b.x)]) == gen, bar);
            __builtin_amdgcn_fence(__ATOMIC_ACQUIRE, "agent");
            asm volatile("s_waitcnt vmcnt(0)" ::: "memory");
        }
    }
    __syncthreads();
}

__device__ __forceinline__ void p1_row(int row, const float* __restrict__ xsrc, const float* __restrict__ csrc, const float* __restrict__ modl, const float* __restrict__ nw,
                                       bf16_t* __restrict__ H, int lane) {
    const bool lat = row < MLAT; const int mi = lat ? (row >> 12) : 4;
    const f32x4* xr = (const f32x4*)(lat ? xsrc + (size_t)row * DM : csrc + (size_t)(row - MLAT) * DM) + lane;
    f32x4 v[8]; float s = 0.f;
#pragma unroll
    for (int j = 0; j < 8; ++j) { v[j] = xr[64 * j]; s += (v[j][0] * v[j][0] + v[j][1] * v[j][1]) + (v[j][2] * v[j][2] + v[j][3] * v[j][3]); }
    const float rinv = rsqrtf(wave_sum(s) * (1.f / DM) + EPS);
    const f32x4* sh = (const f32x4*)(modl + mi * 6144) + lane; const f32x4* scl = (const f32x4*)(modl + mi * 6144 + DM) + lane; const f32x4* nwp = (const f32x4*)nw + lane;
    u32x2* o8 = (u32x2*)(H + (size_t)row * DM) + lane;
#pragma unroll
    for (int j = 0; j < 8; ++j) { const f32x4 y = v[j] * rinv * nwp[64 * j] * (scl[64 * j] + 1.f) + sh[64 * j];
        u32x2 w; w.x = cvt_pk_bf16(y[0], y[1]); w.y = cvt_pk_bf16(y[2], y[3]); o8[64 * j] = w; }
}

__device__ __forceinline__ void p1_row2(int rowA, int rowB, const float* __restrict__ xsrc, const float* __restrict__ csrc, const float* __restrict__ modl,
                                        const float* __restrict__ nw, bf16_t* __restrict__ H, int lane) {
    if (rowB < 0) { p1_row(rowA, xsrc, csrc, modl, nw, H, lane); return; }
    const bool latA = rowA < MLAT, latB = rowB < MLAT; const int miA = latA ? (rowA >> 12) : 4, miB = latB ? (rowB >> 12) : 4;
    const f32x4* xa = (const f32x4*)(latA ? xsrc + (size_t)rowA * DM : csrc + (size_t)(rowA - MLAT) * DM) + lane;
    const f32x4* xb = (const f32x4*)(latB ? xsrc + (size_t)rowB * DM : csrc + (size_t)(rowB - MLAT) * DM) + lane;
    f32x4 va[8], vb[8]; float sa = 0.f, sb = 0.f;
#pragma unroll
    for (int j = 0; j < 8; ++j) { va[j] = xa[64 * j]; vb[j] = xb[64 * j]; }
#pragma unroll
    for (int j = 0; j < 8; ++j) { sa += (va[j][0] * va[j][0] + va[j][1] * va[j][1]) + (va[j][2] * va[j][2] + va[j][3] * va[j][3]);
                                  sb += (vb[j][0] * vb[j][0] + vb[j][1] * vb[j][1]) + (vb[j][2] * vb[j][2] + vb[j][3] * vb[j][3]); }
    const float ra = rsqrtf(wave_sum(sa) * (1.f / DM) + EPS), rb = rsqrtf(wave_sum(sb) * (1.f / DM) + EPS);
    const f32x4* nwp = (const f32x4*)nw + lane;
    const f32x4* sha = (const f32x4*)(modl + miA * 6144) + lane; const f32x4* sca = (const f32x4*)(modl + miA * 6144 + DM) + lane;
    const f32x4* shb = (const f32x4*)(modl + miB * 6144) + lane; const f32x4* scb = (const f32x4*)(modl + miB * 6144 + DM) + lane;
    u32x2* oa = (u32x2*)(H + (size_t)rowA * DM) + lane; u32x2* ob = (u32x2*)(H + (size_t)rowB * DM) + lane;
#pragma unroll
    for (int j = 0; j < 8; ++j) { const f32x4 w4 = nwp[64 * j];
        const f32x4 ya = va[j] * ra * w4 * (sca[64 * j] + 1.f) + sha[64 * j], yb = vb[j] * rb * w4 * (scb[64 * j] + 1.f) + shb[64 * j];
        u32x2 wa, wb; wa.x = cvt_pk_bf16(ya[0], ya[1]); wa.y = cvt_pk_bf16(ya[2], ya[3]); wb.x = cvt_pk_bf16(yb[0], yb[1]); wb.y = cvt_pk_bf16(yb[2], yb[3]);
        oa[64 * j] = wa; ob[64 * j] = wb; }
}

struct Args { const float* in[29]; float* out; unsigned char* ws; int ph_lo, ph_hi, coop, pad; };

__global__ void __launch_bounds__(512, 2) mega_fwd(Args args) {
    extern __shared__ __attribute__((aligned(16))) unsigned char lds_raw[];
    LAS unsigned char* lds = (LAS unsigned char*)lds_raw;
    const int G = gridDim.x;
    unsigned char* ws = args.ws;
    float* MOD = (float*)(ws + WS_MOD);
    float* TC64 = (float*)(ws + WS_TC64); float* TS64 = (float*)(ws + WS_TS64); float* TC128 = (float*)(ws + WS_TC128); float* TS128 = (float*)(ws + WS_TS128);
    float* LAM = (float*)(ws + WS_LAM);
    bf16_t* WIN = (bf16_t*)(ws + WS_WIN); bf16_t* WUP = (bf16_t*)(ws + WS_WUP); bf16_t* WBR = (bf16_t*)(ws + WS_WBR); bf16_t* WOUT = (bf16_t*)(ws + WS_WOUT);
    bf16_t* H = (bf16_t*)(ws + WS_H); bf16_t* QA = (bf16_t*)(ws + WS_QA); bf16_t* KA = (bf16_t*)(ws + WS_KA); bf16_t* VA = (bf16_t*)(ws + WS_VA);
    bf16_t* QB = (bf16_t*)(ws + WS_QB); bf16_t* KB = (bf16_t*)(ws + WS_KB); bf16_t* CKV = (bf16_t*)(ws + WS_CKV); bf16_t* VB = (bf16_t*)(ws + WS_VB);
    bf16_t* QC = (bf16_t*)(ws + WS_QC); bf16_t* KC = (bf16_t*)(ws + WS_KC); bf16_t* VC = (bf16_t*)(ws + WS_VC);
    bf16_t* GATE = (bf16_t*)(ws + WS_GATE); bf16_t* MRG = (bf16_t*)(ws + WS_MRG); bf16_t* BR = (bf16_t*)(ws + WS_BR); bf16_t* Y = (bf16_t*)(ws + WS_Y);
    float* SS = (float*)(ws + WS_SS); float* CTXW = (float*)(ws + WS_CTXW); float* SCR = (float*)(ws + WS_SCR);
    LAS float* xch = (LAS float*)(lds + XCH_OFF);
    volatile LAS unsigned* bst = (volatile LAS unsigned*)(lds + XCH_OFF + 4096);
    if (threadIdx.x < 2) bst[threadIdx.x] = 0u;
    __syncthreads();
    XcdBarrier bar = xcd_barrier_post((unsigned*)(ws + WS_BAR), bst);

    for (int ph = args.ph_lo; ph < args.ph_hi; ++ph) {
        int bx = blockIdx.x; asm volatile("" : "+s"(bx));
        const int vcu = (G % 8 == 0) ? (bx % 8) * (G / 8) + bx / 8 : bx;
        int tid = threadIdx.x; asm volatile("" : "+v"(tid));
        const int lane = tid & 63, wave = __builtin_amdgcn_readfirstlane(tid >> 6);
        if (ph == 0 && (MK_MASK & 1)) {
            {
                LAS float* sc = (LAS float*)lds;
                LAS float* red = (LAS float*)(lds + 65536);
                for (int i = tid; i < 5 * DM; i += 512) { const float v = i < 4 * DM ? args.in[1][i] : args.in[3][i - 4 * DM]; sc[i] = silu_f(v); }
                __syncthreads();
                for (int it = bx; it < DEPTH * 96; it += G) {
                    const int l = it / 96, n0 = (it % 96) * 64;
                    const float* W = args.in[5] + (size_t)l * DM * 6144 + n0 + lane;
                    float a0 = 0.f, a1 = 0.f, a2 = 0.f, a3 = 0.f, a4 = 0.f;
                    const int kb = wave * 256;
#pragma unroll 8
                    for (int k = 0; k < 256; ++k) { const float wv = W[(size_t)(kb + k) * 6144];
                        a0 += sc[kb + k] * wv; a1 += sc[DM + kb + k] * wv; a2 += sc[2 * DM + kb + k] * wv; a3 += sc[3 * DM + kb + k] * wv; a4 += sc[4 * DM + kb + k] * wv; }
                    red[(wave * 5 + 0) * 64 + lane] = a0; red[(wave * 5 + 1) * 64 + lane] = a1; red[(wave * 5 + 2) * 64 + lane] = a2; red[(wave * 5 + 3) * 64 + lane] = a3; red[(wave * 5 + 4) * 64 + lane] = a4;
                    __syncthreads();
                    if (tid < 320) { const int i = tid >> 6; float s = 0.f;
                        for (int w8 = 0; w8 < 8; ++w8) s += red[(w8 * 5 + i) * 64 + lane];
                        MOD[((size_t)l * 5 + i) * 6144 + n0 + lane] = s + args.in[6][(size_t)l * 6144 + n0 + lane]; }
                    __syncthreads();
                }
            }
            if (bx == 1 % G) {
                for (int i = tid; i < 64 * 16; i += 512) { const int pos = i >> 4, f = i & 15; const float ang = (float)pos * INVF32[f]; float s, c; sincos_d((double)ang, s, c); TC64[i] = c; TS64[i] = s; }
                for (int i = tid; i < 64 * 32; i += 512) { const int pos = i >> 5, f = i & 31; const float ang = (float)pos * INVF64[f]; float s, c; sincos_d((double)ang, s, c); TC128[i] = c; TS128[i] = s; }
            }
            if (bx == 2 % G && tid < DEPTH) {
                const int l = tid;
                float s1 = 0.f, s2 = 0.f;
                for (int i = 0; i < 64; ++i) { s1 += args.in[20][l * 64 + i] * args.in[21][l * 64 + i]; s2 += args.in[22][l * 64 + i] * args.in[23][l * 64 + i]; }
                const float lam_init = 0.8f - 0.6f * expf(-0.3f * (float)l);
                LAM[l * 4 + 0] = expf(s1) - expf(s2) + lam_init;
                const float mAq = absmax_n(args.in[9] + l * 128, 128), mAk = absmax_n(args.in[10] + l * 128, 128);
                const float mBqn = absmax_n(args.in[11] + l * 128, 128), mBqr = absmax_n(args.in[12] + l * 64, 64), mBkn = absmax_n(args.in[16] + l * 128, 128), mBkr = absmax_n(args.in[17] + l * 64, 64);
                const float mCq = absmax_n(args.in[18] + l * 64, 64), mCk = absmax_n(args.in[19] + l * 64, 64);
                const float L2E = 1.4426950408889634f;
                LAM[l * 4 + 1] = -(sqrtf(128.f) * mAq * mAk) * L2E;
                LAM[l * 4 + 2] = -(sqrtf(128.f * mBqn * mBqn + 64.f * mBqr * mBqr) * sqrtf(128.f * mBkn * mBkn + 64.f * mBkr * mBkr) * 0.07216878364870323f) * L2E;
                LAM[l * 4 + 3] = -(8.f * mCq * mCk) * L2E;
            }
            __syncthreads();
            {
                LAS float* scr = (LAS float*)(lds + wave * 16640);
                const int gw = vcu * 8 + wave, NGW = G * 8;
                constexpr int I_IN = 32 * (NIN / 64), I_UP = 8 * 32, I_BR = 3 * 16 * 32, I_OUT = 32 * 32, I_L = I_IN + I_UP + I_BR + I_OUT;
                const int n4 = (lane & 15) * 4;
                for (int it = gw; it < DEPTH * I_L; it += NGW) {
                    const int l = it / I_L; int r = it % I_L;
                    if (r < I_IN) { const int nb = r % (NIN / 64), kb = r / (NIN / 64); const int n0 = nb * 64;
                        transpose_item(args.in[7] + (size_t)l * DM * INC, INC, kb * 64, in_src_col(n0 + n4), nullptr, WIN + (size_t)l * NIN * DM, DM, n0, 0, scr, lane); continue; }
                    r -= I_IN;
                    if (r < I_UP) { const int nb = r % 32, kb = r / 32; const int n0 = nb * 64; const int sc_ = up_src_col(n0 + n4);
                        const float* W = (sc_ < 1024 ? args.in[14] : args.in[15]) + (size_t)l * 512 * 1024;
                        transpose_item(W, 1024, kb * 64, sc_ & 1023, args.in[13] + l * 512, WUP + (size_t)l * 2048 * 512, 512, n0, 0, scr, lane); continue; }
                    r -= I_UP;
                    if (r < I_BR) { const int br = r / (16 * 32), r2 = r % (16 * 32); const int nb = r2 % 32, kb = r2 / 32; const int n0 = nb * 64;
                        transpose_item(args.in[25 + br] + (size_t)l * 1024 * DM, DM, kb * 64, n0 + n4, nullptr, WBR + (size_t)l * 2048 * 3072, 3072, n0, br * 1024, scr, lane); continue; }
                    r -= I_BR;
                    { const int nb = r % 32, kb = r / 32; const int n0 = nb * 64;
                      transpose_item(args.in[28] + (size_t)l * DM * DM, DM, kb * 64, n0 + n4, nullptr, WOUT + (size_t)l * DM * DM, DM, n0, 0, scr, lane); }
                }
            }
        } else {
            const int l = (ph == 1) ? 0 : (ph - 2) / 3, st_ = (ph == 1) ? 0 : 1 + (ph - 2) % 3, st = (st_ >= 2) ? st_ + 1 : st_;
            const float* xsrc = (l == 0) ? args.in[0] : args.out;
            const float* csrc = (l == 0) ? args.in[2] : CTXW;
            const float* modl = MOD + (size_t)l * 5 * 6144;
            const int Mrows = (l == DEPTH - 1) ? MLAT : MTOT;
            if (st == 0 && (MK_MASK & 2)) {
                const float* nw = args.in[4] + (size_t)l * DM;
                for (int row = bx * 8 + wave; row < MTOT; row += G * 16) { const int rb = row + G * 8; p1_row2(row, rb < MTOT ? rb : -1, xsrc, csrc, modl, nw, H, lane); }
            } else if (st == 1 && (MK_MASK & 4)) {
                pg8::Gemm g{H, WIN + (size_t)l * NIN * DM, MTOT, NIN, DM}; pg8::StaticOrder S; S.init(MTOT, NIN, G, bx);
                EpiIn E{QA, KA, VA, QB, KB, CKV, QC, KC, VC, GATE, MRG, SS,
                        args.in[9] + l * 128, args.in[10] + l * 128, args.in[11] + l * 128, args.in[12] + l * 64, args.in[17] + l * 64, args.in[18] + l * 64, args.in[19] + l * 64,
                        args.in[8] + (size_t)l * 6144, TC64, TS64, TC128, TS128, xch};
                pg8::gemm_phase<EpiIn>(lds, g, S, E, tid);
            } else if (st == 3 && (MK_MASK & 16)) {
                unsigned* UPC = (unsigned*)(ws + WS_CNT) + (size_t)(2 * DEPTH * 68 + l) * 64;
                const bool merged = (G == 256) && args.coop;
                {
                    pg8::Gemm g{CKV, WUP + (size_t)l * 2048 * 512, MTOT, 2048, 512}; pg8::StaticOrder S; S.init(MTOT, 2048, G, bx);
                    EpiUp E{KB, VB, SS, args.in[16] + l * 128, xch};
                    pg8::gemm_phase<EpiUp>(lds, g, S, E, tid);
                    if (merged) {
                        if (threadIdx.x == 0) {
                            __builtin_amdgcn_fence(__ATOMIC_RELEASE, "agent");
                            asm volatile("s_waitcnt vmcnt(0)" ::: "memory");
                            const unsigned n = (bx < 544) ? (unsigned)((544 - 1 - bx) / G + 1) : 0u;
                            __hip_atomic_fetch_add(UPC, n, __ATOMIC_RELAXED, __HIP_MEMORY_SCOPE_AGENT);
                        }
                    } else if (args.coop) xcd_barrier(bar);
                }
                AttnBufs T{QA, KA, VA, QB, KB, VB, QC, KC, VC, GATE, BR, SCR, LAM + l * 4, args.in[24] + l * 128, 0.8f - 0.6f * expf(-0.3f * (float)l)};
                const int nctx = (l < DEPTH - 1) ? 96 : 0;
                for (int k = 0;; ++k) {
                    int type, b, h, qrow0, NT;
                    if (G == 256) {
                        if (k == 4 && merged) {
                            if (threadIdx.x == 0) { unsigned sp = 0;
                                while (__hip_atomic_load(UPC, __ATOMIC_RELAXED, __HIP_MEMORY_SCOPE_AGENT) < 544u) { __builtin_amdgcn_s_sleep(1); if (++sp > (1u << 22)) break; }
                                __builtin_amdgcn_fence(__ATOMIC_ACQUIRE, "agent");
                                asm volatile("s_waitcnt vmcnt(0)" ::: "memory"); }
                            __syncthreads();
                        }
                        if (k < 6) { const int id = (k & 1) * 256 + vcu; type = (k < 2) ? 0 : (k < 4 ? 2 : 1); b = id >> 7; h = (id >> 4) & 7; qrow0 = b * SEQ + (id & 15) * 256; NT = 68; }
                        else if (k == 6 && bx < nctx) { type = bx >> 5; b = (bx >> 3) & 3; h = bx & 7; qrow0 = MLAT + b * CTXL; NT = 4; }
                        else break;
                    } else {
                        const int it = bx + k * G; if (it >= 1536 + nctx) break;
                        if (it < 1536) { const int id = it & 511; type = it >> 9; b = id >> 7; h = (id >> 4) & 7; qrow0 = b * SEQ + (id & 15) * 256; NT = 68; }
                        else { const int c = it - 1536; type = c >> 5; b = (c >> 3) & 3; h = c & 7; qrow0 = MLAT + b * CTXL; NT = 4; }
                    }
                    attn_item(T, type, b, h, qrow0, NT, (LAS char*)lds, tid);
                }
                __syncthreads();
            } else {
                unsigned* CNT = (unsigned*)(ws + WS_CNT) + (size_t)l * 68 * 64;
                const bool merged = (G == 256) && args.coop;
                const bool ctxl = l < DEPTH - 1;
                pg8::Gemm g3{BR, WBR + (size_t)l * 2048 * 3072, Mrows, 2048, 3072}; EpiBr E3{MRG, Y};
                pg8::Gemm g4{Y, WOUT + (size_t)l * DM * DM, Mrows, DM, DM}; EpiOut E4{xsrc, csrc, args.out, CTXW, modl};
                for (int part = 0; part < 2; ++part) {
                    pg8::StaticOrder S;
                    if (!merged) { if (part) break; S.init(Mrows, 2048, G, bx); }
                    else if (part == 0) S.init(MLAT, 2048, G, bx);
                    else { if (!(ctxl && bx < 32)) break; S.init_one(64 + (bx >> 3), bx & 7); }
                    { int t2 = threadIdx.x; asm volatile("" : "+v"(t2)); pg8::gemm_phase<EpiBr>(lds, g3, S, E3, t2); }
                    if (merged && threadIdx.x == 0) {
                        __builtin_amdgcn_fence(__ATOMIC_RELEASE, "agent");
                        asm volatile("s_waitcnt vmcnt(0)" ::: "memory");
                        pg8::Unit u; for (int i = 0; S.next(i, u); ++i) __hip_atomic_fetch_add(&CNT[u.pm * 64], 1u, __ATOMIC_RELAXED, __HIP_MEMORY_SCOPE_AGENT);
                    }
                }
                if (!merged && args.coop) xcd_barrier(bar);
                for (int part = 0; part < 2; ++part) {
                    pg8::StaticOrder S;
                    if (!merged) { if (part) break; S.init(Mrows, DM, G, bx); }
                    else if (part == 0) S.init(MLAT, DM, G, bx);
                    else { if (!(ctxl && bx >= 32 && bx < 64)) break; S.init_one(64 + ((bx - 32) >> 3), bx & 7); }
                    if (merged) {
                        if (threadIdx.x == 0) {
                            pg8::Unit u;
                            for (int i = 0; S.next(i, u); ++i) { unsigned sp = 0;
                                while (__hip_atomic_load(&CNT[u.pm * 64], __ATOMIC_RELAXED, __HIP_MEMORY_SCOPE_AGENT) < 8u) { __builtin_amdgcn_s_sleep(1); if (++sp > (1u << 22)) break; } }
                            __builtin_amdgcn_fence(__ATOMIC_ACQUIRE, "agent");
                            asm volatile("s_waitcnt vmcnt(0)" ::: "memory");
                        }
                        __syncthreads();
                    }
                    { int t2 = threadIdx.x; asm volatile("" : "+v"(t2)); pg8::gemm_phase<EpiOut>(lds, g4, S, E4, t2); }
                    if (merged && ctxl && threadIdx.x == 0) {
                        __builtin_amdgcn_fence(__ATOMIC_RELEASE, "agent");
                        asm volatile("s_waitcnt vmcnt(0)" ::: "memory");
                        pg8::Unit u; for (int i = 0; S.next(i, u); ++i) __hip_atomic_fetch_add(&CNT[(DEPTH * 68 + u.pm) * 64], 1u, __ATOMIC_RELAXED, __HIP_MEMORY_SCOPE_AGENT);
                    }
                }
                if (l < DEPTH - 1) {
                    const float* nw1 = args.in[4] + (size_t)(l + 1) * DM; const float* mod1 = MOD + (size_t)(l + 1) * 5 * 6144;
                    int t3 = threadIdx.x; asm volatile("" : "+v"(t3));
                    const int lane3 = t3 & 63, wave3 = __builtin_amdgcn_readfirstlane(t3 >> 6);
                    if (merged) {
                        const int r0 = 68 * bx;
                        if (threadIdx.x == 0) {
                            for (int pm = r0 >> 8; pm <= (r0 + 67) >> 8; ++pm) { unsigned sp = 0;
                                while (__hip_atomic_load(&CNT[(DEPTH * 68 + pm) * 64], __ATOMIC_RELAXED, __HIP_MEMORY_SCOPE_AGENT) < 8u) { __builtin_amdgcn_s_sleep(1); if (++sp > (1u << 22)) break; } }
                            __builtin_amdgcn_fence(__ATOMIC_ACQUIRE, "agent");
                            asm volatile("s_waitcnt vmcnt(0)" ::: "memory");
                        }
                        __syncthreads();
                        for (int row = r0 + wave3; row < r0 + 68; row += 16) { const int rb = row + 8; p1_row2(row, rb < r0 + 68 ? rb : -1, args.out, CTXW, mod1, nw1, H, lane3); }
                    } else {
                        if (args.coop) xcd_barrier(bar);
                        for (int row = bx * 8 + wave3; row < MTOT; row += G * 16) { const int rb = row + G * 8; p1_row2(row, rb < MTOT ? rb : -1, args.out, CTXW, mod1, nw1, H, lane3); }
                    }
                }
            }
        }
        if (ph + 1 < args.ph_hi) { if (args.coop) { if (ph == 0) cg::this_grid().sync(); else xcd_barrier(bar); } }
    }
}

extern "C" void kernel_launch(void* const* d_in, const int* in_sizes, int n_in, void* d_out, int out_size, void* d_ws, size_t ws_size, hipStream_t stream) {
    static int grid = 0;
    if (grid == 0) {
        if (n_in != 29 || in_sizes[0] != MLAT * DM || out_size != MLAT * DM || ws_size < WS_END) {
            fprintf(stderr, "kernel_launch: unexpected shapes: n_in %d in0 %d out %d ws %zu (need %zu)\n", n_in, n_in > 0 ? in_sizes[0] : -1, out_size, ws_size, (size_t)WS_END); grid = -1; return; }
        int dev = 0, cus = 0, per_cu = 0;
        if (hipGetDevice(&dev) != hipSuccess || hipDeviceGetAttribute(&cus, hipDeviceAttributeMultiprocessorCount, dev) != hipSuccess) { grid = -1; return; }
        if (hipFuncSetAttribute((const void*)mega_fwd, hipFuncAttributeMaxDynamicSharedMemorySize, LDS_BYTES) != hipSuccess) { fprintf(stderr, "kernel_launch: hipFuncSetAttribute failed\n"); grid = -1; return; }
        if (hipOccupancyMaxActiveBlocksPerMultiprocessor(&per_cu, (const void*)mega_fwd, 512, LDS_BYTES) != hipSuccess || per_cu < 1) { fprintf(stderr, "kernel_launch: occupancy query gives %d\n", per_cu); per_cu = 1; }
        (void)hipGetLastError();
        grid = cus * 1;
    }
    if (grid < 0) return;
    Args a{};
    for (int i = 0; i < 29; ++i) a.in[i] = (const float*)d_in[i];
    a.out = (float*)d_out; a.ws = (unsigned char*)d_ws;
#if MK_COOP
    if (hipMemsetAsync((char*)d_ws + WS_BAR, 0, 16384 + CNT_BYTES, stream) != hipSuccess) { fprintf(stderr, "kernel_launch: memset of the barrier words failed\n"); return; }
    a.ph_lo = 0; a.ph_hi = NPH; a.coop = 1;
    void* kargs[] = {&a};
    hipError_t e = hipLaunchCooperativeKernel((const void*)mega_fwd, dim3(grid), dim3(512), kargs, LDS_BYTES, stream);
    if (e != hipSuccess) fprintf(stderr, "kernel_launch: cooperative launch failed: %s (grid %d)\n", hipGetErrorString(e), grid);
#else
    for (int ph = 0; ph < NPH; ++ph) {
        a.ph_lo = ph; a.ph_hi = ph + 1; a.coop = 0;
        hipLaunchKernelGGL(mega_fwd, dim3(grid), dim3(512), LDS_BYTES, stream, a);
    }
    const hipError_t le = hipPeekAtLastError();
    if (le != hipSuccess) fprintf(stderr, "kernel_launch: launch failed: %s\n", hipGetErrorName(le));
#endif
}
```

```cpp
#include <hip/hip_runtime.h>
#include <hip/hip_cooperative_groups.h>
#include <cstdio>
#include <cstdint>
namespace cg = cooperative_groups;

#ifndef MK_MASK
#define MK_MASK 127
#endif
#ifndef MK_ATYPE
#define MK_ATYPE 7
#endif
#ifndef MK_G1T
#define MK_G1T 127
#endif
#ifndef ATT_SD_A
#define ATT_SD_A 2
#endif
#ifndef ATT_SD_B
#define ATT_SD_B 1
#endif
#ifndef ATT_SD_C
#define ATT_SD_C 2
#endif
#ifndef ATT_DBL_B
#define ATT_DBL_B true
#endif
#ifndef ATT_DBL
#define ATT_DBL false
#endif
#ifndef QKT_GRP
#define QKT_GRP 0
#endif
#ifndef MK_COOP
#define MK_COOP 1
#endif

#define LAS __attribute__((address_space(3)))
typedef unsigned short bf16_t;
typedef short bf16x8 __attribute__((ext_vector_type(8)));
typedef short s16x4 __attribute__((ext_vector_type(4)));
typedef float f32x4 __attribute__((ext_vector_type(4)));
typedef float f32x16 __attribute__((ext_vector_type(16)));
typedef unsigned u32x4 __attribute__((ext_vector_type(4)));
typedef unsigned u32x2 __attribute__((ext_vector_type(2)));

constexpr int DM = 2048, NBATCH = 4, SEQ = 4096, CTXL = 256, DEPTH = 4;
constexpr int MLAT = NBATCH * SEQ, MCTX = NBATCH * CTXL, MTOT = MLAT + MCTX;
constexpr int INC = 15936, NIN = 16128;
constexpr float EPS = 1e-6f;
#ifndef MK_REP_ST
#define MK_REP_ST -1
#endif
constexpr int PPL = 5;
constexpr int NPH = 2 + 3 * DEPTH;

constexpr size_t alignup(size_t x) { return (x + 255) / 256 * 256; }
constexpr size_t WS_MOD = 0;
constexpr size_t WS_TC64 = WS_MOD + alignup((size_t)DEPTH * 5 * 6144 * 4);
constexpr size_t WS_TS64 = WS_TC64 + 4096, WS_TC128 = WS_TS64 + 4096, WS_TS128 = WS_TC128 + 8192;
constexpr size_t WS_LAM = WS_TS128 + 8192;
constexpr size_t WS_BAR = WS_LAM + 256;
constexpr size_t WS_CNT = WS_BAR + 16384;
constexpr size_t CNT_BYTES = (size_t)(2 * DEPTH * 68 + DEPTH) * 256;
constexpr size_t WS_WIN = WS_CNT + CNT_BYTES;
constexpr size_t WS_WUP = WS_WIN + (size_t)DEPTH * NIN * DM * 2;
constexpr size_t WS_WBR = WS_WUP + (size_t)DEPTH * 2048 * 512 * 2;
constexpr size_t WS_WOUT = WS_WBR + (size_t)DEPTH * 2048 * 3072 * 2;
constexpr size_t WS_H = WS_WOUT + (size_t)DEPTH * 2048 * 2048 * 2;
constexpr size_t WS_QA = WS_H + (size_t)MTOT * 2048 * 2;
constexpr size_t WS_KA = WS_QA + (size_t)MTOT * 1024 * 2;
constexpr size_t WS_VA = WS_KA + (size_t)MTOT * 256 * 2;
constexpr size_t WS_QB = WS_VA + (size_t)MTOT * 256 * 2;
constexpr size_t WS_KB = WS_QB + (size_t)MTOT * 1536 * 2;
constexpr size_t WS_CKV = WS_KB + (size_t)MTOT * 1536 * 2;
constexpr size_t WS_VB = WS_CKV + (size_t)MTOT * 512 * 2;
constexpr size_t WS_QC = WS_VB + (size_t)MTOT * 1024 * 2;
constexpr size_t WS_KC = WS_QC + (size_t)MTOT * 1024 * 2;
constexpr size_t WS_VC = WS_KC + (size_t)MTOT * 1024 * 2;
constexpr size_t WS_GATE = WS_VC + (size_t)MTOT * 1024 * 2;
constexpr size_t WS_MRG = WS_GATE + (size_t)MTOT * 3072 * 2;
constexpr size_t WS_BR = WS_MRG + (size_t)MTOT * 6144 * 2;
constexpr size_t WS_Y = WS_BR + (size_t)MTOT * 3072 * 2;
constexpr size_t WS_SS = WS_Y + (size_t)MTOT * 2048 * 2;
constexpr size_t WS_CTXW = WS_SS + (size_t)MTOT * 8 * 4;
constexpr size_t WS_SCR = WS_CTXW + (size_t)MCTX * DM * 4;
constexpr size_t WS_END = WS_SCR + (size_t)256 * 64 * 512 * 4;

constexpr int RING_BYTES = 131072, XCH_OFF = RING_BYTES, LDS_BYTES = 147456;

__device__ __forceinline__ float bf2f(unsigned h) { return __uint_as_float(h << 16); }
__device__ __forceinline__ unsigned cvt_pk_bf16(float lo, float hi) { unsigned r; asm volatile("v_cvt_pk_bf16_f32 %0, %1, %2" : "=v"(r) : "v"(lo), "v"(hi)); return r; }
__device__ __forceinline__ float wave_sum(float v) {
#pragma unroll
    for (int o = 1; o < 64; o <<= 1) v += __shfl_xor(v, o);
    return v;
}
__device__ __forceinline__ float sigm_f(float x) { return __builtin_amdgcn_rcpf(1.f + __builtin_amdgcn_exp2f(-1.4426950408889634f * x)); }
__device__ __forceinline__ float silu_f(float x) { return x * sigm_f(x); }
__device__ __forceinline__ unsigned cvt_pk_bf16_safe(float lo, float hi) { unsigned r; asm volatile("s_nop 1\n\tv_cvt_pk_bf16_f32 %0, %1, %2" : "=v"(r) : "v"(lo), "v"(hi)); return r; }
__device__ __forceinline__ void store8_safe(bf16_t* p, f32x4 a, f32x4 b) {
    u32x4 w; w.x = cvt_pk_bf16_safe(a[0], a[1]); w.y = cvt_pk_bf16_safe(a[2], a[3]); w.z = cvt_pk_bf16_safe(b[0], b[1]); w.w = cvt_pk_bf16_safe(b[2], b[3]);
    *(u32x4*)p = w;
}
__device__ __forceinline__ void store8(bf16_t* p, f32x4 a, f32x4 b) {
    u32x4 w; w.x = cvt_pk_bf16(a[0], a[1]); w.y = cvt_pk_bf16(a[2], a[3]); w.z = cvt_pk_bf16(b[0], b[1]); w.w = cvt_pk_bf16(b[2], b[3]);
    *(u32x4*)p = w;
}

namespace pg8 {
constexpr int BM = 256, BK = 64, HALF = 128, HTB = HALF * BK * 2, NXCD = 8, WGM = 8;
__host__ __device__ __forceinline__ int lds_byte(int r, int c) { const int st = (r >> 4) * 2 + (c >> 5), rr = r & 15, cc = c & 31, ob = rr * 64 + cc * 2; return st * 1024 + (ob ^ (((ob >> 9) & 1) << 5)); }
__host__ __device__ __forceinline__ void stage_rc(int b, int& R, int& C) { const int st = b / 1024, sb = b % 1024, swz = sb ^ (((sb >> 9) & 1) << 5); R = (st >> 1) * 16 + swz / 64; C = (st & 1) * 32 + (swz % 64) / 2; }
__host__ __device__ __forceinline__ int perm32(int rho) { const int n = rho >> 4, i = rho & 15; return 8 * (i >> 2) + 4 * n + (i & 3); }

struct Unit { int pm, pn; };
struct Gemm { const bf16_t* A; const bf16_t* Bt; int M, N, K; };
struct StaticOrder {
    int nM, nN, nwg, G, c, fixed, fpm, fpn;
    __device__ void init(int M, int N, int G_, int c_) { nM = M / BM; nN = N / BM; nwg = nM * nN; G = G_; c = c_; fixed = 0; fpm = 0; fpn = 0; }
    __device__ void init_one(int pm, int pn) { nM = 1; nN = 1; nwg = 1; G = 1; c = 0; fixed = 1; fpm = pm; fpn = pn; }
    __device__ bool next(int i, Unit& u) const {
        if (fixed) { if (i > 0) return false; u.pm = fpm; u.pn = fpn; return true; }
        const long L = (long)i * G + c; if (L >= nwg) return false;
        int wgid = (int)L; { const int q = nwg / NXCD, r = nwg % NXCD, xcd = wgid % NXCD, off = wgid / NXCD; wgid = (xcd < r ? xcd * (q + 1) : r * (q + 1) + (xcd - r) * q) + off; }
        const int nig = WGM * nN, gid = wgid / nig, fm = gid * WGM, gsz = (nM - fm) < WGM ? (nM - fm) : WGM;
        u.pm = fm + ((wgid % nig) % gsz); u.pn = (wgid % nig) / gsz; return true;
    }
};

template <class Epi>
__device__ __forceinline__ void gemm_phase(LAS unsigned char* lds, const Gemm g, const StaticOrder& S, const Epi& E, const int tid) {
    const int wid = __builtin_amdgcn_readfirstlane(tid >> 6), lane = tid & 63, wr = wid >> 2, wc = wid & 3, fr = lane & 15, fq = lane >> 4;
    const int K = g.K, nt = K / BK;
    unsigned voffA[2], voffB[2];
#pragma unroll
    for (int i = 0; i < 2; ++i) { int R, C; stage_rc(tid * 16 + i * 8192, R, C); const int Rb = (R & ~31) + perm32(R & 31);
        voffA[i] = (unsigned)(R * K + C) * 2u; voffB[i] = (unsigned)(Rb * K + C) * 2u; }
    const size_t kstep = (size_t)(BK * 2);
    const size_t hstep = (size_t)HALF * K * 2;
    const size_t tstep = 2 * hstep;
    const unsigned ldsw = (unsigned)wid * 1024u;
    const int aoff = lds_byte(wr * 64 + fr, fq * 8), boff = lds_byte(wc * 32 + fr, fq * 8);
#define PG8_SA(b, h) (((b) * 2 + (h)) * HTB)
#define PG8_SB(b, h) ((4 + (b) * 2 + (h)) * HTB)
#define PG8_STAGE(bufoff, gbase, voff) do { _Pragma("unroll") for (int _i = 0; _i < 2; ++_i) \
        __builtin_amdgcn_global_load_lds((const unsigned*)((const char*)(gbase) + (voff)[_i]), (LAS unsigned*)(lds + (bufoff) + ldsw + _i * 8192), 16, 0, 0); } while (0)
#define PG8_LDA(dst, b, h) do { _Pragma("unroll") for (int m = 0; m < 4; ++m) _Pragma("unroll") for (int k = 0; k < 2; ++k) dst[m][k] = *(const LAS bf16x8*)(lds + PG8_SA(b, h) + aoff + m * 2048 + k * 1024); } while (0)
#define PG8_LDB(dst, b, h) do { _Pragma("unroll") for (int n = 0; n < 2; ++n) _Pragma("unroll") for (int k = 0; k < 2; ++k) dst[n][k] = *(const LAS bf16x8*)(lds + PG8_SB(b, h) + boff + n * 2048 + k * 1024); } while (0)
#define PG8_MMA(ai, bj, At, Bt) do { __builtin_amdgcn_s_setprio(1); _Pragma("unroll") for (int m = 0; m < 4; ++m) _Pragma("unroll") for (int n = 0; n < 2; ++n) _Pragma("unroll") for (int k = 0; k < 2; ++k) \
        acc[ai][bj][m][n] = __builtin_amdgcn_mfma_f32_16x16x32_bf16(Bt[n][k], At[m][k], acc[ai][bj][m][n], 0, 0, 0); __builtin_amdgcn_s_setprio(0); } while (0)
#define PG8_WAIT_V(n) asm volatile("s_waitcnt vmcnt(" #n ")" ::: "memory")
#define PG8_WAIT_L(n) asm volatile("s_waitcnt lgkmcnt(" #n ")" ::: "memory")
#define PG8_BAR __builtin_amdgcn_s_barrier()
#define PG8_SCHED __builtin_amdgcn_sched_barrier(0)
    Unit cur, nxt; int ui = 0;
    if (!S.next(0, cur)) return;
    f32x4 acc[2][2][4][2];
#pragma unroll
    for (int a = 0; a < 2; ++a)
#pragma unroll
        for (int b = 0; b < 2; ++b)
#pragma unroll
            for (int m = 0; m < 4; ++m)
#pragma unroll
                for (int n = 0; n < 2; ++n) acc[a][b][m][n] = (f32x4){0.f, 0.f, 0.f, 0.f};
    bf16x8 At[4][2], B0[2][2], B1[2][2];
    const char* cA = (const char*)g.A + (size_t)cur.pm * tstep; const char* cB = (const char*)g.Bt + (size_t)cur.pn * tstep;
    PG8_STAGE(PG8_SB(0, 0), cB, voffB); PG8_STAGE(PG8_SB(0, 1), cB + hstep, voffB); PG8_STAGE(PG8_SA(0, 0), cA, voffA); PG8_STAGE(PG8_SA(0, 1), cA + hstep, voffA);
    if (wr == 1) PG8_BAR;
    PG8_WAIT_V(2); PG8_BAR;
    PG8_STAGE(PG8_SB(1, 0), cB + kstep, voffB); PG8_STAGE(PG8_SA(1, 0), cA + kstep, voffA); PG8_STAGE(PG8_SB(1, 1), cB + hstep + kstep, voffB);
    PG8_WAIT_V(6); PG8_BAR;
    for (;;) {
        const bool has_next = S.next(ui + 1, nxt);
        const char* nA = has_next ? (const char*)g.A + (size_t)nxt.pm * tstep : cA; const char* nB = has_next ? (const char*)g.Bt + (size_t)nxt.pn * tstep : cB;
        for (int t = 0; t < nt; t += 2) {
            const bool last = (t == nt - 2);
            const char* a1 = cA + (size_t)(t + 1) * kstep;
            const char* a2 = last ? nA : cA + (size_t)(t + 2) * kstep; const char* b2 = last ? nB : cB + (size_t)(t + 2) * kstep;
            const char* a3 = a2 + kstep; const char* b3 = b2 + kstep;
            if constexpr (Epi::MID) { if (t == 16 || t == 32) { int fr_ = fr, fq_ = fq, wr_ = wr, wc_ = wc;
                asm volatile("" : "+v"(fr_), "+v"(fq_)); asm volatile("" : "+s"(wr_), "+s"(wc_));
                E.mid(acc, cur, t >> 4, wr_, wc_, fr_, fq_); PG8_WAIT_V(0); PG8_SCHED; } }
            PG8_LDB(B0, 0, 0); PG8_LDB(B1, 0, 1); PG8_SCHED; PG8_LDA(At, 0, 0); PG8_STAGE(PG8_SA(1, 1), a1 + hstep, voffA);
            PG8_WAIT_V(8); PG8_WAIT_L(0); PG8_BAR; PG8_MMA(0, 0, At, B0); PG8_MMA(0, 1, At, B1); PG8_BAR; PG8_SCHED;
            PG8_LDA(At, 0, 1); PG8_STAGE(PG8_SB(0, 0), b2, voffB); PG8_STAGE(PG8_SB(0, 1), b2 + hstep, voffB); PG8_STAGE(PG8_SA(0, 0), a2, voffA);
            PG8_WAIT_V(8); PG8_WAIT_L(0); PG8_BAR; PG8_MMA(1, 0, At, B0); PG8_MMA(1, 1, At, B1); PG8_BAR; PG8_SCHED;
            PG8_LDB(B0, 1, 0); PG8_LDB(B1, 1, 1); PG8_SCHED; PG8_LDA(At, 1, 0); PG8_STAGE(PG8_SA(0, 1), a2 + hstep, voffA);
            PG8_WAIT_V(8); PG8_WAIT_L(0); PG8_BAR; PG8_MMA(0, 0, At, B0); PG8_MMA(0, 1, At, B1); PG8_BAR; PG8_SCHED;
            PG8_LDA(At, 1, 1); PG8_STAGE(PG8_SB(1, 0), b3, voffB); PG8_STAGE(PG8_SB(1, 1), b3 + hstep, voffB); PG8_STAGE(PG8_SA(1, 0), a3, voffA);
            PG8_WAIT_V(8); PG8_WAIT_L(0); PG8_BAR; PG8_MMA(1, 0, At, B0); PG8_MMA(1, 1, At, B1); PG8_BAR; PG8_SCHED;
        }
        if (wr == 0) PG8_BAR;
        { int fr_ = fr, fq_ = fq, wr_ = wr, wc_ = wc, wid_ = wid;
          asm volatile("" : "+v"(fr_), "+v"(fq_)); asm volatile("" : "+s"(wr_), "+s"(wc_), "+s"(wid_));
          E(acc, cur, wr_, wc_, fr_, fq_, wid_); }
        if (!has_next) break;
#pragma unroll
        for (int a = 0; a < 2; ++a)
#pragma unroll
            for (int b = 0; b < 2; ++b)
#pragma unroll
                for (int m = 0; m < 4; ++m)
#pragma unroll
                    for (int n = 0; n < 2; ++n) acc[a][b][m][n] = (f32x4){0.f, 0.f, 0.f, 0.f};
        cur = nxt; cA = nA; cB = nB; ++ui;
        if (wr == 1) PG8_BAR;
    }
    PG8_WAIT_V(0);
    PG8_BAR;
#undef PG8_SA
#undef PG8_SB
#undef PG8_STAGE
#undef PG8_LDA
#undef PG8_LDB
#undef PG8_MMA
#undef PG8_WAIT_V
#undef PG8_WAIT_L
#undef PG8_BAR
#undef PG8_SCHED
}
}
using pg8::Unit;

__device__ __forceinline__ int in_src_col(int n) {
    const int tile = n >> 8, s = n & 255, bj = s >> 7, wc = (s >> 5) & 3, c = s & 31;
    const int d128 = 64 * (wc & 1) + 32 * bj + c, g128 = wc >> 1;
    const int d64 = 32 * (c >> 4) + 16 * bj + (c & 15), g64 = wc;
    if (tile < 4) return (tile * 2 + g128) * 128 + d128;
    if (tile == 4) return 1024 + g128 * 128 + d128;
    if (tile == 5) return 1280 + s;
    if (tile < 10) return 1536 + ((tile - 6) * 2 + g128) * 192 + d128;
    if (tile < 12) return 1536 + ((tile - 10) * 4 + g64) * 192 + 128 + d64;
    if (tile < 14) return 3072 + (tile - 12) * 256 + s;
    if (tile == 14) return g64 == 0 ? 3584 + d64 : -1;
    if (tile < 19) return 3648 + ((tile - 15) * 4 + g64) * 64 + d64;
    if (tile < 23) return 4672 + ((tile - 19) * 4 + g64) * 64 + d64;
    if (tile < 27) return 5696 + (tile - 23) * 256 + s;
    if (tile < 39) return 6720 + (tile - 27) * 256 + s;
    return 9792 + (tile - 39) * 256 + s;
}
__device__ __forceinline__ int up_src_col(int n) {
    if (n >= 1024) return n;
    const int tile = n >> 8, s = n & 255, bj = s >> 7, wc = (s >> 5) & 3, c = s & 31;
    return (tile * 2 + (wc >> 1)) * 128 + 64 * (wc & 1) + 32 * bj + c;
}

template <int GS>
__device__ __forceinline__ void norm_rope_store(const f32x4 (&acc)[2][2][4][2], int pm, int wr, int wc, int fr, int fq, int wid,
                                                const float* __restrict__ w, const float* __restrict__ tcos, const float* __restrict__ tsin, bool rope,
                                                const float (&pre)[2][4], bf16_t* __restrict__ dst, int ld, int gbase, int ncopies, int copystride, LAS float* xch, const float qs = 1.f) {
    const int dbase = (GS == 128) ? 64 * (wc & 1) + 8 * fq : 32 * (fq >> 1) + 8 * (fq & 1);
    const int bjs = (GS == 128) ? 32 : 16;
    const int axis = (GS == 128) ? (wc & 1) : (fq >> 1);
    const int i0 = (GS == 128) ? 8 * fq : 8 * (fq & 1);
    constexpr int NF = (GS == 128) ? 32 : 16;
    const int wavebase = gbase + ((GS == 128) ? 64 * (wc & 1) : 0) + 8 * fq;
    float ssq[2][4];
#pragma unroll
    for (int ai = 0; ai < 2; ++ai)
#pragma unroll
        for (int m = 0; m < 4; ++m) {
            float s = 0.f;
#pragma unroll
            for (int bj = 0; bj < 2; ++bj)
#pragma unroll
                for (int n = 0; n < 2; ++n)
#pragma unroll
                    for (int j = 0; j < 4; ++j) { const float v = acc[ai][bj][m][n][j] * pre[ai][m]; s += v * v; }
            s += __shfl_xor(s, 16); s += __shfl_xor(s, 32);
            ssq[ai][m] = s;
        }
    if constexpr (GS == 128) {
        if (fq == 0) {
#pragma unroll
            for (int ai = 0; ai < 2; ++ai)
#pragma unroll
                for (int m = 0; m < 4; ++m) xch[wid * 128 + ai * 64 + m * 16 + fr] = ssq[ai][m];
        }
        asm volatile("s_waitcnt lgkmcnt(0)" ::: "memory"); __builtin_amdgcn_s_barrier();
#pragma unroll
        for (int ai = 0; ai < 2; ++ai)
#pragma unroll
            for (int m = 0; m < 4; ++m) ssq[ai][m] += xch[(wid ^ 1) * 128 + ai * 64 + m * 16 + fr];
    }
#pragma unroll
    for (int ai = 0; ai < 2; ++ai)
#pragma unroll
        for (int m = 0; m < 4; ++m) {
            const int rl = ai * 128 + wr * 64 + m * 16 + fr;
            const size_t row = (size_t)pm * 256 + rl;
            const float rinv = rsqrtf(ssq[ai][m] * (1.f / GS) + EPS) * pre[ai][m] * qs;
            const int t = (pm & 15) * 256 + rl; const int pos = axis ? (t & 63) : (t >> 6);
            u32x4 k0, k1;
#pragma unroll
            for (int n = 0; n < 2; ++n) {
                const f32x4 w0 = *(const f32x4*)(w + dbase + 4 * n), w1 = *(const f32x4*)(w + dbase + bjs + 4 * n);
                f32x4 y0 = acc[ai][0][m][n] * rinv * w0, y1 = acc[ai][1][m][n] * rinv * w1;
                if (rope) {
                    const f32x4 c = *(const f32x4*)(tcos + pos * NF + i0 + 4 * n), sn = *(const f32x4*)(tsin + pos * NF + i0 + 4 * n);
                    const f32x4 o0 = y0 * c - y1 * sn, o1 = y1 * c + y0 * sn;
                    y0 = o0; y1 = o1;
                }
                if (n == 0) { k0.x = cvt_pk_bf16(y0[0], y0[1]); k0.y = cvt_pk_bf16(y0[2], y0[3]); k1.x = cvt_pk_bf16(y1[0], y1[1]); k1.y = cvt_pk_bf16(y1[2], y1[3]); }
                else { k0.z = cvt_pk_bf16(y0[0], y0[1]); k0.w = cvt_pk_bf16(y0[2], y0[3]); k1.z = cvt_pk_bf16(y1[0], y1[1]); k1.w = cvt_pk_bf16(y1[2], y1[3]); }
            }
            bf16_t* p = dst + row * ld + wavebase;
            for (int cp = 0; cp < ncopies; ++cp) { *(u32x4*)(p + cp * copystride) = k0; *(u32x4*)(p + cp * copystride + 32) = k1; }
            __builtin_amdgcn_sched_barrier(0);
        }
}

struct EpiIn {
    static constexpr bool MID = false;
    bf16_t *QA, *KA, *VA, *QB, *KB, *CKV, *QC, *KC, *VC, *GATE, *MRG; float* SS;
    const float *wAq, *wAk, *wBqn, *wBqr, *wBkr, *wCq, *wCk, *bmerge;
    const float *tc64, *ts64, *tc128, *ts128;
    LAS float* xch;
    template <int ACT>
    __device__ __forceinline__ void plain(const f32x4 (&acc)[2][2][4][2], int pm, int wr, int wc, int fr, int fq, bf16_t* dst, int ld, int col0) const {
        const int colw = col0 + 32 * wc + 8 * fq;
        f32x4 b[2][2];
#pragma unroll
        for (int bj = 0; bj < 2; ++bj)
#pragma unroll
            for (int n = 0; n < 2; ++n) b[bj][n] = (ACT == 2) ? *(const f32x4*)(bmerge + colw + bj * 128 + 4 * n) : (f32x4){0.f, 0.f, 0.f, 0.f};
#pragma unroll
        for (int ai = 0; ai < 2; ++ai)
#pragma unroll
            for (int m = 0; m < 4; ++m) {
                const size_t row = (size_t)pm * 256 + ai * 128 + wr * 64 + m * 16 + fr;
#pragma unroll
                for (int bj = 0; bj < 2; ++bj) {
                    f32x4 v0 = acc[ai][bj][m][0], v1 = acc[ai][bj][m][1];
                    if (ACT == 1) { for (int j = 0; j < 4; ++j) { v0[j] = silu_f(v0[j]); v1[j] = silu_f(v1[j]); } }
                    if (ACT == 2) { v0 = v0 + b[bj][0]; v1 = v1 + b[bj][1]; for (int j = 0; j < 4; ++j) { v0[j] = sigm_f(v0[j]); v1[j] = sigm_f(v1[j]); } }
                    if (ACT == 0) store8(dst + row * ld + colw + bj * 128, v0, v1); else store8_safe(dst + row * ld + colw + bj * 128, v0, v1);
                }
                __builtin_amdgcn_sched_barrier(0);
            }
    }
    __device__ __forceinline__ void operator()(const f32x4 (&acc)[2][2][4][2], const Unit& u, int wr, int wc, int fr, int fq, int wid) const {
        const int t = u.pn, pm = u.pm; const bool rope = pm < 64;
        const float one[2][4] = {{1.f, 1.f, 1.f, 1.f}, {1.f, 1.f, 1.f, 1.f}};
        if (t < 4 && (MK_G1T & 1)) norm_rope_store<128>(acc, pm, wr, wc, fr, fq, wid, wAq, tc128, ts128, rope, one, QA, 1024, (t * 2 + (wc >> 1)) * 128, 1, 0, xch, 0.08838834764831845f * 1.4426950408889634f);
        else if (t == 4 && (MK_G1T & 1)) norm_rope_store<128>(acc, pm, wr, wc, fr, fq, wid, wAk, tc128, ts128, rope, one, KA, 256, (wc >> 1) * 128, 1, 0, xch);
        else if (t == 5 && (MK_G1T & 2)) plain<0>(acc, pm, wr, wc, fr, fq, VA, 256, 0);
        else if (t < 10 && (MK_G1T & 1)) norm_rope_store<128>(acc, pm, wr, wc, fr, fq, wid, wBqn, tc128, ts128, false, one, QB, 1536, ((t - 6) * 2 + (wc >> 1)) * 192, 1, 0, xch, 0.07216878364870323f * 1.4426950408889634f);
        else if (t < 12 && (MK_G1T & 4)) norm_rope_store<64>(acc, pm, wr, wc, fr, fq, wid, wBqr, tc64, ts64, rope, one, QB, 1536, ((t - 10) * 4 + wc) * 192 + 128, 1, 0, xch, 0.07216878364870323f * 1.4426950408889634f);
        else if (t < 14 && (MK_G1T & 8)) {
            plain<0>(acc, pm, wr, wc, fr, fq, CKV, 512, (t - 12) * 256);
#pragma unroll
            for (int ai = 0; ai < 2; ++ai)
#pragma unroll
                for (int m = 0; m < 4; ++m) {
                    float s = 0.f;
#pragma unroll
                    for (int bj = 0; bj < 2; ++bj)
#pragma unroll
                        for (int n = 0; n < 2; ++n)
#pragma unroll
                            for (int j = 0; j < 4; ++j) { const float v = acc[ai][bj][m][n][j]; s += v * v; }
                    s += __shfl_xor(s, 16); s += __shfl_xor(s, 32);
                    if (fq == 0) SS[((size_t)pm * 256 + ai * 128 + wr * 64 + m * 16 + fr) * 8 + (t - 12) * 4 + wc] = s;
                }
        }
        else if (t == 14 && (MK_G1T & 16)) { if (wc == 0) norm_rope_store<64>(acc, pm, wr, wc, fr, fq, wid, wBkr, tc64, ts64, rope, one, KB, 1536, 128, 8, 192, xch); }
        else if (t < 19 && (MK_G1T & 4)) norm_rope_store<64>(acc, pm, wr, wc, fr, fq, wid, wCq, tc64, ts64, rope, one, QC, 1024, ((t - 15) * 4 + wc) * 64, 1, 0, xch, 0.125f * 1.4426950408889634f);
        else if (t < 23 && (MK_G1T & 4)) norm_rope_store<64>(acc, pm, wr, wc, fr, fq, wid, wCk, tc64, ts64, rope, one, KC, 1024, ((t - 19) * 4 + wc) * 64, 1, 0, xch);
        else if (t < 27 && (MK_G1T & 2)) plain<0>(acc, pm, wr, wc, fr, fq, VC, 1024, (t - 23) * 256);
        else if (t < 39 && (MK_G1T & 32)) plain<1>(acc, pm, wr, wc, fr, fq, GATE, 3072, (t - 27) * 256);
        else if (MK_G1T & 64) plain<2>(acc, pm, wr, wc, fr, fq, MRG, 6144, (t - 39) * 256);
    }
};

struct EpiUp {
    static constexpr bool MID = false;
    bf16_t *KB, *VB; const float* SS; const float* wBkn; LAS float* xch;
    __device__ __forceinline__ void operator()(const f32x4 (&acc)[2][2][4][2], const Unit& u, int wr, int wc, int fr, int fq, int wid) const {
        const int t = u.pn, pm = u.pm;
        float pre[2][4];
#pragma unroll
        for (int ai = 0; ai < 2; ++ai)
#pragma unroll
            for (int m = 0; m < 4; ++m) {
                const size_t row = (size_t)pm * 256 + ai * 128 + wr * 64 + m * 16 + fr;
                const f32x4 a = *(const f32x4*)(SS + row * 8), b = *(const f32x4*)(SS + row * 8 + 4);
                pre[ai][m] = rsqrtf(((a[0] + a[1]) + (a[2] + a[3]) + (b[0] + b[1]) + (b[2] + b[3])) * (1.f / 512.f) + EPS);
                __builtin_amdgcn_sched_barrier(0);
            }
        if (t < 4) norm_rope_store<128>(acc, pm, wr, wc, fr, fq, wid, wBkn, nullptr, nullptr, false, pre, KB, 1536, (t * 2 + (wc >> 1)) * 192, 1, 0, xch);
        else {
            const int colw = (t - 4) * 256 + 32 * wc + 8 * fq;
#pragma unroll
            for (int ai = 0; ai < 2; ++ai)
#pragma unroll
                for (int m = 0; m < 4; ++m) {
                    const size_t row = (size_t)pm * 256 + ai * 128 + wr * 64 + m * 16 + fr;
#pragma unroll
                    for (int bj = 0; bj < 2; ++bj) store8(VB + row * 1024 + colw + bj * 128, acc[ai][bj][m][0] * pre[ai][m], acc[ai][bj][m][1] * pre[ai][m]);
                    __builtin_amdgcn_sched_barrier(0);
                }
        }
    }
};

struct EpiBr {
    static constexpr bool MID = true;
    const bf16_t* MRG; bf16_t* Y;
    __device__ __forceinline__ void mid(f32x4 (&acc)[2][2][4][2], const Unit& u, int i, int wr, int wc, int fr, int fq) const {
#pragma unroll
        for (int ai = 0; ai < 2; ++ai)
#pragma unroll
            for (int m = 0; m < 4; ++m) {
                const size_t row = (size_t)u.pm * 256 + ai * 128 + wr * 64 + m * 16 + fr;
#pragma unroll
                for (int bj = 0; bj < 2; ++bj) {
                    const int col = u.pn * 256 + bj * 128 + 32 * wc + 8 * fq;
                    const u32x4 a = *(const u32x4*)(MRG + row * 6144 + (i - 1) * 2048 + col), b = *(const u32x4*)(MRG + row * 6144 + i * 2048 + col);
#pragma unroll
                    for (int q = 0; q < 4; ++q) {
                        const float r0 = bf2f(a[q] & 0xffffu) * __builtin_amdgcn_rcpf(bf2f(b[q] & 0xffffu)), r1 = bf2f(a[q] >> 16) * __builtin_amdgcn_rcpf(bf2f(b[q] >> 16));
                        acc[ai][bj][m][q >> 1][(q & 1) * 2] *= r0; acc[ai][bj][m][q >> 1][(q & 1) * 2 + 1] *= r1;
                    }
                }
                __builtin_amdgcn_sched_barrier(0);
            }
    }
    __device__ __forceinline__ void operator()(const f32x4 (&acc)[2][2][4][2], const Unit& u, int wr, int wc, int fr, int fq, int wid) const {
#pragma unroll
        for (int ai = 0; ai < 2; ++ai)
#pragma unroll
            for (int m = 0; m < 4; ++m) {
                const size_t row = (size_t)u.pm * 256 + ai * 128 + wr * 64 + m * 16 + fr;
#pragma unroll
                for (int bj = 0; bj < 2; ++bj) {
                    const int col = u.pn * 256 + bj * 128 + 32 * wc + 8 * fq;
                    const u32x4 a = *(const u32x4*)(MRG + row * 6144 + 4096 + col);
                    f32x4 v0 = acc[ai][bj][m][0], v1 = acc[ai][bj][m][1];
                    v0[0] *= bf2f(a[0] & 0xffffu); v0[1] *= bf2f(a[0] >> 16); v0[2] *= bf2f(a[1] & 0xffffu); v0[3] *= bf2f(a[1] >> 16);
                    v1[0] *= bf2f(a[2] & 0xffffu); v1[1] *= bf2f(a[2] >> 16); v1[2] *= bf2f(a[3] & 0xffffu); v1[3] *= bf2f(a[3] >> 16);
                    store8(Y + row * 2048 + col, v0, v1);
                }
                __builtin_amdgcn_sched_barrier(0);
            }
    }
};

struct EpiOut {
    static constexpr bool MID = false;
    const float *xsrc, *csrc; float *xdst, *cdst; const float* mod;
    __device__ __forceinline__ void operator()(const f32x4 (&acc)[2][2][4][2], const Unit& u, int wr, int wc, int fr, int fq, int wid) const {
        const int pm = u.pm; const bool lat = pm < 64;
        const int mi = lat ? (pm >> 4) : 4;
        const float* src = lat ? xsrc : csrc - (size_t)MLAT * DM; float* dst = lat ? xdst : cdst - (size_t)MLAT * DM;
        const float* g = mod + mi * 6144 + 4096;
#pragma unroll
        for (int bj = 0; bj < 2; ++bj) {
            const int col = u.pn * 256 + bj * 128 + 32 * wc + 8 * fq;
            const f32x4 g0 = *(const f32x4*)(g + col), g1 = *(const f32x4*)(g + col + 4);
#pragma unroll
            for (int ai = 0; ai < 2; ++ai)
#pragma unroll
                for (int m = 0; m < 4; ++m) {
                    const size_t row = (size_t)pm * 256 + ai * 128 + wr * 64 + m * 16 + fr;
                    const f32x4 x0 = *(const f32x4*)(src + row * DM + col), x1 = *(const f32x4*)(src + row * DM + col + 4);
                    *(f32x4*)(dst + row * DM + col) = x0 + g0 * acc[ai][bj][m][0];
                    *(f32x4*)(dst + row * DM + col + 4) = x1 + g1 * acc[ai][bj][m][1];
                    __builtin_amdgcn_sched_barrier(0);
                }
        }
    }
};

namespace att {
#define SBAR() __builtin_amdgcn_sched_barrier(0)
__device__ __forceinline__ int crow(int r, int hi) { return (r & 3) + 8 * (r >> 2) + 4 * hi; }
template <int RB> __device__ __forceinline__ int kswz(int row, int colB) { const int x = (RB == 256) ? (row & 15) : ((row >> 1) & 7); return row * RB + (colB ^ (x << 4)); }
__device__ __forceinline__ int v_st(int k, int c) { const int kk = (k & ~0xC) | ((k & 4) << 1) | ((k & 8) >> 1); return ((kk >> 3) * 4 + (c >> 5)) * 512 + ((kk & 7) * 32 + (c & 31)) * 2; }
__device__ __forceinline__ int v_rd_base(int lane) { return ((lane & 3) << 3) | (((lane >> 2) & 3) << 6) | (((lane >> 4) & 1) << 5) | (((lane >> 5) & 1) << 8); }
constexpr int v_rd_off(int d0, int ks, int half) { return d0 * 512 + ks * 4096 + half * 2048; }
template <int OFF> __device__ __forceinline__ s16x4 tr_read(unsigned vb) {
    s16x4 r; asm volatile("ds_read_b64_tr_b16 %0, %1 offset:%2" : "=&v"(r) : "v"(vb), "i"(OFF) : "memory"); return r;
}
template <int D0> __device__ __forceinline__ void pv_one(f32x16& od, unsigned vb, bf16x8 pa0, bf16x8 pa1, bf16x8 pa2, bf16x8 pa3) {
    const s16x4 l0 = tr_read<v_rd_off(D0, 0, 0)>(vb), h0 = tr_read<v_rd_off(D0, 0, 1)>(vb), l1 = tr_read<v_rd_off(D0, 1, 0)>(vb), h1 = tr_read<v_rd_off(D0, 1, 1)>(vb);
    const s16x4 l2 = tr_read<v_rd_off(D0, 2, 0)>(vb), h2 = tr_read<v_rd_off(D0, 2, 1)>(vb), l3 = tr_read<v_rd_off(D0, 3, 0)>(vb), h3 = tr_read<v_rd_off(D0, 3, 1)>(vb);
    asm volatile("s_waitcnt lgkmcnt(0)" ::: "memory"); SBAR();
#define PK(L, H) (bf16x8){L[0], L[1], L[2], L[3], H[0], H[1], H[2], H[3]}
    od = __builtin_amdgcn_mfma_f32_32x32x16_bf16(pa0, PK(l0, h0), od, 0, 0, 0);
    od = __builtin_amdgcn_mfma_f32_32x32x16_bf16(pa1, PK(l1, h1), od, 0, 0, 0);
    od = __builtin_amdgcn_mfma_f32_32x32x16_bf16(pa2, PK(l2, h2), od, 0, 0, 0);
    od = __builtin_amdgcn_mfma_f32_32x32x16_bf16(pa3, PK(l3, h3), od, 0, 0, 0);
#undef PK
}
__device__ __forceinline__ void pv_d0(f32x16 (&o)[4], unsigned vb, bf16x8 pa0, bf16x8 pa1, bf16x8 pa2, bf16x8 pa3) {
    pv_one<0>(o[0], vb, pa0, pa1, pa2, pa3); pv_one<1>(o[1], vb, pa0, pa1, pa2, pa3); pv_one<2>(o[2], vb, pa0, pa1, pa2, pa3); pv_one<3>(o[3], vb, pa0, pa1, pa2, pa3);
}
__device__ __forceinline__ void partialSM(f32x16& p0, f32x16& p1) {
#pragma unroll
    for (int r = 0; r < 16; ++r) p0[r] = __builtin_amdgcn_exp2f(p0[r]);
}
__device__ __forceinline__ void finishSM(f32x16& p0, f32x16& p1, float& l_reg, bf16x8& pa0, bf16x8& pa1, bf16x8& pa2, bf16x8& pa3) {
#pragma unroll
    for (int r = 0; r < 16; ++r) p1[r] = __builtin_amdgcn_exp2f(p1[r]);
    float ps = 0;
#pragma unroll
    for (int r = 0; r < 16; ++r) ps += p0[r];
#pragma unroll
    for (int r = 0; r < 16; ++r) ps += p1[r];
    l_reg += ps;
#define PK8(P, BASE, OUT) do { u32x4 w = {cvt_pk_bf16(P[BASE + 0], P[BASE + 1]), cvt_pk_bf16(P[BASE + 2], P[BASE + 3]), cvt_pk_bf16(P[BASE + 4], P[BASE + 5]), cvt_pk_bf16(P[BASE + 6], P[BASE + 7])}; \
    OUT = *reinterpret_cast<bf16x8*>(&w); } while (0)
    PK8(p0, 0, pa0); PK8(p0, 8, pa1); PK8(p1, 0, pa2); PK8(p1, 8, pa3);
#undef PK8
}
template <int DQK>
__device__ __forceinline__ void qkt(f32x16& p0, f32x16& p1, const LAS char* Ks, const bf16x8 (&qr)[DQK / 16], const int (&ka)[8], float nMB) {
    constexpr int RB = DQK * 2, NA = (RB == 256) ? 8 : 4;
#pragma unroll
    for (int r = 0; r < 16; ++r) { p0[r] = nMB; p1[r] = nMB; }
#pragma unroll
    for (int d0 = 0; d0 < DQK / 16; ++d0) {
        const LAS char* a = Ks + ka[d0 % NA] + (d0 / NA) * (NA * 32);
        const bf16x8 b0 = *(const LAS bf16x8*)(a);
        const bf16x8 b1 = *(const LAS bf16x8*)(a + 32 * RB);
        p0 = __builtin_amdgcn_mfma_f32_32x32x16_bf16(b0, qr[d0], p0, 0, 0, 0);
        p1 = __builtin_amdgcn_mfma_f32_32x32x16_bf16(b1, qr[d0], p1, 0, 0, 0); }
}
constexpr int V_BYTES = 64 * 128 * 2, K_OFF = 3 * V_BYTES, K_STRIDE = 64 * 192 * 2, LI_OFF = K_OFF + 3 * K_STRIDE;

template <int DQK, bool DOUBLE>
__device__ __forceinline__ void attn_pass(const bf16_t* __restrict__ Q, int ldq, const bf16_t* __restrict__ Kg, int ldk, const bf16_t* __restrict__ Vg, int ldv,
                                          int rowc, int rowl, int NT, float nMB, f32x16 (&o)[4], float& l_reg, LAS char* lds, int tid) {
    constexpr int RB = DQK * 2, NCH = DQK / 8, NLD = NCH / 8;
    const int wid = __builtin_amdgcn_readfirstlane(tid >> 6), lane = tid & 63, r32 = lane & 31, hi = lane >> 5;
    LAS char* V_lds = lds; LAS char* K_lds = lds + K_OFF;
    bf16x8 qr[DQK / 16];
    { const bf16_t* Qw = Q + (size_t)(wid * 32 + r32) * ldq + hi * 8;
#pragma unroll
      for (int d0 = 0; d0 < DQK / 16; ++d0) qr[d0] = *(const bf16x8*)(Qw + d0 * 16); }
#pragma unroll
    for (int d = 0; d < 4; ++d) o[d] = f32x16{};
    l_reg = 0.f;
    int vrow[2], vcol[2], krow[NLD], kcol[NLD];
#pragma unroll
    for (int i = 0; i < 2; ++i) { const int q = tid + 512 * i, sub = q >> 5, within = q & 31, kk = (sub >> 2) * 8 + (within >> 2);
        vrow[i] = kk; vcol[i] = (sub & 3) * 32 + (within & 3) * 8; }
#pragma unroll
    for (int i = 0; i < NLD; ++i) { const int q = tid + 512 * i, row = q / NCH, chp = q % NCH; const int x = (RB == 256) ? (row & 15) : ((row >> 1) & 7);
        krow[i] = row; kcol[i] = (chp ^ x) * 8; }
    const unsigned vb0 = (unsigned)(uintptr_t)V_lds + v_rd_base(lane);
    int ka[8];
#pragma unroll
    for (int q = 0; q < 8; ++q) ka[q] = kswz<RB>(r32, q * 32 + hi * 16);
#define KROW0(j) ((j) < 4 ? rowc + 64 * (j) : rowl + 64 * ((j) - 4))
#define DMA(j, b) do { const size_t _r0 = (size_t)KROW0(j); \
    _Pragma("unroll") for (int _i = 0; _i < 2; ++_i) __builtin_amdgcn_global_load_lds((const unsigned*)(Vg + (_r0 + vrow[_i]) * ldv + vcol[_i]), (LAS unsigned*)(V_lds + (b) * V_BYTES + wid * 1024 + _i * 8192), 16, 0, 0); \
    _Pragma("unroll") for (int _i = 0; _i < NLD; ++_i) __builtin_amdgcn_global_load_lds((const unsigned*)(Kg + (_r0 + krow[_i]) * ldk + kcol[_i]), (LAS unsigned*)(K_lds + (b) * K_STRIDE + wid * 1024 + _i * 8192), 16, 0, 0); } while (0)
#define VMW0() asm volatile("s_waitcnt vmcnt(0)" ::: "memory")
    bf16x8 pa0, pa1, pa2, pa3;
    __syncthreads();
    DMA(0, 0); DMA(1, 1); VMW0(); __syncthreads();
    if constexpr (!DOUBLE) {
        f32x16 p0, p1;
        DMA(2, 2);
        int bc = 0, bn = 1, bf = 2;
        for (int j = 0; j < NT; ++j) {
            SBAR(); qkt<DQK>(p0, p1, K_lds + bc * K_STRIDE, qr, ka, nMB);
            partialSM(p0, p1); finishSM(p0, p1, l_reg, pa0, pa1, pa2, pa3); SBAR();
            pv_d0(o, vb0 + bc * V_BYTES, pa0, pa1, pa2, pa3);
            if (j + 1 < NT) { VMW0(); __syncthreads(); if (j + 3 < NT) DMA(j + 3, bc); }
            { const int _t = bc; bc = bn; bn = bf; bf = _t; }
        }
    } else {
    f32x16 pA0, pA1, pB0, pB1;
    qkt<DQK>(pA0, pA1, K_lds, qr, ka, nMB); partialSM(pA0, pA1);
    DMA(2, 2);
    int bp = 0, bc = 1, bn = 2;
#define STEP(j, PC0, PC1, PP0, PP1) do { \
        SBAR(); qkt<DQK>(PC0, PC1, K_lds + bc * K_STRIDE, qr, ka, nMB); \
        finishSM(PP0, PP1, l_reg, pa0, pa1, pa2, pa3); SBAR(); \
        pv_d0(o, vb0 + bp * V_BYTES, pa0, pa1, pa2, pa3); partialSM(PC0, PC1); \
        if ((j) + 1 < NT) { VMW0(); __syncthreads(); if ((j) + 2 < NT) DMA((j) + 2, bp); } \
        { const int _t = bp; bp = bc; bc = bn; bn = _t; } } while (0)
    for (int j = 1; j < NT; j += 2) {
        STEP(j, pB0, pB1, pA0, pA1);
        if (j + 1 < NT) STEP(j + 1, pA0, pA1, pB0, pB1);
    }
    finishSM(pB0, pB1, l_reg, pa0, pa1, pa2, pa3); SBAR();
    pv_d0(o, vb0 + bp * V_BYTES, pa0, pa1, pa2, pa3);
    }
#undef KROW0
#undef DMA
#undef VMW0
#undef STEP
}
__device__ __forceinline__ void row_recip(float l_reg, float (&rli)[16], LAS float* li, int r32, int hi) {
    { auto rr = __builtin_amdgcn_permlane32_swap(__float_as_uint(l_reg), __float_as_uint(l_reg), false, false);
      l_reg = __uint_as_float(rr[0]) + __uint_as_float(rr[1]); }
    if (hi == 0) li[r32] = l_reg;
    asm volatile("s_waitcnt lgkmcnt(0)" ::: "memory");
#pragma unroll
    for (int r = 0; r < 16; ++r) rli[r] = __builtin_amdgcn_rcpf(li[crow(r, hi)]);
    asm volatile("s_waitcnt lgkmcnt(0)" ::: "memory");
}
}

struct AttnBufs { const bf16_t *QA, *KA, *VA, *QB, *KB, *VB, *QC, *KC, *VC, *GATE; bf16_t* BR; float* SCR; const float* lamv; const float* subln; float lam_init; };

template <bool SUBLN>
__device__ __forceinline__ void attn_out(const AttnBufs& T, f32x16 (&o)[4], int type, int h, size_t orow0, LAS char* lds, int wid, int lane, int r32, int hi) {
    __syncthreads();
    LAS float* stg = (LAS float*)(lds + wid * 16896);
#pragma unroll
    for (int d0 = 0; d0 < 4; ++d0)
#pragma unroll
        for (int r = 0; r < 16; ++r) stg[att::crow(r, hi) * 132 + d0 * 32 + r32] = o[d0][r];
    asm volatile("s_waitcnt lgkmcnt(0)" ::: "memory");
    const int rr = lane >> 5, c4 = (lane & 31) * 4;
    const int col = type * 1024 + h * 128 + c4;
    f32x4 wsub = {1.f, 1.f, 1.f, 1.f};
    if (SUBLN) { wsub = *(const f32x4*)(T.subln + c4) * (1.f - T.lam_init); }
    const bf16_t* gp = T.GATE + (orow0 + rr) * 3072 + col; bf16_t* op = T.BR + (orow0 + rr) * 3072 + col;
#pragma unroll 4
    for (int i = 0; i < 16; ++i) {
        f32x4 v = *(const LAS f32x4*)(stg + (2 * i + rr) * 132 + c4);
        const u32x2 gg = *(const u32x2*)(gp + (size_t)i * 2 * 3072);
        if (SUBLN) {
            float s = (v[0] * v[0] + v[1] * v[1]) + (v[2] * v[2] + v[3] * v[3]);
            s += __shfl_xor(s, 1); s += __shfl_xor(s, 2); s += __shfl_xor(s, 4); s += __shfl_xor(s, 8); s += __shfl_xor(s, 16);
            v = v * (rsqrtf(s * (1.f / 128.f) + EPS)) * wsub;
        }
        u32x2 w; w.x = cvt_pk_bf16(v[0] * bf2f(gg.x & 0xffffu), v[1] * bf2f(gg.x >> 16)); w.y = cvt_pk_bf16(v[2] * bf2f(gg.y & 0xffffu), v[3] * bf2f(gg.y >> 16));
        *(u32x2*)(op + (size_t)i * 2 * 3072) = w;
    }
}

__device__ __forceinline__ void attn_item(const AttnBufs& T, int type, int b, int h, int qrow0, int NT, LAS char* lds, int tid_) {
    asm volatile("" : "+v"(tid_));
    const int tid = tid_, wid = __builtin_amdgcn_readfirstlane(tid >> 6), lane = tid & 63, r32 = lane & 31, hi = lane >> 5;
    const int rowc = MLAT + b * CTXL, rowl = b * SEQ;
    LAS float* li = (LAS float*)(lds + att::LI_OFF) + wid * 64;
    constexpr float LOG2E = 1.4426950408889634f;
    const size_t orow0 = (size_t)qrow0 + wid * 32;
    if (type == 0 && (MK_ATYPE & 1)) {
        f32x16 o[4]; float l_reg; float rli[16];
        att::attn_pass<128, ATT_DBL>(T.QA + (size_t)qrow0 * 1024 + h * 128, 1024, T.KA + (h >> 2) * 128, 256, T.VA + (h >> 2) * 128, 256, rowc, rowl, NT,
                            T.lamv[1], o, l_reg, lds, tid);
        att::row_recip(l_reg, rli, li, r32, hi);
#pragma unroll
        for (int d0 = 0; d0 < 4; ++d0)
#pragma unroll
            for (int r = 0; r < 16; ++r) o[d0][r] *= rli[r];
        attn_out<false>(T, o, 0, h, orow0, lds, wid, lane, r32, hi);
    } else if (type == 1 && (MK_ATYPE & 2)) {
        f32x16 o[4]; float l_reg; float rli[16];
        att::attn_pass<192, false>(T.QB + (size_t)qrow0 * 1536 + h * 192, 1536, T.KB + h * 192, 1536, T.VB + h * 128, 1024, rowc, rowl, NT,
                            T.lamv[2], o, l_reg, lds, tid);
        att::row_recip(l_reg, rli, li, r32, hi);
#pragma unroll
        for (int d0 = 0; d0 < 4; ++d0)
#pragma unroll
            for (int r = 0; r < 16; ++r) o[d0][r] *= rli[r];
        attn_out<false>(T, o, 1, h, orow0, lds, wid, lane, r32, hi);
    } else if (MK_ATYPE & 4) {
        f32x16 o[4]; float l_reg; float rli[16];
        att::attn_pass<64, ATT_DBL>(T.QC + (size_t)qrow0 * 1024 + h * 128, 1024, T.KC + h * 128, 1024, T.VC + h * 128, 1024, rowc, rowl, NT,
                           T.lamv[3], o, l_reg, lds, tid);
        att::row_recip(l_reg, rli, li, r32, hi);
        f32x4* scr = (f32x4*)(T.SCR + ((size_t)blockIdx.x * 512 + tid) * 64);
#pragma unroll
        for (int d0 = 0; d0 < 4; ++d0)
#pragma unroll
            for (int q = 0; q < 4; ++q) scr[d0 * 4 + q] = (f32x4){o[d0][q * 4] * rli[q * 4], o[d0][q * 4 + 1] * rli[q * 4 + 1], o[d0][q * 4 + 2] * rli[q * 4 + 2], o[d0][q * 4 + 3] * rli[q * 4 + 3]};
        att::attn_pass<64, ATT_DBL>(T.QC + (size_t)qrow0 * 1024 + h * 128 + 64, 1024, T.KC + h * 128 + 64, 1024, T.VC + h * 128, 1024, rowc, rowl, NT,
                           T.lamv[3], o, l_reg, lds, tid);
        att::row_recip(l_reg, rli, li, r32, hi);
        const float lam = T.lamv[0];
#pragma unroll
        for (int d0 = 0; d0 < 4; ++d0)
#pragma unroll
            for (int q = 0; q < 4; ++q) { const f32x4 a = scr[d0 * 4 + q];
#pragma unroll
                for (int j = 0; j < 4; ++j) o[d0][q * 4 + j] = a[j] - lam * (o[d0][q * 4 + j] * rli[q * 4 + j]); }
        attn_out<true>(T, o, 2, h, orow0, lds, wid, lane, r32, hi);
    }
}

__device__ __forceinline__ void transpose_item(const float* __restrict__ W, int ldw, int k0, int srccol4, const float* __restrict__ kscale,
                                               bf16_t* __restrict__ WT, int ldt, int n0, int kdst0, LAS float* scr, int lane) {
    const int ks = lane >> 4, n4 = (lane & 15) * 4;
#pragma unroll 8
    for (int i = 0; i < 16; ++i) { const int kk = 4 * i + ks;
        f32x4 v = srccol4 >= 0 ? *(const f32x4*)(W + (size_t)(k0 + kk) * ldw + srccol4) : (f32x4){0.f, 0.f, 0.f, 0.f};
        if (kscale) v = v * kscale[k0 + kk];
        LAS float* d = scr + kk * 65 + n4; d[0] = v[0]; d[1] = v[1]; d[2] = v[2]; d[3] = v[3]; }
    asm volatile("s_waitcnt lgkmcnt(0)" ::: "memory");
    const int nn = lane & 7, c = lane >> 3;
#pragma unroll
    for (int j = 0; j < 8; ++j) { const int n = nn + 8 * j; const LAS float* s = scr + (8 * c) * 65 + n;
        u32x4 o; o.x = cvt_pk_bf16(s[0 * 65], s[1 * 65]); o.y = cvt_pk_bf16(s[2 * 65], s[3 * 65]); o.z = cvt_pk_bf16(s[4 * 65], s[5 * 65]); o.w = cvt_pk_bf16(s[6 * 65], s[7 * 65]);
        *(u32x4*)(WT + (size_t)(n0 + n) * ldt + kdst0 + k0 + 8 * c) = o; }
    asm volatile("s_waitcnt lgkmcnt(0)" ::: "memory");
}
__device__ const float INVF32[16] = {1.000000000e+00f, 5.623413324e-01f, 3.162277639e-01f, 1.778279394e-01f, 1.000000015e-01f, 5.623413250e-02f, 3.162277490e-02f, 1.778279431e-02f,
    9.999999776e-03f, 5.623413250e-03f, 3.162277630e-03f, 1.778279431e-03f, 1.000000047e-03f, 5.623413017e-04f, 3.162277571e-04f, 1.778279402e-04f};
__device__ const float INVF64[32] = {1.000000000e+00f, 7.498942614e-01f, 5.623413324e-01f, 4.216965139e-01f, 3.162277639e-01f, 2.371373773e-01f, 1.778279394e-01f, 1.333521307e-01f,
    1.000000015e-01f, 7.498941571e-02f, 5.623413250e-02f, 4.216965288e-02f, 3.162277490e-02f, 2.371373773e-02f, 1.778279431e-02f, 1.333521493e-02f, 9.999999776e-03f, 7.498941850e-03f,
    5.623413250e-03f, 4.216964822e-03f, 3.162277630e-03f, 2.371373586e-03f, 1.778279431e-03f, 1.333521446e-03f, 1.000000047e-03f, 7.498942432e-04f, 5.623413017e-04f, 4.216965172e-04f,
    3.162277571e-04f, 2.371373703e-04f, 1.778279402e-04f, 1.333521504e-04f};
__device__ __forceinline__ void sincos_d(double x, float& s, float& c) {
    const double twopi = 6.283185307179586476925;
    const double k = __builtin_rint(x / twopi), r = x - k * twopi, r2 = r * r;
    double st = r, ct = 1.0, ss = r, cs = 1.0;
    for (int n = 1; n <= 16; ++n) { ct *= -r2 / (double)((2 * n - 1) * (2 * n)); st *= -r2 / (double)((2 * n) * (2 * n + 1)); cs += ct; ss += st; }
    s = (float)ss; c = (float)cs;
}
__device__ __forceinline__ float absmax_n(const float* w, int n) { float m = 0.f; for (int i = 0; i < n; ++i) m = fmaxf(m, fabsf(w[i])); return m; }

typedef unsigned v4u_unused_t;
#define XB_TMO      128
#define XB_XCNT(j)  (256  + 64 * (j))
#define XB_XSUB(j)  (1280 + 64 * (j))
#define XB_XGEN(j)  (2304 + 64 * (j))
#define XB_TOP      3328
#define XB_TOPGEN   3392
#define XCD_BAR_WORDS 3456
#define XB_SPIN_CAP (1u << 18)

__device__ __forceinline__ unsigned xb_ld(unsigned* p)              { return __hip_atomic_load(p, __ATOMIC_RELAXED, __HIP_MEMORY_SCOPE_AGENT); }
__device__ __forceinline__ unsigned xb_add(unsigned* p, unsigned v) { return __hip_atomic_fetch_add(p, v, __ATOMIC_RELAXED, __HIP_MEMORY_SCOPE_AGENT); }
__device__ __forceinline__ unsigned xb_xcc_id() { return (unsigned)__builtin_amdgcn_s_getreg((3 << 11) | 20) & 0xFu; }
#define XB_SPIN(cond, bar) do { unsigned _sp = 0; while (cond) { __builtin_amdgcn_s_sleep(1); \
    if ((++_sp & 255u) == 0u) { if (xb_ld(&(bar)[XB_TMO])) break; if (_sp > XB_SPIN_CAP) { atomicAdd(&(bar)[XB_TMO], 1u); break; } } } } while (0)

struct XcdBarrier {
    unsigned* bar; unsigned x;
    volatile LAS unsigned* st;
};

__device__ __forceinline__ XcdBarrier xcd_barrier_post(unsigned* bar, volatile LAS unsigned* st) {
    XcdBarrier b; b.bar = bar; b.x = xb_xcc_id(); b.st = st;
    if (threadIdx.x == 0) (void)xb_add(&bar[XB_XCNT(b.x)], 1u);
    return b;
}
__device__ __forceinline__ void xcd_barrier_complete(unsigned* bar, unsigned x, unsigned& nloc, unsigned& nx) {
    const unsigned G = gridDim.x * gridDim.y * gridDim.z;
    unsigned sum, cnt, mine, sp = 0u;
    for (;;) {
        sum = 0u; cnt = 0u; mine = 0u;
#pragma unroll
        for (unsigned j = 0; j < 16; ++j) { const unsigned c = xb_ld(&bar[XB_XCNT(j)]); sum += c; cnt += (c > 0u) ? 1u : 0u; mine = (j == x) ? c : mine; }
        if (sum == G) break;
        __builtin_amdgcn_s_sleep(1);
        if ((++sp & 255u) == 0u) { if (xb_ld(&bar[XB_TMO])) break; if (sp > XB_SPIN_CAP) { atomicAdd(&bar[XB_TMO], 1u); break; } }
    }
    nloc = mine > 0u ? mine : 1u; nx = cnt > 0u ? cnt : 1u;
}

__device__ __forceinline__ void xcd_barrier(const XcdBarrier& b) {
    asm volatile("s_waitcnt vmcnt(0)" ::: "memory");
    __syncthreads();
    if (threadIdx.x == 0) {
        unsigned* bar = b.bar;
        __builtin_amdgcn_s_waitcnt(0);
        unsigned nloc = b.st[0], nx = b.st[1];
        if (nloc == 0u) { xcd_barrier_complete(bar, b.x, nloc, nx); b.st[0] = nloc; b.st[1] = nx; }
        const unsigned old = xb_add(&bar[XB_XSUB(b.x)], 1u);
        const unsigned gen = old / nloc;
        if (old + 1u == (gen + 1u) * nloc) {
            __builtin_amdgcn_fence(__ATOMIC_RELEASE, "agent");
            asm volatile("s_waitcnt vmcnt(0)" ::: "memory");
            const unsigned og = xb_add(&bar[XB_TOP], 1u);
            const unsigned tg = og / nx;
            if (og + 1u == (tg + 1u) * nx) xb_add(&bar[XB_TOPGEN], 1u);
            else XB_SPIN(xb_ld(&bar[XB_TOPGEN]) == tg, bar);
            __builtin_amdgcn_fence(__ATOMIC_ACQUIRE, "agent");
            xb_add(&bar[XB_XGEN(b.x)], 1u);
            asm volatile("s_waitcnt vmcnt(0)" ::: "memory");
        } else {
            XB_SPIN(xb_ld(&bar[XB_XGEN(b.x)]) == gen, bar);
            __builtin_amdgcn_fence(__ATOMIC_ACQUIRE, "agent");
            asm volatile("s_waitcnt vmcnt(0)" ::: "memory");
        }
    }
    __syncthreads();
}

__device__ __forceinline__ void p1_row(int row, const float* __restrict__ xsrc, const float* __restrict__ csrc, const float* __restrict__ modl, const float* __restrict__ nw,
                                       bf16_t* __restrict__ H, int lane) {
    const bool lat = row < MLAT; const int mi = lat ? (row >> 12) : 4;
    const f32x4* xr = (const f32x4*)(lat ? xsrc + (size_t)row * DM : csrc + (size_t)(row - MLAT) * DM) + lane;
    f32x4 v[8]; float s = 0.f;
#pragma unroll
    for (int j = 0; j < 8; ++j) { v[j] = xr[64 * j]; s += (v[j][0] * v[j][0] + v[j][1] * v[j][1]) + (v[j][2] * v[j][2] + v[j][3] * v[j][3]); }
    const float rinv = rsqrtf(wave_sum(s) * (1.f / DM) + EPS);
    const f32x4* sh = (const f32x4*)(modl + mi * 6144) + lane; const f32x4* scl = (const f32x4*)(modl + mi * 6144 + DM) + lane; const f32x4* nwp = (const f32x4*)nw + lane;
    u32x2* o8 = (u32x2*)(H + (size_t)row * DM) + lane;
#pragma unroll
    for (int j = 0; j < 8; ++j) { const f32x4 y = v[j] * rinv * nwp[64 * j] * (scl[64 * j] + 1.f) + sh[64 * j];
        u32x2 w; w.x = cvt_pk_bf16(y[0], y[1]); w.y = cvt_pk_bf16(y[2], y[3]); o8[64 * j] = w; }
}

__device__ __forceinline__ void p1_row2(int rowA, int rowB, const float* __restrict__ xsrc, const float* __restrict__ csrc, const float* __restrict__ modl,
                                        const float* __restrict__ nw, bf16_t* __restrict__ H, int lane) {
    if (rowB < 0) { p1_row(rowA, xsrc, csrc, modl, nw, H, lane); return; }
    const bool latA = rowA < MLAT, latB = rowB < MLAT; const int miA = latA ? (rowA >> 12) : 4, miB = latB ? (rowB >> 12) : 4;
    const f32x4* xa = (const f32x4*)(latA ? xsrc + (size_t)rowA * DM : csrc + (size_t)(rowA - MLAT) * DM) + lane;
    const f32x4* xb = (const f32x4*)(latB ? xsrc + (size_t)rowB * DM : csrc + (size_t)(rowB - MLAT) * DM) + lane;
    f32x4 va[8], vb[8]; float sa = 0.f, sb = 0.f;
#pragma unroll
    for (int j = 0; j < 8; ++j) { va[j] = xa[64 * j]; vb[j] = xb[64 * j]; }
#pragma unroll
    for (int j = 0; j < 8; ++j) { sa += (va[j][0] * va[j][0] + va[j][1] * va[j][1]) + (va[j][2] * va[j][2] + va[j][3] * va[j][3]);
                                  sb += (vb[j][0] * vb[j][0] + vb[j][1] * vb[j][1]) + (vb[j][2] * vb[j][2] + vb[j][3] * vb[j][3]); }
    const float ra = rsqrtf(wave_sum(sa) * (1.f / DM) + EPS), rb = rsqrtf(wave_sum(sb) * (1.f / DM) + EPS);
    const f32x4* nwp = (const f32x4*)nw + lane;
    const f32x4* sha = (const f32x4*)(modl + miA * 6144) + lane; const f32x4* sca = (const f32x4*)(modl + miA * 6144 + DM) + lane;
    const f32x4* shb = (const f32x4*)(modl + miB * 6144) + lane; const f32x4* scb = (const f32x4*)(modl + miB * 6144 + DM) + lane;
    u32x2* oa = (u32x2*)(H + (size_t)rowA * DM) + lane; u32x2* ob = (u32x2*)(H + (size_t)rowB * DM) + lane;
#pragma unroll
    for (int j = 0; j < 8; ++j) { const f32x4 w4 = nwp[64 * j];
        const f32x4 ya = va[j] * ra * w4 * (sca[64 * j] + 1.f) + sha[64 * j], yb = vb[j] * rb * w4 * (scb[64 * j] + 1.f) + shb[64 * j];
        u32x2 wa, wb; wa.x = cvt_pk_bf16(ya[0], ya[1]); wa.y = cvt_pk_bf16(ya[2], ya[3]); wb.x = cvt_pk_bf16(yb[0], yb[1]); wb.y = cvt_pk_bf16(yb[2], yb[3]);
        oa[64 * j] = wa; ob[64 * j] = wb; }
}

struct Args { const float* in[29]; float* out; unsigned char* ws; int ph_lo, ph_hi, coop, pad; };

__global__ void __launch_bounds__(512, 2) mega_fwd(Args args) {
    extern __shared__ __attribute__((aligned(16))) unsigned char lds_raw[];
    LAS unsigned char* lds = (LAS unsigned char*)lds_raw;
    const int G = gridDim.x;
    unsigned char* ws = args.ws;
    float* MOD = (float*)(ws + WS_MOD);
    float* TC64 = (float*)(ws + WS_TC64); float* TS64 = (float*)(ws + WS_TS64); float* TC128 = (float*)(ws + WS_TC128); float* TS128 = (float*)(ws + WS_TS128);
    float* LAM = (float*)(ws + WS_LAM);
    bf16_t* WIN = (bf16_t*)(ws + WS_WIN); bf16_t* WUP = (bf16_t*)(ws + WS_WUP); bf16_t* WBR = (bf16_t*)(ws + WS_WBR); bf16_t* WOUT = (bf16_t*)(ws + WS_WOUT);
    bf16_t* H = (bf16_t*)(ws + WS_H); bf16_t* QA = (bf16_t*)(ws + WS_QA); bf16_t* KA = (bf16_t*)(ws + WS_KA); bf16_t* VA = (bf16_t*)(ws + WS_VA);
    bf16_t* QB = (bf16_t*)(ws + WS_QB); bf16_t* KB = (bf16_t*)(ws + WS_KB); bf16_t* CKV = (bf16_t*)(ws + WS_CKV); bf16_t* VB = (bf16_t*)(ws + WS_VB);
    bf16_t* QC = (bf16_t*)(ws + WS_QC); bf16_t* KC = (bf16_t*)(ws + WS_KC); bf16_t* VC = (bf16_t*)(ws + WS_VC);
    bf16_t* GATE = (bf16_t*)(ws + WS_GATE); bf16_t* MRG = (bf16_t*)(ws + WS_MRG); bf16_t* BR = (bf16_t*)(ws + WS_BR); bf16_t* Y = (bf16_t*)(ws + WS_Y);
    float* SS = (float*)(ws + WS_SS); float* CTXW = (float*)(ws + WS_CTXW); float* SCR = (float*)(ws + WS_SCR);
    LAS float* xch = (LAS float*)(lds + XCH_OFF);
    volatile LAS unsigned* bst = (volatile LAS unsigned*)(lds + XCH_OFF + 4096);
    if (threadIdx.x < 2) bst[threadIdx.x] = 0u;
    __syncthreads();
    XcdBarrier bar = xcd_barrier_post((unsigned*)(ws + WS_BAR), bst);

    for (int ph = args.ph_lo; ph < args.ph_hi; ++ph) {
        int bx = blockIdx.x; asm volatile("" : "+s"(bx));
        const int vcu = (G % 8 == 0) ? (bx % 8) * (G / 8) + bx / 8 : bx;
        int tid = threadIdx.x; asm volatile("" : "+v"(tid));
        const int lane = tid & 63, wave = __builtin_amdgcn_readfirstlane(tid >> 6);
        if (ph == 0 && (MK_MASK & 1)) {
            {
                LAS float* sc = (LAS float*)lds;
                LAS float* red = (LAS float*)(lds + 65536);
                for (int i = tid; i < 5 * DM; i += 512) { const float v = i < 4 * DM ? args.in[1][i] : args.in[3][i - 4 * DM]; sc[i] = silu_f(v); }
                __syncthreads();
                for (int it = bx; it < DEPTH * 96; it += G) {
                    const int l = it / 96, n0 = (it % 96) * 64;
                    const float* W = args.in[5] + (size_t)l * DM * 6144 + n0 + lane;
                    float a0 = 0.f, a1 = 0.f, a2 = 0.f, a3 = 0.f, a4 = 0.f;
                    const int kb = wave * 256;
#pragma unroll 8
                    for (int k = 0; k < 256; ++k) { const float wv = W[(size_t)(kb + k) * 6144];
                        a0 += sc[kb + k] * wv; a1 += sc[DM + kb + k] * wv; a2 += sc[2 * DM + kb + k] * wv; a3 += sc[3 * DM + kb + k] * wv; a4 += sc[4 * DM + kb + k] * wv; }
                    red[(wave * 5 + 0) * 64 + lane] = a0; red[(wave * 5 + 1) * 64 + lane] = a1; red[(wave * 5 + 2) * 64 + lane] = a2; red[(wave * 5 + 3) * 64 + lane] = a3; red[(wave * 5 + 4) * 64 + lane] = a4;
                    __syncthreads();
                    if (tid < 320) { const int i = tid >> 6; float s = 0.f;
                        for (int w8 = 0; w8 < 8; ++w8) s += red[(w8 * 5 + i) * 64 + lane];
                        MOD[((size_t)l * 5 + i) * 6144 + n0 + lane] = s + args.in[6][(size_t)l * 6144 + n0 + lane]; }
                    __syncthreads();
                }
            }
            if (bx == 1 % G) {
                for (int i = tid; i < 64 * 16; i += 512) { const int pos = i >> 4, f = i & 15; const float ang = (float)pos * INVF32[f]; float s, c; sincos_d((double)ang, s, c); TC64[i] = c; TS64[i] = s; }
                for (int i = tid; i < 64 * 32; i += 512) { const int pos = i >> 5, f = i & 31; const float ang = (float)pos * INVF64[f]; float s, c; sincos_d((double)ang, s, c); TC128[i] = c; TS128[i] = s; }
            }
            if (bx == 2 % G && tid < DEPTH) {
                const int l = tid;
                float s1 = 0.f, s2 = 0.f;
                for (int i = 0; i < 64; ++i) { s1 += args.in[20][l * 64 + i] * args.in[21][l * 64 + i]; s2 += args.in[22][l * 64 + i] * args.in[23][l * 64 + i]; }
                const float lam_init = 0.8f - 0.6f * expf(-0.3f * (float)l);
                LAM[l * 4 + 0] = expf(s1) - expf(s2) + lam_init;
                const float mAq = absmax_n(args.in[9] + l * 128, 128), mAk = absmax_n(args.in[10] + l * 128, 128);
                const float mBqn = absmax_n(args.in[11] + l * 128, 128), mBqr = absmax_n(args.in[12] + l * 64, 64), mBkn = absmax_n(args.in[16] + l * 128, 128), mBkr = absmax_n(args.in[17] + l * 64, 64);
                const float mCq = absmax_n(args.in[18] + l * 64, 64), mCk = absmax_n(args.in[19] + l * 64, 64);
                const float L2E = 1.4426950408889634f;
                LAM[l * 4 + 1] = -(sqrtf(128.f) * mAq * mAk) * L2E;
                LAM[l * 4 + 2] = -(sqrtf(128.f * mBqn * mBqn + 64.f * mBqr * mBqr) * sqrtf(128.f * mBkn * mBkn + 64.f * mBkr * mBkr) * 0.07216878364870323f) * L2E;
                LAM[l * 4 + 3] = -(8.f * mCq * mCk) * L2E;
            }
            __syncthreads();
            {
                LAS float* scr = (LAS float*)(lds + wave * 16640);
                const int gw = vcu * 8 + wave, NGW = G * 8;
                constexpr int I_IN = 32 * (NIN / 64), I_UP = 8 * 32, I_BR = 3 * 16 * 32, I_OUT = 32 * 32, I_L = I_IN + I_UP + I_BR + I_OUT;
                const int n4 = (lane & 15) * 4;
                for (int it = gw; it < DEPTH * I_L; it += NGW) {
                    const int l = it / I_L; int r = it % I_L;
                    if (r < I_IN) { const int nb = r % (NIN / 64), kb = r / (NIN / 64); const int n0 = nb * 64;
                        transpose_item(args.in[7] + (size_t)l * DM * INC, INC, kb * 64, in_src_col(n0 + n4), nullptr, WIN + (size_t)l * NIN * DM, DM, n0, 0, scr, lane); continue; }
                    r -= I_IN;
                    if (r < I_UP) { const int nb = r % 32, kb = r / 32; const int n0 = nb * 64; const int sc_ = up_src_col(n0 + n4);
                        const float* W = (sc_ < 1024 ? args.in[14] : args.in[15]) + (size_t)l * 512 * 1024;
                        transpose_item(W, 1024, kb * 64, sc_ & 1023, args.in[13] + l * 512, WUP + (size_t)l * 2048 * 512, 512, n0, 0, scr, lane); continue; }
                    r -= I_UP;
                    if (r < I_BR) { const int br = r / (16 * 32), r2 = r % (16 * 32); const int nb = r2 % 32, kb = r2 / 32; const int n0 = nb * 64;
                        transpose_item(args.in[25 + br] + (size_t)l * 1024 * DM, DM, kb * 64, n0 + n4, nullptr, WBR + (size_t)l * 2048 * 3072, 3072, n0, br * 1024, scr, lane); continue; }
                    r -= I_BR;
                    { const int nb = r % 32, kb = r / 32; const int n0 = nb * 64;
                      transpose_item(args.in[28] + (size_t)l * DM * DM, DM, kb * 64, n0 + n4, nullptr, WOUT + (size_t)l * DM * DM, DM, n0, 0, scr, lane); }
                }
            }
        } else {
            const int l = (ph == 1) ? 0 : (ph - 2) / 3, st_ = (ph == 1) ? 0 : 1 + (ph - 2) % 3, st = (st_ >= 2) ? st_ + 1 : st_;
            const float* xsrc = (l == 0) ? args.in[0] : args.out;
            const float* csrc = (l == 0) ? args.in[2] : CTXW;
            const float* modl = MOD + (size_t)l * 5 * 6144;
            const int Mrows = (l == DEPTH - 1) ? MLAT : MTOT;
            if (st == 0 && (MK_MASK & 2)) {
                const float* nw = args.in[4] + (size_t)l * DM;
                for (int row = bx * 8 + wave; row < MTOT; row += G * 16) { const int rb = row + G * 8; p1_row2(row, rb < MTOT ? rb : -1, xsrc, csrc, modl, nw, H, lane); }
            } else if (st == 1 && (MK_MASK & 4)) {
                pg8::Gemm g{H, WIN + (size_t)l * NIN * DM, MTOT, NIN, DM};
                EpiIn E{QA, KA, VA, QB, KB, CKV, QC, KC, VC, GATE, MRG, SS,
                        args.in[9] + l * 128, args.in[10] + l * 128, args.in[11] + l * 128, args.in[12] + l * 64, args.in[17] + l * 64, args.in[18] + l * 64, args.in[19] + l * 64,
                        args.in[8] + (size_t)l * 6144, TC64, TS64, TC128, TS128, xch};
                const bool trim = (l == DEPTH - 1) && (G == 256);
                for (int part = 0; part < 2; ++part) {
                    pg8::StaticOrder S;
                    if (!trim) { if (part) break; S.init(MTOT, NIN, G, bx); }
                    else if (part == 0) S.init(MLAT, NIN, G, bx);
                    else { if (!(bx >= 192 && bx < 244)) break; const int k = bx - 192, j = k % 13;
                           const int pn = (j < 2) ? 4 + j : (j < 5 ? 10 + j : 14 + j);
                           S.init_one(64 + k / 13, pn); }
                    { int t2 = threadIdx.x; asm volatile("" : "+v"(t2)); pg8::gemm_phase<EpiIn>(lds, g, S, E, t2); }
                }
            } else if (st == 3 && (MK_MASK & 16)) {
                unsigned* UPC = (unsigned*)(ws + WS_CNT) + (size_t)(2 * DEPTH * 68 + l) * 64;
                const bool merged = (G == 256) && args.coop;
                {
                    pg8::Gemm g{CKV, WUP + (size_t)l * 2048 * 512, MTOT, 2048, 512}; pg8::StaticOrder S; S.init(MTOT, 2048, G, bx);
                    EpiUp E{KB, VB, SS, args.in[16] + l * 128, xch};
                    pg8::gemm_phase<EpiUp>(lds, g, S, E, tid);
                    if (merged) {
                        if (threadIdx.x == 0) {
                            __builtin_amdgcn_fence(__ATOMIC_RELEASE, "agent");
                            asm volatile("s_waitcnt vmcnt(0)" ::: "memory");
                            const unsigned n = (bx < 544) ? (unsigned)((544 - 1 - bx) / G + 1) : 0u;
                            __hip_atomic_fetch_add(UPC, n, __ATOMIC_RELAXED, __HIP_MEMORY_SCOPE_AGENT);
                        }
                    } else if (args.coop) xcd_barrier(bar);
                }
                AttnBufs T{QA, KA, VA, QB, KB, VB, QC, KC, VC, GATE, BR, SCR, LAM + l * 4, args.in[24] + l * 128, 0.8f - 0.6f * expf(-0.3f * (float)l)};
                const int nctx = (l < DEPTH - 1) ? 96 : 0;
                for (int k = 0;; ++k) {
                    int type, b, h, qrow0, NT;
                    if (G == 256) {
                        if (k == 4 && merged) {
                            if (threadIdx.x == 0) { unsigned sp = 0;
                                while (__hip_atomic_load(UPC, __ATOMIC_RELAXED, __HIP_MEMORY_SCOPE_AGENT) < 544u) { __builtin_amdgcn_s_sleep(1); if (++sp > (1u << 22)) break; }
                                __builtin_amdgcn_fence(__ATOMIC_ACQUIRE, "agent");
                                asm volatile("s_waitcnt vmcnt(0)" ::: "memory"); }
                            __syncthreads();
                        }
                        if (k < 6) { const int id = (k & 1) * 256 + vcu; type = (k < 2) ? 0 : (k < 4 ? 2 : 1); b = id >> 7; h = (id >> 4) & 7; qrow0 = b * SEQ + (id & 15) * 256; NT = 68; }
                        else if (k == 6 && bx < nctx) { type = bx >> 5; b = (bx >> 3) & 3; h = bx & 7; qrow0 = MLAT + b * CTXL; NT = 4; }
                        else break;
                    } else {
                        const int it = bx + k * G; if (it >= 1536 + nctx) break;
                        if (it < 1536) { const int id = it & 511; type = it >> 9; b = id >> 7; h = (id >> 4) & 7; qrow0 = b * SEQ + (id & 15) * 256; NT = 68; }
                        else { const int c = it - 1536; type = c >> 5; b = (c >> 3) & 3; h = c & 7; qrow0 = MLAT + b * CTXL; NT = 4; }
                    }
                    attn_item(T, type, b, h, qrow0, NT, (LAS char*)lds, tid);
                }
                __syncthreads();
            } else {
                unsigned* CNT = (unsigned*)(ws + WS_CNT) + (size_t)l * 68 * 64;
                const bool merged = (G == 256) && args.coop;
                const bool ctxl = l < DEPTH - 1;
                pg8::Gemm g3{BR, WBR + (size_t)l * 2048 * 3072, Mrows, 2048, 3072}; EpiBr E3{MRG, Y};
                pg8::Gemm g4{Y, WOUT + (size_t)l * DM * DM, Mrows, DM, DM}; EpiOut E4{xsrc, csrc, args.out, CTXW, modl};
                for (int part = 0; part < 2; ++part) {
                    pg8::StaticOrder S;
                    if (!merged) { if (part) break; S.init(Mrows, 2048, G, bx); }
                    else if (part == 0) S.init(MLAT, 2048, G, bx);
                    else { if (!(ctxl && bx < 32)) break; S.init_one(64 + (bx >> 3), bx & 7); }
                    { int t2 = threadIdx.x; asm volatile("" : "+v"(t2)); pg8::gemm_phase<EpiBr>(lds, g3, S, E3, t2); }
                    if (merged && threadIdx.x == 0) {
                        __builtin_amdgcn_fence(__ATOMIC_RELEASE, "agent");
                        asm volatile("s_waitcnt vmcnt(0)" ::: "memory");
                        pg8::Unit u; for (int i = 0; S.next(i, u); ++i) __hip_atomic_fetch_add(&CNT[u.pm * 64], 1u, __ATOMIC_RELAXED, __HIP_MEMORY_SCOPE_AGENT);
                    }
                }
                if (!merged && args.coop) xcd_barrier(bar);
                for (int part = 0; part < 2; ++part) {
                    pg8::StaticOrder S;
                    if (!merged) { if (part) break; S.init(Mrows, DM, G, bx); }
                    else if (part == 0) S.init(MLAT, DM, G, bx);
                    else { if (!(ctxl && bx >= 32 && bx < 64)) break; S.init_one(64 + ((bx - 32) >> 3), bx & 7); }
                    if (merged) {
                        if (threadIdx.x == 0) {
                            pg8::Unit u;
                            for (int i = 0; S.next(i, u); ++i) { unsigned sp = 0;
                                while (__hip_atomic_load(&CNT[u.pm * 64], __ATOMIC_RELAXED, __HIP_MEMORY_SCOPE_AGENT) < 8u) { __builtin_amdgcn_s_sleep(1); if (++sp > (1u << 22)) break; } }
                            __builtin_amdgcn_fence(__ATOMIC_ACQUIRE, "agent");
                            asm volatile("s_waitcnt vmcnt(0)" ::: "memory");
                        }
                        __syncthreads();
                    }
                    { int t2 = threadIdx.x; asm volatile("" : "+v"(t2)); pg8::gemm_phase<EpiOut>(lds, g4, S, E4, t2); }
                    if (merged && ctxl && threadIdx.x == 0) {
                        __builtin_amdgcn_fence(__ATOMIC_RELEASE, "agent");
                        asm volatile("s_waitcnt vmcnt(0)" ::: "memory");
                        pg8::Unit u; for (int i = 0; S.next(i, u); ++i) __hip_atomic_fetch_add(&CNT[(DEPTH * 68 + u.pm) * 64], 1u, __ATOMIC_RELAXED, __HIP_MEMORY_SCOPE_AGENT);
                    }
                }
                if (l < DEPTH - 1) {
                    const float* nw1 = args.in[4] + (size_t)(l + 1) * DM; const float* mod1 = MOD + (size_t)(l + 1) * 5 * 6144;
                    int t3 = threadIdx.x; asm volatile("" : "+v"(t3));
                    const int lane3 = t3 & 63, wave3 = __builtin_amdgcn_readfirstlane(t3 >> 6);
                    if (merged) {
                        const int r0 = 68 * bx;
                        if (threadIdx.x == 0) {
                            for (int pm = r0 >> 8; pm <= (r0 + 67) >> 8; ++pm) { unsigned sp = 0;
                                while (__hip_atomic_load(&CNT[(DEPTH * 68 + pm) * 64], __ATOMIC_RELAXED, __HIP_MEMORY_SCOPE_AGENT) < 8u) { __builtin_amdgcn_s_sleep(1); if (++sp > (1u << 22)) break; } }
                            __builtin_amdgcn_fence(__ATOMIC_ACQUIRE, "agent");
                            asm volatile("s_waitcnt vmcnt(0)" ::: "memory");
                        }
                        __syncthreads();
                        for (int row = r0 + wave3; row < r0 + 68; row += 16) { const int rb = row + 8; p1_row2(row, rb < r0 + 68 ? rb : -1, args.out, CTXW, mod1, nw1, H, lane3); }
                    } else {
                        if (args.coop) xcd_barrier(bar);
                        for (int row = bx * 8 + wave3; row < MTOT; row += G * 16) { const int rb = row + G * 8; p1_row2(row, rb < MTOT ? rb : -1, args.out, CTXW, mod1, nw1, H, lane3); }
                    }
                }
            }
        }
        if (ph + 1 < args.ph_hi) { if (args.coop) { if (ph == 0) cg::this_grid().sync(); else xcd_barrier(bar); } }
    }
}

extern "C" void kernel_launch(void* const* d_in, const int* in_sizes, int n_in, void* d_out, int out_size, void* d_ws, size_t ws_size, hipStream_t stream) {
    static int grid = 0;
    if (grid == 0) {
        if (n_in != 29 || in_sizes[0] != MLAT * DM || out_size != MLAT * DM || ws_size < WS_END) {
            fprintf(stderr, "kernel_launch: unexpected shapes: n_in %d in0 %d out %d ws %zu (need %zu)\n", n_in, n_in > 0 ? in_sizes[0] : -1, out_size, ws_size, (size_t)WS_END); grid = -1; return; }
        int dev = 0, cus = 0, per_cu = 0;
        if (hipGetDevice(&dev) != hipSuccess || hipDeviceGetAttribute(&cus, hipDeviceAttributeMultiprocessorCount, dev) != hipSuccess) { grid = -1; return; }
        if (hipFuncSetAttribute((const void*)mega_fwd, hipFuncAttributeMaxDynamicSharedMemorySize, LDS_BYTES) != hipSuccess) { fprintf(stderr, "kernel_launch: hipFuncSetAttribute failed\n"); grid = -1; return; }
        if (hipOccupancyMaxActiveBlocksPerMultiprocessor(&per_cu, (const void*)mega_fwd, 512, LDS_BYTES) != hipSuccess || per_cu < 1) { fprintf(stderr, "kernel_launch: occupancy query gives %d\n", per_cu); per_cu = 1; }
        (void)hipGetLastError();
        grid = cus * 1;
    }
    if (grid < 0) return;
    Args a{};
    for (int i = 0; i < 29; ++i) a.in[i] = (const float*)d_in[i];
    a.out = (float*)d_out; a.ws = (unsigned char*)d_ws;
#if MK_COOP
    if (hipMemsetAsync((char*)d_ws + WS_BAR, 0, 16384 + CNT_BYTES, stream) != hipSuccess) { fprintf(stderr, "kernel_launch: memset of the barrier words failed\n"); return; }
    a.ph_lo = 0; a.ph_hi = NPH; a.coop = 1;
    void* kargs[] = {&a};
    hipError_t e = hipLaunchCooperativeKernel((const void*)mega_fwd, dim3(grid), dim3(512), kargs, LDS_BYTES, stream);
    if (e != hipSuccess) fprintf(stderr, "kernel_launch: cooperative launch failed: %s (grid %d)\n", hipGetErrorString(e), grid);
#else
    for (int ph = 0; ph < NPH; ++ph) {
        a.ph_lo = ph; a.ph_hi = ph + 1; a.coop = 0;
        hipLaunchKernelGGL(mega_fwd, dim3(grid), dim3(512), LDS_BYTES, stream, a);
    }
    const hipError_t le = hipPeekAtLastError();
    if (le != hipSuccess) fprintf(stderr, "kernel_launch: launch failed: %s\n", hipGetErrorName(le));
#endif
}
```

```cpp
#include <hip/hip_runtime.h>
#include <hip/hip_cooperative_groups.h>
#include <cstdio>
#include <cstdint>
namespace cg = cooperative_groups;

#ifndef MK_MASK
#define MK_MASK 127
#endif
#ifndef MK_ATYPE
#define MK_ATYPE 7
#endif
#ifndef MK_G1T
#define MK_G1T 127
#endif
#ifndef ATT_SD_A
#define ATT_SD_A 2
#endif
#ifndef ATT_SD_B
#define ATT_SD_B 1
#endif
#ifndef ATT_SD_C
#define ATT_SD_C 2
#endif
#ifndef ATT_DBL_B
#define ATT_DBL_B true
#endif
#ifndef ATT_DBL
#define ATT_DBL false
#endif
#ifndef QKT_GRP
#define QKT_GRP 0
#endif
#ifndef MK_COOP
#define MK_COOP 1
#endif

#define LAS __attribute__((address_space(3)))
typedef unsigned short bf16_t;
typedef short bf16x8 __attribute__((ext_vector_type(8)));
typedef short s16x4 __attribute__((ext_vector_type(4)));
typedef float f32x4 __attribute__((ext_vector_type(4)));
typedef float f32x16 __attribute__((ext_vector_type(16)));
typedef unsigned u32x4 __attribute__((ext_vector_type(4)));
typedef unsigned u32x2 __attribute__((ext_vector_type(2)));

constexpr int DM = 2048, NBATCH = 4, SEQ = 4096, CTXL = 256, DEPTH = 4;
constexpr int MLAT = NBATCH * SEQ, MCTX = NBATCH * CTXL, MTOT = MLAT + MCTX;
constexpr int INC = 15936, NIN = 16128;
constexpr float EPS = 1e-6f;
#ifndef MK_REP_ST
#define MK_REP_ST -1
#endif
constexpr int PPL = 5;
constexpr int NPH = 2 + 3 * DEPTH;

constexpr size_t alignup(size_t x) { return (x + 255) / 256 * 256; }
constexpr size_t WS_MOD = 0;
constexpr size_t WS_TC64 = WS_MOD + alignup((size_t)DEPTH * 5 * 6144 * 4);
constexpr size_t WS_TS64 = WS_TC64 + 4096, WS_TC128 = WS_TS64 + 4096, WS_TS128 = WS_TC128 + 8192;
constexpr size_t WS_LAM = WS_TS128 + 8192;
constexpr size_t WS_BAR = WS_LAM + 256;
constexpr size_t WS_CNT = WS_BAR + 16384;
constexpr size_t CNT_BYTES = (size_t)(2 * DEPTH * 68 + DEPTH) * 256;
constexpr size_t WS_WIN = WS_CNT + CNT_BYTES;
constexpr size_t WS_WUP = WS_WIN + (size_t)DEPTH * NIN * DM * 2;
constexpr size_t WS_WBR = WS_WUP + (size_t)DEPTH * 2048 * 512 * 2;
constexpr size_t WS_WOUT = WS_WBR + (size_t)DEPTH * 2048 * 3072 * 2;
constexpr size_t WS_H = WS_WOUT + (size_t)DEPTH * 2048 * 2048 * 2;
constexpr size_t WS_QA = WS_H + (size_t)MTOT * 2048 * 2;
constexpr size_t WS_KA = WS_QA + (size_t)MTOT * 1024 * 2;
constexpr size_t WS_VA = WS_KA + (size_t)MTOT * 256 * 2;
constexpr size_t WS_QB = WS_VA + (size_t)MTOT * 256 * 2;
constexpr size_t WS_KB = WS_QB + (size_t)MTOT * 1536 * 2;
constexpr size_t WS_CKV = WS_KB + (size_t)MTOT * 1536 * 2;
constexpr size_t WS_VB = WS_CKV + (size_t)MTOT * 512 * 2;
constexpr size_t WS_QC = WS_VB + (size_t)MTOT * 1024 * 2;
constexpr size_t WS_KC = WS_QC + (size_t)MTOT * 1024 * 2;
constexpr size_t WS_VC = WS_KC + (size_t)MTOT * 1024 * 2;
constexpr size_t WS_GATE = WS_VC + (size_t)MTOT * 1024 * 2;
constexpr size_t WS_MRG = WS_GATE + (size_t)MTOT * 3072 * 2;
constexpr size_t WS_BR = WS_MRG + (size_t)MTOT * 6144 * 2;
constexpr size_t WS_Y = WS_BR + (size_t)MTOT * 3072 * 2;
constexpr size_t WS_SS = WS_Y + (size_t)MTOT * 2048 * 2;
constexpr size_t WS_CTXW = WS_SS + (size_t)MTOT * 8 * 4;
constexpr size_t WS_SCR = WS_CTXW + (size_t)MCTX * DM * 4;
constexpr size_t WS_END = WS_SCR + (size_t)256 * 64 * 512 * 4;

constexpr int RING_BYTES = 131072, XCH_OFF = RING_BYTES, LDS_BYTES = 147456;

__device__ __forceinline__ float bf2f(unsigned h) { return __uint_as_float(h << 16); }
__device__ __forceinline__ unsigned cvt_pk_bf16(float lo, float hi) { unsigned r; asm volatile("v_cvt_pk_bf16_f32 %0, %1, %2" : "=v"(r) : "v"(lo), "v"(hi)); return r; }
__device__ __forceinline__ float wave_sum(float v) {
#pragma unroll
    for (int o = 1; o < 64; o <<= 1) v += __shfl_xor(v, o);
    return v;
}
__device__ __forceinline__ float sigm_f(float x) { return __builtin_amdgcn_rcpf(1.f + __builtin_amdgcn_exp2f(-1.4426950408889634f * x)); }
__device__ __forceinline__ float silu_f(float x) { return x * sigm_f(x); }
__device__ __forceinline__ unsigned cvt_pk_bf16_safe(float lo, float hi) { unsigned r; asm volatile("s_nop 1\n\tv_cvt_pk_bf16_f32 %0, %1, %2" : "=v"(r) : "v"(lo), "v"(hi)); return r; }
__device__ __forceinline__ void store8_safe(bf16_t* p, f32x4 a, f32x4 b) {
    u32x4 w; w.x = cvt_pk_bf16_safe(a[0], a[1]); w.y = cvt_pk_bf16_safe(a[2], a[3]); w.z = cvt_pk_bf16_safe(b[0], b[1]); w.w = cvt_pk_bf16_safe(b[2], b[3]);
    *(u32x4*)p = w;
}
__device__ __forceinline__ void store8(bf16_t* p, f32x4 a, f32x4 b) {
    u32x4 w; w.x = cvt_pk_bf16(a[0], a[1]); w.y = cvt_pk_bf16(a[2], a[3]); w.z = cvt_pk_bf16(b[0], b[1]); w.w = cvt_pk_bf16(b[2], b[3]);
    *(u32x4*)p = w;
}

namespace pg8 {
constexpr int BM = 256, BK = 64, HALF = 128, HTB = HALF * BK * 2, NXCD = 8, WGM = 8;
__host__ __device__ __forceinline__ int lds_byte(int r, int c) { const int st = (r >> 4) * 2 + (c >> 5), rr = r & 15, cc = c & 31, ob = rr * 64 + cc * 2; return st * 1024 + (ob ^ (((ob >> 9) & 1) << 5)); }
__host__ __device__ __forceinline__ void stage_rc(int b, int& R, int& C) { const int st = b / 1024, sb = b % 1024, swz = sb ^ (((sb >> 9) & 1) << 5); R = (st >> 1) * 16 + swz / 64; C = (st & 1) * 32 + (swz % 64) / 2; }
__host__ __device__ __forceinline__ int perm32(int rho) { const int n = rho >> 4, i = rho & 15; return 8 * (i >> 2) + 4 * n + (i & 3); }

struct Unit { int pm, pn; };
struct Gemm { const bf16_t* A; const bf16_t* Bt; int M, N, K; };
struct StaticOrder {
    int nM, nN, nwg, G, c, fixed, fpm, fpn, i0, cnt;
    __device__ void init(int M, int N, int G_, int c_, int i0_ = 0, int cnt_ = 1 << 30) { nM = M / BM; nN = N / BM; nwg = nM * nN; G = G_; c = c_; fixed = 0; fpm = 0; fpn = 0; i0 = i0_; cnt = cnt_; }
    __device__ void init_one(int pm, int pn) { nM = 1; nN = 1; nwg = 1; G = 1; c = 0; fixed = 1; fpm = pm; fpn = pn; i0 = 0; cnt = 1; }
    __device__ bool next(int i, Unit& u) const {
        if (fixed) { if (i > 0) return false; u.pm = fpm; u.pn = fpn; return true; }
        if (i >= cnt) return false;
        const long L = (long)(i + i0) * G + c; if (L >= nwg) return false;
        int wgid = (int)L; { const int q = nwg / NXCD, r = nwg % NXCD, xcd = wgid % NXCD, off = wgid / NXCD; wgid = (xcd < r ? xcd * (q + 1) : r * (q + 1) + (xcd - r) * q) + off; }
        const int nig = WGM * nN, gid = wgid / nig, fm = gid * WGM, gsz = (nM - fm) < WGM ? (nM - fm) : WGM;
        u.pm = fm + ((wgid % nig) % gsz); u.pn = (wgid % nig) / gsz; return true;
    }
};

template <class Epi>
__device__ __forceinline__ void gemm_phase(LAS unsigned char* lds, const Gemm g, const StaticOrder& S, const Epi& E, const int tid) {
    const int wid = __builtin_amdgcn_readfirstlane(tid >> 6), lane = tid & 63, wr = wid >> 2, wc = wid & 3, fr = lane & 15, fq = lane >> 4;
    const int K = g.K, nt = K / BK;
    unsigned voffA[2], voffB[2];
#pragma unroll
    for (int i = 0; i < 2; ++i) { int R, C; stage_rc(tid * 16 + i * 8192, R, C); const int Rb = (R & ~31) + perm32(R & 31);
        voffA[i] = (unsigned)(R * K + C) * 2u; voffB[i] = (unsigned)(Rb * K + C) * 2u; }
    const size_t kstep = (size_t)(BK * 2);
    const size_t hstep = (size_t)HALF * K * 2;
    const size_t tstep = 2 * hstep;
    const unsigned ldsw = (unsigned)wid * 1024u;
    const int aoff = lds_byte(wr * 64 + fr, fq * 8), boff = lds_byte(wc * 32 + fr, fq * 8);
#define PG8_SA(b, h) (((b) * 2 + (h)) * HTB)
#define PG8_SB(b, h) ((4 + (b) * 2 + (h)) * HTB)
#define PG8_STAGE(bufoff, gbase, voff) do { _Pragma("unroll") for (int _i = 0; _i < 2; ++_i) \
        __builtin_amdgcn_global_load_lds((const unsigned*)((const char*)(gbase) + (voff)[_i]), (LAS unsigned*)(lds + (bufoff) + ldsw + _i * 8192), 16, 0, 0); } while (0)
#define PG8_LDA(dst, b, h) do { _Pragma("unroll") for (int m = 0; m < 4; ++m) _Pragma("unroll") for (int k = 0; k < 2; ++k) dst[m][k] = *(const LAS bf16x8*)(lds + PG8_SA(b, h) + aoff + m * 2048 + k * 1024); } while (0)
#define PG8_LDB(dst, b, h) do { _Pragma("unroll") for (int n = 0; n < 2; ++n) _Pragma("unroll") for (int k = 0; k < 2; ++k) dst[n][k] = *(const LAS bf16x8*)(lds + PG8_SB(b, h) + boff + n * 2048 + k * 1024); } while (0)
#define PG8_MMA(ai, bj, At, Bt) do { __builtin_amdgcn_s_setprio(1); _Pragma("unroll") for (int m = 0; m < 4; ++m) _Pragma("unroll") for (int n = 0; n < 2; ++n) _Pragma("unroll") for (int k = 0; k < 2; ++k) \
        acc[ai][bj][m][n] = __builtin_amdgcn_mfma_f32_16x16x32_bf16(Bt[n][k], At[m][k], acc[ai][bj][m][n], 0, 0, 0); __builtin_amdgcn_s_setprio(0); } while (0)
#define PG8_WAIT_V(n) asm volatile("s_waitcnt vmcnt(" #n ")" ::: "memory")
#define PG8_WAIT_L(n) asm volatile("s_waitcnt lgkmcnt(" #n ")" ::: "memory")
#define PG8_BAR __builtin_amdgcn_s_barrier()
#define PG8_SCHED __builtin_amdgcn_sched_barrier(0)
    Unit cur, nxt; int ui = 0;
    if (!S.next(0, cur)) return;
    f32x4 acc[2][2][4][2];
#pragma unroll
    for (int a = 0; a < 2; ++a)
#pragma unroll
        for (int b = 0; b < 2; ++b)
#pragma unroll
            for (int m = 0; m < 4; ++m)
#pragma unroll
                for (int n = 0; n < 2; ++n) acc[a][b][m][n] = (f32x4){0.f, 0.f, 0.f, 0.f};
    bf16x8 At[4][2], B0[2][2], B1[2][2];
    const char* cA = (const char*)g.A + (size_t)cur.pm * tstep; const char* cB = (const char*)g.Bt + (size_t)cur.pn * tstep;
    PG8_STAGE(PG8_SB(0, 0), cB, voffB); PG8_STAGE(PG8_SB(0, 1), cB + hstep, voffB); PG8_STAGE(PG8_SA(0, 0), cA, voffA); PG8_STAGE(PG8_SA(0, 1), cA + hstep, voffA);
    if (wr == 1) PG8_BAR;
    PG8_WAIT_V(2); PG8_BAR;
    PG8_STAGE(PG8_SB(1, 0), cB + kstep, voffB); PG8_STAGE(PG8_SA(1, 0), cA + kstep, voffA); PG8_STAGE(PG8_SB(1, 1), cB + hstep + kstep, voffB);
    PG8_WAIT_V(6); PG8_BAR;
    for (;;) {
        const bool has_next = S.next(ui + 1, nxt);
        const char* nA = has_next ? (const char*)g.A + (size_t)nxt.pm * tstep : cA; const char* nB = has_next ? (const char*)g.Bt + (size_t)nxt.pn * tstep : cB;
        for (int t = 0; t < nt; t += 2) {
            const bool last = (t == nt - 2);
            const char* a1 = cA + (size_t)(t + 1) * kstep;
            const char* a2 = last ? nA : cA + (size_t)(t + 2) * kstep; const char* b2 = last ? nB : cB + (size_t)(t + 2) * kstep;
            const char* a3 = a2 + kstep; const char* b3 = b2 + kstep;
            if constexpr (Epi::MID) { if (t == 16 || t == 32) { int fr_ = fr, fq_ = fq, wr_ = wr, wc_ = wc;
                asm volatile("" : "+v"(fr_), "+v"(fq_)); asm volatile("" : "+s"(wr_), "+s"(wc_));
                E.mid(acc, cur, t >> 4, wr_, wc_, fr_, fq_); PG8_WAIT_V(0); PG8_SCHED; } }
            PG8_LDB(B0, 0, 0); PG8_LDB(B1, 0, 1); PG8_SCHED; PG8_LDA(At, 0, 0); PG8_STAGE(PG8_SA(1, 1), a1 + hstep, voffA);
            PG8_WAIT_V(8); PG8_WAIT_L(0); PG8_BAR; PG8_MMA(0, 0, At, B0); PG8_MMA(0, 1, At, B1); PG8_BAR; PG8_SCHED;
            PG8_LDA(At, 0, 1); PG8_STAGE(PG8_SB(0, 0), b2, voffB); PG8_STAGE(PG8_SB(0, 1), b2 + hstep, voffB); PG8_STAGE(PG8_SA(0, 0), a2, voffA);
            PG8_WAIT_V(8); PG8_WAIT_L(0); PG8_BAR; PG8_MMA(1, 0, At, B0); PG8_MMA(1, 1, At, B1); PG8_BAR; PG8_SCHED;
            PG8_LDB(B0, 1, 0); PG8_LDB(B1, 1, 1); PG8_SCHED; PG8_LDA(At, 1, 0); PG8_STAGE(PG8_SA(0, 1), a2 + hstep, voffA);
            PG8_WAIT_V(8); PG8_WAIT_L(0); PG8_BAR; PG8_MMA(0, 0, At, B0); PG8_MMA(0, 1, At, B1); PG8_BAR; PG8_SCHED;
            PG8_LDA(At, 1, 1); PG8_STAGE(PG8_SB(1, 0), b3, voffB); PG8_STAGE(PG8_SB(1, 1), b3 + hstep, voffB); PG8_STAGE(PG8_SA(1, 0), a3, voffA);
            PG8_WAIT_V(8); PG8_WAIT_L(0); PG8_BAR; PG8_MMA(1, 0, At, B0); PG8_MMA(1, 1, At, B1); PG8_BAR; PG8_SCHED;
        }
        if (wr == 0) PG8_BAR;
        { int fr_ = fr, fq_ = fq, wr_ = wr, wc_ = wc, wid_ = wid;
          asm volatile("" : "+v"(fr_), "+v"(fq_)); asm volatile("" : "+s"(wr_), "+s"(wc_), "+s"(wid_));
          E(acc, cur, wr_, wc_, fr_, fq_, wid_); }
        if (!has_next) break;
#pragma unroll
        for (int a = 0; a < 2; ++a)
#pragma unroll
            for (int b = 0; b < 2; ++b)
#pragma unroll
                for (int m = 0; m < 4; ++m)
#pragma unroll
                    for (int n = 0; n < 2; ++n) acc[a][b][m][n] = (f32x4){0.f, 0.f, 0.f, 0.f};
        cur = nxt; cA = nA; cB = nB; ++ui;
        if (wr == 1) PG8_BAR;
    }
    PG8_WAIT_V(0);
    PG8_BAR;
#undef PG8_SA
#undef PG8_SB
#undef PG8_STAGE
#undef PG8_LDA
#undef PG8_LDB
#undef PG8_MMA
#undef PG8_WAIT_V
#undef PG8_WAIT_L
#undef PG8_BAR
#undef PG8_SCHED
}
}
using pg8::Unit;

__device__ __forceinline__ int in_src_col(int n) {
    const int tile = n >> 8, s = n & 255, bj = s >> 7, wc = (s >> 5) & 3, c = s & 31;
    const int d128 = 64 * (wc & 1) + 32 * bj + c, g128 = wc >> 1;
    const int d64 = 32 * (c >> 4) + 16 * bj + (c & 15), g64 = wc;
    if (tile < 4) return (tile * 2 + g128) * 128 + d128;
    if (tile == 4) return 1024 + g128 * 128 + d128;
    if (tile == 5) return 1280 + s;
    if (tile < 10) return 1536 + ((tile - 6) * 2 + g128) * 192 + d128;
    if (tile < 12) return 1536 + ((tile - 10) * 4 + g64) * 192 + 128 + d64;
    if (tile < 14) return 3072 + (tile - 12) * 256 + s;
    if (tile == 14) return g64 == 0 ? 3584 + d64 : -1;
    if (tile < 19) return 3648 + ((tile - 15) * 4 + g64) * 64 + d64;
    if (tile < 23) return 4672 + ((tile - 19) * 4 + g64) * 64 + d64;
    if (tile < 27) return 5696 + (tile - 23) * 256 + s;
    if (tile < 39) return 6720 + (tile - 27) * 256 + s;
    return 9792 + (tile - 39) * 256 + s;
}
__device__ __forceinline__ int up_src_col(int n) {
    if (n >= 1024) return n;
    const int tile = n >> 8, s = n & 255, bj = s >> 7, wc = (s >> 5) & 3, c = s & 31;
    return (tile * 2 + (wc >> 1)) * 128 + 64 * (wc & 1) + 32 * bj + c;
}

template <int GS>
__device__ __forceinline__ void norm_rope_store(const f32x4 (&acc)[2][2][4][2], int pm, int wr, int wc, int fr, int fq, int wid,
                                                const float* __restrict__ w, const float* __restrict__ tcos, const float* __restrict__ tsin, bool rope,
                                                const float (&pre)[2][4], bf16_t* __restrict__ dst, int ld, int gbase, int ncopies, int copystride, LAS float* xch, const float qs = 1.f) {
    const int dbase = (GS == 128) ? 64 * (wc & 1) + 8 * fq : 32 * (fq >> 1) + 8 * (fq & 1);
    const int bjs = (GS == 128) ? 32 : 16;
    const int axis = (GS == 128) ? (wc & 1) : (fq >> 1);
    const int i0 = (GS == 128) ? 8 * fq : 8 * (fq & 1);
    constexpr int NF = (GS == 128) ? 32 : 16;
    const int wavebase = gbase + ((GS == 128) ? 64 * (wc & 1) : 0) + 8 * fq;
    float ssq[2][4];
#pragma unroll
    for (int ai = 0; ai < 2; ++ai)
#pragma unroll
        for (int m = 0; m < 4; ++m) {
            float s = 0.f;
#pragma unroll
            for (int bj = 0; bj < 2; ++bj)
#pragma unroll
                for (int n = 0; n < 2; ++n)
#pragma unroll
                    for (int j = 0; j < 4; ++j) { const float v = acc[ai][bj][m][n][j] * pre[ai][m]; s += v * v; }
            s += __shfl_xor(s, 16); s += __shfl_xor(s, 32);
            ssq[ai][m] = s;
        }
    if constexpr (GS == 128) {
        if (fq == 0) {
#pragma unroll
            for (int ai = 0; ai < 2; ++ai)
#pragma unroll
                for (int m = 0; m < 4; ++m) xch[wid * 128 + ai * 64 + m * 16 + fr] = ssq[ai][m];
        }
        asm volatile("s_waitcnt lgkmcnt(0)" ::: "memory"); __builtin_amdgcn_s_barrier();
#pragma unroll
        for (int ai = 0; ai < 2; ++ai)
#pragma unroll
            for (int m = 0; m < 4; ++m) ssq[ai][m] += xch[(wid ^ 1) * 128 + ai * 64 + m * 16 + fr];
    }
#pragma unroll
    for (int ai = 0; ai < 2; ++ai)
#pragma unroll
        for (int m = 0; m < 4; ++m) {
            const int rl = ai * 128 + wr * 64 + m * 16 + fr;
            const size_t row = (size_t)pm * 256 + rl;
            const float rinv = rsqrtf(ssq[ai][m] * (1.f / GS) + EPS) * pre[ai][m] * qs;
            const int t = (pm & 15) * 256 + rl; const int pos = axis ? (t & 63) : (t >> 6);
            u32x4 k0, k1;
#pragma unroll
            for (int n = 0; n < 2; ++n) {
                const f32x4 w0 = *(const f32x4*)(w + dbase + 4 * n), w1 = *(const f32x4*)(w + dbase + bjs + 4 * n);
                f32x4 y0 = acc[ai][0][m][n] * rinv * w0, y1 = acc[ai][1][m][n] * rinv * w1;
                if (rope) {
                    const f32x4 c = *(const f32x4*)(tcos + pos * NF + i0 + 4 * n), sn = *(const f32x4*)(tsin + pos * NF + i0 + 4 * n);
                    const f32x4 o0 = y0 * c - y1 * sn, o1 = y1 * c + y0 * sn;
                    y0 = o0; y1 = o1;
                }
                if (n == 0) { k0.x = cvt_pk_bf16(y0[0], y0[1]); k0.y = cvt_pk_bf16(y0[2], y0[3]); k1.x = cvt_pk_bf16(y1[0], y1[1]); k1.y = cvt_pk_bf16(y1[2], y1[3]); }
                else { k0.z = cvt_pk_bf16(y0[0], y0[1]); k0.w = cvt_pk_bf16(y0[2], y0[3]); k1.z = cvt_pk_bf16(y1[0], y1[1]); k1.w = cvt_pk_bf16(y1[2], y1[3]); }
            }
            bf16_t* p = dst + row * ld + wavebase;
            for (int cp = 0; cp < ncopies; ++cp) { *(u32x4*)(p + cp * copystride) = k0; *(u32x4*)(p + cp * copystride + 32) = k1; }
            __builtin_amdgcn_sched_barrier(0);
        }
}

struct EpiIn {
    static constexpr bool MID = false;
    bf16_t *QA, *KA, *VA, *QB, *KB, *CKV, *QC, *KC, *VC, *GATE, *MRG; float* SS;
    const float *wAq, *wAk, *wBqn, *wBqr, *wBkr, *wCq, *wCk, *bmerge;
    const float *tc64, *ts64, *tc128, *ts128;
    LAS float* xch;
    template <int ACT>
    __device__ __forceinline__ void plain(const f32x4 (&acc)[2][2][4][2], int pm, int wr, int wc, int fr, int fq, bf16_t* dst, int ld, int col0) const {
        const int colw = col0 + 32 * wc + 8 * fq;
        f32x4 b[2][2];
#pragma unroll
        for (int bj = 0; bj < 2; ++bj)
#pragma unroll
            for (int n = 0; n < 2; ++n) b[bj][n] = (ACT == 2) ? *(const f32x4*)(bmerge + colw + bj * 128 + 4 * n) : (f32x4){0.f, 0.f, 0.f, 0.f};
#pragma unroll
        for (int ai = 0; ai < 2; ++ai)
#pragma unroll
            for (int m = 0; m < 4; ++m) {
                const size_t row = (size_t)pm * 256 + ai * 128 + wr * 64 + m * 16 + fr;
#pragma unroll
                for (int bj = 0; bj < 2; ++bj) {
                    f32x4 v0 = acc[ai][bj][m][0], v1 = acc[ai][bj][m][1];
                    if (ACT == 1) { for (int j = 0; j < 4; ++j) { v0[j] = silu_f(v0[j]); v1[j] = silu_f(v1[j]); } }
                    if (ACT == 2) { v0 = v0 + b[bj][0]; v1 = v1 + b[bj][1]; for (int j = 0; j < 4; ++j) { v0[j] = sigm_f(v0[j]); v1[j] = sigm_f(v1[j]); } }
                    if (ACT == 0) store8(dst + row * ld + colw + bj * 128, v0, v1); else store8_safe(dst + row * ld + colw + bj * 128, v0, v1);
                }
                __builtin_amdgcn_sched_barrier(0);
            }
    }
    __device__ __forceinline__ void operator()(const f32x4 (&acc)[2][2][4][2], const Unit& u, int wr, int wc, int fr, int fq, int wid) const {
        const int t = u.pn, pm = u.pm; const bool rope = pm < 64;
        const float one[2][4] = {{1.f, 1.f, 1.f, 1.f}, {1.f, 1.f, 1.f, 1.f}};
        if (t < 4 && (MK_G1T & 1)) norm_rope_store<128>(acc, pm, wr, wc, fr, fq, wid, wAq, tc128, ts128, rope, one, QA, 1024, (t * 2 + (wc >> 1)) * 128, 1, 0, xch, 0.08838834764831845f * 1.4426950408889634f);
        else if (t == 4 && (MK_G1T & 1)) norm_rope_store<128>(acc, pm, wr, wc, fr, fq, wid, wAk, tc128, ts128, rope, one, KA, 256, (wc >> 1) * 128, 1, 0, xch);
        else if (t == 5 && (MK_G1T & 2)) plain<0>(acc, pm, wr, wc, fr, fq, VA, 256, 0);
        else if (t < 10 && (MK_G1T & 1)) norm_rope_store<128>(acc, pm, wr, wc, fr, fq, wid, wBqn, tc128, ts128, false, one, QB, 1536, ((t - 6) * 2 + (wc >> 1)) * 192, 1, 0, xch, 0.07216878364870323f * 1.4426950408889634f);
        else if (t < 12 && (MK_G1T & 4)) norm_rope_store<64>(acc, pm, wr, wc, fr, fq, wid, wBqr, tc64, ts64, rope, one, QB, 1536, ((t - 10) * 4 + wc) * 192 + 128, 1, 0, xch, 0.07216878364870323f * 1.4426950408889634f);
        else if (t < 14 && (MK_G1T & 8)) {
            plain<0>(acc, pm, wr, wc, fr, fq, CKV, 512, (t - 12) * 256);
#pragma unroll
            for (int ai = 0; ai < 2; ++ai)
#pragma unroll
                for (int m = 0; m < 4; ++m) {
                    float s = 0.f;
#pragma unroll
                    for (int bj = 0; bj < 2; ++bj)
#pragma unroll
                        for (int n = 0; n < 2; ++n)
#pragma unroll
                            for (int j = 0; j < 4; ++j) { const float v = acc[ai][bj][m][n][j]; s += v * v; }
                    s += __shfl_xor(s, 16); s += __shfl_xor(s, 32);
                    if (fq == 0) SS[((size_t)pm * 256 + ai * 128 + wr * 64 + m * 16 + fr) * 8 + (t - 12) * 4 + wc] = s;
                }
        }
        else if (t == 14 && (MK_G1T & 16)) { if (wc == 0) norm_rope_store<64>(acc, pm, wr, wc, fr, fq, wid, wBkr, tc64, ts64, rope, one, KB, 1536, 128, 8, 192, xch); }
        else if (t < 19 && (MK_G1T & 4)) norm_rope_store<64>(acc, pm, wr, wc, fr, fq, wid, wCq, tc64, ts64, rope, one, QC, 1024, ((t - 15) * 4 + wc) * 64, 1, 0, xch, 0.125f * 1.4426950408889634f);
        else if (t < 23 && (MK_G1T & 4)) norm_rope_store<64>(acc, pm, wr, wc, fr, fq, wid, wCk, tc64, ts64, rope, one, KC, 1024, ((t - 19) * 4 + wc) * 64, 1, 0, xch);
        else if (t < 27 && (MK_G1T & 2)) plain<0>(acc, pm, wr, wc, fr, fq, VC, 1024, (t - 23) * 256);
        else if (t < 39 && (MK_G1T & 32)) plain<1>(acc, pm, wr, wc, fr, fq, GATE, 3072, (t - 27) * 256);
        else if (MK_G1T & 64) plain<2>(acc, pm, wr, wc, fr, fq, MRG, 6144, (t - 39) * 256);
    }
};

struct EpiUp {
    static constexpr bool MID = false;
    bf16_t *KB, *VB; const float* SS; const float* wBkn; LAS float* xch;
    __device__ __forceinline__ void operator()(const f32x4 (&acc)[2][2][4][2], const Unit& u, int wr, int wc, int fr, int fq, int wid) const {
        const int t = u.pn, pm = u.pm;
        float pre[2][4];
#pragma unroll
        for (int ai = 0; ai < 2; ++ai)
#pragma unroll
            for (int m = 0; m < 4; ++m) {
                const size_t row = (size_t)pm * 256 + ai * 128 + wr * 64 + m * 16 + fr;
                const f32x4 a = *(const f32x4*)(SS + row * 8), b = *(const f32x4*)(SS + row * 8 + 4);
                pre[ai][m] = rsqrtf(((a[0] + a[1]) + (a[2] + a[3]) + (b[0] + b[1]) + (b[2] + b[3])) * (1.f / 512.f) + EPS);
                __builtin_amdgcn_sched_barrier(0);
            }
        if (t < 4) norm_rope_store<128>(acc, pm, wr, wc, fr, fq, wid, wBkn, nullptr, nullptr, false, pre, KB, 1536, (t * 2 + (wc >> 1)) * 192, 1, 0, xch);
        else {
            const int colw = (t - 4) * 256 + 32 * wc + 8 * fq;
#pragma unroll
            for (int ai = 0; ai < 2; ++ai)
#pragma unroll
                for (int m = 0; m < 4; ++m) {
                    const size_t row = (size_t)pm * 256 + ai * 128 + wr * 64 + m * 16 + fr;
#pragma unroll
                    for (int bj = 0; bj < 2; ++bj) store8(VB + row * 1024 + colw + bj * 128, acc[ai][bj][m][0] * pre[ai][m], acc[ai][bj][m][1] * pre[ai][m]);
                    __builtin_amdgcn_sched_barrier(0);
                }
        }
    }
};

struct EpiBr {
    static constexpr bool MID = true;
    const bf16_t* MRG; bf16_t* Y;
    __device__ __forceinline__ void mid(f32x4 (&acc)[2][2][4][2], const Unit& u, int i, int wr, int wc, int fr, int fq) const {
#pragma unroll
        for (int ai = 0; ai < 2; ++ai)
#pragma unroll
            for (int m = 0; m < 4; ++m) {
                const size_t row = (size_t)u.pm * 256 + ai * 128 + wr * 64 + m * 16 + fr;
#pragma unroll
                for (int bj = 0; bj < 2; ++bj) {
                    const int col = u.pn * 256 + bj * 128 + 32 * wc + 8 * fq;
                    const u32x4 a = *(const u32x4*)(MRG + row * 6144 + (i - 1) * 2048 + col), b = *(const u32x4*)(MRG + row * 6144 + i * 2048 + col);
#pragma unroll
                    for (int q = 0; q < 4; ++q) {
                        const float r0 = bf2f(a[q] & 0xffffu) * __builtin_amdgcn_rcpf(bf2f(b[q] & 0xffffu)), r1 = bf2f(a[q] >> 16) * __builtin_amdgcn_rcpf(bf2f(b[q] >> 16));
                        acc[ai][bj][m][q >> 1][(q & 1) * 2] *= r0; acc[ai][bj][m][q >> 1][(q & 1) * 2 + 1] *= r1;
                    }
                }
                __builtin_amdgcn_sched_barrier(0);
            }
    }
    __device__ __forceinline__ void operator()(const f32x4 (&acc)[2][2][4][2], const Unit& u, int wr, int wc, int fr, int fq, int wid) const {
#pragma unroll
        for (int ai = 0; ai < 2; ++ai)
#pragma unroll
            for (int m = 0; m < 4; ++m) {
                const size_t row = (size_t)u.pm * 256 + ai * 128 + wr * 64 + m * 16 + fr;
#pragma unroll
                for (int bj = 0; bj < 2; ++bj) {
                    const int col = u.pn * 256 + bj * 128 + 32 * wc + 8 * fq;
                    const u32x4 a = *(const u32x4*)(MRG + row * 6144 + 4096 + col);
                    f32x4 v0 = acc[ai][bj][m][0], v1 = acc[ai][bj][m][1];
                    v0[0] *= bf2f(a[0] & 0xffffu); v0[1] *= bf2f(a[0] >> 16); v0[2] *= bf2f(a[1] & 0xffffu); v0[3] *= bf2f(a[1] >> 16);
                    v1[0] *= bf2f(a[2] & 0xffffu); v1[1] *= bf2f(a[2] >> 16); v1[2] *= bf2f(a[3] & 0xffffu); v1[3] *= bf2f(a[3] >> 16);
                    store8(Y + row * 2048 + col, v0, v1);
                }
                __builtin_amdgcn_sched_barrier(0);
            }
    }
};

struct EpiOut {
    static constexpr bool MID = false;
    const float *xsrc, *csrc; float *xdst, *cdst; const float* mod;
    __device__ __forceinline__ void operator()(const f32x4 (&acc)[2][2][4][2], const Unit& u, int wr, int wc, int fr, int fq, int wid) const {
        const int pm = u.pm; const bool lat = pm < 64;
        const int mi = lat ? (pm >> 4) : 4;
        const float* src = lat ? xsrc : csrc - (size_t)MLAT * DM; float* dst = lat ? xdst : cdst - (size_t)MLAT * DM;
        const float* g = mod + mi * 6144 + 4096;
#pragma unroll
        for (int bj = 0; bj < 2; ++bj) {
            const int col = u.pn * 256 + bj * 128 + 32 * wc + 8 * fq;
            const f32x4 g0 = *(const f32x4*)(g + col), g1 = *(const f32x4*)(g + col + 4);
#pragma unroll
            for (int ai = 0; ai < 2; ++ai)
#pragma unroll
                for (int m = 0; m < 4; ++m) {
                    const size_t row = (size_t)pm * 256 + ai * 128 + wr * 64 + m * 16 + fr;
                    const f32x4 x0 = *(const f32x4*)(src + row * DM + col), x1 = *(const f32x4*)(src + row * DM + col + 4);
                    *(f32x4*)(dst + row * DM + col) = x0 + g0 * acc[ai][bj][m][0];
                    *(f32x4*)(dst + row * DM + col + 4) = x1 + g1 * acc[ai][bj][m][1];
                    __builtin_amdgcn_sched_barrier(0);
                }
        }
    }
};

namespace att {
#define SBAR() __builtin_amdgcn_sched_barrier(0)
__device__ __forceinline__ int crow(int r, int hi) { return (r & 3) + 8 * (r >> 2) + 4 * hi; }
template <int RB> __device__ __forceinline__ int kswz(int row, int colB) { const int x = (RB == 256) ? (row & 15) : ((row >> 1) & 7); return row * RB + (colB ^ (x << 4)); }
__device__ __forceinline__ int v_st(int k, int c) { const int kk = (k & ~0xC) | ((k & 4) << 1) | ((k & 8) >> 1); return ((kk >> 3) * 4 + (c >> 5)) * 512 + ((kk & 7) * 32 + (c & 31)) * 2; }
__device__ __forceinline__ int v_rd_base(int lane) { return ((lane & 3) << 3) | (((lane >> 2) & 3) << 6) | (((lane >> 4) & 1) << 5) | (((lane >> 5) & 1) << 8); }
constexpr int v_rd_off(int d0, int ks, int half) { return d0 * 512 + ks * 4096 + half * 2048; }
template <int OFF> __device__ __forceinline__ s16x4 tr_read(unsigned vb) {
    s16x4 r; asm volatile("ds_read_b64_tr_b16 %0, %1 offset:%2" : "=&v"(r) : "v"(vb), "i"(OFF) : "memory"); return r;
}
template <int D0> __device__ __forceinline__ void pv_one(f32x16& od, unsigned vb, bf16x8 pa0, bf16x8 pa1, bf16x8 pa2, bf16x8 pa3) {
    const s16x4 l0 = tr_read<v_rd_off(D0, 0, 0)>(vb), h0 = tr_read<v_rd_off(D0, 0, 1)>(vb), l1 = tr_read<v_rd_off(D0, 1, 0)>(vb), h1 = tr_read<v_rd_off(D0, 1, 1)>(vb);
    const s16x4 l2 = tr_read<v_rd_off(D0, 2, 0)>(vb), h2 = tr_read<v_rd_off(D0, 2, 1)>(vb), l3 = tr_read<v_rd_off(D0, 3, 0)>(vb), h3 = tr_read<v_rd_off(D0, 3, 1)>(vb);
    asm volatile("s_waitcnt lgkmcnt(0)" ::: "memory"); SBAR();
#define PK(L, H) (bf16x8){L[0], L[1], L[2], L[3], H[0], H[1], H[2], H[3]}
    od = __builtin_amdgcn_mfma_f32_32x32x16_bf16(pa0, PK(l0, h0), od, 0, 0, 0);
    od = __builtin_amdgcn_mfma_f32_32x32x16_bf16(pa1, PK(l1, h1), od, 0, 0, 0);
    od = __builtin_amdgcn_mfma_f32_32x32x16_bf16(pa2, PK(l2, h2), od, 0, 0, 0);
    od = __builtin_amdgcn_mfma_f32_32x32x16_bf16(pa3, PK(l3, h3), od, 0, 0, 0);
#undef PK
}
__device__ __forceinline__ void pv_d0(f32x16 (&o)[4], unsigned vb, bf16x8 pa0, bf16x8 pa1, bf16x8 pa2, bf16x8 pa3) {
    pv_one<0>(o[0], vb, pa0, pa1, pa2, pa3); pv_one<1>(o[1], vb, pa0, pa1, pa2, pa3); pv_one<2>(o[2], vb, pa0, pa1, pa2, pa3); pv_one<3>(o[3], vb, pa0, pa1, pa2, pa3);
}
__device__ __forceinline__ void partialSM(f32x16& p0, f32x16& p1) {
#pragma unroll
    for (int r = 0; r < 16; ++r) p0[r] = __builtin_amdgcn_exp2f(p0[r]);
}
__device__ __forceinline__ void finishSM(f32x16& p0, f32x16& p1, float& l_reg, bf16x8& pa0, bf16x8& pa1, bf16x8& pa2, bf16x8& pa3) {
#pragma unroll
    for (int r = 0; r < 16; ++r) p1[r] = __builtin_amdgcn_exp2f(p1[r]);
    float ps = 0;
#pragma unroll
    for (int r = 0; r < 16; ++r) ps += p0[r];
#pragma unroll
    for (int r = 0; r < 16; ++r) ps += p1[r];
    l_reg += ps;
#define PK8(P, BASE, OUT) do { u32x4 w = {cvt_pk_bf16(P[BASE + 0], P[BASE + 1]), cvt_pk_bf16(P[BASE + 2], P[BASE + 3]), cvt_pk_bf16(P[BASE + 4], P[BASE + 5]), cvt_pk_bf16(P[BASE + 6], P[BASE + 7])}; \
    OUT = *reinterpret_cast<bf16x8*>(&w); } while (0)
    PK8(p0, 0, pa0); PK8(p0, 8, pa1); PK8(p1, 0, pa2); PK8(p1, 8, pa3);
#undef PK8
}
template <int DQK>
__device__ __forceinline__ void qkt(f32x16& p0, f32x16& p1, const LAS char* Ks, const bf16x8 (&qr)[DQK / 16], const int (&ka)[8], float nMB) {
    constexpr int RB = DQK * 2, NA = (RB == 256) ? 8 : 4;
#pragma unroll
    for (int r = 0; r < 16; ++r) { p0[r] = nMB; p1[r] = nMB; }
#pragma unroll
    for (int d0 = 0; d0 < DQK / 16; ++d0) {
        const LAS char* a = Ks + ka[d0 % NA] + (d0 / NA) * (NA * 32);
        const bf16x8 b0 = *(const LAS bf16x8*)(a);
        const bf16x8 b1 = *(const LAS bf16x8*)(a + 32 * RB);
        p0 = __builtin_amdgcn_mfma_f32_32x32x16_bf16(b0, qr[d0], p0, 0, 0, 0);
        p1 = __builtin_amdgcn_mfma_f32_32x32x16_bf16(b1, qr[d0], p1, 0, 0, 0); }
}
constexpr int V_BYTES = 64 * 128 * 2, K_OFF = 3 * V_BYTES, K_STRIDE = 64 * 192 * 2, LI_OFF = K_OFF + 3 * K_STRIDE;

template <int DQK, bool DOUBLE>
__device__ __forceinline__ void attn_pass(const bf16_t* __restrict__ Q, int ldq, const bf16_t* __restrict__ Kg, int ldk, const bf16_t* __restrict__ Vg, int ldv,
                                          int rowc, int rowl, int NT, float nMB, f32x16 (&o)[4], float& l_reg, LAS char* lds, int tid) {
    constexpr int RB = DQK * 2, NCH = DQK / 8, NLD = NCH / 8;
    const int wid = __builtin_amdgcn_readfirstlane(tid >> 6), lane = tid & 63, r32 = lane & 31, hi = lane >> 5;
    LAS char* V_lds = lds; LAS char* K_lds = lds + K_OFF;
    bf16x8 qr[DQK / 16];
    { const bf16_t* Qw = Q + (size_t)(wid * 32 + r32) * ldq + hi * 8;
#pragma unroll
      for (int d0 = 0; d0 < DQK / 16; ++d0) qr[d0] = *(const bf16x8*)(Qw + d0 * 16); }
#pragma unroll
    for (int d = 0; d < 4; ++d) o[d] = f32x16{};
    l_reg = 0.f;
    int vrow[2], vcol[2], krow[NLD], kcol[NLD];
#pragma unroll
    for (int i = 0; i < 2; ++i) { const int q = tid + 512 * i, sub = q >> 5, within = q & 31, kk = (sub >> 2) * 8 + (within >> 2);
        vrow[i] = kk; vcol[i] = (sub & 3) * 32 + (within & 3) * 8; }
#pragma unroll
    for (int i = 0; i < NLD; ++i) { const int q = tid + 512 * i, row = q / NCH, chp = q % NCH; const int x = (RB == 256) ? (row & 15) : ((row >> 1) & 7);
        krow[i] = row; kcol[i] = (chp ^ x) * 8; }
    const unsigned vb0 = (unsigned)(uintptr_t)V_lds + v_rd_base(lane);
    int ka[8];
#pragma unroll
    for (int q = 0; q < 8; ++q) ka[q] = kswz<RB>(r32, q * 32 + hi * 16);
#define KROW0(j) ((j) < 4 ? rowc + 64 * (j) : rowl + 64 * ((j) - 4))
#define DMA(j, b) do { const size_t _r0 = (size_t)KROW0(j); \
    _Pragma("unroll") for (int _i = 0; _i < 2; ++_i) __builtin_amdgcn_global_load_lds((const unsigned*)(Vg + (_r0 + vrow[_i]) * ldv + vcol[_i]), (LAS unsigned*)(V_lds + (b) * V_BYTES + wid * 1024 + _i * 8192), 16, 0, 0); \
    _Pragma("unroll") for (int _i = 0; _i < NLD; ++_i) __builtin_amdgcn_global_load_lds((const unsigned*)(Kg + (_r0 + krow[_i]) * ldk + kcol[_i]), (LAS unsigned*)(K_lds + (b) * K_STRIDE + wid * 1024 + _i * 8192), 16, 0, 0); } while (0)
#define VMW0() asm volatile("s_waitcnt vmcnt(0)" ::: "memory")
    bf16x8 pa0, pa1, pa2, pa3;
    __syncthreads();
    DMA(0, 0); DMA(1, 1); VMW0(); __syncthreads();
    if constexpr (!DOUBLE) {
        f32x16 p0, p1;
        DMA(2, 2);
        int bc = 0, bn = 1, bf = 2;
        for (int j = 0; j < NT; ++j) {
            SBAR(); qkt<DQK>(p0, p1, K_lds + bc * K_STRIDE, qr, ka, nMB);
            partialSM(p0, p1); finishSM(p0, p1, l_reg, pa0, pa1, pa2, pa3); SBAR();
            pv_d0(o, vb0 + bc * V_BYTES, pa0, pa1, pa2, pa3);
            if (j + 1 < NT) { VMW0(); __syncthreads(); if (j + 3 < NT) DMA(j + 3, bc); }
            { const int _t = bc; bc = bn; bn = bf; bf = _t; }
        }
    } else {
    f32x16 pA0, pA1, pB0, pB1;
    qkt<DQK>(pA0, pA1, K_lds, qr, ka, nMB); partialSM(pA0, pA1);
    DMA(2, 2);
    int bp = 0, bc = 1, bn = 2;
#define STEP(j, PC0, PC1, PP0, PP1) do { \
        SBAR(); qkt<DQK>(PC0, PC1, K_lds + bc * K_STRIDE, qr, ka, nMB); \
        finishSM(PP0, PP1, l_reg, pa0, pa1, pa2, pa3); SBAR(); \
        pv_d0(o, vb0 + bp * V_BYTES, pa0, pa1, pa2, pa3); partialSM(PC0, PC1); \
        if ((j) + 1 < NT) { VMW0(); __syncthreads(); if ((j) + 2 < NT) DMA((j) + 2, bp); } \
        { const int _t = bp; bp = bc; bc = bn; bn = _t; } } while (0)
    for (int j = 1; j < NT; j += 2) {
        STEP(j, pB0, pB1, pA0, pA1);
        if (j + 1 < NT) STEP(j + 1, pA0, pA1, pB0, pB1);
    }
    finishSM(pB0, pB1, l_reg, pa0, pa1, pa2, pa3); SBAR();
    pv_d0(o, vb0 + bp * V_BYTES, pa0, pa1, pa2, pa3);
    }
#undef KROW0
#undef DMA
#undef VMW0
#undef STEP
}
__device__ __forceinline__ void row_recip(float l_reg, float (&rli)[16], LAS float* li, int r32, int hi) {
    { auto rr = __builtin_amdgcn_permlane32_swap(__float_as_uint(l_reg), __float_as_uint(l_reg), false, false);
      l_reg = __uint_as_float(rr[0]) + __uint_as_float(rr[1]); }
    if (hi == 0) li[r32] = l_reg;
    asm volatile("s_waitcnt lgkmcnt(0)" ::: "memory");
#pragma unroll
    for (int r = 0; r < 16; ++r) rli[r] = __builtin_amdgcn_rcpf(li[crow(r, hi)]);
    asm volatile("s_waitcnt lgkmcnt(0)" ::: "memory");
}
}

struct AttnBufs { const bf16_t *QA, *KA, *VA, *QB, *KB, *VB, *QC, *KC, *VC, *GATE; bf16_t* BR; float* SCR; const float* lamv; const float* subln; float lam_init; };

template <bool SUBLN>
__device__ __forceinline__ void attn_out(const AttnBufs& T, f32x16 (&o)[4], int type, int h, size_t orow0, LAS char* lds, int wid, int lane, int r32, int hi) {
    __syncthreads();
    LAS float* stg = (LAS float*)(lds + wid * 16896);
#pragma unroll
    for (int d0 = 0; d0 < 4; ++d0)
#pragma unroll
        for (int r = 0; r < 16; ++r) stg[att::crow(r, hi) * 132 + d0 * 32 + r32] = o[d0][r];
    asm volatile("s_waitcnt lgkmcnt(0)" ::: "memory");
    const int rr = lane >> 5, c4 = (lane & 31) * 4;
    const int col = type * 1024 + h * 128 + c4;
    f32x4 wsub = {1.f, 1.f, 1.f, 1.f};
    if (SUBLN) { wsub = *(const f32x4*)(T.subln + c4) * (1.f - T.lam_init); }
    const bf16_t* gp = T.GATE + (orow0 + rr) * 3072 + col; bf16_t* op = T.BR + (orow0 + rr) * 3072 + col;
#pragma unroll 4
    for (int i = 0; i < 16; ++i) {
        f32x4 v = *(const LAS f32x4*)(stg + (2 * i + rr) * 132 + c4);
        const u32x2 gg = *(const u32x2*)(gp + (size_t)i * 2 * 3072);
        if (SUBLN) {
            float s = (v[0] * v[0] + v[1] * v[1]) + (v[2] * v[2] + v[3] * v[3]);
            s += __shfl_xor(s, 1); s += __shfl_xor(s, 2); s += __shfl_xor(s, 4); s += __shfl_xor(s, 8); s += __shfl_xor(s, 16);
            v = v * (rsqrtf(s * (1.f / 128.f) + EPS)) * wsub;
        }
        u32x2 w; w.x = cvt_pk_bf16(v[0] * bf2f(gg.x & 0xffffu), v[1] * bf2f(gg.x >> 16)); w.y = cvt_pk_bf16(v[2] * bf2f(gg.y & 0xffffu), v[3] * bf2f(gg.y >> 16));
        *(u32x2*)(op + (size_t)i * 2 * 3072) = w;
    }
}

__device__ __forceinline__ void attn_item(const AttnBufs& T, int type, int b, int h, int qrow0, int NT, LAS char* lds, int tid_) {
    asm volatile("" : "+v"(tid_));
    const int tid = tid_, wid = __builtin_amdgcn_readfirstlane(tid >> 6), lane = tid & 63, r32 = lane & 31, hi = lane >> 5;
    const int rowc = MLAT + b * CTXL, rowl = b * SEQ;
    LAS float* li = (LAS float*)(lds + att::LI_OFF) + wid * 64;
    constexpr float LOG2E = 1.4426950408889634f;
    const size_t orow0 = (size_t)qrow0 + wid * 32;
    if (type == 0 && (MK_ATYPE & 1)) {
        f32x16 o[4]; float l_reg; float rli[16];
        att::attn_pass<128, ATT_DBL>(T.QA + (size_t)qrow0 * 1024 + h * 128, 1024, T.KA + (h >> 2) * 128, 256, T.VA + (h >> 2) * 128, 256, rowc, rowl, NT,
                            T.lamv[1], o, l_reg, lds, tid);
        att::row_recip(l_reg, rli, li, r32, hi);
#pragma unroll
        for (int d0 = 0; d0 < 4; ++d0)
#pragma unroll
            for (int r = 0; r < 16; ++r) o[d0][r] *= rli[r];
        attn_out<false>(T, o, 0, h, orow0, lds, wid, lane, r32, hi);
    } else if (type == 1 && (MK_ATYPE & 2)) {
        f32x16 o[4]; float l_reg; float rli[16];
        att::attn_pass<192, false>(T.QB + (size_t)qrow0 * 1536 + h * 192, 1536, T.KB + h * 192, 1536, T.VB + h * 128, 1024, rowc, rowl, NT,
                            T.lamv[2], o, l_reg, lds, tid);
        att::row_recip(l_reg, rli, li, r32, hi);
#pragma unroll
        for (int d0 = 0; d0 < 4; ++d0)
#pragma unroll
            for (int r = 0; r < 16; ++r) o[d0][r] *= rli[r];
        attn_out<false>(T, o, 1, h, orow0, lds, wid, lane, r32, hi);
    } else if (MK_ATYPE & 4) {
        f32x16 o[4]; float l_reg; float rli[16];
        att::attn_pass<64, ATT_DBL>(T.QC + (size_t)qrow0 * 1024 + h * 128, 1024, T.KC + h * 128, 1024, T.VC + h * 128, 1024, rowc, rowl, NT,
                           T.lamv[3], o, l_reg, lds, tid);
        att::row_recip(l_reg, rli, li, r32, hi);
        f32x4* scr = (f32x4*)(T.SCR + ((size_t)blockIdx.x * 512 + tid) * 64);
#pragma unroll
        for (int d0 = 0; d0 < 4; ++d0)
#pragma unroll
            for (int q = 0; q < 4; ++q) scr[d0 * 4 + q] = (f32x4){o[d0][q * 4] * rli[q * 4], o[d0][q * 4 + 1] * rli[q * 4 + 1], o[d0][q * 4 + 2] * rli[q * 4 + 2], o[d0][q * 4 + 3] * rli[q * 4 + 3]};
        att::attn_pass<64, ATT_DBL>(T.QC + (size_t)qrow0 * 1024 + h * 128 + 64, 1024, T.KC + h * 128 + 64, 1024, T.VC + h * 128, 1024, rowc, rowl, NT,
                           T.lamv[3], o, l_reg, lds, tid);
        att::row_recip(l_reg, rli, li, r32, hi);
        const float lam = T.lamv[0];
#pragma unroll
        for (int d0 = 0; d0 < 4; ++d0)
#pragma unroll
            for (int q = 0; q < 4; ++q) { const f32x4 a = scr[d0 * 4 + q];
#pragma unroll
                for (int j = 0; j < 4; ++j) o[d0][q * 4 + j] = a[j] - lam * (o[d0][q * 4 + j] * rli[q * 4 + j]); }
        attn_out<true>(T, o, 2, h, orow0, lds, wid, lane, r32, hi);
    }
}

__device__ __forceinline__ void transpose_item(const float* __restrict__ W, int ldw, int k0, int srccol4, const float* __restrict__ kscale,
                                               bf16_t* __restrict__ WT, int ldt, int n0, int kdst0, LAS float* scr, int lane) {
    const int ks = lane >> 4, n4 = (lane & 15) * 4;
#pragma unroll 8
    for (int i = 0; i < 16; ++i) { const int kk = 4 * i + ks;
        f32x4 v = srccol4 >= 0 ? *(const f32x4*)(W + (size_t)(k0 + kk) * ldw + srccol4) : (f32x4){0.f, 0.f, 0.f, 0.f};
        if (kscale) v = v * kscale[k0 + kk];
        LAS float* d = scr + kk * 65 + n4; d[0] = v[0]; d[1] = v[1]; d[2] = v[2]; d[3] = v[3]; }
    asm volatile("s_waitcnt lgkmcnt(0)" ::: "memory");
    const int nn = lane & 7, c = lane >> 3;
#pragma unroll
    for (int j = 0; j < 8; ++j) { const int n = nn + 8 * j; const LAS float* s = scr + (8 * c) * 65 + n;
        u32x4 o; o.x = cvt_pk_bf16(s[0 * 65], s[1 * 65]); o.y = cvt_pk_bf16(s[2 * 65], s[3 * 65]); o.z = cvt_pk_bf16(s[4 * 65], s[5 * 65]); o.w = cvt_pk_bf16(s[6 * 65], s[7 * 65]);
        *(u32x4*)(WT + (size_t)(n0 + n) * ldt + kdst0 + k0 + 8 * c) = o; }
    asm volatile("s_waitcnt lgkmcnt(0)" ::: "memory");
}
__device__ const float INVF32[16] = {1.000000000e+00f, 5.623413324e-01f, 3.162277639e-01f, 1.778279394e-01f, 1.000000015e-01f, 5.623413250e-02f, 3.162277490e-02f, 1.778279431e-02f,
    9.999999776e-03f, 5.623413250e-03f, 3.162277630e-03f, 1.778279431e-03f, 1.000000047e-03f, 5.623413017e-04f, 3.162277571e-04f, 1.778279402e-04f};
__device__ const float INVF64[32] = {1.000000000e+00f, 7.498942614e-01f, 5.623413324e-01f, 4.216965139e-01f, 3.162277639e-01f, 2.371373773e-01f, 1.778279394e-01f, 1.333521307e-01f,
    1.000000015e-01f, 7.498941571e-02f, 5.623413250e-02f, 4.216965288e-02f, 3.162277490e-02f, 2.371373773e-02f, 1.778279431e-02f, 1.333521493e-02f, 9.999999776e-03f, 7.498941850e-03f,
    5.623413250e-03f, 4.216964822e-03f, 3.162277630e-03f, 2.371373586e-03f, 1.778279431e-03f, 1.333521446e-03f, 1.000000047e-03f, 7.498942432e-04f, 5.623413017e-04f, 4.216965172e-04f,
    3.162277571e-04f, 2.371373703e-04f, 1.778279402e-04f, 1.333521504e-04f};
__device__ __forceinline__ void sincos_d(double x, float& s, float& c) {
    const double twopi = 6.283185307179586476925;
    const double k = __builtin_rint(x / twopi), r = x - k * twopi, r2 = r * r;
    double st = r, ct = 1.0, ss = r, cs = 1.0;
    for (int n = 1; n <= 16; ++n) { ct *= -r2 / (double)((2 * n - 1) * (2 * n)); st *= -r2 / (double)((2 * n) * (2 * n + 1)); cs += ct; ss += st; }
    s = (float)ss; c = (float)cs;
}
__device__ __forceinline__ float absmax_n(const float* w, int n) { float m = 0.f; for (int i = 0; i < n; ++i) m = fmaxf(m, fabsf(w[i])); return m; }

typedef unsigned v4u_unused_t;
#define XB_TMO      128
#define XB_XCNT(j)  (256  + 64 * (j))
#define XB_XSUB(j)  (1280 + 64 * (j))
#define XB_XGEN(j)  (2304 + 64 * (j))
#define XB_TOP      3328
#define XB_TOPGEN   3392
#define XCD_BAR_WORDS 3456
#define XB_SPIN_CAP (1u << 18)

__device__ __forceinline__ unsigned xb_ld(unsigned* p)              { return __hip_atomic_load(p, __ATOMIC_RELAXED, __HIP_MEMORY_SCOPE_AGENT); }
__device__ __forceinline__ unsigned xb_add(unsigned* p, unsigned v) { return __hip_atomic_fetch_add(p, v, __ATOMIC_RELAXED, __HIP_MEMORY_SCOPE_AGENT); }
__device__ __forceinline__ unsigned xb_xcc_id() { return (unsigned)__builtin_amdgcn_s_getreg((3 << 11) | 20) & 0xFu; }
#define XB_SPIN(cond, bar) do { unsigned _sp = 0; while (cond) { __builtin_amdgcn_s_sleep(1); \
    if ((++_sp & 255u) == 0u) { if (xb_ld(&(bar)[XB_TMO])) break; if (_sp > XB_SPIN_CAP) { atomicAdd(&(bar)[XB_TMO], 1u); break; } } } } while (0)

struct XcdBarrier {
    unsigned* bar; unsigned x;
    volatile LAS unsigned* st;
};

__device__ __forceinline__ XcdBarrier xcd_barrier_post(unsigned* bar, volatile LAS unsigned* st) {
    XcdBarrier b; b.bar = bar; b.x = xb_xcc_id(); b.st = st;
    if (threadIdx.x == 0) (void)xb_add(&bar[XB_XCNT(b.x)], 1u);
    return b;
}
__device__ __forceinline__ void xcd_barrier_complete(unsigned* bar, unsigned x, unsigned& nloc, unsigned& nx) {
    const unsigned G = gridDim.x * gridDim.y * gridDim.z;
    unsigned sum, cnt, mine, sp = 0u;
    for (;;) {
        sum = 0u; cnt = 0u; mine = 0u;
#pragma unroll
        for (unsigned j = 0; j < 16; ++j) { const unsigned c = xb_ld(&bar[XB_XCNT(j)]); sum += c; cnt += (c > 0u) ? 1u : 0u; mine = (j == x) ? c : mine; }
        if (sum == G) break;
        __builtin_amdgcn_s_sleep(1);
        if ((++sp & 255u) == 0u) { if (xb_ld(&bar[XB_TMO])) break; if (sp > XB_SPIN_CAP) { atomicAdd(&bar[XB_TMO], 1u); break; } }
    }
    nloc = mine > 0u ? mine : 1u; nx = cnt > 0u ? cnt : 1u;
}

__device__ __forceinline__ void xcd_barrier(const XcdBarrier& b) {
    asm volatile("s_waitcnt vmcnt(0)" ::: "memory");
    __syncthreads();
    if (threadIdx.x == 0) {
        unsigned* bar = b.bar;
        __builtin_amdgcn_s_waitcnt(0);
        unsigned nloc = b.st[0], nx = b.st[1];
        if (nloc == 0u) { xcd_barrier_complete(bar, b.x, nloc, nx); b.st[0] = nloc; b.st[1] = nx; }
        const unsigned old = xb_add(&bar[XB_XSUB(b.x)], 1u);
        const unsigned gen = old / nloc;
        if (old + 1u == (gen + 1u) * nloc) {
            __builtin_amdgcn_fence(__ATOMIC_RELEASE, "agent");
            asm volatile("s_waitcnt vmcnt(0)" ::: "memory");
            const unsigned og = xb_add(&bar[XB_TOP], 1u);
            const unsigned tg = og / nx;
            if (og + 1u == (tg + 1u) * nx) xb_add(&bar[XB_TOPGEN], 1u);
            else XB_SPIN(xb_ld(&bar[XB_TOPGEN]) == tg, bar);
            __builtin_amdgcn_fence(__ATOMIC_ACQUIRE, "agent");
            xb_add(&bar[XB_XGEN(b.x)], 1u);
            asm volatile("s_waitcnt vmcnt(0)" ::: "memory");
        } else {
            XB_SPIN(xb_ld(&bar[XB_XGEN(b.x)]) == gen, bar);
            __builtin_amdgcn_fence(__ATOMIC_ACQUIRE, "agent");
            asm volatile("s_waitcnt vmcnt(0)" ::: "memory");
        }
    }
    __syncthreads();
}

__device__ __forceinline__ void p1_row(int row, const float* __restrict__ xsrc, const float* __restrict__ csrc, const float* __restrict__ modl, const float* __restrict__ nw,
                                       bf16_t* __restrict__ H, int lane) {
    const bool lat = row < MLAT; const int mi = lat ? (row >> 12) : 4;
    const f32x4* xr = (const f32x4*)(lat ? xsrc + (size_t)row * DM : csrc + (size_t)(row - MLAT) * DM) + lane;
    f32x4 v[8]; float s = 0.f;
#pragma unroll
    for (int j = 0; j < 8; ++j) { v[j] = xr[64 * j]; s += (v[j][0] * v[j][0] + v[j][1] * v[j][1]) + (v[j][2] * v[j][2] + v[j][3] * v[j][3]); }
    const float rinv = rsqrtf(wave_sum(s) * (1.f / DM) + EPS);
    const f32x4* sh = (const f32x4*)(modl + mi * 6144) + lane; const f32x4* scl = (const f32x4*)(modl + mi * 6144 + DM) + lane; const f32x4* nwp = (const f32x4*)nw + lane;
    u32x2* o8 = (u32x2*)(H + (size_t)row * DM) + lane;
#pragma unroll
    for (int j = 0; j < 8; ++j) { const f32x4 y = v[j] * rinv * nwp[64 * j] * (scl[64 * j] + 1.f) + sh[64 * j];
        u32x2 w; w.x = cvt_pk_bf16(y[0], y[1]); w.y = cvt_pk_bf16(y[2], y[3]); o8[64 * j] = w; }
}

__device__ __forceinline__ void p1_row2(int rowA, int rowB, const float* __restrict__ xsrc, const float* __restrict__ csrc, const float* __restrict__ modl,
                                        const float* __restrict__ nw, bf16_t* __restrict__ H, int lane) {
    if (rowB < 0) { p1_row(rowA, xsrc, csrc, modl, nw, H, lane); return; }
    const bool latA = rowA < MLAT, latB = rowB < MLAT; const int miA = latA ? (rowA >> 12) : 4, miB = latB ? (rowB >> 12) : 4;
    const f32x4* xa = (const f32x4*)(latA ? xsrc + (size_t)rowA * DM : csrc + (size_t)(rowA - MLAT) * DM) + lane;
    const f32x4* xb = (const f32x4*)(latB ? xsrc + (size_t)rowB * DM : csrc + (size_t)(rowB - MLAT) * DM) + lane;
    f32x4 va[8], vb[8]; float sa = 0.f, sb = 0.f;
#pragma unroll
    for (int j = 0; j < 8; ++j) { va[j] = xa[64 * j]; vb[j] = xb[64 * j]; }
#pragma unroll
    for (int j = 0; j < 8; ++j) { sa += (va[j][0] * va[j][0] + va[j][1] * va[j][1]) + (va[j][2] * va[j][2] + va[j][3] * va[j][3]);
                                  sb += (vb[j][0] * vb[j][0] + vb[j][1] * vb[j][1]) + (vb[j][2] * vb[j][2] + vb[j][3] * vb[j][3]); }
    const float ra = rsqrtf(wave_sum(sa) * (1.f / DM) + EPS), rb = rsqrtf(wave_sum(sb) * (1.f / DM) + EPS);
    const f32x4* nwp = (const f32x4*)nw + lane;
    const f32x4* sha = (const f32x4*)(modl + miA * 6144) + lane; const f32x4* sca = (const f32x4*)(modl + miA * 6144 + DM) + lane;
    const f32x4* shb = (const f32x4*)(modl + miB * 6144) + lane; const f32x4* scb = (const f32x4*)(modl + miB * 6144 + DM) + lane;
    u32x2* oa = (u32x2*)(H + (size_t)rowA * DM) + lane; u32x2* ob = (u32x2*)(H + (size_t)rowB * DM) + lane;
#pragma unroll
    for (int j = 0; j < 8; ++j) { const f32x4 w4 = nwp[64 * j];
        const f32x4 ya = va[j] * ra * w4 * (sca[64 * j] + 1.f) + sha[64 * j], yb = vb[j] * rb * w4 * (scb[64 * j] + 1.f) + shb[64 * j];
        u32x2 wa, wb; wa.x = cvt_pk_bf16(ya[0], ya[1]); wa.y = cvt_pk_bf16(ya[2], ya[3]); wb.x = cvt_pk_bf16(yb[0], yb[1]); wb.y = cvt_pk_bf16(yb[2], yb[3]);
        oa[64 * j] = wa; ob[64 * j] = wb; }
}

struct Args { const float* in[29]; float* out; unsigned char* ws; int ph_lo, ph_hi, coop, pad; };

__global__ void __launch_bounds__(512, 2) mega_fwd(Args args) {
    extern __shared__ __attribute__((aligned(16))) unsigned char lds_raw[];
    LAS unsigned char* lds = (LAS unsigned char*)lds_raw;
    const int G = gridDim.x;
    unsigned char* ws = args.ws;
    float* MOD = (float*)(ws + WS_MOD);
    float* TC64 = (float*)(ws + WS_TC64); float* TS64 = (float*)(ws + WS_TS64); float* TC128 = (float*)(ws + WS_TC128); float* TS128 = (float*)(ws + WS_TS128);
    float* LAM = (float*)(ws + WS_LAM);
    bf16_t* WIN = (bf16_t*)(ws + WS_WIN); bf16_t* WUP = (bf16_t*)(ws + WS_WUP); bf16_t* WBR = (bf16_t*)(ws + WS_WBR); bf16_t* WOUT = (bf16_t*)(ws + WS_WOUT);
    bf16_t* H = (bf16_t*)(ws + WS_H); bf16_t* QA = (bf16_t*)(ws + WS_QA); bf16_t* KA = (bf16_t*)(ws + WS_KA); bf16_t* VA = (bf16_t*)(ws + WS_VA);
    bf16_t* QB = (bf16_t*)(ws + WS_QB); bf16_t* KB = (bf16_t*)(ws + WS_KB); bf16_t* CKV = (bf16_t*)(ws + WS_CKV); bf16_t* VB = (bf16_t*)(ws + WS_VB);
    bf16_t* QC = (bf16_t*)(ws + WS_QC); bf16_t* KC = (bf16_t*)(ws + WS_KC); bf16_t* VC = (bf16_t*)(ws + WS_VC);
    bf16_t* GATE = (bf16_t*)(ws + WS_GATE); bf16_t* MRG = (bf16_t*)(ws + WS_MRG); bf16_t* BR = (bf16_t*)(ws + WS_BR); bf16_t* Y = (bf16_t*)(ws + WS_Y);
    float* SS = (float*)(ws + WS_SS); float* CTXW = (float*)(ws + WS_CTXW); float* SCR = (float*)(ws + WS_SCR);
    LAS float* xch = (LAS float*)(lds + XCH_OFF);
    volatile LAS unsigned* bst = (volatile LAS unsigned*)(lds + XCH_OFF + 4096);
    if (threadIdx.x < 2) bst[threadIdx.x] = 0u;
    __syncthreads();
    XcdBarrier bar = xcd_barrier_post((unsigned*)(ws + WS_BAR), bst);

    for (int ph = args.ph_lo; ph < args.ph_hi; ++ph) {
        int bx = blockIdx.x; asm volatile("" : "+s"(bx));
        const int vcu = (G % 8 == 0) ? (bx % 8) * (G / 8) + bx / 8 : bx;
        int tid = threadIdx.x; asm volatile("" : "+v"(tid));
        const int lane = tid & 63, wave = __builtin_amdgcn_readfirstlane(tid >> 6);
        if (ph == 0 && (MK_MASK & 1)) {
            {
                LAS float* sc = (LAS float*)lds;
                LAS float* red = (LAS float*)(lds + 65536);
                for (int i = tid; i < 5 * DM; i += 512) { const float v = i < 4 * DM ? args.in[1][i] : args.in[3][i - 4 * DM]; sc[i] = silu_f(v); }
                __syncthreads();
                for (int it = bx; it < DEPTH * 96; it += G) {
                    const int l = it / 96, n0 = (it % 96) * 64;
                    const float* W = args.in[5] + (size_t)l * DM * 6144 + n0 + lane;
                    float a0 = 0.f, a1 = 0.f, a2 = 0.f, a3 = 0.f, a4 = 0.f;
                    const int kb = wave * 256;
#pragma unroll 8
                    for (int k = 0; k < 256; ++k) { const float wv = W[(size_t)(kb + k) * 6144];
                        a0 += sc[kb + k] * wv; a1 += sc[DM + kb + k] * wv; a2 += sc[2 * DM + kb + k] * wv; a3 += sc[3 * DM + kb + k] * wv; a4 += sc[4 * DM + kb + k] * wv; }
                    red[(wave * 5 + 0) * 64 + lane] = a0; red[(wave * 5 + 1) * 64 + lane] = a1; red[(wave * 5 + 2) * 64 + lane] = a2; red[(wave * 5 + 3) * 64 + lane] = a3; red[(wave * 5 + 4) * 64 + lane] = a4;
                    __syncthreads();
                    if (tid < 320) { const int i = tid >> 6; float s = 0.f;
                        for (int w8 = 0; w8 < 8; ++w8) s += red[(w8 * 5 + i) * 64 + lane];
                        MOD[((size_t)l * 5 + i) * 6144 + n0 + lane] = s + args.in[6][(size_t)l * 6144 + n0 + lane]; }
                    __syncthreads();
                }
            }
            if (bx == 1 % G) {
                for (int i = tid; i < 64 * 16; i += 512) { const int pos = i >> 4, f = i & 15; const float ang = (float)pos * INVF32[f]; float s, c; sincos_d((double)ang, s, c); TC64[i] = c; TS64[i] = s; }
                for (int i = tid; i < 64 * 32; i += 512) { const int pos = i >> 5, f = i & 31; const float ang = (float)pos * INVF64[f]; float s, c; sincos_d((double)ang, s, c); TC128[i] = c; TS128[i] = s; }
            }
            if (bx == 2 % G && tid < DEPTH) {
                const int l = tid;
                float s1 = 0.f, s2 = 0.f;
                for (int i = 0; i < 64; ++i) { s1 += args.in[20][l * 64 + i] * args.in[21][l * 64 + i]; s2 += args.in[22][l * 64 + i] * args.in[23][l * 64 + i]; }
                const float lam_init = 0.8f - 0.6f * expf(-0.3f * (float)l);
                LAM[l * 4 + 0] = expf(s1) - expf(s2) + lam_init;
                const float mAq = absmax_n(args.in[9] + l * 128, 128), mAk = absmax_n(args.in[10] + l * 128, 128);
                const float mBqn = absmax_n(args.in[11] + l * 128, 128), mBqr = absmax_n(args.in[12] + l * 64, 64), mBkn = absmax_n(args.in[16] + l * 128, 128), mBkr = absmax_n(args.in[17] + l * 64, 64);
                const float mCq = absmax_n(args.in[18] + l * 64, 64), mCk = absmax_n(args.in[19] + l * 64, 64);
                const float L2E = 1.4426950408889634f;
                LAM[l * 4 + 1] = -(sqrtf(128.f) * mAq * mAk) * L2E;
                LAM[l * 4 + 2] = -(sqrtf(128.f * mBqn * mBqn + 64.f * mBqr * mBqr) * sqrtf(128.f * mBkn * mBkn + 64.f * mBkr * mBkr) * 0.07216878364870323f) * L2E;
                LAM[l * 4 + 3] = -(8.f * mCq * mCk) * L2E;
            }
            __syncthreads();
            {
                LAS float* scr = (LAS float*)(lds + wave * 16640);
                const int gw = vcu * 8 + wave, NGW = G * 8;
                constexpr int I_IN = 32 * (NIN / 64), I_UP = 8 * 32, I_BR = 3 * 16 * 32, I_OUT = 32 * 32, I_L = I_IN + I_UP + I_BR + I_OUT;
                const int n4 = (lane & 15) * 4;
                for (int it = gw; it < DEPTH * I_L; it += NGW) {
                    const int l = it / I_L; int r = it % I_L;
                    if (r < I_IN) { const int nb = r % (NIN / 64), kb = r / (NIN / 64); const int n0 = nb * 64;
                        transpose_item(args.in[7] + (size_t)l * DM * INC, INC, kb * 64, in_src_col(n0 + n4), nullptr, WIN + (size_t)l * NIN * DM, DM, n0, 0, scr, lane); continue; }
                    r -= I_IN;
                    if (r < I_UP) { const int nb = r % 32, kb = r / 32; const int n0 = nb * 64; const int sc_ = up_src_col(n0 + n4);
                        const float* W = (sc_ < 1024 ? args.in[14] : args.in[15]) + (size_t)l * 512 * 1024;
                        transpose_item(W, 1024, kb * 64, sc_ & 1023, args.in[13] + l * 512, WUP + (size_t)l * 2048 * 512, 512, n0, 0, scr, lane); continue; }
                    r -= I_UP;
                    if (r < I_BR) { const int br = r / (16 * 32), r2 = r % (16 * 32); const int nb = r2 % 32, kb = r2 / 32; const int n0 = nb * 64;
                        transpose_item(args.in[25 + br] + (size_t)l * 1024 * DM, DM, kb * 64, n0 + n4, nullptr, WBR + (size_t)l * 2048 * 3072, 3072, n0, br * 1024, scr, lane); continue; }
                    r -= I_BR;
                    { const int nb = r % 32, kb = r / 32; const int n0 = nb * 64;
                      transpose_item(args.in[28] + (size_t)l * DM * DM, DM, kb * 64, n0 + n4, nullptr, WOUT + (size_t)l * DM * DM, DM, n0, 0, scr, lane); }
                }
            }
        } else {
            const int l = (ph == 1) ? 0 : (ph - 2) / 3, st_ = (ph == 1) ? 0 : 1 + (ph - 2) % 3, st = (st_ >= 2) ? st_ + 1 : st_;
            const float* xsrc = (l == 0) ? args.in[0] : args.out;
            const float* csrc = (l == 0) ? args.in[2] : CTXW;
            const float* modl = MOD + (size_t)l * 5 * 6144;
            const int Mrows = (l == DEPTH - 1) ? MLAT : MTOT;
            if (st == 0 && (MK_MASK & 2)) {
                const float* nw = args.in[4] + (size_t)l * DM;
                for (int row = bx * 8 + wave; row < MTOT; row += G * 16) { const int rb = row + G * 8; p1_row2(row, rb < MTOT ? rb : -1, xsrc, csrc, modl, nw, H, lane); }
            } else if (st == 1 && (MK_MASK & 4)) {
                pg8::Gemm g{H, WIN + (size_t)l * NIN * DM, MTOT, NIN, DM};
                EpiIn E{QA, KA, VA, QB, KB, CKV, QC, KC, VC, GATE, MRG, SS,
                        args.in[9] + l * 128, args.in[10] + l * 128, args.in[11] + l * 128, args.in[12] + l * 64, args.in[17] + l * 64, args.in[18] + l * 64, args.in[19] + l * 64,
                        args.in[8] + (size_t)l * 6144, TC64, TS64, TC128, TS128, xch};
                const bool trim = (l == DEPTH - 1) && (G == 256);
                for (int part = 0; part < 2; ++part) {
                    pg8::StaticOrder S;
                    if (!trim) { if (part) break; S.init(MTOT, NIN, G, bx); }
                    else if (part == 0) S.init(MLAT, NIN, G, bx);
                    else { if (!(bx >= 192 && bx < 244)) break; const int k = bx - 192, j = k % 13;
                           const int pn = (j < 2) ? 4 + j : (j < 5 ? 10 + j : 14 + j);
                           S.init_one(64 + k / 13, pn); }
                    { int t2 = threadIdx.x; asm volatile("" : "+v"(t2)); pg8::gemm_phase<EpiIn>(lds, g, S, E, t2); }
                }
            } else if (st == 3 && (MK_MASK & 16)) {
                unsigned* UPC = (unsigned*)(ws + WS_CNT) + (size_t)(2 * DEPTH * 68 + l) * 64;
                const bool merged = (G == 256) && args.coop;
                {
                    pg8::Gemm g{CKV, WUP + (size_t)l * 2048 * 512, MTOT, 2048, 512}; pg8::StaticOrder S; S.init(MTOT, 2048, G, bx);
                    EpiUp E{KB, VB, SS, args.in[16] + l * 128, xch};
                    pg8::gemm_phase<EpiUp>(lds, g, S, E, tid);
                    if (merged) {
                        if (threadIdx.x == 0) {
                            __builtin_amdgcn_fence(__ATOMIC_RELEASE, "agent");
                            asm volatile("s_waitcnt vmcnt(0)" ::: "memory");
                            const unsigned n = (bx < 544) ? (unsigned)((544 - 1 - bx) / G + 1) : 0u;
                            __hip_atomic_fetch_add(UPC, n, __ATOMIC_RELAXED, __HIP_MEMORY_SCOPE_AGENT);
                        }
                    } else if (args.coop) xcd_barrier(bar);
                }
                AttnBufs T{QA, KA, VA, QB, KB, VB, QC, KC, VC, GATE, BR, SCR, LAM + l * 4, args.in[24] + l * 128, 0.8f - 0.6f * expf(-0.3f * (float)l)};
                const int nctx = (l < DEPTH - 1) ? 96 : 0;
                for (int k = 0;; ++k) {
                    int type, b, h, qrow0, NT;
                    if (G == 256) {
                        if (k == 4 && merged) {
                            if (threadIdx.x == 0) { unsigned sp = 0;
                                while (__hip_atomic_load(UPC, __ATOMIC_RELAXED, __HIP_MEMORY_SCOPE_AGENT) < 544u) { __builtin_amdgcn_s_sleep(1); if (++sp > (1u << 22)) break; }
                                __builtin_amdgcn_fence(__ATOMIC_ACQUIRE, "agent");
                                asm volatile("s_waitcnt vmcnt(0)" ::: "memory"); }
                            __syncthreads();
                        }
                        if (k < 6) { const int id = (k & 1) * 256 + vcu; type = (k < 2) ? 0 : (k < 4 ? 2 : 1); b = id >> 7; h = (id >> 4) & 7; qrow0 = b * SEQ + (id & 15) * 256; NT = 68; }
                        else if (k == 6 && bx >= 256 - nctx) { const int c = bx - (256 - nctx); type = c >> 5; b = (c >> 3) & 3; h = c & 7; qrow0 = MLAT + b * CTXL; NT = 4; }
                        else break;
                    } else {
                        const int it = bx + k * G; if (it >= 1536 + nctx) break;
                        if (it < 1536) { const int id = it & 511; type = it >> 9; b = id >> 7; h = (id >> 4) & 7; qrow0 = b * SEQ + (id & 15) * 256; NT = 68; }
                        else { const int c = it - 1536; type = c >> 5; b = (c >> 3) & 3; h = c & 7; qrow0 = MLAT + b * CTXL; NT = 4; }
                    }
                    attn_item(T, type, b, h, qrow0, NT, (LAS char*)lds, tid);
                }
                __syncthreads();
            } else {
                unsigned* CNT = (unsigned*)(ws + WS_CNT) + (size_t)l * 68 * 64;
                const bool merged = (G == 256) && args.coop;
                const bool ctxl = l < DEPTH - 1;
                pg8::Gemm g3{BR, WBR + (size_t)l * 2048 * 3072, Mrows, 2048, 3072}; EpiBr E3{MRG, Y};
                pg8::Gemm g4{Y, WOUT + (size_t)l * DM * DM, Mrows, DM, DM}; EpiOut E4{xsrc, csrc, args.out, CTXW, modl};
                for (int part = 0; part < 2; ++part) {
                    pg8::StaticOrder S;
                    if (!merged) { if (part) break; S.init(Mrows, 2048, G, bx); }
                    else if (part == 0) S.init(MLAT, 2048, G, bx);
                    else { if (!(ctxl && bx < 32)) break; S.init_one(64 + (bx >> 3), bx & 7); }
                    { int t2 = threadIdx.x; asm volatile("" : "+v"(t2)); pg8::gemm_phase<EpiBr>(lds, g3, S, E3, t2); }
                    if (merged && threadIdx.x == 0) {
                        __builtin_amdgcn_fence(__ATOMIC_RELEASE, "agent");
                        asm volatile("s_waitcnt vmcnt(0)" ::: "memory");
                        pg8::Unit u; for (int i = 0; S.next(i, u); ++i) __hip_atomic_fetch_add(&CNT[u.pm * 64], 1u, __ATOMIC_RELAXED, __HIP_MEMORY_SCOPE_AGENT);
                    }
                }
                if (!merged && args.coop) xcd_barrier(bar);
                for (int part = 0; part < 3; ++part) {
                    pg8::StaticOrder S;
                    if (!merged) { if (part) break; S.init(Mrows, DM, G, bx); }
                    else if (part == 0) S.init(MLAT, DM, G, bx, 0, (ctxl && bx < 32) ? 1 : 2);
                    else if (part == 1) { if (!(ctxl && bx >= 32 && bx < 64)) continue; S.init_one(64 + ((bx - 32) >> 3), bx & 7); }
                    else { if (!(ctxl && bx >= 64 && bx < 96)) break; S.init(MLAT, DM, G, bx - 64, 1, 1); }
                    if (merged) {
                        if (threadIdx.x == 0) {
                            pg8::Unit u;
                            for (int i = 0; S.next(i, u); ++i) { unsigned sp = 0;
                                while (__hip_atomic_load(&CNT[u.pm * 64], __ATOMIC_RELAXED, __HIP_MEMORY_SCOPE_AGENT) < 8u) { __builtin_amdgcn_s_sleep(1); if (++sp > (1u << 22)) break; } }
                            __builtin_amdgcn_fence(__ATOMIC_ACQUIRE, "agent");
                            asm volatile("s_waitcnt vmcnt(0)" ::: "memory");
                        }
                        __syncthreads();
                    }
                    { int t2 = threadIdx.x; asm volatile("" : "+v"(t2)); pg8::gemm_phase<EpiOut>(lds, g4, S, E4, t2); }
                    if (merged && ctxl && threadIdx.x == 0) {
                        __builtin_amdgcn_fence(__ATOMIC_RELEASE, "agent");
                        asm volatile("s_waitcnt vmcnt(0)" ::: "memory");
                        pg8::Unit u; for (int i = 0; S.next(i, u); ++i) __hip_atomic_fetch_add(&CNT[(DEPTH * 68 + u.pm) * 64], 1u, __ATOMIC_RELAXED, __HIP_MEMORY_SCOPE_AGENT);
                    }
                }
                if (l < DEPTH - 1) {
                    const float* nw1 = args.in[4] + (size_t)(l + 1) * DM; const float* mod1 = MOD + (size_t)(l + 1) * 5 * 6144;
                    int t3 = threadIdx.x; asm volatile("" : "+v"(t3));
                    const int lane3 = t3 & 63, wave3 = __builtin_amdgcn_readfirstlane(t3 >> 6);
                    if (merged) {
                        const int r0 = 68 * bx;
                        if (threadIdx.x == 0) {
                            for (int pm = r0 >> 8; pm <= (r0 + 67) >> 8; ++pm) { unsigned sp = 0;
                                while (__hip_atomic_load(&CNT[(DEPTH * 68 + pm) * 64], __ATOMIC_RELAXED, __HIP_MEMORY_SCOPE_AGENT) < 8u) { __builtin_amdgcn_s_sleep(1); if (++sp > (1u << 22)) break; } }
                            __builtin_amdgcn_fence(__ATOMIC_ACQUIRE, "agent");
                            asm volatile("s_waitcnt vmcnt(0)" ::: "memory");
                        }
                        __syncthreads();
                        for (int row = r0 + wave3; row < r0 + 68; row += 16) { const int rb = row + 8; p1_row2(row, rb < r0 + 68 ? rb : -1, args.out, CTXW, mod1, nw1, H, lane3); }
                    } else {
                        if (args.coop) xcd_barrier(bar);
                        for (int row = bx * 8 + wave3; row < MTOT; row += G * 16) { const int rb = row + G * 8; p1_row2(row, rb < MTOT ? rb : -1, args.out, CTXW, mod1, nw1, H, lane3); }
                    }
                }
            }
        }
        if (ph + 1 < args.ph_hi) { if (args.coop) { if (ph == 0) cg::this_grid().sync(); else xcd_barrier(bar); } }
    }
}

extern "C" void kernel_launch(void* const* d_in, const int* in_sizes, int n_in, void* d_out, int out_size, void* d_ws, size_t ws_size, hipStream_t stream) {
    static int grid = 0;
    if (grid == 0) {
        if (n_in != 29 || in_sizes[0] != MLAT * DM || out_size != MLAT * DM || ws_size < WS_END) {
            fprintf(stderr, "kernel_launch: unexpected shapes: n_in %d in0 %d out %d ws %zu (need %zu)\n", n_in, n_in > 0 ? in_sizes[0] : -1, out_size, ws_size, (size_t)WS_END); grid = -1; return; }
        int dev = 0, cus = 0, per_cu = 0;
        if (hipGetDevice(&dev) != hipSuccess || hipDeviceGetAttribute(&cus, hipDeviceAttributeMultiprocessorCount, dev) != hipSuccess) { grid = -1; return; }
        if (hipFuncSetAttribute((const void*)mega_fwd, hipFuncAttributeMaxDynamicSharedMemorySize, LDS_BYTES) != hipSuccess) { fprintf(stderr, "kernel_launch: hipFuncSetAttribute failed\n"); grid = -1; return; }
        if (hipOccupancyMaxActiveBlocksPerMultiprocessor(&per_cu, (const void*)mega_fwd, 512, LDS_BYTES) != hipSuccess || per_cu < 1) { fprintf(stderr, "kernel_launch: occupancy query gives %d\n", per_cu); per_cu = 1; }
        (void)hipGetLastError();
        grid = cus * 1;
    }
    if (grid < 0) return;
    Args a{};
    for (int i = 0; i < 29; ++i) a.in[i] = (const float*)d_in[i];
    a.out = (float*)d_out; a.ws = (unsigned char*)d_ws;
#if MK_COOP
    if (hipMemsetAsync((char*)d_ws + WS_BAR, 0, 16384 + CNT_BYTES, stream) != hipSuccess) { fprintf(stderr, "kernel_launch: memset of the barrier words failed\n"); return; }
    a.ph_lo = 0; a.ph_hi = NPH; a.coop = 1;
    void* kargs[] = {&a};
    hipError_t e = hipLaunchCooperativeKernel((const void*)mega_fwd, dim3(grid), dim3(512), kargs, LDS_BYTES, stream);
    if (e != hipSuccess) fprintf(stderr, "kernel_launch: cooperative launch failed: %s (grid %d)\n", hipGetErrorString(e), grid);
#else
    for (int ph = 0; ph < NPH; ++ph) {
        a.ph_lo = ph; a.ph_hi = ph + 1; a.coop = 0;
        hipLaunchKernelGGL(mega_fwd, dim3(grid), dim3(512), LDS_BYTES, stream, a);
    }
    const hipError_t le = hipPeekAtLastError();
    if (le != hipSuccess) fprintf(stderr, "kernel_launch: launch failed: %s\n", hipGetErrorName(le));
#endif
}
```

```cpp
#include <hip/hip_runtime.h>
#include <hip/hip_cooperative_groups.h>
#include <cstdio>
#include <cstdint>
namespace cg = cooperative_groups;

#ifndef MK_MASK
#define MK_MASK 127
#endif
#ifndef MK_ATYPE
#define MK_ATYPE 7
#endif
#ifndef MK_G1T
#define MK_G1T 127
#endif
#ifndef ATT_SD_A
#define ATT_SD_A 2
#endif
#ifndef ATT_SD_B
#define ATT_SD_B 1
#endif
#ifndef ATT_SD_C
#define ATT_SD_C 2
#endif
#ifndef ATT_DBL_B
#define ATT_DBL_B true
#endif
#ifndef ATT_DBL
#define ATT_DBL false
#endif
#ifndef QKT_GRP
#define QKT_GRP 0
#endif
#ifndef MK_COOP
#define MK_COOP 1
#endif

#define LAS __attribute__((address_space(3)))
typedef unsigned short bf16_t;
typedef short bf16x8 __attribute__((ext_vector_type(8)));
typedef short s16x4 __attribute__((ext_vector_type(4)));
typedef float f32x4 __attribute__((ext_vector_type(4)));
typedef float f32x16 __attribute__((ext_vector_type(16)));
typedef unsigned u32x4 __attribute__((ext_vector_type(4)));
typedef unsigned u32x2 __attribute__((ext_vector_type(2)));

constexpr int DM = 2048, NBATCH = 4, SEQ = 4096, CTXL = 256, DEPTH = 4;
constexpr int MLAT = NBATCH * SEQ, MCTX = NBATCH * CTXL, MTOT = MLAT + MCTX;
constexpr int INC = 15936, NIN = 16128;
constexpr float EPS = 1e-6f;
#ifndef MK_REP_ST
#define MK_REP_ST -1
#endif
constexpr int PPL = 5;
constexpr int NPH = 2 + 3 * DEPTH;

constexpr size_t alignup(size_t x) { return (x + 255) / 256 * 256; }
constexpr size_t WS_MOD = 0;
constexpr size_t WS_TC64 = WS_MOD + alignup((size_t)DEPTH * 5 * 6144 * 4);
constexpr size_t WS_TS64 = WS_TC64 + 4096, WS_TC128 = WS_TS64 + 4096, WS_TS128 = WS_TC128 + 8192;
constexpr size_t WS_LAM = WS_TS128 + 8192;
constexpr size_t WS_BAR = WS_LAM + 256;
constexpr size_t WS_CNT = WS_BAR + 16384;
constexpr size_t CNT_BYTES = (size_t)(2 * DEPTH * 68 + DEPTH) * 256;
constexpr size_t WS_WIN = WS_CNT + CNT_BYTES;
constexpr size_t WS_WUP = WS_WIN + (size_t)DEPTH * NIN * DM * 2;
constexpr size_t WS_WBR = WS_WUP + (size_t)DEPTH * 2048 * 512 * 2;
constexpr size_t WS_WOUT = WS_WBR + (size_t)DEPTH * 2048 * 3072 * 2;
constexpr size_t WS_H = WS_WOUT + (size_t)DEPTH * 2048 * 2048 * 2;
constexpr size_t WS_QA = WS_H + (size_t)MTOT * 2048 * 2;
constexpr size_t WS_KA = WS_QA + (size_t)MTOT * 1024 * 2;
constexpr size_t WS_VA = WS_KA + (size_t)MTOT * 256 * 2;
constexpr size_t WS_QB = WS_VA + (size_t)MTOT * 256 * 2;
constexpr size_t WS_KB = WS_QB + (size_t)MTOT * 1536 * 2;
constexpr size_t WS_CKV = WS_KB + (size_t)MTOT * 1536 * 2;
constexpr size_t WS_VB = WS_CKV + (size_t)MTOT * 512 * 2;
constexpr size_t WS_QC = WS_VB + (size_t)MTOT * 1024 * 2;
constexpr size_t WS_KC = WS_QC + (size_t)MTOT * 1024 * 2;
constexpr size_t WS_VC = WS_KC + (size_t)MTOT * 1024 * 2;
constexpr size_t WS_GATE = WS_VC + (size_t)MTOT * 1024 * 2;
constexpr size_t WS_MRG = WS_GATE + (size_t)MTOT * 3072 * 2;
constexpr size_t WS_BR = WS_MRG + (size_t)MTOT * 6144 * 2;
constexpr size_t WS_Y = WS_BR + (size_t)MTOT * 3072 * 2;
constexpr size_t WS_SS = WS_Y + (size_t)MTOT * 2048 * 2;
constexpr size_t WS_CTXW = WS_SS + (size_t)MTOT * 8 * 4;
constexpr size_t WS_SCR = WS_CTXW + (size_t)MCTX * DM * 4;
constexpr size_t WS_END = WS_SCR + (size_t)256 * 64 * 512 * 4;

constexpr int RING_BYTES = 131072, XCH_OFF = RING_BYTES, LDS_BYTES = 147456;

__device__ __forceinline__ float bf2f(unsigned h) { return __uint_as_float(h << 16); }
__device__ __forceinline__ unsigned cvt_pk_bf16(float lo, float hi) { unsigned r; asm volatile("v_cvt_pk_bf16_f32 %0, %1, %2" : "=v"(r) : "v"(lo), "v"(hi)); return r; }
__device__ __forceinline__ float wave_sum(float v) {
#pragma unroll
    for (int o = 1; o < 64; o <<= 1) v += __shfl_xor(v, o);
    return v;
}
__device__ __forceinline__ float sigm_f(float x) { return __builtin_amdgcn_rcpf(1.f + __builtin_amdgcn_exp2f(-1.4426950408889634f * x)); }
__device__ __forceinline__ float silu_f(float x) { return x * sigm_f(x); }
__device__ __forceinline__ unsigned cvt_pk_bf16_safe(float lo, float hi) { unsigned r; asm volatile("s_nop 1\n\tv_cvt_pk_bf16_f32 %0, %1, %2" : "=v"(r) : "v"(lo), "v"(hi)); return r; }
__device__ __forceinline__ void store8_safe(bf16_t* p, f32x4 a, f32x4 b) {
    u32x4 w; w.x = cvt_pk_bf16_safe(a[0], a[1]); w.y = cvt_pk_bf16_safe(a[2], a[3]); w.z = cvt_pk_bf16_safe(b[0], b[1]); w.w = cvt_pk_bf16_safe(b[2], b[3]);
    *(u32x4*)p = w;
}
__device__ __forceinline__ void store8(bf16_t* p, f32x4 a, f32x4 b) {
    u32x4 w; w.x = cvt_pk_bf16(a[0], a[1]); w.y = cvt_pk_bf16(a[2], a[3]); w.z = cvt_pk_bf16(b[0], b[1]); w.w = cvt_pk_bf16(b[2], b[3]);
    *(u32x4*)p = w;
}

namespace pg8 {
constexpr int BM = 256, BK = 64, HALF = 128, HTB = HALF * BK * 2, NXCD = 8, WGM = 8;
__host__ __device__ __forceinline__ int lds_byte(int r, int c) { const int st = (r >> 4) * 2 + (c >> 5), rr = r & 15, cc = c & 31, ob = rr * 64 + cc * 2; return st * 1024 + (ob ^ (((ob >> 9) & 1) << 5)); }
__host__ __device__ __forceinline__ void stage_rc(int b, int& R, int& C) { const int st = b / 1024, sb = b % 1024, swz = sb ^ (((sb >> 9) & 1) << 5); R = (st >> 1) * 16 + swz / 64; C = (st & 1) * 32 + (swz % 64) / 2; }
__host__ __device__ __forceinline__ int perm32(int rho) { const int n = rho >> 4, i = rho & 15; return 8 * (i >> 2) + 4 * n + (i & 3); }

struct Unit { int pm, pn; };
struct Gemm { const bf16_t* A; const bf16_t* Bt; int M, N, K; };
struct StaticOrder {
    int nM, nN, nwg, G, c, fixed, fpm, fpn, i0, cnt;
    __device__ void init(int M, int N, int G_, int c_, int i0_ = 0, int cnt_ = 1 << 30) { nM = M / BM; nN = N / BM; nwg = nM * nN; G = G_; c = c_; fixed = 0; fpm = 0; fpn = 0; i0 = i0_; cnt = cnt_; }
    __device__ void init_one(int pm, int pn) { nM = 1; nN = 1; nwg = 1; G = 1; c = 0; fixed = 1; fpm = pm; fpn = pn; i0 = 0; cnt = 1; }
    __device__ bool next(int i, Unit& u) const {
        if (fixed) { if (i > 0) return false; u.pm = fpm; u.pn = fpn; return true; }
        if (i >= cnt) return false;
        const long L = (long)(i + i0) * G + c; if (L >= nwg) return false;
        int wgid = (int)L; { const int q = nwg / NXCD, r = nwg % NXCD, xcd = wgid % NXCD, off = wgid / NXCD; wgid = (xcd < r ? xcd * (q + 1) : r * (q + 1) + (xcd - r) * q) + off; }
        const int nig = WGM * nN, gid = wgid / nig, fm = gid * WGM, gsz = (nM - fm) < WGM ? (nM - fm) : WGM;
        u.pm = fm + ((wgid % nig) % gsz); u.pn = (wgid % nig) / gsz; return true;
    }
};

template <class Epi>
__device__ __forceinline__ void gemm_phase(LAS unsigned char* lds, const Gemm g, const StaticOrder& S, const Epi& E, const int tid) {
    const int wid = __builtin_amdgcn_readfirstlane(tid >> 6), lane = tid & 63, wr = wid >> 2, wc = wid & 3, fr = lane & 15, fq = lane >> 4;
    const int K = g.K, nt = K / BK;
    unsigned voffA[2], voffB[2];
#pragma unroll
    for (int i = 0; i < 2; ++i) { int R, C; stage_rc(tid * 16 + i * 8192, R, C); const int Rb = (R & ~31) + perm32(R & 31);
        voffA[i] = (unsigned)(R * K + C) * 2u; voffB[i] = (unsigned)(Rb * K + C) * 2u; }
    const size_t kstep = (size_t)(BK * 2);
    const size_t hstep = (size_t)HALF * K * 2;
    const size_t tstep = 2 * hstep;
    const unsigned ldsw = (unsigned)wid * 1024u;
    const int aoff = lds_byte(wr * 64 + fr, fq * 8), boff = lds_byte(wc * 32 + fr, fq * 8);
#define PG8_SA(b, h) (((b) * 2 + (h)) * HTB)
#define PG8_SB(b, h) ((4 + (b) * 2 + (h)) * HTB)
#define PG8_STAGE(bufoff, gbase, voff) do { _Pragma("unroll") for (int _i = 0; _i < 2; ++_i) \
        __builtin_amdgcn_global_load_lds((const unsigned*)((const char*)(gbase) + (voff)[_i]), (LAS unsigned*)(lds + (bufoff) + ldsw + _i * 8192), 16, 0, 0); } while (0)
#define PG8_LDA(dst, b, h) do { _Pragma("unroll") for (int m = 0; m < 4; ++m) _Pragma("unroll") for (int k = 0; k < 2; ++k) dst[m][k] = *(const LAS bf16x8*)(lds + PG8_SA(b, h) + aoff + m * 2048 + k * 1024); } while (0)
#define PG8_LDB(dst, b, h) do { _Pragma("unroll") for (int n = 0; n < 2; ++n) _Pragma("unroll") for (int k = 0; k < 2; ++k) dst[n][k] = *(const LAS bf16x8*)(lds + PG8_SB(b, h) + boff + n * 2048 + k * 1024); } while (0)
#define PG8_MMA(ai, bj, At, Bt) do { __builtin_amdgcn_s_setprio(1); _Pragma("unroll") for (int m = 0; m < 4; ++m) _Pragma("unroll") for (int n = 0; n < 2; ++n) _Pragma("unroll") for (int k = 0; k < 2; ++k) \
        acc[ai][bj][m][n] = __builtin_amdgcn_mfma_f32_16x16x32_bf16(Bt[n][k], At[m][k], acc[ai][bj][m][n], 0, 0, 0); __builtin_amdgcn_s_setprio(0); } while (0)
#define PG8_WAIT_V(n) asm volatile("s_waitcnt vmcnt(" #n ")" ::: "memory")
#define PG8_WAIT_L(n) asm volatile("s_waitcnt lgkmcnt(" #n ")" ::: "memory")
#define PG8_BAR __builtin_amdgcn_s_barrier()
#define PG8_SCHED __builtin_amdgcn_sched_barrier(0)
    Unit cur, nxt; int ui = 0;
    if (!S.next(0, cur)) return;
    f32x4 acc[2][2][4][2];
#pragma unroll
    for (int a = 0; a < 2; ++a)
#pragma unroll
        for (int b = 0; b < 2; ++b)
#pragma unroll
            for (int m = 0; m < 4; ++m)
#pragma unroll
                for (int n = 0; n < 2; ++n) acc[a][b][m][n] = (f32x4){0.f, 0.f, 0.f, 0.f};
    bf16x8 At[4][2], B0[2][2], B1[2][2];
    const char* cA = (const char*)g.A + (size_t)cur.pm * tstep; const char* cB = (const char*)g.Bt + (size_t)cur.pn * tstep;
    PG8_STAGE(PG8_SB(0, 0), cB, voffB); PG8_STAGE(PG8_SB(0, 1), cB + hstep, voffB); PG8_STAGE(PG8_SA(0, 0), cA, voffA); PG8_STAGE(PG8_SA(0, 1), cA + hstep, voffA);
    if (wr == 1) PG8_BAR;
    PG8_WAIT_V(2); PG8_BAR;
    PG8_STAGE(PG8_SB(1, 0), cB + kstep, voffB); PG8_STAGE(PG8_SA(1, 0), cA + kstep, voffA); PG8_STAGE(PG8_SB(1, 1), cB + hstep + kstep, voffB);
    PG8_WAIT_V(6); PG8_BAR;
    for (;;) {
        const bool has_next = S.next(ui + 1, nxt);
        const char* nA = has_next ? (const char*)g.A + (size_t)nxt.pm * tstep : cA; const char* nB = has_next ? (const char*)g.Bt + (size_t)nxt.pn * tstep : cB;
        for (int t = 0; t < nt; t += 2) {
            const bool last = (t == nt - 2);
            const char* a1 = cA + (size_t)(t + 1) * kstep;
            const char* a2 = last ? nA : cA + (size_t)(t + 2) * kstep; const char* b2 = last ? nB : cB + (size_t)(t + 2) * kstep;
            const char* a3 = a2 + kstep; const char* b3 = b2 + kstep;
            if constexpr (Epi::MID) { if (t == 16 || t == 32) { int fr_ = fr, fq_ = fq, wr_ = wr, wc_ = wc;
                asm volatile("" : "+v"(fr_), "+v"(fq_)); asm volatile("" : "+s"(wr_), "+s"(wc_));
                E.mid(acc, cur, t >> 4, wr_, wc_, fr_, fq_); PG8_WAIT_V(0); PG8_SCHED; } }
            PG8_LDB(B0, 0, 0); PG8_LDB(B1, 0, 1); PG8_SCHED; PG8_LDA(At, 0, 0); PG8_STAGE(PG8_SA(1, 1), a1 + hstep, voffA);
            PG8_WAIT_V(8); PG8_WAIT_L(0); PG8_BAR; PG8_MMA(0, 0, At, B0); PG8_MMA(0, 1, At, B1); PG8_BAR; PG8_SCHED;
            PG8_LDA(At, 0, 1); PG8_STAGE(PG8_SB(0, 0), b2, voffB); PG8_STAGE(PG8_SB(0, 1), b2 + hstep, voffB); PG8_STAGE(PG8_SA(0, 0), a2, voffA);
            PG8_WAIT_V(8); PG8_WAIT_L(0); PG8_BAR; PG8_MMA(1, 0, At, B0); PG8_MMA(1, 1, At, B1); PG8_BAR; PG8_SCHED;
            PG8_LDB(B0, 1, 0); PG8_LDB(B1, 1, 1); PG8_SCHED; PG8_LDA(At, 1, 0); PG8_STAGE(PG8_SA(0, 1), a2 + hstep, voffA);
            PG8_WAIT_V(8); PG8_WAIT_L(0); PG8_BAR; PG8_MMA(0, 0, At, B0); PG8_MMA(0, 1, At, B1); PG8_BAR; PG8_SCHED;
            PG8_LDA(At, 1, 1); PG8_STAGE(PG8_SB(1, 0), b3, voffB); PG8_STAGE(PG8_SB(1, 1), b3 + hstep, voffB); PG8_STAGE(PG8_SA(1, 0), a3, voffA);
            PG8_WAIT_V(8); PG8_WAIT_L(0); PG8_BAR; PG8_MMA(1, 0, At, B0); PG8_MMA(1, 1, At, B1); PG8_BAR; PG8_SCHED;
        }
        if (wr == 0) PG8_BAR;
        { int fr_ = fr, fq_ = fq, wr_ = wr, wc_ = wc, wid_ = wid;
          asm volatile("" : "+v"(fr_), "+v"(fq_)); asm volatile("" : "+s"(wr_), "+s"(wc_), "+s"(wid_));
          E(acc, cur, wr_, wc_, fr_, fq_, wid_); }
        if (!has_next) break;
#pragma unroll
        for (int a = 0; a < 2; ++a)
#pragma unroll
            for (int b = 0; b < 2; ++b)
#pragma unroll
                for (int m = 0; m < 4; ++m)
#pragma unroll
                    for (int n = 0; n < 2; ++n) acc[a][b][m][n] = (f32x4){0.f, 0.f, 0.f, 0.f};
        cur = nxt; cA = nA; cB = nB; ++ui;
        if (wr == 1) PG8_BAR;
    }
    PG8_WAIT_V(0);
    PG8_BAR;
#undef PG8_SA
#undef PG8_SB
#undef PG8_STAGE
#undef PG8_LDA
#undef PG8_LDB
#undef PG8_MMA
#undef PG8_WAIT_V
#undef PG8_WAIT_L
#undef PG8_BAR
#undef PG8_SCHED
}
}
using pg8::Unit;

__device__ __forceinline__ int in_src_col(int n) {
    const int tile = n >> 8, s = n & 255, bj = s >> 7, wc = (s >> 5) & 3, c = s & 31;
    const int d128 = 64 * (wc & 1) + 32 * bj + c, g128 = wc >> 1;
    const int d64 = 32 * (c >> 4) + 16 * bj + (c & 15), g64 = wc;
    if (tile < 4) return (tile * 2 + g128) * 128 + d128;
    if (tile == 4) return 1024 + g128 * 128 + d128;
    if (tile == 5) return 1280 + s;
    if (tile < 10) return 1536 + ((tile - 6) * 2 + g128) * 192 + d128;
    if (tile < 12) return 1536 + ((tile - 10) * 4 + g64) * 192 + 128 + d64;
    if (tile < 14) return 3072 + (tile - 12) * 256 + s;
    if (tile == 14) return g64 == 0 ? 3584 + d64 : -1;
    if (tile < 19) return 3648 + ((tile - 15) * 4 + g64) * 64 + d64;
    if (tile < 23) return 4672 + ((tile - 19) * 4 + g64) * 64 + d64;
    if (tile < 27) return 5696 + (tile - 23) * 256 + s;
    if (tile < 39) return 6720 + (tile - 27) * 256 + s;
    return 9792 + (tile - 39) * 256 + s;
}
__device__ __forceinline__ int up_src_col(int n) {
    if (n >= 1024) return n;
    const int tile = n >> 8, s = n & 255, bj = s >> 7, wc = (s >> 5) & 3, c = s & 31;
    return (tile * 2 + (wc >> 1)) * 128 + 64 * (wc & 1) + 32 * bj + c;
}

template <int GS>
__device__ __forceinline__ void norm_rope_store(const f32x4 (&acc)[2][2][4][2], int pm, int wr, int wc, int fr, int fq, int wid,
                                                const float* __restrict__ w, const float* __restrict__ tcos, const float* __restrict__ tsin, bool rope,
                                                const float (&pre)[2][4], bf16_t* __restrict__ dst, int ld, int gbase, int ncopies, int copystride, LAS float* xch, const float qs = 1.f) {
    const int dbase = (GS == 128) ? 64 * (wc & 1) + 8 * fq : 32 * (fq >> 1) + 8 * (fq & 1);
    const int bjs = (GS == 128) ? 32 : 16;
    const int axis = (GS == 128) ? (wc & 1) : (fq >> 1);
    const int i0 = (GS == 128) ? 8 * fq : 8 * (fq & 1);
    constexpr int NF = (GS == 128) ? 32 : 16;
    const int wavebase = gbase + ((GS == 128) ? 64 * (wc & 1) : 0) + 8 * fq;
    float ssq[2][4];
#pragma unroll
    for (int ai = 0; ai < 2; ++ai)
#pragma unroll
        for (int m = 0; m < 4; ++m) {
            float s = 0.f;
#pragma unroll
            for (int bj = 0; bj < 2; ++bj)
#pragma unroll
                for (int n = 0; n < 2; ++n)
#pragma unroll
                    for (int j = 0; j < 4; ++j) { const float v = acc[ai][bj][m][n][j] * pre[ai][m]; s += v * v; }
            s += __shfl_xor(s, 16); s += __shfl_xor(s, 32);
            ssq[ai][m] = s;
        }
    if constexpr (GS == 128) {
        if (fq == 0) {
#pragma unroll
            for (int ai = 0; ai < 2; ++ai)
#pragma unroll
                for (int m = 0; m < 4; ++m) xch[wid * 128 + ai * 64 + m * 16 + fr] = ssq[ai][m];
        }
        asm volatile("s_waitcnt lgkmcnt(0)" ::: "memory"); __builtin_amdgcn_s_barrier();
#pragma unroll
        for (int ai = 0; ai < 2; ++ai)
#pragma unroll
            for (int m = 0; m < 4; ++m) ssq[ai][m] += xch[(wid ^ 1) * 128 + ai * 64 + m * 16 + fr];
    }
#pragma unroll
    for (int ai = 0; ai < 2; ++ai)
#pragma unroll
        for (int m = 0; m < 4; ++m) {
            const int rl = ai * 128 + wr * 64 + m * 16 + fr;
            const size_t row = (size_t)pm * 256 + rl;
            const float rinv = rsqrtf(ssq[ai][m] * (1.f / GS) + EPS) * pre[ai][m] * qs;
            const int t = (pm & 15) * 256 + rl; const int pos = axis ? (t & 63) : (t >> 6);
            u32x4 k0, k1;
#pragma unroll
            for (int n = 0; n < 2; ++n) {
                const f32x4 w0 = *(const f32x4*)(w + dbase + 4 * n), w1 = *(const f32x4*)(w + dbase + bjs + 4 * n);
                f32x4 y0 = acc[ai][0][m][n] * rinv * w0, y1 = acc[ai][1][m][n] * rinv * w1;
                if (rope) {
                    const f32x4 c = *(const f32x4*)(tcos + pos * NF + i0 + 4 * n), sn = *(const f32x4*)(tsin + pos * NF + i0 + 4 * n);
                    const f32x4 o0 = y0 * c - y1 * sn, o1 = y1 * c + y0 * sn;
                    y0 = o0; y1 = o1;
                }
                if (n == 0) { k0.x = cvt_pk_bf16(y0[0], y0[1]); k0.y = cvt_pk_bf16(y0[2], y0[3]); k1.x = cvt_pk_bf16(y1[0], y1[1]); k1.y = cvt_pk_bf16(y1[2], y1[3]); }
                else { k0.z = cvt_pk_bf16(y0[0], y0[1]); k0.w = cvt_pk_bf16(y0[2], y0[3]); k1.z = cvt_pk_bf16(y1[0], y1[1]); k1.w = cvt_pk_bf16(y1[2], y1[3]); }
            }
            bf16_t* p = dst + row * ld + wavebase;
            for (int cp = 0; cp < ncopies; ++cp) { *(u32x4*)(p + cp * copystride) = k0; *(u32x4*)(p + cp * copystride + 32) = k1; }
            __builtin_amdgcn_sched_barrier(0);
        }
}

struct EpiIn {
    static constexpr bool MID = false;
    bf16_t *QA, *KA, *VA, *QB, *KB, *CKV, *QC, *KC, *VC, *GATE, *MRG; float* SS;
    const float *wAq, *wAk, *wBqn, *wBqr, *wBkr, *wCq, *wCk, *bmerge;
    const float *tc64, *ts64, *tc128, *ts128;
    LAS float* xch;
    template <int ACT>
    __device__ __forceinline__ void plain(const f32x4 (&acc)[2][2][4][2], int pm, int wr, int wc, int fr, int fq, bf16_t* dst, int ld, int col0) const {
        const int colw = col0 + 32 * wc + 8 * fq;
        f32x4 b[2][2];
#pragma unroll
        for (int bj = 0; bj < 2; ++bj)
#pragma unroll
            for (int n = 0; n < 2; ++n) b[bj][n] = (ACT == 2) ? *(const f32x4*)(bmerge + colw + bj * 128 + 4 * n) : (f32x4){0.f, 0.f, 0.f, 0.f};
#pragma unroll
        for (int ai = 0; ai < 2; ++ai)
#pragma unroll
            for (int m = 0; m < 4; ++m) {
                const size_t row = (size_t)pm * 256 + ai * 128 + wr * 64 + m * 16 + fr;
#pragma unroll
                for (int bj = 0; bj < 2; ++bj) {
                    f32x4 v0 = acc[ai][bj][m][0], v1 = acc[ai][bj][m][1];
                    if (ACT == 1) { for (int j = 0; j < 4; ++j) { v0[j] = silu_f(v0[j]); v1[j] = silu_f(v1[j]); } }
                    if (ACT == 2) { v0 = v0 + b[bj][0]; v1 = v1 + b[bj][1]; for (int j = 0; j < 4; ++j) { v0[j] = sigm_f(v0[j]); v1[j] = sigm_f(v1[j]); } }
                    if (ACT == 0) store8(dst + row * ld + colw + bj * 128, v0, v1); else store8_safe(dst + row * ld + colw + bj * 128, v0, v1);
                }
                __builtin_amdgcn_sched_barrier(0);
            }
    }
    __device__ __forceinline__ void operator()(const f32x4 (&acc)[2][2][4][2], const Unit& u, int wr, int wc, int fr, int fq, int wid) const {
        const int t = u.pn, pm = u.pm; const bool rope = pm < 64;
        const float one[2][4] = {{1.f, 1.f, 1.f, 1.f}, {1.f, 1.f, 1.f, 1.f}};
        if (t < 4 && (MK_G1T & 1)) norm_rope_store<128>(acc, pm, wr, wc, fr, fq, wid, wAq, tc128, ts128, rope, one, QA, 1024, (t * 2 + (wc >> 1)) * 128, 1, 0, xch, 0.08838834764831845f * 1.4426950408889634f);
        else if (t == 4 && (MK_G1T & 1)) norm_rope_store<128>(acc, pm, wr, wc, fr, fq, wid, wAk, tc128, ts128, rope, one, KA, 256, (wc >> 1) * 128, 1, 0, xch);
        else if (t == 5 && (MK_G1T & 2)) plain<0>(acc, pm, wr, wc, fr, fq, VA, 256, 0);
        else if (t < 10 && (MK_G1T & 1)) norm_rope_store<128>(acc, pm, wr, wc, fr, fq, wid, wBqn, tc128, ts128, false, one, QB, 1536, ((t - 6) * 2 + (wc >> 1)) * 192, 1, 0, xch, 0.07216878364870323f * 1.4426950408889634f);
        else if (t < 12 && (MK_G1T & 4)) norm_rope_store<64>(acc, pm, wr, wc, fr, fq, wid, wBqr, tc64, ts64, rope, one, QB, 1536, ((t - 10) * 4 + wc) * 192 + 128, 1, 0, xch, 0.07216878364870323f * 1.4426950408889634f);
        else if (t < 14 && (MK_G1T & 8)) {
            plain<0>(acc, pm, wr, wc, fr, fq, CKV, 512, (t - 12) * 256);
#pragma unroll
            for (int ai = 0; ai < 2; ++ai)
#pragma unroll
                for (int m = 0; m < 4; ++m) {
                    float s = 0.f;
#pragma unroll
                    for (int bj = 0; bj < 2; ++bj)
#pragma unroll
                        for (int n = 0; n < 2; ++n)
#pragma unroll
                            for (int j = 0; j < 4; ++j) { const float v = acc[ai][bj][m][n][j]; s += v * v; }
                    s += __shfl_xor(s, 16); s += __shfl_xor(s, 32);
                    if (fq == 0) SS[((size_t)pm * 256 + ai * 128 + wr * 64 + m * 16 + fr) * 8 + (t - 12) * 4 + wc] = s;
                }
        }
        else if (t == 14 && (MK_G1T & 16)) { if (wc == 0) norm_rope_store<64>(acc, pm, wr, wc, fr, fq, wid, wBkr, tc64, ts64, rope, one, KB, 1536, 128, 8, 192, xch); }
        else if (t < 19 && (MK_G1T & 4)) norm_rope_store<64>(acc, pm, wr, wc, fr, fq, wid, wCq, tc64, ts64, rope, one, QC, 1024, ((t - 15) * 4 + wc) * 64, 1, 0, xch, 0.125f * 1.4426950408889634f);
        else if (t < 23 && (MK_G1T & 4)) norm_rope_store<64>(acc, pm, wr, wc, fr, fq, wid, wCk, tc64, ts64, rope, one, KC, 1024, ((t - 19) * 4 + wc) * 64, 1, 0, xch);
        else if (t < 27 && (MK_G1T & 2)) plain<0>(acc, pm, wr, wc, fr, fq, VC, 1024, (t - 23) * 256);
        else if (t < 39 && (MK_G1T & 32)) plain<1>(acc, pm, wr, wc, fr, fq, GATE, 3072, (t - 27) * 256);
        else if (MK_G1T & 64) plain<2>(acc, pm, wr, wc, fr, fq, MRG, 6144, (t - 39) * 256);
    }
};

struct EpiUp {
    static constexpr bool MID = false;
    bf16_t *KB, *VB; const float* SS; const float* wBkn; LAS float* xch;
    __device__ __forceinline__ void operator()(const f32x4 (&acc)[2][2][4][2], const Unit& u, int wr, int wc, int fr, int fq, int wid) const {
        const int t = u.pn, pm = u.pm;
        float pre[2][4];
#pragma unroll
        for (int ai = 0; ai < 2; ++ai)
#pragma unroll
            for (int m = 0; m < 4; ++m) {
                const size_t row = (size_t)pm * 256 + ai * 128 + wr * 64 + m * 16 + fr;
                const f32x4 a = *(const f32x4*)(SS + row * 8), b = *(const f32x4*)(SS + row * 8 + 4);
                pre[ai][m] = rsqrtf(((a[0] + a[1]) + (a[2] + a[3]) + (b[0] + b[1]) + (b[2] + b[3])) * (1.f / 512.f) + EPS);
                __builtin_amdgcn_sched_barrier(0);
            }
        if (t < 4) norm_rope_store<128>(acc, pm, wr, wc, fr, fq, wid, wBkn, nullptr, nullptr, false, pre, KB, 1536, (t * 2 + (wc >> 1)) * 192, 1, 0, xch);
        else {
            const int colw = (t - 4) * 256 + 32 * wc + 8 * fq;
#pragma unroll
            for (int ai = 0; ai < 2; ++ai)
#pragma unroll
                for (int m = 0; m < 4; ++m) {
                    const size_t row = (size_t)pm * 256 + ai * 128 + wr * 64 + m * 16 + fr;
#pragma unroll
                    for (int bj = 0; bj < 2; ++bj) store8(VB + row * 1024 + colw + bj * 128, acc[ai][bj][m][0] * pre[ai][m], acc[ai][bj][m][1] * pre[ai][m]);
                    __builtin_amdgcn_sched_barrier(0);
                }
        }
    }
};

struct EpiBr {
    static constexpr bool MID = true;
    const bf16_t* MRG; bf16_t* Y;
    __device__ __forceinline__ void mid(f32x4 (&acc)[2][2][4][2], const Unit& u, int i, int wr, int wc, int fr, int fq) const {
#pragma unroll
        for (int ai = 0; ai < 2; ++ai)
#pragma unroll
            for (int m = 0; m < 4; ++m) {
                const size_t row = (size_t)u.pm * 256 + ai * 128 + wr * 64 + m * 16 + fr;
#pragma unroll
                for (int bj = 0; bj < 2; ++bj) {
                    const int col = u.pn * 256 + bj * 128 + 32 * wc + 8 * fq;
                    const u32x4 a = *(const u32x4*)(MRG + row * 6144 + (i - 1) * 2048 + col), b = *(const u32x4*)(MRG + row * 6144 + i * 2048 + col);
#pragma unroll
                    for (int q = 0; q < 4; ++q) {
                        const float r0 = bf2f(a[q] & 0xffffu) * __builtin_amdgcn_rcpf(bf2f(b[q] & 0xffffu)), r1 = bf2f(a[q] >> 16) * __builtin_amdgcn_rcpf(bf2f(b[q] >> 16));
                        acc[ai][bj][m][q >> 1][(q & 1) * 2] *= r0; acc[ai][bj][m][q >> 1][(q & 1) * 2 + 1] *= r1;
                    }
                }
                __builtin_amdgcn_sched_barrier(0);
            }
    }
    __device__ __forceinline__ void operator()(const f32x4 (&acc)[2][2][4][2], const Unit& u, int wr, int wc, int fr, int fq, int wid) const {
#pragma unroll
        for (int ai = 0; ai < 2; ++ai)
#pragma unroll
            for (int m = 0; m < 4; ++m) {
                const size_t row = (size_t)u.pm * 256 + ai * 128 + wr * 64 + m * 16 + fr;
#pragma unroll
                for (int bj = 0; bj < 2; ++bj) {
                    const int col = u.pn * 256 + bj * 128 + 32 * wc + 8 * fq;
                    const u32x4 a = *(const u32x4*)(MRG + row * 6144 + 4096 + col);
                    f32x4 v0 = acc[ai][bj][m][0], v1 = acc[ai][bj][m][1];
                    v0[0] *= bf2f(a[0] & 0xffffu); v0[1] *= bf2f(a[0] >> 16); v0[2] *= bf2f(a[1] & 0xffffu); v0[3] *= bf2f(a[1] >> 16);
                    v1[0] *= bf2f(a[2] & 0xffffu); v1[1] *= bf2f(a[2] >> 16); v1[2] *= bf2f(a[3] & 0xffffu); v1[3] *= bf2f(a[3] >> 16);
                    store8(Y + row * 2048 + col, v0, v1);
                }
                __builtin_amdgcn_sched_barrier(0);
            }
    }
};

struct EpiOut {
    static constexpr bool MID = false;
    const float *xsrc, *csrc; float *xdst, *cdst; const float* mod;
    __device__ __forceinline__ void operator()(const f32x4 (&acc)[2][2][4][2], const Unit& u, int wr, int wc, int fr, int fq, int wid) const {
        const int pm = u.pm; const bool lat = pm < 64;
        const int mi = lat ? (pm >> 4) : 4;
        const float* src = lat ? xsrc : csrc - (size_t)MLAT * DM; float* dst = lat ? xdst : cdst - (size_t)MLAT * DM;
        const float* g = mod + mi * 6144 + 4096;
#pragma unroll
        for (int bj = 0; bj < 2; ++bj) {
            const int col = u.pn * 256 + bj * 128 + 32 * wc + 8 * fq;
            const f32x4 g0 = *(const f32x4*)(g + col), g1 = *(const f32x4*)(g + col + 4);
#pragma unroll
            for (int ai = 0; ai < 2; ++ai)
#pragma unroll
                for (int m = 0; m < 4; ++m) {
                    const size_t row = (size_t)pm * 256 + ai * 128 + wr * 64 + m * 16 + fr;
                    const f32x4 x0 = *(const f32x4*)(src + row * DM + col), x1 = *(const f32x4*)(src + row * DM + col + 4);
                    *(f32x4*)(dst + row * DM + col) = x0 + g0 * acc[ai][bj][m][0];
                    *(f32x4*)(dst + row * DM + col + 4) = x1 + g1 * acc[ai][bj][m][1];
                    __builtin_amdgcn_sched_barrier(0);
                }
        }
    }
};

namespace att {
#define SBAR() __builtin_amdgcn_sched_barrier(0)
__device__ __forceinline__ int crow(int r, int hi) { return (r & 3) + 8 * (r >> 2) + 4 * hi; }
template <int RB> __device__ __forceinline__ int kswz(int row, int colB) { const int x = (RB == 256) ? (row & 15) : ((row >> 1) & 7); return row * RB + (colB ^ (x << 4)); }
__device__ __forceinline__ int v_st(int k, int c) { const int kk = (k & ~0xC) | ((k & 4) << 1) | ((k & 8) >> 1); return ((kk >> 3) * 4 + (c >> 5)) * 512 + ((kk & 7) * 32 + (c & 31)) * 2; }
__device__ __forceinline__ int v_rd_base(int lane) { return ((lane & 3) << 3) | (((lane >> 2) & 3) << 6) | (((lane >> 4) & 1) << 5) | (((lane >> 5) & 1) << 8); }
constexpr int v_rd_off(int d0, int ks, int half) { return d0 * 512 + ks * 4096 + half * 2048; }
template <int OFF> __device__ __forceinline__ s16x4 tr_read(unsigned vb) {
    s16x4 r; asm volatile("ds_read_b64_tr_b16 %0, %1 offset:%2" : "=&v"(r) : "v"(vb), "i"(OFF) : "memory"); return r;
}
template <int D0> __device__ __forceinline__ void pv_one(f32x16& od, unsigned vb, bf16x8 pa0, bf16x8 pa1, bf16x8 pa2, bf16x8 pa3) {
    const s16x4 l0 = tr_read<v_rd_off(D0, 0, 0)>(vb), h0 = tr_read<v_rd_off(D0, 0, 1)>(vb), l1 = tr_read<v_rd_off(D0, 1, 0)>(vb), h1 = tr_read<v_rd_off(D0, 1, 1)>(vb);
    const s16x4 l2 = tr_read<v_rd_off(D0, 2, 0)>(vb), h2 = tr_read<v_rd_off(D0, 2, 1)>(vb), l3 = tr_read<v_rd_off(D0, 3, 0)>(vb), h3 = tr_read<v_rd_off(D0, 3, 1)>(vb);
    asm volatile("s_waitcnt lgkmcnt(0)" ::: "memory"); SBAR();
#define PK(L, H) (bf16x8){L[0], L[1], L[2], L[3], H[0], H[1], H[2], H[3]}
    od = __builtin_amdgcn_mfma_f32_32x32x16_bf16(pa0, PK(l0, h0), od, 0, 0, 0);
    od = __builtin_amdgcn_mfma_f32_32x32x16_bf16(pa1, PK(l1, h1), od, 0, 0, 0);
    od = __builtin_amdgcn_mfma_f32_32x32x16_bf16(pa2, PK(l2, h2), od, 0, 0, 0);
    od = __builtin_amdgcn_mfma_f32_32x32x16_bf16(pa3, PK(l3, h3), od, 0, 0, 0);
#undef PK
}
__device__ __forceinline__ void pv_d0(f32x16 (&o)[4], unsigned vb, bf16x8 pa0, bf16x8 pa1, bf16x8 pa2, bf16x8 pa3) {
    pv_one<0>(o[0], vb, pa0, pa1, pa2, pa3); pv_one<1>(o[1], vb, pa0, pa1, pa2, pa3); pv_one<2>(o[2], vb, pa0, pa1, pa2, pa3); pv_one<3>(o[3], vb, pa0, pa1, pa2, pa3);
}
__device__ __forceinline__ void partialSM(f32x16& p0, f32x16& p1) {
#pragma unroll
    for (int r = 0; r < 16; ++r) p0[r] = __builtin_amdgcn_exp2f(p0[r]);
}
__device__ __forceinline__ void finishSM(f32x16& p0, f32x16& p1, float& l_reg, bf16x8& pa0, bf16x8& pa1, bf16x8& pa2, bf16x8& pa3) {
#pragma unroll
    for (int r = 0; r < 16; ++r) p1[r] = __builtin_amdgcn_exp2f(p1[r]);
    float ps = 0;
#pragma unroll
    for (int r = 0; r < 16; ++r) ps += p0[r];
#pragma unroll
    for (int r = 0; r < 16; ++r) ps += p1[r];
    l_reg += ps;
#define PK8(P, BASE, OUT) do { u32x4 w = {cvt_pk_bf16(P[BASE + 0], P[BASE + 1]), cvt_pk_bf16(P[BASE + 2], P[BASE + 3]), cvt_pk_bf16(P[BASE + 4], P[BASE + 5]), cvt_pk_bf16(P[BASE + 6], P[BASE + 7])}; \
    OUT = *reinterpret_cast<bf16x8*>(&w); } while (0)
    PK8(p0, 0, pa0); PK8(p0, 8, pa1); PK8(p1, 0, pa2); PK8(p1, 8, pa3);
#undef PK8
}
template <int DQK>
__device__ __forceinline__ void qkt(f32x16& p0, f32x16& p1, const LAS char* Ks, const bf16x8 (&qr)[DQK / 16], const int (&ka)[8], float nMB) {
    constexpr int RB = DQK * 2, NA = (RB == 256) ? 8 : 4;
#pragma unroll
    for (int r = 0; r < 16; ++r) { p0[r] = nMB; p1[r] = nMB; }
#pragma unroll
    for (int d0 = 0; d0 < DQK / 16; ++d0) {
        const LAS char* a = Ks + ka[d0 % NA] + (d0 / NA) * (NA * 32);
        const bf16x8 b0 = *(const LAS bf16x8*)(a);
        const bf16x8 b1 = *(const LAS bf16x8*)(a + 32 * RB);
        p0 = __builtin_amdgcn_mfma_f32_32x32x16_bf16(b0, qr[d0], p0, 0, 0, 0);
        p1 = __builtin_amdgcn_mfma_f32_32x32x16_bf16(b1, qr[d0], p1, 0, 0, 0); }
}
constexpr int V_BYTES = 64 * 128 * 2, K_OFF = 3 * V_BYTES, K_STRIDE = 64 * 192 * 2, LI_OFF = K_OFF + 3 * K_STRIDE;

template <int DQK, bool DOUBLE>
__device__ __forceinline__ void attn_pass(const bf16_t* __restrict__ Q, int ldq, const bf16_t* __restrict__ Kg, int ldk, const bf16_t* __restrict__ Vg, int ldv,
                                          int rowc, int rowl, int NT, float nMB, f32x16 (&o)[4], float& l_reg, LAS char* lds, int tid) {
    constexpr int RB = DQK * 2, NCH = DQK / 8, NLD = NCH / 8;
    const int wid = __builtin_amdgcn_readfirstlane(tid >> 6), lane = tid & 63, r32 = lane & 31, hi = lane >> 5;
    LAS char* V_lds = lds; LAS char* K_lds = lds + K_OFF;
    bf16x8 qr[DQK / 16];
    { const bf16_t* Qw = Q + (size_t)(wid * 32 + r32) * ldq + hi * 8;
#pragma unroll
      for (int d0 = 0; d0 < DQK / 16; ++d0) qr[d0] = *(const bf16x8*)(Qw + d0 * 16); }
#pragma unroll
    for (int d = 0; d < 4; ++d) o[d] = f32x16{};
    l_reg = 0.f;
    int vrow[2], vcol[2], krow[NLD], kcol[NLD];
#pragma unroll
    for (int i = 0; i < 2; ++i) { const int q = tid + 512 * i, sub = q >> 5, within = q & 31, kk = (sub >> 2) * 8 + (within >> 2);
        vrow[i] = kk; vcol[i] = (sub & 3) * 32 + (within & 3) * 8; }
#pragma unroll
    for (int i = 0; i < NLD; ++i) { const int q = tid + 512 * i, row = q / NCH, chp = q % NCH; const int x = (RB == 256) ? (row & 15) : ((row >> 1) & 7);
        krow[i] = row; kcol[i] = (chp ^ x) * 8; }
    const unsigned vb0 = (unsigned)(uintptr_t)V_lds + v_rd_base(lane);
    int ka[8];
#pragma unroll
    for (int q = 0; q < 8; ++q) ka[q] = kswz<RB>(r32, q * 32 + hi * 16);
#define KROW0(j) ((j) < 4 ? rowc + 64 * (j) : rowl + 64 * ((j) - 4))
#define DMA(j, b) do { const size_t _r0 = (size_t)KROW0(j); \
    _Pragma("unroll") for (int _i = 0; _i < 2; ++_i) __builtin_amdgcn_global_load_lds((const unsigned*)(Vg + (_r0 + vrow[_i]) * ldv + vcol[_i]), (LAS unsigned*)(V_lds + (b) * V_BYTES + wid * 1024 + _i * 8192), 16, 0, 0); \
    _Pragma("unroll") for (int _i = 0; _i < NLD; ++_i) __builtin_amdgcn_global_load_lds((const unsigned*)(Kg + (_r0 + krow[_i]) * ldk + kcol[_i]), (LAS unsigned*)(K_lds + (b) * K_STRIDE + wid * 1024 + _i * 8192), 16, 0, 0); } while (0)
#define VMW0() asm volatile("s_waitcnt vmcnt(0)" ::: "memory")
    bf16x8 pa0, pa1, pa2, pa3;
    __syncthreads();
    DMA(0, 0); DMA(1, 1); VMW0(); __syncthreads();
    if constexpr (!DOUBLE) {
        f32x16 p0, p1;
        DMA(2, 2);
        int bc = 0, bn = 1, bf = 2;
        for (int j = 0; j < NT; ++j) {
            SBAR(); qkt<DQK>(p0, p1, K_lds + bc * K_STRIDE, qr, ka, nMB);
            partialSM(p0, p1); finishSM(p0, p1, l_reg, pa0, pa1, pa2, pa3); SBAR();
            pv_d0(o, vb0 + bc * V_BYTES, pa0, pa1, pa2, pa3);
            if (j + 1 < NT) { VMW0(); __syncthreads(); if (j + 3 < NT) DMA(j + 3, bc); }
            { const int _t = bc; bc = bn; bn = bf; bf = _t; }
        }
    } else {
    f32x16 pA0, pA1, pB0, pB1;
    qkt<DQK>(pA0, pA1, K_lds, qr, ka, nMB); partialSM(pA0, pA1);
    DMA(2, 2);
    int bp = 0, bc = 1, bn = 2;
#define STEP(j, PC0, PC1, PP0, PP1) do { \
        SBAR(); qkt<DQK>(PC0, PC1, K_lds + bc * K_STRIDE, qr, ka, nMB); \
        finishSM(PP0, PP1, l_reg, pa0, pa1, pa2, pa3); SBAR(); \
        pv_d0(o, vb0 + bp * V_BYTES, pa0, pa1, pa2, pa3); partialSM(PC0, PC1); \
        if ((j) + 1 < NT) { VMW0(); __syncthreads(); if ((j) + 2 < NT) DMA((j) + 2, bp); } \
        { const int _t = bp; bp = bc; bc = bn; bn = _t; } } while (0)
    for (int j = 1; j < NT; j += 2) {
        STEP(j, pB0, pB1, pA0, pA1);
        if (j + 1 < NT) STEP(j + 1, pA0, pA1, pB0, pB1);
    }
    finishSM(pB0, pB1, l_reg, pa0, pa1, pa2, pa3); SBAR();
    pv_d0(o, vb0 + bp * V_BYTES, pa0, pa1, pa2, pa3);
    }
#undef KROW0
#undef DMA
#undef VMW0
#undef STEP
}
__device__ __forceinline__ void row_recip(float l_reg, float (&rli)[16], LAS float* li, int r32, int hi) {
    { auto rr = __builtin_amdgcn_permlane32_swap(__float_as_uint(l_reg), __float_as_uint(l_reg), false, false);
      l_reg = __uint_as_float(rr[0]) + __uint_as_float(rr[1]); }
    if (hi == 0) li[r32] = l_reg;
    asm volatile("s_waitcnt lgkmcnt(0)" ::: "memory");
#pragma unroll
    for (int r = 0; r < 16; ++r) rli[r] = __builtin_amdgcn_rcpf(li[crow(r, hi)]);
    asm volatile("s_waitcnt lgkmcnt(0)" ::: "memory");
}
}

struct AttnBufs { const bf16_t *QA, *KA, *VA, *QB, *KB, *VB, *QC, *KC, *VC, *GATE; bf16_t* BR; float* SCR; const float* lamv; const float* subln; float lam_init; };

template <bool SUBLN>
__device__ __forceinline__ void attn_out(const AttnBufs& T, f32x16 (&o)[4], int type, int h, size_t orow0, LAS char* lds, int wid, int lane, int r32, int hi) {
    const int rr = lane >> 5, c4 = (lane & 31) * 4;
    const int col = type * 1024 + h * 128 + c4;
    const bf16_t* gp = T.GATE + (orow0 + rr) * 3072 + col; bf16_t* op = T.BR + (orow0 + rr) * 3072 + col;
    u32x2 gg[16];
#pragma unroll
    for (int i = 0; i < 16; ++i) gg[i] = *(const u32x2*)(gp + (size_t)i * 2 * 3072);
    __syncthreads();
    LAS float* stg = (LAS float*)(lds + wid * 16896);
#pragma unroll
    for (int d0 = 0; d0 < 4; ++d0)
#pragma unroll
        for (int r = 0; r < 16; ++r) stg[att::crow(r, hi) * 132 + d0 * 32 + r32] = o[d0][r];
    asm volatile("s_waitcnt lgkmcnt(0)" ::: "memory");
    f32x4 wsub = {1.f, 1.f, 1.f, 1.f};
    if (SUBLN) { wsub = *(const f32x4*)(T.subln + c4) * (1.f - T.lam_init); }
#pragma unroll
    for (int i = 0; i < 16; ++i) {
        f32x4 v = *(const LAS f32x4*)(stg + (2 * i + rr) * 132 + c4);
        if (SUBLN) {
            float s = (v[0] * v[0] + v[1] * v[1]) + (v[2] * v[2] + v[3] * v[3]);
            s += __shfl_xor(s, 1); s += __shfl_xor(s, 2); s += __shfl_xor(s, 4); s += __shfl_xor(s, 8); s += __shfl_xor(s, 16);
            v = v * (rsqrtf(s * (1.f / 128.f) + EPS)) * wsub;
        }
        u32x2 w; w.x = cvt_pk_bf16(v[0] * bf2f(gg[i].x & 0xffffu), v[1] * bf2f(gg[i].x >> 16)); w.y = cvt_pk_bf16(v[2] * bf2f(gg[i].y & 0xffffu), v[3] * bf2f(gg[i].y >> 16));
        *(u32x2*)(op + (size_t)i * 2 * 3072) = w;
    }
}

__device__ __forceinline__ void attn_item(const AttnBufs& T, int type, int b, int h, int qrow0, int NT, LAS char* lds, int tid_) {
    asm volatile("" : "+v"(tid_));
    const int tid = tid_, wid = __builtin_amdgcn_readfirstlane(tid >> 6), lane = tid & 63, r32 = lane & 31, hi = lane >> 5;
    const int rowc = MLAT + b * CTXL, rowl = b * SEQ;
    LAS float* li = (LAS float*)(lds + att::LI_OFF) + wid * 64;
    constexpr float LOG2E = 1.4426950408889634f;
    const size_t orow0 = (size_t)qrow0 + wid * 32;
    if (type == 0 && (MK_ATYPE & 1)) {
        f32x16 o[4]; float l_reg; float rli[16];
        att::attn_pass<128, ATT_DBL>(T.QA + (size_t)qrow0 * 1024 + h * 128, 1024, T.KA + (h >> 2) * 128, 256, T.VA + (h >> 2) * 128, 256, rowc, rowl, NT,
                            T.lamv[1], o, l_reg, lds, tid);
        att::row_recip(l_reg, rli, li, r32, hi);
#pragma unroll
        for (int d0 = 0; d0 < 4; ++d0)
#pragma unroll
            for (int r = 0; r < 16; ++r) o[d0][r] *= rli[r];
        attn_out<false>(T, o, 0, h, orow0, lds, wid, lane, r32, hi);
    } else if (type == 1 && (MK_ATYPE & 2)) {
        f32x16 o[4]; float l_reg; float rli[16];
        att::attn_pass<192, false>(T.QB + (size_t)qrow0 * 1536 + h * 192, 1536, T.KB + h * 192, 1536, T.VB + h * 128, 1024, rowc, rowl, NT,
                            T.lamv[2], o, l_reg, lds, tid);
        att::row_recip(l_reg, rli, li, r32, hi);
#pragma unroll
        for (int d0 = 0; d0 < 4; ++d0)
#pragma unroll
            for (int r = 0; r < 16; ++r) o[d0][r] *= rli[r];
        attn_out<false>(T, o, 1, h, orow0, lds, wid, lane, r32, hi);
    } else if (MK_ATYPE & 4) {
        f32x16 o[4]; float l_reg; float rli[16];
        att::attn_pass<64, ATT_DBL>(T.QC + (size_t)qrow0 * 1024 + h * 128, 1024, T.KC + h * 128, 1024, T.VC + h * 128, 1024, rowc, rowl, NT,
                           T.lamv[3], o, l_reg, lds, tid);
        att::row_recip(l_reg, rli, li, r32, hi);
        f32x4* scr = (f32x4*)(T.SCR + ((size_t)blockIdx.x * 512 + tid) * 64);
#pragma unroll
        for (int d0 = 0; d0 < 4; ++d0)
#pragma unroll
            for (int q = 0; q < 4; ++q) scr[d0 * 4 + q] = (f32x4){o[d0][q * 4] * rli[q * 4], o[d0][q * 4 + 1] * rli[q * 4 + 1], o[d0][q * 4 + 2] * rli[q * 4 + 2], o[d0][q * 4 + 3] * rli[q * 4 + 3]};
        att::attn_pass<64, ATT_DBL>(T.QC + (size_t)qrow0 * 1024 + h * 128 + 64, 1024, T.KC + h * 128 + 64, 1024, T.VC + h * 128, 1024, rowc, rowl, NT,
                           T.lamv[3], o, l_reg, lds, tid);
        att::row_recip(l_reg, rli, li, r32, hi);
        const float lam = T.lamv[0];
#pragma unroll
        for (int d0 = 0; d0 < 4; ++d0)
#pragma unroll
            for (int q = 0; q < 4; ++q) { const f32x4 a = scr[d0 * 4 + q];
#pragma unroll
                for (int j = 0; j < 4; ++j) o[d0][q * 4 + j] = a[j] - lam * (o[d0][q * 4 + j] * rli[q * 4 + j]); }
        attn_out<true>(T, o, 2, h, orow0, lds, wid, lane, r32, hi);
    }
}

__device__ __forceinline__ void transpose_item(const float* __restrict__ W, int ldw, int k0, int srccol4, const float* __restrict__ kscale,
                                               bf16_t* __restrict__ WT, int ldt, int n0, int kdst0, LAS float* scr, int lane) {
    const int ks = lane >> 4, n4 = (lane & 15) * 4;
#pragma unroll 8
    for (int i = 0; i < 16; ++i) { const int kk = 4 * i + ks;
        f32x4 v = srccol4 >= 0 ? *(const f32x4*)(W + (size_t)(k0 + kk) * ldw + srccol4) : (f32x4){0.f, 0.f, 0.f, 0.f};
        if (kscale) v = v * kscale[k0 + kk];
        LAS float* d = scr + kk * 65 + n4; d[0] = v[0]; d[1] = v[1]; d[2] = v[2]; d[3] = v[3]; }
    asm volatile("s_waitcnt lgkmcnt(0)" ::: "memory");
    const int nn = lane & 7, c = lane >> 3;
#pragma unroll
    for (int j = 0; j < 8; ++j) { const int n = nn + 8 * j; const LAS float* s = scr + (8 * c) * 65 + n;
        u32x4 o; o.x = cvt_pk_bf16(s[0 * 65], s[1 * 65]); o.y = cvt_pk_bf16(s[2 * 65], s[3 * 65]); o.z = cvt_pk_bf16(s[4 * 65], s[5 * 65]); o.w = cvt_pk_bf16(s[6 * 65], s[7 * 65]);
        *(u32x4*)(WT + (size_t)(n0 + n) * ldt + kdst0 + k0 + 8 * c) = o; }
    asm volatile("s_waitcnt lgkmcnt(0)" ::: "memory");
}
__device__ const float INVF32[16] = {1.000000000e+00f, 5.623413324e-01f, 3.162277639e-01f, 1.778279394e-01f, 1.000000015e-01f, 5.623413250e-02f, 3.162277490e-02f, 1.778279431e-02f,
    9.999999776e-03f, 5.623413250e-03f, 3.162277630e-03f, 1.778279431e-03f, 1.000000047e-03f, 5.623413017e-04f, 3.162277571e-04f, 1.778279402e-04f};
__device__ const float INVF64[32] = {1.000000000e+00f, 7.498942614e-01f, 5.623413324e-01f, 4.216965139e-01f, 3.162277639e-01f, 2.371373773e-01f, 1.778279394e-01f, 1.333521307e-01f,
    1.000000015e-01f, 7.498941571e-02f, 5.623413250e-02f, 4.216965288e-02f, 3.162277490e-02f, 2.371373773e-02f, 1.778279431e-02f, 1.333521493e-02f, 9.999999776e-03f, 7.498941850e-03f,
    5.623413250e-03f, 4.216964822e-03f, 3.162277630e-03f, 2.371373586e-03f, 1.778279431e-03f, 1.333521446e-03f, 1.000000047e-03f, 7.498942432e-04f, 5.623413017e-04f, 4.216965172e-04f,
    3.162277571e-04f, 2.371373703e-04f, 1.778279402e-04f, 1.333521504e-04f};
__device__ __forceinline__ void sincos_d(double x, float& s, float& c) {
    const double twopi = 6.283185307179586476925;
    const double k = __builtin_rint(x / twopi), r = x - k * twopi, r2 = r * r;
    double st = r, ct = 1.0, ss = r, cs = 1.0;
    for (int n = 1; n <= 16; ++n) { ct *= -r2 / (double)((2 * n - 1) * (2 * n)); st *= -r2 / (double)((2 * n) * (2 * n + 1)); cs += ct; ss += st; }
    s = (float)ss; c = (float)cs;
}
__device__ __forceinline__ float absmax_n(const float* w, int n) { float m = 0.f; for (int i = 0; i < n; ++i) m = fmaxf(m, fabsf(w[i])); return m; }

typedef unsigned v4u_unused_t;
#define XB_TMO      128
#define XB_XCNT(j)  (256  + 64 * (j))
#define XB_XSUB(j)  (1280 + 64 * (j))
#define XB_XGEN(j)  (2304 + 64 * (j))
#define XB_TOP      3328
#define XB_TOPGEN   3392
#define XCD_BAR_WORDS 3456
#define XB_SPIN_CAP (1u << 18)

__device__ __forceinline__ unsigned xb_ld(unsigned* p)              { return __hip_atomic_load(p, __ATOMIC_RELAXED, __HIP_MEMORY_SCOPE_AGENT); }
__device__ __forceinline__ unsigned xb_add(unsigned* p, unsigned v) { return __hip_atomic_fetch_add(p, v, __ATOMIC_RELAXED, __HIP_MEMORY_SCOPE_AGENT); }
__device__ __forceinline__ unsigned xb_xcc_id() { return (unsigned)__builtin_amdgcn_s_getreg((3 << 11) | 20) & 0xFu; }
#define XB_SPIN(cond, bar) do { unsigned _sp = 0; while (cond) { __builtin_amdgcn_s_sleep(1); \
    if ((++_sp & 255u) == 0u) { if (xb_ld(&(bar)[XB_TMO])) break; if (_sp > XB_SPIN_CAP) { atomicAdd(&(bar)[XB_TMO], 1u); break; } } } } while (0)

struct XcdBarrier {
    unsigned* bar; unsigned x;
    volatile LAS unsigned* st;
};

__device__ __forceinline__ XcdBarrier xcd_barrier_post(unsigned* bar, volatile LAS unsigned* st) {
    XcdBarrier b; b.bar = bar; b.x = xb_xcc_id(); b.st = st;
    if (threadIdx.x == 0) (void)xb_add(&bar[XB_XCNT(b.x)], 1u);
    return b;
}
__device__ __forceinline__ void xcd_barrier_complete(unsigned* bar, unsigned x, unsigned& nloc, unsigned& nx) {
    const unsigned G = gridDim.x * gridDim.y * gridDim.z;
    unsigned sum, cnt, mine, sp = 0u;
    for (;;) {
        sum = 0u; cnt = 0u; mine = 0u;
#pragma unroll
        for (unsigned j = 0; j < 16; ++j) { const unsigned c = xb_ld(&bar[XB_XCNT(j)]); sum += c; cnt += (c > 0u) ? 1u : 0u; mine = (j == x) ? c : mine; }
        if (sum == G) break;
        __builtin_amdgcn_s_sleep(1);
        if ((++sp & 255u) == 0u) { if (xb_ld(&bar[XB_TMO])) break; if (sp > XB_SPIN_CAP) { atomicAdd(&bar[XB_TMO], 1u); break; } }
    }
    nloc = mine > 0u ? mine : 1u; nx = cnt > 0u ? cnt : 1u;
}

__device__ __forceinline__ void xcd_barrier(const XcdBarrier& b) {
    asm volatile("s_waitcnt vmcnt(0)" ::: "memory");
    __syncthreads();
    if (threadIdx.x == 0) {
        unsigned* bar = b.bar;
        __builtin_amdgcn_s_waitcnt(0);
        unsigned nloc = b.st[0], nx = b.st[1];
        if (nloc == 0u) { xcd_barrier_complete(bar, b.x, nloc, nx); b.st[0] = nloc; b.st[1] = nx; }
        const unsigned old = xb_add(&bar[XB_XSUB(b.x)], 1u);
        const unsigned gen = old / nloc;
        if (old + 1u == (gen + 1u) * nloc) {
            __builtin_amdgcn_fence(__ATOMIC_RELEASE, "agent");
            asm volatile("s_waitcnt vmcnt(0)" ::: "memory");
            const unsigned og = xb_add(&bar[XB_TOP], 1u);
            const unsigned tg = og / nx;
            if (og + 1u == (tg + 1u) * nx) xb_add(&bar[XB_TOPGEN], 1u);
            else XB_SPIN(xb_ld(&bar[XB_TOPGEN]) == tg, bar);
            __builtin_amdgcn_fence(__ATOMIC_ACQUIRE, "agent");
            xb_add(&bar[XB_XGEN(b.x)], 1u);
            asm volatile("s_waitcnt vmcnt(0)" ::: "memory");
        } else {
            XB_SPIN(xb_ld(&bar[XB_XGEN(b.x)]) == gen, bar);
            __builtin_amdgcn_fence(__ATOMIC_ACQUIRE, "agent");
            asm volatile("s_waitcnt vmcnt(0)" ::: "memory");
        }
    }
    __syncthreads();
}

__device__ __forceinline__ void p1_row(int row, const float* __restrict__ xsrc, const float* __restrict__ csrc, const float* __restrict__ modl, const float* __restrict__ nw,
                                       bf16_t* __restrict__ H, int lane) {
    const bool lat = row < MLAT; const int mi = lat ? (row >> 12) : 4;
    const f32x4* xr = (const f32x4*)(lat ? xsrc + (size_t)row * DM : csrc + (size_t)(row - MLAT) * DM) + lane;
    f32x4 v[8]; float s = 0.f;
#pragma unroll
    for (int j = 0; j < 8; ++j) { v[j] = xr[64 * j]; s += (v[j][0] * v[j][0] + v[j][1] * v[j][1]) + (v[j][2] * v[j][2] + v[j][3] * v[j][3]); }
    const float rinv = rsqrtf(wave_sum(s) * (1.f / DM) + EPS);
    const f32x4* sh = (const f32x4*)(modl + mi * 6144) + lane; const f32x4* scl = (const f32x4*)(modl + mi * 6144 + DM) + lane; const f32x4* nwp = (const f32x4*)nw + lane;
    u32x2* o8 = (u32x2*)(H + (size_t)row * DM) + lane;
#pragma unroll
    for (int j = 0; j < 8; ++j) { const f32x4 y = v[j] * rinv * nwp[64 * j] * (scl[64 * j] + 1.f) + sh[64 * j];
        u32x2 w; w.x = cvt_pk_bf16(y[0], y[1]); w.y = cvt_pk_bf16(y[2], y[3]); o8[64 * j] = w; }
}

__device__ __forceinline__ void p1_row2(int rowA, int rowB, const float* __restrict__ xsrc, const float* __restrict__ csrc, const float* __restrict__ modl,
                                        const float* __restrict__ nw, bf16_t* __restrict__ H, int lane) {
    if (rowB < 0) { p1_row(rowA, xsrc, csrc, modl, nw, H, lane); return; }
    const bool latA = rowA < MLAT, latB = rowB < MLAT; const int miA = latA ? (rowA >> 12) : 4, miB = latB ? (rowB >> 12) : 4;
    const f32x4* xa = (const f32x4*)(latA ? xsrc + (size_t)rowA * DM : csrc + (size_t)(rowA - MLAT) * DM) + lane;
    const f32x4* xb = (const f32x4*)(latB ? xsrc + (size_t)rowB * DM : csrc + (size_t)(rowB - MLAT) * DM) + lane;
    f32x4 va[8], vb[8]; float sa = 0.f, sb = 0.f;
#pragma unroll
    for (int j = 0; j < 8; ++j) { va[j] = xa[64 * j]; vb[j] = xb[64 * j]; }
#pragma unroll
    for (int j = 0; j < 8; ++j) { sa += (va[j][0] * va[j][0] + va[j][1] * va[j][1]) + (va[j][2] * va[j][2] + va[j][3] * va[j][3]);
                                  sb += (vb[j][0] * vb[j][0] + vb[j][1] * vb[j][1]) + (vb[j][2] * vb[j][2] + vb[j][3] * vb[j][3]); }
    const float ra = rsqrtf(wave_sum(sa) * (1.f / DM) + EPS), rb = rsqrtf(wave_sum(sb) * (1.f / DM) + EPS);
    const f32x4* nwp = (const f32x4*)nw + lane;
    const f32x4* sha = (const f32x4*)(modl + miA * 6144) + lane; const f32x4* sca = (const f32x4*)(modl + miA * 6144 + DM) + lane;
    const f32x4* shb = (const f32x4*)(modl + miB * 6144) + lane; const f32x4* scb = (const f32x4*)(modl + miB * 6144 + DM) + lane;
    u32x2* oa = (u32x2*)(H + (size_t)rowA * DM) + lane; u32x2* ob = (u32x2*)(H + (size_t)rowB * DM) + lane;
#pragma unroll
    for (int j = 0; j < 8; ++j) { const f32x4 w4 = nwp[64 * j];
        const f32x4 ya = va[j] * ra * w4 * (sca[64 * j] + 1.f) + sha[64 * j], yb = vb[j] * rb * w4 * (scb[64 * j] + 1.f) + shb[64 * j];
        u32x2 wa, wb; wa.x = cvt_pk_bf16(ya[0], ya[1]); wa.y = cvt_pk_bf16(ya[2], ya[3]); wb.x = cvt_pk_bf16(yb[0], yb[1]); wb.y = cvt_pk_bf16(yb[2], yb[3]);
        oa[64 * j] = wa; ob[64 * j] = wb; }
}

struct Args { const float* in[29]; float* out; unsigned char* ws; int ph_lo, ph_hi, coop, pad; };

__global__ void __launch_bounds__(512, 2) mega_fwd(Args args) {
    extern __shared__ __attribute__((aligned(16))) unsigned char lds_raw[];
    LAS unsigned char* lds = (LAS unsigned char*)lds_raw;
    const int G = gridDim.x;
    unsigned char* ws = args.ws;
    float* MOD = (float*)(ws + WS_MOD);
    float* TC64 = (float*)(ws + WS_TC64); float* TS64 = (float*)(ws + WS_TS64); float* TC128 = (float*)(ws + WS_TC128); float* TS128 = (float*)(ws + WS_TS128);
    float* LAM = (float*)(ws + WS_LAM);
    bf16_t* WIN = (bf16_t*)(ws + WS_WIN); bf16_t* WUP = (bf16_t*)(ws + WS_WUP); bf16_t* WBR = (bf16_t*)(ws + WS_WBR); bf16_t* WOUT = (bf16_t*)(ws + WS_WOUT);
    bf16_t* H = (bf16_t*)(ws + WS_H); bf16_t* QA = (bf16_t*)(ws + WS_QA); bf16_t* KA = (bf16_t*)(ws + WS_KA); bf16_t* VA = (bf16_t*)(ws + WS_VA);
    bf16_t* QB = (bf16_t*)(ws + WS_QB); bf16_t* KB = (bf16_t*)(ws + WS_KB); bf16_t* CKV = (bf16_t*)(ws + WS_CKV); bf16_t* VB = (bf16_t*)(ws + WS_VB);
    bf16_t* QC = (bf16_t*)(ws + WS_QC); bf16_t* KC = (bf16_t*)(ws + WS_KC); bf16_t* VC = (bf16_t*)(ws + WS_VC);
    bf16_t* GATE = (bf16_t*)(ws + WS_GATE); bf16_t* MRG = (bf16_t*)(ws + WS_MRG); bf16_t* BR = (bf16_t*)(ws + WS_BR); bf16_t* Y = (bf16_t*)(ws + WS_Y);
    float* SS = (float*)(ws + WS_SS); float* CTXW = (float*)(ws + WS_CTXW); float* SCR = (float*)(ws + WS_SCR);
    LAS float* xch = (LAS float*)(lds + XCH_OFF);
    volatile LAS unsigned* bst = (volatile LAS unsigned*)(lds + XCH_OFF + 4096);
    if (threadIdx.x < 2) bst[threadIdx.x] = 0u;
    __syncthreads();
    XcdBarrier bar = xcd_barrier_post((unsigned*)(ws + WS_BAR), bst);

    for (int ph = args.ph_lo; ph < args.ph_hi; ++ph) {
        int bx = blockIdx.x; asm volatile("" : "+s"(bx));
        const int vcu = (G % 8 == 0) ? (bx % 8) * (G / 8) + bx / 8 : bx;
        int tid = threadIdx.x; asm volatile("" : "+v"(tid));
        const int lane = tid & 63, wave = __builtin_amdgcn_readfirstlane(tid >> 6);
        if (ph == 0 && (MK_MASK & 1)) {
            {
                LAS float* sc = (LAS float*)lds;
                LAS float* red = (LAS float*)(lds + 65536);
                for (int i = tid; i < 5 * DM; i += 512) { const float v = i < 4 * DM ? args.in[1][i] : args.in[3][i - 4 * DM]; sc[i] = silu_f(v); }
                __syncthreads();
                for (int it = bx; it < DEPTH * 96; it += G) {
                    const int l = it / 96, n0 = (it % 96) * 64;
                    const float* W = args.in[5] + (size_t)l * DM * 6144 + n0 + lane;
                    float a0 = 0.f, a1 = 0.f, a2 = 0.f, a3 = 0.f, a4 = 0.f;
                    const int kb = wave * 256;
#pragma unroll 8
                    for (int k = 0; k < 256; ++k) { const float wv = W[(size_t)(kb + k) * 6144];
                        a0 += sc[kb + k] * wv; a1 += sc[DM + kb + k] * wv; a2 += sc[2 * DM + kb + k] * wv; a3 += sc[3 * DM + kb + k] * wv; a4 += sc[4 * DM + kb + k] * wv; }
                    red[(wave * 5 + 0) * 64 + lane] = a0; red[(wave * 5 + 1) * 64 + lane] = a1; red[(wave * 5 + 2) * 64 + lane] = a2; red[(wave * 5 + 3) * 64 + lane] = a3; red[(wave * 5 + 4) * 64 + lane] = a4;
                    __syncthreads();
                    if (tid < 320) { const int i = tid >> 6; float s = 0.f;
                        for (int w8 = 0; w8 < 8; ++w8) s += red[(w8 * 5 + i) * 64 + lane];
                        MOD[((size_t)l * 5 + i) * 6144 + n0 + lane] = s + args.in[6][(size_t)l * 6144 + n0 + lane]; }
                    __syncthreads();
                }
            }
            if (bx == 1 % G) {
                for (int i = tid; i < 64 * 16; i += 512) { const int pos = i >> 4, f = i & 15; const float ang = (float)pos * INVF32[f]; float s, c; sincos_d((double)ang, s, c); TC64[i] = c; TS64[i] = s; }
                for (int i = tid; i < 64 * 32; i += 512) { const int pos = i >> 5, f = i & 31; const float ang = (float)pos * INVF64[f]; float s, c; sincos_d((double)ang, s, c); TC128[i] = c; TS128[i] = s; }
            }
            if (bx == 2 % G && tid < DEPTH) {
                const int l = tid;
                float s1 = 0.f, s2 = 0.f;
                for (int i = 0; i < 64; ++i) { s1 += args.in[20][l * 64 + i] * args.in[21][l * 64 + i]; s2 += args.in[22][l * 64 + i] * args.in[23][l * 64 + i]; }
                const float lam_init = 0.8f - 0.6f * expf(-0.3f * (float)l);
                LAM[l * 4 + 0] = expf(s1) - expf(s2) + lam_init;
                const float mAq = absmax_n(args.in[9] + l * 128, 128), mAk = absmax_n(args.in[10] + l * 128, 128);
                const float mBqn = absmax_n(args.in[11] + l * 128, 128), mBqr = absmax_n(args.in[12] + l * 64, 64), mBkn = absmax_n(args.in[16] + l * 128, 128), mBkr = absmax_n(args.in[17] + l * 64, 64);
                const float mCq = absmax_n(args.in[18] + l * 64, 64), mCk = absmax_n(args.in[19] + l * 64, 64);
                const float L2E = 1.4426950408889634f;
                LAM[l * 4 + 1] = -(sqrtf(128.f) * mAq * mAk) * L2E;
                LAM[l * 4 + 2] = -(sqrtf(128.f * mBqn * mBqn + 64.f * mBqr * mBqr) * sqrtf(128.f * mBkn * mBkn + 64.f * mBkr * mBkr) * 0.07216878364870323f) * L2E;
                LAM[l * 4 + 3] = -(8.f * mCq * mCk) * L2E;
            }
            __syncthreads();
            {
                LAS float* scr = (LAS float*)(lds + wave * 16640);
                const int gw = vcu * 8 + wave, NGW = G * 8;
                constexpr int I_IN = 32 * (NIN / 64), I_UP = 8 * 32, I_BR = 3 * 16 * 32, I_OUT = 32 * 32, I_L = I_IN + I_UP + I_BR + I_OUT;
                const int n4 = (lane & 15) * 4;
                for (int it = gw; it < DEPTH * I_L; it += NGW) {
                    const int l = it / I_L; int r = it % I_L;
                    if (r < I_IN) { const int nb = r % (NIN / 64), kb = r / (NIN / 64); const int n0 = nb * 64;
                        transpose_item(args.in[7] + (size_t)l * DM * INC, INC, kb * 64, in_src_col(n0 + n4), nullptr, WIN + (size_t)l * NIN * DM, DM, n0, 0, scr, lane); continue; }
                    r -= I_IN;
                    if (r < I_UP) { const int nb = r % 32, kb = r / 32; const int n0 = nb * 64; const int sc_ = up_src_col(n0 + n4);
                        const float* W = (sc_ < 1024 ? args.in[14] : args.in[15]) + (size_t)l * 512 * 1024;
                        transpose_item(W, 1024, kb * 64, sc_ & 1023, args.in[13] + l * 512, WUP + (size_t)l * 2048 * 512, 512, n0, 0, scr, lane); continue; }
                    r -= I_UP;
                    if (r < I_BR) { const int br = r / (16 * 32), r2 = r % (16 * 32); const int nb = r2 % 32, kb = r2 / 32; const int n0 = nb * 64;
                        transpose_item(args.in[25 + br] + (size_t)l * 1024 * DM, DM, kb * 64, n0 + n4, nullptr, WBR + (size_t)l * 2048 * 3072, 3072, n0, br * 1024, scr, lane); continue; }
                    r -= I_BR;
                    { const int nb = r % 32, kb = r / 32; const int n0 = nb * 64;
                      transpose_item(args.in[28] + (size_t)l * DM * DM, DM, kb * 64, n0 + n4, nullptr, WOUT + (size_t)l * DM * DM, DM, n0, 0, scr, lane); }
                }
            }
        } else {
            const int l = (ph == 1) ? 0 : (ph - 2) / 3, st_ = (ph == 1) ? 0 : 1 + (ph - 2) % 3, st = (st_ >= 2) ? st_ + 1 : st_;
            const float* xsrc = (l == 0) ? args.in[0] : args.out;
            const float* csrc = (l == 0) ? args.in[2] : CTXW;
            const float* modl = MOD + (size_t)l * 5 * 6144;
            const int Mrows = (l == DEPTH - 1) ? MLAT : MTOT;
            if (st == 0 && (MK_MASK & 2)) {
                const float* nw = args.in[4] + (size_t)l * DM;
                for (int row = bx * 8 + wave; row < MTOT; row += G * 16) { const int rb = row + G * 8; p1_row2(row, rb < MTOT ? rb : -1, xsrc, csrc, modl, nw, H, lane); }
            } else if (st == 1 && (MK_MASK & 4)) {
                pg8::Gemm g{H, WIN + (size_t)l * NIN * DM, MTOT, NIN, DM};
                EpiIn E{QA, KA, VA, QB, KB, CKV, QC, KC, VC, GATE, MRG, SS,
                        args.in[9] + l * 128, args.in[10] + l * 128, args.in[11] + l * 128, args.in[12] + l * 64, args.in[17] + l * 64, args.in[18] + l * 64, args.in[19] + l * 64,
                        args.in[8] + (size_t)l * 6144, TC64, TS64, TC128, TS128, xch};
                const bool trim = (l == DEPTH - 1) && (G == 256);
                for (int part = 0; part < 2; ++part) {
                    pg8::StaticOrder S;
                    if (!trim) { if (part) break; S.init(MTOT, NIN, G, bx); }
                    else if (part == 0) S.init(MLAT, NIN, G, bx);
                    else { if (!(bx >= 192 && bx < 244)) break; const int k = bx - 192, j = k % 13;
                           const int pn = (j < 2) ? 4 + j : (j < 5 ? 10 + j : 14 + j);
                           S.init_one(64 + k / 13, pn); }
                    { int t2 = threadIdx.x; asm volatile("" : "+v"(t2)); pg8::gemm_phase<EpiIn>(lds, g, S, E, t2); }
                }
            } else if (st == 3 && (MK_MASK & 16)) {
                unsigned* UPC = (unsigned*)(ws + WS_CNT) + (size_t)(2 * DEPTH * 68 + l) * 64;
                const bool merged = (G == 256) && args.coop;
                {
                    pg8::Gemm g{CKV, WUP + (size_t)l * 2048 * 512, MTOT, 2048, 512}; pg8::StaticOrder S; S.init(MTOT, 2048, G, bx);
                    EpiUp E{KB, VB, SS, args.in[16] + l * 128, xch};
                    pg8::gemm_phase<EpiUp>(lds, g, S, E, tid);
                    if (merged) {
                        if (threadIdx.x == 0) {
                            __builtin_amdgcn_fence(__ATOMIC_RELEASE, "agent");
                            asm volatile("s_waitcnt vmcnt(0)" ::: "memory");
                            const unsigned n = (bx < 544) ? (unsigned)((544 - 1 - bx) / G + 1) : 0u;
                            __hip_atomic_fetch_add(UPC, n, __ATOMIC_RELAXED, __HIP_MEMORY_SCOPE_AGENT);
                        }
                    } else if (args.coop) xcd_barrier(bar);
                }
                AttnBufs T{QA, KA, VA, QB, KB, VB, QC, KC, VC, GATE, BR, SCR, LAM + l * 4, args.in[24] + l * 128, 0.8f - 0.6f * expf(-0.3f * (float)l)};
                const int nctx = (l < DEPTH - 1) ? 96 : 0;
                for (int k = 0;; ++k) {
                    int type, b, h, qrow0, NT;
                    if (G == 256) {
                        if (k == 4 && merged) {
                            if (threadIdx.x == 0) { unsigned sp = 0;
                                while (__hip_atomic_load(UPC, __ATOMIC_RELAXED, __HIP_MEMORY_SCOPE_AGENT) < 544u) { __builtin_amdgcn_s_sleep(1); if (++sp > (1u << 22)) break; }
                                __builtin_amdgcn_fence(__ATOMIC_ACQUIRE, "agent");
                                asm volatile("s_waitcnt vmcnt(0)" ::: "memory"); }
                            __syncthreads();
                        }
                        if (k < 6) { const int id = (k & 1) * 256 + vcu; type = (k < 2) ? 0 : (k < 4 ? 2 : 1); b = id >> 7; h = (id >> 4) & 7; qrow0 = b * SEQ + (id & 15) * 256; NT = 68; }
                        else if (k == 6 && bx >= 256 - nctx) { const int c = bx - (256 - nctx); type = c >> 5; b = (c >> 3) & 3; h = c & 7; qrow0 = MLAT + b * CTXL; NT = 4; }
                        else break;
                    } else {
                        const int it = bx + k * G; if (it >= 1536 + nctx) break;
                        if (it < 1536) { const int id = it & 511; type = it >> 9; b = id >> 7; h = (id >> 4) & 7; qrow0 = b * SEQ + (id & 15) * 256; NT = 68; }
                        else { const int c = it - 1536; type = c >> 5; b = (c >> 3) & 3; h = c & 7; qrow0 = MLAT + b * CTXL; NT = 4; }
                    }
                    attn_item(T, type, b, h, qrow0, NT, (LAS char*)lds, tid);
                }
                __syncthreads();
            } else {
                unsigned* CNT = (unsigned*)(ws + WS_CNT) + (size_t)l * 68 * 64;
                const bool merged = (G == 256) && args.coop;
                const bool ctxl = l < DEPTH - 1;
                pg8::Gemm g3{BR, WBR + (size_t)l * 2048 * 3072, Mrows, 2048, 3072}; EpiBr E3{MRG, Y};
                pg8::Gemm g4{Y, WOUT + (size_t)l * DM * DM, Mrows, DM, DM}; EpiOut E4{xsrc, csrc, args.out, CTXW, modl};
                for (int part = 0; part < 2; ++part) {
                    pg8::StaticOrder S;
                    if (!merged) { if (part) break; S.init(Mrows, 2048, G, bx); }
                    else if (part == 0) S.init(MLAT, 2048, G, bx);
                    else { if (!(ctxl && bx < 32)) break; S.init_one(64 + (bx >> 3), bx & 7); }
                    { int t2 = threadIdx.x; asm volatile("" : "+v"(t2)); pg8::gemm_phase<EpiBr>(lds, g3, S, E3, t2); }
                    if (merged && threadIdx.x == 0) {
                        __builtin_amdgcn_fence(__ATOMIC_RELEASE, "agent");
                        asm volatile("s_waitcnt vmcnt(0)" ::: "memory");
                        pg8::Unit u; for (int i = 0; S.next(i, u); ++i) __hip_atomic_fetch_add(&CNT[u.pm * 64], 1u, __ATOMIC_RELAXED, __HIP_MEMORY_SCOPE_AGENT);
                    }
                }
                if (!merged && args.coop) xcd_barrier(bar);
                for (int part = 0; part < 3; ++part) {
                    pg8::StaticOrder S;
                    if (!merged) { if (part) break; S.init(Mrows, DM, G, bx); }
                    else if (part == 0) S.init(MLAT, DM, G, bx, 0, (ctxl && bx < 32) ? 1 : 2);
                    else if (part == 1) { if (!(ctxl && bx >= 32 && bx < 64)) continue; S.init_one(64 + ((bx - 32) >> 3), bx & 7); }
                    else { if (!(ctxl && bx >= 64 && bx < 96)) break; S.init(MLAT, DM, G, bx - 64, 1, 1); }
                    if (merged) {
                        if (threadIdx.x == 0) {
                            pg8::Unit u;
                            for (int i = 0; S.next(i, u); ++i) { unsigned sp = 0;
                                while (__hip_atomic_load(&CNT[u.pm * 64], __ATOMIC_RELAXED, __HIP_MEMORY_SCOPE_AGENT) < 8u) { __builtin_amdgcn_s_sleep(1); if (++sp > (1u << 22)) break; } }
                            __builtin_amdgcn_fence(__ATOMIC_ACQUIRE, "agent");
                            asm volatile("s_waitcnt vmcnt(0)" ::: "memory");
                        }
                        __syncthreads();
                    }
                    { int t2 = threadIdx.x; asm volatile("" : "+v"(t2)); pg8::gemm_phase<EpiOut>(lds, g4, S, E4, t2); }
                    if (merged && ctxl && threadIdx.x == 0) {
                        __builtin_amdgcn_fence(__ATOMIC_RELEASE, "agent");
                        asm volatile("s_waitcnt vmcnt(0)" ::: "memory");
                        pg8::Unit u; for (int i = 0; S.next(i, u); ++i) __hip_atomic_fetch_add(&CNT[(DEPTH * 68 + u.pm) * 64], 1u, __ATOMIC_RELAXED, __HIP_MEMORY_SCOPE_AGENT);
                    }
                }
                if (l < DEPTH - 1) {
                    const float* nw1 = args.in[4] + (size_t)(l + 1) * DM; const float* mod1 = MOD + (size_t)(l + 1) * 5 * 6144;
                    int t3 = threadIdx.x; asm volatile("" : "+v"(t3));
                    const int lane3 = t3 & 63, wave3 = __builtin_amdgcn_readfirstlane(t3 >> 6);
                    if (merged) {
                        const int r0 = 68 * bx;
                        if (threadIdx.x == 0) {
                            for (int pm = r0 >> 8; pm <= (r0 + 67) >> 8; ++pm) { unsigned sp = 0;
                                while (__hip_atomic_load(&CNT[(DEPTH * 68 + pm) * 64], __ATOMIC_RELAXED, __HIP_MEMORY_SCOPE_AGENT) < 8u) { __builtin_amdgcn_s_sleep(1); if (++sp > (1u << 22)) break; } }
                            __builtin_amdgcn_fence(__ATOMIC_ACQUIRE, "agent");
                            asm volatile("s_waitcnt vmcnt(0)" ::: "memory");
                        }
                        __syncthreads();
                        for (int row = r0 + wave3; row < r0 + 68; row += 16) { const int rb = row + 8; p1_row2(row, rb < r0 + 68 ? rb : -1, args.out, CTXW, mod1, nw1, H, lane3); }
                    } else {
                        if (args.coop) xcd_barrier(bar);
                        for (int row = bx * 8 + wave3; row < MTOT; row += G * 16) { const int rb = row + G * 8; p1_row2(row, rb < MTOT ? rb : -1, args.out, CTXW, mod1, nw1, H, lane3); }
                    }
                }
            }
        }
        if (ph + 1 < args.ph_hi) { if (args.coop) { if (ph == 0) cg::this_grid().sync(); else xcd_barrier(bar); } }
    }
}

extern "C" void kernel_launch(void* const* d_in, const int* in_sizes, int n_in, void* d_out, int out_size, void* d_ws, size_t ws_size, hipStream_t stream) {
    static int grid = 0;
    if (grid == 0) {
        if (n_in != 29 || in_sizes[0] != MLAT * DM || out_size != MLAT * DM || ws_size < WS_END) {
            fprintf(stderr, "kernel_launch: unexpected shapes: n_in %d in0 %d out %d ws %zu (need %zu)\n", n_in, n_in > 0 ? in_sizes[0] : -1, out_size, ws_size, (size_t)WS_END); grid = -1; return; }
        int dev = 0, cus = 0, per_cu = 0;
        if (hipGetDevice(&dev) != hipSuccess || hipDeviceGetAttribute(&cus, hipDeviceAttributeMultiprocessorCount, dev) != hipSuccess) { grid = -1; return; }
        if (hipFuncSetAttribute((const void*)mega_fwd, hipFuncAttributeMaxDynamicSharedMemorySize, LDS_BYTES) != hipSuccess) { fprintf(stderr, "kernel_launch: hipFuncSetAttribute failed\n"); grid = -1; return; }
        if (hipOccupancyMaxActiveBlocksPerMultiprocessor(&per_cu, (const void*)mega_fwd, 512, LDS_BYTES) != hipSuccess || per_cu < 1) { fprintf(stderr, "kernel_launch: occupancy query gives %d\n", per_cu); per_cu = 1; }
        (void)hipGetLastError();
        grid = cus * 1;
    }
    if (grid < 0) return;
    Args a{};
    for (int i = 0; i < 29; ++i) a.in[i] = (const float*)d_in[i];
    a.out = (float*)d_out; a.ws = (unsigned char*)d_ws;
#if MK_COOP
    if (hipMemsetAsync((char*)d_ws + WS_BAR, 0, 16384 + CNT_BYTES, stream) != hipSuccess) { fprintf(stderr, "kernel_launch: memset of the barrier words failed\n"); return; }
    a.ph_lo = 0; a.ph_hi = NPH; a.coop = 1;
    void* kargs[] = {&a};
    hipError_t e = hipLaunchCooperativeKernel((const void*)mega_fwd, dim3(grid), dim3(512), kargs, LDS_BYTES, stream);
    if (e != hipSuccess) fprintf(stderr, "kernel_launch: cooperative launch failed: %s (grid %d)\n", hipGetErrorString(e), grid);
#else
    for (int ph = 0; ph < NPH; ++ph) {
        a.ph_lo = ph; a.ph_hi = ph + 1; a.coop = 0;
        hipLaunchKernelGGL(mega_fwd, dim3(grid), dim3(512), LDS_BYTES, stream, a);
    }
    const hipError_t le = hipPeekAtLastError();
    if (le != hipSuccess) fprintf(stderr, "kernel_launch: launch failed: %s\n", hipGetErrorName(le));
#endif
}
```

```cpp
#include <hip/hip_runtime.h>
#include <hip/hip_cooperative_groups.h>
#include <cstdio>
#include <cstdint>
namespace cg = cooperative_groups;

#ifndef MK_MASK
#define MK_MASK 127
#endif
#ifndef MK_ATYPE
#define MK_ATYPE 7
#endif
#ifndef MK_G1T
#define MK_G1T 127
#endif
#ifndef ATT_SD_A
#define ATT_SD_A 2
#endif
#ifndef ATT_SD_B
#define ATT_SD_B 1
#endif
#ifndef ATT_SD_C
#define ATT_SD_C 2
#endif
#ifndef ATT_DBL_B
#define ATT_DBL_B true
#endif
#ifndef ATT_DBL
#define ATT_DBL false
#endif
#ifndef QKT_GRP
#define QKT_GRP 0
#endif
#ifndef MK_COOP
#define MK_COOP 1
#endif

#define LAS __attribute__((address_space(3)))
typedef unsigned short bf16_t;
typedef short bf16x8 __attribute__((ext_vector_type(8)));
typedef short s16x4 __attribute__((ext_vector_type(4)));
typedef float f32x4 __attribute__((ext_vector_type(4)));
typedef float f32x16 __attribute__((ext_vector_type(16)));
typedef unsigned u32x4 __attribute__((ext_vector_type(4)));
typedef unsigned u32x2 __attribute__((ext_vector_type(2)));

constexpr int DM = 2048, NBATCH = 4, SEQ = 4096, CTXL = 256, DEPTH = 4;
constexpr int MLAT = NBATCH * SEQ, MCTX = NBATCH * CTXL, MTOT = MLAT + MCTX;
constexpr int INC = 15936, NIN = 16128;
constexpr float EPS = 1e-6f;
#ifndef MK_REP_ST
#define MK_REP_ST -1
#endif
constexpr int PPL = 5;
constexpr int NPH = 2 + 3 * DEPTH;

constexpr size_t alignup(size_t x) { return (x + 255) / 256 * 256; }
constexpr size_t WS_MOD = 0;
constexpr size_t WS_TC64 = WS_MOD + alignup((size_t)DEPTH * 5 * 6144 * 4);
constexpr size_t WS_TS64 = WS_TC64 + 4096, WS_TC128 = WS_TS64 + 4096, WS_TS128 = WS_TC128 + 8192;
constexpr size_t WS_LAM = WS_TS128 + 8192;
constexpr size_t WS_BAR = WS_LAM + 256;
constexpr size_t WS_CNT = WS_BAR + 16384;
constexpr size_t CNT_BYTES = (size_t)(2 * DEPTH * 68 + DEPTH) * 256;
constexpr size_t WS_WIN = WS_CNT + CNT_BYTES;
constexpr size_t WS_WUP = WS_WIN + (size_t)DEPTH * NIN * DM * 2;
constexpr size_t WS_WBR = WS_WUP + (size_t)DEPTH * 2048 * 512 * 2;
constexpr size_t WS_WOUT = WS_WBR + (size_t)DEPTH * 2048 * 3072 * 2;
constexpr size_t WS_H = WS_WOUT + (size_t)DEPTH * 2048 * 2048 * 2;
constexpr size_t WS_QA = WS_H + (size_t)MTOT * 2048 * 2;
constexpr size_t WS_KA = WS_QA + (size_t)MTOT * 1024 * 2;
constexpr size_t WS_VA = WS_KA + (size_t)MTOT * 256 * 2;
constexpr size_t WS_QB = WS_VA + (size_t)MTOT * 256 * 2;
constexpr size_t WS_KB = WS_QB + (size_t)MTOT * 1536 * 2;
constexpr size_t WS_CKV = WS_KB + (size_t)MTOT * 1536 * 2;
constexpr size_t WS_VB = WS_CKV + (size_t)MTOT * 512 * 2;
constexpr size_t WS_QC = WS_VB + (size_t)MTOT * 1024 * 2;
constexpr size_t WS_KC = WS_QC + (size_t)MTOT * 1024 * 2;
constexpr size_t WS_VC = WS_KC + (size_t)MTOT * 1024 * 2;
constexpr size_t WS_GATE = WS_VC + (size_t)MTOT * 1024 * 2;
constexpr size_t WS_MRG = WS_GATE + (size_t)MTOT * 3072 * 2;
constexpr size_t WS_BR = WS_MRG + (size_t)MTOT * 6144 * 2;
constexpr size_t WS_Y = WS_BR + (size_t)MTOT * 3072 * 2;
constexpr size_t WS_SS = WS_Y + (size_t)MTOT * 2048 * 2;
constexpr size_t WS_CTXW = WS_SS + (size_t)MTOT * 8 * 4;
constexpr size_t WS_SCR = WS_CTXW + (size_t)MCTX * DM * 4;
constexpr size_t WS_END = WS_SCR + (size_t)256 * 64 * 512 * 4;

constexpr int RING_BYTES = 131072, XCH_OFF = RING_BYTES, LDS_BYTES = 147456;

__device__ __forceinline__ float bf2f(unsigned h) { return __uint_as_float(h << 16); }
__device__ __forceinline__ unsigned cvt_pk_bf16(float lo, float hi) { unsigned r; asm volatile("v_cvt_pk_bf16_f32 %0, %1, %2" : "=v"(r) : "v"(lo), "v"(hi)); return r; }
__device__ __forceinline__ float wave_sum(float v) {
#pragma unroll
    for (int o = 1; o < 64; o <<= 1) v += __shfl_xor(v, o);
    return v;
}
__device__ __forceinline__ float sigm_f(float x) { return __builtin_amdgcn_rcpf(1.f + __builtin_amdgcn_exp2f(-1.4426950408889634f * x)); }
__device__ __forceinline__ float silu_f(float x) { return x * sigm_f(x); }
__device__ __forceinline__ unsigned cvt_pk_bf16_safe(float lo, float hi) { unsigned r; asm volatile("s_nop 1\n\tv_cvt_pk_bf16_f32 %0, %1, %2" : "=v"(r) : "v"(lo), "v"(hi)); return r; }
__device__ __forceinline__ void store8_safe(bf16_t* p, f32x4 a, f32x4 b) {
    u32x4 w; w.x = cvt_pk_bf16_safe(a[0], a[1]); w.y = cvt_pk_bf16_safe(a[2], a[3]); w.z = cvt_pk_bf16_safe(b[0], b[1]); w.w = cvt_pk_bf16_safe(b[2], b[3]);
    *(u32x4*)p = w;
}
__device__ __forceinline__ void store8(bf16_t* p, f32x4 a, f32x4 b) {
    u32x4 w; w.x = cvt_pk_bf16(a[0], a[1]); w.y = cvt_pk_bf16(a[2], a[3]); w.z = cvt_pk_bf16(b[0], b[1]); w.w = cvt_pk_bf16(b[2], b[3]);
    *(u32x4*)p = w;
}

namespace pg8 {
constexpr int BM = 256, BK = 64, HALF = 128, HTB = HALF * BK * 2, NXCD = 8, WGM = 8;
__host__ __device__ __forceinline__ int lds_byte(int r, int c) { const int st = (r >> 4) * 2 + (c >> 5), rr = r & 15, cc = c & 31, ob = rr * 64 + cc * 2; return st * 1024 + (ob ^ (((ob >> 9) & 1) << 5)); }
__host__ __device__ __forceinline__ void stage_rc(int b, int& R, int& C) { const int st = b / 1024, sb = b % 1024, swz = sb ^ (((sb >> 9) & 1) << 5); R = (st >> 1) * 16 + swz / 64; C = (st & 1) * 32 + (swz % 64) / 2; }
__host__ __device__ __forceinline__ int perm32(int rho) { const int n = rho >> 4, i = rho & 15; return 8 * (i >> 2) + 4 * n + (i & 3); }

struct Unit { int pm, pn; };
struct Gemm { const bf16_t* A; const bf16_t* Bt; int M, N, K; };
struct StaticOrder {
    int nM, nN, nwg, G, c, fixed, fpm, fpn, i0, cnt;
    __device__ void init(int M, int N, int G_, int c_, int i0_ = 0, int cnt_ = 1 << 30) { nM = M / BM; nN = N / BM; nwg = nM * nN; G = G_; c = c_; fixed = 0; fpm = 0; fpn = 0; i0 = i0_; cnt = cnt_; }
    __device__ void init_one(int pm, int pn) { nM = 1; nN = 1; nwg = 1; G = 1; c = 0; fixed = 1; fpm = pm; fpn = pn; i0 = 0; cnt = 1; }
    __device__ bool next(int i, Unit& u) const {
        if (fixed) { if (i > 0) return false; u.pm = fpm; u.pn = fpn; return true; }
        if (i >= cnt) return false;
        const long L = (long)(i + i0) * G + c; if (L >= nwg) return false;
        int wgid = (int)L; { const int q = nwg / NXCD, r = nwg % NXCD, xcd = wgid % NXCD, off = wgid / NXCD; wgid = (xcd < r ? xcd * (q + 1) : r * (q + 1) + (xcd - r) * q) + off; }
        const int nig = WGM * nN, gid = wgid / nig, fm = gid * WGM, gsz = (nM - fm) < WGM ? (nM - fm) : WGM;
        u.pm = fm + ((wgid % nig) % gsz); u.pn = (wgid % nig) / gsz; return true;
    }
};

template <class Epi>
__device__ __forceinline__ void gemm_phase(LAS unsigned char* lds, const Gemm g, const StaticOrder& S, const Epi& E, const int tid) {
    const int wid = __builtin_amdgcn_readfirstlane(tid >> 6), lane = tid & 63, wr = wid >> 2, wc = wid & 3, fr = lane & 15, fq = lane >> 4;
    const int K = g.K, nt = K / BK;
    unsigned voffA[2], voffB[2];
#pragma unroll
    for (int i = 0; i < 2; ++i) { int R, C; stage_rc(tid * 16 + i * 8192, R, C); const int Rb = (R & ~31) + perm32(R & 31);
        voffA[i] = (unsigned)(R * K + C) * 2u; voffB[i] = (unsigned)(Rb * K + C) * 2u; }
    const size_t kstep = (size_t)(BK * 2);
    const size_t hstep = (size_t)HALF * K * 2;
    const size_t tstep = 2 * hstep;
    const unsigned ldsw = (unsigned)wid * 1024u;
    const int aoff = lds_byte(wr * 64 + fr, fq * 8), boff = lds_byte(wc * 32 + fr, fq * 8);
#define PG8_SA(b, h) (((b) * 2 + (h)) * HTB)
#define PG8_SB(b, h) ((4 + (b) * 2 + (h)) * HTB)
#define PG8_STAGE(bufoff, gbase, voff) do { _Pragma("unroll") for (int _i = 0; _i < 2; ++_i) \
        __builtin_amdgcn_global_load_lds((const unsigned*)((const char*)(gbase) + (voff)[_i]), (LAS unsigned*)(lds + (bufoff) + ldsw + _i * 8192), 16, 0, 0); } while (0)
#define PG8_LDA(dst, b, h) do { _Pragma("unroll") for (int m = 0; m < 4; ++m) _Pragma("unroll") for (int k = 0; k < 2; ++k) dst[m][k] = *(const LAS bf16x8*)(lds + PG8_SA(b, h) + aoff + m * 2048 + k * 1024); } while (0)
#define PG8_LDB(dst, b, h) do { _Pragma("unroll") for (int n = 0; n < 2; ++n) _Pragma("unroll") for (int k = 0; k < 2; ++k) dst[n][k] = *(const LAS bf16x8*)(lds + PG8_SB(b, h) + boff + n * 2048 + k * 1024); } while (0)
#define PG8_MMA(ai, bj, At, Bt) do { __builtin_amdgcn_s_setprio(1); _Pragma("unroll") for (int m = 0; m < 4; ++m) _Pragma("unroll") for (int n = 0; n < 2; ++n) _Pragma("unroll") for (int k = 0; k < 2; ++k) \
        acc[ai][bj][m][n] = __builtin_amdgcn_mfma_f32_16x16x32_bf16(Bt[n][k], At[m][k], acc[ai][bj][m][n], 0, 0, 0); __builtin_amdgcn_s_setprio(0); } while (0)
#define PG8_WAIT_V(n) asm volatile("s_waitcnt vmcnt(" #n ")" ::: "memory")
#define PG8_WAIT_L(n) asm volatile("s_waitcnt lgkmcnt(" #n ")" ::: "memory")
#define PG8_BAR __builtin_amdgcn_s_barrier()
#define PG8_SCHED __builtin_amdgcn_sched_barrier(0)
    Unit cur, nxt; int ui = 0;
    if (!S.next(0, cur)) return;
    f32x4 acc[2][2][4][2];
#pragma unroll
    for (int a = 0; a < 2; ++a)
#pragma unroll
        for (int b = 0; b < 2; ++b)
#pragma unroll
            for (int m = 0; m < 4; ++m)
#pragma unroll
                for (int n = 0; n < 2; ++n) acc[a][b][m][n] = (f32x4){0.f, 0.f, 0.f, 0.f};
    bf16x8 At[4][2], B0[2][2], B1[2][2];
    const char* cA = (const char*)g.A + (size_t)cur.pm * tstep; const char* cB = (const char*)g.Bt + (size_t)cur.pn * tstep;
    PG8_STAGE(PG8_SB(0, 0), cB, voffB); PG8_STAGE(PG8_SB(0, 1), cB + hstep, voffB); PG8_STAGE(PG8_SA(0, 0), cA, voffA); PG8_STAGE(PG8_SA(0, 1), cA + hstep, voffA);
    if (wr == 1) PG8_BAR;
    PG8_WAIT_V(2); PG8_BAR;
    PG8_STAGE(PG8_SB(1, 0), cB + kstep, voffB); PG8_STAGE(PG8_SA(1, 0), cA + kstep, voffA); PG8_STAGE(PG8_SB(1, 1), cB + hstep + kstep, voffB);
    PG8_WAIT_V(6); PG8_BAR;
    for (;;) {
        const bool has_next = S.next(ui + 1, nxt);
        const char* nA = has_next ? (const char*)g.A + (size_t)nxt.pm * tstep : cA; const char* nB = has_next ? (const char*)g.Bt + (size_t)nxt.pn * tstep : cB;
        for (int t = 0; t < nt; t += 2) {
            const bool last = (t == nt - 2);
            const char* a1 = cA + (size_t)(t + 1) * kstep;
            const char* a2 = last ? nA : cA + (size_t)(t + 2) * kstep; const char* b2 = last ? nB : cB + (size_t)(t + 2) * kstep;
            const char* a3 = a2 + kstep; const char* b3 = b2 + kstep;
            if constexpr (Epi::MID) { if (t == 16 || t == 32) { int fr_ = fr, fq_ = fq, wr_ = wr, wc_ = wc;
                asm volatile("" : "+v"(fr_), "+v"(fq_)); asm volatile("" : "+s"(wr_), "+s"(wc_));
                E.mid(acc, cur, t >> 4, wr_, wc_, fr_, fq_); PG8_WAIT_V(0); PG8_SCHED; } }
            PG8_LDB(B0, 0, 0); PG8_LDB(B1, 0, 1); PG8_SCHED; PG8_LDA(At, 0, 0); PG8_STAGE(PG8_SA(1, 1), a1 + hstep, voffA);
            PG8_WAIT_V(8); PG8_WAIT_L(0); PG8_BAR; PG8_MMA(0, 0, At, B0); PG8_MMA(0, 1, At, B1); PG8_BAR; PG8_SCHED;
            PG8_LDA(At, 0, 1); PG8_STAGE(PG8_SB(0, 0), b2, voffB); PG8_STAGE(PG8_SB(0, 1), b2 + hstep, voffB); PG8_STAGE(PG8_SA(0, 0), a2, voffA);
            PG8_WAIT_V(8); PG8_WAIT_L(0); PG8_BAR; PG8_MMA(1, 0, At, B0); PG8_MMA(1, 1, At, B1); PG8_BAR; PG8_SCHED;
            PG8_LDB(B0, 1, 0); PG8_LDB(B1, 1, 1); PG8_SCHED; PG8_LDA(At, 1, 0); PG8_STAGE(PG8_SA(0, 1), a2 + hstep, voffA);
            PG8_WAIT_V(8); PG8_WAIT_L(0); PG8_BAR; PG8_MMA(0, 0, At, B0); PG8_MMA(0, 1, At, B1); PG8_BAR; PG8_SCHED;
            PG8_LDA(At, 1, 1); PG8_STAGE(PG8_SB(1, 0), b3, voffB); PG8_STAGE(PG8_SB(1, 1), b3 + hstep, voffB); PG8_STAGE(PG8_SA(1, 0), a3, voffA);
            PG8_WAIT_V(8); PG8_WAIT_L(0); PG8_BAR; PG8_MMA(1, 0, At, B0); PG8_MMA(1, 1, At, B1); PG8_BAR; PG8_SCHED;
        }
        if (wr == 0) PG8_BAR;
        { int fr_ = fr, fq_ = fq, wr_ = wr, wc_ = wc, wid_ = wid;
          asm volatile("" : "+v"(fr_), "+v"(fq_)); asm volatile("" : "+s"(wr_), "+s"(wc_), "+s"(wid_));
          E(acc, cur, wr_, wc_, fr_, fq_, wid_); }
        if (!has_next) break;
#pragma unroll
        for (int a = 0; a < 2; ++a)
#pragma unroll
            for (int b = 0; b < 2; ++b)
#pragma unroll
                for (int m = 0; m < 4; ++m)
#pragma unroll
                    for (int n = 0; n < 2; ++n) acc[a][b][m][n] = (f32x4){0.f, 0.f, 0.f, 0.f};
        cur = nxt; cA = nA; cB = nB; ++ui;
        if (wr == 1) PG8_BAR;
    }
    PG8_WAIT_V(0);
    PG8_BAR;
#undef PG8_SA
#undef PG8_SB
#undef PG8_STAGE
#undef PG8_LDA
#undef PG8_LDB
#undef PG8_MMA
#undef PG8_WAIT_V
#undef PG8_WAIT_L
#undef PG8_BAR
#undef PG8_SCHED
}
}
using pg8::Unit;

__device__ __forceinline__ int in_src_col(int n) {
    const int tile = n >> 8, s = n & 255, bj = s >> 7, wc = (s >> 5) & 3, c = s & 31;
    const int d128 = 64 * (wc & 1) + 32 * bj + c, g128 = wc >> 1;
    const int d64 = 32 * (c >> 4) + 16 * bj + (c & 15), g64 = wc;
    if (tile < 4) return (tile * 2 + g128) * 128 + d128;
    if (tile == 4) return 1024 + g128 * 128 + d128;
    if (tile == 5) return 1280 + s;
    if (tile < 10) return 1536 + ((tile - 6) * 2 + g128) * 192 + d128;
    if (tile < 12) return 1536 + ((tile - 10) * 4 + g64) * 192 + 128 + d64;
    if (tile < 14) return 3072 + (tile - 12) * 256 + s;
    if (tile == 14) return g64 == 0 ? 3584 + d64 : -1;
    if (tile < 19) return 3648 + ((tile - 15) * 4 + g64) * 64 + d64;
    if (tile < 23) return 4672 + ((tile - 19) * 4 + g64) * 64 + d64;
    if (tile < 27) return 5696 + (tile - 23) * 256 + s;
    if (tile < 39) return 6720 + (tile - 27) * 256 + s;
    return 9792 + (tile - 39) * 256 + s;
}
__device__ __forceinline__ int up_src_col(int n) {
    if (n >= 1024) return n;
    const int tile = n >> 8, s = n & 255, bj = s >> 7, wc = (s >> 5) & 3, c = s & 31;
    return (tile * 2 + (wc >> 1)) * 128 + 64 * (wc & 1) + 32 * bj + c;
}

template <int GS>
__device__ __forceinline__ void norm_rope_store(const f32x4 (&acc)[2][2][4][2], int pm, int wr, int wc, int fr, int fq, int wid,
                                                const float* __restrict__ w, const float* __restrict__ tcos, const float* __restrict__ tsin, bool rope,
                                                const float (&pre)[2][4], bf16_t* __restrict__ dst, int ld, int gbase, int ncopies, int copystride, LAS float* xch, const float qs = 1.f) {
    const int dbase = (GS == 128) ? 64 * (wc & 1) + 8 * fq : 32 * (fq >> 1) + 8 * (fq & 1);
    const int bjs = (GS == 128) ? 32 : 16;
    const int axis = (GS == 128) ? (wc & 1) : (fq >> 1);
    const int i0 = (GS == 128) ? 8 * fq : 8 * (fq & 1);
    constexpr int NF = (GS == 128) ? 32 : 16;
    const int wavebase = gbase + ((GS == 128) ? 64 * (wc & 1) : 0) + 8 * fq;
    float ssq[2][4];
#pragma unroll
    for (int ai = 0; ai < 2; ++ai)
#pragma unroll
        for (int m = 0; m < 4; ++m) {
            float s = 0.f;
#pragma unroll
            for (int bj = 0; bj < 2; ++bj)
#pragma unroll
                for (int n = 0; n < 2; ++n)
#pragma unroll
                    for (int j = 0; j < 4; ++j) { const float v = acc[ai][bj][m][n][j] * pre[ai][m]; s += v * v; }
            s += __shfl_xor(s, 16); s += __shfl_xor(s, 32);
            ssq[ai][m] = s;
        }
    if constexpr (GS == 128) {
        if (fq == 0) {
#pragma unroll
            for (int ai = 0; ai < 2; ++ai)
#pragma unroll
                for (int m = 0; m < 4; ++m) xch[wid * 128 + ai * 64 + m * 16 + fr] = ssq[ai][m];
        }
        asm volatile("s_waitcnt lgkmcnt(0)" ::: "memory"); __builtin_amdgcn_s_barrier();
#pragma unroll
        for (int ai = 0; ai < 2; ++ai)
#pragma unroll
            for (int m = 0; m < 4; ++m) ssq[ai][m] += xch[(wid ^ 1) * 128 + ai * 64 + m * 16 + fr];
    }
#pragma unroll
    for (int ai = 0; ai < 2; ++ai)
#pragma unroll
        for (int m = 0; m < 4; ++m) {
            const int rl = ai * 128 + wr * 64 + m * 16 + fr;
            const size_t row = (size_t)pm * 256 + rl;
            const float rinv = rsqrtf(ssq[ai][m] * (1.f / GS) + EPS) * pre[ai][m] * qs;
            const int t = (pm & 15) * 256 + rl; const int pos = axis ? (t & 63) : (t >> 6);
            u32x4 k0, k1;
#pragma unroll
            for (int n = 0; n < 2; ++n) {
                const f32x4 w0 = *(const f32x4*)(w + dbase + 4 * n), w1 = *(const f32x4*)(w + dbase + bjs + 4 * n);
                f32x4 y0 = acc[ai][0][m][n] * rinv * w0, y1 = acc[ai][1][m][n] * rinv * w1;
                if (rope) {
                    const f32x4 c = *(const f32x4*)(tcos + pos * NF + i0 + 4 * n), sn = *(const f32x4*)(tsin + pos * NF + i0 + 4 * n);
                    const f32x4 o0 = y0 * c - y1 * sn, o1 = y1 * c + y0 * sn;
                    y0 = o0; y1 = o1;
                }
                if (n == 0) { k0.x = cvt_pk_bf16(y0[0], y0[1]); k0.y = cvt_pk_bf16(y0[2], y0[3]); k1.x = cvt_pk_bf16(y1[0], y1[1]); k1.y = cvt_pk_bf16(y1[2], y1[3]); }
                else { k0.z = cvt_pk_bf16(y0[0], y0[1]); k0.w = cvt_pk_bf16(y0[2], y0[3]); k1.z = cvt_pk_bf16(y1[0], y1[1]); k1.w = cvt_pk_bf16(y1[2], y1[3]); }
            }
            bf16_t* p = dst + row * ld + wavebase;
            for (int cp = 0; cp < ncopies; ++cp) { *(u32x4*)(p + cp * copystride) = k0; *(u32x4*)(p + cp * copystride + 32) = k1; }
            __builtin_amdgcn_sched_barrier(0);
        }
}

struct EpiIn {
    static constexpr bool MID = false;
    bf16_t *QA, *KA, *VA, *QB, *KB, *CKV, *QC, *KC, *VC, *GATE, *MRG; float* SS;
    const float *wAq, *wAk, *wBqn, *wBqr, *wBkr, *wCq, *wCk, *bmerge;
    const float *tc64, *ts64, *tc128, *ts128;
    LAS float* xch;
    template <int ACT>
    __device__ __forceinline__ void plain(const f32x4 (&acc)[2][2][4][2], int pm, int wr, int wc, int fr, int fq, bf16_t* dst, int ld, int col0) const {
        const int colw = col0 + 32 * wc + 8 * fq;
        f32x4 b[2][2];
#pragma unroll
        for (int bj = 0; bj < 2; ++bj)
#pragma unroll
            for (int n = 0; n < 2; ++n) b[bj][n] = (ACT == 2) ? *(const f32x4*)(bmerge + colw + bj * 128 + 4 * n) : (f32x4){0.f, 0.f, 0.f, 0.f};
#pragma unroll
        for (int ai = 0; ai < 2; ++ai)
#pragma unroll
            for (int m = 0; m < 4; ++m) {
                const size_t row = (size_t)pm * 256 + ai * 128 + wr * 64 + m * 16 + fr;
#pragma unroll
                for (int bj = 0; bj < 2; ++bj) {
                    f32x4 v0 = acc[ai][bj][m][0], v1 = acc[ai][bj][m][1];
                    if (ACT == 1) { for (int j = 0; j < 4; ++j) { v0[j] = silu_f(v0[j]); v1[j] = silu_f(v1[j]); } }
                    if (ACT == 2) { v0 = v0 + b[bj][0]; v1 = v1 + b[bj][1]; for (int j = 0; j < 4; ++j) { v0[j] = sigm_f(v0[j]); v1[j] = sigm_f(v1[j]); } }
                    if (ACT == 0) store8(dst + row * ld + colw + bj * 128, v0, v1); else store8_safe(dst + row * ld + colw + bj * 128, v0, v1);
                }
                __builtin_amdgcn_sched_barrier(0);
            }
    }
    __device__ __forceinline__ void operator()(const f32x4 (&acc)[2][2][4][2], const Unit& u, int wr, int wc, int fr, int fq, int wid) const {
        const int t = u.pn, pm = u.pm; const bool rope = pm < 64;
        const float one[2][4] = {{1.f, 1.f, 1.f, 1.f}, {1.f, 1.f, 1.f, 1.f}};
        if (t < 4 && (MK_G1T & 1)) norm_rope_store<128>(acc, pm, wr, wc, fr, fq, wid, wAq, tc128, ts128, rope, one, QA, 1024, (t * 2 + (wc >> 1)) * 128, 1, 0, xch, 0.08838834764831845f * 1.4426950408889634f);
        else if (t == 4 && (MK_G1T & 1)) norm_rope_store<128>(acc, pm, wr, wc, fr, fq, wid, wAk, tc128, ts128, rope, one, KA, 256, (wc >> 1) * 128, 1, 0, xch);
        else if (t == 5 && (MK_G1T & 2)) plain<0>(acc, pm, wr, wc, fr, fq, VA, 256, 0);
        else if (t < 10 && (MK_G1T & 1)) norm_rope_store<128>(acc, pm, wr, wc, fr, fq, wid, wBqn, tc128, ts128, false, one, QB, 1536, ((t - 6) * 2 + (wc >> 1)) * 192, 1, 0, xch, 0.07216878364870323f * 1.4426950408889634f);
        else if (t < 12 && (MK_G1T & 4)) norm_rope_store<64>(acc, pm, wr, wc, fr, fq, wid, wBqr, tc64, ts64, rope, one, QB, 1536, ((t - 10) * 4 + wc) * 192 + 128, 1, 0, xch, 0.07216878364870323f * 1.4426950408889634f);
        else if (t < 14 && (MK_G1T & 8)) {
            plain<0>(acc, pm, wr, wc, fr, fq, CKV, 512, (t - 12) * 256);
#pragma unroll
            for (int ai = 0; ai < 2; ++ai)
#pragma unroll
                for (int m = 0; m < 4; ++m) {
                    float s = 0.f;
#pragma unroll
                    for (int bj = 0; bj < 2; ++bj)
#pragma unroll
                        for (int n = 0; n < 2; ++n)
#pragma unroll
                            for (int j = 0; j < 4; ++j) { const float v = acc[ai][bj][m][n][j]; s += v * v; }
                    s += __shfl_xor(s, 16); s += __shfl_xor(s, 32);
                    if (fq == 0) SS[((size_t)pm * 256 + ai * 128 + wr * 64 + m * 16 + fr) * 8 + (t - 12) * 4 + wc] = s;
                }
        }
        else if (t == 14 && (MK_G1T & 16)) { if (wc == 0) norm_rope_store<64>(acc, pm, wr, wc, fr, fq, wid, wBkr, tc64, ts64, rope, one, KB, 1536, 128, 8, 192, xch); }
        else if (t < 19 && (MK_G1T & 4)) norm_rope_store<64>(acc, pm, wr, wc, fr, fq, wid, wCq, tc64, ts64, rope, one, QC, 1024, ((t - 15) * 4 + wc) * 64, 1, 0, xch, 0.125f * 1.4426950408889634f);
        else if (t < 23 && (MK_G1T & 4)) norm_rope_store<64>(acc, pm, wr, wc, fr, fq, wid, wCk, tc64, ts64, rope, one, KC, 1024, ((t - 19) * 4 + wc) * 64, 1, 0, xch);
        else if (t < 27 && (MK_G1T & 2)) plain<0>(acc, pm, wr, wc, fr, fq, VC, 1024, (t - 23) * 256);
        else if (t < 39 && (MK_G1T & 32)) plain<1>(acc, pm, wr, wc, fr, fq, GATE, 3072, (t - 27) * 256);
        else if (MK_G1T & 64) plain<2>(acc, pm, wr, wc, fr, fq, MRG, 6144, (t - 39) * 256);
    }
};

struct EpiUp {
    static constexpr bool MID = false;
    bf16_t *KB, *VB; const float* SS; const float* wBkn; LAS float* xch;
    __device__ __forceinline__ void operator()(const f32x4 (&acc)[2][2][4][2], const Unit& u, int wr, int wc, int fr, int fq, int wid) const {
        const int t = u.pn, pm = u.pm;
        float pre[2][4];
#pragma unroll
        for (int ai = 0; ai < 2; ++ai)
#pragma unroll
            for (int m = 0; m < 4; ++m) {
                const size_t row = (size_t)pm * 256 + ai * 128 + wr * 64 + m * 16 + fr;
                const f32x4 a = *(const f32x4*)(SS + row * 8), b = *(const f32x4*)(SS + row * 8 + 4);
                pre[ai][m] = rsqrtf(((a[0] + a[1]) + (a[2] + a[3]) + (b[0] + b[1]) + (b[2] + b[3])) * (1.f / 512.f) + EPS);
                __builtin_amdgcn_sched_barrier(0);
            }
        if (t < 4) norm_rope_store<128>(acc, pm, wr, wc, fr, fq, wid, wBkn, nullptr, nullptr, false, pre, KB, 1536, (t * 2 + (wc >> 1)) * 192, 1, 0, xch);
        else {
            const int colw = (t - 4) * 256 + 32 * wc + 8 * fq;
#pragma unroll
            for (int ai = 0; ai < 2; ++ai)
#pragma unroll
                for (int m = 0; m < 4; ++m) {
                    const size_t row = (size_t)pm * 256 + ai * 128 + wr * 64 + m * 16 + fr;
#pragma unroll
                    for (int bj = 0; bj < 2; ++bj) store8(VB + row * 1024 + colw + bj * 128, acc[ai][bj][m][0] * pre[ai][m], acc[ai][bj][m][1] * pre[ai][m]);
                    __builtin_amdgcn_sched_barrier(0);
                }
        }
    }
};

struct EpiBr {
    static constexpr bool MID = true;
    const bf16_t* MRG; bf16_t* Y;
    __device__ __forceinline__ void mid(f32x4 (&acc)[2][2][4][2], const Unit& u, int i, int wr, int wc, int fr, int fq) const {
#pragma unroll
        for (int ai = 0; ai < 2; ++ai)
#pragma unroll
            for (int mh = 0; mh < 2; ++mh) {
                u32x4 a[2][2], b[2][2];
#pragma unroll
                for (int mm = 0; mm < 2; ++mm)
#pragma unroll
                    for (int bj = 0; bj < 2; ++bj) {
                        const size_t row = (size_t)u.pm * 256 + ai * 128 + wr * 64 + (mh * 2 + mm) * 16 + fr; const int col = u.pn * 256 + bj * 128 + 32 * wc + 8 * fq;
                        a[mm][bj] = *(const u32x4*)(MRG + row * 6144 + (i - 1) * 2048 + col); b[mm][bj] = *(const u32x4*)(MRG + row * 6144 + i * 2048 + col); }
#pragma unroll
                for (int mm = 0; mm < 2; ++mm)
#pragma unroll
                    for (int bj = 0; bj < 2; ++bj)
#pragma unroll
                        for (int q = 0; q < 4; ++q) {
                            const float r0 = bf2f(a[mm][bj][q] & 0xffffu) * __builtin_amdgcn_rcpf(bf2f(b[mm][bj][q] & 0xffffu)), r1 = bf2f(a[mm][bj][q] >> 16) * __builtin_amdgcn_rcpf(bf2f(b[mm][bj][q] >> 16));
                            acc[ai][bj][mh * 2 + mm][q >> 1][(q & 1) * 2] *= r0; acc[ai][bj][mh * 2 + mm][q >> 1][(q & 1) * 2 + 1] *= r1;
                        }
                __builtin_amdgcn_sched_barrier(0);
            }
    }
    __device__ __forceinline__ void operator()(const f32x4 (&acc)[2][2][4][2], const Unit& u, int wr, int wc, int fr, int fq, int wid) const {
#pragma unroll
        for (int ai = 0; ai < 2; ++ai) {
            u32x4 a[4][2];
#pragma unroll
            for (int m = 0; m < 4; ++m)
#pragma unroll
                for (int bj = 0; bj < 2; ++bj) {
                    const size_t row = (size_t)u.pm * 256 + ai * 128 + wr * 64 + m * 16 + fr; const int col = u.pn * 256 + bj * 128 + 32 * wc + 8 * fq;
                    a[m][bj] = *(const u32x4*)(MRG + row * 6144 + 4096 + col); }
#pragma unroll
            for (int m = 0; m < 4; ++m)
#pragma unroll
                for (int bj = 0; bj < 2; ++bj) {
                    const size_t row = (size_t)u.pm * 256 + ai * 128 + wr * 64 + m * 16 + fr; const int col = u.pn * 256 + bj * 128 + 32 * wc + 8 * fq;
                    const u32x4 g = a[m][bj];
                    f32x4 v0 = acc[ai][bj][m][0], v1 = acc[ai][bj][m][1];
                    v0[0] *= bf2f(g[0] & 0xffffu); v0[1] *= bf2f(g[0] >> 16); v0[2] *= bf2f(g[1] & 0xffffu); v0[3] *= bf2f(g[1] >> 16);
                    v1[0] *= bf2f(g[2] & 0xffffu); v1[1] *= bf2f(g[2] >> 16); v1[2] *= bf2f(g[3] & 0xffffu); v1[3] *= bf2f(g[3] >> 16);
                    store8(Y + row * 2048 + col, v0, v1);
                }
            __builtin_amdgcn_sched_barrier(0);
        }
    }
};

struct EpiOut {
    static constexpr bool MID = false;
    const float *xsrc, *csrc; float *xdst, *cdst; const float* mod;
    __device__ __forceinline__ void operator()(const f32x4 (&acc)[2][2][4][2], const Unit& u, int wr, int wc, int fr, int fq, int wid) const {
        const int pm = u.pm; const bool lat = pm < 64;
        const int mi = lat ? (pm >> 4) : 4;
        const float* src = lat ? xsrc : csrc - (size_t)MLAT * DM; float* dst = lat ? xdst : cdst - (size_t)MLAT * DM;
        const float* g = mod + mi * 6144 + 4096;
#pragma unroll
        for (int bj = 0; bj < 2; ++bj) {
            const int col = u.pn * 256 + bj * 128 + 32 * wc + 8 * fq;
            const f32x4 g0 = *(const f32x4*)(g + col), g1 = *(const f32x4*)(g + col + 4);
#pragma unroll
            for (int ai = 0; ai < 2; ++ai) {
                f32x4 x0[4], x1[4];
#pragma unroll
                for (int m = 0; m < 4; ++m) { const size_t row = (size_t)pm * 256 + ai * 128 + wr * 64 + m * 16 + fr;
                    x0[m] = *(const f32x4*)(src + row * DM + col); x1[m] = *(const f32x4*)(src + row * DM + col + 4); }
#pragma unroll
                for (int m = 0; m < 4; ++m) { const size_t row = (size_t)pm * 256 + ai * 128 + wr * 64 + m * 16 + fr;
                    *(f32x4*)(dst + row * DM + col) = x0[m] + g0 * acc[ai][bj][m][0];
                    *(f32x4*)(dst + row * DM + col + 4) = x1[m] + g1 * acc[ai][bj][m][1]; }
                __builtin_amdgcn_sched_barrier(0);
            }
        }
    }
};

namespace att {
#define SBAR() __builtin_amdgcn_sched_barrier(0)
__device__ __forceinline__ int crow(int r, int hi) { return (r & 3) + 8 * (r >> 2) + 4 * hi; }
template <int RB> __device__ __forceinline__ int kswz(int row, int colB) { const int x = (RB == 256) ? (row & 15) : ((row >> 1) & 7); return row * RB + (colB ^ (x << 4)); }
__device__ __forceinline__ int v_st(int k, int c) { const int kk = (k & ~0xC) | ((k & 4) << 1) | ((k & 8) >> 1); return ((kk >> 3) * 4 + (c >> 5)) * 512 + ((kk & 7) * 32 + (c & 31)) * 2; }
__device__ __forceinline__ int v_rd_base(int lane) { return ((lane & 3) << 3) | (((lane >> 2) & 3) << 6) | (((lane >> 4) & 1) << 5) | (((lane >> 5) & 1) << 8); }
constexpr int v_rd_off(int d0, int ks, int half) { return d0 * 512 + ks * 4096 + half * 2048; }
template <int OFF> __device__ __forceinline__ s16x4 tr_read(unsigned vb) {
    s16x4 r; asm volatile("ds_read_b64_tr_b16 %0, %1 offset:%2" : "=&v"(r) : "v"(vb), "i"(OFF) : "memory"); return r;
}
template <int D0> __device__ __forceinline__ void pv_one(f32x16& od, unsigned vb, bf16x8 pa0, bf16x8 pa1, bf16x8 pa2, bf16x8 pa3) {
    const s16x4 l0 = tr_read<v_rd_off(D0, 0, 0)>(vb), h0 = tr_read<v_rd_off(D0, 0, 1)>(vb), l1 = tr_read<v_rd_off(D0, 1, 0)>(vb), h1 = tr_read<v_rd_off(D0, 1, 1)>(vb);
    const s16x4 l2 = tr_read<v_rd_off(D0, 2, 0)>(vb), h2 = tr_read<v_rd_off(D0, 2, 1)>(vb), l3 = tr_read<v_rd_off(D0, 3, 0)>(vb), h3 = tr_read<v_rd_off(D0, 3, 1)>(vb);
    asm volatile("s_waitcnt lgkmcnt(0)" ::: "memory"); SBAR();
#define PK(L, H) (bf16x8){L[0], L[1], L[2], L[3], H[0], H[1], H[2], H[3]}
    od = __builtin_amdgcn_mfma_f32_32x32x16_bf16(pa0, PK(l0, h0), od, 0, 0, 0);
    od = __builtin_amdgcn_mfma_f32_32x32x16_bf16(pa1, PK(l1, h1), od, 0, 0, 0);
    od = __builtin_amdgcn_mfma_f32_32x32x16_bf16(pa2, PK(l2, h2), od, 0, 0, 0);
    od = __builtin_amdgcn_mfma_f32_32x32x16_bf16(pa3, PK(l3, h3), od, 0, 0, 0);
#undef PK
}
__device__ __forceinline__ void pv_d0(f32x16 (&o)[4], unsigned vb, bf16x8 pa0, bf16x8 pa1, bf16x8 pa2, bf16x8 pa3) {
    pv_one<0>(o[0], vb, pa0, pa1, pa2, pa3); pv_one<1>(o[1], vb, pa0, pa1, pa2, pa3); pv_one<2>(o[2], vb, pa0, pa1, pa2, pa3); pv_one<3>(o[3], vb, pa0, pa1, pa2, pa3);
}
__device__ __forceinline__ void partialSM(f32x16& p0, f32x16& p1) {
#pragma unroll
    for (int r = 0; r < 16; ++r) p0[r] = __builtin_amdgcn_exp2f(p0[r]);
}
__device__ __forceinline__ void finishSM(f32x16& p0, f32x16& p1, float& l_reg, bf16x8& pa0, bf16x8& pa1, bf16x8& pa2, bf16x8& pa3) {
#pragma unroll
    for (int r = 0; r < 16; ++r) p1[r] = __builtin_amdgcn_exp2f(p1[r]);
    float ps = 0;
#pragma unroll
    for (int r = 0; r < 16; ++r) ps += p0[r];
#pragma unroll
    for (int r = 0; r < 16; ++r) ps += p1[r];
    l_reg += ps;
#define PK8(P, BASE, OUT) do { u32x4 w = {cvt_pk_bf16(P[BASE + 0], P[BASE + 1]), cvt_pk_bf16(P[BASE + 2], P[BASE + 3]), cvt_pk_bf16(P[BASE + 4], P[BASE + 5]), cvt_pk_bf16(P[BASE + 6], P[BASE + 7])}; \
    OUT = *reinterpret_cast<bf16x8*>(&w); } while (0)
    PK8(p0, 0, pa0); PK8(p0, 8, pa1); PK8(p1, 0, pa2); PK8(p1, 8, pa3);
#undef PK8
}
template <int DQK>
__device__ __forceinline__ void qkt(f32x16& p0, f32x16& p1, const LAS char* Ks, const bf16x8 (&qr)[DQK / 16], const int (&ka)[8], float nMB) {
    constexpr int RB = DQK * 2, NA = (RB == 256) ? 8 : 4;
#pragma unroll
    for (int r = 0; r < 16; ++r) { p0[r] = nMB; p1[r] = nMB; }
#pragma unroll
    for (int d0 = 0; d0 < DQK / 16; ++d0) {
        const LAS char* a = Ks + ka[d0 % NA] + (d0 / NA) * (NA * 32);
        const bf16x8 b0 = *(const LAS bf16x8*)(a);
        const bf16x8 b1 = *(const LAS bf16x8*)(a + 32 * RB);
        p0 = __builtin_amdgcn_mfma_f32_32x32x16_bf16(b0, qr[d0], p0, 0, 0, 0);
        p1 = __builtin_amdgcn_mfma_f32_32x32x16_bf16(b1, qr[d0], p1, 0, 0, 0); }
}
constexpr int V_BYTES = 64 * 128 * 2, K_OFF = 3 * V_BYTES, K_STRIDE = 64 * 192 * 2, LI_OFF = K_OFF + 3 * K_STRIDE;

template <int DQK, bool DOUBLE>
__device__ __forceinline__ void attn_pass(const bf16_t* __restrict__ Q, int ldq, const bf16_t* __restrict__ Kg, int ldk, const bf16_t* __restrict__ Vg, int ldv,
                                          int rowc, int rowl, int NT, float nMB, f32x16 (&o)[4], float& l_reg, LAS char* lds, int tid) {
    constexpr int RB = DQK * 2, NCH = DQK / 8, NLD = NCH / 8;
    const int wid = __builtin_amdgcn_readfirstlane(tid >> 6), lane = tid & 63, r32 = lane & 31, hi = lane >> 5;
    LAS char* V_lds = lds; LAS char* K_lds = lds + K_OFF;
    bf16x8 qr[DQK / 16];
    { const bf16_t* Qw = Q + (size_t)(wid * 32 + r32) * ldq + hi * 8;
#pragma unroll
      for (int d0 = 0; d0 < DQK / 16; ++d0) qr[d0] = *(const bf16x8*)(Qw + d0 * 16); }
#pragma unroll
    for (int d = 0; d < 4; ++d) o[d] = f32x16{};
    l_reg = 0.f;
    int vrow[2], vcol[2], krow[NLD], kcol[NLD];
#pragma unroll
    for (int i = 0; i < 2; ++i) { const int q = tid + 512 * i, sub = q >> 5, within = q & 31, kk = (sub >> 2) * 8 + (within >> 2);
        vrow[i] = kk; vcol[i] = (sub & 3) * 32 + (within & 3) * 8; }
#pragma unroll
    for (int i = 0; i < NLD; ++i) { const int q = tid + 512 * i, row = q / NCH, chp = q % NCH; const int x = (RB == 256) ? (row & 15) : ((row >> 1) & 7);
        krow[i] = row; kcol[i] = (chp ^ x) * 8; }
    const unsigned vb0 = (unsigned)(uintptr_t)V_lds + v_rd_base(lane);
    int ka[8];
#pragma unroll
    for (int q = 0; q < 8; ++q) ka[q] = kswz<RB>(r32, q * 32 + hi * 16);
#define KROW0(j) ((j) < 4 ? rowc + 64 * (j) : rowl + 64 * ((j) - 4))
#define DMA(j, b) do { const size_t _r0 = (size_t)KROW0(j); \
    _Pragma("unroll") for (int _i = 0; _i < 2; ++_i) __builtin_amdgcn_global_load_lds((const unsigned*)(Vg + (_r0 + vrow[_i]) * ldv + vcol[_i]), (LAS unsigned*)(V_lds + (b) * V_BYTES + wid * 1024 + _i * 8192), 16, 0, 0); \
    _Pragma("unroll") for (int _i = 0; _i < NLD; ++_i) __builtin_amdgcn_global_load_lds((const unsigned*)(Kg + (_r0 + krow[_i]) * ldk + kcol[_i]), (LAS unsigned*)(K_lds + (b) * K_STRIDE + wid * 1024 + _i * 8192), 16, 0, 0); } while (0)
#define VMW0() asm volatile("s_waitcnt vmcnt(0)" ::: "memory")
    bf16x8 pa0, pa1, pa2, pa3;
    __syncthreads();
    DMA(0, 0); DMA(1, 1); VMW0(); __syncthreads();
    if constexpr (!DOUBLE) {
        f32x16 p0, p1;
        DMA(2, 2);
        int bc = 0, bn = 1, bf = 2;
        for (int j = 0; j < NT; ++j) {
            SBAR(); qkt<DQK>(p0, p1, K_lds + bc * K_STRIDE, qr, ka, nMB);
            partialSM(p0, p1); finishSM(p0, p1, l_reg, pa0, pa1, pa2, pa3); SBAR();
            pv_d0(o, vb0 + bc * V_BYTES, pa0, pa1, pa2, pa3);
            if (j + 1 < NT) { VMW0(); __syncthreads(); if (j + 3 < NT) DMA(j + 3, bc); }
            { const int _t = bc; bc = bn; bn = bf; bf = _t; }
        }
    } else {
    f32x16 pA0, pA1, pB0, pB1;
    qkt<DQK>(pA0, pA1, K_lds, qr, ka, nMB); partialSM(pA0, pA1);
    DMA(2, 2);
    int bp = 0, bc = 1, bn = 2;
#define STEP(j, PC0, PC1, PP0, PP1) do { \
        SBAR(); qkt<DQK>(PC0, PC1, K_lds + bc * K_STRIDE, qr, ka, nMB); \
        finishSM(PP0, PP1, l_reg, pa0, pa1, pa2, pa3); SBAR(); \
        pv_d0(o, vb0 + bp * V_BYTES, pa0, pa1, pa2, pa3); partialSM(PC0, PC1); \
        if ((j) + 1 < NT) { VMW0(); __syncthreads(); if ((j) + 2 < NT) DMA((j) + 2, bp); } \
        { const int _t = bp; bp = bc; bc = bn; bn = _t; } } while (0)
    for (int j = 1; j < NT; j += 2) {
        STEP(j, pB0, pB1, pA0, pA1);
        if (j + 1 < NT) STEP(j + 1, pA0, pA1, pB0, pB1);
    }
    finishSM(pB0, pB1, l_reg, pa0, pa1, pa2, pa3); SBAR();
    pv_d0(o, vb0 + bp * V_BYTES, pa0, pa1, pa2, pa3);
    }
#undef KROW0
#undef DMA
#undef VMW0
#undef STEP
}
__device__ __forceinline__ void row_recip(float l_reg, float (&rli)[16], LAS float* li, int r32, int hi) {
    { auto rr = __builtin_amdgcn_permlane32_swap(__float_as_uint(l_reg), __float_as_uint(l_reg), false, false);
      l_reg = __uint_as_float(rr[0]) + __uint_as_float(rr[1]); }
    if (hi == 0) li[r32] = l_reg;
    asm volatile("s_waitcnt lgkmcnt(0)" ::: "memory");
#pragma unroll
    for (int r = 0; r < 16; ++r) rli[r] = __builtin_amdgcn_rcpf(li[crow(r, hi)]);
    asm volatile("s_waitcnt lgkmcnt(0)" ::: "memory");
}
}

struct AttnBufs { const bf16_t *QA, *KA, *VA, *QB, *KB, *VB, *QC, *KC, *VC, *GATE; bf16_t* BR; float* SCR; const float* lamv; const float* subln; float lam_init; };

template <bool SUBLN>
__device__ __forceinline__ void attn_out(const AttnBufs& T, f32x16 (&o)[4], int type, int h, size_t orow0, LAS char* lds, int wid, int lane, int r32, int hi) {
    const int rr = lane >> 5, c4 = (lane & 31) * 4;
    const int col = type * 1024 + h * 128 + c4;
    const bf16_t* gp = T.GATE + (orow0 + rr) * 3072 + col; bf16_t* op = T.BR + (orow0 + rr) * 3072 + col;
    u32x2 gg[16];
#pragma unroll
    for (int i = 0; i < 16; ++i) gg[i] = *(const u32x2*)(gp + (size_t)i * 2 * 3072);
    __syncthreads();
    LAS float* stg = (LAS float*)(lds + wid * 16896);
#pragma unroll
    for (int d0 = 0; d0 < 4; ++d0)
#pragma unroll
        for (int r = 0; r < 16; ++r) stg[att::crow(r, hi) * 132 + d0 * 32 + r32] = o[d0][r];
    asm volatile("s_waitcnt lgkmcnt(0)" ::: "memory");
    f32x4 wsub = {1.f, 1.f, 1.f, 1.f};
    if (SUBLN) { wsub = *(const f32x4*)(T.subln + c4) * (1.f - T.lam_init); }
#pragma unroll
    for (int i = 0; i < 16; ++i) {
        f32x4 v = *(const LAS f32x4*)(stg + (2 * i + rr) * 132 + c4);
        if (SUBLN) {
            float s = (v[0] * v[0] + v[1] * v[1]) + (v[2] * v[2] + v[3] * v[3]);
            s += __shfl_xor(s, 1); s += __shfl_xor(s, 2); s += __shfl_xor(s, 4); s += __shfl_xor(s, 8); s += __shfl_xor(s, 16);
            v = v * (rsqrtf(s * (1.f / 128.f) + EPS)) * wsub;
        }
        u32x2 w; w.x = cvt_pk_bf16(v[0] * bf2f(gg[i].x & 0xffffu), v[1] * bf2f(gg[i].x >> 16)); w.y = cvt_pk_bf16(v[2] * bf2f(gg[i].y & 0xffffu), v[3] * bf2f(gg[i].y >> 16));
        *(u32x2*)(op + (size_t)i * 2 * 3072) = w;
    }
}

__device__ __forceinline__ void attn_item(const AttnBufs& T, int type, int b, int h, int qrow0, int NT, LAS char* lds, int tid_) {
    asm volatile("" : "+v"(tid_));
    const int tid = tid_, wid = __builtin_amdgcn_readfirstlane(tid >> 6), lane = tid & 63, r32 = lane & 31, hi = lane >> 5;
    const int rowc = MLAT + b * CTXL, rowl = b * SEQ;
    LAS float* li = (LAS float*)(lds + att::LI_OFF) + wid * 64;
    constexpr float LOG2E = 1.4426950408889634f;
    const size_t orow0 = (size_t)qrow0 + wid * 32;
    if (type == 0 && (MK_ATYPE & 1)) {
        f32x16 o[4]; float l_reg; float rli[16];
        att::attn_pass<128, ATT_DBL>(T.QA + (size_t)qrow0 * 1024 + h * 128, 1024, T.KA + (h >> 2) * 128, 256, T.VA + (h >> 2) * 128, 256, rowc, rowl, NT,
                            T.lamv[1], o, l_reg, lds, tid);
        att::row_recip(l_reg, rli, li, r32, hi);
#pragma unroll
        for (int d0 = 0; d0 < 4; ++d0)
#pragma unroll
            for (int r = 0; r < 16; ++r) o[d0][r] *= rli[r];
        attn_out<false>(T, o, 0, h, orow0, lds, wid, lane, r32, hi);
    } else if (type == 1 && (MK_ATYPE & 2)) {
        f32x16 o[4]; float l_reg; float rli[16];
        att::attn_pass<192, false>(T.QB + (size_t)qrow0 * 1536 + h * 192, 1536, T.KB + h * 192, 1536, T.VB + h * 128, 1024, rowc, rowl, NT,
                            T.lamv[2], o, l_reg, lds, tid);
        att::row_recip(l_reg, rli, li, r32, hi);
#pragma unroll
        for (int d0 = 0; d0 < 4; ++d0)
#pragma unroll
            for (int r = 0; r < 16; ++r) o[d0][r] *= rli[r];
        attn_out<false>(T, o, 1, h, orow0, lds, wid, lane, r32, hi);
    } else if (MK_ATYPE & 4) {
        f32x16 o[4]; float l_reg; float rli[16];
        att::attn_pass<64, ATT_DBL>(T.QC + (size_t)qrow0 * 1024 + h * 128, 1024, T.KC + h * 128, 1024, T.VC + h * 128, 1024, rowc, rowl, NT,
                           T.lamv[3], o, l_reg, lds, tid);
        att::row_recip(l_reg, rli, li, r32, hi);
        f32x4* scr = (f32x4*)(T.SCR + ((size_t)blockIdx.x * 512 + tid) * 64);
#pragma unroll
        for (int d0 = 0; d0 < 4; ++d0)
#pragma unroll
            for (int q = 0; q < 4; ++q) scr[d0 * 4 + q] = (f32x4){o[d0][q * 4] * rli[q * 4], o[d0][q * 4 + 1] * rli[q * 4 + 1], o[d0][q * 4 + 2] * rli[q * 4 + 2], o[d0][q * 4 + 3] * rli[q * 4 + 3]};
        att::attn_pass<64, ATT_DBL>(T.QC + (size_t)qrow0 * 1024 + h * 128 + 64, 1024, T.KC + h * 128 + 64, 1024, T.VC + h * 128, 1024, rowc, rowl, NT,
                           T.lamv[3], o, l_reg, lds, tid);
        att::row_recip(l_reg, rli, li, r32, hi);
        const float lam = T.lamv[0];
#pragma unroll
        for (int d0 = 0; d0 < 4; ++d0)
#pragma unroll
            for (int q = 0; q < 4; ++q) { const f32x4 a = scr[d0 * 4 + q];
#pragma unroll
                for (int j = 0; j < 4; ++j) o[d0][q * 4 + j] = a[j] - lam * (o[d0][q * 4 + j] * rli[q * 4 + j]); }
        attn_out<true>(T, o, 2, h, orow0, lds, wid, lane, r32, hi);
    }
}

__device__ __forceinline__ void transpose_item(const float* __restrict__ W, int ldw, int k0, int srccol4, const float* __restrict__ kscale,
                                               bf16_t* __restrict__ WT, int ldt, int n0, int kdst0, LAS float* scr, int lane) {
    const int ks = lane >> 4, n4 = (lane & 15) * 4;
#pragma unroll 8
    for (int i = 0; i < 16; ++i) { const int kk = 4 * i + ks;
        f32x4 v = srccol4 >= 0 ? *(const f32x4*)(W + (size_t)(k0 + kk) * ldw + srccol4) : (f32x4){0.f, 0.f, 0.f, 0.f};
        if (kscale) v = v * kscale[k0 + kk];
        LAS float* d = scr + kk * 65 + n4; d[0] = v[0]; d[1] = v[1]; d[2] = v[2]; d[3] = v[3]; }
    asm volatile("s_waitcnt lgkmcnt(0)" ::: "memory");
    const int nn = lane & 7, c = lane >> 3;
#pragma unroll
    for (int j = 0; j < 8; ++j) { const int n = nn + 8 * j; const LAS float* s = scr + (8 * c) * 65 + n;
        u32x4 o; o.x = cvt_pk_bf16(s[0 * 65], s[1 * 65]); o.y = cvt_pk_bf16(s[2 * 65], s[3 * 65]); o.z = cvt_pk_bf16(s[4 * 65], s[5 * 65]); o.w = cvt_pk_bf16(s[6 * 65], s[7 * 65]);
        *(u32x4*)(WT + (size_t)(n0 + n) * ldt + kdst0 + k0 + 8 * c) = o; }
    asm volatile("s_waitcnt lgkmcnt(0)" ::: "memory");
}
__device__ const float INVF32[16] = {1.000000000e+00f, 5.623413324e-01f, 3.162277639e-01f, 1.778279394e-01f, 1.000000015e-01f, 5.623413250e-02f, 3.162277490e-02f, 1.778279431e-02f,
    9.999999776e-03f, 5.623413250e-03f, 3.162277630e-03f, 1.778279431e-03f, 1.000000047e-03f, 5.623413017e-04f, 3.162277571e-04f, 1.778279402e-04f};
__device__ const float INVF64[32] = {1.000000000e+00f, 7.498942614e-01f, 5.623413324e-01f, 4.216965139e-01f, 3.162277639e-01f, 2.371373773e-01f, 1.778279394e-01f, 1.333521307e-01f,
    1.000000015e-01f, 7.498941571e-02f, 5.623413250e-02f, 4.216965288e-02f, 3.162277490e-02f, 2.371373773e-02f, 1.778279431e-02f, 1.333521493e-02f, 9.999999776e-03f, 7.498941850e-03f,
    5.623413250e-03f, 4.216964822e-03f, 3.162277630e-03f, 2.371373586e-03f, 1.778279431e-03f, 1.333521446e-03f, 1.000000047e-03f, 7.498942432e-04f, 5.623413017e-04f, 4.216965172e-04f,
    3.162277571e-04f, 2.371373703e-04f, 1.778279402e-04f, 1.333521504e-04f};
__device__ __forceinline__ void sincos_d(double x, float& s, float& c) {
    const double twopi = 6.283185307179586476925;
    const double k = __builtin_rint(x / twopi), r = x - k * twopi, r2 = r * r;
    double st = r, ct = 1.0, ss = r, cs = 1.0;
    for (int n = 1; n <= 16; ++n) { ct *= -r2 / (double)((2 * n - 1) * (2 * n)); st *= -r2 / (double)((2 * n) * (2 * n + 1)); cs += ct; ss += st; }
    s = (float)ss; c = (float)cs;
}
__device__ __forceinline__ float absmax_n(const float* w, int n) { float m = 0.f; for (int i = 0; i < n; ++i) m = fmaxf(m, fabsf(w[i])); return m; }

typedef unsigned v4u_unused_t;
#define XB_TMO      128
#define XB_XCNT(j)  (256  + 64 * (j))
#define XB_XSUB(j)  (1280 + 64 * (j))
#define XB_XGEN(j)  (2304 + 64 * (j))
#define XB_TOP      3328
#define XB_TOPGEN   3392
#define XCD_BAR_WORDS 3456
#define XB_SPIN_CAP (1u << 18)

__device__ __forceinline__ unsigned xb_ld(unsigned* p)              { return __hip_atomic_load(p, __ATOMIC_RELAXED, __HIP_MEMORY_SCOPE_AGENT); }
__device__ __forceinline__ unsigned xb_add(unsigned* p, unsigned v) { return __hip_atomic_fetch_add(p, v, __ATOMIC_RELAXED, __HIP_MEMORY_SCOPE_AGENT); }
__device__ __forceinline__ unsigned xb_xcc_id() { return (unsigned)__builtin_amdgcn_s_getreg((3 << 11) | 20) & 0xFu; }
#define XB_SPIN(cond, bar) do { unsigned _sp = 0; while (cond) { __builtin_amdgcn_s_sleep(1); \
    if ((++_sp & 255u) == 0u) { if (xb_ld(&(bar)[XB_TMO])) break; if (_sp > XB_SPIN_CAP) { atomicAdd(&(bar)[XB_TMO], 1u); break; } } } } while (0)

struct XcdBarrier {
    unsigned* bar; unsigned x;
    volatile LAS unsigned* st;
};

__device__ __forceinline__ XcdBarrier xcd_barrier_post(unsigned* bar, volatile LAS unsigned* st) {
    XcdBarrier b; b.bar = bar; b.x = xb_xcc_id(); b.st = st;
    if (threadIdx.x == 0) (void)xb_add(&bar[XB_XCNT(b.x)], 1u);
    return b;
}
__device__ __forceinline__ void xcd_barrier_complete(unsigned* bar, unsigned x, unsigned& nloc, unsigned& nx) {
    const unsigned G = gridDim.x * gridDim.y * gridDim.z;
    unsigned sum, cnt, mine, sp = 0u;
    for (;;) {
        sum = 0u; cnt = 0u; mine = 0u;
#pragma unroll
        for (unsigned j = 0; j < 16; ++j) { const unsigned c = xb_ld(&bar[XB_XCNT(j)]); sum += c; cnt += (c > 0u) ? 1u : 0u; mine = (j == x) ? c : mine; }
        if (sum == G) break;
        __builtin_amdgcn_s_sleep(1);
        if ((++sp & 255u) == 0u) { if (xb_ld(&bar[XB_TMO])) break; if (sp > XB_SPIN_CAP) { atomicAdd(&bar[XB_TMO], 1u); break; } }
    }
    nloc = mine > 0u ? mine : 1u; nx = cnt > 0u ? cnt : 1u;
}

__device__ __forceinline__ void xcd_barrier(const XcdBarrier& b) {
    asm volatile("s_waitcnt vmcnt(0)" ::: "memory");
    __syncthreads();
    if (threadIdx.x == 0) {
        unsigned* bar = b.bar;
        __builtin_amdgcn_s_waitcnt(0);
        unsigned nloc = b.st[0], nx = b.st[1];
        if (nloc == 0u) { xcd_barrier_complete(bar, b.x, nloc, nx); b.st[0] = nloc; b.st[1] = nx; }
        const unsigned old = xb_add(&bar[XB_XSUB(b.x)], 1u);
        const unsigned gen = old / nloc;
        if (old + 1u == (gen + 1u) * nloc) {
            __builtin_amdgcn_fence(__ATOMIC_RELEASE, "agent");
            asm volatile("s_waitcnt vmcnt(0)" ::: "memory");
            const unsigned og = xb_add(&bar[XB_TOP], 1u);
            const unsigned tg = og / nx;
            if (og + 1u == (tg + 1u) * nx) xb_add(&bar[XB_TOPGEN], 1u);
            else XB_SPIN(xb_ld(&bar[XB_TOPGEN]) == tg, bar);
            __builtin_amdgcn_fence(__ATOMIC_ACQUIRE, "agent");
            xb_add(&bar[XB_XGEN(b.x)], 1u);
            asm volatile("s_waitcnt vmcnt(0)" ::: "memory");
        } else {
            XB_SPIN(xb_ld(&bar[XB_XGEN(b.x)]) == gen, bar);
            __builtin_amdgcn_fence(__ATOMIC_ACQUIRE, "agent");
            asm volatile("s_waitcnt vmcnt(0)" ::: "memory");
        }
    }
    __syncthreads();
}

__device__ __forceinline__ void p1_row(int row, const float* __restrict__ xsrc, const float* __restrict__ csrc, const float* __restrict__ modl, const float* __restrict__ nw,
                                       bf16_t* __restrict__ H, int lane) {
    const bool lat = row < MLAT; const int mi = lat ? (row >> 12) : 4;
    const f32x4* xr = (const f32x4*)(lat ? xsrc + (size_t)row * DM : csrc + (size_t)(row - MLAT) * DM) + lane;
    f32x4 v[8]; float s = 0.f;
#pragma unroll
    for (int j = 0; j < 8; ++j) { v[j] = xr[64 * j]; s += (v[j][0] * v[j][0] + v[j][1] * v[j][1]) + (v[j][2] * v[j][2] + v[j][3] * v[j][3]); }
    const float rinv = rsqrtf(wave_sum(s) * (1.f / DM) + EPS);
    const f32x4* sh = (const f32x4*)(modl + mi * 6144) + lane; const f32x4* scl = (const f32x4*)(modl + mi * 6144 + DM) + lane; const f32x4* nwp = (const f32x4*)nw + lane;
    u32x2* o8 = (u32x2*)(H + (size_t)row * DM) + lane;
#pragma unroll
    for (int j = 0; j < 8; ++j) { const f32x4 y = v[j] * rinv * nwp[64 * j] * (scl[64 * j] + 1.f) + sh[64 * j];
        u32x2 w; w.x = cvt_pk_bf16(y[0], y[1]); w.y = cvt_pk_bf16(y[2], y[3]); o8[64 * j] = w; }
}

__device__ __forceinline__ void p1_row2(int rowA, int rowB, const float* __restrict__ xsrc, const float* __restrict__ csrc, const float* __restrict__ modl,
                                        const float* __restrict__ nw, bf16_t* __restrict__ H, int lane) {
    if (rowB < 0) { p1_row(rowA, xsrc, csrc, modl, nw, H, lane); return; }
    const bool latA = rowA < MLAT, latB = rowB < MLAT; const int miA = latA ? (rowA >> 12) : 4, miB = latB ? (rowB >> 12) : 4;
    const f32x4* xa = (const f32x4*)(latA ? xsrc + (size_t)rowA * DM : csrc + (size_t)(rowA - MLAT) * DM) + lane;
    const f32x4* xb = (const f32x4*)(latB ? xsrc + (size_t)rowB * DM : csrc + (size_t)(rowB - MLAT) * DM) + lane;
    f32x4 va[8], vb[8]; float sa = 0.f, sb = 0.f;
#pragma unroll
    for (int j = 0; j < 8; ++j) { va[j] = xa[64 * j]; vb[j] = xb[64 * j]; }
#pragma unroll
    for (int j = 0; j < 8; ++j) { sa += (va[j][0] * va[j][0] + va[j][1] * va[j][1]) + (va[j][2] * va[j][2] + va[j][3] * va[j][3]);
                                  sb += (vb[j][0] * vb[j][0] + vb[j][1] * vb[j][1]) + (vb[j][2] * vb[j][2] + vb[j][3] * vb[j][3]); }
    const float ra = rsqrtf(wave_sum(sa) * (1.f / DM) + EPS), rb = rsqrtf(wave_sum(sb) * (1.f / DM) + EPS);
    const f32x4* nwp = (const f32x4*)nw + lane;
    const f32x4* sha = (const f32x4*)(modl + miA * 6144) + lane; const f32x4* sca = (const f32x4*)(modl + miA * 6144 + DM) + lane;
    const f32x4* shb = (const f32x4*)(modl + miB * 6144) + lane; const f32x4* scb = (const f32x4*)(modl + miB * 6144 + DM) + lane;
    u32x2* oa = (u32x2*)(H + (size_t)rowA * DM) + lane; u32x2* ob = (u32x2*)(H + (size_t)rowB * DM) + lane;
#pragma unroll
    for (int j = 0; j < 8; ++j) { const f32x4 w4 = nwp[64 * j];
        const f32x4 ya = va[j] * ra * w4 * (sca[64 * j] + 1.f) + sha[64 * j], yb = vb[j] * rb * w4 * (scb[64 * j] + 1.f) + shb[64 * j];
        u32x2 wa, wb; wa.x = cvt_pk_bf16(ya[0], ya[1]); wa.y = cvt_pk_bf16(ya[2], ya[3]); wb.x = cvt_pk_bf16(yb[0], yb[1]); wb.y = cvt_pk_bf16(yb[2], yb[3]);
        oa[64 * j] = wa; ob[64 * j] = wb; }
}

struct Args { const float* in[29]; float* out; unsigned char* ws; int ph_lo, ph_hi, coop, pad; };

__global__ void __launch_bounds__(512, 2) mega_fwd(Args args) {
    extern __shared__ __attribute__((aligned(16))) unsigned char lds_raw[];
    LAS unsigned char* lds = (LAS unsigned char*)lds_raw;
    const int G = gridDim.x;
    unsigned char* ws = args.ws;
    float* MOD = (float*)(ws + WS_MOD);
    float* TC64 = (float*)(ws + WS_TC64); float* TS64 = (float*)(ws + WS_TS64); float* TC128 = (float*)(ws + WS_TC128); float* TS128 = (float*)(ws + WS_TS128);
    float* LAM = (float*)(ws + WS_LAM);
    bf16_t* WIN = (bf16_t*)(ws + WS_WIN); bf16_t* WUP = (bf16_t*)(ws + WS_WUP); bf16_t* WBR = (bf16_t*)(ws + WS_WBR); bf16_t* WOUT = (bf16_t*)(ws + WS_WOUT);
    bf16_t* H = (bf16_t*)(ws + WS_H); bf16_t* QA = (bf16_t*)(ws + WS_QA); bf16_t* KA = (bf16_t*)(ws + WS_KA); bf16_t* VA = (bf16_t*)(ws + WS_VA);
    bf16_t* QB = (bf16_t*)(ws + WS_QB); bf16_t* KB = (bf16_t*)(ws + WS_KB); bf16_t* CKV = (bf16_t*)(ws + WS_CKV); bf16_t* VB = (bf16_t*)(ws + WS_VB);
    bf16_t* QC = (bf16_t*)(ws + WS_QC); bf16_t* KC = (bf16_t*)(ws + WS_KC); bf16_t* VC = (bf16_t*)(ws + WS_VC);
    bf16_t* GATE = (bf16_t*)(ws + WS_GATE); bf16_t* MRG = (bf16_t*)(ws + WS_MRG); bf16_t* BR = (bf16_t*)(ws + WS_BR); bf16_t* Y = (bf16_t*)(ws + WS_Y);
    float* SS = (float*)(ws + WS_SS); float* CTXW = (float*)(ws + WS_CTXW); float* SCR = (float*)(ws + WS_SCR);
    LAS float* xch = (LAS float*)(lds + XCH_OFF);
    volatile LAS unsigned* bst = (volatile LAS unsigned*)(lds + XCH_OFF + 4096);
    if (threadIdx.x < 2) bst[threadIdx.x] = 0u;
    __syncthreads();
    XcdBarrier bar = xcd_barrier_post((unsigned*)(ws + WS_BAR), bst);

    for (int ph = args.ph_lo; ph < args.ph_hi; ++ph) {
        int bx = blockIdx.x; asm volatile("" : "+s"(bx));
        const int vcu = (G % 8 == 0) ? (bx % 8) * (G / 8) + bx / 8 : bx;
        int tid = threadIdx.x; asm volatile("" : "+v"(tid));
        const int lane = tid & 63, wave = __builtin_amdgcn_readfirstlane(tid >> 6);
        if (ph == 0 && (MK_MASK & 1)) {
            {
                LAS float* sc = (LAS float*)lds;
                LAS float* red = (LAS float*)(lds + 65536);
                for (int i = tid; i < 5 * DM; i += 512) { const float v = i < 4 * DM ? args.in[1][i] : args.in[3][i - 4 * DM]; sc[i] = silu_f(v); }
                __syncthreads();
                for (int it = bx; it < DEPTH * 96; it += G) {
                    const int l = it / 96, n0 = (it % 96) * 64;
                    const float* W = args.in[5] + (size_t)l * DM * 6144 + n0 + lane;
                    float a0 = 0.f, a1 = 0.f, a2 = 0.f, a3 = 0.f, a4 = 0.f;
                    const int kb = wave * 256;
#pragma unroll 8
                    for (int k = 0; k < 256; ++k) { const float wv = W[(size_t)(kb + k) * 6144];
                        a0 += sc[kb + k] * wv; a1 += sc[DM + kb + k] * wv; a2 += sc[2 * DM + kb + k] * wv; a3 += sc[3 * DM + kb + k] * wv; a4 += sc[4 * DM + kb + k] * wv; }
                    red[(wave * 5 + 0) * 64 + lane] = a0; red[(wave * 5 + 1) * 64 + lane] = a1; red[(wave * 5 + 2) * 64 + lane] = a2; red[(wave * 5 + 3) * 64 + lane] = a3; red[(wave * 5 + 4) * 64 + lane] = a4;
                    __syncthreads();
                    if (tid < 320) { const int i = tid >> 6; float s = 0.f;
                        for (int w8 = 0; w8 < 8; ++w8) s += red[(w8 * 5 + i) * 64 + lane];
                        MOD[((size_t)l * 5 + i) * 6144 + n0 + lane] = s + args.in[6][(size_t)l * 6144 + n0 + lane]; }
                    __syncthreads();
                }
            }
            if (bx == 1 % G) {
                for (int i = tid; i < 64 * 16; i += 512) { const int pos = i >> 4, f = i & 15; const float ang = (float)pos * INVF32[f]; float s, c; sincos_d((double)ang, s, c); TC64[i] = c; TS64[i] = s; }
                for (int i = tid; i < 64 * 32; i += 512) { const int pos = i >> 5, f = i & 31; const float ang = (float)pos * INVF64[f]; float s, c; sincos_d((double)ang, s, c); TC128[i] = c; TS128[i] = s; }
            }
            if (bx == 2 % G && tid < DEPTH) {
                const int l = tid;
                float s1 = 0.f, s2 = 0.f;
                for (int i = 0; i < 64; ++i) { s1 += args.in[20][l * 64 + i] * args.in[21][l * 64 + i]; s2 += args.in[22][l * 64 + i] * args.in[23][l * 64 + i]; }
                const float lam_init = 0.8f - 0.6f * expf(-0.3f * (float)l);
                LAM[l * 4 + 0] = expf(s1) - expf(s2) + lam_init;
                const float mAq = absmax_n(args.in[9] + l * 128, 128), mAk = absmax_n(args.in[10] + l * 128, 128);
                const float mBqn = absmax_n(args.in[11] + l * 128, 128), mBqr = absmax_n(args.in[12] + l * 64, 64), mBkn = absmax_n(args.in[16] + l * 128, 128), mBkr = absmax_n(args.in[17] + l * 64, 64);
                const float mCq = absmax_n(args.in[18] + l * 64, 64), mCk = absmax_n(args.in[19] + l * 64, 64);
                const float L2E = 1.4426950408889634f;
                LAM[l * 4 + 1] = -(sqrtf(128.f) * mAq * mAk) * L2E;
                LAM[l * 4 + 2] = -(sqrtf(128.f * mBqn * mBqn + 64.f * mBqr * mBqr) * sqrtf(128.f * mBkn * mBkn + 64.f * mBkr * mBkr) * 0.07216878364870323f) * L2E;
                LAM[l * 4 + 3] = -(8.f * mCq * mCk) * L2E;
            }
            __syncthreads();
            {
                LAS float* scr = (LAS float*)(lds + wave * 16640);
                const int gw = vcu * 8 + wave, NGW = G * 8;
                constexpr int I_IN = 32 * (NIN / 64), I_UP = 8 * 32, I_BR = 3 * 16 * 32, I_OUT = 32 * 32, I_L = I_IN + I_UP + I_BR + I_OUT;
                const int n4 = (lane & 15) * 4;
                for (int it = gw; it < DEPTH * I_L; it += NGW) {
                    const int l = it / I_L; int r = it % I_L;
                    if (r < I_IN) { const int nb = r % (NIN / 64), kb = r / (NIN / 64); const int n0 = nb * 64;
                        transpose_item(args.in[7] + (size_t)l * DM * INC, INC, kb * 64, in_src_col(n0 + n4), nullptr, WIN + (size_t)l * NIN * DM, DM, n0, 0, scr, lane); continue; }
                    r -= I_IN;
                    if (r < I_UP) { const int nb = r % 32, kb = r / 32; const int n0 = nb * 64; const int sc_ = up_src_col(n0 + n4);
                        const float* W = (sc_ < 1024 ? args.in[14] : args.in[15]) + (size_t)l * 512 * 1024;
                        transpose_item(W, 1024, kb * 64, sc_ & 1023, args.in[13] + l * 512, WUP + (size_t)l * 2048 * 512, 512, n0, 0, scr, lane); continue; }
                    r -= I_UP;
                    if (r < I_BR) { const int br = r / (16 * 32), r2 = r % (16 * 32); const int nb = r2 % 32, kb = r2 / 32; const int n0 = nb * 64;
                        transpose_item(args.in[25 + br] + (size_t)l * 1024 * DM, DM, kb * 64, n0 + n4, nullptr, WBR + (size_t)l * 2048 * 3072, 3072, n0, br * 1024, scr, lane); continue; }
                    r -= I_BR;
                    { const int nb = r % 32, kb = r / 32; const int n0 = nb * 64;
                      transpose_item(args.in[28] + (size_t)l * DM * DM, DM, kb * 64, n0 + n4, nullptr, WOUT + (size_t)l * DM * DM, DM, n0, 0, scr, lane); }
                }
            }
        } else {
            const int l = (ph == 1) ? 0 : (ph - 2) / 3, st_ = (ph == 1) ? 0 : 1 + (ph - 2) % 3, st = (st_ >= 2) ? st_ + 1 : st_;
            const float* xsrc = (l == 0) ? args.in[0] : args.out;
            const float* csrc = (l == 0) ? args.in[2] : CTXW;
            const float* modl = MOD + (size_t)l * 5 * 6144;
            const int Mrows = (l == DEPTH - 1) ? MLAT : MTOT;
            if (st == 0 && (MK_MASK & 2)) {
                const float* nw = args.in[4] + (size_t)l * DM;
                for (int row = bx * 8 + wave; row < MTOT; row += G * 16) { const int rb = row + G * 8; p1_row2(row, rb < MTOT ? rb : -1, xsrc, csrc, modl, nw, H, lane); }
            } else if (st == 1 && (MK_MASK & 4)) {
                pg8::Gemm g{H, WIN + (size_t)l * NIN * DM, MTOT, NIN, DM};
                EpiIn E{QA, KA, VA, QB, KB, CKV, QC, KC, VC, GATE, MRG, SS,
                        args.in[9] + l * 128, args.in[10] + l * 128, args.in[11] + l * 128, args.in[12] + l * 64, args.in[17] + l * 64, args.in[18] + l * 64, args.in[19] + l * 64,
                        args.in[8] + (size_t)l * 6144, TC64, TS64, TC128, TS128, xch};
                const bool trim = (l == DEPTH - 1) && (G == 256);
                for (int part = 0; part < 2; ++part) {
                    pg8::StaticOrder S;
                    if (!trim) { if (part) break; S.init(MTOT, NIN, G, bx); }
                    else if (part == 0) S.init(MLAT, NIN, G, bx);
                    else { if (!(bx >= 192 && bx < 244)) break; const int k = bx - 192, j = k % 13;
                           const int pn = (j < 2) ? 4 + j : (j < 5 ? 10 + j : 14 + j);
                           S.init_one(64 + k / 13, pn); }
                    { int t2 = threadIdx.x; asm volatile("" : "+v"(t2)); pg8::gemm_phase<EpiIn>(lds, g, S, E, t2); }
                }
            } else if (st == 3 && (MK_MASK & 16)) {
                unsigned* UPC = (unsigned*)(ws + WS_CNT) + (size_t)(2 * DEPTH * 68 + l) * 64;
                const bool merged = (G == 256) && args.coop;
                {
                    pg8::Gemm g{CKV, WUP + (size_t)l * 2048 * 512, MTOT, 2048, 512}; pg8::StaticOrder S; S.init(MTOT, 2048, G, bx);
                    EpiUp E{KB, VB, SS, args.in[16] + l * 128, xch};
                    pg8::gemm_phase<EpiUp>(lds, g, S, E, tid);
                    if (merged) {
                        if (threadIdx.x == 0) {
                            __builtin_amdgcn_fence(__ATOMIC_RELEASE, "agent");
                            asm volatile("s_waitcnt vmcnt(0)" ::: "memory");
                            const unsigned n = (bx < 544) ? (unsigned)((544 - 1 - bx) / G + 1) : 0u;
                            __hip_atomic_fetch_add(UPC, n, __ATOMIC_RELAXED, __HIP_MEMORY_SCOPE_AGENT);
                        }
                    } else if (args.coop) xcd_barrier(bar);
                }
                AttnBufs T{QA, KA, VA, QB, KB, VB, QC, KC, VC, GATE, BR, SCR, LAM + l * 4, args.in[24] + l * 128, 0.8f - 0.6f * expf(-0.3f * (float)l)};
                const int nctx = (l < DEPTH - 1) ? 96 : 0;
                for (int k = 0;; ++k) {
                    int type, b, h, qrow0, NT;
                    if (G == 256) {
                        if (k == 4 && merged) {
                            if (threadIdx.x == 0) { unsigned sp = 0;
                                while (__hip_atomic_load(UPC, __ATOMIC_RELAXED, __HIP_MEMORY_SCOPE_AGENT) < 544u) { __builtin_amdgcn_s_sleep(1); if (++sp > (1u << 22)) break; }
                                __builtin_amdgcn_fence(__ATOMIC_ACQUIRE, "agent");
                                asm volatile("s_waitcnt vmcnt(0)" ::: "memory"); }
                            __syncthreads();
                        }
                        if (k < 6) { const int id = (k & 1) * 256 + vcu; type = (k < 2) ? 0 : (k < 4 ? 2 : 1); b = id >> 7; h = (id >> 4) & 7; qrow0 = b * SEQ + (id & 15) * 256; NT = 68; }
                        else if (k == 6 && bx >= 256 - nctx) { const int c = bx - (256 - nctx); type = c >> 5; b = (c >> 3) & 3; h = c & 7; qrow0 = MLAT + b * CTXL; NT = 4; }
                        else break;
                    } else {
                        const int it = bx + k * G; if (it >= 1536 + nctx) break;
                        if (it < 1536) { const int id = it & 511; type = it >> 9; b = id >> 7; h = (id >> 4) & 7; qrow0 = b * SEQ + (id & 15) * 256; NT = 68; }
                        else { const int c = it - 1536; type = c >> 5; b = (c >> 3) & 3; h = c & 7; qrow0 = MLAT + b * CTXL; NT = 4; }
                    }
                    attn_item(T, type, b, h, qrow0, NT, (LAS char*)lds, tid);
                }
                __syncthreads();
            } else {
                unsigned* CNT = (unsigned*)(ws + WS_CNT) + (size_t)l * 68 * 64;
                const bool merged = (G == 256) && args.coop;
                const bool ctxl = l < DEPTH - 1;
                pg8::Gemm g3{BR, WBR + (size_t)l * 2048 * 3072, Mrows, 2048, 3072}; EpiBr E3{MRG, Y};
                pg8::Gemm g4{Y, WOUT + (size_t)l * DM * DM, Mrows, DM, DM}; EpiOut E4{xsrc, csrc, args.out, CTXW, modl};
                for (int part = 0; part < 2; ++part) {
                    pg8::StaticOrder S;
                    if (!merged) { if (part) break; S.init(Mrows, 2048, G, bx); }
                    else if (part == 0) S.init(MLAT, 2048, G, bx);
                    else { if (!(ctxl && bx < 32)) break; S.init_one(64 + (bx >> 3), bx & 7); }
                    { int t2 = threadIdx.x; asm volatile("" : "+v"(t2)); pg8::gemm_phase<EpiBr>(lds, g3, S, E3, t2); }
                    if (merged && threadIdx.x == 0) {
                        __builtin_amdgcn_fence(__ATOMIC_RELEASE, "agent");
                        asm volatile("s_waitcnt vmcnt(0)" ::: "memory");
                        pg8::Unit u; for (int i = 0; S.next(i, u); ++i) __hip_atomic_fetch_add(&CNT[u.pm * 64], 1u, __ATOMIC_RELAXED, __HIP_MEMORY_SCOPE_AGENT);
                    }
                }
                if (!merged && args.coop) xcd_barrier(bar);
                for (int part = 0; part < 3; ++part) {
                    pg8::StaticOrder S;
                    if (!merged) { if (part) break; S.init(Mrows, DM, G, bx); }
                    else if (part == 0) S.init(MLAT, DM, G, bx, 0, (ctxl && bx < 32) ? 1 : 2);
                    else if (part == 1) { if (!(ctxl && bx >= 32 && bx < 64)) continue; S.init_one(64 + ((bx - 32) >> 3), bx & 7); }
                    else { if (!(ctxl && bx >= 64 && bx < 96)) break; S.init(MLAT, DM, G, bx - 64, 1, 1); }
                    if (merged) {
                        if (threadIdx.x == 0) {
                            pg8::Unit u;
                            for (int i = 0; S.next(i, u); ++i) { unsigned sp = 0;
                                while (__hip_atomic_load(&CNT[u.pm * 64], __ATOMIC_RELAXED, __HIP_MEMORY_SCOPE_AGENT) < 8u) { __builtin_amdgcn_s_sleep(1); if (++sp > (1u << 22)) break; } }
                            __builtin_amdgcn_fence(__ATOMIC_ACQUIRE, "agent");
                            asm volatile("s_waitcnt vmcnt(0)" ::: "memory");
                        }
                        __syncthreads();
                    }
                    { int t2 = threadIdx.x; asm volatile("" : "+v"(t2)); pg8::gemm_phase<EpiOut>(lds, g4, S, E4, t2); }
                    if (merged && ctxl && threadIdx.x == 0) {
                        __builtin_amdgcn_fence(__ATOMIC_RELEASE, "agent");
                        asm volatile("s_waitcnt vmcnt(0)" ::: "memory");
                        pg8::Unit u; for (int i = 0; S.next(i, u); ++i) __hip_atomic_fetch_add(&CNT[(DEPTH * 68 + u.pm) * 64], 1u, __ATOMIC_RELAXED, __HIP_MEMORY_SCOPE_AGENT);
                    }
                }
                if (l < DEPTH - 1) {
                    const float* nw1 = args.in[4] + (size_t)(l + 1) * DM; const float* mod1 = MOD + (size_t)(l + 1) * 5 * 6144;
                    int t3 = threadIdx.x; asm volatile("" : "+v"(t3));
                    const int lane3 = t3 & 63, wave3 = __builtin_amdgcn_readfirstlane(t3 >> 6);
                    if (merged) {
                        const int r0 = 68 * bx;
                        if (threadIdx.x == 0) {
                            for (int pm = r0 >> 8; pm <= (r0 + 67) >> 8; ++pm) { unsigned sp = 0;
                                while (__hip_atomic_load(&CNT[(DEPTH * 68 + pm) * 64], __ATOMIC_RELAXED, __HIP_MEMORY_SCOPE_AGENT) < 8u) { __builtin_amdgcn_s_sleep(1); if (++sp > (1u << 22)) break; } }
                            __builtin_amdgcn_fence(__ATOMIC_ACQUIRE, "agent");
                            asm volatile("s_waitcnt vmcnt(0)" ::: "memory");
                        }
                        __syncthreads();
                        for (int row = r0 + wave3; row < r0 + 68; row += 16) { const int rb = row + 8; p1_row2(row, rb < r0 + 68 ? rb : -1, args.out, CTXW, mod1, nw1, H, lane3); }
                    } else {
                        if (args.coop) xcd_barrier(bar);
                        for (int row = bx * 8 + wave3; row < MTOT; row += G * 16) { const int rb = row + G * 8; p1_row2(row, rb < MTOT ? rb : -1, args.out, CTXW, mod1, nw1, H, lane3); }
                    }
                }
            }
        }
        if (ph + 1 < args.ph_hi) { if (args.coop) { if (ph == 0) cg::this_grid().sync(); else xcd_barrier(bar); } }
    }
}

extern "C" void kernel_launch(void* const* d_in, const int* in_sizes, int n_in, void* d_out, int out_size, void* d_ws, size_t ws_size, hipStream_t stream) {
    static int grid = 0;
    if (grid == 0) {
        if (n_in != 29 || in_sizes[0] != MLAT * DM || out_size != MLAT * DM || ws_size < WS_END) {
            fprintf(stderr, "kernel_launch: unexpected shapes: n_in %d in0 %d out %d ws %zu (need %zu)\n", n_in, n_in > 0 ? in_sizes[0] : -1, out_size, ws_size, (size_t)WS_END); grid = -1; return; }
        int dev = 0, cus = 0, per_cu = 0;
        if (hipGetDevice(&dev) != hipSuccess || hipDeviceGetAttribute(&cus, hipDeviceAttributeMultiprocessorCount, dev) != hipSuccess) { grid = -1; return; }
        if (hipFuncSetAttribute((const void*)mega_fwd, hipFuncAttributeMaxDynamicSharedMemorySize, LDS_BYTES) != hipSuccess) { fprintf(stderr, "kernel_launch: hipFuncSetAttribute failed\n"); grid = -1; return; }
        if (hipOccupancyMaxActiveBlocksPerMultiprocessor(&per_cu, (const void*)mega_fwd, 512, LDS_BYTES) != hipSuccess || per_cu < 1) { fprintf(stderr, "kernel_launch: occupancy query gives %d\n", per_cu); per_cu = 1; }
        (void)hipGetLastError();
        grid = cus * 1;
    }
    if (grid < 0) return;
    Args a{};
    for (int i = 0; i < 29; ++i) a.in[i] = (const float*)d_in[i];
    a.out = (float*)d_out; a.ws = (unsigned char*)d_ws;
#if MK_COOP
    if (hipMemsetAsync((char*)d_ws + WS_BAR, 0, 16384 + CNT_BYTES, stream) != hipSuccess) { fprintf(stderr, "kernel_launch: memset of the barrier words failed\n"); return; }
    a.ph_lo = 0; a.ph_hi = NPH; a.coop = 1;
    void* kargs[] = {&a};
    hipError_t e = hipLaunchCooperativeKernel((const void*)mega_fwd, dim3(grid), dim3(512), kargs, LDS_BYTES, stream);
    if (e != hipSuccess) fprintf(stderr, "kernel_launch: cooperative launch failed: %s (grid %d)\n", hipGetErrorString(e), grid);
#else
    for (int ph = 0; ph < NPH; ++ph) {
        a.ph_lo = ph; a.ph_hi = ph + 1; a.coop = 0;
        hipLaunchKernelGGL(mega_fwd, dim3(grid), dim3(512), LDS_BYTES, stream, a);
    }
    const hipError_t le = hipPeekAtLastError();
    if (le != hipSuccess) fprintf(stderr, "kernel_launch: launch failed: %s\n", hipGetErrorName(le));
#endif
}
```

```cpp
#include <hip/hip_runtime.h>
#include <hip/hip_cooperative_groups.h>
#include <cstdio>
#include <cstdint>
namespace cg = cooperative_groups;

#ifndef MK_MASK
#define MK_MASK 127
#endif
#ifndef MK_ATYPE
#define MK_ATYPE 7
#endif
#ifndef MK_G1T
#define MK_G1T 127
#endif
#ifndef ATT_SD_A
#define ATT_SD_A 2
#endif
#ifndef ATT_SD_B
#define ATT_SD_B 1
#endif
#ifndef ATT_SD_C
#define ATT_SD_C 2
#endif
#ifndef ATT_DBL_B
#define ATT_DBL_B true
#endif
#ifndef ATT_DBL
#define ATT_DBL false
#endif
#ifndef QKT_GRP
#define QKT_GRP 0
#endif
#ifndef MK_COOP
#define MK_COOP 1
#endif

#define LAS __attribute__((address_space(3)))
typedef unsigned short bf16_t;
typedef short bf16x8 __attribute__((ext_vector_type(8)));
typedef short s16x4 __attribute__((ext_vector_type(4)));
typedef float f32x4 __attribute__((ext_vector_type(4)));
typedef float f32x16 __attribute__((ext_vector_type(16)));
typedef unsigned u32x4 __attribute__((ext_vector_type(4)));
typedef unsigned u32x2 __attribute__((ext_vector_type(2)));

constexpr int DM = 2048, NBATCH = 4, SEQ = 4096, CTXL = 256, DEPTH = 4;
constexpr int MLAT = NBATCH * SEQ, MCTX = NBATCH * CTXL, MTOT = MLAT + MCTX;
constexpr int INC = 15936, NIN = 16128;
constexpr float EPS = 1e-6f;
#ifndef MK_REP_ST
#define MK_REP_ST -1
#endif
constexpr int PPL = 5;
constexpr int NPH = 2 + 3 * DEPTH;

constexpr size_t alignup(size_t x) { return (x + 255) / 256 * 256; }
constexpr size_t WS_MOD = 0;
constexpr size_t WS_TC64 = WS_MOD + alignup((size_t)DEPTH * 5 * 6144 * 4);
constexpr size_t WS_TS64 = WS_TC64 + 4096, WS_TC128 = WS_TS64 + 4096, WS_TS128 = WS_TC128 + 8192;
constexpr size_t WS_LAM = WS_TS128 + 8192;
constexpr size_t WS_BAR = WS_LAM + 256;
constexpr size_t WS_CNT = WS_BAR + 16384;
constexpr size_t CNT_BYTES = (size_t)(2 * DEPTH * 68 + DEPTH) * 256;
constexpr size_t WS_WIN = WS_CNT + CNT_BYTES;
constexpr size_t WS_WUP = WS_WIN + (size_t)DEPTH * NIN * DM * 2;
constexpr size_t WS_WBR = WS_WUP + (size_t)DEPTH * 2048 * 512 * 2;
constexpr size_t WS_WOUT = WS_WBR + (size_t)DEPTH * 2048 * 3072 * 2;
constexpr size_t WS_H = WS_WOUT + (size_t)DEPTH * 2048 * 2048 * 2;
constexpr size_t WS_QA = WS_H + (size_t)MTOT * 2048 * 2;
constexpr size_t WS_KA = WS_QA + (size_t)MTOT * 1024 * 2;
constexpr size_t WS_VA = WS_KA + (size_t)MTOT * 256 * 2;
constexpr size_t WS_QB = WS_VA + (size_t)MTOT * 256 * 2;
constexpr size_t WS_KB = WS_QB + (size_t)MTOT * 1536 * 2;
constexpr size_t WS_CKV = WS_KB + (size_t)MTOT * 1536 * 2;
constexpr size_t WS_VB = WS_CKV + (size_t)MTOT * 512 * 2;
constexpr size_t WS_QC = WS_VB + (size_t)MTOT * 1024 * 2;
constexpr size_t WS_KC = WS_QC + (size_t)MTOT * 1024 * 2;
constexpr size_t WS_VC = WS_KC + (size_t)MTOT * 1024 * 2;
constexpr size_t WS_GATE = WS_VC + (size_t)MTOT * 1024 * 2;
constexpr size_t WS_MRG = WS_GATE + (size_t)MTOT * 3072 * 2;
constexpr size_t WS_BR = WS_MRG + (size_t)MTOT * 6144 * 2;
constexpr size_t WS_Y = WS_BR + (size_t)MTOT * 3072 * 2;
constexpr size_t WS_SS = WS_Y + (size_t)MTOT * 2048 * 2;
constexpr size_t WS_CTXW = WS_SS + (size_t)MTOT * 8 * 4;
constexpr size_t WS_SCR = WS_CTXW + (size_t)MCTX * DM * 4;
constexpr size_t WS_END = WS_SCR + (size_t)256 * 64 * 512 * 4;

constexpr int RING_BYTES = 131072, XCH_OFF = RING_BYTES, LDS_BYTES = 147456;

__device__ __forceinline__ float bf2f(unsigned h) { return __uint_as_float(h << 16); }
__device__ __forceinline__ unsigned cvt_pk_bf16(float lo, float hi) { unsigned r; asm volatile("v_cvt_pk_bf16_f32 %0, %1, %2" : "=v"(r) : "v"(lo), "v"(hi)); return r; }
__device__ __forceinline__ float wave_sum(float v) {
#pragma unroll
    for (int o = 1; o < 64; o <<= 1) v += __shfl_xor(v, o);
    return v;
}
__device__ __forceinline__ float sigm_f(float x) { return __builtin_amdgcn_rcpf(1.f + __builtin_amdgcn_exp2f(-1.4426950408889634f * x)); }
__device__ __forceinline__ float silu_f(float x) { return x * sigm_f(x); }
__device__ __forceinline__ unsigned cvt_pk_bf16_safe(float lo, float hi) { unsigned r; asm volatile("s_nop 1\n\tv_cvt_pk_bf16_f32 %0, %1, %2" : "=v"(r) : "v"(lo), "v"(hi)); return r; }
__device__ __forceinline__ void store8_safe(bf16_t* p, f32x4 a, f32x4 b) {
    u32x4 w; w.x = cvt_pk_bf16_safe(a[0], a[1]); w.y = cvt_pk_bf16_safe(a[2], a[3]); w.z = cvt_pk_bf16_safe(b[0], b[1]); w.w = cvt_pk_bf16_safe(b[2], b[3]);
    *(u32x4*)p = w;
}
__device__ __forceinline__ void store8(bf16_t* p, f32x4 a, f32x4 b) {
    u32x4 w; w.x = cvt_pk_bf16(a[0], a[1]); w.y = cvt_pk_bf16(a[2], a[3]); w.z = cvt_pk_bf16(b[0], b[1]); w.w = cvt_pk_bf16(b[2], b[3]);
    *(u32x4*)p = w;
}

namespace pg8 {
constexpr int BM = 256, BK = 64, HALF = 128, HTB = HALF * BK * 2, NXCD = 8, WGM = 8;
__host__ __device__ __forceinline__ int lds_byte(int r, int c) { const int st = (r >> 4) * 2 + (c >> 5), rr = r & 15, cc = c & 31, ob = rr * 64 + cc * 2; return st * 1024 + (ob ^ (((ob >> 9) & 1) << 5)); }
__host__ __device__ __forceinline__ void stage_rc(int b, int& R, int& C) { const int st = b / 1024, sb = b % 1024, swz = sb ^ (((sb >> 9) & 1) << 5); R = (st >> 1) * 16 + swz / 64; C = (st & 1) * 32 + (swz % 64) / 2; }
__host__ __device__ __forceinline__ int perm32(int rho) { const int n = rho >> 4, i = rho & 15; return 8 * (i >> 2) + 4 * n + (i & 3); }

struct Unit { int pm, pn; };
struct Gemm { const bf16_t* A; const bf16_t* Bt; int M, N, K; };
struct StaticOrder {
    int nM, nN, nwg, G, c, fixed, fpm, fpn, i0, cnt;
    __device__ void init(int M, int N, int G_, int c_, int i0_ = 0, int cnt_ = 1 << 30) { nM = M / BM; nN = N / BM; nwg = nM * nN; G = G_; c = c_; fixed = 0; fpm = 0; fpn = 0; i0 = i0_; cnt = cnt_; }
    __device__ void init_one(int pm, int pn) { nM = 1; nN = 1; nwg = 1; G = 1; c = 0; fixed = 1; fpm = pm; fpn = pn; i0 = 0; cnt = 1; }
    __device__ bool next(int i, Unit& u) const {
        if (fixed) { if (i > 0) return false; u.pm = fpm; u.pn = fpn; return true; }
        if (i >= cnt) return false;
        const long L = (long)(i + i0) * G + c; if (L >= nwg) return false;
        int wgid = (int)L; { const int q = nwg / NXCD, r = nwg % NXCD, xcd = wgid % NXCD, off = wgid / NXCD; wgid = (xcd < r ? xcd * (q + 1) : r * (q + 1) + (xcd - r) * q) + off; }
        const int nig = WGM * nN, gid = wgid / nig, fm = gid * WGM, gsz = (nM - fm) < WGM ? (nM - fm) : WGM;
        u.pm = fm + ((wgid % nig) % gsz); u.pn = (wgid % nig) / gsz; return true;
    }
};

template <class Epi>
__device__ __forceinline__ void gemm_phase(LAS unsigned char* lds, const Gemm g, const StaticOrder& S, const Epi& E, const int tid) {
    const int wid = __builtin_amdgcn_readfirstlane(tid >> 6), lane = tid & 63, wr = wid >> 2, wc = wid & 3, fr = lane & 15, fq = lane >> 4;
    const int K = g.K, nt = K / BK;
    unsigned voffA[2], voffB[2];
#pragma unroll
    for (int i = 0; i < 2; ++i) { int R, C; stage_rc(tid * 16 + i * 8192, R, C); const int Rb = (R & ~31) + perm32(R & 31);
        voffA[i] = (unsigned)(R * K + C) * 2u; voffB[i] = (unsigned)(Rb * K + C) * 2u; }
    const size_t kstep = (size_t)(BK * 2);
    const size_t hstep = (size_t)HALF * K * 2;
    const size_t tstep = 2 * hstep;
    const unsigned ldsw = (unsigned)wid * 1024u;
    const int aoff = lds_byte(wr * 64 + fr, fq * 8), boff = lds_byte(wc * 32 + fr, fq * 8);
#define PG8_SA(b, h) (((b) * 2 + (h)) * HTB)
#define PG8_SB(b, h) ((4 + (b) * 2 + (h)) * HTB)
#define PG8_STAGE(bufoff, gbase, voff) do { _Pragma("unroll") for (int _i = 0; _i < 2; ++_i) \
        __builtin_amdgcn_global_load_lds((const unsigned*)((const char*)(gbase) + (voff)[_i]), (LAS unsigned*)(lds + (bufoff) + ldsw + _i * 8192), 16, 0, 0); } while (0)
#define PG8_LDA(dst, b, h) do { _Pragma("unroll") for (int m = 0; m < 4; ++m) _Pragma("unroll") for (int k = 0; k < 2; ++k) dst[m][k] = *(const LAS bf16x8*)(lds + PG8_SA(b, h) + aoff + m * 2048 + k * 1024); } while (0)
#define PG8_LDB(dst, b, h) do { _Pragma("unroll") for (int n = 0; n < 2; ++n) _Pragma("unroll") for (int k = 0; k < 2; ++k) dst[n][k] = *(const LAS bf16x8*)(lds + PG8_SB(b, h) + boff + n * 2048 + k * 1024); } while (0)
#define PG8_MMA(ai, bj, At, Bt) do { __builtin_amdgcn_s_setprio(1); _Pragma("unroll") for (int m = 0; m < 4; ++m) _Pragma("unroll") for (int n = 0; n < 2; ++n) _Pragma("unroll") for (int k = 0; k < 2; ++k) \
        acc[ai][bj][m][n] = __builtin_amdgcn_mfma_f32_16x16x32_bf16(Bt[n][k], At[m][k], acc[ai][bj][m][n], 0, 0, 0); __builtin_amdgcn_s_setprio(0); } while (0)
#define PG8_WAIT_V(n) asm volatile("s_waitcnt vmcnt(" #n ")" ::: "memory")
#define PG8_WAIT_L(n) asm volatile("s_waitcnt lgkmcnt(" #n ")" ::: "memory")
#define PG8_BAR __builtin_amdgcn_s_barrier()
#define PG8_SCHED __builtin_amdgcn_sched_barrier(0)
    Unit cur, nxt; int ui = 0;
    if (!S.next(0, cur)) return;
    f32x4 acc[2][2][4][2];
#pragma unroll
    for (int a = 0; a < 2; ++a)
#pragma unroll
        for (int b = 0; b < 2; ++b)
#pragma unroll
            for (int m = 0; m < 4; ++m)
#pragma unroll
                for (int n = 0; n < 2; ++n) acc[a][b][m][n] = (f32x4){0.f, 0.f, 0.f, 0.f};
    bf16x8 At[4][2], B0[2][2], B1[2][2];
    const char* cA = (const char*)g.A + (size_t)cur.pm * tstep; const char* cB = (const char*)g.Bt + (size_t)cur.pn * tstep;
    PG8_STAGE(PG8_SB(0, 0), cB, voffB); PG8_STAGE(PG8_SB(0, 1), cB + hstep, voffB); PG8_STAGE(PG8_SA(0, 0), cA, voffA); PG8_STAGE(PG8_SA(0, 1), cA + hstep, voffA);
    if (wr == 1) PG8_BAR;
    PG8_WAIT_V(2); PG8_BAR;
    PG8_STAGE(PG8_SB(1, 0), cB + kstep, voffB); PG8_STAGE(PG8_SA(1, 0), cA + kstep, voffA); PG8_STAGE(PG8_SB(1, 1), cB + hstep + kstep, voffB);
    PG8_WAIT_V(6); PG8_BAR;
    for (;;) {
        const bool has_next = S.next(ui + 1, nxt);
        const char* nA = has_next ? (const char*)g.A + (size_t)nxt.pm * tstep : cA; const char* nB = has_next ? (const char*)g.Bt + (size_t)nxt.pn * tstep : cB;
        for (int t = 0; t < nt; t += 2) {
            const bool last = (t == nt - 2);
            const char* a1 = cA + (size_t)(t + 1) * kstep;
            const char* a2 = last ? nA : cA + (size_t)(t + 2) * kstep; const char* b2 = last ? nB : cB + (size_t)(t + 2) * kstep;
            const char* a3 = a2 + kstep; const char* b3 = b2 + kstep;
            if constexpr (Epi::MID) { if (t == 16 || t == 32) { int fr_ = fr, fq_ = fq, wr_ = wr, wc_ = wc;
                asm volatile("" : "+v"(fr_), "+v"(fq_)); asm volatile("" : "+s"(wr_), "+s"(wc_));
                E.mid(acc, cur, t >> 4, wr_, wc_, fr_, fq_); PG8_WAIT_V(0); PG8_SCHED; } }
            PG8_LDB(B0, 0, 0); PG8_LDB(B1, 0, 1); PG8_SCHED; PG8_LDA(At, 0, 0); PG8_STAGE(PG8_SA(1, 1), a1 + hstep, voffA);
            PG8_WAIT_V(8); PG8_WAIT_L(0); PG8_BAR; PG8_MMA(0, 0, At, B0); PG8_MMA(0, 1, At, B1); PG8_BAR; PG8_SCHED;
            PG8_LDA(At, 0, 1); PG8_STAGE(PG8_SB(0, 0), b2, voffB); PG8_STAGE(PG8_SB(0, 1), b2 + hstep, voffB); PG8_STAGE(PG8_SA(0, 0), a2, voffA);
            PG8_WAIT_V(8); PG8_WAIT_L(0); PG8_BAR; PG8_MMA(1, 0, At, B0); PG8_MMA(1, 1, At, B1); PG8_BAR; PG8_SCHED;
            PG8_LDB(B0, 1, 0); PG8_LDB(B1, 1, 1); PG8_SCHED; PG8_LDA(At, 1, 0); PG8_STAGE(PG8_SA(0, 1), a2 + hstep, voffA);
            PG8_WAIT_V(8); PG8_WAIT_L(0); PG8_BAR; PG8_MMA(0, 0, At, B0); PG8_MMA(0, 1, At, B1); PG8_BAR; PG8_SCHED;
            PG8_LDA(At, 1, 1); PG8_STAGE(PG8_SB(1, 0), b3, voffB); PG8_STAGE(PG8_SB(1, 1), b3 + hstep, voffB); PG8_STAGE(PG8_SA(1, 0), a3, voffA);
            PG8_WAIT_V(8); PG8_WAIT_L(0); PG8_BAR; PG8_MMA(1, 0, At, B0); PG8_MMA(1, 1, At, B1); PG8_BAR; PG8_SCHED;
        }
        if (wr == 0) PG8_BAR;
        { int fr_ = fr, fq_ = fq, wr_ = wr, wc_ = wc, wid_ = wid;
          asm volatile("" : "+v"(fr_), "+v"(fq_)); asm volatile("" : "+s"(wr_), "+s"(wc_), "+s"(wid_));
          E(acc, cur, wr_, wc_, fr_, fq_, wid_); }
        if (!has_next) break;
#pragma unroll
        for (int a = 0; a < 2; ++a)
#pragma unroll
            for (int b = 0; b < 2; ++b)
#pragma unroll
                for (int m = 0; m < 4; ++m)
#pragma unroll
                    for (int n = 0; n < 2; ++n) acc[a][b][m][n] = (f32x4){0.f, 0.f, 0.f, 0.f};
        cur = nxt; cA = nA; cB = nB; ++ui;
        if (wr == 1) PG8_BAR;
    }
    PG8_WAIT_V(0);
    PG8_BAR;
#undef PG8_SA
#undef PG8_SB
#undef PG8_STAGE
#undef PG8_LDA
#undef PG8_LDB
#undef PG8_MMA
#undef PG8_WAIT_V
#undef PG8_WAIT_L
#undef PG8_BAR
#undef PG8_SCHED
}
}
using pg8::Unit;

__device__ __forceinline__ int in_src_col(int n) {
    const int tile = n >> 8, s = n & 255, bj = s >> 7, wc = (s >> 5) & 3, c = s & 31;
    const int d128 = 64 * (wc & 1) + 32 * bj + c, g128 = wc >> 1;
    const int d64 = 32 * (c >> 4) + 16 * bj + (c & 15), g64 = wc;
    if (tile < 4) return (tile * 2 + g128) * 128 + d128;
    if (tile == 4) return 1024 + g128 * 128 + d128;
    if (tile == 5) return 1280 + s;
    if (tile < 10) return 1536 + ((tile - 6) * 2 + g128) * 192 + d128;
    if (tile < 12) return 1536 + ((tile - 10) * 4 + g64) * 192 + 128 + d64;
    if (tile < 14) return 3072 + (tile - 12) * 256 + s;
    if (tile == 14) return g64 == 0 ? 3584 + d64 : -1;
    if (tile < 19) return 3648 + ((tile - 15) * 4 + g64) * 64 + d64;
    if (tile < 23) return 4672 + ((tile - 19) * 4 + g64) * 64 + d64;
    if (tile < 27) return 5696 + (tile - 23) * 256 + s;
    if (tile < 39) return 6720 + (tile - 27) * 256 + s;
    return 9792 + (tile - 39) * 256 + s;
}
__device__ __forceinline__ int up_src_col(int n) {
    if (n >= 1024) return n;
    const int tile = n >> 8, s = n & 255, bj = s >> 7, wc = (s >> 5) & 3, c = s & 31;
    return (tile * 2 + (wc >> 1)) * 128 + 64 * (wc & 1) + 32 * bj + c;
}

template <int GS>
__device__ __forceinline__ void norm_rope_store(const f32x4 (&acc)[2][2][4][2], int pm, int wr, int wc, int fr, int fq, int wid,
                                                const float* __restrict__ w, const float* __restrict__ tcos, const float* __restrict__ tsin, bool rope,
                                                const float (&pre)[2][4], bf16_t* __restrict__ dst, int ld, int gbase, int ncopies, int copystride, LAS float* xch, const float qs = 1.f) {
    const int dbase = (GS == 128) ? 64 * (wc & 1) + 8 * fq : 32 * (fq >> 1) + 8 * (fq & 1);
    const int bjs = (GS == 128) ? 32 : 16;
    const int axis = (GS == 128) ? (wc & 1) : (fq >> 1);
    const int i0 = (GS == 128) ? 8 * fq : 8 * (fq & 1);
    constexpr int NF = (GS == 128) ? 32 : 16;
    const int wavebase = gbase + ((GS == 128) ? 64 * (wc & 1) : 0) + 8 * fq;
    float ssq[2][4];
#pragma unroll
    for (int ai = 0; ai < 2; ++ai)
#pragma unroll
        for (int m = 0; m < 4; ++m) {
            float s = 0.f;
#pragma unroll
            for (int bj = 0; bj < 2; ++bj)
#pragma unroll
                for (int n = 0; n < 2; ++n)
#pragma unroll
                    for (int j = 0; j < 4; ++j) { const float v = acc[ai][bj][m][n][j] * pre[ai][m]; s += v * v; }
            s += __shfl_xor(s, 16); s += __shfl_xor(s, 32);
            ssq[ai][m] = s;
        }
    if constexpr (GS == 128) {
        if (fq == 0) {
#pragma unroll
            for (int ai = 0; ai < 2; ++ai)
#pragma unroll
                for (int m = 0; m < 4; ++m) xch[wid * 128 + ai * 64 + m * 16 + fr] = ssq[ai][m];
        }
        asm volatile("s_waitcnt lgkmcnt(0)" ::: "memory"); __builtin_amdgcn_s_barrier();
#pragma unroll
        for (int ai = 0; ai < 2; ++ai)
#pragma unroll
            for (int m = 0; m < 4; ++m) ssq[ai][m] += xch[(wid ^ 1) * 128 + ai * 64 + m * 16 + fr];
    }
#pragma unroll
    for (int ai = 0; ai < 2; ++ai)
#pragma unroll
        for (int mh = 0; mh < 2; ++mh) {
            u32x4 k0[2], k1[2];
            float rinv[2]; int pos[2];
#pragma unroll
            for (int mm = 0; mm < 2; ++mm) { const int m = mh * 2 + mm, rl = ai * 128 + wr * 64 + m * 16 + fr, t = (pm & 15) * 256 + rl;
                rinv[mm] = rsqrtf(ssq[ai][m] * (1.f / GS) + EPS) * pre[ai][m] * qs; pos[mm] = axis ? (t & 63) : (t >> 6); }
#pragma unroll
            for (int n = 0; n < 2; ++n) {
                const f32x4 w0 = *(const f32x4*)(w + dbase + 4 * n), w1 = *(const f32x4*)(w + dbase + bjs + 4 * n);
                f32x4 c[2], sn[2];
                if (rope) {
#pragma unroll
                    for (int mm = 0; mm < 2; ++mm) { c[mm] = *(const f32x4*)(tcos + pos[mm] * NF + i0 + 4 * n); sn[mm] = *(const f32x4*)(tsin + pos[mm] * NF + i0 + 4 * n); }
                }
#pragma unroll
                for (int mm = 0; mm < 2; ++mm) { const int m = mh * 2 + mm;
                    f32x4 y0 = acc[ai][0][m][n] * rinv[mm] * w0, y1 = acc[ai][1][m][n] * rinv[mm] * w1;
                    if (rope) { const f32x4 o0 = y0 * c[mm] - y1 * sn[mm], o1 = y1 * c[mm] + y0 * sn[mm]; y0 = o0; y1 = o1; }
                    if (n == 0) { k0[mm].x = cvt_pk_bf16(y0[0], y0[1]); k0[mm].y = cvt_pk_bf16(y0[2], y0[3]); k1[mm].x = cvt_pk_bf16(y1[0], y1[1]); k1[mm].y = cvt_pk_bf16(y1[2], y1[3]); }
                    else { k0[mm].z = cvt_pk_bf16(y0[0], y0[1]); k0[mm].w = cvt_pk_bf16(y0[2], y0[3]); k1[mm].z = cvt_pk_bf16(y1[0], y1[1]); k1[mm].w = cvt_pk_bf16(y1[2], y1[3]); }
                }
            }
#pragma unroll
            for (int mm = 0; mm < 2; ++mm) { const size_t row = (size_t)pm * 256 + ai * 128 + wr * 64 + (mh * 2 + mm) * 16 + fr;
                bf16_t* p = dst + row * ld + wavebase;
                for (int cp = 0; cp < ncopies; ++cp) { *(u32x4*)(p + cp * copystride) = k0[mm]; *(u32x4*)(p + cp * copystride + 32) = k1[mm]; } }
            __builtin_amdgcn_sched_barrier(0);
        }
}

struct EpiIn {
    static constexpr bool MID = false;
    bf16_t *QA, *KA, *VA, *QB, *KB, *CKV, *QC, *KC, *VC, *GATE, *MRG; float* SS;
    const float *wAq, *wAk, *wBqn, *wBqr, *wBkr, *wCq, *wCk, *bmerge;
    const float *tc64, *ts64, *tc128, *ts128;
    LAS float* xch;
    template <int ACT>
    __device__ __forceinline__ void plain(const f32x4 (&acc)[2][2][4][2], int pm, int wr, int wc, int fr, int fq, bf16_t* dst, int ld, int col0) const {
        const int colw = col0 + 32 * wc + 8 * fq;
        f32x4 b[2][2];
#pragma unroll
        for (int bj = 0; bj < 2; ++bj)
#pragma unroll
            for (int n = 0; n < 2; ++n) b[bj][n] = (ACT == 2) ? *(const f32x4*)(bmerge + colw + bj * 128 + 4 * n) : (f32x4){0.f, 0.f, 0.f, 0.f};
#pragma unroll
        for (int ai = 0; ai < 2; ++ai)
#pragma unroll
            for (int m = 0; m < 4; ++m) {
                const size_t row = (size_t)pm * 256 + ai * 128 + wr * 64 + m * 16 + fr;
#pragma unroll
                for (int bj = 0; bj < 2; ++bj) {
                    f32x4 v0 = acc[ai][bj][m][0], v1 = acc[ai][bj][m][1];
                    if (ACT == 1) { for (int j = 0; j < 4; ++j) { v0[j] = silu_f(v0[j]); v1[j] = silu_f(v1[j]); } }
                    if (ACT == 2) { v0 = v0 + b[bj][0]; v1 = v1 + b[bj][1]; for (int j = 0; j < 4; ++j) { v0[j] = sigm_f(v0[j]); v1[j] = sigm_f(v1[j]); } }
                    if (ACT == 0) store8(dst + row * ld + colw + bj * 128, v0, v1); else store8_safe(dst + row * ld + colw + bj * 128, v0, v1);
                }
                __builtin_amdgcn_sched_barrier(0);
            }
    }
    __device__ __forceinline__ void operator()(const f32x4 (&acc)[2][2][4][2], const Unit& u, int wr, int wc, int fr, int fq, int wid) const {
        const int t = u.pn, pm = u.pm; const bool rope = pm < 64;
        const float one[2][4] = {{1.f, 1.f, 1.f, 1.f}, {1.f, 1.f, 1.f, 1.f}};
        if (t < 4 && (MK_G1T & 1)) norm_rope_store<128>(acc, pm, wr, wc, fr, fq, wid, wAq, tc128, ts128, rope, one, QA, 1024, (t * 2 + (wc >> 1)) * 128, 1, 0, xch, 0.08838834764831845f * 1.4426950408889634f);
        else if (t == 4 && (MK_G1T & 1)) norm_rope_store<128>(acc, pm, wr, wc, fr, fq, wid, wAk, tc128, ts128, rope, one, KA, 256, (wc >> 1) * 128, 1, 0, xch);
        else if (t == 5 && (MK_G1T & 2)) plain<0>(acc, pm, wr, wc, fr, fq, VA, 256, 0);
        else if (t < 10 && (MK_G1T & 1)) norm_rope_store<128>(acc, pm, wr, wc, fr, fq, wid, wBqn, tc128, ts128, false, one, QB, 1536, ((t - 6) * 2 + (wc >> 1)) * 192, 1, 0, xch, 0.07216878364870323f * 1.4426950408889634f);
        else if (t < 12 && (MK_G1T & 4)) norm_rope_store<64>(acc, pm, wr, wc, fr, fq, wid, wBqr, tc64, ts64, rope, one, QB, 1536, ((t - 10) * 4 + wc) * 192 + 128, 1, 0, xch, 0.07216878364870323f * 1.4426950408889634f);
        else if (t < 14 && (MK_G1T & 8)) {
            plain<0>(acc, pm, wr, wc, fr, fq, CKV, 512, (t - 12) * 256);
#pragma unroll
            for (int ai = 0; ai < 2; ++ai)
#pragma unroll
                for (int m = 0; m < 4; ++m) {
                    float s = 0.f;
#pragma unroll
                    for (int bj = 0; bj < 2; ++bj)
#pragma unroll
                        for (int n = 0; n < 2; ++n)
#pragma unroll
                            for (int j = 0; j < 4; ++j) { const float v = acc[ai][bj][m][n][j]; s += v * v; }
                    s += __shfl_xor(s, 16); s += __shfl_xor(s, 32);
                    if (fq == 0) SS[((size_t)pm * 256 + ai * 128 + wr * 64 + m * 16 + fr) * 8 + (t - 12) * 4 + wc] = s;
                }
        }
        else if (t == 14 && (MK_G1T & 16)) { if (wc == 0) norm_rope_store<64>(acc, pm, wr, wc, fr, fq, wid, wBkr, tc64, ts64, rope, one, KB, 1536, 128, 8, 192, xch); }
        else if (t < 19 && (MK_G1T & 4)) norm_rope_store<64>(acc, pm, wr, wc, fr, fq, wid, wCq, tc64, ts64, rope, one, QC, 1024, ((t - 15) * 4 + wc) * 64, 1, 0, xch, 0.125f * 1.4426950408889634f);
        else if (t < 23 && (MK_G1T & 4)) norm_rope_store<64>(acc, pm, wr, wc, fr, fq, wid, wCk, tc64, ts64, rope, one, KC, 1024, ((t - 19) * 4 + wc) * 64, 1, 0, xch);
        else if (t < 27 && (MK_G1T & 2)) plain<0>(acc, pm, wr, wc, fr, fq, VC, 1024, (t - 23) * 256);
        else if (t < 39 && (MK_G1T & 32)) plain<1>(acc, pm, wr, wc, fr, fq, GATE, 3072, (t - 27) * 256);
        else if (MK_G1T & 64) plain<2>(acc, pm, wr, wc, fr, fq, MRG, 6144, (t - 39) * 256);
    }
};

struct EpiUp {
    static constexpr bool MID = false;
    bf16_t *KB, *VB; const float* SS; const float* wBkn; LAS float* xch;
    __device__ __forceinline__ void operator()(const f32x4 (&acc)[2][2][4][2], const Unit& u, int wr, int wc, int fr, int fq, int wid) const {
        const int t = u.pn, pm = u.pm;
        float pre[2][4];
#pragma unroll
        for (int ai = 0; ai < 2; ++ai) {
            f32x4 a[4], b[4];
#pragma unroll
            for (int m = 0; m < 4; ++m) { const size_t row = (size_t)pm * 256 + ai * 128 + wr * 64 + m * 16 + fr; a[m] = *(const f32x4*)(SS + row * 8); b[m] = *(const f32x4*)(SS + row * 8 + 4); }
#pragma unroll
            for (int m = 0; m < 4; ++m) pre[ai][m] = rsqrtf(((a[m][0] + a[m][1]) + (a[m][2] + a[m][3]) + (b[m][0] + b[m][1]) + (b[m][2] + b[m][3])) * (1.f / 512.f) + EPS);
            __builtin_amdgcn_sched_barrier(0);
        }
        if (t < 4) norm_rope_store<128>(acc, pm, wr, wc, fr, fq, wid, wBkn, nullptr, nullptr, false, pre, KB, 1536, (t * 2 + (wc >> 1)) * 192, 1, 0, xch);
        else {
            const int colw = (t - 4) * 256 + 32 * wc + 8 * fq;
#pragma unroll
            for (int ai = 0; ai < 2; ++ai)
#pragma unroll
                for (int m = 0; m < 4; ++m) {
                    const size_t row = (size_t)pm * 256 + ai * 128 + wr * 64 + m * 16 + fr;
#pragma unroll
                    for (int bj = 0; bj < 2; ++bj) store8(VB + row * 1024 + colw + bj * 128, acc[ai][bj][m][0] * pre[ai][m], acc[ai][bj][m][1] * pre[ai][m]);
                    __builtin_amdgcn_sched_barrier(0);
                }
        }
    }
};

struct EpiBr {
    static constexpr bool MID = true;
    const bf16_t* MRG; bf16_t* Y;
    __device__ __forceinline__ void mid(f32x4 (&acc)[2][2][4][2], const Unit& u, int i, int wr, int wc, int fr, int fq) const {
#pragma unroll
        for (int ai = 0; ai < 2; ++ai)
#pragma unroll
            for (int mh = 0; mh < 2; ++mh) {
                u32x4 a[2][2], b[2][2];
#pragma unroll
                for (int mm = 0; mm < 2; ++mm)
#pragma unroll
                    for (int bj = 0; bj < 2; ++bj) {
                        const size_t row = (size_t)u.pm * 256 + ai * 128 + wr * 64 + (mh * 2 + mm) * 16 + fr; const int col = u.pn * 256 + bj * 128 + 32 * wc + 8 * fq;
                        a[mm][bj] = *(const u32x4*)(MRG + row * 6144 + (i - 1) * 2048 + col); b[mm][bj] = *(const u32x4*)(MRG + row * 6144 + i * 2048 + col); }
#pragma unroll
                for (int mm = 0; mm < 2; ++mm)
#pragma unroll
                    for (int bj = 0; bj < 2; ++bj)
#pragma unroll
                        for (int q = 0; q < 4; ++q) {
                            const float r0 = bf2f(a[mm][bj][q] & 0xffffu) * __builtin_amdgcn_rcpf(bf2f(b[mm][bj][q] & 0xffffu)), r1 = bf2f(a[mm][bj][q] >> 16) * __builtin_amdgcn_rcpf(bf2f(b[mm][bj][q] >> 16));
                            acc[ai][bj][mh * 2 + mm][q >> 1][(q & 1) * 2] *= r0; acc[ai][bj][mh * 2 + mm][q >> 1][(q & 1) * 2 + 1] *= r1;
                        }
                __builtin_amdgcn_sched_barrier(0);
            }
    }
    __device__ __forceinline__ void operator()(const f32x4 (&acc)[2][2][4][2], const Unit& u, int wr, int wc, int fr, int fq, int wid) const {
#pragma unroll
        for (int ai = 0; ai < 2; ++ai) {
            u32x4 a[4][2];
#pragma unroll
            for (int m = 0; m < 4; ++m)
#pragma unroll
                for (int bj = 0; bj < 2; ++bj) {
                    const size_t row = (size_t)u.pm * 256 + ai * 128 + wr * 64 + m * 16 + fr; const int col = u.pn * 256 + bj * 128 + 32 * wc + 8 * fq;
                    a[m][bj] = *(const u32x4*)(MRG + row * 6144 + 4096 + col); }
#pragma unroll
            for (int m = 0; m < 4; ++m)
#pragma unroll
                for (int bj = 0; bj < 2; ++bj) {
                    const size_t row = (size_t)u.pm * 256 + ai * 128 + wr * 64 + m * 16 + fr; const int col = u.pn * 256 + bj * 128 + 32 * wc + 8 * fq;
                    const u32x4 g = a[m][bj];
                    f32x4 v0 = acc[ai][bj][m][0], v1 = acc[ai][bj][m][1];
                    v0[0] *= bf2f(g[0] & 0xffffu); v0[1] *= bf2f(g[0] >> 16); v0[2] *= bf2f(g[1] & 0xffffu); v0[3] *= bf2f(g[1] >> 16);
                    v1[0] *= bf2f(g[2] & 0xffffu); v1[1] *= bf2f(g[2] >> 16); v1[2] *= bf2f(g[3] & 0xffffu); v1[3] *= bf2f(g[3] >> 16);
                    store8(Y + row * 2048 + col, v0, v1);
                }
            __builtin_amdgcn_sched_barrier(0);
        }
    }
};

struct EpiOut {
    static constexpr bool MID = false;
    const float *xsrc, *csrc; float *xdst, *cdst; const float* mod;
    __device__ __forceinline__ void operator()(const f32x4 (&acc)[2][2][4][2], const Unit& u, int wr, int wc, int fr, int fq, int wid) const {
        const int pm = u.pm; const bool lat = pm < 64;
        const int mi = lat ? (pm >> 4) : 4;
        const float* src = lat ? xsrc : csrc - (size_t)MLAT * DM; float* dst = lat ? xdst : cdst - (size_t)MLAT * DM;
        const float* g = mod + mi * 6144 + 4096;
#pragma unroll
        for (int bj = 0; bj < 2; ++bj) {
            const int col = u.pn * 256 + bj * 128 + 32 * wc + 8 * fq;
            const f32x4 g0 = *(const f32x4*)(g + col), g1 = *(const f32x4*)(g + col + 4);
#pragma unroll
            for (int ai = 0; ai < 2; ++ai) {
                f32x4 x0[4], x1[4];
#pragma unroll
                for (int m = 0; m < 4; ++m) { const size_t row = (size_t)pm * 256 + ai * 128 + wr * 64 + m * 16 + fr;
                    x0[m] = *(const f32x4*)(src + row * DM + col); x1[m] = *(const f32x4*)(src + row * DM + col + 4); }
#pragma unroll
                for (int m = 0; m < 4; ++m) { const size_t row = (size_t)pm * 256 + ai * 128 + wr * 64 + m * 16 + fr;
                    *(f32x4*)(dst + row * DM + col) = x0[m] + g0 * acc[ai][bj][m][0];
                    *(f32x4*)(dst + row * DM + col + 4) = x1[m] + g1 * acc[ai][bj][m][1]; }
                __builtin_amdgcn_sched_barrier(0);
            }
        }
    }
};

namespace att {
#define SBAR() __builtin_amdgcn_sched_barrier(0)
__device__ __forceinline__ int crow(int r, int hi) { return (r & 3) + 8 * (r >> 2) + 4 * hi; }
template <int RB> __device__ __forceinline__ int kswz(int row, int colB) { const int x = (RB == 256) ? (row & 15) : ((row >> 1) & 7); return row * RB + (colB ^ (x << 4)); }
__device__ __forceinline__ int v_st(int k, int c) { const int kk = (k & ~0xC) | ((k & 4) << 1) | ((k & 8) >> 1); return ((kk >> 3) * 4 + (c >> 5)) * 512 + ((kk & 7) * 32 + (c & 31)) * 2; }
__device__ __forceinline__ int v_rd_base(int lane) { return ((lane & 3) << 3) | (((lane >> 2) & 3) << 6) | (((lane >> 4) & 1) << 5) | (((lane >> 5) & 1) << 8); }
constexpr int v_rd_off(int d0, int ks, int half) { return d0 * 512 + ks * 4096 + half * 2048; }
template <int OFF> __device__ __forceinline__ s16x4 tr_read(unsigned vb) {
    s16x4 r; asm volatile("ds_read_b64_tr_b16 %0, %1 offset:%2" : "=&v"(r) : "v"(vb), "i"(OFF) : "memory"); return r;
}
template <int D0> __device__ __forceinline__ void pv_one(f32x16& od, unsigned vb, bf16x8 pa0, bf16x8 pa1, bf16x8 pa2, bf16x8 pa3) {
    const s16x4 l0 = tr_read<v_rd_off(D0, 0, 0)>(vb), h0 = tr_read<v_rd_off(D0, 0, 1)>(vb), l1 = tr_read<v_rd_off(D0, 1, 0)>(vb), h1 = tr_read<v_rd_off(D0, 1, 1)>(vb);
    const s16x4 l2 = tr_read<v_rd_off(D0, 2, 0)>(vb), h2 = tr_read<v_rd_off(D0, 2, 1)>(vb), l3 = tr_read<v_rd_off(D0, 3, 0)>(vb), h3 = tr_read<v_rd_off(D0, 3, 1)>(vb);
    asm volatile("s_waitcnt lgkmcnt(0)" ::: "memory"); SBAR();
#define PK(L, H) (bf16x8){L[0], L[1], L[2], L[3], H[0], H[1], H[2], H[3]}
    od = __builtin_amdgcn_mfma_f32_32x32x16_bf16(pa0, PK(l0, h0), od, 0, 0, 0);
    od = __builtin_amdgcn_mfma_f32_32x32x16_bf16(pa1, PK(l1, h1), od, 0, 0, 0);
    od = __builtin_amdgcn_mfma_f32_32x32x16_bf16(pa2, PK(l2, h2), od, 0, 0, 0);
    od = __builtin_amdgcn_mfma_f32_32x32x16_bf16(pa3, PK(l3, h3), od, 0, 0, 0);
#undef PK
}
__device__ __forceinline__ void pv_d0(f32x16 (&o)[4], unsigned vb, bf16x8 pa0, bf16x8 pa1, bf16x8 pa2, bf16x8 pa3) {
    pv_one<0>(o[0], vb, pa0, pa1, pa2, pa3); pv_one<1>(o[1], vb, pa0, pa1, pa2, pa3); pv_one<2>(o[2], vb, pa0, pa1, pa2, pa3); pv_one<3>(o[3], vb, pa0, pa1, pa2, pa3);
}
__device__ __forceinline__ void partialSM(f32x16& p0, f32x16& p1) {
#pragma unroll
    for (int r = 0; r < 16; ++r) p0[r] = __builtin_amdgcn_exp2f(p0[r]);
}
__device__ __forceinline__ void finishSM(f32x16& p0, f32x16& p1, float& l_reg, bf16x8& pa0, bf16x8& pa1, bf16x8& pa2, bf16x8& pa3) {
#pragma unroll
    for (int r = 0; r < 16; ++r) p1[r] = __builtin_amdgcn_exp2f(p1[r]);
    float ps = 0;
#pragma unroll
    for (int r = 0; r < 16; ++r) ps += p0[r];
#pragma unroll
    for (int r = 0; r < 16; ++r) ps += p1[r];
    l_reg += ps;
#define PK8(P, BASE, OUT) do { u32x4 w = {cvt_pk_bf16(P[BASE + 0], P[BASE + 1]), cvt_pk_bf16(P[BASE + 2], P[BASE + 3]), cvt_pk_bf16(P[BASE + 4], P[BASE + 5]), cvt_pk_bf16(P[BASE + 6], P[BASE + 7])}; \
    OUT = *reinterpret_cast<bf16x8*>(&w); } while (0)
    PK8(p0, 0, pa0); PK8(p0, 8, pa1); PK8(p1, 0, pa2); PK8(p1, 8, pa3);
#undef PK8
}
template <int DQK>
__device__ __forceinline__ void qkt(f32x16& p0, f32x16& p1, const LAS char* Ks, const bf16x8 (&qr)[DQK / 16], const int (&ka)[8], float nMB) {
    constexpr int RB = DQK * 2, NA = (RB == 256) ? 8 : 4;
#pragma unroll
    for (int r = 0; r < 16; ++r) { p0[r] = nMB; p1[r] = nMB; }
#pragma unroll
    for (int d0 = 0; d0 < DQK / 16; ++d0) {
        const LAS char* a = Ks + ka[d0 % NA] + (d0 / NA) * (NA * 32);
        const bf16x8 b0 = *(const LAS bf16x8*)(a);
        const bf16x8 b1 = *(const LAS bf16x8*)(a + 32 * RB);
        p0 = __builtin_amdgcn_mfma_f32_32x32x16_bf16(b0, qr[d0], p0, 0, 0, 0);
        p1 = __builtin_amdgcn_mfma_f32_32x32x16_bf16(b1, qr[d0], p1, 0, 0, 0); }
}
constexpr int V_BYTES = 64 * 128 * 2, K_OFF = 3 * V_BYTES, K_STRIDE = 64 * 192 * 2, LI_OFF = K_OFF + 3 * K_STRIDE;

template <int DQK, bool DOUBLE>
__device__ __forceinline__ void attn_pass(const bf16_t* __restrict__ Q, int ldq, const bf16_t* __restrict__ Kg, int ldk, const bf16_t* __restrict__ Vg, int ldv,
                                          int rowc, int rowl, int NT, float nMB, f32x16 (&o)[4], float& l_reg, LAS char* lds, int tid) {
    constexpr int RB = DQK * 2, NCH = DQK / 8, NLD = NCH / 8;
    const int wid = __builtin_amdgcn_readfirstlane(tid >> 6), lane = tid & 63, r32 = lane & 31, hi = lane >> 5;
    LAS char* V_lds = lds; LAS char* K_lds = lds + K_OFF;
    bf16x8 qr[DQK / 16];
    { const bf16_t* Qw = Q + (size_t)(wid * 32 + r32) * ldq + hi * 8;
#pragma unroll
      for (int d0 = 0; d0 < DQK / 16; ++d0) qr[d0] = *(const bf16x8*)(Qw + d0 * 16); }
#pragma unroll
    for (int d = 0; d < 4; ++d) o[d] = f32x16{};
    l_reg = 0.f;
    int vrow[2], vcol[2], krow[NLD], kcol[NLD];
#pragma unroll
    for (int i = 0; i < 2; ++i) { const int q = tid + 512 * i, sub = q >> 5, within = q & 31, kk = (sub >> 2) * 8 + (within >> 2);
        vrow[i] = kk; vcol[i] = (sub & 3) * 32 + (within & 3) * 8; }
#pragma unroll
    for (int i = 0; i < NLD; ++i) { const int q = tid + 512 * i, row = q / NCH, chp = q % NCH; const int x = (RB == 256) ? (row & 15) : ((row >> 1) & 7);
        krow[i] = row; kcol[i] = (chp ^ x) * 8; }
    const unsigned vb0 = (unsigned)(uintptr_t)V_lds + v_rd_base(lane);
    int ka[8];
#pragma unroll
    for (int q = 0; q < 8; ++q) ka[q] = kswz<RB>(r32, q * 32 + hi * 16);
#define KROW0(j) ((j) < 4 ? rowc + 64 * (j) : rowl + 64 * ((j) - 4))
#define DMA(j, b) do { const size_t _r0 = (size_t)KROW0(j); \
    _Pragma("unroll") for (int _i = 0; _i < 2; ++_i) __builtin_amdgcn_global_load_lds((const unsigned*)(Vg + (_r0 + vrow[_i]) * ldv + vcol[_i]), (LAS unsigned*)(V_lds + (b) * V_BYTES + wid * 1024 + _i * 8192), 16, 0, 0); \
    _Pragma("unroll") for (int _i = 0; _i < NLD; ++_i) __builtin_amdgcn_global_load_lds((const unsigned*)(Kg + (_r0 + krow[_i]) * ldk + kcol[_i]), (LAS unsigned*)(K_lds + (b) * K_STRIDE + wid * 1024 + _i * 8192), 16, 0, 0); } while (0)
#define VMW0() asm volatile("s_waitcnt vmcnt(0)" ::: "memory")
    bf16x8 pa0, pa1, pa2, pa3;
    __syncthreads();
    DMA(0, 0); DMA(1, 1); VMW0(); __syncthreads();
    if constexpr (!DOUBLE) {
        f32x16 p0, p1;
        DMA(2, 2);
        int bc = 0, bn = 1, bf = 2;
        for (int j = 0; j < NT; ++j) {
            SBAR(); qkt<DQK>(p0, p1, K_lds + bc * K_STRIDE, qr, ka, nMB);
            partialSM(p0, p1); finishSM(p0, p1, l_reg, pa0, pa1, pa2, pa3); SBAR();
            pv_d0(o, vb0 + bc * V_BYTES, pa0, pa1, pa2, pa3);
            if (j + 1 < NT) { VMW0(); __syncthreads(); if (j + 3 < NT) DMA(j + 3, bc); }
            { const int _t = bc; bc = bn; bn = bf; bf = _t; }
        }
    } else {
    f32x16 pA0, pA1, pB0, pB1;
    qkt<DQK>(pA0, pA1, K_lds, qr, ka, nMB); partialSM(pA0, pA1);
    DMA(2, 2);
    int bp = 0, bc = 1, bn = 2;
#define STEP(j, PC0, PC1, PP0, PP1) do { \
        SBAR(); qkt<DQK>(PC0, PC1, K_lds + bc * K_STRIDE, qr, ka, nMB); \
        finishSM(PP0, PP1, l_reg, pa0, pa1, pa2, pa3); SBAR(); \
        pv_d0(o, vb0 + bp * V_BYTES, pa0, pa1, pa2, pa3); partialSM(PC0, PC1); \
        if ((j) + 1 < NT) { VMW0(); __syncthreads(); if ((j) + 2 < NT) DMA((j) + 2, bp); } \
        { const int _t = bp; bp = bc; bc = bn; bn = _t; } } while (0)
    for (int j = 1; j < NT; j += 2) {
        STEP(j, pB0, pB1, pA0, pA1);
        if (j + 1 < NT) STEP(j + 1, pA0, pA1, pB0, pB1);
    }
    finishSM(pB0, pB1, l_reg, pa0, pa1, pa2, pa3); SBAR();
    pv_d0(o, vb0 + bp * V_BYTES, pa0, pa1, pa2, pa3);
    }
#undef KROW0
#undef DMA
#undef VMW0
#undef STEP
}
__device__ __forceinline__ void row_recip(float l_reg, float (&rli)[16], LAS float* li, int r32, int hi) {
    { auto rr = __builtin_amdgcn_permlane32_swap(__float_as_uint(l_reg), __float_as_uint(l_reg), false, false);
      l_reg = __uint_as_float(rr[0]) + __uint_as_float(rr[1]); }
    if (hi == 0) li[r32] = l_reg;
    asm volatile("s_waitcnt lgkmcnt(0)" ::: "memory");
#pragma unroll
    for (int r = 0; r < 16; ++r) rli[r] = __builtin_amdgcn_rcpf(li[crow(r, hi)]);
    asm volatile("s_waitcnt lgkmcnt(0)" ::: "memory");
}
}

struct AttnBufs { const bf16_t *QA, *KA, *VA, *QB, *KB, *VB, *QC, *KC, *VC, *GATE; bf16_t* BR; float* SCR; const float* lamv; const float* subln; float lam_init; };

template <bool SUBLN>
__device__ __forceinline__ void attn_out(const AttnBufs& T, f32x16 (&o)[4], int type, int h, size_t orow0, LAS char* lds, int wid, int lane, int r32, int hi) {
    const int rr = lane >> 5, c4 = (lane & 31) * 4;
    const int col = type * 1024 + h * 128 + c4;
    const bf16_t* gp = T.GATE + (orow0 + rr) * 3072 + col; bf16_t* op = T.BR + (orow0 + rr) * 3072 + col;
    u32x2 gg[16];
#pragma unroll
    for (int i = 0; i < 16; ++i) gg[i] = *(const u32x2*)(gp + (size_t)i * 2 * 3072);
    __syncthreads();
    LAS float* stg = (LAS float*)(lds + wid * 16896);
#pragma unroll
    for (int d0 = 0; d0 < 4; ++d0)
#pragma unroll
        for (int r = 0; r < 16; ++r) stg[att::crow(r, hi) * 132 + d0 * 32 + r32] = o[d0][r];
    asm volatile("s_waitcnt lgkmcnt(0)" ::: "memory");
    f32x4 wsub = {1.f, 1.f, 1.f, 1.f};
    if (SUBLN) { wsub = *(const f32x4*)(T.subln + c4) * (1.f - T.lam_init); }
#pragma unroll
    for (int i = 0; i < 16; ++i) {
        f32x4 v = *(const LAS f32x4*)(stg + (2 * i + rr) * 132 + c4);
        if (SUBLN) {
            float s = (v[0] * v[0] + v[1] * v[1]) + (v[2] * v[2] + v[3] * v[3]);
            s += __shfl_xor(s, 1); s += __shfl_xor(s, 2); s += __shfl_xor(s, 4); s += __shfl_xor(s, 8); s += __shfl_xor(s, 16);
            v = v * (rsqrtf(s * (1.f / 128.f) + EPS)) * wsub;
        }
        u32x2 w; w.x = cvt_pk_bf16(v[0] * bf2f(gg[i].x & 0xffffu), v[1] * bf2f(gg[i].x >> 16)); w.y = cvt_pk_bf16(v[2] * bf2f(gg[i].y & 0xffffu), v[3] * bf2f(gg[i].y >> 16));
        *(u32x2*)(op + (size_t)i * 2 * 3072) = w;
    }
}

__device__ __forceinline__ void attn_item(const AttnBufs& T, int type, int b, int h, int qrow0, int NT, LAS char* lds, int tid_) {
    asm volatile("" : "+v"(tid_));
    const int tid = tid_, wid = __builtin_amdgcn_readfirstlane(tid >> 6), lane = tid & 63, r32 = lane & 31, hi = lane >> 5;
    const int rowc = MLAT + b * CTXL, rowl = b * SEQ;
    LAS float* li = (LAS float*)(lds + att::LI_OFF) + wid * 64;
    constexpr float LOG2E = 1.4426950408889634f;
    const size_t orow0 = (size_t)qrow0 + wid * 32;
    if (type == 0 && (MK_ATYPE & 1)) {
        f32x16 o[4]; float l_reg; float rli[16];
        att::attn_pass<128, ATT_DBL>(T.QA + (size_t)qrow0 * 1024 + h * 128, 1024, T.KA + (h >> 2) * 128, 256, T.VA + (h >> 2) * 128, 256, rowc, rowl, NT,
                            T.lamv[1], o, l_reg, lds, tid);
        att::row_recip(l_reg, rli, li, r32, hi);
#pragma unroll
        for (int d0 = 0; d0 < 4; ++d0)
#pragma unroll
            for (int r = 0; r < 16; ++r) o[d0][r] *= rli[r];
        attn_out<false>(T, o, 0, h, orow0, lds, wid, lane, r32, hi);
    } else if (type == 1 && (MK_ATYPE & 2)) {
        f32x16 o[4]; float l_reg; float rli[16];
        att::attn_pass<192, false>(T.QB + (size_t)qrow0 * 1536 + h * 192, 1536, T.KB + h * 192, 1536, T.VB + h * 128, 1024, rowc, rowl, NT,
                            T.lamv[2], o, l_reg, lds, tid);
        att::row_recip(l_reg, rli, li, r32, hi);
#pragma unroll
        for (int d0 = 0; d0 < 4; ++d0)
#pragma unroll
            for (int r = 0; r < 16; ++r) o[d0][r] *= rli[r];
        attn_out<false>(T, o, 1, h, orow0, lds, wid, lane, r32, hi);
    } else if (MK_ATYPE & 4) {
        f32x16 o[4]; float l_reg; float rli[16];
        att::attn_pass<64, ATT_DBL>(T.QC + (size_t)qrow0 * 1024 + h * 128, 1024, T.KC + h * 128, 1024, T.VC + h * 128, 1024, rowc, rowl, NT,
                           T.lamv[3], o, l_reg, lds, tid);
        att::row_recip(l_reg, rli, li, r32, hi);
        f32x4* scr = (f32x4*)(T.SCR + ((size_t)blockIdx.x * 512 + tid) * 64);
#pragma unroll
        for (int d0 = 0; d0 < 4; ++d0)
#pragma unroll
            for (int q = 0; q < 4; ++q) scr[d0 * 4 + q] = (f32x4){o[d0][q * 4] * rli[q * 4], o[d0][q * 4 + 1] * rli[q * 4 + 1], o[d0][q * 4 + 2] * rli[q * 4 + 2], o[d0][q * 4 + 3] * rli[q * 4 + 3]};
        att::attn_pass<64, ATT_DBL>(T.QC + (size_t)qrow0 * 1024 + h * 128 + 64, 1024, T.KC + h * 128 + 64, 1024, T.VC + h * 128, 1024, rowc, rowl, NT,
                           T.lamv[3], o, l_reg, lds, tid);
        att::row_recip(l_reg, rli, li, r32, hi);
        const float lam = T.lamv[0];
#pragma unroll
        for (int d0 = 0; d0 < 4; ++d0)
#pragma unroll
            for (int q = 0; q < 4; ++q) { const f32x4 a = scr[d0 * 4 + q];
#pragma unroll
                for (int j = 0; j < 4; ++j) o[d0][q * 4 + j] = a[j] - lam * (o[d0][q * 4 + j] * rli[q * 4 + j]); }
        attn_out<true>(T, o, 2, h, orow0, lds, wid, lane, r32, hi);
    }
}

__device__ __forceinline__ void transpose_item(const float* __restrict__ W, int ldw, int k0, int srccol4, const float* __restrict__ kscale,
                                               bf16_t* __restrict__ WT, int ldt, int n0, int kdst0, LAS float* scr, int lane) {
    const int ks = lane >> 4, n4 = (lane & 15) * 4;
#pragma unroll 8
    for (int i = 0; i < 16; ++i) { const int kk = 4 * i + ks;
        f32x4 v = srccol4 >= 0 ? *(const f32x4*)(W + (size_t)(k0 + kk) * ldw + srccol4) : (f32x4){0.f, 0.f, 0.f, 0.f};
        if (kscale) v = v * kscale[k0 + kk];
        LAS float* d = scr + kk * 65 + n4; d[0] = v[0]; d[1] = v[1]; d[2] = v[2]; d[3] = v[3]; }
    asm volatile("s_waitcnt lgkmcnt(0)" ::: "memory");
    const int nn = lane & 7, c = lane >> 3;
#pragma unroll
    for (int j = 0; j < 8; ++j) { const int n = nn + 8 * j; const LAS float* s = scr + (8 * c) * 65 + n;
        u32x4 o; o.x = cvt_pk_bf16(s[0 * 65], s[1 * 65]); o.y = cvt_pk_bf16(s[2 * 65], s[3 * 65]); o.z = cvt_pk_bf16(s[4 * 65], s[5 * 65]); o.w = cvt_pk_bf16(s[6 * 65], s[7 * 65]);
        *(u32x4*)(WT + (size_t)(n0 + n) * ldt + kdst0 + k0 + 8 * c) = o; }
    asm volatile("s_waitcnt lgkmcnt(0)" ::: "memory");
}
__device__ const float INVF32[16] = {1.000000000e+00f, 5.623413324e-01f, 3.162277639e-01f, 1.778279394e-01f, 1.000000015e-01f, 5.623413250e-02f, 3.162277490e-02f, 1.778279431e-02f,
    9.999999776e-03f, 5.623413250e-03f, 3.162277630e-03f, 1.778279431e-03f, 1.000000047e-03f, 5.623413017e-04f, 3.162277571e-04f, 1.778279402e-04f};
__device__ const float INVF64[32] = {1.000000000e+00f, 7.498942614e-01f, 5.623413324e-01f, 4.216965139e-01f, 3.162277639e-01f, 2.371373773e-01f, 1.778279394e-01f, 1.333521307e-01f,
    1.000000015e-01f, 7.498941571e-02f, 5.623413250e-02f, 4.216965288e-02f, 3.162277490e-02f, 2.371373773e-02f, 1.778279431e-02f, 1.333521493e-02f, 9.999999776e-03f, 7.498941850e-03f,
    5.623413250e-03f, 4.216964822e-03f, 3.162277630e-03f, 2.371373586e-03f, 1.778279431e-03f, 1.333521446e-03f, 1.000000047e-03f, 7.498942432e-04f, 5.623413017e-04f, 4.216965172e-04f,
    3.162277571e-04f, 2.371373703e-04f, 1.778279402e-04f, 1.333521504e-04f};
__device__ __forceinline__ void sincos_d(double x, float& s, float& c) {
    const double twopi = 6.283185307179586476925;
    const double k = __builtin_rint(x / twopi), r = x - k * twopi, r2 = r * r;
    double st = r, ct = 1.0, ss = r, cs = 1.0;
    for (int n = 1; n <= 16; ++n) { ct *= -r2 / (double)((2 * n - 1) * (2 * n)); st *= -r2 / (double)((2 * n) * (2 * n + 1)); cs += ct; ss += st; }
    s = (float)ss; c = (float)cs;
}
__device__ __forceinline__ float absmax_n(const float* w, int n) { float m = 0.f; for (int i = 0; i < n; ++i) m = fmaxf(m, fabsf(w[i])); return m; }

typedef unsigned v4u_unused_t;
#define XB_TMO      128
#define XB_XCNT(j)  (256  + 64 * (j))
#define XB_XSUB(j)  (1280 + 64 * (j))
#define XB_XGEN(j)  (2304 + 64 * (j))
#define XB_TOP      3328
#define XB_TOPGEN   3392
#define XCD_BAR_WORDS 3456
#define XB_SPIN_CAP (1u << 18)

__device__ __forceinline__ unsigned xb_ld(unsigned* p)              { return __hip_atomic_load(p, __ATOMIC_RELAXED, __HIP_MEMORY_SCOPE_AGENT); }
__device__ __forceinline__ unsigned xb_add(unsigned* p, unsigned v) { return __hip_atomic_fetch_add(p, v, __ATOMIC_RELAXED, __HIP_MEMORY_SCOPE_AGENT); }
__device__ __forceinline__ unsigned xb_xcc_id() { return (unsigned)__builtin_amdgcn_s_getreg((3 << 11) | 20) & 0xFu; }
#define XB_SPIN(cond, bar) do { unsigned _sp = 0; while (cond) { __builtin_amdgcn_s_sleep(1); \
    if ((++_sp & 255u) == 0u) { if (xb_ld(&(bar)[XB_TMO])) break; if (_sp > XB_SPIN_CAP) { atomicAdd(&(bar)[XB_TMO], 1u); break; } } } } while (0)

struct XcdBarrier {
    unsigned* bar; unsigned x;
    volatile LAS unsigned* st;
};

__device__ __forceinline__ XcdBarrier xcd_barrier_post(unsigned* bar, volatile LAS unsigned* st) {
    XcdBarrier b; b.bar = bar; b.x = xb_xcc_id(); b.st = st;
    if (threadIdx.x == 0) (void)xb_add(&bar[XB_XCNT(b.x)], 1u);
    return b;
}
__device__ __forceinline__ void xcd_barrier_complete(unsigned* bar, unsigned x, unsigned& nloc, unsigned& nx) {
    const unsigned G = gridDim.x * gridDim.y * gridDim.z;
    unsigned sum, cnt, mine, sp = 0u;
    for (;;) {
        sum = 0u; cnt = 0u; mine = 0u;
#pragma unroll
        for (unsigned j = 0; j < 16; ++j) { const unsigned c = xb_ld(&bar[XB_XCNT(j)]); sum += c; cnt += (c > 0u) ? 1u : 0u; mine = (j == x) ? c : mine; }
        if (sum == G) break;
        __builtin_amdgcn_s_sleep(1);
        if ((++sp & 255u) == 0u) { if (xb_ld(&bar[XB_TMO])) break; if (sp > XB_SPIN_CAP) { atomicAdd(&bar[XB_TMO], 1u); break; } }
    }
    nloc = mine > 0u ? mine : 1u; nx = cnt > 0u ? cnt : 1u;
}

__device__ __forceinline__ void xcd_barrier(const XcdBarrier& b) {
    asm volatile("s_waitcnt vmcnt(0)" ::: "memory");
    __syncthreads();
    if (threadIdx.x == 0) {
        unsigned* bar = b.bar;
        __builtin_amdgcn_s_waitcnt(0);
        unsigned nloc = b.st[0], nx = b.st[1];
        if (nloc == 0u) { xcd_barrier_complete(bar, b.x, nloc, nx); b.st[0] = nloc; b.st[1] = nx; }
        const unsigned old = xb_add(&bar[XB_XSUB(b.x)], 1u);
        const unsigned gen = old / nloc;
        if (old + 1u == (gen + 1u) * nloc) {
            __builtin_amdgcn_fence(__ATOMIC_RELEASE, "agent");
            asm volatile("s_waitcnt vmcnt(0)" ::: "memory");
            const unsigned og = xb_add(&bar[XB_TOP], 1u);
            const unsigned tg = og / nx;
            if (og + 1u == (tg + 1u) * nx) xb_add(&bar[XB_TOPGEN], 1u);
            else XB_SPIN(xb_ld(&bar[XB_TOPGEN]) == tg, bar);
            __builtin_amdgcn_fence(__ATOMIC_ACQUIRE, "agent");
            xb_add(&bar[XB_XGEN(b.x)], 1u);
            asm volatile("s_waitcnt vmcnt(0)" ::: "memory");
        } else {
            XB_SPIN(xb_ld(&bar[XB_XGEN(b.x)]) == gen, bar);
            __builtin_amdgcn_fence(__ATOMIC_ACQUIRE, "agent");
            asm volatile("s_waitcnt vmcnt(0)" ::: "memory");
        }
    }
    __syncthreads();
}

__device__ __forceinline__ void p1_row(int row, const float* __restrict__ xsrc, const float* __restrict__ csrc, const float* __restrict__ modl, const float* __restrict__ nw,
                                       bf16_t* __restrict__ H, int lane) {
    const bool lat = row < MLAT; const int mi = lat ? (row >> 12) : 4;
    const f32x4* xr = (const f32x4*)(lat ? xsrc + (size_t)row * DM : csrc + (size_t)(row - MLAT) * DM) + lane;
    f32x4 v[8]; float s = 0.f;
#pragma unroll
    for (int j = 0; j < 8; ++j) { v[j] = xr[64 * j]; s += (v[j][0] * v[j][0] + v[j][1] * v[j][1]) + (v[j][2] * v[j][2] + v[j][3] * v[j][3]); }
    const float rinv = rsqrtf(wave_sum(s) * (1.f / DM) + EPS);
    const f32x4* sh = (const f32x4*)(modl + mi * 6144) + lane; const f32x4* scl = (const f32x4*)(modl + mi * 6144 + DM) + lane; const f32x4* nwp = (const f32x4*)nw + lane;
    u32x2* o8 = (u32x2*)(H + (size_t)row * DM) + lane;
#pragma unroll
    for (int j = 0; j < 8; ++j) { const f32x4 y = v[j] * rinv * nwp[64 * j] * (scl[64 * j] + 1.f) + sh[64 * j];
        u32x2 w; w.x = cvt_pk_bf16(y[0], y[1]); w.y = cvt_pk_bf16(y[2], y[3]); o8[64 * j] = w; }
}

__device__ __forceinline__ void p1_row2(int rowA, int rowB, const float* __restrict__ xsrc, const float* __restrict__ csrc, const float* __restrict__ modl,
                                        const float* __restrict__ nw, bf16_t* __restrict__ H, int lane) {
    if (rowB < 0) { p1_row(rowA, xsrc, csrc, modl, nw, H, lane); return; }
    const bool latA = rowA < MLAT, latB = rowB < MLAT; const int miA = latA ? (rowA >> 12) : 4, miB = latB ? (rowB >> 12) : 4;
    const f32x4* xa = (const f32x4*)(latA ? xsrc + (size_t)rowA * DM : csrc + (size_t)(rowA - MLAT) * DM) + lane;
    const f32x4* xb = (const f32x4*)(latB ? xsrc + (size_t)rowB * DM : csrc + (size_t)(rowB - MLAT) * DM) + lane;
    f32x4 va[8], vb[8]; float sa = 0.f, sb = 0.f;
#pragma unroll
    for (int j = 0; j < 8; ++j) { va[j] = xa[64 * j]; vb[j] = xb[64 * j]; }
#pragma unroll
    for (int j = 0; j < 8; ++j) { sa += (va[j][0] * va[j][0] + va[j][1] * va[j][1]) + (va[j][2] * va[j][2] + va[j][3] * va[j][3]);
                                  sb += (vb[j][0] * vb[j][0] + vb[j][1] * vb[j][1]) + (vb[j][2] * vb[j][2] + vb[j][3] * vb[j][3]); }
    const float ra = rsqrtf(wave_sum(sa) * (1.f / DM) + EPS), rb = rsqrtf(wave_sum(sb) * (1.f / DM) + EPS);
    const f32x4* nwp = (const f32x4*)nw + lane;
    const f32x4* sha = (const f32x4*)(modl + miA * 6144) + lane; const f32x4* sca = (const f32x4*)(modl + miA * 6144 + DM) + lane;
    const f32x4* shb = (const f32x4*)(modl + miB * 6144) + lane; const f32x4* scb = (const f32x4*)(modl + miB * 6144 + DM) + lane;
    u32x2* oa = (u32x2*)(H + (size_t)rowA * DM) + lane; u32x2* ob = (u32x2*)(H + (size_t)rowB * DM) + lane;
#pragma unroll
    for (int j = 0; j < 8; ++j) { const f32x4 w4 = nwp[64 * j];
        const f32x4 ya = va[j] * ra * w4 * (sca[64 * j] + 1.f) + sha[64 * j], yb = vb[j] * rb * w4 * (scb[64 * j] + 1.f) + shb[64 * j];
        u32x2 wa, wb; wa.x = cvt_pk_bf16(ya[0], ya[1]); wa.y = cvt_pk_bf16(ya[2], ya[3]); wb.x = cvt_pk_bf16(yb[0], yb[1]); wb.y = cvt_pk_bf16(yb[2], yb[3]);
        oa[64 * j] = wa; ob[64 * j] = wb; }
}

struct Args { const float* in[29]; float* out; unsigned char* ws; int ph_lo, ph_hi, coop, pad; };

__global__ void __launch_bounds__(512, 2) mega_fwd(Args args) {
    extern __shared__ __attribute__((aligned(16))) unsigned char lds_raw[];
    LAS unsigned char* lds = (LAS unsigned char*)lds_raw;
    const int G = gridDim.x;
    unsigned char* ws = args.ws;
    float* MOD = (float*)(ws + WS_MOD);
    float* TC64 = (float*)(ws + WS_TC64); float* TS64 = (float*)(ws + WS_TS64); float* TC128 = (float*)(ws + WS_TC128); float* TS128 = (float*)(ws + WS_TS128);
    float* LAM = (float*)(ws + WS_LAM);
    bf16_t* WIN = (bf16_t*)(ws + WS_WIN); bf16_t* WUP = (bf16_t*)(ws + WS_WUP); bf16_t* WBR = (bf16_t*)(ws + WS_WBR); bf16_t* WOUT = (bf16_t*)(ws + WS_WOUT);
    bf16_t* H = (bf16_t*)(ws + WS_H); bf16_t* QA = (bf16_t*)(ws + WS_QA); bf16_t* KA = (bf16_t*)(ws + WS_KA); bf16_t* VA = (bf16_t*)(ws + WS_VA);
    bf16_t* QB = (bf16_t*)(ws + WS_QB); bf16_t* KB = (bf16_t*)(ws + WS_KB); bf16_t* CKV = (bf16_t*)(ws + WS_CKV); bf16_t* VB = (bf16_t*)(ws + WS_VB);
    bf16_t* QC = (bf16_t*)(ws + WS_QC); bf16_t* KC = (bf16_t*)(ws + WS_KC); bf16_t* VC = (bf16_t*)(ws + WS_VC);
    bf16_t* GATE = (bf16_t*)(ws + WS_GATE); bf16_t* MRG = (bf16_t*)(ws + WS_MRG); bf16_t* BR = (bf16_t*)(ws + WS_BR); bf16_t* Y = (bf16_t*)(ws + WS_Y);
    float* SS = (float*)(ws + WS_SS); float* CTXW = (float*)(ws + WS_CTXW); float* SCR = (float*)(ws + WS_SCR);
    LAS float* xch = (LAS float*)(lds + XCH_OFF);
    volatile LAS unsigned* bst = (volatile LAS unsigned*)(lds + XCH_OFF + 4096);
    if (threadIdx.x < 2) bst[threadIdx.x] = 0u;
    __syncthreads();
    XcdBarrier bar = xcd_barrier_post((unsigned*)(ws + WS_BAR), bst);

    for (int ph = args.ph_lo; ph < args.ph_hi; ++ph) {
        int bx = blockIdx.x; asm volatile("" : "+s"(bx));
        const int vcu = (G % 8 == 0) ? (bx % 8) * (G / 8) + bx / 8 : bx;
        int tid = threadIdx.x; asm volatile("" : "+v"(tid));
        const int lane = tid & 63, wave = __builtin_amdgcn_readfirstlane(tid >> 6);
        if (ph == 0 && (MK_MASK & 1)) {
            {
                LAS float* sc = (LAS float*)lds;
                LAS float* red = (LAS float*)(lds + 65536);
                for (int i = tid; i < 5 * DM; i += 512) { const float v = i < 4 * DM ? args.in[1][i] : args.in[3][i - 4 * DM]; sc[i] = silu_f(v); }
                __syncthreads();
                for (int it = bx; it < DEPTH * 96; it += G) {
                    const int l = it / 96, n0 = (it % 96) * 64;
                    const float* W = args.in[5] + (size_t)l * DM * 6144 + n0 + lane;
                    float a0 = 0.f, a1 = 0.f, a2 = 0.f, a3 = 0.f, a4 = 0.f;
                    const int kb = wave * 256;
#pragma unroll 8
                    for (int k = 0; k < 256; ++k) { const float wv = W[(size_t)(kb + k) * 6144];
                        a0 += sc[kb + k] * wv; a1 += sc[DM + kb + k] * wv; a2 += sc[2 * DM + kb + k] * wv; a3 += sc[3 * DM + kb + k] * wv; a4 += sc[4 * DM + kb + k] * wv; }
                    red[(wave * 5 + 0) * 64 + lane] = a0; red[(wave * 5 + 1) * 64 + lane] = a1; red[(wave * 5 + 2) * 64 + lane] = a2; red[(wave * 5 + 3) * 64 + lane] = a3; red[(wave * 5 + 4) * 64 + lane] = a4;
                    __syncthreads();
                    if (tid < 320) { const int i = tid >> 6; float s = 0.f;
                        for (int w8 = 0; w8 < 8; ++w8) s += red[(w8 * 5 + i) * 64 + lane];
                        MOD[((size_t)l * 5 + i) * 6144 + n0 + lane] = s + args.in[6][(size_t)l * 6144 + n0 + lane]; }
                    __syncthreads();
                }
            }
            if (bx == 1 % G) {
                for (int i = tid; i < 64 * 16; i += 512) { const int pos = i >> 4, f = i & 15; const float ang = (float)pos * INVF32[f]; float s, c; sincos_d((double)ang, s, c); TC64[i] = c; TS64[i] = s; }
                for (int i = tid; i < 64 * 32; i += 512) { const int pos = i >> 5, f = i & 31; const float ang = (float)pos * INVF64[f]; float s, c; sincos_d((double)ang, s, c); TC128[i] = c; TS128[i] = s; }
            }
            if (bx == 2 % G && tid < DEPTH) {
                const int l = tid;
                float s1 = 0.f, s2 = 0.f;
                for (int i = 0; i < 64; ++i) { s1 += args.in[20][l * 64 + i] * args.in[21][l * 64 + i]; s2 += args.in[22][l * 64 + i] * args.in[23][l * 64 + i]; }
                const float lam_init = 0.8f - 0.6f * expf(-0.3f * (float)l);
                LAM[l * 4 + 0] = expf(s1) - expf(s2) + lam_init;
                const float mAq = absmax_n(args.in[9] + l * 128, 128), mAk = absmax_n(args.in[10] + l * 128, 128);
                const float mBqn = absmax_n(args.in[11] + l * 128, 128), mBqr = absmax_n(args.in[12] + l * 64, 64), mBkn = absmax_n(args.in[16] + l * 128, 128), mBkr = absmax_n(args.in[17] + l * 64, 64);
                const float mCq = absmax_n(args.in[18] + l * 64, 64), mCk = absmax_n(args.in[19] + l * 64, 64);
                const float L2E = 1.4426950408889634f;
                LAM[l * 4 + 1] = -(sqrtf(128.f) * mAq * mAk) * L2E;
                LAM[l * 4 + 2] = -(sqrtf(128.f * mBqn * mBqn + 64.f * mBqr * mBqr) * sqrtf(128.f * mBkn * mBkn + 64.f * mBkr * mBkr) * 0.07216878364870323f) * L2E;
                LAM[l * 4 + 3] = -(8.f * mCq * mCk) * L2E;
            }
            __syncthreads();
            {
                LAS float* scr = (LAS float*)(lds + wave * 16640);
                const int gw = vcu * 8 + wave, NGW = G * 8;
                constexpr int I_IN = 32 * (NIN / 64), I_UP = 8 * 32, I_BR = 3 * 16 * 32, I_OUT = 32 * 32, I_L = I_IN + I_UP + I_BR + I_OUT;
                const int n4 = (lane & 15) * 4;
                for (int it = gw; it < DEPTH * I_L; it += NGW) {
                    const int l = it / I_L; int r = it % I_L;
                    if (r < I_IN) { const int nb = r % (NIN / 64), kb = r / (NIN / 64); const int n0 = nb * 64;
                        transpose_item(args.in[7] + (size_t)l * DM * INC, INC, kb * 64, in_src_col(n0 + n4), nullptr, WIN + (size_t)l * NIN * DM, DM, n0, 0, scr, lane); continue; }
                    r -= I_IN;
                    if (r < I_UP) { const int nb = r % 32, kb = r / 32; const int n0 = nb * 64; const int sc_ = up_src_col(n0 + n4);
                        const float* W = (sc_ < 1024 ? args.in[14] : args.in[15]) + (size_t)l * 512 * 1024;
                        transpose_item(W, 1024, kb * 64, sc_ & 1023, args.in[13] + l * 512, WUP + (size_t)l * 2048 * 512, 512, n0, 0, scr, lane); continue; }
                    r -= I_UP;
                    if (r < I_BR) { const int br = r / (16 * 32), r2 = r % (16 * 32); const int nb = r2 % 32, kb = r2 / 32; const int n0 = nb * 64;
                        transpose_item(args.in[25 + br] + (size_t)l * 1024 * DM, DM, kb * 64, n0 + n4, nullptr, WBR + (size_t)l * 2048 * 3072, 3072, n0, br * 1024, scr, lane); continue; }
                    r -= I_BR;
                    { const int nb = r % 32, kb = r / 32; const int n0 = nb * 64;
                      transpose_item(args.in[28] + (size_t)l * DM * DM, DM, kb * 64, n0 + n4, nullptr, WOUT + (size_t)l * DM * DM, DM, n0, 0, scr, lane); }
                }
            }
        } else {
            const int l = (ph == 1) ? 0 : (ph - 2) / 3, st_ = (ph == 1) ? 0 : 1 + (ph - 2) % 3, st = (st_ >= 2) ? st_ + 1 : st_;
            const float* xsrc = (l == 0) ? args.in[0] : args.out;
            const float* csrc = (l == 0) ? args.in[2] : CTXW;
            const float* modl = MOD + (size_t)l * 5 * 6144;
            const int Mrows = (l == DEPTH - 1) ? MLAT : MTOT;
            if (st == 0 && (MK_MASK & 2)) {
                const float* nw = args.in[4] + (size_t)l * DM;
                for (int row = bx * 8 + wave; row < MTOT; row += G * 16) { const int rb = row + G * 8; p1_row2(row, rb < MTOT ? rb : -1, xsrc, csrc, modl, nw, H, lane); }
            } else if (st == 1 && (MK_MASK & 4)) {
                pg8::Gemm g{H, WIN + (size_t)l * NIN * DM, MTOT, NIN, DM};
                EpiIn E{QA, KA, VA, QB, KB, CKV, QC, KC, VC, GATE, MRG, SS,
                        args.in[9] + l * 128, args.in[10] + l * 128, args.in[11] + l * 128, args.in[12] + l * 64, args.in[17] + l * 64, args.in[18] + l * 64, args.in[19] + l * 64,
                        args.in[8] + (size_t)l * 6144, TC64, TS64, TC128, TS128, xch};
                const bool trim = (l == DEPTH - 1) && (G == 256);
                for (int part = 0; part < 2; ++part) {
                    pg8::StaticOrder S;
                    if (!trim) { if (part) break; S.init(MTOT, NIN, G, bx); }
                    else if (part == 0) S.init(MLAT, NIN, G, bx);
                    else { if (!(bx >= 192 && bx < 244)) break; const int k = bx - 192, j = k % 13;
                           const int pn = (j < 2) ? 4 + j : (j < 5 ? 10 + j : 14 + j);
                           S.init_one(64 + k / 13, pn); }
                    { int t2 = threadIdx.x; asm volatile("" : "+v"(t2)); pg8::gemm_phase<EpiIn>(lds, g, S, E, t2); }
                }
            } else if (st == 3 && (MK_MASK & 16)) {
                unsigned* UPC = (unsigned*)(ws + WS_CNT) + (size_t)(2 * DEPTH * 68 + l) * 64;
                const bool merged = (G == 256) && args.coop;
                {
                    pg8::Gemm g{CKV, WUP + (size_t)l * 2048 * 512, MTOT, 2048, 512}; pg8::StaticOrder S; S.init(MTOT, 2048, G, bx);
                    EpiUp E{KB, VB, SS, args.in[16] + l * 128, xch};
                    pg8::gemm_phase<EpiUp>(lds, g, S, E, tid);
                    if (merged) {
                        if (threadIdx.x == 0) {
                            __builtin_amdgcn_fence(__ATOMIC_RELEASE, "agent");
                            asm volatile("s_waitcnt vmcnt(0)" ::: "memory");
                            const unsigned n = (bx < 544) ? (unsigned)((544 - 1 - bx) / G + 1) : 0u;
                            __hip_atomic_fetch_add(UPC, n, __ATOMIC_RELAXED, __HIP_MEMORY_SCOPE_AGENT);
                        }
                    } else if (args.coop) xcd_barrier(bar);
                }
                AttnBufs T{QA, KA, VA, QB, KB, VB, QC, KC, VC, GATE, BR, SCR, LAM + l * 4, args.in[24] + l * 128, 0.8f - 0.6f * expf(-0.3f * (float)l)};
                const int nctx = (l < DEPTH - 1) ? 96 : 0;
                for (int k = 0;; ++k) {
                    int type, b, h, qrow0, NT;
                    if (G == 256) {
                        if (k == 4 && merged) {
                            if (threadIdx.x == 0) { unsigned sp = 0;
                                while (__hip_atomic_load(UPC, __ATOMIC_RELAXED, __HIP_MEMORY_SCOPE_AGENT) < 544u) { __builtin_amdgcn_s_sleep(1); if (++sp > (1u << 22)) break; }
                                __builtin_amdgcn_fence(__ATOMIC_ACQUIRE, "agent");
                                asm volatile("s_waitcnt vmcnt(0)" ::: "memory"); }
                            __syncthreads();
                        }
                        if (k < 6) { const int id = (k & 1) * 256 + vcu; type = (k < 2) ? 0 : (k < 4 ? 2 : 1); b = id >> 7; h = (id >> 4) & 7; qrow0 = b * SEQ + (id & 15) * 256; NT = 68; }
                        else if (k == 6 && bx >= 256 - nctx) { const int c = bx - (256 - nctx); type = c >> 5; b = (c >> 3) & 3; h = c & 7; qrow0 = MLAT + b * CTXL; NT = 4; }
                        else break;
                    } else {
                        const int it = bx + k * G; if (it >= 1536 + nctx) break;
                        if (it < 1536) { const int id = it & 511; type = it >> 9; b = id >> 7; h = (id >> 4) & 7; qrow0 = b * SEQ + (id & 15) * 256; NT = 68; }
                        else { const int c = it - 1536; type = c >> 5; b = (c >> 3) & 3; h = c & 7; qrow0 = MLAT + b * CTXL; NT = 4; }
                    }
                    attn_item(T, type, b, h, qrow0, NT, (LAS char*)lds, tid);
                }
                __syncthreads();
            } else {
                unsigned* CNT = (unsigned*)(ws + WS_CNT) + (size_t)l * 68 * 64;
                const bool merged = (G == 256) && args.coop;
                const bool ctxl = l < DEPTH - 1;
                pg8::Gemm g3{BR, WBR + (size_t)l * 2048 * 3072, Mrows, 2048, 3072}; EpiBr E3{MRG, Y};
                pg8::Gemm g4{Y, WOUT + (size_t)l * DM * DM, Mrows, DM, DM}; EpiOut E4{xsrc, csrc, args.out, CTXW, modl};
                for (int part = 0; part < 2; ++part) {
                    pg8::StaticOrder S;
                    if (!merged) { if (part) break; S.init(Mrows, 2048, G, bx); }
                    else if (part == 0) S.init(MLAT, 2048, G, bx);
                    else { if (!(ctxl && bx < 32)) break; S.init_one(64 + (bx >> 3), bx & 7); }
                    { int t2 = threadIdx.x; asm volatile("" : "+v"(t2)); pg8::gemm_phase<EpiBr>(lds, g3, S, E3, t2); }
                    if (merged && threadIdx.x == 0) {
                        __builtin_amdgcn_fence(__ATOMIC_RELEASE, "agent");
                        asm volatile("s_waitcnt vmcnt(0)" ::: "memory");
                        pg8::Unit u; for (int i = 0; S.next(i, u); ++i) __hip_atomic_fetch_add(&CNT[u.pm * 64], 1u, __ATOMIC_RELAXED, __HIP_MEMORY_SCOPE_AGENT);
                    }
                }
                if (!merged && args.coop) xcd_barrier(bar);
                for (int part = 0; part < 3; ++part) {
                    pg8::StaticOrder S;
                    if (!merged) { if (part) break; S.init(Mrows, DM, G, bx); }
                    else if (part == 0) S.init(MLAT, DM, G, bx, 0, (ctxl && bx < 32) ? 1 : 2);
                    else if (part == 1) { if (!(ctxl && bx >= 32 && bx < 64)) continue; S.init_one(64 + ((bx - 32) >> 3), bx & 7); }
                    else { if (!(ctxl && bx >= 64 && bx < 96)) break; S.init(MLAT, DM, G, bx - 64, 1, 1); }
                    if (merged) {
                        if (threadIdx.x == 0) {
                            pg8::Unit u;
                            for (int i = 0; S.next(i, u); ++i) { unsigned sp = 0;
                                while (__hip_atomic_load(&CNT[u.pm * 64], __ATOMIC_RELAXED, __HIP_MEMORY_SCOPE_AGENT) < 8u) { __builtin_amdgcn_s_sleep(1); if (++sp > (1u << 22)) break; } }
                            __builtin_amdgcn_fence(__ATOMIC_ACQUIRE, "agent");
                            asm volatile("s_waitcnt vmcnt(0)" ::: "memory");
                        }
                        __syncthreads();
                    }
                    { int t2 = threadIdx.x; asm volatile("" : "+v"(t2)); pg8::gemm_phase<EpiOut>(lds, g4, S, E4, t2); }
                    if (merged && ctxl && threadIdx.x == 0) {
                        __builtin_amdgcn_fence(__ATOMIC_RELEASE, "agent");
                        asm volatile("s_waitcnt vmcnt(0)" ::: "memory");
                        pg8::Unit u; for (int i = 0; S.next(i, u); ++i) __hip_atomic_fetch_add(&CNT[(DEPTH * 68 + u.pm) * 64], 1u, __ATOMIC_RELAXED, __HIP_MEMORY_SCOPE_AGENT);
                    }
                }
                if (l < DEPTH - 1) {
                    const float* nw1 = args.in[4] + (size_t)(l + 1) * DM; const float* mod1 = MOD + (size_t)(l + 1) * 5 * 6144;
                    int t3 = threadIdx.x; asm volatile("" : "+v"(t3));
                    const int lane3 = t3 & 63, wave3 = __builtin_amdgcn_readfirstlane(t3 >> 6);
                    if (merged) {
                        const int r0 = 68 * bx;
                        if (threadIdx.x == 0) {
                            for (int pm = r0 >> 8; pm <= (r0 + 67) >> 8; ++pm) { unsigned sp = 0;
                                while (__hip_atomic_load(&CNT[(DEPTH * 68 + pm) * 64], __ATOMIC_RELAXED, __HIP_MEMORY_SCOPE_AGENT) < 8u) { __builtin_amdgcn_s_sleep(1); if (++sp > (1u << 22)) break; } }
                            __builtin_amdgcn_fence(__ATOMIC_ACQUIRE, "agent");
                            asm volatile("s_waitcnt vmcnt(0)" ::: "memory");
                        }
                        __syncthreads();
                        for (int row = r0 + wave3; row < r0 + 68; row += 16) { const int rb = row + 8; p1_row2(row, rb < r0 + 68 ? rb : -1, args.out, CTXW, mod1, nw1, H, lane3); }
                    } else {
                        if (args.coop) xcd_barrier(bar);
                        for (int row = bx * 8 + wave3; row < MTOT; row += G * 16) { const int rb = row + G * 8; p1_row2(row, rb < MTOT ? rb : -1, args.out, CTXW, mod1, nw1, H, lane3); }
                    }
                }
            }
        }
        if (ph + 1 < args.ph_hi) { if (args.coop) { if (ph == 0) cg::this_grid().sync(); else xcd_barrier(bar); } }
    }
}

extern "C" void kernel_launch(void* const* d_in, const int* in_sizes, int n_in, void* d_out, int out_size, void* d_ws, size_t ws_size, hipStream_t stream) {
    static int grid = 0;
    if (grid == 0) {
        if (n_in != 29 || in_sizes[0] != MLAT * DM || out_size != MLAT * DM || ws_size < WS_END) {
            fprintf(stderr, "kernel_launch: unexpected shapes: n_in %d in0 %d out %d ws %zu (need %zu)\n", n_in, n_in > 0 ? in_sizes[0] : -1, out_size, ws_size, (size_t)WS_END); grid = -1; return; }
        int dev = 0, cus = 0, per_cu = 0;
        if (hipGetDevice(&dev) != hipSuccess || hipDeviceGetAttribute(&cus, hipDeviceAttributeMultiprocessorCount, dev) != hipSuccess) { grid = -1; return; }
        if (hipFuncSetAttribute((const void*)mega_fwd, hipFuncAttributeMaxDynamicSharedMemorySize, LDS_BYTES) != hipSuccess) { fprintf(stderr, "kernel_launch: hipFuncSetAttribute failed\n"); grid = -1; return; }
        if (hipOccupancyMaxActiveBlocksPerMultiprocessor(&per_cu, (const void*)mega_fwd, 512, LDS_BYTES) != hipSuccess || per_cu < 1) { fprintf(stderr, "kernel_launch: occupancy query gives %d\n", per_cu); per_cu = 1; }
        (void)hipGetLastError();
        grid = cus * 1;
    }
    if (grid < 0) return;
    Args a{};
    for (int i = 0; i < 29; ++i) a.in[i] = (const float*)d_in[i];
    a.out = (float*)d_out; a.ws = (unsigned char*)d_ws;
#if MK_COOP
    if (hipMemsetAsync((char*)d_ws + WS_BAR, 0, 16384 + CNT_BYTES, stream) != hipSuccess) { fprintf(stderr, "kernel_launch: memset of the barrier words failed\n"); return; }
    a.ph_lo = 0; a.ph_hi = NPH; a.coop = 1;
    void* kargs[] = {&a};
    hipError_t e = hipLaunchCooperativeKernel((const void*)mega_fwd, dim3(grid), dim3(512), kargs, LDS_BYTES, stream);
    if (e != hipSuccess) fprintf(stderr, "kernel_launch: cooperative launch failed: %s (grid %d)\n", hipGetErrorString(e), grid);
#else
    for (int ph = 0; ph < NPH; ++ph) {
        a.ph_lo = ph; a.ph_hi = ph + 1; a.coop = 0;
        hipLaunchKernelGGL(mega_fwd, dim3(grid), dim3(512), LDS_BYTES, stream, a);
    }
    const hipError_t le = hipPeekAtLastError();
    if (le != hipSuccess) fprintf(stderr, "kernel_launch: launch failed: %s\n", hipGetErrorName(le));
#endif
}
```
